# Optimizing an MI355X kernel written in HIP

```python
import jax, jax.numpy as jnp
from jax import lax
import numpy as np

D_MODEL = 1024
BATCH = 2
SEQ = 8192
DEPTH = 2

CTX_LEN = 256
GRID_W = 64
EPS = 1e-6

GLA_HEADS = 4
GLA_DK = 32
GLA_DV = 64
GLA_QK = GLA_HEADS * GLA_DK
W_GLA = GLA_HEADS * GLA_DV
GLA_RANK = 16
GLA_TAU = 16.0
GLA_CHUNK = 64
GLA_GATE_BIAS = 2.0
FFT_GROUPS = 4
FFT_DG = 64
W_FFT = FFT_GROUPS * FFT_DG
W_CONV = 256
CONV_WIDTH = 3
POOL_WINDOWS = (2, 4, 8, 16)
POOL_GROUPS = 4
POOL_DG = 64
W_POOL = POOL_GROUPS * POOL_DG
D_MIX = W_GLA + W_FFT + W_CONV + W_POOL
D_FF = 2816

COL_SIZES = (GLA_QK, W_GLA, GLA_RANK, GLA_RANK, GLA_QK, W_GLA, W_FFT, W_CONV, W_CONV, W_CONV, W_POOL)
D_IN = sum(COL_SIZES)
SPLITS = tuple(int(s) for s in np.cumsum(COL_SIZES)[:-1])
KVA_COLS = GLA_QK + W_GLA + 2 * GLA_RANK

kernel_name = "hybrid_parallel_gla_fnet_conv_pool_dit"


def rmsnorm(x, g):
    xf = x.astype(jnp.float32)
    y = xf * lax.rsqrt(jnp.mean(xf * xf, axis=-1, keepdims=True) + EPS)
    return (y * g.astype(jnp.float32)).astype(x.dtype)


def on_grid(fn, u, grid):
    if not grid:
        return fn(u)
    b, n, ch = u.shape
    rows = n // GRID_W
    return fn(u.reshape(b, rows, GRID_W, ch)).reshape(b, n, ch)


def dwconv3(u, w, bias):
    pad = [(0, 0)] * (u.ndim - 2) + [(1, 1), (0, 0)]
    up = jnp.pad(u, pad)
    return up[..., :-2, :] * w[0] + up[..., 1:-1, :] * w[1] + up[..., 2:, :] * w[2] + bias


def pool_minus_self(u, window):
    n = u.shape[-2]
    t = np.arange(n)
    lo = np.clip(t - window // 2, 0, n - 1)
    hi = np.clip(t + window // 2 - 1, 0, n - 1)
    count = jnp.asarray((hi - lo + 1).astype(np.float32)[:, None])
    uf = u.astype(jnp.float32)
    cs = jnp.cumsum(uf, axis=-2)
    cs = jnp.concatenate([jnp.zeros_like(cs[..., :1, :]), cs], axis=-2)
    total = jnp.take(cs, hi + 1, axis=-2) - jnp.take(cs, lo, axis=-2)
    return (total / count - uf).astype(u.dtype)


def pool_mixer(u, w_pool, scale, grid):
    def f(z):
        return jnp.concatenate(
            [pool_minus_self(z[..., i * POOL_DG:(i + 1) * POOL_DG], w) for i, w in enumerate(POOL_WINDOWS)],
            axis=-1)
    p = on_grid(f, u, grid)
    b, n, _ = u.shape
    y = jnp.einsum('bngc,gcd->bngd', p.reshape(b, n, POOL_GROUPS, POOL_DG), w_pool)
    return y.reshape(b, n, W_POOL) * scale


def fourier_mixer(u, w_f):
    b, n, _ = u.shape
    uf = u.astype(jnp.float32).reshape(b, n, FFT_GROUPS, FFT_DG)
    f = jnp.fft.fft2(uf, axes=(1, 3), norm='ortho').real.astype(u.dtype)
    y = jnp.einsum('bngc,gcd->bngd', f, w_f)
    return y.reshape(b, n, W_FFT)


def gla_kv_decay(p_k, p_v, p_af, p_ab, w_a2, b_a2):
    b, n, _ = p_k.shape
    k = p_k.astype(jnp.float32).reshape(b, n, GLA_HEADS, GLA_DK)
    v = p_v.astype(jnp.float32).reshape(b, n, GLA_HEADS, GLA_DV)
    la_f = jax.nn.log_sigmoid((p_af @ w_a2[0] + b_a2[0]).astype(jnp.float32)) / GLA_TAU
    la_b = jax.nn.log_sigmoid((p_ab @ w_a2[1] + b_a2[1]).astype(jnp.float32)) / GLA_TAU
    return (k, v, la_f.reshape(b, n, GLA_HEADS, GLA_DK), la_b.reshape(b, n, GLA_HEADS, GLA_DK))


def gla_chunked(q, k, v, log_a, h0):
    b, n, h, dk = q.shape
    dv = v.shape[-1]
    nc = n // GLA_CHUNK
    causal = np.tril(np.ones((GLA_CHUNK, GLA_CHUNK), dtype=bool))[None, :, :, None, None]

    def to_chunks(t):
        return t.reshape(b, nc, GLA_CHUNK, h, t.shape[-1]).swapaxes(0, 1)

    def step(state, inp):
        qc, kc, vc, ac = inp
        cum = jnp.cumsum(ac, axis=1)
        o_inter = jnp.einsum('bihk,bhkv->bihv', qc * jnp.exp(cum), state)
        diff = cum[:, :, None] - cum[:, None, :]
        decay = jnp.where(causal, jnp.exp(jnp.minimum(diff, 0.0)), 0.0)
        attn = jnp.einsum('bihk,bjhk,bijhk->bhij', qc, kc, decay)
        o_intra = jnp.einsum('bhij,bjhv->bihv', attn, vc)
        last = cum[:, -1]
        k_dec = kc * jnp.exp(last[:, None] - cum)
        new_state = state * jnp.exp(last)[..., None] + jnp.einsum('bjhk,bjhv->bhkv', k_dec, vc)
        return new_state, o_intra + o_inter

    state, o = lax.scan(step, h0, (to_chunks(q), to_chunks(k), to_chunks(v), to_chunks(log_a)))
    return o.swapaxes(0, 1).reshape(b, n, h, dv), state


def gla_final_state(k, v, log_a):
    cum = jnp.cumsum(log_a, axis=1)
    return jnp.einsum('blhk,blhv->bhkv', k * jnp.exp(cum[:, -1:] - cum), v)


def mixers(p, grid, h0_f, h0_b, w_a2, b_a2, gla_g, fft_w, conv_w, conv_b, pool_w, pool_scale):
    p_k, p_v, p_af, p_ab, p_q, p_g, p_fft, p_h, p_bg, p_cg, p_pool = jnp.split(p, SPLITS, axis=-1)
    b, n, _ = p.shape
    k, v, la_f, la_b = gla_kv_decay(p_k, p_v, p_af, p_ab, w_a2, b_a2)
    q = p_q.astype(jnp.float32).reshape(b, n, GLA_HEADS, GLA_DK) * (GLA_DK ** -0.5)
    o_f, s_f = gla_chunked(q, k, v, la_f, h0_f)
    o_b, s_b = gla_chunked(jnp.flip(q, 1), jnp.flip(k, 1), jnp.flip(v, 1), jnp.flip(la_b, 1), h0_b)
    o = rmsnorm(o_f + jnp.flip(o_b, 1), gla_g)
    o = o * jax.nn.silu(p_g.astype(jnp.float32).reshape(b, n, GLA_HEADS, GLA_DV))
    y_gla = o.reshape(b, n, W_GLA).astype(p.dtype)
    y_fft = fourier_mixer(p_fft, fft_w)
    y_conv = p_bg * on_grid(lambda z: dwconv3(z, conv_w, conv_b), p_cg * p_h, grid)
    y_pool = pool_mixer(p_pool, pool_w, pool_scale, grid)
    return jnp.concatenate([y_gla, y_fft, y_conv, y_pool], axis=-1), (s_f, s_b)


def conv_ffn(h, grid, w_up, cw, cb, w_down):
    a, u = jnp.split(h @ w_up, 2, axis=-1)
    a = on_grid(lambda z: dwconv3(z, cw, cb), a, grid)
    return (jax.nn.silu(a) * u) @ w_down


def setup_inputs(seed: int = 0) -> dict:
    key = jax.random.key(seed)
    ks = jax.random.split(key, 23)
    D = D_MODEL

    def nrm(k, shape, scale):
        return jax.random.normal(k, shape, jnp.float32) * scale

    return {
        'x': nrm(ks[0], (BATCH, SEQ, D), 1.0),
        'c': nrm(ks[1], (BATCH, D), 1.0),
        'ctx': nrm(ks[2], (BATCH, CTX_LEN, D), 1.0),
        'c_ctx': nrm(ks[3], (D,), 1.0),
        'norm1_g': 1.0 + nrm(ks[4], (DEPTH, D), 0.02),
        'norm2_g': 1.0 + nrm(ks[5], (DEPTH, D), 0.02),
        'w_mod': nrm(ks[6], (DEPTH, D, 6 * D), 0.5 * D ** -0.5),
        'b_mod': nrm(ks[7], (DEPTH, 6 * D), 0.02),
        'w_in': nrm(ks[8], (DEPTH, D, D_IN), D ** -0.5),
        'gla_w_a2': nrm(ks[9], (DEPTH, 2, GLA_RANK, GLA_QK), GLA_RANK ** -0.5),
        'gla_b_a2': GLA_GATE_BIAS + nrm(ks[10], (DEPTH, 2, GLA_QK), 0.1),
        'gla_norm_g': 1.0 + nrm(ks[11], (DEPTH, GLA_DV), 0.02),
        'fft_w': nrm(ks[12], (DEPTH, FFT_GROUPS, FFT_DG, FFT_DG), FFT_DG ** -0.5),
        'conv_w': nrm(ks[13], (DEPTH, CONV_WIDTH, W_CONV), CONV_WIDTH ** -0.5),
        'conv_b': nrm(ks[14], (DEPTH, W_CONV), 0.02),
        'pool_w': nrm(ks[15], (DEPTH, POOL_GROUPS, POOL_DG, POOL_DG), POOL_DG ** -0.5),
        'pool_scale': 1.0 + nrm(ks[16], (DEPTH, W_POOL), 0.1),
        'w_out': nrm(ks[17], (DEPTH, D_MIX, D), D_MIX ** -0.5),
        'ffn_w_up': nrm(ks[18], (DEPTH, D, 2 * D_FF), D ** -0.5),
        'ffn_conv_w': nrm(ks[19], (DEPTH, CONV_WIDTH, D_FF), CONV_WIDTH ** -0.5),
        'ffn_conv_b': nrm(ks[20], (DEPTH, D_FF), 0.02),
        'ffn_w_down': nrm(ks[21], (DEPTH, D_FF, D), D_FF ** -0.5),
        'final_norm_g': 1.0 + nrm(ks[22], (D,), 0.02),
    }


def reference(x, c, ctx, c_ctx, norm1_g, norm2_g, w_mod, b_mod, w_in, gla_w_a2, gla_b_a2, gla_norm_g,
              fft_w, conv_w, conv_b, pool_w, pool_scale, w_out, ffn_w_up, ffn_conv_w, ffn_conv_b,
              ffn_w_down, final_norm_g):
    D = D_MODEL
    s_lat = jax.nn.silu(c)
    s_ctx = jax.nn.silu(c_ctx)
    xc = ctx
    for i in range(DEPTH):
        last = i == DEPTH - 1
        if last:
            mod_c = s_ctx @ w_mod[i][:, :2 * D] + b_mod[i][:2 * D]
            csh1, csc1 = jnp.split(mod_c, 2)
            hc = rmsnorm(xc, norm1_g[i]) * (1 + csc1) + csh1
            pc = hc @ w_in[i][:, :KVA_COLS]
            pk, pv, paf, pab = jnp.split(pc, SPLITS[:3], axis=-1)
            k_c, v_c, la_f_c, la_b_c = gla_kv_decay(pk, pv, paf, pab, gla_w_a2[i], gla_b_a2[i])
            h_f = gla_final_state(k_c, v_c, la_f_c)
            h_b = gla_final_state(jnp.flip(k_c, 1), jnp.flip(v_c, 1), jnp.flip(la_b_c, 1))
        else:
            mod_c = s_ctx @ w_mod[i] + b_mod[i]
            csh1, csc1, cg1, csh2, csc2, cg2 = jnp.split(mod_c, 6)
            hc = rmsnorm(xc, norm1_g[i]) * (1 + csc1) + csh1
            zeros = jnp.zeros((xc.shape[0], GLA_HEADS, GLA_DK, GLA_DV), jnp.float32)
            yc, (h_f, h_b) = mixers(hc @ w_in[i], False, zeros, zeros, gla_w_a2[i], gla_b_a2[i],
                                    gla_norm_g[i], fft_w[i], conv_w[i], conv_b[i], pool_w[i], pool_scale[i])
            xc = xc + cg1 * (yc @ w_out[i])
            hc2 = rmsnorm(xc, norm2_g[i]) * (1 + csc2) + csh2
            xc = xc + cg2 * conv_ffn(hc2, False, ffn_w_up[i], ffn_conv_w[i], ffn_conv_b[i], ffn_w_down[i])
        mod = s_lat @ w_mod[i] + b_mod[i]
        sh1, sc1, g1, sh2, sc2, g2 = [m[:, None, :] for m in jnp.split(mod, 6, axis=-1)]
        hx = rmsnorm(x, norm1_g[i]) * (1 + sc1) + sh1
        yx, _ = mixers(hx @ w_in[i], True, h_f, h_b, gla_w_a2[i], gla_b_a2[i], gla_norm_g[i],
                       fft_w[i], conv_w[i], conv_b[i], pool_w[i], pool_scale[i])
        x = x + g1 * (yx @ w_out[i])
        hx2 = rmsnorm(x, norm2_g[i]) * (1 + sc2) + sh2
        x = x + g2 * conv_ffn(hx2, True, ffn_w_up[i], ffn_conv_w[i], ffn_conv_b[i], ffn_w_down[i])
    return rmsnorm(x, final_norm_g)
```

```cpp
#include <hip/hip_runtime.h>
#include <hip/hip_cooperative_groups.h>
#include <cstdio>
#include <cstdint>
namespace cg = cooperative_groups;
namespace pg8 {
#define PG8_LAS __attribute__((address_space(3)))
typedef unsigned short bf16_t;
typedef short bf16x8 __attribute__((ext_vector_type(8)));
typedef float f32x4 __attribute__((ext_vector_type(4)));
typedef unsigned u32x4 __attribute__((ext_vector_type(4)));
constexpr int BM = 256, BK = 64, HALF = 128, HTB = HALF * BK * 2  , STAGE_BYTES = 8 * HTB, NXCD = 8, WGM = 8;

__host__ __device__ __forceinline__ int lds_byte(int r, int c) { const int st = (r >> 4) * 2 + (c >> 5), rr = r & 15, cc = c & 31, ob = rr * 64 + cc * 2; return st * 1024 + (ob ^ (((ob >> 9) & 1) << 5)); }
__host__ __device__ __forceinline__ void stage_rc(int b, int& R, int& C) { const int st = b / 1024, sb = b % 1024, swz = sb ^ (((sb >> 9) & 1) << 5); R = (st >> 1) * 16 + swz / 64; C = (st & 1) * 32 + (swz % 64) / 2; }
__host__ __device__ __forceinline__ int perm32(int rho) { const int n = rho >> 4, i = rho & 15; return 8 * (i >> 2) + 4 * n + (i & 3); }

struct Unit { int pm, pn, ks; };
struct Gemm { const bf16_t* A; const bf16_t* Bt; int M, N, K, ld; };

struct StaticOrder {
    int nM, nN, nwg, G, c;
    __host__ __device__ void init(int M, int N, int G_, int c_) { nM = M / BM; nN = N / BM; nwg = nM * nN; G = G_; c = c_; }
    __host__ __device__ bool next(int i, Unit& u) const {
        const long L = (long)i * G + c; if (L >= nwg) return false;
        int wgid = (int)L; { const int q = nwg / NXCD, r = nwg % NXCD, xcd = wgid % NXCD, off = wgid / NXCD; wgid = (xcd < r ? xcd * (q + 1) : r * (q + 1) + (xcd - r) * q) + off; }
        const int nig = WGM * nN, gid = wgid / nig, fm = gid * WGM, gsz = (nM - fm) < WGM ? (nM - fm) : WGM;
        u.pm = fm + ((wgid % nig) % gsz); u.pn = (wgid % nig) / gsz; u.ks = 0; return true;
    }
    __device__ __forceinline__ void a_ready(const Unit&) const {}
    __device__ __forceinline__ void done(const Unit&) const {}
};

__device__ __forceinline__ unsigned cvt_pk_bf16(float lo, float hi) { unsigned r; asm volatile("v_cvt_pk_bf16_f32 %0, %1, %2" : "=v"(r) : "v"(lo), "v"(hi)); return r; }
template <class Epi, class Sched, bool ALIGN_EPI = false, bool SP2 = false>
__device__ __forceinline__ void gemm_phase(PG8_LAS unsigned char* lds, const Gemm g, const Sched& S, const Epi& E, int tid_in) {
    int tid_ = tid_in; asm volatile("" : "+v"(tid_)); const int tid = tid_, wid = __builtin_amdgcn_readfirstlane(tid >> 6), lane = tid & 63, wr = wid >> 2, wc = wid & 3, fr = lane & 15, fq = lane >> 4;
    const int K = g.ld, nt = g.K / BK; const size_t sstep = (size_t)g.K * 2;
    unsigned voffA[2], voffB[2];
#pragma unroll
    for (int i = 0; i < 2; ++i) { int R, C; stage_rc(tid * 16 + i * 8192, R, C); const int Rb = Epi::PERM ? ((R & ~31) + perm32(R & 31)) : R;
        voffA[i] = (unsigned)(R * K + C) * 2u; voffB[i] = (unsigned)(Rb * K + C) * 2u; }
    const size_t kstep = (size_t)(BK * 2);
    const size_t hstep = (size_t)HALF * K * 2;
    const size_t tstep = 2 * hstep;
    const unsigned ldsw = (unsigned)wid * 1024u;
    const int aoff = lds_byte(wr * 64 + fr, fq * 8), boff = lds_byte(wc * 32 + fr, fq * 8);
#define PG8_SA(b, h) (((b) * 2 + (h)) * HTB)
#define PG8_SB(b, h) ((4 + (b) * 2 + (h)) * HTB)
#define PG8_STAGE(bufoff, gbase, voff) do { _Pragma("unroll") for (int _i = 0; _i < 2; ++_i) \
        __builtin_amdgcn_global_load_lds((const unsigned*)((const char*)(gbase) + (voff)[_i]), (PG8_LAS unsigned*)(lds + (bufoff) + ldsw + _i * 8192), 16, 0, 0); } while (0)
#define PG8_LDA(dst, b, h) do { _Pragma("unroll") for (int m = 0; m < 4; ++m) _Pragma("unroll") for (int k = 0; k < 2; ++k) dst[m][k] = *(const PG8_LAS bf16x8*)(lds + PG8_SA(b, h) + aoff + m * 2048 + k * 1024); } while (0)
#define PG8_LDB(dst, b, h) do { _Pragma("unroll") for (int n = 0; n < 2; ++n) _Pragma("unroll") for (int k = 0; k < 2; ++k) dst[n][k] = *(const PG8_LAS bf16x8*)(lds + PG8_SB(b, h) + boff + n * 2048 + k * 1024); } while (0)
#define PG8_MMA(ai, bj, At, Bt) do { __builtin_amdgcn_s_setprio(1); _Pragma("unroll") for (int m = 0; m < 4; ++m) _Pragma("unroll") for (int n = 0; n < 2; ++n) _Pragma("unroll") for (int k = 0; k < 2; ++k) \
        acc[ai][bj][m][n] = __builtin_amdgcn_mfma_f32_16x16x32_bf16(Bt[n][k], At[m][k], acc[ai][bj][m][n], 0, 0, 0); __builtin_amdgcn_s_setprio(0); } while (0)
#define PG8_WAIT_V(n) asm volatile("s_waitcnt vmcnt(" #n ")" ::: "memory")
#define PG8_WAIT_L(n) asm volatile("s_waitcnt lgkmcnt(" #n ")" ::: "memory")
#define PG8_BAR __builtin_amdgcn_s_barrier()
#define PG8_SCHED __builtin_amdgcn_sched_barrier(0)
    Unit cur, nxt; int ui = 0;
    if (!S.next(0, cur)) return;
    f32x4 acc[2][2][4][2];
#pragma unroll
    for (int a = 0; a < 2; ++a)
#pragma unroll
        for (int b = 0; b < 2; ++b)
#pragma unroll
            for (int m = 0; m < 4; ++m)
#pragma unroll
                for (int n = 0; n < 2; ++n) acc[a][b][m][n] = (f32x4){0.f, 0.f, 0.f, 0.f};
    bf16x8 At[4][2], B0[2][2], B1[2][2];
    const char* cA = (const char*)g.A + (size_t)cur.pm * tstep + (size_t)cur.ks * sstep; const char* cB = (const char*)g.Bt + (size_t)cur.pn * tstep + (size_t)cur.ks * sstep;
    S.a_ready(cur);
    if constexpr (SP2) {
        PG8_STAGE(PG8_SB(0, 0), cB, voffB); PG8_STAGE(PG8_SB(0, 1), cB + hstep, voffB); PG8_STAGE(PG8_SA(0, 0), cA, voffA); PG8_STAGE(PG8_SA(0, 1), cA + hstep, voffA);
        if (wr == 1) PG8_BAR;
        PG8_WAIT_V(2); PG8_BAR;
        PG8_STAGE(PG8_SB(1, 0), cB + kstep, voffB); PG8_STAGE(PG8_SA(1, 0), cA + kstep, voffA); PG8_STAGE(PG8_SB(1, 1), cB + hstep + kstep, voffB);
        PG8_WAIT_V(6); PG8_BAR;
    } else {
        PG8_STAGE(PG8_SB(0, 0), cB, voffB); PG8_STAGE(PG8_SA(0, 0), cA, voffA); PG8_STAGE(PG8_SB(0, 1), cB + hstep, voffB); PG8_STAGE(PG8_SA(0, 1), cA + hstep, voffA);
        if (wr == 1) PG8_BAR;
        PG8_WAIT_V(4); PG8_BAR;
        PG8_STAGE(PG8_SB(1, 0), cB + kstep, voffB); PG8_STAGE(PG8_SA(1, 0), cA + kstep, voffA); PG8_STAGE(PG8_SB(1, 1), cB + hstep + kstep, voffB);
        PG8_WAIT_V(6); PG8_BAR;
    }
    for (;;) {
        const bool has_next = S.next(ui + 1, nxt);
        const char* nA = has_next ? (const char*)g.A + (size_t)nxt.pm * tstep + (size_t)nxt.ks * sstep : cA; const char* nB = has_next ? (const char*)g.Bt + (size_t)nxt.pn * tstep + (size_t)nxt.ks * sstep : cB;
        for (int t = 0; t < nt; t += 2) {
            const bool last = (t == nt - 2);
            const char* a1 = cA + (size_t)(t + 1) * kstep;
            const char* a2 = last ? nA : cA + (size_t)(t + 2) * kstep; const char* b2 = last ? nB : cB + (size_t)(t + 2) * kstep;
            const char* a3 = a2 + kstep; const char* b3 = b2 + kstep;
            if (last && has_next) S.a_ready(nxt);
            if constexpr (SP2) {
            PG8_LDB(B0, 0, 0); PG8_LDB(B1, 0, 1); PG8_SCHED; PG8_LDA(At, 0, 0); PG8_STAGE(PG8_SA(1, 1), a1 + hstep, voffA);
            PG8_WAIT_V(8); PG8_WAIT_L(0); PG8_BAR; PG8_MMA(0, 0, At, B0); PG8_MMA(0, 1, At, B1); PG8_BAR; PG8_SCHED;
            PG8_LDA(At, 0, 1); PG8_STAGE(PG8_SB(0, 0), b2, voffB); PG8_STAGE(PG8_SB(0, 1), b2 + hstep, voffB); PG8_STAGE(PG8_SA(0, 0), a2, voffA);
            PG8_WAIT_V(8); PG8_WAIT_L(0); PG8_BAR; PG8_MMA(1, 0, At, B0); PG8_MMA(1, 1, At, B1); PG8_BAR; PG8_SCHED;
            PG8_LDB(B0, 1, 0); PG8_LDB(B1, 1, 1); PG8_SCHED; PG8_LDA(At, 1, 0); PG8_STAGE(PG8_SA(0, 1), a2 + hstep, voffA);
            PG8_WAIT_V(8); PG8_WAIT_L(0); PG8_BAR; PG8_MMA(0, 0, At, B0); PG8_MMA(0, 1, At, B1); PG8_BAR; PG8_SCHED;
            PG8_LDA(At, 1, 1); PG8_STAGE(PG8_SB(1, 0), b3, voffB); PG8_STAGE(PG8_SB(1, 1), b3 + hstep, voffB); PG8_STAGE(PG8_SA(1, 0), a3, voffA);
            PG8_WAIT_V(8); PG8_WAIT_L(0); PG8_BAR; PG8_MMA(1, 0, At, B0); PG8_MMA(1, 1, At, B1); PG8_BAR; PG8_SCHED;
            } else {
            PG8_LDB(B0, 0, 0); PG8_SCHED; PG8_LDA(At, 0, 0); PG8_STAGE(PG8_SA(1, 1), a1 + hstep, voffA);
            PG8_WAIT_L(8); PG8_BAR; PG8_WAIT_L(0); PG8_MMA(0, 0, At, B0); PG8_BAR; PG8_SCHED;
            PG8_LDB(B1, 0, 1); PG8_STAGE(PG8_SB(0, 0), b2, voffB);
            PG8_BAR; PG8_WAIT_L(0); PG8_MMA(0, 1, At, B1); PG8_BAR;
            PG8_LDA(At, 0, 1); PG8_STAGE(PG8_SA(0, 0), a2, voffA);
            PG8_BAR; PG8_WAIT_L(0); PG8_MMA(1, 0, At, B0); PG8_BAR; PG8_SCHED;
            PG8_STAGE(PG8_SB(0, 1), b2 + hstep, voffB);
            PG8_WAIT_V(6); PG8_BAR; PG8_MMA(1, 1, At, B1); PG8_BAR;
            PG8_LDB(B0, 1, 0); PG8_SCHED; PG8_LDA(At, 1, 0); PG8_STAGE(PG8_SA(0, 1), a2 + hstep, voffA);
            PG8_WAIT_L(8); PG8_BAR; PG8_WAIT_L(0); PG8_MMA(0, 0, At, B0); PG8_BAR; PG8_SCHED;
            PG8_LDB(B1, 1, 1); PG8_STAGE(PG8_SB(1, 0), b3, voffB);
            PG8_BAR; PG8_WAIT_L(0); PG8_MMA(0, 1, At, B1); PG8_BAR;
            PG8_LDA(At, 1, 1); PG8_STAGE(PG8_SA(1, 0), a3, voffA);
            PG8_BAR; PG8_WAIT_L(0); PG8_MMA(1, 0, At, B0); PG8_BAR; PG8_SCHED;
            PG8_STAGE(PG8_SB(1, 1), b3 + hstep, voffB);
            PG8_WAIT_V(6); PG8_BAR; PG8_MMA(1, 1, At, B1); PG8_BAR;
            }
        }
        if constexpr (ALIGN_EPI) { if (wr == 0) PG8_BAR; }
        if constexpr (!Epi::AFTER_DRAIN) { E(acc, cur, wr, wc, fr, fq); S.done(cur); }
        if (!has_next) break;
#pragma unroll
        for (int a = 0; a < 2; ++a)
#pragma unroll
            for (int b = 0; b < 2; ++b)
#pragma unroll
                for (int m = 0; m < 4; ++m)
#pragma unroll
                    for (int n = 0; n < 2; ++n) acc[a][b][m][n] = (f32x4){0.f, 0.f, 0.f, 0.f};
        cur = nxt; cA = nA; cB = nB; ++ui;
        if constexpr (ALIGN_EPI) { if (wr == 1) PG8_BAR; }
    }
    PG8_WAIT_V(0);
    if constexpr (!ALIGN_EPI) { if (wr == 0) PG8_BAR; }
    PG8_BAR;
    if constexpr (Epi::AFTER_DRAIN) { E.fused(acc, cur, wr, wc, fr, fq, lds, wid, lane); S.done(cur); }
#undef PG8_SA
#undef PG8_SB
#undef PG8_STAGE
#undef PG8_LDA
#undef PG8_LDB
#undef PG8_MMA
#undef PG8_WAIT_V
#undef PG8_WAIT_L
#undef PG8_BAR
#undef PG8_SCHED
}
}
#define LAS __attribute__((address_space(3)))
typedef unsigned short bf16;
typedef float f32x4 __attribute__((ext_vector_type(4)));
typedef short bf16x8 __attribute__((ext_vector_type(8)));
typedef unsigned u32x4 __attribute__((ext_vector_type(4)));
typedef unsigned u32x2 __attribute__((ext_vector_type(2)));
#define LDS_WAIT() asm volatile("s_waitcnt lgkmcnt(0)" ::: "memory")

constexpr int D = 1024, SEQ = 8192, ML = 16384, MC = 512, MT = ML + MC, CTXL = 256;
constexpr int DIN = 2080, NP = 2560, DFF = 2816, NUP = 5632;
constexpr int PK = 0, PQ = 128, PV = 256, PLA = 512, PG = 768, PFA = 1024, PFB = 1280, PH = 1536, PBG = 1792, PCG = 2048, PPOOL = 2304;
constexpr int NCH = 132;
constexpr float EPS = 1e-6f;
constexpr size_t MiB = 1u << 20;
constexpr size_t WS_CTL = 0;
constexpr size_t WS_MOD = 1 * MiB;
constexpr size_t WS_MCS = 1 * MiB + 256 * 1024;
constexpr size_t WS_F1 = 1 * MiB + 512 * 1024;
constexpr size_t WS_F2 = WS_F1 + 32 * 1024;
constexpr size_t WS_FC = WS_F2 + 64 * 1024;
constexpr size_t WS_SLOT = 49 * MiB;
constexpr size_t WS_XB2 = 208 * MiB;
constexpr int CW_FIN = 3584;
constexpr size_t WS_W = 2 * MiB;
constexpr size_t W_IN_B = (size_t)NP * D * 2, W_OUT_B = (size_t)D * D * 2, W_UP_B = (size_t)NUP * D * 2, W_DN_B = (size_t)D * DFF * 2;
constexpr size_t W_LAYER_B = W_IN_B + W_OUT_B + W_UP_B + W_DN_B;
constexpr size_t WS_HX = 50 * MiB;
constexpr size_t WS_YMIX = 83 * MiB;
constexpr size_t WS_P = 116 * MiB;
constexpr size_t WS_XC = 207 * MiB;
constexpr size_t WS_ST = 209 * MiB;
constexpr size_t WS_DEC = 226 * MiB;
constexpr size_t WS_CAU = 227 * MiB;
constexpr size_t WS_PART = 233 * MiB;
constexpr size_t WS_END = 255 * MiB;
static_assert(WS_W + 2 * W_LAYER_B <= WS_HX, "weights");
static_assert(WS_P + (size_t)MT * DFF * 2 <= WS_XC, "act");
constexpr int RING_BYTES = 131072, LDS_BYTES = 147456;

struct Params {
    const float *x, *c, *ctx, *c_ctx, *norm1_g, *norm2_g, *w_mod, *b_mod, *w_in, *w_a2, *b_a2, *gla_g, *fft_w, *conv_w, *conv_b, *pool_w,
        *pool_scale, *w_out, *w_up, *ffn_cw, *ffn_cb, *w_down, *final_g;
    float* out; unsigned char* ws;
};

typedef const __attribute__((address_space(4))) Params* PP;
__device__ __forceinline__ unsigned f2bf(float f) { unsigned u = __builtin_bit_cast(unsigned, f); return (u + 0x7fffu + ((u >> 16) & 1u)) >> 16; }
__device__ __forceinline__ unsigned pk2(float lo, float hi) { return f2bf(lo) | (f2bf(hi) << 16); }
__device__ __forceinline__ float bf2f(unsigned h) { return __builtin_bit_cast(float, h << 16); }
__device__ __forceinline__ float bflo(unsigned w) { return __builtin_bit_cast(float, w << 16); }
__device__ __forceinline__ float bfhi(unsigned w) { return __builtin_bit_cast(float, w & 0xffff0000u); }
__device__ __forceinline__ float shfl_f(float v, int src_lane) { return __builtin_bit_cast(float, __builtin_amdgcn_ds_bpermute(src_lane << 2, __builtin_bit_cast(int, v))); }
__device__ __forceinline__ float wave_sum(float v, int lane) {
#pragma unroll
    for (int o = 1; o < 64; o <<= 1) v += shfl_f(v, lane ^ o);
    return v;
}
__device__ __forceinline__ float silu_f(float x) { return x * __builtin_amdgcn_rcpf(1.f + __expf(-x)); }
__device__ __forceinline__ float cos_rev(float r) { return __builtin_amdgcn_cosf(r); }
__device__ __forceinline__ float sin_rev(float r) { return __builtin_amdgcn_sinf(r); }
__device__ __forceinline__ bf16x8 pack8(float a0, float a1, float a2, float a3, float a4, float a5, float a6, float a7) {
    u32x4 w; w.x = pk2(a0, a1); w.y = pk2(a2, a3); w.z = pk2(a4, a5); w.w = pk2(a6, a7); return __builtin_bit_cast(bf16x8, w);
}
#define MFMA16(a, b, c) __builtin_amdgcn_mfma_f32_16x16x32_bf16(a, b, c, 0, 0, 0)

struct EpiP {
    static constexpr bool PERM = true, AFTER_DRAIN = false;
    bf16* O; const float* ba2;
    __device__ __forceinline__ void operator()(const pg8::f32x4 (&acc)[2][2][4][2], const pg8::Unit& u, int wr, int wc, int fr, int fq) const {
        const int row0 = u.pm * 256 + wr * 64 + fr, col0 = u.pn * 256 + wc * 32 + 8 * fq;
        const bool la = (u.pn == 2);
#pragma unroll
        for (int ai = 0; ai < 2; ++ai)
#pragma unroll
            for (int m = 0; m < 4; ++m) { bf16* rowp = O + (size_t)(row0 + ai * 128 + m * 16) * NP + col0;
#pragma unroll
                for (int bj = 0; bj < 2; ++bj) { pg8::f32x4 v0 = acc[ai][bj][m][0], v1 = acc[ai][bj][m][1];
                    if (la) { const float* bp = ba2 + (col0 + bj * 128 - PLA); const f32x4 b0 = *(const f32x4*)bp, b1 = *(const f32x4*)(bp + 4);
#pragma unroll
                        for (int e = 0; e < 4; ++e) { float xa = v0[e] + b0[e], xb = v1[e] + b1[e];
                            v0[e] = (fminf(xa, 0.f) - __logf(1.f + __expf(-fabsf(xa)))) * 0.0625f; v1[e] = (fminf(xb, 0.f) - __logf(1.f + __expf(-fabsf(xb)))) * 0.0625f; } }
                    u32x4 w; w.x = pg8::cvt_pk_bf16(v0[0], v0[1]); w.y = pg8::cvt_pk_bf16(v0[2], v0[3]); w.z = pg8::cvt_pk_bf16(v1[0], v1[1]); w.w = pg8::cvt_pk_bf16(v1[2], v1[3]);
                    *(u32x4*)(rowp + bj * 128) = w; } }
    }
};
template <bool INB, bool OUTB>
struct EpiRes {
    static constexpr bool PERM = false, AFTER_DRAIN = false;
    const void* xin; void* out; const float* modg;
    __device__ __forceinline__ void operator()(const pg8::f32x4 (&acc)[2][2][4][2], const pg8::Unit& u, int wr, int wc, int fr, int fq) const {
        const int w = u.pm >> 5; const int cb = u.pn * 256 + wc * 32 + 4 * fq;
        f32x4 gv[2][2];
#pragma unroll
        for (int bj = 0; bj < 2; ++bj)
#pragma unroll
            for (int n = 0; n < 2; ++n) gv[bj][n] = *(const f32x4*)(modg + w * 6144 + cb + bj * 128 + 16 * n);
        constexpr int RG = INB ? 4 : 2;
#pragma unroll
        for (int ai = 0; ai < 2; ++ai)
#pragma unroll
            for (int mp = 0; mp < 4 / RG; ++mp) {
                u32x2 xb[RG][2][2]; f32x4 xf[INB ? 1 : RG][2][2];
#pragma unroll
                for (int mm = 0; mm < RG; ++mm) { const size_t ro = (size_t)(u.pm * 256 + ai * 128 + wr * 64 + (RG * mp + mm) * 16 + fr) * D + cb;
#pragma unroll
                    for (int bj = 0; bj < 2; ++bj)
#pragma unroll
                        for (int n = 0; n < 2; ++n) {
                            if (INB) xb[mm][bj][n] = *(const u32x2*)((const bf16*)xin + ro + bj * 128 + 16 * n);
                            else xf[INB ? 0 : mm][bj][n] = *(const f32x4*)((const float*)xin + ro + bj * 128 + 16 * n); } }
#pragma unroll
                for (int mm = 0; mm < RG; ++mm) { const int m = RG * mp + mm; const size_t ro = (size_t)(u.pm * 256 + ai * 128 + wr * 64 + m * 16 + fr) * D + cb;
#pragma unroll
                    for (int bj = 0; bj < 2; ++bj)
#pragma unroll
                        for (int n = 0; n < 2; ++n) { const pg8::f32x4 a = acc[ai][bj][m][n]; const f32x4 g4 = gv[bj][n]; f32x4 x;
                            if (INB) { const u32x2 t = xb[mm][bj][n]; x = (f32x4){bflo(t.x), bfhi(t.x), bflo(t.y), bfhi(t.y)}; } else x = xf[INB ? 0 : mm][bj][n];
                            f32x4 y; y[0] = x[0] + g4[0] * a[0]; y[1] = x[1] + g4[1] * a[1]; y[2] = x[2] + g4[2] * a[2]; y[3] = x[3] + g4[3] * a[3];
                            if (OUTB) { u32x2 pk; pk.x = pg8::cvt_pk_bf16(y[0], y[1]); pk.y = pg8::cvt_pk_bf16(y[2], y[3]); *(u32x2*)((bf16*)out + ro + bj * 128 + 16 * n) = pk; }
                            else *(f32x4*)((float*)out + ro + bj * 128 + 16 * n) = y; } }
            }
    }
};
struct EpiFinal {
    static constexpr bool PERM = false, AFTER_DRAIN = true;
    const bf16* xin; float* out; const float* modg; const float* gfin; float* slots; unsigned* cnt;
    __device__ __forceinline__ void fused(pg8::f32x4 (&acc)[2][2][4][2], const pg8::Unit& u, int wr, int wc, int fr, int fq, LAS unsigned char* lds, int wid, int lane) const {
        const int w = u.pm >> 5; const int cb = u.pn * 256 + wc * 32 + 4 * fq;
        LAS float* P = (LAS float*)lds;
        LAS float* S = (LAS float*)(lds + 4096);
        LAS unsigned* flag = (LAS unsigned*)(lds + 8192);
        f32x4 gv[2][2];
#pragma unroll
        for (int bj = 0; bj < 2; ++bj)
#pragma unroll
            for (int n = 0; n < 2; ++n) gv[bj][n] = *(const f32x4*)(modg + w * 6144 + cb + bj * 128 + 16 * n);
#pragma unroll
        for (int ai = 0; ai < 2; ++ai) {
            u32x2 xb[4][2][2];
#pragma unroll
            for (int m = 0; m < 4; ++m) { const size_t ro = (size_t)(u.pm * 256 + ai * 128 + wr * 64 + m * 16 + fr) * D + cb;
#pragma unroll
                for (int bj = 0; bj < 2; ++bj)
#pragma unroll
                    for (int n = 0; n < 2; ++n) xb[m][bj][n] = *(const u32x2*)(xin + ro + bj * 128 + 16 * n); }
#pragma unroll
            for (int m = 0; m < 4; ++m) { float sq = 0.f;
#pragma unroll
                for (int bj = 0; bj < 2; ++bj)
#pragma unroll
                    for (int n = 0; n < 2; ++n) { const u32x2 t = xb[m][bj][n]; const f32x4 g4 = gv[bj][n]; pg8::f32x4 a = acc[ai][bj][m][n];
                        a[0] = bflo(t.x) + g4[0] * a[0]; a[1] = bfhi(t.x) + g4[1] * a[1]; a[2] = bflo(t.y) + g4[2] * a[2]; a[3] = bfhi(t.y) + g4[3] * a[3];
                        acc[ai][bj][m][n] = a; sq += (a[0] * a[0] + a[1] * a[1]) + (a[2] * a[2] + a[3] * a[3]); }
                sq += shfl_f(sq, lane ^ 16); sq += shfl_f(sq, lane ^ 32);
                if (fq == 0) P[(ai * 128 + wr * 64 + m * 16 + fr) * 4 + wc] = sq; }
        }
        asm volatile("s_waitcnt lgkmcnt(0)" ::: "memory"); __builtin_amdgcn_s_barrier(); asm volatile("" ::: "memory");
        const int row = wid * 32 + (lane & 31);
        if (lane < 32) { const float t = (P[row * 4 + 0] + P[row * 4 + 1]) + (P[row * 4 + 2] + P[row * 4 + 3]);
            __hip_atomic_store(slots + ((size_t)(u.pm * 256 + row) * 4 + u.pn), t, __ATOMIC_RELAXED, __HIP_MEMORY_SCOPE_AGENT); }
        asm volatile("s_waitcnt vmcnt(0)" ::: "memory");
        if (lane == 0) (void)__hip_atomic_fetch_add(cnt + 64 * u.pm, 1u, __ATOMIC_RELAXED, __HIP_MEMORY_SCOPE_AGENT);
        if (wid == 0) { unsigned sp = 0;
            while ((unsigned)__builtin_amdgcn_readfirstlane((int)__hip_atomic_load(cnt + 64 * u.pm, __ATOMIC_RELAXED, __HIP_MEMORY_SCOPE_AGENT)) < 32u) { __builtin_amdgcn_s_sleep(2); if (++sp > (1u << 22)) break; }
            __builtin_amdgcn_fence(__ATOMIC_ACQUIRE, "agent");
            if (lane == 0) flag[0] = 1u; }
        asm volatile("s_waitcnt vmcnt(0) lgkmcnt(0)" ::: "memory"); __builtin_amdgcn_s_barrier(); asm volatile("" ::: "memory");
        if (lane < 32) { const float* sl = slots + (size_t)(u.pm * 256 + row) * 4; float t = 0.f;
#pragma unroll
            for (int q = 0; q < 4; ++q) t += __hip_atomic_load(sl + q, __ATOMIC_RELAXED, __HIP_MEMORY_SCOPE_AGENT);
            S[row] = 1.f / sqrtf(t * (1.f / D) + EPS); }
        asm volatile("s_waitcnt vmcnt(0) lgkmcnt(0)" ::: "memory"); __builtin_amdgcn_s_barrier(); asm volatile("" ::: "memory");
        f32x4 gf[2][2];
#pragma unroll
        for (int bj = 0; bj < 2; ++bj)
#pragma unroll
            for (int n = 0; n < 2; ++n) gf[bj][n] = *(const f32x4*)(gfin + cb + bj * 128 + 16 * n);
#pragma unroll
        for (int ai = 0; ai < 2; ++ai)
#pragma unroll
            for (int m = 0; m < 4; ++m) { const int r = ai * 128 + wr * 64 + m * 16 + fr; const float rs = S[r]; float* o = out + (size_t)(u.pm * 256 + r) * D + cb;
#pragma unroll
                for (int bj = 0; bj < 2; ++bj)
#pragma unroll
                    for (int n = 0; n < 2; ++n) { const pg8::f32x4 a = acc[ai][bj][m][n]; const f32x4 g4 = gf[bj][n];
                        *(f32x4*)(o + bj * 128 + 16 * n) = (f32x4){a[0] * rs * g4[0], a[1] * rs * g4[1], a[2] * rs * g4[2], a[3] * rs * g4[3]}; } }
    }
};
struct EpiUp {
    static constexpr bool PERM = true, AFTER_DRAIN = false;
    bf16* ACT; const float* cw; const float* cb;
    __device__ __forceinline__ void operator()(const pg8::f32x4 (&acc)[2][2][4][2], const pg8::Unit& u, int wr, int wc, int fr, int fq) const {
        const int hc0 = u.pn * 128 + wc * 32 + 8 * fq;
#pragma unroll
        for (int ai = 0; ai < 2; ++ai) { const int blk = ai * 2 + wr;
            float res[4][8];
#pragma unroll
            for (int n = 0; n < 2; ++n) {
                const f32x4 w0 = *(const f32x4*)(cw + hc0 + 4 * n), w1 = *(const f32x4*)(cw + DFF + hc0 + 4 * n), w2 = *(const f32x4*)(cw + 2 * DFF + hc0 + 4 * n), bb = *(const f32x4*)(cb + hc0 + 4 * n);
#pragma unroll
                for (int e = 0; e < 4; ++e) {
                    float xs[4], ps[4], ns[4]; const float bprev = 0.f, bnext = 0.f;
#pragma unroll
                    for (int m = 0; m < 4; ++m) { xs[m] = acc[ai][0][m][n][e]; ps[m] = __builtin_bit_cast(float, __builtin_amdgcn_update_dpp(0, __builtin_bit_cast(int, xs[m]), 0x121, 0xf, 0xf, false)); ns[m] = __builtin_bit_cast(float, __builtin_amdgcn_update_dpp(0, __builtin_bit_cast(int, xs[m]), 0x12f, 0xf, 0xf, false)); }
#pragma unroll
                    for (int m = 0; m < 4; ++m) {
                        const float oldp = (m > 0) ? ps[m > 0 ? m - 1 : 0] : bprev, oldn = (m < 3) ? ns[m < 3 ? m + 1 : 3] : bnext;
                        const float prev = __builtin_bit_cast(float, __builtin_amdgcn_update_dpp(__builtin_bit_cast(int, oldp), __builtin_bit_cast(int, xs[m]), 0x111, 0xf, 0xf, false));
                        const float next = __builtin_bit_cast(float, __builtin_amdgcn_update_dpp(__builtin_bit_cast(int, oldn), __builtin_bit_cast(int, xs[m]), 0x101, 0xf, 0xf, false));
                        const float a = w0[e] * prev + w1[e] * xs[m] + w2[e] * next + bb[e];
                        res[m][4 * n + e] = silu_f(a) * acc[ai][1][m][n][e];
                    }
                }
            }
#pragma unroll
            for (int m = 0; m < 4; ++m) { const int r = u.pm * 256 + ai * 128 + wr * 64 + m * 16 + fr;
                u32x4 w; w.x = pg8::cvt_pk_bf16(res[m][0], res[m][1]); w.y = pg8::cvt_pk_bf16(res[m][2], res[m][3]); w.z = pg8::cvt_pk_bf16(res[m][4], res[m][5]); w.w = pg8::cvt_pk_bf16(res[m][6], res[m][7]);
                *(u32x4*)(ACT + (size_t)r * DFF + hc0) = w; }
        }
    }
};
struct EpiUpCtx {
    static constexpr bool PERM = true, AFTER_DRAIN = false;
    bf16* ACT; const float* cw; const float* cb; LAS float* ex;
    __device__ __forceinline__ void operator()(const pg8::f32x4 (&acc)[2][2][4][2], const pg8::Unit& u, int wr, int wc, int fr, int fq) const {
        const int hc0 = u.pn * 128 + wc * 32 + 8 * fq;
            const int colw = wc * 32 + 8 * fq;
#pragma unroll
            for (int ai = 0; ai < 2; ++ai) { const int blk = ai * 2 + wr;
                if (fr == 0) {
#pragma unroll
                    for (int n = 0; n < 2; ++n)
#pragma unroll
                        for (int e = 0; e < 4; ++e) ex[(blk * 2 + 0) * 128 + colw + 4 * n + e] = acc[ai][0][0][n][e]; }
                if (fr == 15) {
#pragma unroll
                    for (int n = 0; n < 2; ++n)
#pragma unroll
                        for (int e = 0; e < 4; ++e) ex[(blk * 2 + 1) * 128 + colw + 4 * n + e] = acc[ai][0][3][n][e]; } }
            asm volatile("s_waitcnt lgkmcnt(0)" ::: "memory"); __builtin_amdgcn_s_barrier(); asm volatile("" ::: "memory");
#pragma unroll
            for (int ai = 0; ai < 2; ++ai) { const int blk = ai * 2 + wr;
                float res[4][8];
    #pragma unroll
                for (int n = 0; n < 2; ++n) {
                    const f32x4 w0 = *(const f32x4*)(cw + hc0 + 4 * n), w1 = *(const f32x4*)(cw + DFF + hc0 + 4 * n), w2 = *(const f32x4*)(cw + 2 * DFF + hc0 + 4 * n), bb = *(const f32x4*)(cb + hc0 + 4 * n);
    #pragma unroll
                    for (int e = 0; e < 4; ++e) {
                        float xs[4], ps[4], ns[4]; float bprev = 0.f, bnext = 0.f; if (blk > 0) bprev = ex[((blk - 1) * 2 + 1) * 128 + colw + 4 * n + e]; if (blk < 3) bnext = ex[((blk + 1) * 2 + 0) * 128 + colw + 4 * n + e];
    #pragma unroll
                        for (int m = 0; m < 4; ++m) { xs[m] = acc[ai][0][m][n][e]; ps[m] = __builtin_bit_cast(float, __builtin_amdgcn_update_dpp(0, __builtin_bit_cast(int, xs[m]), 0x121, 0xf, 0xf, false)); ns[m] = __builtin_bit_cast(float, __builtin_amdgcn_update_dpp(0, __builtin_bit_cast(int, xs[m]), 0x12f, 0xf, 0xf, false)); }
    #pragma unroll
                        for (int m = 0; m < 4; ++m) {
                            const float prev = (fr > 0) ? ps[m] : (m > 0 ? ps[m > 0 ? m - 1 : 0] : bprev);
                            const float next = (fr < 15) ? ns[m] : (m < 3 ? ns[m < 3 ? m + 1 : 3] : bnext);
                            const float a = w0[e] * prev + w1[e] * xs[m] + w2[e] * next + bb[e];
                            res[m][4 * n + e] = silu_f(a) * acc[ai][1][m][n][e];
                        }
                    }
                }
    #pragma unroll
                for (int m = 0; m < 4; ++m) { const int r = u.pm * 256 + ai * 128 + wr * 64 + m * 16 + fr;
                    u32x4 w; w.x = pg8::cvt_pk_bf16(res[m][0], res[m][1]); w.y = pg8::cvt_pk_bf16(res[m][2], res[m][3]); w.z = pg8::cvt_pk_bf16(res[m][4], res[m][5]); w.w = pg8::cvt_pk_bf16(res[m][6], res[m][7]);
                    *(u32x4*)(ACT + (size_t)r * DFF + hc0) = w; }
            }

    }
};
struct CtxOrder {
    int nN, c, c0;
    __device__ void init(int N, int c_, int c0_) { nN = N / 256; c = c_; c0 = c0_; }
    __device__ bool next(int i, pg8::Unit& u) const { const int j = c - c0; if (i > 0 || j < 0 || j >= 2 * nN) return false; u.pm = 64 + (j & 1); u.pn = j >> 1; u.ks = 0; return true; }
    __device__ __forceinline__ void a_ready(const pg8::Unit&) const {}
    __device__ __forceinline__ void done(const pg8::Unit&) const {}
};

struct SplitOrder {
    int nunits, G, c;
    __device__ void init(int nks, int G_, int c_) { nunits = 8 * nks; G = G_; c = c_; }
    __device__ bool next(int i, pg8::Unit& u) const { const int id = i * G + c; if (id >= nunits) return false; u.pm = 64 + (id & 1); u.pn = (id >> 1) & 3; u.ks = id >> 3; return true; }
    __device__ __forceinline__ void a_ready(const pg8::Unit&) const {}
    __device__ __forceinline__ void done(const pg8::Unit&) const {}
};
struct EpiPartial {
    static constexpr bool PERM = false, AFTER_DRAIN = false;
    float* part;
    __device__ __forceinline__ void operator()(const pg8::f32x4 (&acc)[2][2][4][2], const pg8::Unit& u, int wr, int wc, int fr, int fq) const {
#pragma unroll
        for (int ai = 0; ai < 2; ++ai)
#pragma unroll
            for (int m = 0; m < 4; ++m) { const int r = u.pm * 256 + ai * 128 + wr * 64 + m * 16 + fr; float* o = part + ((size_t)u.ks * MC + (size_t)(r - ML)) * D;
#pragma unroll
                for (int bj = 0; bj < 2; ++bj)
#pragma unroll
                    for (int n = 0; n < 2; ++n) { const int c = u.pn * 256 + bj * 128 + wc * 32 + 16 * n + 4 * fq; const pg8::f32x4 a = acc[ai][bj][m][n];
                        *(f32x4*)(o + c) = (f32x4){a[0], a[1], a[2], a[3]}; } }
    }
};
typedef __attribute__((address_space(1))) unsigned gu32;
#define XB_TMO      128
#define XB_XCNT(j)  (256  + 64 * (j))
#define XB_XSUB(j)  (1280 + 64 * (j))
#define XB_XGEN(j)  (2304 + 64 * (j))
#define XB_TOP      3328
#define XB_TOPGEN   3392
#define XCD_BAR_WORDS 3456
#define XB_SPIN_CAP (1u << 18)

__device__ __forceinline__ unsigned xb_ld(unsigned* p)              { return __hip_atomic_load(p, __ATOMIC_RELAXED, __HIP_MEMORY_SCOPE_AGENT); }
__device__ __forceinline__ unsigned xb_add(unsigned* p, unsigned v) { return __hip_atomic_fetch_add(p, v, __ATOMIC_RELAXED, __HIP_MEMORY_SCOPE_AGENT); }
__device__ __forceinline__ unsigned xb_xcc_id() { return (unsigned)__builtin_amdgcn_s_getreg((3 << 11) | 20) & 0xFu; }
#define XB_SPIN(cond, bar) do { unsigned _sp = 0; while (cond) { __builtin_amdgcn_s_sleep(1); \
    if ((++_sp & 255u) == 0u) { if (xb_ld(&(bar)[XB_TMO])) break; if (_sp > XB_SPIN_CAP) { atomicAdd(&(bar)[XB_TMO], 1u); break; } } } } while (0)

struct XcdBarrier {
    unsigned* bar; unsigned x;
    volatile LAS unsigned* st;
};

__device__ __forceinline__ XcdBarrier xcd_barrier_post(unsigned* bar, volatile LAS unsigned* st, int tid_) {
    XcdBarrier b; b.bar = bar; b.x = xb_xcc_id(); b.st = st;
    if (tid_ == 0) (void)xb_add(&bar[XB_XCNT(b.x)], 1u);
    return b;
}
__device__ __forceinline__ void xcd_barrier_complete(unsigned* bar, unsigned x, unsigned& nloc, unsigned& nx) {
    const unsigned G = gridDim.x * gridDim.y * gridDim.z;
    unsigned sum, cnt, mine, sp = 0u;
    for (;;) {
        sum = 0u; cnt = 0u; mine = 0u;
#pragma unroll
        for (unsigned j = 0; j < 16; ++j) { const unsigned c = xb_ld(&bar[XB_XCNT(j)]); sum += c; cnt += (c > 0u) ? 1u : 0u; mine = (j == x) ? c : mine; }
        if (sum == G) break;
        __builtin_amdgcn_s_sleep(1);
        if ((++sp & 255u) == 0u) { if (xb_ld(&bar[XB_TMO])) break; if (sp > XB_SPIN_CAP) { atomicAdd(&bar[XB_TMO], 1u); break; } }
    }
    nloc = mine > 0u ? mine : 1u; nx = cnt > 0u ? cnt : 1u;
}

__device__ __forceinline__ void xcd_barrier(const XcdBarrier& b, int tid_) {
    asm volatile("s_waitcnt vmcnt(0)" ::: "memory");
    __syncthreads();
    if (tid_ == 0) {
        unsigned* bar = b.bar; asm volatile("" : "+s"(bar)); unsigned bx = (unsigned)__builtin_amdgcn_readfirstlane((int)b.x); asm volatile("" : "+s"(bx));
        __builtin_amdgcn_s_waitcnt(0);
        unsigned nloc = b.st[0], nx = b.st[1];
        if (nloc == 0u) { xcd_barrier_complete(bar, bx, nloc, nx); b.st[0] = nloc; b.st[1] = nx; }
        const unsigned old = xb_add(&bar[XB_XSUB(bx)], 1u);
        const unsigned gen = old / nloc;
        if (old + 1u == (gen + 1u) * nloc) {
            __builtin_amdgcn_fence(__ATOMIC_RELEASE, "agent");
            asm volatile("s_waitcnt vmcnt(0)" ::: "memory");
            const unsigned og = xb_add(&bar[XB_TOP], 1u);
            const unsigned tg = og / nx;
            if (og + 1u == (tg + 1u) * nx) xb_add(&bar[XB_TOPGEN], 1u);
            else XB_SPIN(xb_ld(&bar[XB_TOPGEN]) == tg, bar);
            __builtin_amdgcn_fence(__ATOMIC_ACQUIRE, "agent");
            xb_add(&bar[XB_XGEN(bx)], 1u);
            asm volatile("s_waitcnt vmcnt(0)" ::: "memory");
        } else {
            XB_SPIN(xb_ld(&bar[XB_XGEN(bx)]) == gen, bar);
            __builtin_amdgcn_fence(__ATOMIC_ACQUIRE, "agent");
            asm volatile("s_waitcnt vmcnt(0)" ::: "memory");
        }
    }
    __syncthreads();
}
struct Ctx {
    LAS unsigned char* lds; int tid, lane, wave, G, gw, NGW;
    float* MOD; float* MCS; bf16 *F1, *F2, *FC; bf16 *HX, *YMIX, *PB, *ACT, *TB, *CAU; float *XC, *ST, *DEC;
};
__device__ __forceinline__ bf16* win_t(PP p, int l) { return (bf16*)(p->ws + WS_W + (size_t)l * W_LAYER_B); }
__device__ __forceinline__ bf16* wout_t(PP p, int l) { return (bf16*)(p->ws + WS_W + (size_t)l * W_LAYER_B + W_IN_B); }
__device__ __forceinline__ bf16* wup_t(PP p, int l) { return (bf16*)(p->ws + WS_W + (size_t)l * W_LAYER_B + W_IN_B + W_OUT_B); }
__device__ __forceinline__ bf16* wdn_t(PP p, int l) { return (bf16*)(p->ws + WS_W + (size_t)l * W_LAYER_B + W_IN_B + W_OUT_B + W_UP_B); }

__device__ __forceinline__ void transpose_item(const float* W, int K, int N, bf16* WT, int k0, int n0, int dst0, float scale, LAS float* scr, int lane) {
#pragma unroll
    for (int i = 0; i < 32; ++i) { const int kk = 2 * i + (lane >> 5); scr[kk * 33 + (lane & 31)] = W[(size_t)(k0 + kk) * N + n0 + (lane & 31)] * scale; }
    LDS_WAIT(); __builtin_amdgcn_wave_barrier();
    const int c = lane & 7;
#pragma unroll
    for (int j = 0; j < 4; ++j) { const int n = (lane >> 3) + 8 * j; const LAS float* s = scr + (8 * c) * 33 + n;
        u32x4 o; o.x = pk2(s[0 * 33], s[1 * 33]); o.y = pk2(s[2 * 33], s[3 * 33]); o.z = pk2(s[4 * 33], s[5 * 33]); o.w = pk2(s[6 * 33], s[7 * 33]);
        *(u32x4*)(WT + (size_t)(dst0 + n) * K + k0 + 8 * c) = o; }
    LDS_WAIT(); __builtin_amdgcn_wave_barrier();
}

__device__ __forceinline__ void phase0(PP p, Ctx& F) {
    LAS float* sv = (LAS float*)F.lds; LAS float* red = sv + 3072;
    for (int i = F.tid; i < 3072; i += 512) { const int w = i >> 10, k = i & 1023; const float cv = (w < 2) ? p->c[w * 1024 + k] : p->c_ctx[k]; sv[i] = cv / (1.f + expf(-cv)); }
    __syncthreads();
    for (int it = blockIdx.x; it < 192; it += F.G) {
        const int l = it / 96, c0 = (it % 96) * 64; const float* W = p->w_mod + (size_t)l * 1024 * 6144 + c0 + F.lane;
        float a0 = 0.f, a1 = 0.f, a2 = 0.f; const int kb = F.wave * 128;
#pragma unroll 32
        for (int k = 0; k < 128; ++k) { const float wv = W[(size_t)(kb + k) * 6144]; a0 += sv[kb + k] * wv; a1 += sv[1024 + kb + k] * wv; a2 += sv[2048 + kb + k] * wv; }
        red[(F.wave * 3 + 0) * 64 + F.lane] = a0; red[(F.wave * 3 + 1) * 64 + F.lane] = a1; red[(F.wave * 3 + 2) * 64 + F.lane] = a2;
        __syncthreads();
        if (F.tid < 192) { const int w = F.tid >> 6, ln = F.tid & 63; float s = 0.f;
#pragma unroll
            for (int q = 0; q < 8; ++q) s += red[(q * 3 + w) * 64 + ln];
            F.MOD[(l * 3 + w) * 6144 + c0 + ln] = s + p->b_mod[l * 6144 + c0 + ln]; }
        __syncthreads();
    }
    __syncthreads();
    LAS float* scr = (LAS float*)(F.lds + F.wave * 16384);
    constexpr int I_IN = 48 * 16, I_OUT = 32 * 16, I_UP = 176 * 16, I_DN = 32 * 44, I_L = I_IN + I_OUT + I_UP + I_DN;
    for (int it = F.gw; it < 2 * I_L; it += F.NGW) {
        const int l = it / I_L; int r = it % I_L;
        if (r < I_IN) { const int cb = r / 16, kb = r % 16; int src, dst; float sc = 1.f;
            if (cb < 4) { src = 32 * cb; dst = PK + 32 * cb; }
            else if (cb < 8) { src = 416 + 32 * (cb - 4); dst = PQ + 32 * (cb - 4); sc = 0.17677669529663687f; }
            else if (cb < 16) { src = 128 + 32 * (cb - 8); dst = PV + 32 * (cb - 8); }
            else if (cb < 24) { src = 544 + 32 * (cb - 16); dst = PG + 32 * (cb - 16); }
            else if (cb < 32) { src = 1056 + 32 * (cb - 24); dst = PH + 32 * (cb - 24); }
            else if (cb < 40) { src = 1312 + 32 * (cb - 32); dst = PBG + 32 * (cb - 32); }
            else { src = 1568 + 32 * (cb - 40); dst = PCG + 32 * (cb - 40); }
            transpose_item(p->w_in + (size_t)l * D * DIN, D, DIN, win_t(p, l), 64 * kb, src, dst, sc, scr, F.lane); continue; }
        r -= I_IN;
        if (r < I_OUT) { const int cb = r / 16, kb = r % 16; transpose_item(p->w_out + (size_t)l * D * D, D, D, wout_t(p, l), 64 * kb, 32 * cb, 32 * cb, 1.f, scr, F.lane); continue; }
        r -= I_OUT;
        if (r < I_UP) { const int cb = r / 16, kb = r % 16; const int c = 32 * cb, isu = (c >= DFF) ? 1 : 0, j = c - isu * DFF; const int dst = (j / 128) * 256 + isu * 128 + (j % 128);
            transpose_item(p->w_up + (size_t)l * D * NUP, D, NUP, wup_t(p, l), 64 * kb, c, dst, 1.f, scr, F.lane); continue; }
        r -= I_UP;
        { const int cb = r / 44, kb = r % 44; transpose_item(p->w_down + (size_t)l * DFF * D, DFF, D, wdn_t(p, l), 64 * kb, 32 * cb, 32 * cb, 1.f, scr, F.lane); }
    }
    const int gt = blockIdx.x * 512 + F.tid, NT = F.G * 512;
    const int gtm = (F.G == 256) ? ((int)blockIdx.x - 192) * 512 + F.tid : gt; const int NTm = (F.G == 256) ? 32768 : NT;
    for (int i = gtm; i >= 0 && i < 32768; i += NTm) { const int d = i & 63, c = (i >> 6) & 63, g = (i >> 12) & 3, l = i >> 14;
        const float* wf = p->fft_w + (size_t)((l * 4 + g) * 64) * 64 + d; float mc = 0.f, ms = 0.f;
        for (int f = 0; f < 64; ++f) { const float a = (float)((f * c) & 63) * (1.f / 64.f); const float w = wf[f * 64]; mc += cos_rev(a) * w; ms -= sin_rev(a) * w; }
        F.MCS[(((l * 4 + g) * 2 + 0) * 64 + c) * 64 + d] = mc * 0.125f; F.MCS[(((l * 4 + g) * 2 + 1) * 64 + c) * 64 + d] = ms * 0.125f; }
    for (int i = gt; i < MC * D / 4; i += NT) ((f32x4*)F.XC)[i] = ((const f32x4*)p->ctx)[i];
    for (int i = gt; i < 180224; i += NT) {
        if (i < 16384) { const int mm = i >> 7, kk = i & 127, k1 = mm & 63, n1 = kk & 63; const float a = (float)((k1 * n1) & 63) * (1.f / 64.f); const float C = cos_rev(a), S = sin_rev(a);
            const float v = (mm < 64) ? (kk < 64 ? C : S) : (kk < 64 ? -S : C); F.F1[i] = (bf16)f2bf(v); }
        else if (i < 49152) { const int j = i - 16384, k2 = j >> 8, kk = j & 255, n2 = kk & 127; const float a = (float)((k2 * n2) & 127) * (1.f / 128.f);
            const float v = (kk < 128 ? cos_rev(a) : sin_rev(a)) * 0.011048543456039806f; F.F2[j] = (bf16)f2bf(v); }
        else { const int j = i - 49152, k = j >> 9, kk = j & 511, n = kk & 255; const float a = (float)((k * n) & 255) * (1.f / 256.f);
            const float v = (kk < 256 ? cos_rev(a) : sin_rev(a)) * 0.0625f; F.FC[j] = (bf16)f2bf(v); }
    }
}

__device__ __forceinline__ void fold_items(PP p, Ctx& F) {
    for (int it4 = F.gw; it4 < 1792; it4 += F.NGW) {
        const int dq = it4 & 3, it = it4 >> 2;
        const int l = it / 224, r = it % 224, s = r / 16, kb = r % 16; const int k = 64 * kb + F.lane;
        const float* wrow = p->w_in + (size_t)l * D * DIN + (size_t)k * DIN; bf16* WT = win_t(p, l);
        if (s < 2) {
            const f32x4* src = (const f32x4*)(wrow + 384 + 16 * s); f32x4 r4[4];
#pragma unroll
            for (int q = 0; q < 4; ++q) r4[q] = src[q];
            const float* M = p->w_a2 + (size_t)((l * 2 + s) * 16) * 128;
            for (int d = 32 * dq; d < 32 * dq + 32; ++d) { float a = 0.f;
#pragma unroll
                for (int c = 0; c < 16; ++c) a += r4[c >> 2][c & 3] * M[c * 128 + d];
                WT[(size_t)(PLA + s * 128 + d) * D + k] = (bf16)f2bf(a); }
        } else {
            const int kind = (s - 2) >> 2, g = (s - 2) & 3;
            const f32x4* src = (const f32x4*)(wrow + (kind < 2 ? 800 : 1824) + 64 * g); f32x4 r4[16];
#pragma unroll
            for (int q = 0; q < 16; ++q) r4[q] = src[q];
            const float* M = (kind < 2) ? (F.MCS + (size_t)(((l * 4 + g) * 2 + kind) * 64) * 64) : (p->pool_w + (size_t)((l * 4 + g) * 64) * 64);
            const int drow = (kind == 0 ? PFA : (kind == 1 ? PFB : PPOOL)) + 64 * g;
            for (int d = 16 * dq; d < 16 * dq + 16; ++d) { float a = 0.f;
#pragma unroll
                for (int c = 0; c < 64; ++c) a += r4[c >> 2][c & 3] * M[c * 64 + d];
                if (kind == 2) a *= p->pool_scale[l * 256 + g * 64 + d];
                WT[(size_t)(drow + d) * D + k] = (bf16)f2bf(a); }
        }
    }
}

__device__ __forceinline__ void norm_row_bf16(const float* xrow, bf16* orow, const float* g, const float* sc, const float* sh, int lane, const float* part, int nparts, const float* gate, float* xout) {
    f32x4 v[4]; float s = 0.f;
#pragma unroll
    for (int j = 0; j < 4; ++j) v[j] = ((const f32x4*)xrow)[lane + 64 * j];
    if (nparts > 0) {
        f32x4 a[4];
#pragma unroll
        for (int j = 0; j < 4; ++j) a[j] = (f32x4){0.f, 0.f, 0.f, 0.f};
        for (int q = 0; q < nparts; ++q) {
#pragma unroll
            for (int j = 0; j < 4; ++j) { const f32x4 t = ((const f32x4*)(part + (size_t)q * MC * D))[lane + 64 * j]; a[j][0] += t[0]; a[j][1] += t[1]; a[j][2] += t[2]; a[j][3] += t[3]; } }
#pragma unroll
        for (int j = 0; j < 4; ++j) { const f32x4 gv = ((const f32x4*)gate)[lane + 64 * j];
#pragma unroll
            for (int e = 0; e < 4; ++e) v[j][e] += gv[e] * a[j][e];
            ((f32x4*)xout)[lane + 64 * j] = v[j]; }
    }
#pragma unroll
    for (int j = 0; j < 4; ++j) s += (v[j][0] * v[j][0] + v[j][1] * v[j][1]) + (v[j][2] * v[j][2] + v[j][3] * v[j][3]);
    const float rstd = 1.f / sqrtf(wave_sum(s, lane) * (1.f / D) + EPS);
#pragma unroll
    for (int j = 0; j < 4; ++j) { const int idx = lane + 64 * j; const f32x4 gv = ((const f32x4*)g)[idx], scv = ((const f32x4*)sc)[idx], shv = ((const f32x4*)sh)[idx];
        float y[4];
#pragma unroll
        for (int e = 0; e < 4; ++e) y[e] = v[j][e] * rstd * gv[e] * (1.f + scv[e]) + shv[e];
        u32x2 o; o.x = pk2(y[0], y[1]); o.y = pk2(y[2], y[3]); ((u32x2*)orow)[idx] = o; }
}
template <bool FINAL, bool INB>
__device__ __forceinline__ void norm_rows4(const void* xbase, bf16* obase, float* fout, const float* g, const float* modl, int which, int m0, int stride, int lane) {
    f32x4 v[4][4]; float s[4]; int mk[4]; bool ok[4];
#pragma unroll
    for (int k = 0; k < 4; ++k) { const int m = m0 + k * stride; ok[k] = m < ML; mk[k] = ok[k] ? m : ML - 1;
#pragma unroll
        for (int j = 0; j < 4; ++j) {
            if (INB) { const u32x2 t = ((const u32x2*)((const bf16*)xbase + (size_t)mk[k] * D))[lane + 64 * j]; v[k][j] = (f32x4){bflo(t.x), bfhi(t.x), bflo(t.y), bfhi(t.y)}; }
            else v[k][j] = ((const f32x4*)((const float*)xbase + (size_t)mk[k] * D))[lane + 64 * j]; } }
    f32x4 gm[4], sh4[4];
    { const float* mod = FINAL ? g : modl + (m0 >> 13) * 6144 + which * 3072;
#pragma unroll
      for (int j = 0; j < 4; ++j) { const int idx = lane + 64 * j; const f32x4 gv = ((const f32x4*)g)[idx];
          if (FINAL) { gm[j] = gv; sh4[j] = (f32x4){0.f, 0.f, 0.f, 0.f}; }
          else { const f32x4 scv = ((const f32x4*)(mod + 1024))[idx]; sh4[j] = ((const f32x4*)mod)[idx];
#pragma unroll
              for (int e = 0; e < 4; ++e) gm[j][e] = gv[e] * (1.f + scv[e]); } } }
#pragma unroll
    for (int k = 0; k < 4; ++k) { float a = 0.f;
#pragma unroll
        for (int j = 0; j < 4; ++j) a += (v[k][j][0] * v[k][j][0] + v[k][j][1] * v[k][j][1]) + (v[k][j][2] * v[k][j][2] + v[k][j][3] * v[k][j][3]);
        s[k] = a; }
#pragma unroll
    for (int o = 1; o < 64; o <<= 1) {
#pragma unroll
        for (int k = 0; k < 4; ++k) s[k] += shfl_f(s[k], lane ^ o); }
#pragma unroll
    for (int k = 0; k < 4; ++k) { if (!ok[k]) continue;
        const float rstd = 1.f / sqrtf(s[k] * (1.f / D) + EPS);
#pragma unroll
        for (int j = 0; j < 4; ++j) { const int idx = lane + 64 * j;
            if (FINAL) { f32x4 y;
#pragma unroll
                for (int e = 0; e < 4; ++e) y[e] = v[k][j][e] * rstd * gm[j][e];
                ((f32x4*)(fout + (size_t)mk[k] * D))[idx] = y; }
            else { float y[4];
#pragma unroll
                for (int e = 0; e < 4; ++e) y[e] = v[k][j][e] * rstd * gm[j][e] + sh4[j][e];
                u32x2 o; o.x = pk2(y[0], y[1]); o.y = pk2(y[2], y[3]); ((u32x2*)(obase + (size_t)mk[k] * D))[idx] = o; } }
    }
}
__device__ __forceinline__ void norm_phase(PP p, Ctx& F, int l, int which, int mrows) {
    const float* g = (which == 0 ? p->norm1_g : p->norm2_g) + l * D;
    const float* PART = (const float*)(p->ws + WS_PART);
    if (l == 0 && which == 0) { for (int m0 = F.gw; m0 < ML; m0 += 4 * F.NGW) norm_rows4<false, false>(p->x, F.HX, nullptr, g, F.MOD + l * 3 * 6144, which, m0, F.NGW, F.lane); }
    else { const void* xb = (l == 1 && which == 1 && F.G == 256) ? (const void*)(p->ws + WS_XB2) : (const void*)p->out;
        for (int m0 = F.gw; m0 < ML; m0 += 4 * F.NGW) norm_rows4<false, true>(xb, F.HX, nullptr, g, F.MOD + l * 3 * 6144, which, m0, F.NGW, F.lane); }
    for (int m = ML + F.gw; m < mrows; m += F.NGW) {
        int nparts = 0; const float* gate = nullptr;
        const float* xr = ((l == 0 && which == 0) ? p->ctx : F.XC) + (size_t)(m - ML) * D;
        if (l == 0 && which == 1) { nparts = 4; gate = F.MOD + 2 * 6144 + 2048; }
        if (l == 1 && which == 0) { nparts = 11; gate = F.MOD + 2 * 6144 + 5120; }
        const float* part = PART + (size_t)(m - ML) * D; float* xout = F.XC + (size_t)(m - ML) * D;
        const float* mod = F.MOD + (l * 3 + 2) * 6144 + which * 3072;
        norm_row_bf16(xr, F.HX + (size_t)m * D, g, mod + 1024, mod, F.lane, part, nparts, gate, xout);
    }
}
__device__ __forceinline__ void final_norm(PP p, Ctx& F) {
    for (int m0 = F.gw; m0 < ML; m0 += 4 * F.NGW) norm_rows4<true, false>(p->ws + WS_HX  , nullptr, p->out, p->final_g, nullptr, 0, m0, F.NGW, F.lane);
}
constexpr int CP = 260;
__device__ __forceinline__ int chunk_row0(int b, int cidx) { return (cidx < 4) ? (ML + b * CTXL + cidx * 64) : (b * SEQ + (cidx - 4) * 64); }
__device__ __forceinline__ void cum_to_lds(LAS float* cum, const bf16* PB, int row0, int tid) {
    { const int oct = tid & 31, j0 = tid >> 5; u32x4 w[4];
#pragma unroll
      for (int q = 0; q < 4; ++q) w[q] = *(const u32x4*)(PB + (size_t)(row0 + j0 + 16 * q) * NP + PLA + 8 * oct);
#pragma unroll
      for (int q = 0; q < 4; ++q) { LAS float* d = cum + (j0 + 16 * q) * CP + 8 * oct;
          *(LAS f32x4*)d = (f32x4){bflo(w[q].x), bfhi(w[q].x), bflo(w[q].y), bfhi(w[q].y)}; *(LAS f32x4*)(d + 4) = (f32x4){bflo(w[q].z), bfhi(w[q].z), bflo(w[q].w), bfhi(w[q].w)}; } }
    __syncthreads();
    if (tid < 256) { float s = 0.f;
        if (tid < 128) {
#pragma unroll 16
            for (int j = 0; j < 64; ++j) { s += cum[j * CP + tid]; cum[j * CP + tid] = s; }
        } else {
#pragma unroll 16
            for (int j = 63; j >= 0; --j) { s += cum[j * CP + tid]; cum[j * CP + tid] = s; }
        } }
    __syncthreads();
}
typedef float f32x2_t __attribute__((ext_vector_type(2)));
typedef __bf16 bf16x2_t __attribute__((ext_vector_type(2)));
__device__ __forceinline__ unsigned pkh(float lo, float hi) { f32x2_t v = {lo, hi}; bf16x2_t b = __builtin_convertvector(v, bf16x2_t); return __builtin_bit_cast(unsigned, b); }
__device__ __forceinline__ bf16x8 pack8h(float a0, float a1, float a2, float a3, float a4, float a5, float a6, float a7) {
    u32x4 w; w.x = pkh(a0, a1); w.y = pkh(a2, a3); w.z = pkh(a4, a5); w.w = pkh(a6, a7); return __builtin_bit_cast(bf16x8, w);
}
__device__ __forceinline__ void la_load(u32x4 (&w)[4], const bf16* PB, int row0, int tid) {
    const int oct = tid & 31, j0 = tid >> 5;
#pragma unroll
    for (int q = 0; q < 4; ++q) w[q] = *(const u32x4*)(PB + (size_t)(row0 + j0 + 16 * q) * NP + PLA + 8 * oct);
}
__device__ __forceinline__ void la_scan(LAS float* cum, const u32x4 (&w)[4], int tid) {
    const int oct = tid & 31, j0 = tid >> 5;
#pragma unroll
    for (int q = 0; q < 4; ++q) { LAS float* d = cum + (j0 + 16 * q) * CP + 8 * oct;
        *(LAS f32x4*)d = (f32x4){bflo(w[q].x), bfhi(w[q].x), bflo(w[q].y), bfhi(w[q].y)}; *(LAS f32x4*)(d + 4) = (f32x4){bflo(w[q].z), bfhi(w[q].z), bflo(w[q].w), bfhi(w[q].w)}; }
    __syncthreads();
    if (tid < 256) { float carry = 0.f;
        if (tid < 128) {
#pragma unroll
            for (int hf = 0; hf < 4; ++hf) { float v[16];
#pragma unroll
                for (int j = 0; j < 16; ++j) v[j] = cum[(16 * hf + j) * CP + tid];
                v[0] += carry;
#pragma unroll
                for (int j = 1; j < 16; ++j) v[j] += v[j - 1];
                carry = v[15];
#pragma unroll
                for (int j = 0; j < 16; ++j) cum[(16 * hf + j) * CP + tid] = v[j]; }
        } else {
#pragma unroll
            for (int hf = 3; hf >= 0; --hf) { float v[16];
#pragma unroll
                for (int j = 0; j < 16; ++j) v[j] = cum[(16 * hf + j) * CP + tid];
                v[15] += carry;
#pragma unroll
                for (int j = 14; j >= 0; --j) v[j] += v[j + 1];
                carry = v[0];
#pragma unroll
                for (int j = 0; j < 16; ++j) cum[(16 * hf + j) * CP + tid] = v[j]; }
        } }
    __syncthreads();
}
__device__ __forceinline__ void gla_a_item(Ctx& F, int b, int cidx) {
    LAS float* cum = (LAS float*)F.lds; const int row0 = chunk_row0(b, cidx);
    const int h = F.wave & 3, dir = F.wave >> 2, chb = dir * 128 + h * 32, lr = F.lane & 15, g = F.lane >> 4;
    const int jl = dir ? 0 : 63;
    u32x4 wla[4]; la_load(wla, F.PB, row0, F.tid);
    unsigned short kt[2][2][8], vt[2][4][8];
#pragma unroll
    for (int ks = 0; ks < 2; ++ks) { const int j0 = 32 * ks + 8 * g;
#pragma unroll
        for (int mb = 0; mb < 2; ++mb)
#pragma unroll
            for (int e = 0; e < 8; ++e) kt[ks][mb][e] = F.PB[(size_t)(row0 + j0 + e) * NP + PK + h * 32 + 16 * mb + lr];
#pragma unroll
        for (int nb = 0; nb < 4; ++nb)
#pragma unroll
            for (int e = 0; e < 8; ++e) vt[ks][nb][e] = F.PB[(size_t)(row0 + j0 + e) * NP + PV + h * 64 + 16 * nb + lr]; }
    la_scan(cum, wla, F.tid);
    f32x4 acc[2][4];
#pragma unroll
    for (int mb = 0; mb < 2; ++mb)
#pragma unroll
        for (int nb = 0; nb < 4; ++nb) acc[mb][nb] = (f32x4){0.f, 0.f, 0.f, 0.f};
#pragma unroll
    for (int ks = 0; ks < 2; ++ks) {
        bf16x8 af[2], bfr[4]; const int j0 = 32 * ks + 8 * g;
#pragma unroll
        for (int mb = 0; mb < 2; ++mb) { const int dk = 16 * mb + lr; const float last = cum[jl * CP + chb + dk]; float a[8];
#pragma unroll
            for (int e = 0; e < 8; ++e) { const int j = j0 + e; a[e] = bf2f(kt[ks][mb][e]) * __expf(last - cum[j * CP + chb + dk]); }
            af[mb] = pack8h(a[0], a[1], a[2], a[3], a[4], a[5], a[6], a[7]); }
#pragma unroll
        for (int nb = 0; nb < 4; ++nb) { const unsigned short* t = vt[ks][nb];
            u32x4 w; w.x = t[0] | ((unsigned)t[1] << 16); w.y = t[2] | ((unsigned)t[3] << 16); w.z = t[4] | ((unsigned)t[5] << 16); w.w = t[6] | ((unsigned)t[7] << 16);
            bfr[nb] = __builtin_bit_cast(bf16x8, w); }
#pragma unroll
        for (int mb = 0; mb < 2; ++mb)
#pragma unroll
            for (int nb = 0; nb < 4; ++nb) acc[mb][nb] = MFMA16(af[mb], bfr[nb], acc[mb][nb]);
    }
    const size_t sidx = (size_t)(((b * 2 + dir) * 4 + h) * NCH + cidx);
    float* st = F.ST + sidx * 2048;
#pragma unroll
    for (int mb = 0; mb < 2; ++mb)
#pragma unroll
        for (int nb = 0; nb < 4; ++nb) *(f32x4*)(st + (16 * nb + lr) * 32 + 16 * mb + 4 * g) = acc[mb][nb];
    if (F.lane < 32) F.DEC[sidx * 32 + F.lane] = __expf(cum[jl * CP + chb + F.lane]);
    __syncthreads();
}
__device__ __forceinline__ void gla_scan(Ctx& F) {
    LAS float* xa = (LAS float*)F.lds; LAS float* xb = xa + 512;
    const int seg = F.tid >> 6, el = F.tid & 63;
    for (int blk = blockIdx.x; blk < 512; blk += F.G) {
        const int ge = blk * 64 + el, e = ge & 2047, seq = ge >> 11, dir = (seq >> 2) & 1, dk = e & 31;
        float* st = F.ST + (size_t)seq * NCH * 2048 + e; const float* dc = F.DEC + (size_t)seq * NCH * 32 + dk;
        float u[17], d[17];
#pragma unroll
        for (int i = 0; i < 17; ++i) { const int s = seg * 17 + i; const bool ok = s < NCH; const int sc = ok ? s : NCH - 1; const int c = dir ? (sc < 4 ? 3 - sc : 135 - sc) : sc;
            const float uu = st[(size_t)c * 2048], dd = dc[c * 32]; u[i] = ok ? uu : 0.f; d[i] = ok ? dd : 1.f; }
        float A = 1.f, B = 0.f;
#pragma unroll
        for (int i = 0; i < 17; ++i) { B = B * d[i] + u[i]; A *= d[i]; }
        xa[F.tid] = A; xb[F.tid] = B;
        __syncthreads();
        float S = 0.f;
        for (int sg = 0; sg < seg; ++sg) S = S * xa[sg * 64 + el] + xb[sg * 64 + el];
#pragma unroll
        for (int i = 0; i < 17; ++i) { const int s = seg * 17 + i; if (s < NCH) { const int c = dir ? (s < 4 ? 3 - s : 135 - s) : s; st[(size_t)c * 2048] = S; } S = S * d[i] + u[i]; }
        __syncthreads();
    }
}
template <int NI>
__device__ __forceinline__ void gla_c_item(PP p, Ctx& F, int l, int b, int cidx, int sub) {
    LAS float* cum = (LAS float*)F.lds; const int row0 = chunk_row0(b, cidx);
    const int h = F.wave & 3, half = (NI == 2) ? (F.wave >> 2) : sub, ibase = (NI == 2) ? 0 : (F.wave >> 2), lr = F.lane & 15, g = F.lane >> 4;
    u32x4 wla[4]; la_load(wla, F.PB, row0, F.tid);
    f32x4 o[4][2];
#pragma unroll
    for (int mb = 0; mb < 4; ++mb) { o[mb][0] = (f32x4){0.f, 0.f, 0.f, 0.f}; o[mb][1] = (f32x4){0.f, 0.f, 0.f, 0.f}; }
    bf16x8 av[4][2];
#pragma unroll
    for (int mb = 0; mb < 4; ++mb)
#pragma unroll
        for (int pp = 0; pp < 2; ++pp) { unsigned short t[8];
#pragma unroll
            for (int e = 0; e < 8; ++e) { const int j = 32 * pp + (e < 4 ? 4 * g + e : 16 + 4 * g + (e - 4)); t[e] = F.PB[(size_t)(row0 + j) * NP + PV + h * 64 + 16 * mb + lr]; }
            u32x4 w; w.x = t[0] | ((unsigned)t[1] << 16); w.y = t[2] | ((unsigned)t[3] << 16); w.z = t[4] | ((unsigned)t[5] << 16); w.w = t[6] | ((unsigned)t[7] << 16);
            av[mb][pp] = __builtin_bit_cast(bf16x8, w); }
    u32x4 qraw[2], kraw[4]; f32x4 sraw[2][4][2];
#pragma unroll
    for (int ibl = 0; ibl < NI; ++ibl) qraw[ibl] = *(const u32x4*)(F.PB + (size_t)(row0 + 16 * (2 * half + ibase + ibl) + lr) * NP + PQ + h * 32 + 8 * g);
#pragma unroll
    for (int jb = 0; jb < 4; ++jb) kraw[jb] = *(const u32x4*)(F.PB + (size_t)(row0 + 16 * jb + lr) * NP + PK + h * 32 + 8 * g);
    { const float* st = F.ST + (size_t)(((b * 2 + 0) * 4 + h) * NCH + cidx) * 2048;
#pragma unroll
        for (int mb = 0; mb < 4; ++mb) { sraw[0][mb][0] = *(const f32x4*)(st + (16 * mb + lr) * 32 + 8 * g); sraw[0][mb][1] = *(const f32x4*)(st + (16 * mb + lr) * 32 + 8 * g + 4); } }
    la_scan(cum, wla, F.tid);
    { const float* st = F.ST + (size_t)(((b * 2 + 1) * 4 + h) * NCH + cidx) * 2048;
#pragma unroll
        for (int mb = 0; mb < 4; ++mb) { sraw[1][mb][0] = *(const f32x4*)(st + (16 * mb + lr) * 32 + 8 * g); sraw[1][mb][1] = *(const f32x4*)(st + (16 * mb + lr) * 32 + 8 * g + 4); } }
#pragma unroll
    for (int dir = 0; dir < 2; ++dir) {
        const int chb = dir * 128 + h * 32;
        bf16x8 bq[2];
#pragma unroll
        for (int ibl = 0; ibl < NI; ++ibl) { const int i = 16 * (2 * half + ibase + ibl) + lr;
            const u32x4 qw = qraw[ibl];
            const f32x4 c0 = *(const LAS f32x4*)(cum + i * CP + chb + 8 * g), c1 = *(const LAS f32x4*)(cum + i * CP + chb + 8 * g + 4);
            bq[ibl] = pack8h(bflo(qw.x) * __expf(c0[0]), bfhi(qw.x) * __expf(c0[1]), bflo(qw.y) * __expf(c0[2]), bfhi(qw.y) * __expf(c0[3]),
                            bflo(qw.z) * __expf(c1[0]), bfhi(qw.z) * __expf(c1[1]), bflo(qw.w) * __expf(c1[2]), bfhi(qw.w) * __expf(c1[3])); }
#pragma unroll
        for (int mb = 0; mb < 4; ++mb) { const f32x4 s0 = sraw[dir][mb][0], s1 = sraw[dir][mb][1];
            const bf16x8 as = pack8h(s0[0], s0[1], s0[2], s0[3], s1[0], s1[1], s1[2], s1[3]);
            o[mb][0] = MFMA16(as, bq[0], o[mb][0]); if (NI == 2) o[mb][1] = MFMA16(as, bq[1], o[mb][1]); }
#pragma unroll
        for (int pp = 0; pp < 2; ++pp) {
            if ((dir == 0 && half == 0 && pp == 1) || (dir == 1 && half == 1 && pp == 0)) continue;
            f32x4 sc[2][2];
#pragma unroll
            for (int q = 0; q < 2; ++q) { const int jb = 2 * pp + q, j = 16 * jb + lr;
                const u32x4 kw = kraw[jb];
                const f32x4 c0 = *(const LAS f32x4*)(cum + j * CP + chb + 8 * g), c1 = *(const LAS f32x4*)(cum + j * CP + chb + 8 * g + 4);
                const bf16x8 ak = pack8h(bflo(kw.x) * __expf(-c0[0]), bfhi(kw.x) * __expf(-c0[1]), bflo(kw.y) * __expf(-c0[2]), bfhi(kw.y) * __expf(-c0[3]),
                                        bflo(kw.z) * __expf(-c1[0]), bfhi(kw.z) * __expf(-c1[1]), bflo(kw.w) * __expf(-c1[2]), bfhi(kw.w) * __expf(-c1[3]));
#pragma unroll
                for (int ibl = 0; ibl < NI; ++ibl) { f32x4 z = (f32x4){0.f, 0.f, 0.f, 0.f}; z = MFMA16(ak, bq[ibl], z);
                    const int i = 16 * (2 * half + ibase + ibl) + lr;
#pragma unroll
                    for (int r = 0; r < 4; ++r) { const int jj = 16 * jb + 4 * g + r; const bool keep = dir ? (jj >= i) : (jj <= i); z[r] = keep ? z[r] : 0.f; }
                    sc[q][ibl] = z; } }
#pragma unroll
            for (int ibl = 0; ibl < NI; ++ibl) { const bf16x8 pb = pack8h(sc[0][ibl][0], sc[0][ibl][1], sc[0][ibl][2], sc[0][ibl][3], sc[1][ibl][0], sc[1][ibl][1], sc[1][ibl][2], sc[1][ibl][3]);
#pragma unroll
                for (int mb = 0; mb < 4; ++mb) o[mb][ibl] = MFMA16(av[mb][pp], pb, o[mb][ibl]); }
        }
    }
    const float* gg = p->gla_g + l * 64;
#pragma unroll
    for (int ibl = 0; ibl < NI; ++ibl) { float ss = 0.f;
#pragma unroll
        for (int mb = 0; mb < 4; ++mb) ss += (o[mb][ibl][0] * o[mb][ibl][0] + o[mb][ibl][1] * o[mb][ibl][1]) + (o[mb][ibl][2] * o[mb][ibl][2] + o[mb][ibl][3] * o[mb][ibl][3]);
        ss += shfl_f(ss, F.lane ^ 16); ss += shfl_f(ss, F.lane ^ 32);
        const float rstd = 1.f / sqrtf(ss * (1.f / 64.f) + EPS);
        const int i = 16 * (2 * half + ibase + ibl) + lr; const size_t row = (size_t)(row0 + i);
#pragma unroll
        for (int mb = 0; mb < 4; ++mb) { const int dv = 16 * mb + 4 * g; const f32x4 gv = *(const f32x4*)(gg + dv);
            const u32x2 gw = *(const u32x2*)(F.PB + row * NP + PG + h * 64 + dv);
            const float y0 = o[mb][ibl][0] * rstd * gv[0] * silu_f(bflo(gw.x)), y1 = o[mb][ibl][1] * rstd * gv[1] * silu_f(bfhi(gw.x));
            const float y2 = o[mb][ibl][2] * rstd * gv[2] * silu_f(bflo(gw.y)), y3 = o[mb][ibl][3] * rstd * gv[3] * silu_f(bfhi(gw.y));
            u32x2 w; w.x = pk2(y0, y1); w.y = pk2(y2, y3); *(u32x2*)(F.YMIX + row * D + h * 64 + dv) = w; }
    }
    __syncthreads();
}

template <int NKS, int GRP>
__device__ __forceinline__ void dft_mma_lds(f32x4 (&acc)[8], const LAS unsigned char* fl, int pitchB, const bf16* re, const bf16* im, size_t rstride, int khalf, int lane) {
    const int lr = lane & 15, g = lane >> 4;
#pragma unroll
    for (int k0 = 0; k0 < NKS; k0 += GRP) {
        bf16x8 bfrag[GRP];
#pragma unroll
        for (int kq = 0; kq < GRP; ++kq) { const int ks = k0 + kq; const int kk0 = 32 * ks + 8 * g; const bool part = kk0 >= khalf; const int idx = part ? kk0 - khalf : kk0;
            const bf16* src = (part ? im : re) + (size_t)idx * rstride + lr; unsigned short t[8];
#pragma unroll
            for (int e = 0; e < 8; ++e) t[e] = src[(size_t)e * rstride];
            u32x4 w; w.x = t[0] | ((unsigned)t[1] << 16); w.y = t[2] | ((unsigned)t[3] << 16); w.z = t[4] | ((unsigned)t[5] << 16); w.w = t[6] | ((unsigned)t[7] << 16);
            bfrag[kq] = __builtin_bit_cast(bf16x8, w); }
#pragma unroll
        for (int kq = 0; kq < GRP; ++kq) { const int ks = k0 + kq;
#pragma unroll
            for (int mb = 0; mb < 8; ++mb) { const bf16x8 a = *(const LAS bf16x8*)(fl + (16 * mb + lr) * pitchB + (32 * ks + 8 * g) * 2); acc[mb] = MFMA16(a, bfrag[kq], acc[mb]); }
        }
    }
}
__device__ __forceinline__ void f_to_lds(LAS unsigned char* fl, const bf16* Fm, int rows, int rowB, int tid) {
    const int cpr = rowB >> 4, n = rows * cpr;
    for (int i = tid; i < n; i += 512) { const int r = i / cpr, c = i - r * cpr; *(LAS u32x4*)(fl + r * (rowB + 16) + c * 16) = *(const u32x4*)((const unsigned char*)Fm + (size_t)r * rowB + c * 16); }
    __syncthreads();
}
template <int NKS, int GRP = 4, int NMB = 8>
__device__ __forceinline__ void dft_mma(f32x4 (&acc)[NMB], const bf16* Fm, int ldF, int mrow0, const bf16* re, const bf16* im, size_t rstride, int khalf, int lane) {
    const int lr = lane & 15, g = lane >> 4;
#pragma unroll
    for (int k0 = 0; k0 < NKS; k0 += GRP) {
        bf16x8 bfrag[GRP];
#pragma unroll
        for (int kq = 0; kq < GRP; ++kq) { const int ks = k0 + kq; const int kk0 = 32 * ks + 8 * g; const bool part = kk0 >= khalf; const int idx = part ? kk0 - khalf : kk0;
            const bf16* src = (part ? im : re) + (size_t)idx * rstride + lr; unsigned short t[8];
#pragma unroll
            for (int e = 0; e < 8; ++e) t[e] = src[(size_t)e * rstride];
            u32x4 w; w.x = t[0] | ((unsigned)t[1] << 16); w.y = t[2] | ((unsigned)t[3] << 16); w.z = t[4] | ((unsigned)t[5] << 16); w.w = t[6] | ((unsigned)t[7] << 16);
            bfrag[kq] = __builtin_bit_cast(bf16x8, w); }
#pragma unroll
        for (int kq = 0; kq < GRP; ++kq) { const int ks = k0 + kq;
            bf16x8 a[NMB];
#pragma unroll
            for (int mb = 0; mb < NMB; ++mb) a[mb] = *(const bf16x8*)(Fm + (size_t)(mrow0 + 16 * mb + lr) * ldF + 32 * ks + 8 * g);
#pragma unroll
            for (int mb = 0; mb < NMB; ++mb) acc[mb] = MFMA16(a[mb], bfrag[kq], acc[mb]);
            if (kq & 1) __builtin_amdgcn_sched_barrier(0);
        }
    }
}
__device__ __forceinline__ void dft_mma_loop(f32x4 (&acc)[8], const bf16* Fm, int ldF, int mrow0, int nks, const bf16* re, const bf16* im, size_t rstride, int khalf, int lane) {
    const int lr = lane & 15, g = lane >> 4;
#pragma unroll 1
    for (int ks = 0; ks < nks; ++ks) { const int kk0 = 32 * ks + 8 * g; const bool part = kk0 >= khalf; const int idx = part ? kk0 - khalf : kk0;
        const bf16* src = (part ? im : re) + (size_t)idx * rstride + lr; unsigned short t[8];
#pragma unroll
        for (int e = 0; e < 8; ++e) t[e] = src[(size_t)e * rstride];
        u32x4 w; w.x = t[0] | ((unsigned)t[1] << 16); w.y = t[2] | ((unsigned)t[3] << 16); w.z = t[4] | ((unsigned)t[5] << 16); w.w = t[6] | ((unsigned)t[7] << 16);
        const bf16x8 bfrag = __builtin_bit_cast(bf16x8, w);
#pragma unroll
        for (int mb = 0; mb < 8; ++mb) { const bf16x8 a = *(const bf16x8*)(Fm + (size_t)(mrow0 + 16 * mb + lr) * ldF + 32 * ks + 8 * g); acc[mb] = MFMA16(a, bfrag, acc[mb]); }
    }
}
__device__ __forceinline__ void fft_stage1(Ctx& F) {
    const int lr = F.lane & 15, g = F.lane >> 4;
    f_to_lds(F.lds, F.F1, 128, 256, F.tid);
    for (int it = F.gw; it < 4096; it += F.NGW) { const int cb = it & 15, n2 = (it >> 4) & 127, b = it >> 11;
        f32x4 acc[8];
#pragma unroll
        for (int mb = 0; mb < 8; ++mb) acc[mb] = (f32x4){0.f, 0.f, 0.f, 0.f};
        const bf16* re = F.PB + (size_t)(b * SEQ + n2) * NP + PFA + 16 * cb;
        dft_mma_lds<4, 4>(acc, F.lds, 272, re, re + 256, (size_t)128 * NP, 64, F.lane);
#pragma unroll
        for (int mb = 0; mb < 4; ++mb)
#pragma unroll
            for (int r = 0; r < 4; ++r) { const int k1 = 16 * mb + 4 * g + r; const float a = (float)(k1 * n2) * (1.f / 8192.f); const float c = cos_rev(a), s = sin_rev(a);
                const float tr = acc[mb][r], ti = acc[mb + 4][r]; const float xr = tr * c + ti * s, xi = ti * c - tr * s;
                bf16* dst = F.TB + ((size_t)((b * 64 + k1) * 2) * 128 + n2) * 256 + 16 * cb + lr;
                dst[0] = (bf16)f2bf(xr); dst[(size_t)128 * 256] = (bf16)f2bf(xi); }
    }
}
__device__ __forceinline__ void fft_stage2(Ctx& F, int l) {
    const int lr = F.lane & 15, g = F.lane >> 4;
    f_to_lds(F.lds, F.F2, 128, 512, F.tid);
    for (int it = F.gw; it < 2048; it += F.NGW) {
        f32x4 acc[8];
#pragma unroll
        for (int mb = 0; mb < 8; ++mb) acc[mb] = (f32x4){0.f, 0.f, 0.f, 0.f};
        const int cb = it & 15, k1 = (it >> 4) & 63, b = it >> 10;
        const bf16* re = F.TB + (size_t)((b * 64 + k1) * 2) * 128 * 256 + 16 * cb;
        dft_mma_lds<8, 4>(acc, F.lds, 528, re, re + (size_t)128 * 256, 256, 128, F.lane);
#pragma unroll
        for (int mb = 0; mb < 8; ++mb)
#pragma unroll
            for (int r = 0; r < 4; ++r) { const int k2 = 16 * mb + 4 * g + r; F.YMIX[(size_t)(b * SEQ + k1 + 64 * k2) * D + 256 + 16 * cb + lr] = (bf16)f2bf(acc[mb][r]); }
    }
    __syncthreads();
}
__device__ __forceinline__ void ctx_dft(Ctx& F, int w0, int nw) {
    const int lr = F.lane & 15, g = F.lane >> 4;
    for (int it = w0; it >= 0 && it < 256; it += nw) { const int mq = it & 7, cb = (it >> 3) & 15, b = it >> 7;
            f32x4 acc[2] = {(f32x4){0.f, 0.f, 0.f, 0.f}, (f32x4){0.f, 0.f, 0.f, 0.f}};
            const bf16* re = F.PB + (size_t)(ML + b * CTXL) * NP + PFA + 16 * cb;
            dft_mma<8, 4, 2>(acc, F.FC, 512, 32 * mq, re, re, (size_t)NP, 256, F.lane); __builtin_amdgcn_sched_barrier(0);
            dft_mma<8, 4, 2>(acc, F.FC + 256, 512, 32 * mq, re + 256, re + 256, (size_t)NP, 256, F.lane);
#pragma unroll
            for (int mb = 0; mb < 2; ++mb)
#pragma unroll
                for (int r = 0; r < 4; ++r) { const int k = 32 * mq + 16 * mb + 4 * g + r; F.YMIX[(size_t)(ML + b * CTXL + k) * D + 256 + 16 * cb + lr] = (bf16)f2bf(acc[mb][r]); }
        }
}
__device__ __forceinline__ void load8(const bf16* q, float (&v)[8]) { const u32x4 w = *(const u32x4*)q; v[0] = bflo(w.x); v[1] = bfhi(w.x); v[2] = bflo(w.y); v[3] = bfhi(w.y); v[4] = bflo(w.z); v[5] = bfhi(w.z); v[6] = bflo(w.w); v[7] = bfhi(w.w); }
__device__ __forceinline__ void store8(bf16* q, const float (&v)[8]) { u32x4 w; w.x = pk2(v[0], v[1]); w.y = pk2(v[2], v[3]); w.z = pk2(v[4], v[5]); w.w = pk2(v[6], v[7]); *(u32x4*)q = w; }
__device__ __forceinline__ u32x4 ldrow(const bf16* base, int rbase, int t, int n, int col) { const int tc = t < 0 ? 0 : (t > n - 1 ? n - 1 : t); return *(const u32x4*)(base + (size_t)(rbase + tc) * NP + col); }
__device__ __forceinline__ void unpack8(const u32x4 w, float (&v)[8]) { v[0] = bflo(w.x); v[1] = bfhi(w.x); v[2] = bflo(w.y); v[3] = bfhi(w.y); v[4] = bflo(w.z); v[5] = bfhi(w.z); v[6] = bflo(w.w); v[7] = bfhi(w.w); }
__device__ __forceinline__ void convpool_item(PP p, Ctx& F, int l, int it) {
    int rbase, n, t0;
    if (it < 256) { rbase = it * 64; n = 64; t0 = 0; } else { const int sg = it - 256; rbase = ML + (sg >> 2) * CTXL; n = CTXL; t0 = (sg & 3) * 64; }
    const int oct = F.tid & 31, tl = F.tid >> 5, c0 = 8 * oct, tb = t0 + tl * 4;
    {
        u32x4 hw_[6], cw_[6], bw_[4];
#pragma unroll
        for (int i = 0; i < 6; ++i) { hw_[i] = ldrow(F.PB, rbase, tb - 1 + i, n, PH + c0); cw_[i] = ldrow(F.PB, rbase, tb - 1 + i, n, PCG + c0); }
#pragma unroll
        for (int q = 0; q < 4; ++q) bw_[q] = ldrow(F.PB, rbase, tb + q, n, PBG + c0);
        const f32x4 w0a = *(const f32x4*)(p->conv_w + (l * 3 + 0) * 256 + c0), w0b = *(const f32x4*)(p->conv_w + (l * 3 + 0) * 256 + c0 + 4);
        const f32x4 w1a = *(const f32x4*)(p->conv_w + (l * 3 + 1) * 256 + c0), w1b = *(const f32x4*)(p->conv_w + (l * 3 + 1) * 256 + c0 + 4);
        const f32x4 w2a = *(const f32x4*)(p->conv_w + (l * 3 + 2) * 256 + c0), w2b = *(const f32x4*)(p->conv_w + (l * 3 + 2) * 256 + c0 + 4);
        const f32x4 cba = *(const f32x4*)(p->conv_b + l * 256 + c0), cbb = *(const f32x4*)(p->conv_b + l * 256 + c0 + 4);
        float hc[6][8];
#pragma unroll
        for (int i = 0; i < 6; ++i) { float a[8], b[8]; unpack8(hw_[i], a); unpack8(cw_[i], b); const int t = tb - 1 + i; const float msk = (t >= 0 && t < n) ? 1.f : 0.f;
#pragma unroll
            for (int e = 0; e < 8; ++e) hc[i][e] = a[e] * b[e] * msk; }
#pragma unroll
        for (int q = 0; q < 4; ++q) { float bg[8], y[8]; unpack8(bw_[q], bg);
#pragma unroll
            for (int e = 0; e < 8; ++e) { const float w0 = e < 4 ? w0a[e & 3] : w0b[e & 3], w1 = e < 4 ? w1a[e & 3] : w1b[e & 3], w2 = e < 4 ? w2a[e & 3] : w2b[e & 3], cb = e < 4 ? cba[e & 3] : cbb[e & 3];
                y[e] = bg[e] * (w0 * hc[q][e] + w1 * hc[q + 1][e] + w2 * hc[q + 2][e] + cb); }
            store8(F.YMIX + (size_t)(rbase + tb + q) * D + 512 + c0, y); }
    }
    __builtin_amdgcn_sched_barrier(0);
    {
        const int wnd = 2 << (oct >> 3), hw = wnd >> 1;
        float s[4][8], self[4][8];
#pragma unroll
        for (int q = 0; q < 4; ++q) { unpack8(ldrow(F.PB, rbase, tb + q, n, PPOOL + c0), self[q]);
#pragma unroll
            for (int e = 0; e < 8; ++e) s[q][e] = 0.f; }
        __builtin_amdgcn_sched_barrier(0);
#pragma unroll
        for (int bt = 0; bt < 19; bt += 7) {
            u32x4 pw[7];
#pragma unroll
            for (int ii = 0; ii < 7; ++ii) if (bt + ii < 19) pw[ii] = ldrow(F.PB, rbase, tb - hw + bt + ii, n, PPOOL + c0);
#pragma unroll
            for (int ii = 0; ii < 7; ++ii) if (bt + ii < 19) { const int i = bt + ii; float v[8]; unpack8(pw[ii], v); const int t = tb - hw + i; const bool inr = (t >= 0 && t < n);
#pragma unroll
                for (int q = 0; q < 4; ++q) { const float mk = (inr && i >= q && i < q + wnd) ? 1.f : 0.f;
#pragma unroll
                    for (int e = 0; e < 8; ++e) s[q][e] += mk * v[e]; } }
            __builtin_amdgcn_sched_barrier(0);
        }
#pragma unroll
        for (int q = 0; q < 4; ++q) { const int t = tb + q; const int lo = (t - hw > 0) ? t - hw : 0, hi = (t + hw - 1 < n - 1) ? t + hw - 1 : n - 1; const float inv = 1.f / (float)(hi - lo + 1);
            float y[8];
#pragma unroll
            for (int e = 0; e < 8; ++e) y[e] = s[q][e] * inv - self[q][e];
            store8(F.YMIX + (size_t)(rbase + t) * D + 768 + c0, y); }
    }
}
__device__ __forceinline__ void ctx_act(PP p, Ctx& F, int l) {
    const int gt = blockIdx.x * 512 + F.tid, NT = F.G * 512;
    for (int i = gt; i < MC * 352; i += NT) { const int oc = i % 352, rc = i / 352, t = rc & 255, c0 = 8 * oc;
        const bf16* base = F.CAU + (size_t)rc * NUP + c0; float a[8], y[8], u[8];
        const float* cw = p->ffn_cw + (size_t)l * 3 * DFF + c0; const float* cb = p->ffn_cb + (size_t)l * DFF + c0;
#pragma unroll
        for (int e = 0; e < 8; ++e) y[e] = cb[e];
        if (t > 0) { load8(base - NUP, a);
#pragma unroll
            for (int e = 0; e < 8; ++e) y[e] += cw[e] * a[e]; }
        load8(base, a);
#pragma unroll
        for (int e = 0; e < 8; ++e) y[e] += cw[DFF + e] * a[e];
        if (t < 255) { load8(base + NUP, a);
#pragma unroll
            for (int e = 0; e < 8; ++e) y[e] += cw[2 * DFF + e] * a[e]; }
        load8(base + DFF, u);
#pragma unroll
        for (int e = 0; e < 8; ++e) y[e] = silu_f(y[e]) * u[e];
        store8(F.ACT + (size_t)(ML + rc) * DFF + c0, y);
    }
}
__global__ void __launch_bounds__(512, 2) fwd_megakernel(Params p_) {
    PP p = (PP)__builtin_amdgcn_kernarg_segment_ptr();
    extern __shared__ __attribute__((aligned(16))) unsigned char lds_raw[];
    cg::grid_group grid = cg::this_grid();
    Ctx F;
    F.lds = (LAS unsigned char*)lds_raw; F.tid = threadIdx.x; F.lane = F.tid & 63; F.wave = __builtin_amdgcn_readfirstlane(F.tid >> 6);
    const int wave_s = F.wave;
    F.G = gridDim.x; F.gw = blockIdx.x * 8 + F.wave; F.NGW = F.G * 8;
    unsigned char* ws = p->ws;
#define SETPTRS() do { { PP q_ = (PP)__builtin_amdgcn_kernarg_segment_ptr(); asm volatile("" : "+s"(q_)); p = q_; } unsigned char* w_ = p->ws; asm volatile("" : "+s"(w_)); \
    F.MOD = (float*)(w_ + WS_MOD); F.MCS = (float*)(w_ + WS_MCS); F.F1 = (bf16*)(w_ + WS_F1); F.F2 = (bf16*)(w_ + WS_F2); F.FC = (bf16*)(w_ + WS_FC); \
    F.HX = (bf16*)(w_ + WS_HX); F.TB = (bf16*)(w_ + WS_HX); F.YMIX = (bf16*)(w_ + WS_YMIX); F.PB = (bf16*)(w_ + WS_P); F.ACT = (bf16*)(w_ + WS_P); \
    F.XC = (float*)(w_ + WS_XC); F.ST = (float*)(w_ + WS_ST); F.DEC = (float*)(w_ + WS_DEC); F.CAU = (bf16*)(w_ + WS_CAU); } while (0)
    SETPTRS();

#ifndef NO_P0
#define REFRESH() do { int t_; asm volatile("v_mbcnt_lo_u32_b32 %0, -1, 0\n\tv_mbcnt_hi_u32_b32 %0, -1, %0" : "=v"(t_)); t_ |= (wave_s << 6); F.tid = t_; F.lane = t_ & 63; F.wave = __builtin_amdgcn_readfirstlane(t_ >> 6); F.gw = blockIdx.x * 8 + F.wave; SETPTRS(); } while (0)
    { volatile LAS unsigned* misc = (volatile LAS unsigned*)(F.lds + RING_BYTES); if (F.tid < 64) misc[F.tid] = 0u; }
    __syncthreads();
    XcdBarrier bar = xcd_barrier_post((unsigned*)(ws + WS_CTL), (volatile LAS unsigned*)(F.lds + RING_BYTES) + 8, F.tid);
#define GSYNC() do { REFRESH(); xcd_barrier(bar, F.tid); } while (0)
    REFRESH();
    phase0(p, F);
#endif
    if (p->ws == nullptr) grid.sync();
    GSYNC();
#define L0() ({ int lq_ = l; asm volatile("" : "+s"(lq_)); lq_ == 0; })
    for (int l = 0; l < 2; ++l) {
        const int M6 = L0() ? MT : ML;
#ifndef NO_P1
        REFRESH();
        norm_phase(p, F, l, 0, MT);
        REFRESH();
        if (L0()) fold_items(p, F);
#ifdef PROBE_B
        REFRESH(); norm_phase(p, F, l, 0, MT); if (L0()) fold_items(p, F);
#endif
#endif
        GSYNC();
#ifndef NO_P2
        REFRESH();
        { pg8::Gemm g{F.HX, win_t(p, l), MT, NP, D, D}; pg8::StaticOrder S; S.init(MT, NP, F.G, (int)blockIdx.x);
          EpiP E{F.PB, p->b_a2 + l * 256};
          pg8::gemm_phase<EpiP, pg8::StaticOrder, true, true>(F.lds, g, S, E, F.tid);
#ifdef PROBE_C
          __syncthreads(); pg8::gemm_phase<EpiP, pg8::StaticOrder, true, true>(F.lds, g, S, E, F.tid);
#endif
        }
#endif
        GSYNC();
#ifdef PROBE_A
        for (int rep_ = 0; rep_ < 2; ++rep_) {
#else
        {
#endif
#ifndef NO_GA
        REFRESH();
        for (int it = blockIdx.x; it < 2 * NCH; it += F.G) gla_a_item(F, it / NCH, it % NCH);
#ifdef PR_GA
        __syncthreads(); REFRESH();
        for (int it = blockIdx.x; it < 2 * NCH; it += F.G) gla_a_item(F, it / NCH, it % NCH);
#endif
#endif
#ifndef NO_F1
        REFRESH();
        fft_stage1(F);
#ifdef PR_F1
        __syncthreads(); REFRESH();
        fft_stage1(F);
#endif
#endif
#ifndef NO_CP
        REFRESH();
        for (int v = blockIdx.x; v < 512; v += F.G) { const int it = (v < 256) ? v : 256 + ((v + 248) & 255);
            if (it >= (L0() ? 264 : 256)) continue; convpool_item(p, F, l, it); }
#ifdef PR_CP
        __syncthreads(); REFRESH();
        for (int v = blockIdx.x; v < 512; v += F.G) { const int it = (v < 256) ? v : 256 + ((v + 248) & 255);
            if (it >= (L0() ? 264 : 256)) continue; convpool_item(p, F, l, it); }
#endif
#endif
        }
        GSYNC();
#ifdef PROBE_A
        REFRESH(); fft_stage2(F, l);
#endif
#ifndef NO_F2
        REFRESH();
        fft_stage2(F, l);
#ifdef PR_F2
        __syncthreads(); REFRESH();
        fft_stage2(F, l);
#endif
#endif
#ifndef NO_SC
        REFRESH();
        gla_scan(F);
#endif
        GSYNC();
#ifdef PROBE_A
        for (int rep_ = 0; rep_ < 2; ++rep_) {
#else
        {
#endif
#ifndef NO_GC
        REFRESH();
        for (int it = blockIdx.x; it < 256; it += F.G) gla_c_item<2>(p, F, l, it >> 7, 4 + (it & 127), 0);
        if (L0()) for (int j = blockIdx.x; j < 16; j += F.G) gla_c_item<1>(p, F, l, j >> 3, (j >> 1) & 3, j & 1);
        if (L0()) { if (F.G == 256) ctx_dft(F, F.gw - 256, 1 << 30); else ctx_dft(F, F.gw, F.NGW); }
#ifdef PR_GC
        __syncthreads(); REFRESH();
        for (int it = blockIdx.x; it < 256; it += F.G) gla_c_item<2>(p, F, l, it >> 7, 4 + (it & 127), 0);
#endif
#endif
        }
        GSYNC();
#ifndef NO_P6
        REFRESH();
        if (L0()) { pg8::Gemm g{F.YMIX, wout_t(p, l), MT, D, 256, D}; SplitOrder S; S.init(4, F.G, (int)blockIdx.x);
          EpiPartial E{(float*)(p->ws + WS_PART)};
          pg8::gemm_phase<EpiPartial, SplitOrder, false, false>(F.lds, g, S, E, F.tid); __syncthreads(); }
        REFRESH();
        { pg8::Gemm g{F.YMIX, wout_t(p, l), ML, D, D, D}; pg8::StaticOrder S; S.init(ML, D, F.G, (int)blockIdx.x);
          if (L0()) { EpiRes<false, true> E{p->x, p->out, F.MOD + l * 3 * 6144 + 2048}; pg8::gemm_phase<EpiRes<false, true>, pg8::StaticOrder, true, true>(F.lds, g, S, E, F.tid); }
          else { EpiRes<true, true> E{p->out, (F.G == 256) ? (void*)(p->ws + WS_XB2) : (void*)p->out, F.MOD + l * 3 * 6144 + 2048}; pg8::gemm_phase<EpiRes<true, true>, pg8::StaticOrder, true, true>(F.lds, g, S, E, F.tid); } }
#endif
        GSYNC();
#ifndef NO_P7
        REFRESH();
        norm_phase(p, F, l, 1, M6);
#ifdef PROBE_B
        REFRESH(); norm_phase(p, F, l, 1, M6);
#endif
#endif
        GSYNC();
#ifndef NO_P8
        REFRESH();
        { pg8::Gemm g{F.HX, wup_t(p, l), ML, NUP, D, D}; pg8::StaticOrder S; S.init(ML, NUP, F.G, (int)blockIdx.x);
          EpiUp E{F.ACT, p->ffn_cw + (size_t)l * 3 * DFF, p->ffn_cb + (size_t)l * DFF};
          pg8::gemm_phase<EpiUp, pg8::StaticOrder, true, true>(F.lds, g, S, E, F.tid);
        }
        if (L0()) { REFRESH(); __syncthreads();
          pg8::Gemm g{F.HX, wup_t(p, l), MT, NUP, D, D}; CtxOrder S; S.init(NUP, (int)blockIdx.x, 128);
          EpiUpCtx E{F.ACT, p->ffn_cw + (size_t)l * 3 * DFF, p->ffn_cb + (size_t)l * DFF, (LAS float*)(F.lds + RING_BYTES + 1024)};
          pg8::gemm_phase<EpiUpCtx, CtxOrder, true, false>(F.lds, g, S, E, F.tid); }
#endif
        GSYNC();
#ifndef NO_P9
        REFRESH();
        if (L0()) { pg8::Gemm g{F.ACT, wdn_t(p, l), MT, D, 256, DFF}; SplitOrder S; S.init(11, F.G, (int)blockIdx.x);
          EpiPartial E{(float*)(p->ws + WS_PART)};
          pg8::gemm_phase<EpiPartial, SplitOrder, false, false>(F.lds, g, S, E, F.tid); __syncthreads(); }
        REFRESH();
        { pg8::Gemm g{F.ACT, wdn_t(p, l), ML, D, DFF, DFF}; pg8::StaticOrder S; S.init(ML, D, F.G, (int)blockIdx.x);
          if (L0()) { EpiRes<true, true> E{p->out, p->out, F.MOD + l * 3 * 6144 + 5120}; pg8::gemm_phase<EpiRes<true, true>, pg8::StaticOrder, true, true>(F.lds, g, S, E, F.tid); }
          else if (F.G == 256) { EpiFinal E{(const bf16*)(p->ws + WS_XB2), p->out, F.MOD + l * 3 * 6144 + 5120, p->final_g, (float*)(p->ws + WS_SLOT), (unsigned*)(p->ws + WS_CTL) + CW_FIN};
            pg8::gemm_phase<EpiFinal, pg8::StaticOrder, false, true>(F.lds, g, S, E, F.tid); }
          else { EpiRes<true, false> E{p->out, p->ws + WS_HX, F.MOD + l * 3 * 6144 + 5120}; pg8::gemm_phase<EpiRes<true, false>, pg8::StaticOrder, true, true>(F.lds, g, S, E, F.tid); } }
#endif
        if (L0() || F.G != 256) GSYNC();
    }
        REFRESH();
    if (F.G != 256) final_norm(p, F);
}

extern "C" void kernel_launch(void* const* d_in, const int* in_sizes, int n_in, void* d_out, int out_size, void* d_ws, size_t ws_size, hipStream_t stream) {
    static int grid = 0;
    if (grid == 0) {
        if (n_in != 23 || in_sizes[0] != ML * D || out_size != ML * D || ws_size < WS_END) { fprintf(stderr, "kernel_launch: unexpected shapes / workspace (%d inputs, ws %zu)\n", n_in, ws_size); grid = -1; return; }
        int dev = 0, cus = 0, per_cu = 0;
        hipGetDevice(&dev); hipDeviceGetAttribute(&cus, hipDeviceAttributeMultiprocessorCount, dev);
        if (hipFuncSetAttribute((const void*)fwd_megakernel, hipFuncAttributeMaxDynamicSharedMemorySize, LDS_BYTES) != hipSuccess) { fprintf(stderr, "hipFuncSetAttribute failed\n"); grid = -1; return; }
        if (hipOccupancyMaxActiveBlocksPerMultiprocessor(&per_cu, (const void*)fwd_megakernel, 512, LDS_BYTES) != hipSuccess || per_cu < 1) per_cu = 1;
        (void)hipGetLastError();
        grid = cus * 1;
    }
    if (grid < 0) return;
    if (hipMemsetAsync((char*)d_ws + WS_CTL, 0, 32768, stream) != hipSuccess) { fprintf(stderr, "memset failed\n"); return; }
    Params p{};
    const float** pp = (const float**)&p;
    for (int i = 0; i < 23; ++i) pp[i] = (const float*)d_in[i];
    p.out = (float*)d_out; p.ws = (unsigned char*)d_ws;
    void* args[] = {&p};
    hipError_t e = hipLaunchCooperativeKernel((const void*)fwd_megakernel, dim3(grid), dim3(512), args, LDS_BYTES, stream);
    if (e != hipSuccess) fprintf(stderr, "cooperative launch failed: %s (grid %d)\n", hipGetErrorString(e), grid);
}
```

```cpp
#include <hip/hip_runtime.h>
#include <hip/hip_cooperative_groups.h>
#include <cstdio>
#include <cstdint>
namespace cg = cooperative_groups;
namespace pg8 {
#define PG8_LAS __attribute__((address_space(3)))
typedef unsigned short bf16_t;
typedef short bf16x8 __attribute__((ext_vector_type(8)));
typedef float f32x4 __attribute__((ext_vector_type(4)));
typedef unsigned u32x4 __attribute__((ext_vector_type(4)));
constexpr int BM = 256, BK = 64, HALF = 128, HTB = HALF * BK * 2  , STAGE_BYTES = 8 * HTB, NXCD = 8, WGM = 8;

__host__ __device__ __forceinline__ int lds_byte(int r, int c) { const int st = (r >> 4) * 2 + (c >> 5), rr = r & 15, cc = c & 31, ob = rr * 64 + cc * 2; return st * 1024 + (ob ^ (((ob >> 9) & 1) << 5)); }
__host__ __device__ __forceinline__ void stage_rc(int b, int& R, int& C) { const int st = b / 1024, sb = b % 1024, swz = sb ^ (((sb >> 9) & 1) << 5); R = (st >> 1) * 16 + swz / 64; C = (st & 1) * 32 + (swz % 64) / 2; }
__host__ __device__ __forceinline__ int perm32(int rho) { const int n = rho >> 4, i = rho & 15; return 8 * (i >> 2) + 4 * n + (i & 3); }

struct Unit { int pm, pn, ks; };
struct Gemm { const bf16_t* A; const bf16_t* Bt; int M, N, K, ld; };

struct StaticOrder {
    int nM, nN, nwg, G, c;
    __host__ __device__ void init(int M, int N, int G_, int c_) { nM = M / BM; nN = N / BM; nwg = nM * nN; G = G_; c = c_; }
    __host__ __device__ bool next(int i, Unit& u) const {
        const long L = (long)i * G + c; if (L >= nwg) return false;
        int wgid = (int)L; { const int q = nwg / NXCD, r = nwg % NXCD, xcd = wgid % NXCD, off = wgid / NXCD; wgid = (xcd < r ? xcd * (q + 1) : r * (q + 1) + (xcd - r) * q) + off; }
        const int nig = WGM * nN, gid = wgid / nig, fm = gid * WGM, gsz = (nM - fm) < WGM ? (nM - fm) : WGM;
        u.pm = fm + ((wgid % nig) % gsz); u.pn = (wgid % nig) / gsz; u.ks = 0; return true;
    }
    __device__ __forceinline__ void a_ready(const Unit&) const {}
    __device__ __forceinline__ void done(const Unit&) const {}
};

__device__ __forceinline__ unsigned cvt_pk_bf16(float lo, float hi) { unsigned r; asm volatile("v_cvt_pk_bf16_f32 %0, %1, %2" : "=v"(r) : "v"(lo), "v"(hi)); return r; }
template <class Epi, class Sched, bool ALIGN_EPI = false, bool SP2 = false>
__device__ __forceinline__ void gemm_phase(PG8_LAS unsigned char* lds, const Gemm g, const Sched& S, const Epi& E, int tid_in) {
    int tid_ = tid_in; asm volatile("" : "+v"(tid_)); const int tid = tid_, wid = __builtin_amdgcn_readfirstlane(tid >> 6), lane = tid & 63, wr = wid >> 2, wc = wid & 3, fr = lane & 15, fq = lane >> 4;
    const int K = g.ld, nt = g.K / BK; const size_t sstep = (size_t)g.K * 2;
    unsigned voffA[2], voffB[2];
#pragma unroll
    for (int i = 0; i < 2; ++i) { int R, C; stage_rc(tid * 16 + i * 8192, R, C); const int Rb = Epi::PERM ? ((R & ~31) + perm32(R & 31)) : R;
        voffA[i] = (unsigned)(R * K + C) * 2u; voffB[i] = (unsigned)(Rb * K + C) * 2u; }
    const size_t kstep = (size_t)(BK * 2);
    const size_t hstep = (size_t)HALF * K * 2;
    const size_t tstep = 2 * hstep;
    const unsigned ldsw = (unsigned)wid * 1024u;
    const int aoff = lds_byte(wr * 64 + fr, fq * 8), boff = lds_byte(wc * 32 + fr, fq * 8);
#define PG8_SA(b, h) (((b) * 2 + (h)) * HTB)
#define PG8_SB(b, h) ((4 + (b) * 2 + (h)) * HTB)
#define PG8_STAGE(bufoff, gbase, voff) do { _Pragma("unroll") for (int _i = 0; _i < 2; ++_i) \
        __builtin_amdgcn_global_load_lds((const unsigned*)((const char*)(gbase) + (voff)[_i]), (PG8_LAS unsigned*)(lds + (bufoff) + ldsw + _i * 8192), 16, 0, 0); } while (0)
#define PG8_LDA(dst, b, h) do { _Pragma("unroll") for (int m = 0; m < 4; ++m) _Pragma("unroll") for (int k = 0; k < 2; ++k) dst[m][k] = *(const PG8_LAS bf16x8*)(lds + PG8_SA(b, h) + aoff + m * 2048 + k * 1024); } while (0)
#define PG8_LDB(dst, b, h) do { _Pragma("unroll") for (int n = 0; n < 2; ++n) _Pragma("unroll") for (int k = 0; k < 2; ++k) dst[n][k] = *(const PG8_LAS bf16x8*)(lds + PG8_SB(b, h) + boff + n * 2048 + k * 1024); } while (0)
#define PG8_MMA(ai, bj, At, Bt) do { __builtin_amdgcn_s_setprio(1); _Pragma("unroll") for (int m = 0; m < 4; ++m) _Pragma("unroll") for (int n = 0; n < 2; ++n) _Pragma("unroll") for (int k = 0; k < 2; ++k) \
        acc[ai][bj][m][n] = __builtin_amdgcn_mfma_f32_16x16x32_bf16(Bt[n][k], At[m][k], acc[ai][bj][m][n], 0, 0, 0); __builtin_amdgcn_s_setprio(0); } while (0)
#define PG8_WAIT_V(n) asm volatile("s_waitcnt vmcnt(" #n ")" ::: "memory")
#define PG8_WAIT_L(n) asm volatile("s_waitcnt lgkmcnt(" #n ")" ::: "memory")
#define PG8_BAR __builtin_amdgcn_s_barrier()
#define PG8_SCHED __builtin_amdgcn_sched_barrier(0)
    Unit cur, nxt; int ui = 0;
    if (!S.next(0, cur)) return;
    f32x4 acc[2][2][4][2];
#pragma unroll
    for (int a = 0; a < 2; ++a)
#pragma unroll
        for (int b = 0; b < 2; ++b)
#pragma unroll
            for (int m = 0; m < 4; ++m)
#pragma unroll
                for (int n = 0; n < 2; ++n) acc[a][b][m][n] = (f32x4){0.f, 0.f, 0.f, 0.f};
    bf16x8 At[4][2], B0[2][2], B1[2][2];
    const char* cA = (const char*)g.A + (size_t)cur.pm * tstep + (size_t)cur.ks * sstep; const char* cB = (const char*)g.Bt + (size_t)cur.pn * tstep + (size_t)cur.ks * sstep;
    S.a_ready(cur);
    if constexpr (SP2) {
        PG8_STAGE(PG8_SB(0, 0), cB, voffB); PG8_STAGE(PG8_SB(0, 1), cB + hstep, voffB); PG8_STAGE(PG8_SA(0, 0), cA, voffA); PG8_STAGE(PG8_SA(0, 1), cA + hstep, voffA);
        if (wr == 1) PG8_BAR;
        PG8_WAIT_V(2); PG8_BAR;
        PG8_STAGE(PG8_SB(1, 0), cB + kstep, voffB); PG8_STAGE(PG8_SA(1, 0), cA + kstep, voffA); PG8_STAGE(PG8_SB(1, 1), cB + hstep + kstep, voffB);
        PG8_WAIT_V(6); PG8_BAR;
    } else {
        PG8_STAGE(PG8_SB(0, 0), cB, voffB); PG8_STAGE(PG8_SA(0, 0), cA, voffA); PG8_STAGE(PG8_SB(0, 1), cB + hstep, voffB); PG8_STAGE(PG8_SA(0, 1), cA + hstep, voffA);
        if (wr == 1) PG8_BAR;
        PG8_WAIT_V(4); PG8_BAR;
        PG8_STAGE(PG8_SB(1, 0), cB + kstep, voffB); PG8_STAGE(PG8_SA(1, 0), cA + kstep, voffA); PG8_STAGE(PG8_SB(1, 1), cB + hstep + kstep, voffB);
        PG8_WAIT_V(6); PG8_BAR;
    }
    for (;;) {
        const bool has_next = S.next(ui + 1, nxt);
        const char* nA = has_next ? (const char*)g.A + (size_t)nxt.pm * tstep + (size_t)nxt.ks * sstep : cA; const char* nB = has_next ? (const char*)g.Bt + (size_t)nxt.pn * tstep + (size_t)nxt.ks * sstep : cB;
        for (int t = 0; t < nt; t += 2) {
            const bool last = (t == nt - 2);
            const char* a1 = cA + (size_t)(t + 1) * kstep;
            const char* a2 = last ? nA : cA + (size_t)(t + 2) * kstep; const char* b2 = last ? nB : cB + (size_t)(t + 2) * kstep;
            const char* a3 = a2 + kstep; const char* b3 = b2 + kstep;
            if (last && has_next) S.a_ready(nxt);
            if constexpr (SP2) {
            PG8_LDB(B0, 0, 0); PG8_LDB(B1, 0, 1); PG8_SCHED; PG8_LDA(At, 0, 0); PG8_STAGE(PG8_SA(1, 1), a1 + hstep, voffA);
            PG8_WAIT_V(8); PG8_WAIT_L(0); PG8_BAR; PG8_MMA(0, 0, At, B0); PG8_MMA(0, 1, At, B1); PG8_BAR; PG8_SCHED;
            PG8_LDA(At, 0, 1); PG8_STAGE(PG8_SB(0, 0), b2, voffB); PG8_STAGE(PG8_SB(0, 1), b2 + hstep, voffB); PG8_STAGE(PG8_SA(0, 0), a2, voffA);
            PG8_WAIT_V(8); PG8_WAIT_L(0); PG8_BAR; PG8_MMA(1, 0, At, B0); PG8_MMA(1, 1, At, B1); PG8_BAR; PG8_SCHED;
            PG8_LDB(B0, 1, 0); PG8_LDB(B1, 1, 1); PG8_SCHED; PG8_LDA(At, 1, 0); PG8_STAGE(PG8_SA(0, 1), a2 + hstep, voffA);
            PG8_WAIT_V(8); PG8_WAIT_L(0); PG8_BAR; PG8_MMA(0, 0, At, B0); PG8_MMA(0, 1, At, B1); PG8_BAR; PG8_SCHED;
            PG8_LDA(At, 1, 1); PG8_STAGE(PG8_SB(1, 0), b3, voffB); PG8_STAGE(PG8_SB(1, 1), b3 + hstep, voffB); PG8_STAGE(PG8_SA(1, 0), a3, voffA);
            PG8_WAIT_V(8); PG8_WAIT_L(0); PG8_BAR; PG8_MMA(1, 0, At, B0); PG8_MMA(1, 1, At, B1); PG8_BAR; PG8_SCHED;
            } else {
            PG8_LDB(B0, 0, 0); PG8_SCHED; PG8_LDA(At, 0, 0); PG8_STAGE(PG8_SA(1, 1), a1 + hstep, voffA);
            PG8_WAIT_L(8); PG8_BAR; PG8_WAIT_L(0); PG8_MMA(0, 0, At, B0); PG8_BAR; PG8_SCHED;
            PG8_LDB(B1, 0, 1); PG8_STAGE(PG8_SB(0, 0), b2, voffB);
            PG8_BAR; PG8_WAIT_L(0); PG8_MMA(0, 1, At, B1); PG8_BAR;
            PG8_LDA(At, 0, 1); PG8_STAGE(PG8_SA(0, 0), a2, voffA);
            PG8_BAR; PG8_WAIT_L(0); PG8_MMA(1, 0, At, B0); PG8_BAR; PG8_SCHED;
            PG8_STAGE(PG8_SB(0, 1), b2 + hstep, voffB);
            PG8_WAIT_V(6); PG8_BAR; PG8_MMA(1, 1, At, B1); PG8_BAR;
            PG8_LDB(B0, 1, 0); PG8_SCHED; PG8_LDA(At, 1, 0); PG8_STAGE(PG8_SA(0, 1), a2 + hstep, voffA);
            PG8_WAIT_L(8); PG8_BAR; PG8_WAIT_L(0); PG8_MMA(0, 0, At, B0); PG8_BAR; PG8_SCHED;
            PG8_LDB(B1, 1, 1); PG8_STAGE(PG8_SB(1, 0), b3, voffB);
            PG8_BAR; PG8_WAIT_L(0); PG8_MMA(0, 1, At, B1); PG8_BAR;
            PG8_LDA(At, 1, 1); PG8_STAGE(PG8_SA(1, 0), a3, voffA);
            PG8_BAR; PG8_WAIT_L(0); PG8_MMA(1, 0, At, B0); PG8_BAR; PG8_SCHED;
            PG8_STAGE(PG8_SB(1, 1), b3 + hstep, voffB);
            PG8_WAIT_V(6); PG8_BAR; PG8_MMA(1, 1, At, B1); PG8_BAR;
            }
        }
        if constexpr (ALIGN_EPI) { if (wr == 0) PG8_BAR; }
        if constexpr (!Epi::AFTER_DRAIN) { E(acc, cur, wr, wc, fr, fq); S.done(cur); }
        if (!has_next) break;
#pragma unroll
        for (int a = 0; a < 2; ++a)
#pragma unroll
            for (int b = 0; b < 2; ++b)
#pragma unroll
                for (int m = 0; m < 4; ++m)
#pragma unroll
                    for (int n = 0; n < 2; ++n) acc[a][b][m][n] = (f32x4){0.f, 0.f, 0.f, 0.f};
        cur = nxt; cA = nA; cB = nB; ++ui;
        if constexpr (ALIGN_EPI) { if (wr == 1) PG8_BAR; }
    }
    PG8_WAIT_V(0);
    if constexpr (!ALIGN_EPI) { if (wr == 0) PG8_BAR; }
    PG8_BAR;
    if constexpr (Epi::AFTER_DRAIN) { E.fused(acc, cur, wr, wc, fr, fq, lds, wid, lane); S.done(cur); }
#undef PG8_SA
#undef PG8_SB
#undef PG8_STAGE
#undef PG8_LDA
#undef PG8_LDB
#undef PG8_MMA
#undef PG8_WAIT_V
#undef PG8_WAIT_L
#undef PG8_BAR
#undef PG8_SCHED
}
}
#define LAS __attribute__((address_space(3)))
typedef unsigned short bf16;
typedef float f32x4 __attribute__((ext_vector_type(4)));
typedef short bf16x8 __attribute__((ext_vector_type(8)));
typedef unsigned u32x4 __attribute__((ext_vector_type(4)));
typedef unsigned u32x2 __attribute__((ext_vector_type(2)));
#define LDS_WAIT() asm volatile("s_waitcnt lgkmcnt(0)" ::: "memory")

constexpr int D = 1024, SEQ = 8192, ML = 16384, MC = 512, MT = ML + MC, CTXL = 256;
constexpr int DIN = 2080, NP = 2560, DFF = 2816, NUP = 5632;
constexpr int PK = 0, PQ = 128, PV = 256, PLA = 512, PG = 768, PFA = 1024, PFB = 1280, PH = 1536, PBG = 1792, PCG = 2048, PPOOL = 2304;
constexpr int NCH = 132;
constexpr float EPS = 1e-6f;
constexpr size_t MiB = 1u << 20;
constexpr size_t WS_CTL = 0;
constexpr size_t WS_MOD = 1 * MiB;
constexpr size_t WS_MCS = 1 * MiB + 256 * 1024;
constexpr size_t WS_F1 = 1 * MiB + 512 * 1024;
constexpr size_t WS_F2 = WS_F1 + 32 * 1024;
constexpr size_t WS_FC = WS_F2 + 64 * 1024;
constexpr size_t WS_SLOT = 49 * MiB;
constexpr size_t WS_XB2 = 208 * MiB;
constexpr int CW_FIN = 3584;
constexpr size_t WS_W = 2 * MiB;
constexpr size_t W_IN_B = (size_t)NP * D * 2, W_OUT_B = (size_t)D * D * 2, W_UP_B = (size_t)NUP * D * 2, W_DN_B = (size_t)D * DFF * 2;
constexpr size_t W_LAYER_B = W_IN_B + W_OUT_B + W_UP_B + W_DN_B;
constexpr size_t WS_HX = 50 * MiB;
constexpr size_t WS_YMIX = 83 * MiB;
constexpr size_t WS_P = 116 * MiB;
constexpr size_t WS_XC = 207 * MiB;
constexpr size_t WS_ST = 209 * MiB;
constexpr size_t WS_DEC = 226 * MiB;
constexpr size_t WS_CAU = 227 * MiB;
constexpr size_t WS_PART = 233 * MiB;
constexpr size_t WS_END = 255 * MiB;
static_assert(WS_W + 2 * W_LAYER_B <= WS_HX, "weights");
static_assert(WS_P + (size_t)MT * DFF * 2 <= WS_XC, "act");
constexpr int RING_BYTES = 131072, LDS_BYTES = 147456;

struct Params {
    const float *x, *c, *ctx, *c_ctx, *norm1_g, *norm2_g, *w_mod, *b_mod, *w_in, *w_a2, *b_a2, *gla_g, *fft_w, *conv_w, *conv_b, *pool_w,
        *pool_scale, *w_out, *w_up, *ffn_cw, *ffn_cb, *w_down, *final_g;
    float* out; unsigned char* ws;
};

typedef const __attribute__((address_space(4))) Params* PP;
__device__ __forceinline__ unsigned f2bf(float f) { unsigned u = __builtin_bit_cast(unsigned, f); return (u + 0x7fffu + ((u >> 16) & 1u)) >> 16; }
__device__ __forceinline__ unsigned pk2(float lo, float hi) { return f2bf(lo) | (f2bf(hi) << 16); }
__device__ __forceinline__ float bf2f(unsigned h) { return __builtin_bit_cast(float, h << 16); }
__device__ __forceinline__ float bflo(unsigned w) { return __builtin_bit_cast(float, w << 16); }
__device__ __forceinline__ float bfhi(unsigned w) { return __builtin_bit_cast(float, w & 0xffff0000u); }
__device__ __forceinline__ float shfl_f(float v, int src_lane) { return __builtin_bit_cast(float, __builtin_amdgcn_ds_bpermute(src_lane << 2, __builtin_bit_cast(int, v))); }
__device__ __forceinline__ float wave_sum(float v, int lane) {
#pragma unroll
    for (int o = 1; o < 64; o <<= 1) v += shfl_f(v, lane ^ o);
    return v;
}
__device__ __forceinline__ float silu_f(float x) { return x * __builtin_amdgcn_rcpf(1.f + __expf(-x)); }
__device__ __forceinline__ float cos_rev(float r) { return __builtin_amdgcn_cosf(r); }
__device__ __forceinline__ float sin_rev(float r) { return __builtin_amdgcn_sinf(r); }
__device__ __forceinline__ bf16x8 pack8(float a0, float a1, float a2, float a3, float a4, float a5, float a6, float a7) {
    u32x4 w; w.x = pk2(a0, a1); w.y = pk2(a2, a3); w.z = pk2(a4, a5); w.w = pk2(a6, a7); return __builtin_bit_cast(bf16x8, w);
}
#define MFMA16(a, b, c) __builtin_amdgcn_mfma_f32_16x16x32_bf16(a, b, c, 0, 0, 0)

struct EpiP {
    static constexpr bool PERM = true, AFTER_DRAIN = false;
    bf16* O; const float* ba2;
    __device__ __forceinline__ void operator()(const pg8::f32x4 (&acc)[2][2][4][2], const pg8::Unit& u, int wr, int wc, int fr, int fq) const {
        const int row0 = u.pm * 256 + wr * 64 + fr, col0 = u.pn * 256 + wc * 32 + 8 * fq;
        const bool la = (u.pn == 2);
#pragma unroll
        for (int ai = 0; ai < 2; ++ai)
#pragma unroll
            for (int m = 0; m < 4; ++m) { bf16* rowp = O + (size_t)(row0 + ai * 128 + m * 16) * NP + col0;
#pragma unroll
                for (int bj = 0; bj < 2; ++bj) { pg8::f32x4 v0 = acc[ai][bj][m][0], v1 = acc[ai][bj][m][1];
                    if (la) { const float* bp = ba2 + (col0 + bj * 128 - PLA); const f32x4 b0 = *(const f32x4*)bp, b1 = *(const f32x4*)(bp + 4);
#pragma unroll
                        for (int e = 0; e < 4; ++e) { float xa = v0[e] + b0[e], xb = v1[e] + b1[e];
                            v0[e] = (fminf(xa, 0.f) - __logf(1.f + __expf(-fabsf(xa)))) * 0.0625f; v1[e] = (fminf(xb, 0.f) - __logf(1.f + __expf(-fabsf(xb)))) * 0.0625f; } }
                    u32x4 w; w.x = pg8::cvt_pk_bf16(v0[0], v0[1]); w.y = pg8::cvt_pk_bf16(v0[2], v0[3]); w.z = pg8::cvt_pk_bf16(v1[0], v1[1]); w.w = pg8::cvt_pk_bf16(v1[2], v1[3]);
                    *(u32x4*)(rowp + bj * 128) = w; } }
    }
};
template <bool INB, bool OUTB>
struct EpiRes {
    static constexpr bool PERM = false, AFTER_DRAIN = false;
    const void* xin; void* out; const float* modg;
    __device__ __forceinline__ void operator()(const pg8::f32x4 (&acc)[2][2][4][2], const pg8::Unit& u, int wr, int wc, int fr, int fq) const {
        const int w = u.pm >> 5; const int cb = u.pn * 256 + wc * 32 + 4 * fq;
        f32x4 gv[2][2];
#pragma unroll
        for (int bj = 0; bj < 2; ++bj)
#pragma unroll
            for (int n = 0; n < 2; ++n) gv[bj][n] = *(const f32x4*)(modg + w * 6144 + cb + bj * 128 + 16 * n);
        constexpr int RG = INB ? 4 : 2;
#pragma unroll
        for (int ai = 0; ai < 2; ++ai)
#pragma unroll
            for (int mp = 0; mp < 4 / RG; ++mp) {
                u32x2 xb[RG][2][2]; f32x4 xf[INB ? 1 : RG][2][2];
#pragma unroll
                for (int mm = 0; mm < RG; ++mm) { const size_t ro = (size_t)(u.pm * 256 + ai * 128 + wr * 64 + (RG * mp + mm) * 16 + fr) * D + cb;
#pragma unroll
                    for (int bj = 0; bj < 2; ++bj)
#pragma unroll
                        for (int n = 0; n < 2; ++n) {
                            if (INB) xb[mm][bj][n] = *(const u32x2*)((const bf16*)xin + ro + bj * 128 + 16 * n);
                            else xf[INB ? 0 : mm][bj][n] = *(const f32x4*)((const float*)xin + ro + bj * 128 + 16 * n); } }
#pragma unroll
                for (int mm = 0; mm < RG; ++mm) { const int m = RG * mp + mm; const size_t ro = (size_t)(u.pm * 256 + ai * 128 + wr * 64 + m * 16 + fr) * D + cb;
#pragma unroll
                    for (int bj = 0; bj < 2; ++bj)
#pragma unroll
                        for (int n = 0; n < 2; ++n) { const pg8::f32x4 a = acc[ai][bj][m][n]; const f32x4 g4 = gv[bj][n]; f32x4 x;
                            if (INB) { const u32x2 t = xb[mm][bj][n]; x = (f32x4){bflo(t.x), bfhi(t.x), bflo(t.y), bfhi(t.y)}; } else x = xf[INB ? 0 : mm][bj][n];
                            f32x4 y; y[0] = x[0] + g4[0] * a[0]; y[1] = x[1] + g4[1] * a[1]; y[2] = x[2] + g4[2] * a[2]; y[3] = x[3] + g4[3] * a[3];
                            if (OUTB) { u32x2 pk; pk.x = pg8::cvt_pk_bf16(y[0], y[1]); pk.y = pg8::cvt_pk_bf16(y[2], y[3]); *(u32x2*)((bf16*)out + ro + bj * 128 + 16 * n) = pk; }
                            else *(f32x4*)((float*)out + ro + bj * 128 + 16 * n) = y; } }
            }
    }
};
struct EpiFinal {
    static constexpr bool PERM = false, AFTER_DRAIN = true;
    const bf16* xin; float* out; const float* modg; const float* gfin; float* slots; unsigned* cnt;
    __device__ __forceinline__ void fused(pg8::f32x4 (&acc)[2][2][4][2], const pg8::Unit& u, int wr, int wc, int fr, int fq, LAS unsigned char* lds, int wid, int lane) const {
        const int w = u.pm >> 5; const int cb = u.pn * 256 + wc * 32 + 4 * fq;
        LAS float* P = (LAS float*)lds;
        LAS float* S = (LAS float*)(lds + 4096);
        LAS unsigned* flag = (LAS unsigned*)(lds + 8192);
        f32x4 gv[2][2];
#pragma unroll
        for (int bj = 0; bj < 2; ++bj)
#pragma unroll
            for (int n = 0; n < 2; ++n) gv[bj][n] = *(const f32x4*)(modg + w * 6144 + cb + bj * 128 + 16 * n);
#pragma unroll
        for (int ai = 0; ai < 2; ++ai) {
            u32x2 xb[4][2][2];
#pragma unroll
            for (int m = 0; m < 4; ++m) { const size_t ro = (size_t)(u.pm * 256 + ai * 128 + wr * 64 + m * 16 + fr) * D + cb;
#pragma unroll
                for (int bj = 0; bj < 2; ++bj)
#pragma unroll
                    for (int n = 0; n < 2; ++n) xb[m][bj][n] = *(const u32x2*)(xin + ro + bj * 128 + 16 * n); }
#pragma unroll
            for (int m = 0; m < 4; ++m) { float sq = 0.f;
#pragma unroll
                for (int bj = 0; bj < 2; ++bj)
#pragma unroll
                    for (int n = 0; n < 2; ++n) { const u32x2 t = xb[m][bj][n]; const f32x4 g4 = gv[bj][n]; pg8::f32x4 a = acc[ai][bj][m][n];
                        a[0] = bflo(t.x) + g4[0] * a[0]; a[1] = bfhi(t.x) + g4[1] * a[1]; a[2] = bflo(t.y) + g4[2] * a[2]; a[3] = bfhi(t.y) + g4[3] * a[3];
                        acc[ai][bj][m][n] = a; sq += (a[0] * a[0] + a[1] * a[1]) + (a[2] * a[2] + a[3] * a[3]); }
                sq += shfl_f(sq, lane ^ 16); sq += shfl_f(sq, lane ^ 32);
                if (fq == 0) P[(ai * 128 + wr * 64 + m * 16 + fr) * 4 + wc] = sq; }
        }
        asm volatile("s_waitcnt lgkmcnt(0)" ::: "memory"); __builtin_amdgcn_s_barrier(); asm volatile("" ::: "memory");
        const int row = wid * 32 + (lane & 31);
        if (lane < 32) { const float t = (P[row * 4 + 0] + P[row * 4 + 1]) + (P[row * 4 + 2] + P[row * 4 + 3]);
            __hip_atomic_store(slots + ((size_t)(u.pm * 256 + row) * 4 + u.pn), t, __ATOMIC_RELAXED, __HIP_MEMORY_SCOPE_AGENT); }
        asm volatile("s_waitcnt vmcnt(0)" ::: "memory");
        if (lane == 0) (void)__hip_atomic_fetch_add(cnt + 64 * u.pm, 1u, __ATOMIC_RELAXED, __HIP_MEMORY_SCOPE_AGENT);
        if (wid == 0) { unsigned sp = 0;
            while ((unsigned)__builtin_amdgcn_readfirstlane((int)__hip_atomic_load(cnt + 64 * u.pm, __ATOMIC_RELAXED, __HIP_MEMORY_SCOPE_AGENT)) < 32u) { __builtin_amdgcn_s_sleep(2); if (++sp > (1u << 22)) break; }
            __builtin_amdgcn_fence(__ATOMIC_ACQUIRE, "agent");
            if (lane == 0) flag[0] = 1u; }
        asm volatile("s_waitcnt vmcnt(0) lgkmcnt(0)" ::: "memory"); __builtin_amdgcn_s_barrier(); asm volatile("" ::: "memory");
        if (lane < 32) { const float* sl = slots + (size_t)(u.pm * 256 + row) * 4; float t = 0.f;
#pragma unroll
            for (int q = 0; q < 4; ++q) t += __hip_atomic_load(sl + q, __ATOMIC_RELAXED, __HIP_MEMORY_SCOPE_AGENT);
            S[row] = 1.f / sqrtf(t * (1.f / D) + EPS); }
        asm volatile("s_waitcnt vmcnt(0) lgkmcnt(0)" ::: "memory"); __builtin_amdgcn_s_barrier(); asm volatile("" ::: "memory");
        f32x4 gf[2][2];
#pragma unroll
        for (int bj = 0; bj < 2; ++bj)
#pragma unroll
            for (int n = 0; n < 2; ++n) gf[bj][n] = *(const f32x4*)(gfin + cb + bj * 128 + 16 * n);
#pragma unroll
        for (int ai = 0; ai < 2; ++ai)
#pragma unroll
            for (int m = 0; m < 4; ++m) { const int r = ai * 128 + wr * 64 + m * 16 + fr; const float rs = S[r]; float* o = out + (size_t)(u.pm * 256 + r) * D + cb;
#pragma unroll
                for (int bj = 0; bj < 2; ++bj)
#pragma unroll
                    for (int n = 0; n < 2; ++n) { const pg8::f32x4 a = acc[ai][bj][m][n]; const f32x4 g4 = gf[bj][n];
                        *(f32x4*)(o + bj * 128 + 16 * n) = (f32x4){a[0] * rs * g4[0], a[1] * rs * g4[1], a[2] * rs * g4[2], a[3] * rs * g4[3]}; } }
    }
};
struct EpiResNorm {
    static constexpr bool PERM = false, AFTER_DRAIN = true;
    const bf16* xin; bf16* xout; bf16* hout; const float* modg; const float* gn; const float* modn; float* slots; unsigned* cnt;
    __device__ __forceinline__ void fused(pg8::f32x4 (&acc)[2][2][4][2], const pg8::Unit& u, int wr, int wc, int fr, int fq, LAS unsigned char* lds, int wid, int lane) const {
        const int w = u.pm >> 5; const int cb = u.pn * 256 + wc * 32 + 4 * fq;
        LAS float* P = (LAS float*)lds;
        LAS float* S = (LAS float*)(lds + 4096);
        LAS unsigned* flag = (LAS unsigned*)(lds + 8192);
        f32x4 gv[2][2];
#pragma unroll
        for (int bj = 0; bj < 2; ++bj)
#pragma unroll
            for (int n = 0; n < 2; ++n) gv[bj][n] = *(const f32x4*)(modg + w * 6144 + cb + bj * 128 + 16 * n);
#pragma unroll
        for (int ai = 0; ai < 2; ++ai) {
            u32x2 xb[4][2][2];
#pragma unroll
            for (int m = 0; m < 4; ++m) { const size_t ro = (size_t)(u.pm * 256 + ai * 128 + wr * 64 + m * 16 + fr) * D + cb;
#pragma unroll
                for (int bj = 0; bj < 2; ++bj)
#pragma unroll
                    for (int n = 0; n < 2; ++n) xb[m][bj][n] = *(const u32x2*)(xin + ro + bj * 128 + 16 * n); }
#pragma unroll
            for (int m = 0; m < 4; ++m) { float sq = 0.f;
#pragma unroll
                for (int bj = 0; bj < 2; ++bj)
#pragma unroll
                    for (int n = 0; n < 2; ++n) { const u32x2 t = xb[m][bj][n]; const f32x4 g4 = gv[bj][n]; pg8::f32x4 a = acc[ai][bj][m][n];
                        a[0] = bflo(t.x) + g4[0] * a[0]; a[1] = bfhi(t.x) + g4[1] * a[1]; a[2] = bflo(t.y) + g4[2] * a[2]; a[3] = bfhi(t.y) + g4[3] * a[3];
                        acc[ai][bj][m][n] = a; sq += (a[0] * a[0] + a[1] * a[1]) + (a[2] * a[2] + a[3] * a[3]);
                        { u32x2 pk; pk.x = pg8::cvt_pk_bf16(a[0], a[1]); pk.y = pg8::cvt_pk_bf16(a[2], a[3]); *(u32x2*)(xout + (size_t)(u.pm * 256 + ai * 128 + wr * 64 + m * 16 + fr) * D + cb + bj * 128 + 16 * n) = pk; } }
                sq += shfl_f(sq, lane ^ 16); sq += shfl_f(sq, lane ^ 32);
                if (fq == 0) P[(ai * 128 + wr * 64 + m * 16 + fr) * 4 + wc] = sq; }
        }
        asm volatile("s_waitcnt lgkmcnt(0)" ::: "memory"); __builtin_amdgcn_s_barrier(); asm volatile("" ::: "memory");
        const int row = wid * 32 + (lane & 31);
        if (lane < 32) { const float t = (P[row * 4 + 0] + P[row * 4 + 1]) + (P[row * 4 + 2] + P[row * 4 + 3]);
            __hip_atomic_store(slots + ((size_t)(u.pm * 256 + row) * 4 + u.pn), t, __ATOMIC_RELAXED, __HIP_MEMORY_SCOPE_AGENT); }
        asm volatile("s_waitcnt vmcnt(0)" ::: "memory");
        if (lane == 0) (void)__hip_atomic_fetch_add(cnt + 64 * u.pm, 1u, __ATOMIC_RELAXED, __HIP_MEMORY_SCOPE_AGENT);
        if (wid == 0) { unsigned sp = 0;
            while ((unsigned)__builtin_amdgcn_readfirstlane((int)__hip_atomic_load(cnt + 64 * u.pm, __ATOMIC_RELAXED, __HIP_MEMORY_SCOPE_AGENT)) < 32u) { __builtin_amdgcn_s_sleep(2); if (++sp > (1u << 22)) break; }
            __builtin_amdgcn_fence(__ATOMIC_ACQUIRE, "agent");
            if (lane == 0) flag[0] = 1u; }
        asm volatile("s_waitcnt vmcnt(0) lgkmcnt(0)" ::: "memory"); __builtin_amdgcn_s_barrier(); asm volatile("" ::: "memory");
        if (lane < 32) { const float* sl = slots + (size_t)(u.pm * 256 + row) * 4; float t = 0.f;
#pragma unroll
            for (int q = 0; q < 4; ++q) t += __hip_atomic_load(sl + q, __ATOMIC_RELAXED, __HIP_MEMORY_SCOPE_AGENT);
            S[row] = 1.f / sqrtf(t * (1.f / D) + EPS); }
        asm volatile("s_waitcnt vmcnt(0) lgkmcnt(0)" ::: "memory"); __builtin_amdgcn_s_barrier(); asm volatile("" ::: "memory");
        f32x4 gm[2][2], shv[2][2];
#pragma unroll
        for (int bj = 0; bj < 2; ++bj)
#pragma unroll
            for (int n = 0; n < 2; ++n) { const int c = cb + bj * 128 + 16 * n; const f32x4 g4 = *(const f32x4*)(gn + c), s4 = *(const f32x4*)(modn + w * 6144 + 4096 + c);
                shv[bj][n] = *(const f32x4*)(modn + w * 6144 + 3072 + c); gm[bj][n] = (f32x4){g4[0] * (1.f + s4[0]), g4[1] * (1.f + s4[1]), g4[2] * (1.f + s4[2]), g4[3] * (1.f + s4[3])}; }
#pragma unroll
        for (int ai = 0; ai < 2; ++ai)
#pragma unroll
            for (int m = 0; m < 4; ++m) { const int r = ai * 128 + wr * 64 + m * 16 + fr; const float rs = S[r]; bf16* o = hout + (size_t)(u.pm * 256 + r) * D + cb;
#pragma unroll
                for (int bj = 0; bj < 2; ++bj)
#pragma unroll
                    for (int n = 0; n < 2; ++n) { const pg8::f32x4 a = acc[ai][bj][m][n]; const f32x4 g4 = gm[bj][n], h4 = shv[bj][n];
                        u32x2 pk; pk.x = pg8::cvt_pk_bf16(a[0] * rs * g4[0] + h4[0], a[1] * rs * g4[1] + h4[1]); pk.y = pg8::cvt_pk_bf16(a[2] * rs * g4[2] + h4[2], a[3] * rs * g4[3] + h4[3]);
                        *(u32x2*)(o + bj * 128 + 16 * n) = pk; } }
    }
};
struct EpiUp {
    static constexpr bool PERM = true, AFTER_DRAIN = false;
    bf16* ACT; const float* cw; const float* cb;
    __device__ __forceinline__ void operator()(const pg8::f32x4 (&acc)[2][2][4][2], const pg8::Unit& u, int wr, int wc, int fr, int fq) const {
        const int hc0 = u.pn * 128 + wc * 32 + 8 * fq;
#pragma unroll
        for (int ai = 0; ai < 2; ++ai) { const int blk = ai * 2 + wr;
            float res[4][8];
#pragma unroll
            for (int n = 0; n < 2; ++n) {
                const f32x4 w0 = *(const f32x4*)(cw + hc0 + 4 * n), w1 = *(const f32x4*)(cw + DFF + hc0 + 4 * n), w2 = *(const f32x4*)(cw + 2 * DFF + hc0 + 4 * n), bb = *(const f32x4*)(cb + hc0 + 4 * n);
#pragma unroll
                for (int e = 0; e < 4; ++e) {
                    float xs[4], ps[4], ns[4]; const float bprev = 0.f, bnext = 0.f;
#pragma unroll
                    for (int m = 0; m < 4; ++m) { xs[m] = acc[ai][0][m][n][e]; ps[m] = __builtin_bit_cast(float, __builtin_amdgcn_update_dpp(0, __builtin_bit_cast(int, xs[m]), 0x121, 0xf, 0xf, false)); ns[m] = __builtin_bit_cast(float, __builtin_amdgcn_update_dpp(0, __builtin_bit_cast(int, xs[m]), 0x12f, 0xf, 0xf, false)); }
#pragma unroll
                    for (int m = 0; m < 4; ++m) {
                        const float oldp = (m > 0) ? ps[m > 0 ? m - 1 : 0] : bprev, oldn = (m < 3) ? ns[m < 3 ? m + 1 : 3] : bnext;
                        const float prev = __builtin_bit_cast(float, __builtin_amdgcn_update_dpp(__builtin_bit_cast(int, oldp), __builtin_bit_cast(int, xs[m]), 0x111, 0xf, 0xf, false));
                        const float next = __builtin_bit_cast(float, __builtin_amdgcn_update_dpp(__builtin_bit_cast(int, oldn), __builtin_bit_cast(int, xs[m]), 0x101, 0xf, 0xf, false));
                        const float a = w0[e] * prev + w1[e] * xs[m] + w2[e] * next + bb[e];
                        res[m][4 * n + e] = silu_f(a) * acc[ai][1][m][n][e];
                    }
                }
            }
#pragma unroll
            for (int m = 0; m < 4; ++m) { const int r = u.pm * 256 + ai * 128 + wr * 64 + m * 16 + fr;
                u32x4 w; w.x = pg8::cvt_pk_bf16(res[m][0], res[m][1]); w.y = pg8::cvt_pk_bf16(res[m][2], res[m][3]); w.z = pg8::cvt_pk_bf16(res[m][4], res[m][5]); w.w = pg8::cvt_pk_bf16(res[m][6], res[m][7]);
                *(u32x4*)(ACT + (size_t)r * DFF + hc0) = w; }
        }
    }
};
struct EpiUpCtx {
    static constexpr bool PERM = true, AFTER_DRAIN = false;
    bf16* ACT; const float* cw; const float* cb; LAS float* ex;
    __device__ __forceinline__ void operator()(const pg8::f32x4 (&acc)[2][2][4][2], const pg8::Unit& u, int wr, int wc, int fr, int fq) const {
        const int hc0 = u.pn * 128 + wc * 32 + 8 * fq;
            const int colw = wc * 32 + 8 * fq;
#pragma unroll
            for (int ai = 0; ai < 2; ++ai) { const int blk = ai * 2 + wr;
                if (fr == 0) {
#pragma unroll
                    for (int n = 0; n < 2; ++n)
#pragma unroll
                        for (int e = 0; e < 4; ++e) ex[(blk * 2 + 0) * 128 + colw + 4 * n + e] = acc[ai][0][0][n][e]; }
                if (fr == 15) {
#pragma unroll
                    for (int n = 0; n < 2; ++n)
#pragma unroll
                        for (int e = 0; e < 4; ++e) ex[(blk * 2 + 1) * 128 + colw + 4 * n + e] = acc[ai][0][3][n][e]; } }
            asm volatile("s_waitcnt lgkmcnt(0)" ::: "memory"); __builtin_amdgcn_s_barrier(); asm volatile("" ::: "memory");
#pragma unroll
            for (int ai = 0; ai < 2; ++ai) { const int blk = ai * 2 + wr;
                float res[4][8];
    #pragma unroll
                for (int n = 0; n < 2; ++n) {
                    const f32x4 w0 = *(const f32x4*)(cw + hc0 + 4 * n), w1 = *(const f32x4*)(cw + DFF + hc0 + 4 * n), w2 = *(const f32x4*)(cw + 2 * DFF + hc0 + 4 * n), bb = *(const f32x4*)(cb + hc0 + 4 * n);
    #pragma unroll
                    for (int e = 0; e < 4; ++e) {
                        float xs[4], ps[4], ns[4]; float bprev = 0.f, bnext = 0.f; if (blk > 0) bprev = ex[((blk - 1) * 2 + 1) * 128 + colw + 4 * n + e]; if (blk < 3) bnext = ex[((blk + 1) * 2 + 0) * 128 + colw + 4 * n + e];
    #pragma unroll
                        for (int m = 0; m < 4; ++m) { xs[m] = acc[ai][0][m][n][e]; ps[m] = __builtin_bit_cast(float, __builtin_amdgcn_update_dpp(0, __builtin_bit_cast(int, xs[m]), 0x121, 0xf, 0xf, false)); ns[m] = __builtin_bit_cast(float, __builtin_amdgcn_update_dpp(0, __builtin_bit_cast(int, xs[m]), 0x12f, 0xf, 0xf, false)); }
    #pragma unroll
                        for (int m = 0; m < 4; ++m) {
                            const float prev = (fr > 0) ? ps[m] : (m > 0 ? ps[m > 0 ? m - 1 : 0] : bprev);
                            const float next = (fr < 15) ? ns[m] : (m < 3 ? ns[m < 3 ? m + 1 : 3] : bnext);
                            const float a = w0[e] * prev + w1[e] * xs[m] + w2[e] * next + bb[e];
                            res[m][4 * n + e] = silu_f(a) * acc[ai][1][m][n][e];
                        }
                    }
                }
    #pragma unroll
                for (int m = 0; m < 4; ++m) { const int r = u.pm * 256 + ai * 128 + wr * 64 + m * 16 + fr;
                    u32x4 w; w.x = pg8::cvt_pk_bf16(res[m][0], res[m][1]); w.y = pg8::cvt_pk_bf16(res[m][2], res[m][3]); w.z = pg8::cvt_pk_bf16(res[m][4], res[m][5]); w.w = pg8::cvt_pk_bf16(res[m][6], res[m][7]);
                    *(u32x4*)(ACT + (size_t)r * DFF + hc0) = w; }
            }

    }
};
struct CtxOrder {
    int nN, c, c0;
    __device__ void init(int N, int c_, int c0_) { nN = N / 256; c = c_; c0 = c0_; }
    __device__ bool next(int i, pg8::Unit& u) const { const int j = c - c0; if (i > 0 || j < 0 || j >= 2 * nN) return false; u.pm = 64 + (j & 1); u.pn = j >> 1; u.ks = 0; return true; }
    __device__ __forceinline__ void a_ready(const pg8::Unit&) const {}
    __device__ __forceinline__ void done(const pg8::Unit&) const {}
};

struct SplitOrder {
    int nunits, G, c;
    __device__ void init(int nks, int G_, int c_) { nunits = 8 * nks; G = G_; c = c_; }
    __device__ bool next(int i, pg8::Unit& u) const { const int id = i * G + c; if (id >= nunits) return false; u.pm = 64 + (id & 1); u.pn = (id >> 1) & 3; u.ks = id >> 3; return true; }
    __device__ __forceinline__ void a_ready(const pg8::Unit&) const {}
    __device__ __forceinline__ void done(const pg8::Unit&) const {}
};
struct EpiPartial {
    static constexpr bool PERM = false, AFTER_DRAIN = false;
    float* part;
    __device__ __forceinline__ void operator()(const pg8::f32x4 (&acc)[2][2][4][2], const pg8::Unit& u, int wr, int wc, int fr, int fq) const {
#pragma unroll
        for (int ai = 0; ai < 2; ++ai)
#pragma unroll
            for (int m = 0; m < 4; ++m) { const int r = u.pm * 256 + ai * 128 + wr * 64 + m * 16 + fr; float* o = part + ((size_t)u.ks * MC + (size_t)(r - ML)) * D;
#pragma unroll
                for (int bj = 0; bj < 2; ++bj)
#pragma unroll
                    for (int n = 0; n < 2; ++n) { const int c = u.pn * 256 + bj * 128 + wc * 32 + 16 * n + 4 * fq; const pg8::f32x4 a = acc[ai][bj][m][n];
                        *(f32x4*)(o + c) = (f32x4){a[0], a[1], a[2], a[3]}; } }
    }
};
typedef __attribute__((address_space(1))) unsigned gu32;
#define XB_TMO      128
#define XB_XCNT(j)  (256  + 64 * (j))
#define XB_XSUB(j)  (1280 + 64 * (j))
#define XB_XGEN(j)  (2304 + 64 * (j))
#define XB_TOP      3328
#define XB_TOPGEN   3392
#define XCD_BAR_WORDS 3456
#define XB_SPIN_CAP (1u << 18)

__device__ __forceinline__ unsigned xb_ld(unsigned* p)              { return __hip_atomic_load(p, __ATOMIC_RELAXED, __HIP_MEMORY_SCOPE_AGENT); }
__device__ __forceinline__ unsigned xb_add(unsigned* p, unsigned v) { return __hip_atomic_fetch_add(p, v, __ATOMIC_RELAXED, __HIP_MEMORY_SCOPE_AGENT); }
__device__ __forceinline__ unsigned xb_xcc_id() { return (unsigned)__builtin_amdgcn_s_getreg((3 << 11) | 20) & 0xFu; }
#define XB_SPIN(cond, bar) do { unsigned _sp = 0; while (cond) { __builtin_amdgcn_s_sleep(1); \
    if ((++_sp & 255u) == 0u) { if (xb_ld(&(bar)[XB_TMO])) break; if (_sp > XB_SPIN_CAP) { atomicAdd(&(bar)[XB_TMO], 1u); break; } } } } while (0)

struct XcdBarrier {
    unsigned* bar; unsigned x;
    volatile LAS unsigned* st;
};

__device__ __forceinline__ XcdBarrier xcd_barrier_post(unsigned* bar, volatile LAS unsigned* st, int tid_) {
    XcdBarrier b; b.bar = bar; b.x = xb_xcc_id(); b.st = st;
    if (tid_ == 0) (void)xb_add(&bar[XB_XCNT(b.x)], 1u);
    return b;
}
__device__ __forceinline__ void xcd_barrier_complete(unsigned* bar, unsigned x, unsigned& nloc, unsigned& nx) {
    const unsigned G = gridDim.x * gridDim.y * gridDim.z;
    unsigned sum, cnt, mine, sp = 0u;
    for (;;) {
        sum = 0u; cnt = 0u; mine = 0u;
#pragma unroll
        for (unsigned j = 0; j < 16; ++j) { const unsigned c = xb_ld(&bar[XB_XCNT(j)]); sum += c; cnt += (c > 0u) ? 1u : 0u; mine = (j == x) ? c : mine; }
        if (sum == G) break;
        __builtin_amdgcn_s_sleep(1);
        if ((++sp & 255u) == 0u) { if (xb_ld(&bar[XB_TMO])) break; if (sp > XB_SPIN_CAP) { atomicAdd(&bar[XB_TMO], 1u); break; } }
    }
    nloc = mine > 0u ? mine : 1u; nx = cnt > 0u ? cnt : 1u;
}

__device__ __forceinline__ void xcd_barrier(const XcdBarrier& b, int tid_) {
    asm volatile("s_waitcnt vmcnt(0)" ::: "memory");
    __syncthreads();
    if (tid_ == 0) {
        unsigned* bar = b.bar; asm volatile("" : "+s"(bar)); unsigned bx = (unsigned)__builtin_amdgcn_readfirstlane((int)b.x); asm volatile("" : "+s"(bx));
        __builtin_amdgcn_s_waitcnt(0);
        unsigned nloc = b.st[0], nx = b.st[1];
        if (nloc == 0u) { xcd_barrier_complete(bar, bx, nloc, nx); b.st[0] = nloc; b.st[1] = nx; }
        const unsigned old = xb_add(&bar[XB_XSUB(bx)], 1u);
        const unsigned gen = old / nloc;
        if (old + 1u == (gen + 1u) * nloc) {
            __builtin_amdgcn_fence(__ATOMIC_RELEASE, "agent");
            asm volatile("s_waitcnt vmcnt(0)" ::: "memory");
            const unsigned og = xb_add(&bar[XB_TOP], 1u);
            const unsigned tg = og / nx;
            if (og + 1u == (tg + 1u) * nx) xb_add(&bar[XB_TOPGEN], 1u);
            else XB_SPIN(xb_ld(&bar[XB_TOPGEN]) == tg, bar);
            __builtin_amdgcn_fence(__ATOMIC_ACQUIRE, "agent");
            xb_add(&bar[XB_XGEN(bx)], 1u);
            asm volatile("s_waitcnt vmcnt(0)" ::: "memory");
        } else {
            XB_SPIN(xb_ld(&bar[XB_XGEN(bx)]) == gen, bar);
            __builtin_amdgcn_fence(__ATOMIC_ACQUIRE, "agent");
            asm volatile("s_waitcnt vmcnt(0)" ::: "memory");
        }
    }
    __syncthreads();
}
struct Ctx {
    LAS unsigned char* lds; int tid, lane, wave, G, gw, NGW;
    float* MOD; float* MCS; bf16 *F1, *F2, *FC; bf16 *HX, *YMIX, *PB, *ACT, *TB, *CAU; float *XC, *ST, *DEC;
};
__device__ __forceinline__ bf16* win_t(PP p, int l) { return (bf16*)(p->ws + WS_W + (size_t)l * W_LAYER_B); }
__device__ __forceinline__ bf16* wout_t(PP p, int l) { return (bf16*)(p->ws + WS_W + (size_t)l * W_LAYER_B + W_IN_B); }
__device__ __forceinline__ bf16* wup_t(PP p, int l) { return (bf16*)(p->ws + WS_W + (size_t)l * W_LAYER_B + W_IN_B + W_OUT_B); }
__device__ __forceinline__ bf16* wdn_t(PP p, int l) { return (bf16*)(p->ws + WS_W + (size_t)l * W_LAYER_B + W_IN_B + W_OUT_B + W_UP_B); }

__device__ __forceinline__ void transpose_item(const float* W, int K, int N, bf16* WT, int k0, int n0, int dst0, float scale, LAS float* scr, int lane) {
#pragma unroll
    for (int i = 0; i < 32; ++i) { const int kk = 2 * i + (lane >> 5); scr[kk * 33 + (lane & 31)] = W[(size_t)(k0 + kk) * N + n0 + (lane & 31)] * scale; }
    LDS_WAIT(); __builtin_amdgcn_wave_barrier();
    const int c = lane & 7;
#pragma unroll
    for (int j = 0; j < 4; ++j) { const int n = (lane >> 3) + 8 * j; const LAS float* s = scr + (8 * c) * 33 + n;
        u32x4 o; o.x = pk2(s[0 * 33], s[1 * 33]); o.y = pk2(s[2 * 33], s[3 * 33]); o.z = pk2(s[4 * 33], s[5 * 33]); o.w = pk2(s[6 * 33], s[7 * 33]);
        *(u32x4*)(WT + (size_t)(dst0 + n) * K + k0 + 8 * c) = o; }
    LDS_WAIT(); __builtin_amdgcn_wave_barrier();
}

__device__ __forceinline__ void phase0(PP p, Ctx& F) {
    LAS float* sv = (LAS float*)F.lds; LAS float* red = sv + 3072;
    for (int i = F.tid; i < 3072; i += 512) { const int w = i >> 10, k = i & 1023; const float cv = (w < 2) ? p->c[w * 1024 + k] : p->c_ctx[k]; sv[i] = cv / (1.f + expf(-cv)); }
    __syncthreads();
    for (int it = blockIdx.x; it < 192; it += F.G) {
        const int l = it / 96, c0 = (it % 96) * 64; const float* W = p->w_mod + (size_t)l * 1024 * 6144 + c0 + F.lane;
        float a0 = 0.f, a1 = 0.f, a2 = 0.f; const int kb = F.wave * 128;
#pragma unroll 32
        for (int k = 0; k < 128; ++k) { const float wv = W[(size_t)(kb + k) * 6144]; a0 += sv[kb + k] * wv; a1 += sv[1024 + kb + k] * wv; a2 += sv[2048 + kb + k] * wv; }
        red[(F.wave * 3 + 0) * 64 + F.lane] = a0; red[(F.wave * 3 + 1) * 64 + F.lane] = a1; red[(F.wave * 3 + 2) * 64 + F.lane] = a2;
        __syncthreads();
        if (F.tid < 192) { const int w = F.tid >> 6, ln = F.tid & 63; float s = 0.f;
#pragma unroll
            for (int q = 0; q < 8; ++q) s += red[(q * 3 + w) * 64 + ln];
            F.MOD[(l * 3 + w) * 6144 + c0 + ln] = s + p->b_mod[l * 6144 + c0 + ln]; }
        __syncthreads();
    }
    __syncthreads();
    LAS float* scr = (LAS float*)(F.lds + F.wave * 16384);
    constexpr int I_IN = 48 * 16, I_OUT = 32 * 16, I_UP = 176 * 16, I_DN = 32 * 44, I_L = I_IN + I_OUT + I_UP + I_DN;
    for (int it = F.gw; it < 2 * I_L; it += F.NGW) {
        const int l = it / I_L; int r = it % I_L;
        if (r < I_IN) { const int cb = r / 16, kb = r % 16; int src, dst; float sc = 1.f;
            if (cb < 4) { src = 32 * cb; dst = PK + 32 * cb; }
            else if (cb < 8) { src = 416 + 32 * (cb - 4); dst = PQ + 32 * (cb - 4); sc = 0.17677669529663687f; }
            else if (cb < 16) { src = 128 + 32 * (cb - 8); dst = PV + 32 * (cb - 8); }
            else if (cb < 24) { src = 544 + 32 * (cb - 16); dst = PG + 32 * (cb - 16); }
            else if (cb < 32) { src = 1056 + 32 * (cb - 24); dst = PH + 32 * (cb - 24); }
            else if (cb < 40) { src = 1312 + 32 * (cb - 32); dst = PBG + 32 * (cb - 32); }
            else { src = 1568 + 32 * (cb - 40); dst = PCG + 32 * (cb - 40); }
            transpose_item(p->w_in + (size_t)l * D * DIN, D, DIN, win_t(p, l), 64 * kb, src, dst, sc, scr, F.lane); continue; }
        r -= I_IN;
        if (r < I_OUT) { const int cb = r / 16, kb = r % 16; transpose_item(p->w_out + (size_t)l * D * D, D, D, wout_t(p, l), 64 * kb, 32 * cb, 32 * cb, 1.f, scr, F.lane); continue; }
        r -= I_OUT;
        if (r < I_UP) { const int cb = r / 16, kb = r % 16; const int c = 32 * cb, isu = (c >= DFF) ? 1 : 0, j = c - isu * DFF; const int dst = (j / 128) * 256 + isu * 128 + (j % 128);
            transpose_item(p->w_up + (size_t)l * D * NUP, D, NUP, wup_t(p, l), 64 * kb, c, dst, 1.f, scr, F.lane); continue; }
        r -= I_UP;
        { const int cb = r / 44, kb = r % 44; transpose_item(p->w_down + (size_t)l * DFF * D, DFF, D, wdn_t(p, l), 64 * kb, 32 * cb, 32 * cb, 1.f, scr, F.lane); }
    }
    const int gt = blockIdx.x * 512 + F.tid, NT = F.G * 512;
    const int gtm = (F.G == 256) ? ((int)blockIdx.x - 192) * 512 + F.tid : gt; const int NTm = (F.G == 256) ? 32768 : NT;
    for (int i = gtm; i >= 0 && i < 32768; i += NTm) { const int d = i & 63, c = (i >> 6) & 63, g = (i >> 12) & 3, l = i >> 14;
        const float* wf = p->fft_w + (size_t)((l * 4 + g) * 64) * 64 + d; float mc = 0.f, ms = 0.f;
        for (int f = 0; f < 64; ++f) { const float a = (float)((f * c) & 63) * (1.f / 64.f); const float w = wf[f * 64]; mc += cos_rev(a) * w; ms -= sin_rev(a) * w; }
        F.MCS[(((l * 4 + g) * 2 + 0) * 64 + c) * 64 + d] = mc * 0.125f; F.MCS[(((l * 4 + g) * 2 + 1) * 64 + c) * 64 + d] = ms * 0.125f; }
    for (int i = gt; i < MC * D / 4; i += NT) ((f32x4*)F.XC)[i] = ((const f32x4*)p->ctx)[i];
    for (int i = gt; i < 180224; i += NT) {
        if (i < 16384) { const int mm = i >> 7, kk = i & 127, k1 = mm & 63, n1 = kk & 63; const float a = (float)((k1 * n1) & 63) * (1.f / 64.f); const float C = cos_rev(a), S = sin_rev(a);
            const float v = (mm < 64) ? (kk < 64 ? C : S) : (kk < 64 ? -S : C); F.F1[i] = (bf16)f2bf(v); }
        else if (i < 49152) { const int j = i - 16384, k2 = j >> 8, kk = j & 255, n2 = kk & 127; const float a = (float)((k2 * n2) & 127) * (1.f / 128.f);
            const float v = (kk < 128 ? cos_rev(a) : sin_rev(a)) * 0.011048543456039806f; F.F2[j] = (bf16)f2bf(v); }
        else { const int j = i - 49152, k = j >> 9, kk = j & 511, n = kk & 255; const float a = (float)((k * n) & 255) * (1.f / 256.f);
            const float v = (kk < 256 ? cos_rev(a) : sin_rev(a)) * 0.0625f; F.FC[j] = (bf16)f2bf(v); }
    }
}

__device__ __forceinline__ void fold_items(PP p, Ctx& F) {
    for (int it4 = F.gw; it4 < 1792; it4 += F.NGW) {
        const int dq = it4 & 3, it = it4 >> 2;
        const int l = it / 224, r = it % 224, s = r / 16, kb = r % 16; const int k = 64 * kb + F.lane;
        const float* wrow = p->w_in + (size_t)l * D * DIN + (size_t)k * DIN; bf16* WT = win_t(p, l);
        if (s < 2) {
            const f32x4* src = (const f32x4*)(wrow + 384 + 16 * s); f32x4 r4[4];
#pragma unroll
            for (int q = 0; q < 4; ++q) r4[q] = src[q];
            const float* M = p->w_a2 + (size_t)((l * 2 + s) * 16) * 128;
            for (int d = 32 * dq; d < 32 * dq + 32; ++d) { float a = 0.f;
#pragma unroll
                for (int c = 0; c < 16; ++c) a += r4[c >> 2][c & 3] * M[c * 128 + d];
                WT[(size_t)(PLA + s * 128 + d) * D + k] = (bf16)f2bf(a); }
        } else {
            const int kind = (s - 2) >> 2, g = (s - 2) & 3;
            const f32x4* src = (const f32x4*)(wrow + (kind < 2 ? 800 : 1824) + 64 * g); f32x4 r4[16];
#pragma unroll
            for (int q = 0; q < 16; ++q) r4[q] = src[q];
            const float* M = (kind < 2) ? (F.MCS + (size_t)(((l * 4 + g) * 2 + kind) * 64) * 64) : (p->pool_w + (size_t)((l * 4 + g) * 64) * 64);
            const int drow = (kind == 0 ? PFA : (kind == 1 ? PFB : PPOOL)) + 64 * g;
            for (int d = 16 * dq; d < 16 * dq + 16; ++d) { float a = 0.f;
#pragma unroll
                for (int c = 0; c < 64; ++c) a += r4[c >> 2][c & 3] * M[c * 64 + d];
                if (kind == 2) a *= p->pool_scale[l * 256 + g * 64 + d];
                WT[(size_t)(drow + d) * D + k] = (bf16)f2bf(a); }
        }
    }
}

__device__ __forceinline__ void norm_row_bf16(const float* xrow, bf16* orow, const float* g, const float* sc, const float* sh, int lane, const float* part, int nparts, const float* gate, float* xout) {
    f32x4 v[4]; float s = 0.f;
#pragma unroll
    for (int j = 0; j < 4; ++j) v[j] = ((const f32x4*)xrow)[lane + 64 * j];
    if (nparts > 0) {
        f32x4 a[4];
#pragma unroll
        for (int j = 0; j < 4; ++j) a[j] = (f32x4){0.f, 0.f, 0.f, 0.f};
        for (int q = 0; q < nparts; ++q) {
#pragma unroll
            for (int j = 0; j < 4; ++j) { const f32x4 t = ((const f32x4*)(part + (size_t)q * MC * D))[lane + 64 * j]; a[j][0] += t[0]; a[j][1] += t[1]; a[j][2] += t[2]; a[j][3] += t[3]; } }
#pragma unroll
        for (int j = 0; j < 4; ++j) { const f32x4 gv = ((const f32x4*)gate)[lane + 64 * j];
#pragma unroll
            for (int e = 0; e < 4; ++e) v[j][e] += gv[e] * a[j][e];
            ((f32x4*)xout)[lane + 64 * j] = v[j]; }
    }
#pragma unroll
    for (int j = 0; j < 4; ++j) s += (v[j][0] * v[j][0] + v[j][1] * v[j][1]) + (v[j][2] * v[j][2] + v[j][3] * v[j][3]);
    const float rstd = 1.f / sqrtf(wave_sum(s, lane) * (1.f / D) + EPS);
#pragma unroll
    for (int j = 0; j < 4; ++j) { const int idx = lane + 64 * j; const f32x4 gv = ((const f32x4*)g)[idx], scv = ((const f32x4*)sc)[idx], shv = ((const f32x4*)sh)[idx];
        float y[4];
#pragma unroll
        for (int e = 0; e < 4; ++e) y[e] = v[j][e] * rstd * gv[e] * (1.f + scv[e]) + shv[e];
        u32x2 o; o.x = pk2(y[0], y[1]); o.y = pk2(y[2], y[3]); ((u32x2*)orow)[idx] = o; }
}
template <bool FINAL, bool INB>
__device__ __forceinline__ void norm_rows4(const void* xbase, bf16* obase, float* fout, const float* g, const float* modl, int which, int m0, int stride, int lane) {
    f32x4 v[4][4]; float s[4]; int mk[4]; bool ok[4];
#pragma unroll
    for (int k = 0; k < 4; ++k) { const int m = m0 + k * stride; ok[k] = m < ML; mk[k] = ok[k] ? m : ML - 1;
#pragma unroll
        for (int j = 0; j < 4; ++j) {
            if (INB) { const u32x2 t = ((const u32x2*)((const bf16*)xbase + (size_t)mk[k] * D))[lane + 64 * j]; v[k][j] = (f32x4){bflo(t.x), bfhi(t.x), bflo(t.y), bfhi(t.y)}; }
            else v[k][j] = ((const f32x4*)((const float*)xbase + (size_t)mk[k] * D))[lane + 64 * j]; } }
    f32x4 gm[4], sh4[4];
    { const float* mod = FINAL ? g : modl + (m0 >> 13) * 6144 + which * 3072;
#pragma unroll
      for (int j = 0; j < 4; ++j) { const int idx = lane + 64 * j; const f32x4 gv = ((const f32x4*)g)[idx];
          if (FINAL) { gm[j] = gv; sh4[j] = (f32x4){0.f, 0.f, 0.f, 0.f}; }
          else { const f32x4 scv = ((const f32x4*)(mod + 1024))[idx]; sh4[j] = ((const f32x4*)mod)[idx];
#pragma unroll
              for (int e = 0; e < 4; ++e) gm[j][e] = gv[e] * (1.f + scv[e]); } } }
#pragma unroll
    for (int k = 0; k < 4; ++k) { float a = 0.f;
#pragma unroll
        for (int j = 0; j < 4; ++j) a += (v[k][j][0] * v[k][j][0] + v[k][j][1] * v[k][j][1]) + (v[k][j][2] * v[k][j][2] + v[k][j][3] * v[k][j][3]);
        s[k] = a; }
#pragma unroll
    for (int o = 1; o < 64; o <<= 1) {
#pragma unroll
        for (int k = 0; k < 4; ++k) s[k] += shfl_f(s[k], lane ^ o); }
#pragma unroll
    for (int k = 0; k < 4; ++k) { if (!ok[k]) continue;
        const float rstd = 1.f / sqrtf(s[k] * (1.f / D) + EPS);
#pragma unroll
        for (int j = 0; j < 4; ++j) { const int idx = lane + 64 * j;
            if (FINAL) { f32x4 y;
#pragma unroll
                for (int e = 0; e < 4; ++e) y[e] = v[k][j][e] * rstd * gm[j][e];
                ((f32x4*)(fout + (size_t)mk[k] * D))[idx] = y; }
            else { float y[4];
#pragma unroll
                for (int e = 0; e < 4; ++e) y[e] = v[k][j][e] * rstd * gm[j][e] + sh4[j][e];
                u32x2 o; o.x = pk2(y[0], y[1]); o.y = pk2(y[2], y[3]); ((u32x2*)(obase + (size_t)mk[k] * D))[idx] = o; } }
    }
}
__device__ __forceinline__ void norm_phase(PP p, Ctx& F, int l, int which, int mrows) {
    const float* g = (which == 0 ? p->norm1_g : p->norm2_g) + l * D;
    const float* PART = (const float*)(p->ws + WS_PART);
    if (l == 0 && which == 0) { for (int m0 = F.gw; m0 < ML; m0 += 4 * F.NGW) norm_rows4<false, false>(p->x, F.HX, nullptr, g, F.MOD + l * 3 * 6144, which, m0, F.NGW, F.lane); }
    else { const void* xb = (l == 1 && which == 1 && F.G == 256) ? (const void*)(p->ws + WS_XB2) : (const void*)p->out;
        for (int m0 = F.gw; m0 < ML; m0 += 4 * F.NGW) norm_rows4<false, true>(xb, F.HX, nullptr, g, F.MOD + l * 3 * 6144, which, m0, F.NGW, F.lane); }
    for (int m = ML + F.gw; m < mrows; m += F.NGW) {
        int nparts = 0; const float* gate = nullptr;
        const float* xr = ((l == 0 && which == 0) ? p->ctx : F.XC) + (size_t)(m - ML) * D;
        if (l == 0 && which == 1) { nparts = 4; gate = F.MOD + 2 * 6144 + 2048; }
        if (l == 1 && which == 0) { nparts = 11; gate = F.MOD + 2 * 6144 + 5120; }
        const float* part = PART + (size_t)(m - ML) * D; float* xout = F.XC + (size_t)(m - ML) * D;
        const float* mod = F.MOD + (l * 3 + 2) * 6144 + which * 3072;
        norm_row_bf16(xr, F.HX + (size_t)m * D, g, mod + 1024, mod, F.lane, part, nparts, gate, xout);
    }
}
__device__ __forceinline__ void final_norm(PP p, Ctx& F) {
    for (int m0 = F.gw; m0 < ML; m0 += 4 * F.NGW) norm_rows4<true, false>(p->ws + WS_HX  , nullptr, p->out, p->final_g, nullptr, 0, m0, F.NGW, F.lane);
}
constexpr int CP = 260;
__device__ __forceinline__ int chunk_row0(int b, int cidx) { return (cidx < 4) ? (ML + b * CTXL + cidx * 64) : (b * SEQ + (cidx - 4) * 64); }
__device__ __forceinline__ void cum_to_lds(LAS float* cum, const bf16* PB, int row0, int tid) {
    { const int oct = tid & 31, j0 = tid >> 5; u32x4 w[4];
#pragma unroll
      for (int q = 0; q < 4; ++q) w[q] = *(const u32x4*)(PB + (size_t)(row0 + j0 + 16 * q) * NP + PLA + 8 * oct);
#pragma unroll
      for (int q = 0; q < 4; ++q) { LAS float* d = cum + (j0 + 16 * q) * CP + 8 * oct;
          *(LAS f32x4*)d = (f32x4){bflo(w[q].x), bfhi(w[q].x), bflo(w[q].y), bfhi(w[q].y)}; *(LAS f32x4*)(d + 4) = (f32x4){bflo(w[q].z), bfhi(w[q].z), bflo(w[q].w), bfhi(w[q].w)}; } }
    __syncthreads();
    if (tid < 256) { float s = 0.f;
        if (tid < 128) {
#pragma unroll 16
            for (int j = 0; j < 64; ++j) { s += cum[j * CP + tid]; cum[j * CP + tid] = s; }
        } else {
#pragma unroll 16
            for (int j = 63; j >= 0; --j) { s += cum[j * CP + tid]; cum[j * CP + tid] = s; }
        } }
    __syncthreads();
}
typedef float f32x2_t __attribute__((ext_vector_type(2)));
typedef __bf16 bf16x2_t __attribute__((ext_vector_type(2)));
__device__ __forceinline__ unsigned pkh(float lo, float hi) { f32x2_t v = {lo, hi}; bf16x2_t b = __builtin_convertvector(v, bf16x2_t); return __builtin_bit_cast(unsigned, b); }
__device__ __forceinline__ bf16x8 pack8h(float a0, float a1, float a2, float a3, float a4, float a5, float a6, float a7) {
    u32x4 w; w.x = pkh(a0, a1); w.y = pkh(a2, a3); w.z = pkh(a4, a5); w.w = pkh(a6, a7); return __builtin_bit_cast(bf16x8, w);
}
__device__ __forceinline__ void la_load(u32x4 (&w)[4], const bf16* PB, int row0, int tid) {
    const int oct = tid & 31, j0 = tid >> 5;
#pragma unroll
    for (int q = 0; q < 4; ++q) w[q] = *(const u32x4*)(PB + (size_t)(row0 + j0 + 16 * q) * NP + PLA + 8 * oct);
}
__device__ __forceinline__ void la_scan(LAS float* cum, const u32x4 (&w)[4], int tid) {
    const int oct = tid & 31, j0 = tid >> 5;
#pragma unroll
    for (int q = 0; q < 4; ++q) { LAS float* d = cum + (j0 + 16 * q) * CP + 8 * oct;
        *(LAS f32x4*)d = (f32x4){bflo(w[q].x), bfhi(w[q].x), bflo(w[q].y), bfhi(w[q].y)}; *(LAS f32x4*)(d + 4) = (f32x4){bflo(w[q].z), bfhi(w[q].z), bflo(w[q].w), bfhi(w[q].w)}; }
    __syncthreads();
    if (tid < 256) { float carry = 0.f;
        if (tid < 128) {
#pragma unroll
            for (int hf = 0; hf < 4; ++hf) { float v[16];
#pragma unroll
                for (int j = 0; j < 16; ++j) v[j] = cum[(16 * hf + j) * CP + tid];
                v[0] += carry;
#pragma unroll
                for (int j = 1; j < 16; ++j) v[j] += v[j - 1];
                carry = v[15];
#pragma unroll
                for (int j = 0; j < 16; ++j) cum[(16 * hf + j) * CP + tid] = v[j]; }
        } else {
#pragma unroll
            for (int hf = 3; hf >= 0; --hf) { float v[16];
#pragma unroll
                for (int j = 0; j < 16; ++j) v[j] = cum[(16 * hf + j) * CP + tid];
                v[15] += carry;
#pragma unroll
                for (int j = 14; j >= 0; --j) v[j] += v[j + 1];
                carry = v[0];
#pragma unroll
                for (int j = 0; j < 16; ++j) cum[(16 * hf + j) * CP + tid] = v[j]; }
        } }
    __syncthreads();
}
__device__ __forceinline__ void gla_a_item(Ctx& F, int b, int cidx) {
    LAS float* cum = (LAS float*)F.lds; const int row0 = chunk_row0(b, cidx);
    const int h = F.wave & 3, dir = F.wave >> 2, chb = dir * 128 + h * 32, lr = F.lane & 15, g = F.lane >> 4;
    const int jl = dir ? 0 : 63;
    u32x4 wla[4]; la_load(wla, F.PB, row0, F.tid);
    unsigned short kt[2][2][8], vt[2][4][8];
#pragma unroll
    for (int ks = 0; ks < 2; ++ks) { const int j0 = 32 * ks + 8 * g;
#pragma unroll
        for (int mb = 0; mb < 2; ++mb)
#pragma unroll
            for (int e = 0; e < 8; ++e) kt[ks][mb][e] = F.PB[(size_t)(row0 + j0 + e) * NP + PK + h * 32 + 16 * mb + lr];
#pragma unroll
        for (int nb = 0; nb < 4; ++nb)
#pragma unroll
            for (int e = 0; e < 8; ++e) vt[ks][nb][e] = F.PB[(size_t)(row0 + j0 + e) * NP + PV + h * 64 + 16 * nb + lr]; }
    la_scan(cum, wla, F.tid);
    f32x4 acc[2][4];
#pragma unroll
    for (int mb = 0; mb < 2; ++mb)
#pragma unroll
        for (int nb = 0; nb < 4; ++nb) acc[mb][nb] = (f32x4){0.f, 0.f, 0.f, 0.f};
#pragma unroll
    for (int ks = 0; ks < 2; ++ks) {
        bf16x8 af[2], bfr[4]; const int j0 = 32 * ks + 8 * g;
#pragma unroll
        for (int mb = 0; mb < 2; ++mb) { const int dk = 16 * mb + lr; const float last = cum[jl * CP + chb + dk]; float a[8];
#pragma unroll
            for (int e = 0; e < 8; ++e) { const int j = j0 + e; a[e] = bf2f(kt[ks][mb][e]) * __expf(last - cum[j * CP + chb + dk]); }
            af[mb] = pack8h(a[0], a[1], a[2], a[3], a[4], a[5], a[6], a[7]); }
#pragma unroll
        for (int nb = 0; nb < 4; ++nb) { const unsigned short* t = vt[ks][nb];
            u32x4 w; w.x = t[0] | ((unsigned)t[1] << 16); w.y = t[2] | ((unsigned)t[3] << 16); w.z = t[4] | ((unsigned)t[5] << 16); w.w = t[6] | ((unsigned)t[7] << 16);
            bfr[nb] = __builtin_bit_cast(bf16x8, w); }
#pragma unroll
        for (int mb = 0; mb < 2; ++mb)
#pragma unroll
            for (int nb = 0; nb < 4; ++nb) acc[mb][nb] = MFMA16(af[mb], bfr[nb], acc[mb][nb]);
    }
    const size_t sidx = (size_t)(((b * 2 + dir) * 4 + h) * NCH + cidx);
    float* st = F.ST + sidx * 2048;
#pragma unroll
    for (int mb = 0; mb < 2; ++mb)
#pragma unroll
        for (int nb = 0; nb < 4; ++nb) *(f32x4*)(st + (16 * nb + lr) * 32 + 16 * mb + 4 * g) = acc[mb][nb];
    if (F.lane < 32) F.DEC[sidx * 32 + F.lane] = __expf(cum[jl * CP + chb + F.lane]);
    __syncthreads();
}
__device__ __forceinline__ void gla_scan(Ctx& F) {
    LAS float* xa = (LAS float*)F.lds; LAS float* xb = xa + 512;
    const int seg = F.tid >> 6, el = F.tid & 63;
    for (int blk = blockIdx.x; blk < 512; blk += F.G) {
        const int ge = blk * 64 + el, e = ge & 2047, seq = ge >> 11, dir = (seq >> 2) & 1, dk = e & 31;
        float* st = F.ST + (size_t)seq * NCH * 2048 + e; const float* dc = F.DEC + (size_t)seq * NCH * 32 + dk;
        float u[17], d[17];
#pragma unroll
        for (int i = 0; i < 17; ++i) { const int s = seg * 17 + i; const bool ok = s < NCH; const int sc = ok ? s : NCH - 1; const int c = dir ? (sc < 4 ? 3 - sc : 135 - sc) : sc;
            const float uu = st[(size_t)c * 2048], dd = dc[c * 32]; u[i] = ok ? uu : 0.f; d[i] = ok ? dd : 1.f; }
        float A = 1.f, B = 0.f;
#pragma unroll
        for (int i = 0; i < 17; ++i) { B = B * d[i] + u[i]; A *= d[i]; }
        xa[F.tid] = A; xb[F.tid] = B;
        __syncthreads();
        float S = 0.f;
        for (int sg = 0; sg < seg; ++sg) S = S * xa[sg * 64 + el] + xb[sg * 64 + el];
#pragma unroll
        for (int i = 0; i < 17; ++i) { const int s = seg * 17 + i; if (s < NCH) { const int c = dir ? (s < 4 ? 3 - s : 135 - s) : s; st[(size_t)c * 2048] = S; } S = S * d[i] + u[i]; }
        __syncthreads();
    }
}
template <int NI>
__device__ __forceinline__ void gla_c_item(PP p, Ctx& F, int l, int b, int cidx, int sub) {
    LAS float* cum = (LAS float*)F.lds; const int row0 = chunk_row0(b, cidx);
    const int h = F.wave & 3, half = (NI == 2) ? (F.wave >> 2) : sub, ibase = (NI == 2) ? 0 : (F.wave >> 2), lr = F.lane & 15, g = F.lane >> 4;
    u32x4 wla[4]; la_load(wla, F.PB, row0, F.tid);
    f32x4 o[4][2];
#pragma unroll
    for (int mb = 0; mb < 4; ++mb) { o[mb][0] = (f32x4){0.f, 0.f, 0.f, 0.f}; o[mb][1] = (f32x4){0.f, 0.f, 0.f, 0.f}; }
    bf16x8 av[4][2];
#pragma unroll
    for (int mb = 0; mb < 4; ++mb)
#pragma unroll
        for (int pp = 0; pp < 2; ++pp) { unsigned short t[8];
#pragma unroll
            for (int e = 0; e < 8; ++e) { const int j = 32 * pp + (e < 4 ? 4 * g + e : 16 + 4 * g + (e - 4)); t[e] = F.PB[(size_t)(row0 + j) * NP + PV + h * 64 + 16 * mb + lr]; }
            u32x4 w; w.x = t[0] | ((unsigned)t[1] << 16); w.y = t[2] | ((unsigned)t[3] << 16); w.z = t[4] | ((unsigned)t[5] << 16); w.w = t[6] | ((unsigned)t[7] << 16);
            av[mb][pp] = __builtin_bit_cast(bf16x8, w); }
    u32x4 qraw[2], kraw[4]; f32x4 sraw[2][4][2];
#pragma unroll
    for (int ibl = 0; ibl < NI; ++ibl) qraw[ibl] = *(const u32x4*)(F.PB + (size_t)(row0 + 16 * (2 * half + ibase + ibl) + lr) * NP + PQ + h * 32 + 8 * g);
#pragma unroll
    for (int jb = 0; jb < 4; ++jb) kraw[jb] = *(const u32x4*)(F.PB + (size_t)(row0 + 16 * jb + lr) * NP + PK + h * 32 + 8 * g);
    { const float* st = F.ST + (size_t)(((b * 2 + 0) * 4 + h) * NCH + cidx) * 2048;
#pragma unroll
        for (int mb = 0; mb < 4; ++mb) { sraw[0][mb][0] = *(const f32x4*)(st + (16 * mb + lr) * 32 + 8 * g); sraw[0][mb][1] = *(const f32x4*)(st + (16 * mb + lr) * 32 + 8 * g + 4); } }
    la_scan(cum, wla, F.tid);
    { const float* st = F.ST + (size_t)(((b * 2 + 1) * 4 + h) * NCH + cidx) * 2048;
#pragma unroll
        for (int mb = 0; mb < 4; ++mb) { sraw[1][mb][0] = *(const f32x4*)(st + (16 * mb + lr) * 32 + 8 * g); sraw[1][mb][1] = *(const f32x4*)(st + (16 * mb + lr) * 32 + 8 * g + 4); } }
#pragma unroll
    for (int dir = 0; dir < 2; ++dir) {
        const int chb = dir * 128 + h * 32;
        bf16x8 bq[2];
#pragma unroll
        for (int ibl = 0; ibl < NI; ++ibl) { const int i = 16 * (2 * half + ibase + ibl) + lr;
            const u32x4 qw = qraw[ibl];
            const f32x4 c0 = *(const LAS f32x4*)(cum + i * CP + chb + 8 * g), c1 = *(const LAS f32x4*)(cum + i * CP + chb + 8 * g + 4);
            bq[ibl] = pack8h(bflo(qw.x) * __expf(c0[0]), bfhi(qw.x) * __expf(c0[1]), bflo(qw.y) * __expf(c0[2]), bfhi(qw.y) * __expf(c0[3]),
                            bflo(qw.z) * __expf(c1[0]), bfhi(qw.z) * __expf(c1[1]), bflo(qw.w) * __expf(c1[2]), bfhi(qw.w) * __expf(c1[3])); }
#pragma unroll
        for (int mb = 0; mb < 4; ++mb) { const f32x4 s0 = sraw[dir][mb][0], s1 = sraw[dir][mb][1];
            const bf16x8 as = pack8h(s0[0], s0[1], s0[2], s0[3], s1[0], s1[1], s1[2], s1[3]);
            o[mb][0] = MFMA16(as, bq[0], o[mb][0]); if (NI == 2) o[mb][1] = MFMA16(as, bq[1], o[mb][1]); }
#pragma unroll
        for (int pp = 0; pp < 2; ++pp) {
            if ((dir == 0 && half == 0 && pp == 1) || (dir == 1 && half == 1 && pp == 0)) continue;
            f32x4 sc[2][2];
#pragma unroll
            for (int q = 0; q < 2; ++q) { const int jb = 2 * pp + q, j = 16 * jb + lr;
                const u32x4 kw = kraw[jb];
                const f32x4 c0 = *(const LAS f32x4*)(cum + j * CP + chb + 8 * g), c1 = *(const LAS f32x4*)(cum + j * CP + chb + 8 * g + 4);
                const bf16x8 ak = pack8h(bflo(kw.x) * __expf(-c0[0]), bfhi(kw.x) * __expf(-c0[1]), bflo(kw.y) * __expf(-c0[2]), bfhi(kw.y) * __expf(-c0[3]),
                                        bflo(kw.z) * __expf(-c1[0]), bfhi(kw.z) * __expf(-c1[1]), bflo(kw.w) * __expf(-c1[2]), bfhi(kw.w) * __expf(-c1[3]));
#pragma unroll
                for (int ibl = 0; ibl < NI; ++ibl) { f32x4 z = (f32x4){0.f, 0.f, 0.f, 0.f}; z = MFMA16(ak, bq[ibl], z);
                    const int i = 16 * (2 * half + ibase + ibl) + lr;
#pragma unroll
                    for (int r = 0; r < 4; ++r) { const int jj = 16 * jb + 4 * g + r; const bool keep = dir ? (jj >= i) : (jj <= i); z[r] = keep ? z[r] : 0.f; }
                    sc[q][ibl] = z; } }
#pragma unroll
            for (int ibl = 0; ibl < NI; ++ibl) { const bf16x8 pb = pack8h(sc[0][ibl][0], sc[0][ibl][1], sc[0][ibl][2], sc[0][ibl][3], sc[1][ibl][0], sc[1][ibl][1], sc[1][ibl][2], sc[1][ibl][3]);
#pragma unroll
                for (int mb = 0; mb < 4; ++mb) o[mb][ibl] = MFMA16(av[mb][pp], pb, o[mb][ibl]); }
        }
    }
    const float* gg = p->gla_g + l * 64;
#pragma unroll
    for (int ibl = 0; ibl < NI; ++ibl) { float ss = 0.f;
#pragma unroll
        for (int mb = 0; mb < 4; ++mb) ss += (o[mb][ibl][0] * o[mb][ibl][0] + o[mb][ibl][1] * o[mb][ibl][1]) + (o[mb][ibl][2] * o[mb][ibl][2] + o[mb][ibl][3] * o[mb][ibl][3]);
        ss += shfl_f(ss, F.lane ^ 16); ss += shfl_f(ss, F.lane ^ 32);
        const float rstd = 1.f / sqrtf(ss * (1.f / 64.f) + EPS);
        const int i = 16 * (2 * half + ibase + ibl) + lr; const size_t row = (size_t)(row0 + i);
#pragma unroll
        for (int mb = 0; mb < 4; ++mb) { const int dv = 16 * mb + 4 * g; const f32x4 gv = *(const f32x4*)(gg + dv);
            const u32x2 gw = *(const u32x2*)(F.PB + row * NP + PG + h * 64 + dv);
            const float y0 = o[mb][ibl][0] * rstd * gv[0] * silu_f(bflo(gw.x)), y1 = o[mb][ibl][1] * rstd * gv[1] * silu_f(bfhi(gw.x));
            const float y2 = o[mb][ibl][2] * rstd * gv[2] * silu_f(bflo(gw.y)), y3 = o[mb][ibl][3] * rstd * gv[3] * silu_f(bfhi(gw.y));
            u32x2 w; w.x = pk2(y0, y1); w.y = pk2(y2, y3); *(u32x2*)(F.YMIX + row * D + h * 64 + dv) = w; }
    }
    __syncthreads();
}

template <int NKS, int GRP>
__device__ __forceinline__ void dft_mma_lds(f32x4 (&acc)[8], const LAS unsigned char* fl, int pitchB, const bf16* re, const bf16* im, size_t rstride, int khalf, int lane) {
    const int lr = lane & 15, g = lane >> 4;
#pragma unroll
    for (int k0 = 0; k0 < NKS; k0 += GRP) {
        bf16x8 bfrag[GRP];
#pragma unroll
        for (int kq = 0; kq < GRP; ++kq) { const int ks = k0 + kq; const int kk0 = 32 * ks + 8 * g; const bool part = kk0 >= khalf; const int idx = part ? kk0 - khalf : kk0;
            const bf16* src = (part ? im : re) + (size_t)idx * rstride + lr; unsigned short t[8];
#pragma unroll
            for (int e = 0; e < 8; ++e) t[e] = src[(size_t)e * rstride];
            u32x4 w; w.x = t[0] | ((unsigned)t[1] << 16); w.y = t[2] | ((unsigned)t[3] << 16); w.z = t[4] | ((unsigned)t[5] << 16); w.w = t[6] | ((unsigned)t[7] << 16);
            bfrag[kq] = __builtin_bit_cast(bf16x8, w); }
#pragma unroll
        for (int kq = 0; kq < GRP; ++kq) { const int ks = k0 + kq;
#pragma unroll
            for (int mb = 0; mb < 8; ++mb) { const bf16x8 a = *(const LAS bf16x8*)(fl + (16 * mb + lr) * pitchB + (32 * ks + 8 * g) * 2); acc[mb] = MFMA16(a, bfrag[kq], acc[mb]); }
        }
    }
}
__device__ __forceinline__ void f_to_lds(LAS unsigned char* fl, const bf16* Fm, int rows, int rowB, int tid) {
    const int cpr = rowB >> 4, n = rows * cpr;
    for (int i = tid; i < n; i += 512) { const int r = i / cpr, c = i - r * cpr; *(LAS u32x4*)(fl + r * (rowB + 16) + c * 16) = *(const u32x4*)((const unsigned char*)Fm + (size_t)r * rowB + c * 16); }
    __syncthreads();
}
template <int NKS, int GRP = 4, int NMB = 8>
__device__ __forceinline__ void dft_mma(f32x4 (&acc)[NMB], const bf16* Fm, int ldF, int mrow0, const bf16* re, const bf16* im, size_t rstride, int khalf, int lane) {
    const int lr = lane & 15, g = lane >> 4;
#pragma unroll
    for (int k0 = 0; k0 < NKS; k0 += GRP) {
        bf16x8 bfrag[GRP];
#pragma unroll
        for (int kq = 0; kq < GRP; ++kq) { const int ks = k0 + kq; const int kk0 = 32 * ks + 8 * g; const bool part = kk0 >= khalf; const int idx = part ? kk0 - khalf : kk0;
            const bf16* src = (part ? im : re) + (size_t)idx * rstride + lr; unsigned short t[8];
#pragma unroll
            for (int e = 0; e < 8; ++e) t[e] = src[(size_t)e * rstride];
            u32x4 w; w.x = t[0] | ((unsigned)t[1] << 16); w.y = t[2] | ((unsigned)t[3] << 16); w.z = t[4] | ((unsigned)t[5] << 16); w.w = t[6] | ((unsigned)t[7] << 16);
            bfrag[kq] = __builtin_bit_cast(bf16x8, w); }
#pragma unroll
        for (int kq = 0; kq < GRP; ++kq) { const int ks = k0 + kq;
            bf16x8 a[NMB];
#pragma unroll
            for (int mb = 0; mb < NMB; ++mb) a[mb] = *(const bf16x8*)(Fm + (size_t)(mrow0 + 16 * mb + lr) * ldF + 32 * ks + 8 * g);
#pragma unroll
            for (int mb = 0; mb < NMB; ++mb) acc[mb] = MFMA16(a[mb], bfrag[kq], acc[mb]);
            if (kq & 1) __builtin_amdgcn_sched_barrier(0);
        }
    }
}
__device__ __forceinline__ void dft_mma_loop(f32x4 (&acc)[8], const bf16* Fm, int ldF, int mrow0, int nks, const bf16* re, const bf16* im, size_t rstride, int khalf, int lane) {
    const int lr = lane & 15, g = lane >> 4;
#pragma unroll 1
    for (int ks = 0; ks < nks; ++ks) { const int kk0 = 32 * ks + 8 * g; const bool part = kk0 >= khalf; const int idx = part ? kk0 - khalf : kk0;
        const bf16* src = (part ? im : re) + (size_t)idx * rstride + lr; unsigned short t[8];
#pragma unroll
        for (int e = 0; e < 8; ++e) t[e] = src[(size_t)e * rstride];
        u32x4 w; w.x = t[0] | ((unsigned)t[1] << 16); w.y = t[2] | ((unsigned)t[3] << 16); w.z = t[4] | ((unsigned)t[5] << 16); w.w = t[6] | ((unsigned)t[7] << 16);
        const bf16x8 bfrag = __builtin_bit_cast(bf16x8, w);
#pragma unroll
        for (int mb = 0; mb < 8; ++mb) { const bf16x8 a = *(const bf16x8*)(Fm + (size_t)(mrow0 + 16 * mb + lr) * ldF + 32 * ks + 8 * g); acc[mb] = MFMA16(a, bfrag, acc[mb]); }
    }
}
__device__ __forceinline__ void fft_stage1(Ctx& F) {
    const int lr = F.lane & 15, g = F.lane >> 4;
    f_to_lds(F.lds, F.F1, 128, 256, F.tid);
    for (int it = F.gw; it < 4096; it += F.NGW) { const int cb = it & 15, n2 = (it >> 4) & 127, b = it >> 11;
        f32x4 acc[8];
#pragma unroll
        for (int mb = 0; mb < 8; ++mb) acc[mb] = (f32x4){0.f, 0.f, 0.f, 0.f};
        const bf16* re = F.PB + (size_t)(b * SEQ + n2) * NP + PFA + 16 * cb;
        dft_mma_lds<4, 4>(acc, F.lds, 272, re, re + 256, (size_t)128 * NP, 64, F.lane);
#pragma unroll
        for (int mb = 0; mb < 4; ++mb)
#pragma unroll
            for (int r = 0; r < 4; ++r) { const int k1 = 16 * mb + 4 * g + r; const float a = (float)(k1 * n2) * (1.f / 8192.f); const float c = cos_rev(a), s = sin_rev(a);
                const float tr = acc[mb][r], ti = acc[mb + 4][r]; const float xr = tr * c + ti * s, xi = ti * c - tr * s;
                bf16* dst = F.TB + ((size_t)((b * 64 + k1) * 2) * 128 + n2) * 256 + 16 * cb + lr;
                dst[0] = (bf16)f2bf(xr); dst[(size_t)128 * 256] = (bf16)f2bf(xi); }
    }
}
__device__ __forceinline__ void fft_stage2(Ctx& F, int l) {
    const int lr = F.lane & 15, g = F.lane >> 4;
    f_to_lds(F.lds, F.F2, 128, 512, F.tid);
    for (int it = F.gw; it < 2048; it += F.NGW) {
        f32x4 acc[8];
#pragma unroll
        for (int mb = 0; mb < 8; ++mb) acc[mb] = (f32x4){0.f, 0.f, 0.f, 0.f};
        const int cb = it & 15, k1 = (it >> 4) & 63, b = it >> 10;
        const bf16* re = F.TB + (size_t)((b * 64 + k1) * 2) * 128 * 256 + 16 * cb;
        dft_mma_lds<8, 4>(acc, F.lds, 528, re, re + (size_t)128 * 256, 256, 128, F.lane);
#pragma unroll
        for (int mb = 0; mb < 8; ++mb)
#pragma unroll
            for (int r = 0; r < 4; ++r) { const int k2 = 16 * mb + 4 * g + r; F.YMIX[(size_t)(b * SEQ + k1 + 64 * k2) * D + 256 + 16 * cb + lr] = (bf16)f2bf(acc[mb][r]); }
    }
    __syncthreads();
}
__device__ __forceinline__ void ctx_dft(Ctx& F, int w0, int nw) {
    const int lr = F.lane & 15, g = F.lane >> 4;
    for (int it = w0; it >= 0 && it < 256; it += nw) { const int mq = it & 7, cb = (it >> 3) & 15, b = it >> 7;
            f32x4 acc[2] = {(f32x4){0.f, 0.f, 0.f, 0.f}, (f32x4){0.f, 0.f, 0.f, 0.f}};
            const bf16* re = F.PB + (size_t)(ML + b * CTXL) * NP + PFA + 16 * cb;
            dft_mma<8, 4, 2>(acc, F.FC, 512, 32 * mq, re, re, (size_t)NP, 256, F.lane); __builtin_amdgcn_sched_barrier(0);
            dft_mma<8, 4, 2>(acc, F.FC + 256, 512, 32 * mq, re + 256, re + 256, (size_t)NP, 256, F.lane);
#pragma unroll
            for (int mb = 0; mb < 2; ++mb)
#pragma unroll
                for (int r = 0; r < 4; ++r) { const int k = 32 * mq + 16 * mb + 4 * g + r; F.YMIX[(size_t)(ML + b * CTXL + k) * D + 256 + 16 * cb + lr] = (bf16)f2bf(acc[mb][r]); }
        }
}
__device__ __forceinline__ void load8(const bf16* q, float (&v)[8]) { const u32x4 w = *(const u32x4*)q; v[0] = bflo(w.x); v[1] = bfhi(w.x); v[2] = bflo(w.y); v[3] = bfhi(w.y); v[4] = bflo(w.z); v[5] = bfhi(w.z); v[6] = bflo(w.w); v[7] = bfhi(w.w); }
__device__ __forceinline__ void store8(bf16* q, const float (&v)[8]) { u32x4 w; w.x = pk2(v[0], v[1]); w.y = pk2(v[2], v[3]); w.z = pk2(v[4], v[5]); w.w = pk2(v[6], v[7]); *(u32x4*)q = w; }
__device__ __forceinline__ u32x4 ldrow(const bf16* base, int rbase, int t, int n, int col) { const int tc = t < 0 ? 0 : (t > n - 1 ? n - 1 : t); return *(const u32x4*)(base + (size_t)(rbase + tc) * NP + col); }
__device__ __forceinline__ void unpack8(const u32x4 w, float (&v)[8]) { v[0] = bflo(w.x); v[1] = bfhi(w.x); v[2] = bflo(w.y); v[3] = bfhi(w.y); v[4] = bflo(w.z); v[5] = bfhi(w.z); v[6] = bflo(w.w); v[7] = bfhi(w.w); }
__device__ __forceinline__ void convpool_item(PP p, Ctx& F, int l, int it) {
    int rbase, n, t0;
    if (it < 256) { rbase = it * 64; n = 64; t0 = 0; } else { const int sg = it - 256; rbase = ML + (sg >> 2) * CTXL; n = CTXL; t0 = (sg & 3) * 64; }
    const int oct = F.tid & 31, tl = F.tid >> 5, c0 = 8 * oct, tb = t0 + tl * 4;
    {
        u32x4 hw_[6], cw_[6], bw_[4];
#pragma unroll
        for (int i = 0; i < 6; ++i) { hw_[i] = ldrow(F.PB, rbase, tb - 1 + i, n, PH + c0); cw_[i] = ldrow(F.PB, rbase, tb - 1 + i, n, PCG + c0); }
#pragma unroll
        for (int q = 0; q < 4; ++q) bw_[q] = ldrow(F.PB, rbase, tb + q, n, PBG + c0);
        const f32x4 w0a = *(const f32x4*)(p->conv_w + (l * 3 + 0) * 256 + c0), w0b = *(const f32x4*)(p->conv_w + (l * 3 + 0) * 256 + c0 + 4);
        const f32x4 w1a = *(const f32x4*)(p->conv_w + (l * 3 + 1) * 256 + c0), w1b = *(const f32x4*)(p->conv_w + (l * 3 + 1) * 256 + c0 + 4);
        const f32x4 w2a = *(const f32x4*)(p->conv_w + (l * 3 + 2) * 256 + c0), w2b = *(const f32x4*)(p->conv_w + (l * 3 + 2) * 256 + c0 + 4);
        const f32x4 cba = *(const f32x4*)(p->conv_b + l * 256 + c0), cbb = *(const f32x4*)(p->conv_b + l * 256 + c0 + 4);
        float hc[6][8];
#pragma unroll
        for (int i = 0; i < 6; ++i) { float a[8], b[8]; unpack8(hw_[i], a); unpack8(cw_[i], b); const int t = tb - 1 + i; const float msk = (t >= 0 && t < n) ? 1.f : 0.f;
#pragma unroll
            for (int e = 0; e < 8; ++e) hc[i][e] = a[e] * b[e] * msk; }
#pragma unroll
        for (int q = 0; q < 4; ++q) { float bg[8], y[8]; unpack8(bw_[q], bg);
#pragma unroll
            for (int e = 0; e < 8; ++e) { const float w0 = e < 4 ? w0a[e & 3] : w0b[e & 3], w1 = e < 4 ? w1a[e & 3] : w1b[e & 3], w2 = e < 4 ? w2a[e & 3] : w2b[e & 3], cb = e < 4 ? cba[e & 3] : cbb[e & 3];
                y[e] = bg[e] * (w0 * hc[q][e] + w1 * hc[q + 1][e] + w2 * hc[q + 2][e] + cb); }
            store8(F.YMIX + (size_t)(rbase + tb + q) * D + 512 + c0, y); }
    }
    __builtin_amdgcn_sched_barrier(0);
    {
        const int wnd = 2 << (oct >> 3), hw = wnd >> 1;
        float s[4][8], self[4][8];
#pragma unroll
        for (int q = 0; q < 4; ++q) { unpack8(ldrow(F.PB, rbase, tb + q, n, PPOOL + c0), self[q]);
#pragma unroll
            for (int e = 0; e < 8; ++e) s[q][e] = 0.f; }
        __builtin_amdgcn_sched_barrier(0);
#pragma unroll
        for (int bt = 0; bt < 19; bt += 7) {
            u32x4 pw[7];
#pragma unroll
            for (int ii = 0; ii < 7; ++ii) if (bt + ii < 19) pw[ii] = ldrow(F.PB, rbase, tb - hw + bt + ii, n, PPOOL + c0);
#pragma unroll
            for (int ii = 0; ii < 7; ++ii) if (bt + ii < 19) { const int i = bt + ii; float v[8]; unpack8(pw[ii], v); const int t = tb - hw + i; const bool inr = (t >= 0 && t < n);
#pragma unroll
                for (int q = 0; q < 4; ++q) { const float mk = (inr && i >= q && i < q + wnd) ? 1.f : 0.f;
#pragma unroll
                    for (int e = 0; e < 8; ++e) s[q][e] += mk * v[e]; } }
            __builtin_amdgcn_sched_barrier(0);
        }
#pragma unroll
        for (int q = 0; q < 4; ++q) { const int t = tb + q; const int lo = (t - hw > 0) ? t - hw : 0, hi = (t + hw - 1 < n - 1) ? t + hw - 1 : n - 1; const float inv = 1.f / (float)(hi - lo + 1);
            float y[8];
#pragma unroll
            for (int e = 0; e < 8; ++e) y[e] = s[q][e] * inv - self[q][e];
            store8(F.YMIX + (size_t)(rbase + t) * D + 768 + c0, y); }
    }
}
__device__ __forceinline__ void ctx_act(PP p, Ctx& F, int l) {
    const int gt = blockIdx.x * 512 + F.tid, NT = F.G * 512;
    for (int i = gt; i < MC * 352; i += NT) { const int oc = i % 352, rc = i / 352, t = rc & 255, c0 = 8 * oc;
        const bf16* base = F.CAU + (size_t)rc * NUP + c0; float a[8], y[8], u[8];
        const float* cw = p->ffn_cw + (size_t)l * 3 * DFF + c0; const float* cb = p->ffn_cb + (size_t)l * DFF + c0;
#pragma unroll
        for (int e = 0; e < 8; ++e) y[e] = cb[e];
        if (t > 0) { load8(base - NUP, a);
#pragma unroll
            for (int e = 0; e < 8; ++e) y[e] += cw[e] * a[e]; }
        load8(base, a);
#pragma unroll
        for (int e = 0; e < 8; ++e) y[e] += cw[DFF + e] * a[e];
        if (t < 255) { load8(base + NUP, a);
#pragma unroll
            for (int e = 0; e < 8; ++e) y[e] += cw[2 * DFF + e] * a[e]; }
        load8(base + DFF, u);
#pragma unroll
        for (int e = 0; e < 8; ++e) y[e] = silu_f(y[e]) * u[e];
        store8(F.ACT + (size_t)(ML + rc) * DFF + c0, y);
    }
}
__global__ void __launch_bounds__(512, 2) fwd_megakernel(Params p_) {
    PP p = (PP)__builtin_amdgcn_kernarg_segment_ptr();
    extern __shared__ __attribute__((aligned(16))) unsigned char lds_raw[];
    cg::grid_group grid = cg::this_grid();
    Ctx F;
    F.lds = (LAS unsigned char*)lds_raw; F.tid = threadIdx.x; F.lane = F.tid & 63; F.wave = __builtin_amdgcn_readfirstlane(F.tid >> 6);
    const int wave_s = F.wave;
    F.G = gridDim.x; F.gw = blockIdx.x * 8 + F.wave; F.NGW = F.G * 8;
    unsigned char* ws = p->ws;
#define SETPTRS() do { { PP q_ = (PP)__builtin_amdgcn_kernarg_segment_ptr(); asm volatile("" : "+s"(q_)); p = q_; } unsigned char* w_ = p->ws; asm volatile("" : "+s"(w_)); \
    F.MOD = (float*)(w_ + WS_MOD); F.MCS = (float*)(w_ + WS_MCS); F.F1 = (bf16*)(w_ + WS_F1); F.F2 = (bf16*)(w_ + WS_F2); F.FC = (bf16*)(w_ + WS_FC); \
    F.HX = (bf16*)(w_ + WS_HX); F.TB = (bf16*)(w_ + WS_HX); F.YMIX = (bf16*)(w_ + WS_YMIX); F.PB = (bf16*)(w_ + WS_P); F.ACT = (bf16*)(w_ + WS_P); \
    F.XC = (float*)(w_ + WS_XC); F.ST = (float*)(w_ + WS_ST); F.DEC = (float*)(w_ + WS_DEC); F.CAU = (bf16*)(w_ + WS_CAU); } while (0)
    SETPTRS();

#ifndef NO_P0
#define REFRESH() do { int t_; asm volatile("v_mbcnt_lo_u32_b32 %0, -1, 0\n\tv_mbcnt_hi_u32_b32 %0, -1, %0" : "=v"(t_)); t_ |= (wave_s << 6); F.tid = t_; F.lane = t_ & 63; F.wave = __builtin_amdgcn_readfirstlane(t_ >> 6); F.gw = blockIdx.x * 8 + F.wave; SETPTRS(); } while (0)
    { volatile LAS unsigned* misc = (volatile LAS unsigned*)(F.lds + RING_BYTES); if (F.tid < 64) misc[F.tid] = 0u; }
    __syncthreads();
    XcdBarrier bar = xcd_barrier_post((unsigned*)(ws + WS_CTL), (volatile LAS unsigned*)(F.lds + RING_BYTES) + 8, F.tid);
#define GSYNC() do { REFRESH(); xcd_barrier(bar, F.tid); } while (0)
    REFRESH();
    phase0(p, F);
#endif
    if (p->ws == nullptr) grid.sync();
    GSYNC();
#define L0() ({ int lq_ = l; asm volatile("" : "+s"(lq_)); lq_ == 0; })
    for (int l = 0; l < 2; ++l) {
        const int M6 = L0() ? MT : ML;
#ifndef NO_P1
        REFRESH();
        norm_phase(p, F, l, 0, MT);
        REFRESH();
        if (L0()) fold_items(p, F);
#ifdef PROBE_B
        REFRESH(); norm_phase(p, F, l, 0, MT); if (L0()) fold_items(p, F);
#endif
#endif
        GSYNC();
#ifndef NO_P2
        REFRESH();
        { pg8::Gemm g{F.HX, win_t(p, l), MT, NP, D, D}; pg8::StaticOrder S; S.init(MT, NP, F.G, (int)blockIdx.x);
          EpiP E{F.PB, p->b_a2 + l * 256};
          pg8::gemm_phase<EpiP, pg8::StaticOrder, true, true>(F.lds, g, S, E, F.tid);
#ifdef PROBE_C
          __syncthreads(); pg8::gemm_phase<EpiP, pg8::StaticOrder, true, true>(F.lds, g, S, E, F.tid);
#endif
        }
#endif
        GSYNC();
#ifdef PROBE_A
        for (int rep_ = 0; rep_ < 2; ++rep_) {
#else
        {
#endif
#ifndef NO_GA
        REFRESH();
        for (int it = blockIdx.x; it < 2 * NCH; it += F.G) gla_a_item(F, it / NCH, it % NCH);
#ifdef PR_GA
        __syncthreads(); REFRESH();
        for (int it = blockIdx.x; it < 2 * NCH; it += F.G) gla_a_item(F, it / NCH, it % NCH);
#endif
#endif
#ifndef NO_F1
        REFRESH();
        fft_stage1(F);
#ifdef PR_F1
        __syncthreads(); REFRESH();
        fft_stage1(F);
#endif
#endif
#ifndef NO_CP
        REFRESH();
        for (int v = blockIdx.x; v < 512; v += F.G) { const int it = (v < 256) ? v : 256 + ((v + 248) & 255);
            if (it >= (L0() ? 264 : 256)) continue; convpool_item(p, F, l, it); }
#ifdef PR_CP
        __syncthreads(); REFRESH();
        for (int v = blockIdx.x; v < 512; v += F.G) { const int it = (v < 256) ? v : 256 + ((v + 248) & 255);
            if (it >= (L0() ? 264 : 256)) continue; convpool_item(p, F, l, it); }
#endif
#endif
        }
        GSYNC();
#ifdef PROBE_A
        REFRESH(); fft_stage2(F, l);
#endif
#ifndef NO_F2
        REFRESH();
        fft_stage2(F, l);
#ifdef PR_F2
        __syncthreads(); REFRESH();
        fft_stage2(F, l);
#endif
#endif
#ifndef NO_SC
        REFRESH();
        gla_scan(F);
#endif
        GSYNC();
#ifdef PROBE_A
        for (int rep_ = 0; rep_ < 2; ++rep_) {
#else
        {
#endif
#ifndef NO_GC
        REFRESH();
        for (int it = blockIdx.x; it < 256; it += F.G) gla_c_item<2>(p, F, l, it >> 7, 4 + (it & 127), 0);
        if (L0()) for (int j = blockIdx.x; j < 16; j += F.G) gla_c_item<1>(p, F, l, j >> 3, (j >> 1) & 3, j & 1);
        if (L0()) { if (F.G == 256) ctx_dft(F, F.gw - 256, 1 << 30); else ctx_dft(F, F.gw, F.NGW); }
#ifdef PR_GC
        __syncthreads(); REFRESH();
        for (int it = blockIdx.x; it < 256; it += F.G) gla_c_item<2>(p, F, l, it >> 7, 4 + (it & 127), 0);
#endif
#endif
        }
        GSYNC();
#ifndef NO_P6
        REFRESH();
        if (L0()) { pg8::Gemm g{F.YMIX, wout_t(p, l), MT, D, 256, D}; SplitOrder S; S.init(4, F.G, (int)blockIdx.x);
          EpiPartial E{(float*)(p->ws + WS_PART)};
          pg8::gemm_phase<EpiPartial, SplitOrder, false, false>(F.lds, g, S, E, F.tid); __syncthreads(); }
        REFRESH();
        { pg8::Gemm g{F.YMIX, wout_t(p, l), ML, D, D, D}; pg8::StaticOrder S; S.init(ML, D, F.G, (int)blockIdx.x);
          if (L0()) { EpiRes<false, true> E{p->x, p->out, F.MOD + l * 3 * 6144 + 2048}; pg8::gemm_phase<EpiRes<false, true>, pg8::StaticOrder, true, true>(F.lds, g, S, E, F.tid); }
          else if (F.G == 256) { EpiResNorm E{(const bf16*)p->out, (bf16*)(p->ws + WS_XB2), F.HX, F.MOD + l * 3 * 6144 + 2048, p->norm2_g + l * D, F.MOD + l * 3 * 6144, (float*)(p->ws + WS_SLOT) + 65536 * 2, (unsigned*)(p->ws + WS_CTL) + CW_FIN + 4096};
            pg8::gemm_phase<EpiResNorm, pg8::StaticOrder, false, true>(F.lds, g, S, E, F.tid); }
          else { EpiRes<true, true> E{p->out, p->out, F.MOD + l * 3 * 6144 + 2048}; pg8::gemm_phase<EpiRes<true, true>, pg8::StaticOrder, true, true>(F.lds, g, S, E, F.tid); } }
#endif
        GSYNC();
        if (L0() || F.G != 256) { REFRESH(); norm_phase(p, F, l, 1, M6); GSYNC(); }
#ifndef NO_P8
        REFRESH();
        { pg8::Gemm g{F.HX, wup_t(p, l), ML, NUP, D, D}; pg8::StaticOrder S; S.init(ML, NUP, F.G, (int)blockIdx.x);
          EpiUp E{F.ACT, p->ffn_cw + (size_t)l * 3 * DFF, p->ffn_cb + (size_t)l * DFF};
          pg8::gemm_phase<EpiUp, pg8::StaticOrder, true, true>(F.lds, g, S, E, F.tid);
        }
        if (L0()) { REFRESH(); __syncthreads();
          pg8::Gemm g{F.HX, wup_t(p, l), MT, NUP, D, D}; CtxOrder S; S.init(NUP, (int)blockIdx.x, 128);
          EpiUpCtx E{F.ACT, p->ffn_cw + (size_t)l * 3 * DFF, p->ffn_cb + (size_t)l * DFF, (LAS float*)(F.lds + RING_BYTES + 1024)};
          pg8::gemm_phase<EpiUpCtx, CtxOrder, true, false>(F.lds, g, S, E, F.tid); }
#endif
        GSYNC();
#ifndef NO_P9
        REFRESH();
        if (L0()) { pg8::Gemm g{F.ACT, wdn_t(p, l), MT, D, 256, DFF}; SplitOrder S; S.init(11, F.G, (int)blockIdx.x);
          EpiPartial E{(float*)(p->ws + WS_PART)};
          pg8::gemm_phase<EpiPartial, SplitOrder, false, false>(F.lds, g, S, E, F.tid); __syncthreads(); }
        REFRESH();
        { pg8::Gemm g{F.ACT, wdn_t(p, l), ML, D, DFF, DFF}; pg8::StaticOrder S; S.init(ML, D, F.G, (int)blockIdx.x);
          if (L0()) { EpiRes<true, true> E{p->out, p->out, F.MOD + l * 3 * 6144 + 5120}; pg8::gemm_phase<EpiRes<true, true>, pg8::StaticOrder, true, true>(F.lds, g, S, E, F.tid); }
          else if (F.G == 256) { EpiFinal E{(const bf16*)(p->ws + WS_XB2), p->out, F.MOD + l * 3 * 6144 + 5120, p->final_g, (float*)(p->ws + WS_SLOT), (unsigned*)(p->ws + WS_CTL) + CW_FIN};
            pg8::gemm_phase<EpiFinal, pg8::StaticOrder, false, true>(F.lds, g, S, E, F.tid); }
          else { EpiRes<true, false> E{p->out, p->ws + WS_HX, F.MOD + l * 3 * 6144 + 5120}; pg8::gemm_phase<EpiRes<true, false>, pg8::StaticOrder, true, true>(F.lds, g, S, E, F.tid); } }
#endif
        if (L0() || F.G != 256) GSYNC();
    }
        REFRESH();
    if (F.G != 256) final_norm(p, F);
}

extern "C" void kernel_launch(void* const* d_in, const int* in_sizes, int n_in, void* d_out, int out_size, void* d_ws, size_t ws_size, hipStream_t stream) {
    static int grid = 0;
    if (grid == 0) {
        if (n_in != 23 || in_sizes[0] != ML * D || out_size != ML * D || ws_size < WS_END) { fprintf(stderr, "kernel_launch: unexpected shapes / workspace (%d inputs, ws %zu)\n", n_in, ws_size); grid = -1; return; }
        int dev = 0, cus = 0, per_cu = 0;
        hipGetDevice(&dev); hipDeviceGetAttribute(&cus, hipDeviceAttributeMultiprocessorCount, dev);
        if (hipFuncSetAttribute((const void*)fwd_megakernel, hipFuncAttributeMaxDynamicSharedMemorySize, LDS_BYTES) != hipSuccess) { fprintf(stderr, "hipFuncSetAttribute failed\n"); grid = -1; return; }
        if (hipOccupancyMaxActiveBlocksPerMultiprocessor(&per_cu, (const void*)fwd_megakernel, 512, LDS_BYTES) != hipSuccess || per_cu < 1) per_cu = 1;
        (void)hipGetLastError();
        grid = cus * 1;
    }
    if (grid < 0) return;
    if (hipMemsetAsync((char*)d_ws + WS_CTL, 0, 65536, stream) != hipSuccess) { fprintf(stderr, "memset failed\n"); return; }
    Params p{};
    const float** pp = (const float**)&p;
    for (int i = 0; i < 23; ++i) pp[i] = (const float*)d_in[i];
    p.out = (float*)d_out; p.ws = (unsigned char*)d_ws;
    void* args[] = {&p};
    hipError_t e = hipLaunchCooperativeKernel((const void*)fwd_megakernel, dim3(grid), dim3(512), args, LDS_BYTES, stream);
    if (e != hipSuccess) fprintf(stderr, "cooperative launch failed: %s (grid %d)\n", hipGetErrorString(e), grid);
}
```

```cpp
#include <hip/hip_runtime.h>
#include <hip/hip_cooperative_groups.h>
#include <cstdio>
#include <cstdint>
namespace cg = cooperative_groups;
namespace pg8 {
#define PG8_LAS __attribute__((address_space(3)))
typedef unsigned short bf16_t;
typedef short bf16x8 __attribute__((ext_vector_type(8)));
typedef float f32x4 __attribute__((ext_vector_type(4)));
typedef unsigned u32x4 __attribute__((ext_vector_type(4)));
constexpr int BM = 256, BK = 64, HALF = 128, HTB = HALF * BK * 2  , STAGE_BYTES = 8 * HTB, NXCD = 8, WGM = 8;

__host__ __device__ __forceinline__ int lds_byte(int r, int c) { const int st = (r >> 4) * 2 + (c >> 5), rr = r & 15, cc = c & 31, ob = rr * 64 + cc * 2; return st * 1024 + (ob ^ (((ob >> 9) & 1) << 5)); }
__host__ __device__ __forceinline__ void stage_rc(int b, int& R, int& C) { const int st = b / 1024, sb = b % 1024, swz = sb ^ (((sb >> 9) & 1) << 5); R = (st >> 1) * 16 + swz / 64; C = (st & 1) * 32 + (swz % 64) / 2; }
__host__ __device__ __forceinline__ int perm32(int rho) { const int n = rho >> 4, i = rho & 15; return 8 * (i >> 2) + 4 * n + (i & 3); }

struct Unit { int pm, pn, ks; };
struct Gemm { const bf16_t* A; const bf16_t* Bt; int M, N, K, ld; };

struct StaticOrder {
    int nM, nN, nwg, G, c;
    __host__ __device__ void init(int M, int N, int G_, int c_) { nM = M / BM; nN = N / BM; nwg = nM * nN; G = G_; c = c_; }
    __host__ __device__ bool next(int i, Unit& u) const {
        const long L = (long)i * G + c; if (L >= nwg) return false;
        int wgid = (int)L; { const int q = nwg / NXCD, r = nwg % NXCD, xcd = wgid % NXCD, off = wgid / NXCD; wgid = (xcd < r ? xcd * (q + 1) : r * (q + 1) + (xcd - r) * q) + off; }
        const int nig = WGM * nN, gid = wgid / nig, fm = gid * WGM, gsz = (nM - fm) < WGM ? (nM - fm) : WGM;
        u.pm = fm + ((wgid % nig) % gsz); u.pn = (wgid % nig) / gsz; u.ks = 0; return true;
    }
    __device__ __forceinline__ void a_ready(const Unit&) const {}
    __device__ __forceinline__ void done(const Unit&) const {}
};

__device__ __forceinline__ unsigned cvt_pk_bf16(float lo, float hi) { unsigned r; asm volatile("v_cvt_pk_bf16_f32 %0, %1, %2" : "=v"(r) : "v"(lo), "v"(hi)); return r; }
template <class Epi, class Sched, bool ALIGN_EPI = false, bool SP2 = false>
__device__ __forceinline__ void gemm_phase(PG8_LAS unsigned char* lds, const Gemm g, const Sched& S, const Epi& E, int tid_in) {
    int tid_ = tid_in; asm volatile("" : "+v"(tid_)); const int tid = tid_, wid = __builtin_amdgcn_readfirstlane(tid >> 6), lane = tid & 63, wr = wid >> 2, wc = wid & 3, fr = lane & 15, fq = lane >> 4;
    const int K = g.ld, nt = g.K / BK; const size_t sstep = (size_t)g.K * 2;
    unsigned voffA[2], voffB[2];
#pragma unroll
    for (int i = 0; i < 2; ++i) { int R, C; stage_rc(tid * 16 + i * 8192, R, C); const int Rb = Epi::PERM ? ((R & ~31) + perm32(R & 31)) : R;
        voffA[i] = (unsigned)(R * K + C) * 2u; voffB[i] = (unsigned)(Rb * K + C) * 2u; }
    const size_t kstep = (size_t)(BK * 2);
    const size_t hstep = (size_t)HALF * K * 2;
    const size_t tstep = 2 * hstep;
    const unsigned ldsw = (unsigned)wid * 1024u;
    const int aoff = lds_byte(wr * 64 + fr, fq * 8), boff = lds_byte(wc * 32 + fr, fq * 8);
#define PG8_SA(b, h) (((b) * 2 + (h)) * HTB)
#define PG8_SB(b, h) ((4 + (b) * 2 + (h)) * HTB)
#define PG8_STAGE(bufoff, gbase, voff) do { _Pragma("unroll") for (int _i = 0; _i < 2; ++_i) \
        __builtin_amdgcn_global_load_lds((const unsigned*)((const char*)(gbase) + (voff)[_i]), (PG8_LAS unsigned*)(lds + (bufoff) + ldsw + _i * 8192), 16, 0, 0); } while (0)
#define PG8_LDA(dst, b, h) do { _Pragma("unroll") for (int m = 0; m < 4; ++m) _Pragma("unroll") for (int k = 0; k < 2; ++k) dst[m][k] = *(const PG8_LAS bf16x8*)(lds + PG8_SA(b, h) + aoff + m * 2048 + k * 1024); } while (0)
#define PG8_LDB(dst, b, h) do { _Pragma("unroll") for (int n = 0; n < 2; ++n) _Pragma("unroll") for (int k = 0; k < 2; ++k) dst[n][k] = *(const PG8_LAS bf16x8*)(lds + PG8_SB(b, h) + boff + n * 2048 + k * 1024); } while (0)
#define PG8_MMA(ai, bj, At, Bt) do { __builtin_amdgcn_s_setprio(1); _Pragma("unroll") for (int m = 0; m < 4; ++m) _Pragma("unroll") for (int n = 0; n < 2; ++n) _Pragma("unroll") for (int k = 0; k < 2; ++k) \
        acc[ai][bj][m][n] = __builtin_amdgcn_mfma_f32_16x16x32_bf16(Bt[n][k], At[m][k], acc[ai][bj][m][n], 0, 0, 0); __builtin_amdgcn_s_setprio(0); } while (0)
#define PG8_WAIT_V(n) asm volatile("s_waitcnt vmcnt(" #n ")" ::: "memory")
#define PG8_WAIT_L(n) asm volatile("s_waitcnt lgkmcnt(" #n ")" ::: "memory")
#define PG8_BAR __builtin_amdgcn_s_barrier()
#define PG8_SCHED __builtin_amdgcn_sched_barrier(0)
    Unit cur, nxt; int ui = 0;
    if (!S.next(0, cur)) return;
    f32x4 acc[2][2][4][2];
#pragma unroll
    for (int a = 0; a < 2; ++a)
#pragma unroll
        for (int b = 0; b < 2; ++b)
#pragma unroll
            for (int m = 0; m < 4; ++m)
#pragma unroll
                for (int n = 0; n < 2; ++n) acc[a][b][m][n] = (f32x4){0.f, 0.f, 0.f, 0.f};
    bf16x8 At[4][2], B0[2][2], B1[2][2];
    const char* cA = (const char*)g.A + (size_t)cur.pm * tstep + (size_t)cur.ks * sstep; const char* cB = (const char*)g.Bt + (size_t)cur.pn * tstep + (size_t)cur.ks * sstep;
    S.a_ready(cur);
    if constexpr (SP2) {
        PG8_STAGE(PG8_SB(0, 0), cB, voffB); PG8_STAGE(PG8_SB(0, 1), cB + hstep, voffB); PG8_STAGE(PG8_SA(0, 0), cA, voffA); PG8_STAGE(PG8_SA(0, 1), cA + hstep, voffA);
        if (wr == 1) PG8_BAR;
        PG8_WAIT_V(2); PG8_BAR;
        PG8_STAGE(PG8_SB(1, 0), cB + kstep, voffB); PG8_STAGE(PG8_SA(1, 0), cA + kstep, voffA); PG8_STAGE(PG8_SB(1, 1), cB + hstep + kstep, voffB);
        PG8_WAIT_V(6); PG8_BAR;
    } else {
        PG8_STAGE(PG8_SB(0, 0), cB, voffB); PG8_STAGE(PG8_SA(0, 0), cA, voffA); PG8_STAGE(PG8_SB(0, 1), cB + hstep, voffB); PG8_STAGE(PG8_SA(0, 1), cA + hstep, voffA);
        if (wr == 1) PG8_BAR;
        PG8_WAIT_V(4); PG8_BAR;
        PG8_STAGE(PG8_SB(1, 0), cB + kstep, voffB); PG8_STAGE(PG8_SA(1, 0), cA + kstep, voffA); PG8_STAGE(PG8_SB(1, 1), cB + hstep + kstep, voffB);
        PG8_WAIT_V(6); PG8_BAR;
    }
    for (;;) {
        const bool has_next = S.next(ui + 1, nxt);
        const char* nA = has_next ? (const char*)g.A + (size_t)nxt.pm * tstep + (size_t)nxt.ks * sstep : cA; const char* nB = has_next ? (const char*)g.Bt + (size_t)nxt.pn * tstep + (size_t)nxt.ks * sstep : cB;
        for (int t = 0; t < nt; t += 2) {
            const bool last = (t == nt - 2);
            const char* a1 = cA + (size_t)(t + 1) * kstep;
            const char* a2 = last ? nA : cA + (size_t)(t + 2) * kstep; const char* b2 = last ? nB : cB + (size_t)(t + 2) * kstep;
            const char* a3 = a2 + kstep; const char* b3 = b2 + kstep;
            if (last && has_next) S.a_ready(nxt);
            if constexpr (SP2) {
            PG8_LDB(B0, 0, 0); PG8_LDB(B1, 0, 1); PG8_SCHED; PG8_LDA(At, 0, 0); PG8_STAGE(PG8_SA(1, 1), a1 + hstep, voffA);
            PG8_WAIT_V(8); PG8_WAIT_L(0); PG8_BAR; PG8_MMA(0, 0, At, B0); PG8_MMA(0, 1, At, B1); PG8_BAR; PG8_SCHED;
            PG8_LDA(At, 0, 1); PG8_STAGE(PG8_SB(0, 0), b2, voffB); PG8_STAGE(PG8_SB(0, 1), b2 + hstep, voffB); PG8_STAGE(PG8_SA(0, 0), a2, voffA);
            PG8_WAIT_V(8); PG8_WAIT_L(0); PG8_BAR; PG8_MMA(1, 0, At, B0); PG8_MMA(1, 1, At, B1); PG8_BAR; PG8_SCHED;
            PG8_LDB(B0, 1, 0); PG8_LDB(B1, 1, 1); PG8_SCHED; PG8_LDA(At, 1, 0); PG8_STAGE(PG8_SA(0, 1), a2 + hstep, voffA);
            PG8_WAIT_V(8); PG8_WAIT_L(0); PG8_BAR; PG8_MMA(0, 0, At, B0); PG8_MMA(0, 1, At, B1); PG8_BAR; PG8_SCHED;
            PG8_LDA(At, 1, 1); PG8_STAGE(PG8_SB(1, 0), b3, voffB); PG8_STAGE(PG8_SB(1, 1), b3 + hstep, voffB); PG8_STAGE(PG8_SA(1, 0), a3, voffA);
            PG8_WAIT_V(8); PG8_WAIT_L(0); PG8_BAR; PG8_MMA(1, 0, At, B0); PG8_MMA(1, 1, At, B1); PG8_BAR; PG8_SCHED;
            } else {
            PG8_LDB(B0, 0, 0); PG8_SCHED; PG8_LDA(At, 0, 0); PG8_STAGE(PG8_SA(1, 1), a1 + hstep, voffA);
            PG8_WAIT_L(8); PG8_BAR; PG8_WAIT_L(0); PG8_MMA(0, 0, At, B0); PG8_BAR; PG8_SCHED;
            PG8_LDB(B1, 0, 1); PG8_STAGE(PG8_SB(0, 0), b2, voffB);
            PG8_BAR; PG8_WAIT_L(0); PG8_MMA(0, 1, At, B1); PG8_BAR;
            PG8_LDA(At, 0, 1); PG8_STAGE(PG8_SA(0, 0), a2, voffA);
            PG8_BAR; PG8_WAIT_L(0); PG8_MMA(1, 0, At, B0); PG8_BAR; PG8_SCHED;
            PG8_STAGE(PG8_SB(0, 1), b2 + hstep, voffB);
            PG8_WAIT_V(6); PG8_BAR; PG8_MMA(1, 1, At, B1); PG8_BAR;
            PG8_LDB(B0, 1, 0); PG8_SCHED; PG8_LDA(At, 1, 0); PG8_STAGE(PG8_SA(0, 1), a2 + hstep, voffA);
            PG8_WAIT_L(8); PG8_BAR; PG8_WAIT_L(0); PG8_MMA(0, 0, At, B0); PG8_BAR; PG8_SCHED;
            PG8_LDB(B1, 1, 1); PG8_STAGE(PG8_SB(1, 0), b3, voffB);
            PG8_BAR; PG8_WAIT_L(0); PG8_MMA(0, 1, At, B1); PG8_BAR;
            PG8_LDA(At, 1, 1); PG8_STAGE(PG8_SA(1, 0), a3, voffA);
            PG8_BAR; PG8_WAIT_L(0); PG8_MMA(1, 0, At, B0); PG8_BAR; PG8_SCHED;
            PG8_STAGE(PG8_SB(1, 1), b3 + hstep, voffB);
            PG8_WAIT_V(6); PG8_BAR; PG8_MMA(1, 1, At, B1); PG8_BAR;
            }
        }
        if constexpr (ALIGN_EPI) { if (wr == 0) PG8_BAR; }
        if constexpr (!Epi::AFTER_DRAIN) { E(acc, cur, wr, wc, fr, fq); S.done(cur); }
        if (!has_next) break;
#pragma unroll
        for (int a = 0; a < 2; ++a)
#pragma unroll
            for (int b = 0; b < 2; ++b)
#pragma unroll
                for (int m = 0; m < 4; ++m)
#pragma unroll
                    for (int n = 0; n < 2; ++n) acc[a][b][m][n] = (f32x4){0.f, 0.f, 0.f, 0.f};
        cur = nxt; cA = nA; cB = nB; ++ui;
        if constexpr (ALIGN_EPI) { if (wr == 1) PG8_BAR; }
    }
    PG8_WAIT_V(0);
    if constexpr (!ALIGN_EPI) { if (wr == 0) PG8_BAR; }
    PG8_BAR;
    if constexpr (Epi::AFTER_DRAIN) { E.fused(acc, cur, wr, wc, fr, fq, lds, wid, lane); S.done(cur); }
#undef PG8_SA
#undef PG8_SB
#undef PG8_STAGE
#undef PG8_LDA
#undef PG8_LDB
#undef PG8_MMA
#undef PG8_WAIT_V
#undef PG8_WAIT_L
#undef PG8_BAR
#undef PG8_SCHED
}
}
#define LAS __attribute__((address_space(3)))
typedef unsigned short bf16;
typedef float f32x4 __attribute__((ext_vector_type(4)));
typedef short bf16x8 __attribute__((ext_vector_type(8)));
typedef unsigned u32x4 __attribute__((ext_vector_type(4)));
typedef unsigned u32x2 __attribute__((ext_vector_type(2)));
#define LDS_WAIT() asm volatile("s_waitcnt lgkmcnt(0)" ::: "memory")

constexpr int D = 1024, SEQ = 8192, ML = 16384, MC = 512, MT = ML + MC, CTXL = 256;
constexpr int DIN = 2080, NP = 2560, DFF = 2816, NUP = 5632;
constexpr int PK = 0, PQ = 128, PV = 256, PLA = 512, PG = 768, PFA = 1024, PFB = 1280, PH = 1536, PBG = 1792, PCG = 2048, PPOOL = 2304;
constexpr int NCH = 132;
constexpr float EPS = 1e-6f;
constexpr size_t MiB = 1u << 20;
constexpr size_t WS_CTL = 0;
constexpr size_t WS_MOD = 1 * MiB;
constexpr size_t WS_MCS = 1 * MiB + 256 * 1024;
constexpr size_t WS_F1 = 1 * MiB + 512 * 1024;
constexpr size_t WS_F2 = WS_F1 + 32 * 1024;
constexpr size_t WS_FC = WS_F2 + 64 * 1024;
constexpr size_t WS_SLOT = 49 * MiB;
constexpr size_t WS_XB2 = 208 * MiB;
constexpr int CW_FIN = 3584;
constexpr size_t WS_W = 2 * MiB;
constexpr size_t W_IN_B = (size_t)NP * D * 2, W_OUT_B = (size_t)D * D * 2, W_UP_B = (size_t)NUP * D * 2, W_DN_B = (size_t)D * DFF * 2;
constexpr size_t W_LAYER_B = W_IN_B + W_OUT_B + W_UP_B + W_DN_B;
constexpr size_t WS_HX = 50 * MiB;
constexpr size_t WS_YMIX = 83 * MiB;
constexpr size_t WS_P = 116 * MiB;
constexpr size_t WS_XC = 207 * MiB;
constexpr size_t WS_ST = 209 * MiB;
constexpr size_t WS_DEC = 226 * MiB;
constexpr size_t WS_CAU = 227 * MiB;
constexpr size_t WS_PART = 233 * MiB;
constexpr size_t WS_END = 255 * MiB;
static_assert(WS_W + 2 * W_LAYER_B <= WS_HX, "weights");
static_assert(WS_P + (size_t)MT * DFF * 2 <= WS_XC, "act");
constexpr int RING_BYTES = 131072, LDS_BYTES = 147456;

struct Params {
    const float *x, *c, *ctx, *c_ctx, *norm1_g, *norm2_g, *w_mod, *b_mod, *w_in, *w_a2, *b_a2, *gla_g, *fft_w, *conv_w, *conv_b, *pool_w,
        *pool_scale, *w_out, *w_up, *ffn_cw, *ffn_cb, *w_down, *final_g;
    float* out; unsigned char* ws;
};

typedef const __attribute__((address_space(4))) Params* PP;
__device__ __forceinline__ unsigned f2bf(float f) { unsigned u = __builtin_bit_cast(unsigned, f); return (u + 0x7fffu + ((u >> 16) & 1u)) >> 16; }
__device__ __forceinline__ unsigned pk2(float lo, float hi) { return f2bf(lo) | (f2bf(hi) << 16); }
__device__ __forceinline__ float bf2f(unsigned h) { return __builtin_bit_cast(float, h << 16); }
__device__ __forceinline__ float bflo(unsigned w) { return __builtin_bit_cast(float, w << 16); }
__device__ __forceinline__ float bfhi(unsigned w) { return __builtin_bit_cast(float, w & 0xffff0000u); }
__device__ __forceinline__ float shfl_f(float v, int src_lane) { return __builtin_bit_cast(float, __builtin_amdgcn_ds_bpermute(src_lane << 2, __builtin_bit_cast(int, v))); }
__device__ __forceinline__ float wave_sum(float v, int lane) {
#pragma unroll
    for (int o = 1; o < 64; o <<= 1) v += shfl_f(v, lane ^ o);
    return v;
}
__device__ __forceinline__ float silu_f(float x) { return x * __builtin_amdgcn_rcpf(1.f + __expf(-x)); }
__device__ __forceinline__ float cos_rev(float r) { return __builtin_amdgcn_cosf(r); }
__device__ __forceinline__ float sin_rev(float r) { return __builtin_amdgcn_sinf(r); }
__device__ __forceinline__ bf16x8 pack8(float a0, float a1, float a2, float a3, float a4, float a5, float a6, float a7) {
    u32x4 w; w.x = pk2(a0, a1); w.y = pk2(a2, a3); w.z = pk2(a4, a5); w.w = pk2(a6, a7); return __builtin_bit_cast(bf16x8, w);
}
#define MFMA16(a, b, c) __builtin_amdgcn_mfma_f32_16x16x32_bf16(a, b, c, 0, 0, 0)

struct EpiP {
    static constexpr bool PERM = true, AFTER_DRAIN = false;
    bf16* O; const float* ba2;
    __device__ __forceinline__ void operator()(const pg8::f32x4 (&acc)[2][2][4][2], const pg8::Unit& u, int wr, int wc, int fr, int fq) const {
        const int row0 = u.pm * 256 + wr * 64 + fr, col0 = u.pn * 256 + wc * 32 + 8 * fq;
        const bool la = (u.pn == 2);
#pragma unroll
        for (int ai = 0; ai < 2; ++ai)
#pragma unroll
            for (int m = 0; m < 4; ++m) { bf16* rowp = O + (size_t)(row0 + ai * 128 + m * 16) * NP + col0;
#pragma unroll
                for (int bj = 0; bj < 2; ++bj) { pg8::f32x4 v0 = acc[ai][bj][m][0], v1 = acc[ai][bj][m][1];
                    if (la) { const float* bp = ba2 + (col0 + bj * 128 - PLA); const f32x4 b0 = *(const f32x4*)bp, b1 = *(const f32x4*)(bp + 4);
#pragma unroll
                        for (int e = 0; e < 4; ++e) { float xa = v0[e] + b0[e], xb = v1[e] + b1[e];
                            v0[e] = (fminf(xa, 0.f) - __logf(1.f + __expf(-fabsf(xa)))) * 0.0625f; v1[e] = (fminf(xb, 0.f) - __logf(1.f + __expf(-fabsf(xb)))) * 0.0625f; } }
                    u32x4 w; w.x = pg8::cvt_pk_bf16(v0[0], v0[1]); w.y = pg8::cvt_pk_bf16(v0[2], v0[3]); w.z = pg8::cvt_pk_bf16(v1[0], v1[1]); w.w = pg8::cvt_pk_bf16(v1[2], v1[3]);
                    *(u32x4*)(rowp + bj * 128) = w; } }
    }
};
template <bool INB, bool OUTB>
struct EpiRes {
    static constexpr bool PERM = true, AFTER_DRAIN = false;
    const void* xin; void* out; const float* modg;
    __device__ __forceinline__ void operator()(const pg8::f32x4 (&acc)[2][2][4][2], const pg8::Unit& u, int wr, int wc, int fr, int fq) const {
        const int w = u.pm >> 5; const int cb = u.pn * 256 + wc * 32 + 8 * fq;
        f32x4 gv[2][2];
#pragma unroll
        for (int bj = 0; bj < 2; ++bj)
#pragma unroll
            for (int n = 0; n < 2; ++n) gv[bj][n] = *(const f32x4*)(modg + w * 6144 + cb + bj * 128 + 4 * n);
        constexpr int RG = INB ? 4 : 2;
#pragma unroll
        for (int ai = 0; ai < 2; ++ai)
#pragma unroll
            for (int mp = 0; mp < 4 / RG; ++mp) {
                u32x4 xb[RG][2]; f32x4 xf[INB ? 1 : RG][2][2];
#pragma unroll
                for (int mm = 0; mm < RG; ++mm) { const size_t ro = (size_t)(u.pm * 256 + ai * 128 + wr * 64 + (RG * mp + mm) * 16 + fr) * D + cb;
#pragma unroll
                    for (int bj = 0; bj < 2; ++bj) {
                        if (INB) xb[mm][bj] = *(const u32x4*)((const bf16*)xin + ro + bj * 128);
                        else { xf[INB ? 0 : mm][bj][0] = *(const f32x4*)((const float*)xin + ro + bj * 128); xf[INB ? 0 : mm][bj][1] = *(const f32x4*)((const float*)xin + ro + bj * 128 + 4); } } }
#pragma unroll
                for (int mm = 0; mm < RG; ++mm) { const int m = RG * mp + mm; const size_t ro = (size_t)(u.pm * 256 + ai * 128 + wr * 64 + m * 16 + fr) * D + cb;
#pragma unroll
                    for (int bj = 0; bj < 2; ++bj) { f32x4 x0, x1;
                        if (INB) { const u32x4 t = xb[mm][bj]; x0 = (f32x4){bflo(t.x), bfhi(t.x), bflo(t.y), bfhi(t.y)}; x1 = (f32x4){bflo(t.z), bfhi(t.z), bflo(t.w), bfhi(t.w)}; }
                        else { x0 = xf[INB ? 0 : mm][bj][0]; x1 = xf[INB ? 0 : mm][bj][1]; }
                        const pg8::f32x4 a0 = acc[ai][bj][m][0], a1 = acc[ai][bj][m][1]; const f32x4 g0 = gv[bj][0], g1 = gv[bj][1];
                        f32x4 y0, y1;
#pragma unroll
                        for (int e = 0; e < 4; ++e) { y0[e] = x0[e] + g0[e] * a0[e]; y1[e] = x1[e] + g1[e] * a1[e]; }
                        if (OUTB) { u32x4 pk; pk.x = pg8::cvt_pk_bf16(y0[0], y0[1]); pk.y = pg8::cvt_pk_bf16(y0[2], y0[3]); pk.z = pg8::cvt_pk_bf16(y1[0], y1[1]); pk.w = pg8::cvt_pk_bf16(y1[2], y1[3]);
                            *(u32x4*)((bf16*)out + ro + bj * 128) = pk; }
                        else { *(f32x4*)((float*)out + ro + bj * 128) = y0; *(f32x4*)((float*)out + ro + bj * 128 + 4) = y1; } } }
            }
    }
};
template <bool STORE_X>
__device__ __forceinline__ void panel_rms(pg8::f32x4 (&acc)[2][2][4][2], const pg8::Unit& u, int wr, int wc, int fr, int fq, LAS unsigned char* lds, int wid, int lane,
                                          const bf16* xin, bf16* xout, const float* modg, float* slots, unsigned* cnt) {
    const int w = u.pm >> 5; const int cb = u.pn * 256 + wc * 32 + 8 * fq;
    LAS float* P = (LAS float*)lds;
    LAS float* S = (LAS float*)(lds + 4096);
    f32x4 gv[2][2];
#pragma unroll
    for (int bj = 0; bj < 2; ++bj)
#pragma unroll
        for (int n = 0; n < 2; ++n) gv[bj][n] = *(const f32x4*)(modg + w * 6144 + cb + bj * 128 + 4 * n);
#pragma unroll
    for (int ai = 0; ai < 2; ++ai) {
        u32x4 xb[4][2];
#pragma unroll
        for (int m = 0; m < 4; ++m) { const size_t ro = (size_t)(u.pm * 256 + ai * 128 + wr * 64 + m * 16 + fr) * D + cb;
#pragma unroll
            for (int bj = 0; bj < 2; ++bj) xb[m][bj] = *(const u32x4*)(xin + ro + bj * 128); }
#pragma unroll
        for (int m = 0; m < 4; ++m) { float sq = 0.f; const size_t ro = (size_t)(u.pm * 256 + ai * 128 + wr * 64 + m * 16 + fr) * D + cb;
#pragma unroll
            for (int bj = 0; bj < 2; ++bj) { const u32x4 t = xb[m][bj]; const f32x4 g0 = gv[bj][0], g1 = gv[bj][1]; pg8::f32x4 a0 = acc[ai][bj][m][0], a1 = acc[ai][bj][m][1];
                a0[0] = bflo(t.x) + g0[0] * a0[0]; a0[1] = bfhi(t.x) + g0[1] * a0[1]; a0[2] = bflo(t.y) + g0[2] * a0[2]; a0[3] = bfhi(t.y) + g0[3] * a0[3];
                a1[0] = bflo(t.z) + g1[0] * a1[0]; a1[1] = bfhi(t.z) + g1[1] * a1[1]; a1[2] = bflo(t.w) + g1[2] * a1[2]; a1[3] = bfhi(t.w) + g1[3] * a1[3];
                acc[ai][bj][m][0] = a0; acc[ai][bj][m][1] = a1;
                sq += ((a0[0] * a0[0] + a0[1] * a0[1]) + (a0[2] * a0[2] + a0[3] * a0[3])) + ((a1[0] * a1[0] + a1[1] * a1[1]) + (a1[2] * a1[2] + a1[3] * a1[3]));
                if (STORE_X) { u32x4 pk; pk.x = pg8::cvt_pk_bf16(a0[0], a0[1]); pk.y = pg8::cvt_pk_bf16(a0[2], a0[3]); pk.z = pg8::cvt_pk_bf16(a1[0], a1[1]); pk.w = pg8::cvt_pk_bf16(a1[2], a1[3]);
                    *(u32x4*)(xout + ro + bj * 128) = pk; } }
            sq += shfl_f(sq, lane ^ 16); sq += shfl_f(sq, lane ^ 32);
            if (fq == 0) P[(ai * 128 + wr * 64 + m * 16 + fr) * 4 + wc] = sq; }
    }
    asm volatile("s_waitcnt lgkmcnt(0)" ::: "memory"); __builtin_amdgcn_s_barrier(); asm volatile("" ::: "memory");
    const int row = wid * 32 + (lane & 31);
    if (lane < 32) { const float t = (P[row * 4 + 0] + P[row * 4 + 1]) + (P[row * 4 + 2] + P[row * 4 + 3]);
        __hip_atomic_store(slots + ((size_t)(u.pm * 256 + row) * 4 + u.pn), t, __ATOMIC_RELAXED, __HIP_MEMORY_SCOPE_AGENT); }
    asm volatile("s_waitcnt vmcnt(0)" ::: "memory");
    if (lane == 0) (void)__hip_atomic_fetch_add(cnt + 64 * u.pm, 1u, __ATOMIC_RELAXED, __HIP_MEMORY_SCOPE_AGENT);
    if (wid == 0) { unsigned sp = 0;
        while ((unsigned)__builtin_amdgcn_readfirstlane((int)__hip_atomic_load(cnt + 64 * u.pm, __ATOMIC_RELAXED, __HIP_MEMORY_SCOPE_AGENT)) < 32u) { __builtin_amdgcn_s_sleep(2); if (++sp > (1u << 22)) break; }
        __builtin_amdgcn_fence(__ATOMIC_ACQUIRE, "agent"); }
    asm volatile("s_waitcnt vmcnt(0) lgkmcnt(0)" ::: "memory"); __builtin_amdgcn_s_barrier(); asm volatile("" ::: "memory");
    if (lane < 32) { const float* sl = slots + (size_t)(u.pm * 256 + row) * 4; float t = 0.f;
#pragma unroll
        for (int q = 0; q < 4; ++q) t += __hip_atomic_load(sl + q, __ATOMIC_RELAXED, __HIP_MEMORY_SCOPE_AGENT);
        S[row] = 1.f / sqrtf(t * (1.f / D) + EPS); }
    asm volatile("s_waitcnt vmcnt(0) lgkmcnt(0)" ::: "memory"); __builtin_amdgcn_s_barrier(); asm volatile("" ::: "memory");
}
struct EpiFinal {
    static constexpr bool PERM = true, AFTER_DRAIN = true;
    const bf16* xin; float* out; const float* modg; const float* gfin; float* slots; unsigned* cnt;
    __device__ __forceinline__ void fused(pg8::f32x4 (&acc)[2][2][4][2], const pg8::Unit& u, int wr, int wc, int fr, int fq, LAS unsigned char* lds, int wid, int lane) const {
        panel_rms<false>(acc, u, wr, wc, fr, fq, lds, wid, lane, xin, nullptr, modg, slots, cnt);
        const LAS float* S = (const LAS float*)(lds + 4096); const int cb = u.pn * 256 + wc * 32 + 8 * fq;
        f32x4 gf[2][2];
#pragma unroll
        for (int bj = 0; bj < 2; ++bj)
#pragma unroll
            for (int n = 0; n < 2; ++n) gf[bj][n] = *(const f32x4*)(gfin + cb + bj * 128 + 4 * n);
#pragma unroll
        for (int ai = 0; ai < 2; ++ai)
#pragma unroll
            for (int m = 0; m < 4; ++m) { const int r = ai * 128 + wr * 64 + m * 16 + fr; const float rs = S[r]; float* o = out + (size_t)(u.pm * 256 + r) * D + cb;
#pragma unroll
                for (int bj = 0; bj < 2; ++bj)
#pragma unroll
                    for (int n = 0; n < 2; ++n) { const pg8::f32x4 a = acc[ai][bj][m][n]; const f32x4 g4 = gf[bj][n];
                        *(f32x4*)(o + bj * 128 + 4 * n) = (f32x4){a[0] * rs * g4[0], a[1] * rs * g4[1], a[2] * rs * g4[2], a[3] * rs * g4[3]}; } }
    }
};
struct EpiResNorm {
    static constexpr bool PERM = true, AFTER_DRAIN = true;
    const bf16* xin; bf16* xout; bf16* hout; const float* modg; const float* gn; const float* modn; float* slots; unsigned* cnt;
    __device__ __forceinline__ void fused(pg8::f32x4 (&acc)[2][2][4][2], const pg8::Unit& u, int wr, int wc, int fr, int fq, LAS unsigned char* lds, int wid, int lane) const {
        panel_rms<true>(acc, u, wr, wc, fr, fq, lds, wid, lane, xin, xout, modg, slots, cnt);
        const LAS float* S = (const LAS float*)(lds + 4096); const int w = u.pm >> 5; const int cb = u.pn * 256 + wc * 32 + 8 * fq;
        f32x4 gm[2][2], shv[2][2];
#pragma unroll
        for (int bj = 0; bj < 2; ++bj)
#pragma unroll
            for (int n = 0; n < 2; ++n) { const int c = cb + bj * 128 + 4 * n; const f32x4 g4 = *(const f32x4*)(gn + c), s4 = *(const f32x4*)(modn + w * 6144 + 4096 + c);
                shv[bj][n] = *(const f32x4*)(modn + w * 6144 + 3072 + c); gm[bj][n] = (f32x4){g4[0] * (1.f + s4[0]), g4[1] * (1.f + s4[1]), g4[2] * (1.f + s4[2]), g4[3] * (1.f + s4[3])}; }
#pragma unroll
        for (int ai = 0; ai < 2; ++ai)
#pragma unroll
            for (int m = 0; m < 4; ++m) { const int r = ai * 128 + wr * 64 + m * 16 + fr; const float rs = S[r]; bf16* o = hout + (size_t)(u.pm * 256 + r) * D + cb;
#pragma unroll
                for (int bj = 0; bj < 2; ++bj) { const pg8::f32x4 a0 = acc[ai][bj][m][0], a1 = acc[ai][bj][m][1]; const f32x4 g0 = gm[bj][0], g1 = gm[bj][1], h0 = shv[bj][0], h1 = shv[bj][1];
                    u32x4 pk; pk.x = pg8::cvt_pk_bf16(a0[0] * rs * g0[0] + h0[0], a0[1] * rs * g0[1] + h0[1]); pk.y = pg8::cvt_pk_bf16(a0[2] * rs * g0[2] + h0[2], a0[3] * rs * g0[3] + h0[3]);
                    pk.z = pg8::cvt_pk_bf16(a1[0] * rs * g1[0] + h1[0], a1[1] * rs * g1[1] + h1[1]); pk.w = pg8::cvt_pk_bf16(a1[2] * rs * g1[2] + h1[2], a1[3] * rs * g1[3] + h1[3]);
                    *(u32x4*)(o + bj * 128) = pk; } }
    }
};
struct EpiUp {
    static constexpr bool PERM = true, AFTER_DRAIN = false;
    bf16* ACT; const float* cw; const float* cb;
    __device__ __forceinline__ void operator()(const pg8::f32x4 (&acc)[2][2][4][2], const pg8::Unit& u, int wr, int wc, int fr, int fq) const {
        const int hc0 = u.pn * 128 + wc * 32 + 8 * fq;
#pragma unroll
        for (int ai = 0; ai < 2; ++ai) { const int blk = ai * 2 + wr;
            float res[4][8];
#pragma unroll
            for (int n = 0; n < 2; ++n) {
                const f32x4 w0 = *(const f32x4*)(cw + hc0 + 4 * n), w1 = *(const f32x4*)(cw + DFF + hc0 + 4 * n), w2 = *(const f32x4*)(cw + 2 * DFF + hc0 + 4 * n), bb = *(const f32x4*)(cb + hc0 + 4 * n);
#pragma unroll
                for (int e = 0; e < 4; ++e) {
                    float xs[4], ps[4], ns[4]; const float bprev = 0.f, bnext = 0.f;
#pragma unroll
                    for (int m = 0; m < 4; ++m) { xs[m] = acc[ai][0][m][n][e]; ps[m] = __builtin_bit_cast(float, __builtin_amdgcn_update_dpp(0, __builtin_bit_cast(int, xs[m]), 0x121, 0xf, 0xf, false)); ns[m] = __builtin_bit_cast(float, __builtin_amdgcn_update_dpp(0, __builtin_bit_cast(int, xs[m]), 0x12f, 0xf, 0xf, false)); }
#pragma unroll
                    for (int m = 0; m < 4; ++m) {
                        const float oldp = (m > 0) ? ps[m > 0 ? m - 1 : 0] : bprev, oldn = (m < 3) ? ns[m < 3 ? m + 1 : 3] : bnext;
                        const float prev = __builtin_bit_cast(float, __builtin_amdgcn_update_dpp(__builtin_bit_cast(int, oldp), __builtin_bit_cast(int, xs[m]), 0x111, 0xf, 0xf, false));
                        const float next = __builtin_bit_cast(float, __builtin_amdgcn_update_dpp(__builtin_bit_cast(int, oldn), __builtin_bit_cast(int, xs[m]), 0x101, 0xf, 0xf, false));
                        const float a = w0[e] * prev + w1[e] * xs[m] + w2[e] * next + bb[e];
                        res[m][4 * n + e] = silu_f(a) * acc[ai][1][m][n][e];
                    }
                }
            }
#pragma unroll
            for (int m = 0; m < 4; ++m) { const int r = u.pm * 256 + ai * 128 + wr * 64 + m * 16 + fr;
                u32x4 w; w.x = pg8::cvt_pk_bf16(res[m][0], res[m][1]); w.y = pg8::cvt_pk_bf16(res[m][2], res[m][3]); w.z = pg8::cvt_pk_bf16(res[m][4], res[m][5]); w.w = pg8::cvt_pk_bf16(res[m][6], res[m][7]);
                *(u32x4*)(ACT + (size_t)r * DFF + hc0) = w; }
        }
    }
};
struct EpiUpCtx {
    static constexpr bool PERM = true, AFTER_DRAIN = false;
    bf16* ACT; const float* cw; const float* cb; LAS float* ex;
    __device__ __forceinline__ void operator()(const pg8::f32x4 (&acc)[2][2][4][2], const pg8::Unit& u, int wr, int wc, int fr, int fq) const {
        const int hc0 = u.pn * 128 + wc * 32 + 8 * fq;
            const int colw = wc * 32 + 8 * fq;
#pragma unroll
            for (int ai = 0; ai < 2; ++ai) { const int blk = ai * 2 + wr;
                if (fr == 0) {
#pragma unroll
                    for (int n = 0; n < 2; ++n)
#pragma unroll
                        for (int e = 0; e < 4; ++e) ex[(blk * 2 + 0) * 128 + colw + 4 * n + e] = acc[ai][0][0][n][e]; }
                if (fr == 15) {
#pragma unroll
                    for (int n = 0; n < 2; ++n)
#pragma unroll
                        for (int e = 0; e < 4; ++e) ex[(blk * 2 + 1) * 128 + colw + 4 * n + e] = acc[ai][0][3][n][e]; } }
            asm volatile("s_waitcnt lgkmcnt(0)" ::: "memory"); __builtin_amdgcn_s_barrier(); asm volatile("" ::: "memory");
#pragma unroll
            for (int ai = 0; ai < 2; ++ai) { const int blk = ai * 2 + wr;
                float res[4][8];
    #pragma unroll
                for (int n = 0; n < 2; ++n) {
                    const f32x4 w0 = *(const f32x4*)(cw + hc0 + 4 * n), w1 = *(const f32x4*)(cw + DFF + hc0 + 4 * n), w2 = *(const f32x4*)(cw + 2 * DFF + hc0 + 4 * n), bb = *(const f32x4*)(cb + hc0 + 4 * n);
    #pragma unroll
                    for (int e = 0; e < 4; ++e) {
                        float xs[4], ps[4], ns[4]; float bprev = 0.f, bnext = 0.f; if (blk > 0) bprev = ex[((blk - 1) * 2 + 1) * 128 + colw + 4 * n + e]; if (blk < 3) bnext = ex[((blk + 1) * 2 + 0) * 128 + colw + 4 * n + e];
    #pragma unroll
                        for (int m = 0; m < 4; ++m) { xs[m] = acc[ai][0][m][n][e]; ps[m] = __builtin_bit_cast(float, __builtin_amdgcn_update_dpp(0, __builtin_bit_cast(int, xs[m]), 0x121, 0xf, 0xf, false)); ns[m] = __builtin_bit_cast(float, __builtin_amdgcn_update_dpp(0, __builtin_bit_cast(int, xs[m]), 0x12f, 0xf, 0xf, false)); }
    #pragma unroll
                        for (int m = 0; m < 4; ++m) {
                            const float prev = (fr > 0) ? ps[m] : (m > 0 ? ps[m > 0 ? m - 1 : 0] : bprev);
                            const float next = (fr < 15) ? ns[m] : (m < 3 ? ns[m < 3 ? m + 1 : 3] : bnext);
                            const float a = w0[e] * prev + w1[e] * xs[m] + w2[e] * next + bb[e];
                            res[m][4 * n + e] = silu_f(a) * acc[ai][1][m][n][e];
                        }
                    }
                }
    #pragma unroll
                for (int m = 0; m < 4; ++m) { const int r = u.pm * 256 + ai * 128 + wr * 64 + m * 16 + fr;
                    u32x4 w; w.x = pg8::cvt_pk_bf16(res[m][0], res[m][1]); w.y = pg8::cvt_pk_bf16(res[m][2], res[m][3]); w.z = pg8::cvt_pk_bf16(res[m][4], res[m][5]); w.w = pg8::cvt_pk_bf16(res[m][6], res[m][7]);
                    *(u32x4*)(ACT + (size_t)r * DFF + hc0) = w; }
            }

    }
};
struct CtxOrder {
    int nN, c, c0;
    __device__ void init(int N, int c_, int c0_) { nN = N / 256; c = c_; c0 = c0_; }
    __device__ bool next(int i, pg8::Unit& u) const { const int j = c - c0; if (i > 0 || j < 0 || j >= 2 * nN) return false; u.pm = 64 + (j & 1); u.pn = j >> 1; u.ks = 0; return true; }
    __device__ __forceinline__ void a_ready(const pg8::Unit&) const {}
    __device__ __forceinline__ void done(const pg8::Unit&) const {}
};

struct SplitOrder {
    int nunits, G, c;
    __device__ void init(int nks, int G_, int c_) { nunits = 8 * nks; G = G_; c = c_; }
    __device__ bool next(int i, pg8::Unit& u) const { const int id = i * G + c; if (id >= nunits) return false; u.pm = 64 + (id & 1); u.pn = (id >> 1) & 3; u.ks = id >> 3; return true; }
    __device__ __forceinline__ void a_ready(const pg8::Unit&) const {}
    __device__ __forceinline__ void done(const pg8::Unit&) const {}
};
struct EpiPartial {
    static constexpr bool PERM = false, AFTER_DRAIN = false;
    float* part;
    __device__ __forceinline__ void operator()(const pg8::f32x4 (&acc)[2][2][4][2], const pg8::Unit& u, int wr, int wc, int fr, int fq) const {
#pragma unroll
        for (int ai = 0; ai < 2; ++ai)
#pragma unroll
            for (int m = 0; m < 4; ++m) { const int r = u.pm * 256 + ai * 128 + wr * 64 + m * 16 + fr; float* o = part + ((size_t)u.ks * MC + (size_t)(r - ML)) * D;
#pragma unroll
                for (int bj = 0; bj < 2; ++bj)
#pragma unroll
                    for (int n = 0; n < 2; ++n) { const int c = u.pn * 256 + bj * 128 + wc * 32 + 16 * n + 4 * fq; const pg8::f32x4 a = acc[ai][bj][m][n];
                        *(f32x4*)(o + c) = (f32x4){a[0], a[1], a[2], a[3]}; } }
    }
};
typedef __attribute__((address_space(1))) unsigned gu32;
#define XB_TMO      128
#define XB_XCNT(j)  (256  + 64 * (j))
#define XB_XSUB(j)  (1280 + 64 * (j))
#define XB_XGEN(j)  (2304 + 64 * (j))
#define XB_TOP      3328
#define XB_TOPGEN   3392
#define XCD_BAR_WORDS 3456
#define XB_SPIN_CAP (1u << 18)

__device__ __forceinline__ unsigned xb_ld(unsigned* p)              { return __hip_atomic_load(p, __ATOMIC_RELAXED, __HIP_MEMORY_SCOPE_AGENT); }
__device__ __forceinline__ unsigned xb_add(unsigned* p, unsigned v) { return __hip_atomic_fetch_add(p, v, __ATOMIC_RELAXED, __HIP_MEMORY_SCOPE_AGENT); }
__device__ __forceinline__ unsigned xb_xcc_id() { return (unsigned)__builtin_amdgcn_s_getreg((3 << 11) | 20) & 0xFu; }
#define XB_SPIN(cond, bar) do { unsigned _sp = 0; while (cond) { __builtin_amdgcn_s_sleep(1); \
    if ((++_sp & 255u) == 0u) { if (xb_ld(&(bar)[XB_TMO])) break; if (_sp > XB_SPIN_CAP) { atomicAdd(&(bar)[XB_TMO], 1u); break; } } } } while (0)

struct XcdBarrier {
    unsigned* bar; unsigned x;
    volatile LAS unsigned* st;
};

__device__ __forceinline__ XcdBarrier xcd_barrier_post(unsigned* bar, volatile LAS unsigned* st, int tid_) {
    XcdBarrier b; b.bar = bar; b.x = xb_xcc_id(); b.st = st;
    if (tid_ == 0) (void)xb_add(&bar[XB_XCNT(b.x)], 1u);
    return b;
}
__device__ __forceinline__ void xcd_barrier_complete(unsigned* bar, unsigned x, unsigned& nloc, unsigned& nx) {
    const unsigned G = gridDim.x * gridDim.y * gridDim.z;
    unsigned sum, cnt, mine, sp = 0u;
    for (;;) {
        sum = 0u; cnt = 0u; mine = 0u;
#pragma unroll
        for (unsigned j = 0; j < 16; ++j) { const unsigned c = xb_ld(&bar[XB_XCNT(j)]); sum += c; cnt += (c > 0u) ? 1u : 0u; mine = (j == x) ? c : mine; }
        if (sum == G) break;
        __builtin_amdgcn_s_sleep(1);
        if ((++sp & 255u) == 0u) { if (xb_ld(&bar[XB_TMO])) break; if (sp > XB_SPIN_CAP) { atomicAdd(&bar[XB_TMO], 1u); break; } }
    }
    nloc = mine > 0u ? mine : 1u; nx = cnt > 0u ? cnt : 1u;
}

__device__ __forceinline__ void xcd_barrier(const XcdBarrier& b, int tid_) {
    asm volatile("s_waitcnt vmcnt(0)" ::: "memory");
    __syncthreads();
    if (tid_ == 0) {
        unsigned* bar = b.bar; asm volatile("" : "+s"(bar)); unsigned bx = (unsigned)__builtin_amdgcn_readfirstlane((int)b.x); asm volatile("" : "+s"(bx));
        __builtin_amdgcn_s_waitcnt(0);
        unsigned nloc = b.st[0], nx = b.st[1];
        if (nloc == 0u) { xcd_barrier_complete(bar, bx, nloc, nx); b.st[0] = nloc; b.st[1] = nx; }
        const unsigned old = xb_add(&bar[XB_XSUB(bx)], 1u);
        const unsigned gen = old / nloc;
        if (old + 1u == (gen + 1u) * nloc) {
            __builtin_amdgcn_fence(__ATOMIC_RELEASE, "agent");
            asm volatile("s_waitcnt vmcnt(0)" ::: "memory");
            const unsigned og = xb_add(&bar[XB_TOP], 1u);
            const unsigned tg = og / nx;
            if (og + 1u == (tg + 1u) * nx) xb_add(&bar[XB_TOPGEN], 1u);
            else XB_SPIN(xb_ld(&bar[XB_TOPGEN]) == tg, bar);
            __builtin_amdgcn_fence(__ATOMIC_ACQUIRE, "agent");
            xb_add(&bar[XB_XGEN(bx)], 1u);
            asm volatile("s_waitcnt vmcnt(0)" ::: "memory");
        } else {
            XB_SPIN(xb_ld(&bar[XB_XGEN(bx)]) == gen, bar);
            __builtin_amdgcn_fence(__ATOMIC_ACQUIRE, "agent");
            asm volatile("s_waitcnt vmcnt(0)" ::: "memory");
        }
    }
    __syncthreads();
}
struct Ctx {
    LAS unsigned char* lds; int tid, lane, wave, G, gw, NGW;
    float* MOD; float* MCS; bf16 *F1, *F2, *FC; bf16 *HX, *YMIX, *PB, *ACT, *TB, *CAU; float *XC, *ST, *DEC;
};
__device__ __forceinline__ bf16* win_t(PP p, int l) { return (bf16*)(p->ws + WS_W + (size_t)l * W_LAYER_B); }
__device__ __forceinline__ bf16* wout_t(PP p, int l) { return (bf16*)(p->ws + WS_W + (size_t)l * W_LAYER_B + W_IN_B); }
__device__ __forceinline__ bf16* wup_t(PP p, int l) { return (bf16*)(p->ws + WS_W + (size_t)l * W_LAYER_B + W_IN_B + W_OUT_B); }
__device__ __forceinline__ bf16* wdn_t(PP p, int l) { return (bf16*)(p->ws + WS_W + (size_t)l * W_LAYER_B + W_IN_B + W_OUT_B + W_UP_B); }

__device__ __forceinline__ void transpose_item(const float* W, int K, int N, bf16* WT, int k0, int n0, int dst0, float scale, LAS float* scr, int lane) {
#pragma unroll
    for (int i = 0; i < 32; ++i) { const int kk = 2 * i + (lane >> 5); scr[kk * 33 + (lane & 31)] = W[(size_t)(k0 + kk) * N + n0 + (lane & 31)] * scale; }
    LDS_WAIT(); __builtin_amdgcn_wave_barrier();
    const int c = lane & 7;
#pragma unroll
    for (int j = 0; j < 4; ++j) { const int n = (lane >> 3) + 8 * j; const LAS float* s = scr + (8 * c) * 33 + n;
        u32x4 o; o.x = pk2(s[0 * 33], s[1 * 33]); o.y = pk2(s[2 * 33], s[3 * 33]); o.z = pk2(s[4 * 33], s[5 * 33]); o.w = pk2(s[6 * 33], s[7 * 33]);
        *(u32x4*)(WT + (size_t)(dst0 + n) * K + k0 + 8 * c) = o; }
    LDS_WAIT(); __builtin_amdgcn_wave_barrier();
}

__device__ __forceinline__ void phase0(PP p, Ctx& F) {
    LAS float* sv = (LAS float*)F.lds; LAS float* red = sv + 3072;
    for (int i = F.tid; i < 3072; i += 512) { const int w = i >> 10, k = i & 1023; const float cv = (w < 2) ? p->c[w * 1024 + k] : p->c_ctx[k]; sv[i] = cv / (1.f + expf(-cv)); }
    __syncthreads();
    for (int it = blockIdx.x; it < 192; it += F.G) {
        const int l = it / 96, c0 = (it % 96) * 64; const float* W = p->w_mod + (size_t)l * 1024 * 6144 + c0 + F.lane;
        float a0 = 0.f, a1 = 0.f, a2 = 0.f; const int kb = F.wave * 128;
#pragma unroll 32
        for (int k = 0; k < 128; ++k) { const float wv = W[(size_t)(kb + k) * 6144]; a0 += sv[kb + k] * wv; a1 += sv[1024 + kb + k] * wv; a2 += sv[2048 + kb + k] * wv; }
        red[(F.wave * 3 + 0) * 64 + F.lane] = a0; red[(F.wave * 3 + 1) * 64 + F.lane] = a1; red[(F.wave * 3 + 2) * 64 + F.lane] = a2;
        __syncthreads();
        if (F.tid < 192) { const int w = F.tid >> 6, ln = F.tid & 63; float s = 0.f;
#pragma unroll
            for (int q = 0; q < 8; ++q) s += red[(q * 3 + w) * 64 + ln];
            F.MOD[(l * 3 + w) * 6144 + c0 + ln] = s + p->b_mod[l * 6144 + c0 + ln]; }
        __syncthreads();
    }
    __syncthreads();
    LAS float* scr = (LAS float*)(F.lds + F.wave * 16384);
    constexpr int I_IN = 48 * 16, I_OUT = 32 * 16, I_UP = 176 * 16, I_DN = 32 * 44, I_L = I_IN + I_OUT + I_UP + I_DN;
    for (int it = F.gw; it < 2 * I_L; it += F.NGW) {
        const int l = it / I_L; int r = it % I_L;
        if (r < I_IN) { const int cb = r / 16, kb = r % 16; int src, dst; float sc = 1.f;
            if (cb < 4) { src = 32 * cb; dst = PK + 32 * cb; }
            else if (cb < 8) { src = 416 + 32 * (cb - 4); dst = PQ + 32 * (cb - 4); sc = 0.17677669529663687f; }
            else if (cb < 16) { src = 128 + 32 * (cb - 8); dst = PV + 32 * (cb - 8); }
            else if (cb < 24) { src = 544 + 32 * (cb - 16); dst = PG + 32 * (cb - 16); }
            else if (cb < 32) { src = 1056 + 32 * (cb - 24); dst = PH + 32 * (cb - 24); }
            else if (cb < 40) { src = 1312 + 32 * (cb - 32); dst = PBG + 32 * (cb - 32); }
            else { src = 1568 + 32 * (cb - 40); dst = PCG + 32 * (cb - 40); }
            transpose_item(p->w_in + (size_t)l * D * DIN, D, DIN, win_t(p, l), 64 * kb, src, dst, sc, scr, F.lane); continue; }
        r -= I_IN;
        if (r < I_OUT) { const int cb = r / 16, kb = r % 16; transpose_item(p->w_out + (size_t)l * D * D, D, D, wout_t(p, l), 64 * kb, 32 * cb, 32 * cb, 1.f, scr, F.lane); continue; }
        r -= I_OUT;
        if (r < I_UP) { const int cb = r / 16, kb = r % 16; const int c = 32 * cb, isu = (c >= DFF) ? 1 : 0, j = c - isu * DFF; const int dst = (j / 128) * 256 + isu * 128 + (j % 128);
            transpose_item(p->w_up + (size_t)l * D * NUP, D, NUP, wup_t(p, l), 64 * kb, c, dst, 1.f, scr, F.lane); continue; }
        r -= I_UP;
        { const int cb = r / 44, kb = r % 44; transpose_item(p->w_down + (size_t)l * DFF * D, DFF, D, wdn_t(p, l), 64 * kb, 32 * cb, 32 * cb, 1.f, scr, F.lane); }
    }
    const int gt = blockIdx.x * 512 + F.tid, NT = F.G * 512;
    const int gtm = (F.G == 256) ? ((int)blockIdx.x - 192) * 512 + F.tid : gt; const int NTm = (F.G == 256) ? 32768 : NT;
    for (int i = gtm; i >= 0 && i < 32768; i += NTm) { const int d = i & 63, c = (i >> 6) & 63, g = (i >> 12) & 3, l = i >> 14;
        const float* wf = p->fft_w + (size_t)((l * 4 + g) * 64) * 64 + d; float mc = 0.f, ms = 0.f;
        for (int f = 0; f < 64; ++f) { const float a = (float)((f * c) & 63) * (1.f / 64.f); const float w = wf[f * 64]; mc += cos_rev(a) * w; ms -= sin_rev(a) * w; }
        F.MCS[(((l * 4 + g) * 2 + 0) * 64 + c) * 64 + d] = mc * 0.125f; F.MCS[(((l * 4 + g) * 2 + 1) * 64 + c) * 64 + d] = ms * 0.125f; }
    for (int i = gt; i < MC * D / 4; i += NT) ((f32x4*)F.XC)[i] = ((const f32x4*)p->ctx)[i];
    for (int i = gt; i < 180224; i += NT) {
        if (i < 16384) { const int mm = i >> 7, kk = i & 127, k1 = mm & 63, n1 = kk & 63; const float a = (float)((k1 * n1) & 63) * (1.f / 64.f); const float C = cos_rev(a), S = sin_rev(a);
            const float v = (mm < 64) ? (kk < 64 ? C : S) : (kk < 64 ? -S : C); F.F1[i] = (bf16)f2bf(v); }
        else if (i < 49152) { const int j = i - 16384, k2 = j >> 8, kk = j & 255, n2 = kk & 127; const float a = (float)((k2 * n2) & 127) * (1.f / 128.f);
            const float v = (kk < 128 ? cos_rev(a) : sin_rev(a)) * 0.011048543456039806f; F.F2[j] = (bf16)f2bf(v); }
        else { const int j = i - 49152, k = j >> 9, kk = j & 511, n = kk & 255; const float a = (float)((k * n) & 255) * (1.f / 256.f);
            const float v = (kk < 256 ? cos_rev(a) : sin_rev(a)) * 0.0625f; F.FC[j] = (bf16)f2bf(v); }
    }
}

__device__ __forceinline__ void fold_items(PP p, Ctx& F) {
    for (int it4 = F.gw; it4 < 1792; it4 += F.NGW) {
        const int dq = it4 & 3, it = it4 >> 2;
        const int l = it / 224, r = it % 224, s = r / 16, kb = r % 16; const int k = 64 * kb + F.lane;
        const float* wrow = p->w_in + (size_t)l * D * DIN + (size_t)k * DIN; bf16* WT = win_t(p, l);
        if (s < 2) {
            const f32x4* src = (const f32x4*)(wrow + 384 + 16 * s); f32x4 r4[4];
#pragma unroll
            for (int q = 0; q < 4; ++q) r4[q] = src[q];
            const float* M = p->w_a2 + (size_t)((l * 2 + s) * 16) * 128;
            for (int d = 32 * dq; d < 32 * dq + 32; ++d) { float a = 0.f;
#pragma unroll
                for (int c = 0; c < 16; ++c) a += r4[c >> 2][c & 3] * M[c * 128 + d];
                WT[(size_t)(PLA + s * 128 + d) * D + k] = (bf16)f2bf(a); }
        } else {
            const int kind = (s - 2) >> 2, g = (s - 2) & 3;
            const f32x4* src = (const f32x4*)(wrow + (kind < 2 ? 800 : 1824) + 64 * g); f32x4 r4[16];
#pragma unroll
            for (int q = 0; q < 16; ++q) r4[q] = src[q];
            const float* M = (kind < 2) ? (F.MCS + (size_t)(((l * 4 + g) * 2 + kind) * 64) * 64) : (p->pool_w + (size_t)((l * 4 + g) * 64) * 64);
            const int drow = (kind == 0 ? PFA : (kind == 1 ? PFB : PPOOL)) + 64 * g;
            for (int d = 16 * dq; d < 16 * dq + 16; ++d) { float a = 0.f;
#pragma unroll
                for (int c = 0; c < 64; ++c) a += r4[c >> 2][c & 3] * M[c * 64 + d];
                if (kind == 2) a *= p->pool_scale[l * 256 + g * 64 + d];
                WT[(size_t)(drow + d) * D + k] = (bf16)f2bf(a); }
        }
    }
}

__device__ __forceinline__ void norm_row_bf16(const float* xrow, bf16* orow, const float* g, const float* sc, const float* sh, int lane, const float* part, int nparts, const float* gate, float* xout) {
    f32x4 v[4]; float s = 0.f;
#pragma unroll
    for (int j = 0; j < 4; ++j) v[j] = ((const f32x4*)xrow)[lane + 64 * j];
    if (nparts > 0) {
        f32x4 a[4];
#pragma unroll
        for (int j = 0; j < 4; ++j) a[j] = (f32x4){0.f, 0.f, 0.f, 0.f};
        for (int q = 0; q < nparts; ++q) {
#pragma unroll
            for (int j = 0; j < 4; ++j) { const f32x4 t = ((const f32x4*)(part + (size_t)q * MC * D))[lane + 64 * j]; a[j][0] += t[0]; a[j][1] += t[1]; a[j][2] += t[2]; a[j][3] += t[3]; } }
#pragma unroll
        for (int j = 0; j < 4; ++j) { const f32x4 gv = ((const f32x4*)gate)[lane + 64 * j];
#pragma unroll
            for (int e = 0; e < 4; ++e) v[j][e] += gv[e] * a[j][e];
            ((f32x4*)xout)[lane + 64 * j] = v[j]; }
    }
#pragma unroll
    for (int j = 0; j < 4; ++j) s += (v[j][0] * v[j][0] + v[j][1] * v[j][1]) + (v[j][2] * v[j][2] + v[j][3] * v[j][3]);
    const float rstd = 1.f / sqrtf(wave_sum(s, lane) * (1.f / D) + EPS);
#pragma unroll
    for (int j = 0; j < 4; ++j) { const int idx = lane + 64 * j; const f32x4 gv = ((const f32x4*)g)[idx], scv = ((const f32x4*)sc)[idx], shv = ((const f32x4*)sh)[idx];
        float y[4];
#pragma unroll
        for (int e = 0; e < 4; ++e) y[e] = v[j][e] * rstd * gv[e] * (1.f + scv[e]) + shv[e];
        u32x2 o; o.x = pk2(y[0], y[1]); o.y = pk2(y[2], y[3]); ((u32x2*)orow)[idx] = o; }
}
template <bool FINAL, bool INB>
__device__ __forceinline__ void norm_rows4(const void* xbase, bf16* obase, float* fout, const float* g, const float* modl, int which, int m0, int stride, int lane) {
    f32x4 v[4][4]; float s[4]; int mk[4]; bool ok[4];
#pragma unroll
    for (int k = 0; k < 4; ++k) { const int m = m0 + k * stride; ok[k] = m < ML; mk[k] = ok[k] ? m : ML - 1;
#pragma unroll
        for (int j = 0; j < 4; ++j) {
            if (INB) { const u32x2 t = ((const u32x2*)((const bf16*)xbase + (size_t)mk[k] * D))[lane + 64 * j]; v[k][j] = (f32x4){bflo(t.x), bfhi(t.x), bflo(t.y), bfhi(t.y)}; }
            else v[k][j] = ((const f32x4*)((const float*)xbase + (size_t)mk[k] * D))[lane + 64 * j]; } }
    f32x4 gm[4], sh4[4];
    { const float* mod = FINAL ? g : modl + (m0 >> 13) * 6144 + which * 3072;
#pragma unroll
      for (int j = 0; j < 4; ++j) { const int idx = lane + 64 * j; const f32x4 gv = ((const f32x4*)g)[idx];
          if (FINAL) { gm[j] = gv; sh4[j] = (f32x4){0.f, 0.f, 0.f, 0.f}; }
          else { const f32x4 scv = ((const f32x4*)(mod + 1024))[idx]; sh4[j] = ((const f32x4*)mod)[idx];
#pragma unroll
              for (int e = 0; e < 4; ++e) gm[j][e] = gv[e] * (1.f + scv[e]); } } }
#pragma unroll
    for (int k = 0; k < 4; ++k) { float a = 0.f;
#pragma unroll
        for (int j = 0; j < 4; ++j) a += (v[k][j][0] * v[k][j][0] + v[k][j][1] * v[k][j][1]) + (v[k][j][2] * v[k][j][2] + v[k][j][3] * v[k][j][3]);
        s[k] = a; }
#pragma unroll
    for (int o = 1; o < 64; o <<= 1) {
#pragma unroll
        for (int k = 0; k < 4; ++k) s[k] += shfl_f(s[k], lane ^ o); }
#pragma unroll
    for (int k = 0; k < 4; ++k) { if (!ok[k]) continue;
        const float rstd = 1.f / sqrtf(s[k] * (1.f / D) + EPS);
#pragma unroll
        for (int j = 0; j < 4; ++j) { const int idx = lane + 64 * j;
            if (FINAL) { f32x4 y;
#pragma unroll
                for (int e = 0; e < 4; ++e) y[e] = v[k][j][e] * rstd * gm[j][e];
                ((f32x4*)(fout + (size_t)mk[k] * D))[idx] = y; }
            else { float y[4];
#pragma unroll
                for (int e = 0; e < 4; ++e) y[e] = v[k][j][e] * rstd * gm[j][e] + sh4[j][e];
                u32x2 o; o.x = pk2(y[0], y[1]); o.y = pk2(y[2], y[3]); ((u32x2*)(obase + (size_t)mk[k] * D))[idx] = o; } }
    }
}
__device__ __forceinline__ void norm_phase(PP p, Ctx& F, int l, int which, int mrows) {
    const float* g = (which == 0 ? p->norm1_g : p->norm2_g) + l * D;
    const float* PART = (const float*)(p->ws + WS_PART);
    if (l == 0 && which == 0) { for (int m0 = F.gw; m0 < ML; m0 += 4 * F.NGW) norm_rows4<false, false>(p->x, F.HX, nullptr, g, F.MOD + l * 3 * 6144, which, m0, F.NGW, F.lane); }
    else { const void* xb = (l == 1 && which == 1 && F.G == 256) ? (const void*)(p->ws + WS_XB2) : (const void*)p->out;
        for (int m0 = F.gw; m0 < ML; m0 += 4 * F.NGW) norm_rows4<false, true>(xb, F.HX, nullptr, g, F.MOD + l * 3 * 6144, which, m0, F.NGW, F.lane); }
    for (int m = ML + F.gw; m < mrows; m += F.NGW) {
        int nparts = 0; const float* gate = nullptr;
        const float* xr = ((l == 0 && which == 0) ? p->ctx : F.XC) + (size_t)(m - ML) * D;
        if (l == 0 && which == 1) { nparts = 4; gate = F.MOD + 2 * 6144 + 2048; }
        if (l == 1 && which == 0) { nparts = 11; gate = F.MOD + 2 * 6144 + 5120; }
        const float* part = PART + (size_t)(m - ML) * D; float* xout = F.XC + (size_t)(m - ML) * D;
        const float* mod = F.MOD + (l * 3 + 2) * 6144 + which * 3072;
        norm_row_bf16(xr, F.HX + (size_t)m * D, g, mod + 1024, mod, F.lane, part, nparts, gate, xout);
    }
}
__device__ __forceinline__ void final_norm(PP p, Ctx& F) {
    for (int m0 = F.gw; m0 < ML; m0 += 4 * F.NGW) norm_rows4<true, false>(p->ws + WS_HX  , nullptr, p->out, p->final_g, nullptr, 0, m0, F.NGW, F.lane);
}
constexpr int CP = 260;
__device__ __forceinline__ int chunk_row0(int b, int cidx) { return (cidx < 4) ? (ML + b * CTXL + cidx * 64) : (b * SEQ + (cidx - 4) * 64); }
__device__ __forceinline__ void cum_to_lds(LAS float* cum, const bf16* PB, int row0, int tid) {
    { const int oct = tid & 31, j0 = tid >> 5; u32x4 w[4];
#pragma unroll
      for (int q = 0; q < 4; ++q) w[q] = *(const u32x4*)(PB + (size_t)(row0 + j0 + 16 * q) * NP + PLA + 8 * oct);
#pragma unroll
      for (int q = 0; q < 4; ++q) { LAS float* d = cum + (j0 + 16 * q) * CP + 8 * oct;
          *(LAS f32x4*)d = (f32x4){bflo(w[q].x), bfhi(w[q].x), bflo(w[q].y), bfhi(w[q].y)}; *(LAS f32x4*)(d + 4) = (f32x4){bflo(w[q].z), bfhi(w[q].z), bflo(w[q].w), bfhi(w[q].w)}; } }
    __syncthreads();
    if (tid < 256) { float s = 0.f;
        if (tid < 128) {
#pragma unroll 16
            for (int j = 0; j < 64; ++j) { s += cum[j * CP + tid]; cum[j * CP + tid] = s; }
        } else {
#pragma unroll 16
            for (int j = 63; j >= 0; --j) { s += cum[j * CP + tid]; cum[j * CP + tid] = s; }
        } }
    __syncthreads();
}
typedef float f32x2_t __attribute__((ext_vector_type(2)));
typedef __bf16 bf16x2_t __attribute__((ext_vector_type(2)));
__device__ __forceinline__ unsigned pkh(float lo, float hi) { f32x2_t v = {lo, hi}; bf16x2_t b = __builtin_convertvector(v, bf16x2_t); return __builtin_bit_cast(unsigned, b); }
__device__ __forceinline__ bf16x8 pack8h(float a0, float a1, float a2, float a3, float a4, float a5, float a6, float a7) {
    u32x4 w; w.x = pkh(a0, a1); w.y = pkh(a2, a3); w.z = pkh(a4, a5); w.w = pkh(a6, a7); return __builtin_bit_cast(bf16x8, w);
}
__device__ __forceinline__ void la_load(u32x4 (&w)[4], const bf16* PB, int row0, int tid) {
    const int oct = tid & 31, j0 = tid >> 5;
#pragma unroll
    for (int q = 0; q < 4; ++q) w[q] = *(const u32x4*)(PB + (size_t)(row0 + j0 + 16 * q) * NP + PLA + 8 * oct);
}
__device__ __forceinline__ void la_scan(LAS float* cum, const u32x4 (&w)[4], int tid) {
    const int oct = tid & 31, j0 = tid >> 5;
#pragma unroll
    for (int q = 0; q < 4; ++q) { LAS float* d = cum + (j0 + 16 * q) * CP + 8 * oct;
        *(LAS f32x4*)d = (f32x4){bflo(w[q].x), bfhi(w[q].x), bflo(w[q].y), bfhi(w[q].y)}; *(LAS f32x4*)(d + 4) = (f32x4){bflo(w[q].z), bfhi(w[q].z), bflo(w[q].w), bfhi(w[q].w)}; }
    __syncthreads();
    if (tid < 256) { float carry = 0.f;
        if (tid < 128) {
#pragma unroll
            for (int hf = 0; hf < 4; ++hf) { float v[16];
#pragma unroll
                for (int j = 0; j < 16; ++j) v[j] = cum[(16 * hf + j) * CP + tid];
                v[0] += carry;
#pragma unroll
                for (int j = 1; j < 16; ++j) v[j] += v[j - 1];
                carry = v[15];
#pragma unroll
                for (int j = 0; j < 16; ++j) cum[(16 * hf + j) * CP + tid] = v[j]; }
        } else {
#pragma unroll
            for (int hf = 3; hf >= 0; --hf) { float v[16];
#pragma unroll
                for (int j = 0; j < 16; ++j) v[j] = cum[(16 * hf + j) * CP + tid];
                v[15] += carry;
#pragma unroll
                for (int j = 14; j >= 0; --j) v[j] += v[j + 1];
                carry = v[0];
#pragma unroll
                for (int j = 0; j < 16; ++j) cum[(16 * hf + j) * CP + tid] = v[j]; }
        } }
    __syncthreads();
}
__device__ __forceinline__ void gla_a_item(Ctx& F, int b, int cidx) {
    LAS float* cum = (LAS float*)F.lds; const int row0 = chunk_row0(b, cidx);
    const int h = F.wave & 3, dir = F.wave >> 2, chb = dir * 128 + h * 32, lr = F.lane & 15, g = F.lane >> 4;
    const int jl = dir ? 0 : 63;
    u32x4 wla[4]; la_load(wla, F.PB, row0, F.tid);
    unsigned short kt[2][2][8], vt[2][4][8];
#pragma unroll
    for (int ks = 0; ks < 2; ++ks) { const int j0 = 32 * ks + 8 * g;
#pragma unroll
        for (int mb = 0; mb < 2; ++mb)
#pragma unroll
            for (int e = 0; e < 8; ++e) kt[ks][mb][e] = F.PB[(size_t)(row0 + j0 + e) * NP + PK + h * 32 + 16 * mb + lr];
#pragma unroll
        for (int nb = 0; nb < 4; ++nb)
#pragma unroll
            for (int e = 0; e < 8; ++e) vt[ks][nb][e] = F.PB[(size_t)(row0 + j0 + e) * NP + PV + h * 64 + 16 * nb + lr]; }
    la_scan(cum, wla, F.tid);
    f32x4 acc[2][4];
#pragma unroll
    for (int mb = 0; mb < 2; ++mb)
#pragma unroll
        for (int nb = 0; nb < 4; ++nb) acc[mb][nb] = (f32x4){0.f, 0.f, 0.f, 0.f};
#pragma unroll
    for (int ks = 0; ks < 2; ++ks) {
        bf16x8 af[2], bfr[4]; const int j0 = 32 * ks + 8 * g;
#pragma unroll
        for (int mb = 0; mb < 2; ++mb) { const int dk = 16 * mb + lr; const float last = cum[jl * CP + chb + dk]; float a[8];
#pragma unroll
            for (int e = 0; e < 8; ++e) { const int j = j0 + e; a[e] = bf2f(kt[ks][mb][e]) * __expf(last - cum[j * CP + chb + dk]); }
            af[mb] = pack8h(a[0], a[1], a[2], a[3], a[4], a[5], a[6], a[7]); }
#pragma unroll
        for (int nb = 0; nb < 4; ++nb) { const unsigned short* t = vt[ks][nb];
            u32x4 w; w.x = t[0] | ((unsigned)t[1] << 16); w.y = t[2] | ((unsigned)t[3] << 16); w.z = t[4] | ((unsigned)t[5] << 16); w.w = t[6] | ((unsigned)t[7] << 16);
            bfr[nb] = __builtin_bit_cast(bf16x8, w); }
#pragma unroll
        for (int mb = 0; mb < 2; ++mb)
#pragma unroll
            for (int nb = 0; nb < 4; ++nb) acc[mb][nb] = MFMA16(af[mb], bfr[nb], acc[mb][nb]);
    }
    const size_t sidx = (size_t)(((b * 2 + dir) * 4 + h) * NCH + cidx);
    float* st = F.ST + sidx * 2048;
#pragma unroll
    for (int mb = 0; mb < 2; ++mb)
#pragma unroll
        for (int nb = 0; nb < 4; ++nb) *(f32x4*)(st + (16 * nb + lr) * 32 + 16 * mb + 4 * g) = acc[mb][nb];
    if (F.lane < 32) F.DEC[sidx * 32 + F.lane] = __expf(cum[jl * CP + chb + F.lane]);
    __syncthreads();
}
__device__ __forceinline__ void gla_scan(Ctx& F) {
    LAS float* xa = (LAS float*)F.lds; LAS float* xb = xa + 512;
    const int seg = F.tid >> 6, el = F.tid & 63;
    for (int blk = blockIdx.x; blk < 512; blk += F.G) {
        const int ge = blk * 64 + el, e = ge & 2047, seq = ge >> 11, dir = (seq >> 2) & 1, dk = e & 31;
        float* st = F.ST + (size_t)seq * NCH * 2048 + e; const float* dc = F.DEC + (size_t)seq * NCH * 32 + dk;
        float u[17], d[17];
#pragma unroll
        for (int i = 0; i < 17; ++i) { const int s = seg * 17 + i; const bool ok = s < NCH; const int sc = ok ? s : NCH - 1; const int c = dir ? (sc < 4 ? 3 - sc : 135 - sc) : sc;
            const float uu = st[(size_t)c * 2048], dd = dc[c * 32]; u[i] = ok ? uu : 0.f; d[i] = ok ? dd : 1.f; }
        float A = 1.f, B = 0.f;
#pragma unroll
        for (int i = 0; i < 17; ++i) { B = B * d[i] + u[i]; A *= d[i]; }
        xa[F.tid] = A; xb[F.tid] = B;
        __syncthreads();
        float S = 0.f;
        for (int sg = 0; sg < seg; ++sg) S = S * xa[sg * 64 + el] + xb[sg * 64 + el];
#pragma unroll
        for (int i = 0; i < 17; ++i) { const int s = seg * 17 + i; if (s < NCH) { const int c = dir ? (s < 4 ? 3 - s : 135 - s) : s; st[(size_t)c * 2048] = S; } S = S * d[i] + u[i]; }
        __syncthreads();
    }
}
template <int NI>
__device__ __forceinline__ void gla_c_item(PP p, Ctx& F, int l, int b, int cidx, int sub) {
    LAS float* cum = (LAS float*)F.lds; const int row0 = chunk_row0(b, cidx);
    const int h = F.wave & 3, half = (NI == 2) ? (F.wave >> 2) : sub, ibase = (NI == 2) ? 0 : (F.wave >> 2), lr = F.lane & 15, g = F.lane >> 4;
    u32x4 wla[4]; la_load(wla, F.PB, row0, F.tid);
    f32x4 o[4][2];
#pragma unroll
    for (int mb = 0; mb < 4; ++mb) { o[mb][0] = (f32x4){0.f, 0.f, 0.f, 0.f}; o[mb][1] = (f32x4){0.f, 0.f, 0.f, 0.f}; }
    bf16x8 av[4][2];
#pragma unroll
    for (int mb = 0; mb < 4; ++mb)
#pragma unroll
        for (int pp = 0; pp < 2; ++pp) { unsigned short t[8];
#pragma unroll
            for (int e = 0; e < 8; ++e) { const int j = 32 * pp + (e < 4 ? 4 * g + e : 16 + 4 * g + (e - 4)); t[e] = F.PB[(size_t)(row0 + j) * NP + PV + h * 64 + 16 * mb + lr]; }
            u32x4 w; w.x = t[0] | ((unsigned)t[1] << 16); w.y = t[2] | ((unsigned)t[3] << 16); w.z = t[4] | ((unsigned)t[5] << 16); w.w = t[6] | ((unsigned)t[7] << 16);
            av[mb][pp] = __builtin_bit_cast(bf16x8, w); }
    u32x4 qraw[2], kraw[4]; f32x4 sraw[2][4][2];
#pragma unroll
    for (int ibl = 0; ibl < NI; ++ibl) qraw[ibl] = *(const u32x4*)(F.PB + (size_t)(row0 + 16 * (2 * half + ibase + ibl) + lr) * NP + PQ + h * 32 + 8 * g);
#pragma unroll
    for (int jb = 0; jb < 4; ++jb) kraw[jb] = *(const u32x4*)(F.PB + (size_t)(row0 + 16 * jb + lr) * NP + PK + h * 32 + 8 * g);
    { const float* st = F.ST + (size_t)(((b * 2 + 0) * 4 + h) * NCH + cidx) * 2048;
#pragma unroll
        for (int mb = 0; mb < 4; ++mb) { sraw[0][mb][0] = *(const f32x4*)(st + (16 * mb + lr) * 32 + 8 * g); sraw[0][mb][1] = *(const f32x4*)(st + (16 * mb + lr) * 32 + 8 * g + 4); } }
    la_scan(cum, wla, F.tid);
    { const float* st = F.ST + (size_t)(((b * 2 + 1) * 4 + h) * NCH + cidx) * 2048;
#pragma unroll
        for (int mb = 0; mb < 4; ++mb) { sraw[1][mb][0] = *(const f32x4*)(st + (16 * mb + lr) * 32 + 8 * g); sraw[1][mb][1] = *(const f32x4*)(st + (16 * mb + lr) * 32 + 8 * g + 4); } }
#pragma unroll
    for (int dir = 0; dir < 2; ++dir) {
        const int chb = dir * 128 + h * 32;
        bf16x8 bq[2];
#pragma unroll
        for (int ibl = 0; ibl < NI; ++ibl) { const int i = 16 * (2 * half + ibase + ibl) + lr;
            const u32x4 qw = qraw[ibl];
            const f32x4 c0 = *(const LAS f32x4*)(cum + i * CP + chb + 8 * g), c1 = *(const LAS f32x4*)(cum + i * CP + chb + 8 * g + 4);
            bq[ibl] = pack8h(bflo(qw.x) * __expf(c0[0]), bfhi(qw.x) * __expf(c0[1]), bflo(qw.y) * __expf(c0[2]), bfhi(qw.y) * __expf(c0[3]),
                            bflo(qw.z) * __expf(c1[0]), bfhi(qw.z) * __expf(c1[1]), bflo(qw.w) * __expf(c1[2]), bfhi(qw.w) * __expf(c1[3])); }
#pragma unroll
        for (int mb = 0; mb < 4; ++mb) { const f32x4 s0 = sraw[dir][mb][0], s1 = sraw[dir][mb][1];
            const bf16x8 as = pack8h(s0[0], s0[1], s0[2], s0[3], s1[0], s1[1], s1[2], s1[3]);
            o[mb][0] = MFMA16(as, bq[0], o[mb][0]); if (NI == 2) o[mb][1] = MFMA16(as, bq[1], o[mb][1]); }
#pragma unroll
        for (int pp = 0; pp < 2; ++pp) {
            if ((dir == 0 && half == 0 && pp == 1) || (dir == 1 && half == 1 && pp == 0)) continue;
            f32x4 sc[2][2];
#pragma unroll
            for (int q = 0; q < 2; ++q) { const int jb = 2 * pp + q, j = 16 * jb + lr;
                const u32x4 kw = kraw[jb];
                const f32x4 c0 = *(const LAS f32x4*)(cum + j * CP + chb + 8 * g), c1 = *(const LAS f32x4*)(cum + j * CP + chb + 8 * g + 4);
                const bf16x8 ak = pack8h(bflo(kw.x) * __expf(-c0[0]), bfhi(kw.x) * __expf(-c0[1]), bflo(kw.y) * __expf(-c0[2]), bfhi(kw.y) * __expf(-c0[3]),
                                        bflo(kw.z) * __expf(-c1[0]), bfhi(kw.z) * __expf(-c1[1]), bflo(kw.w) * __expf(-c1[2]), bfhi(kw.w) * __expf(-c1[3]));
#pragma unroll
                for (int ibl = 0; ibl < NI; ++ibl) { f32x4 z = (f32x4){0.f, 0.f, 0.f, 0.f}; z = MFMA16(ak, bq[ibl], z);
                    const int i = 16 * (2 * half + ibase + ibl) + lr;
#pragma unroll
                    for (int r = 0; r < 4; ++r) { const int jj = 16 * jb + 4 * g + r; const bool keep = dir ? (jj >= i) : (jj <= i); z[r] = keep ? z[r] : 0.f; }
                    sc[q][ibl] = z; } }
#pragma unroll
            for (int ibl = 0; ibl < NI; ++ibl) { const bf16x8 pb = pack8h(sc[0][ibl][0], sc[0][ibl][1], sc[0][ibl][2], sc[0][ibl][3], sc[1][ibl][0], sc[1][ibl][1], sc[1][ibl][2], sc[1][ibl][3]);
#pragma unroll
                for (int mb = 0; mb < 4; ++mb) o[mb][ibl] = MFMA16(av[mb][pp], pb, o[mb][ibl]); }
        }
    }
    const float* gg = p->gla_g + l * 64;
#pragma unroll
    for (int ibl = 0; ibl < NI; ++ibl) { float ss = 0.f;
#pragma unroll
        for (int mb = 0; mb < 4; ++mb) ss += (o[mb][ibl][0] * o[mb][ibl][0] + o[mb][ibl][1] * o[mb][ibl][1]) + (o[mb][ibl][2] * o[mb][ibl][2] + o[mb][ibl][3] * o[mb][ibl][3]);
        ss += shfl_f(ss, F.lane ^ 16); ss += shfl_f(ss, F.lane ^ 32);
        const float rstd = 1.f / sqrtf(ss * (1.f / 64.f) + EPS);
        const int i = 16 * (2 * half + ibase + ibl) + lr; const size_t row = (size_t)(row0 + i);
#pragma unroll
        for (int mb = 0; mb < 4; ++mb) { const int dv = 16 * mb + 4 * g; const f32x4 gv = *(const f32x4*)(gg + dv);
            const u32x2 gw = *(const u32x2*)(F.PB + row * NP + PG + h * 64 + dv);
            const float y0 = o[mb][ibl][0] * rstd * gv[0] * silu_f(bflo(gw.x)), y1 = o[mb][ibl][1] * rstd * gv[1] * silu_f(bfhi(gw.x));
            const float y2 = o[mb][ibl][2] * rstd * gv[2] * silu_f(bflo(gw.y)), y3 = o[mb][ibl][3] * rstd * gv[3] * silu_f(bfhi(gw.y));
            u32x2 w; w.x = pk2(y0, y1); w.y = pk2(y2, y3); *(u32x2*)(F.YMIX + row * D + h * 64 + dv) = w; }
    }
    __syncthreads();
}

template <int NKS, int GRP>
__device__ __forceinline__ void dft_mma_lds(f32x4 (&acc)[8], const LAS unsigned char* fl, int pitchB, const bf16* re, const bf16* im, size_t rstride, int khalf, int lane) {
    const int lr = lane & 15, g = lane >> 4;
#pragma unroll
    for (int k0 = 0; k0 < NKS; k0 += GRP) {
        bf16x8 bfrag[GRP];
#pragma unroll
        for (int kq = 0; kq < GRP; ++kq) { const int ks = k0 + kq; const int kk0 = 32 * ks + 8 * g; const bool part = kk0 >= khalf; const int idx = part ? kk0 - khalf : kk0;
            const bf16* src = (part ? im : re) + (size_t)idx * rstride + lr; unsigned short t[8];
#pragma unroll
            for (int e = 0; e < 8; ++e) t[e] = src[(size_t)e * rstride];
            u32x4 w; w.x = t[0] | ((unsigned)t[1] << 16); w.y = t[2] | ((unsigned)t[3] << 16); w.z = t[4] | ((unsigned)t[5] << 16); w.w = t[6] | ((unsigned)t[7] << 16);
            bfrag[kq] = __builtin_bit_cast(bf16x8, w); }
#pragma unroll
        for (int kq = 0; kq < GRP; ++kq) { const int ks = k0 + kq;
#pragma unroll
            for (int mb = 0; mb < 8; ++mb) { const bf16x8 a = *(const LAS bf16x8*)(fl + (16 * mb + lr) * pitchB + (32 * ks + 8 * g) * 2); acc[mb] = MFMA16(a, bfrag[kq], acc[mb]); }
        }
    }
}
__device__ __forceinline__ void f_to_lds(LAS unsigned char* fl, const bf16* Fm, int rows, int rowB, int tid) {
    const int cpr = rowB >> 4, n = rows * cpr;
    for (int i = tid; i < n; i += 512) { const int r = i / cpr, c = i - r * cpr; *(LAS u32x4*)(fl + r * (rowB + 16) + c * 16) = *(const u32x4*)((const unsigned char*)Fm + (size_t)r * rowB + c * 16); }
    __syncthreads();
}
template <int NKS, int GRP = 4, int NMB = 8>
__device__ __forceinline__ void dft_mma(f32x4 (&acc)[NMB], const bf16* Fm, int ldF, int mrow0, const bf16* re, const bf16* im, size_t rstride, int khalf, int lane) {
    const int lr = lane & 15, g = lane >> 4;
#pragma unroll
    for (int k0 = 0; k0 < NKS; k0 += GRP) {
        bf16x8 bfrag[GRP];
#pragma unroll
        for (int kq = 0; kq < GRP; ++kq) { const int ks = k0 + kq; const int kk0 = 32 * ks + 8 * g; const bool part = kk0 >= khalf; const int idx = part ? kk0 - khalf : kk0;
            const bf16* src = (part ? im : re) + (size_t)idx * rstride + lr; unsigned short t[8];
#pragma unroll
            for (int e = 0; e < 8; ++e) t[e] = src[(size_t)e * rstride];
            u32x4 w; w.x = t[0] | ((unsigned)t[1] << 16); w.y = t[2] | ((unsigned)t[3] << 16); w.z = t[4] | ((unsigned)t[5] << 16); w.w = t[6] | ((unsigned)t[7] << 16);
            bfrag[kq] = __builtin_bit_cast(bf16x8, w); }
#pragma unroll
        for (int kq = 0; kq < GRP; ++kq) { const int ks = k0 + kq;
            bf16x8 a[NMB];
#pragma unroll
            for (int mb = 0; mb < NMB; ++mb) a[mb] = *(const bf16x8*)(Fm + (size_t)(mrow0 + 16 * mb + lr) * ldF + 32 * ks + 8 * g);
#pragma unroll
            for (int mb = 0; mb < NMB; ++mb) acc[mb] = MFMA16(a[mb], bfrag[kq], acc[mb]);
            if (kq & 1) __builtin_amdgcn_sched_barrier(0);
        }
    }
}
__device__ __forceinline__ void dft_mma_loop(f32x4 (&acc)[8], const bf16* Fm, int ldF, int mrow0, int nks, const bf16* re, const bf16* im, size_t rstride, int khalf, int lane) {
    const int lr = lane & 15, g = lane >> 4;
#pragma unroll 1
    for (int ks = 0; ks < nks; ++ks) { const int kk0 = 32 * ks + 8 * g; const bool part = kk0 >= khalf; const int idx = part ? kk0 - khalf : kk0;
        const bf16* src = (part ? im : re) + (size_t)idx * rstride + lr; unsigned short t[8];
#pragma unroll
        for (int e = 0; e < 8; ++e) t[e] = src[(size_t)e * rstride];
        u32x4 w; w.x = t[0] | ((unsigned)t[1] << 16); w.y = t[2] | ((unsigned)t[3] << 16); w.z = t[4] | ((unsigned)t[5] << 16); w.w = t[6] | ((unsigned)t[7] << 16);
        const bf16x8 bfrag = __builtin_bit_cast(bf16x8, w);
#pragma unroll
        for (int mb = 0; mb < 8; ++mb) { const bf16x8 a = *(const bf16x8*)(Fm + (size_t)(mrow0 + 16 * mb + lr) * ldF + 32 * ks + 8 * g); acc[mb] = MFMA16(a, bfrag, acc[mb]); }
    }
}
__device__ __forceinline__ void fft_stage1(Ctx& F) {
    const int lr = F.lane & 15, g = F.lane >> 4;
    f_to_lds(F.lds, F.F1, 128, 256, F.tid);
    for (int it = F.gw; it < 4096; it += F.NGW) { const int cb = it & 15, n2 = (it >> 4) & 127, b = it >> 11;
        f32x4 acc[8];
#pragma unroll
        for (int mb = 0; mb < 8; ++mb) acc[mb] = (f32x4){0.f, 0.f, 0.f, 0.f};
        const bf16* re = F.PB + (size_t)(b * SEQ + n2) * NP + PFA + 16 * cb;
        dft_mma_lds<4, 4>(acc, F.lds, 272, re, re + 256, (size_t)128 * NP, 64, F.lane);
#pragma unroll
        for (int mb = 0; mb < 4; ++mb)
#pragma unroll
            for (int r = 0; r < 4; ++r) { const int k1 = 16 * mb + 4 * g + r; const float a = (float)(k1 * n2) * (1.f / 8192.f); const float c = cos_rev(a), s = sin_rev(a);
                const float tr = acc[mb][r], ti = acc[mb + 4][r]; const float xr = tr * c + ti * s, xi = ti * c - tr * s;
                bf16* dst = F.TB + ((size_t)((b * 64 + k1) * 2) * 128 + n2) * 256 + 16 * cb + lr;
                dst[0] = (bf16)f2bf(xr); dst[(size_t)128 * 256] = (bf16)f2bf(xi); }
    }
}
__device__ __forceinline__ void fft_stage2(Ctx& F, int l) {
    const int lr = F.lane & 15, g = F.lane >> 4;
    f_to_lds(F.lds, F.F2, 128, 512, F.tid);
    for (int it = F.gw; it < 2048; it += F.NGW) {
        f32x4 acc[8];
#pragma unroll
        for (int mb = 0; mb < 8; ++mb) acc[mb] = (f32x4){0.f, 0.f, 0.f, 0.f};
        const int cb = it & 15, k1 = (it >> 4) & 63, b = it >> 10;
        const bf16* re = F.TB + (size_t)((b * 64 + k1) * 2) * 128 * 256 + 16 * cb;
        dft_mma_lds<8, 4>(acc, F.lds, 528, re, re + (size_t)128 * 256, 256, 128, F.lane);
#pragma unroll
        for (int mb = 0; mb < 8; ++mb)
#pragma unroll
            for (int r = 0; r < 4; ++r) { const int k2 = 16 * mb + 4 * g + r; F.YMIX[(size_t)(b * SEQ + k1 + 64 * k2) * D + 256 + 16 * cb + lr] = (bf16)f2bf(acc[mb][r]); }
    }
    __syncthreads();
}
__device__ __forceinline__ void ctx_dft(Ctx& F, int w0, int nw) {
    const int lr = F.lane & 15, g = F.lane >> 4;
    for (int it = w0; it >= 0 && it < 256; it += nw) { const int mq = it & 7, cb = (it >> 3) & 15, b = it >> 7;
            f32x4 acc[2] = {(f32x4){0.f, 0.f, 0.f, 0.f}, (f32x4){0.f, 0.f, 0.f, 0.f}};
            const bf16* re = F.PB + (size_t)(ML + b * CTXL) * NP + PFA + 16 * cb;
            dft_mma<8, 4, 2>(acc, F.FC, 512, 32 * mq, re, re, (size_t)NP, 256, F.lane); __builtin_amdgcn_sched_barrier(0);
            dft_mma<8, 4, 2>(acc, F.FC + 256, 512, 32 * mq, re + 256, re + 256, (size_t)NP, 256, F.lane);
#pragma unroll
            for (int mb = 0; mb < 2; ++mb)
#pragma unroll
                for (int r = 0; r < 4; ++r) { const int k = 32 * mq + 16 * mb + 4 * g + r; F.YMIX[(size_t)(ML + b * CTXL + k) * D + 256 + 16 * cb + lr] = (bf16)f2bf(acc[mb][r]); }
        }
}
__device__ __forceinline__ void load8(const bf16* q, float (&v)[8]) { const u32x4 w = *(const u32x4*)q; v[0] = bflo(w.x); v[1] = bfhi(w.x); v[2] = bflo(w.y); v[3] = bfhi(w.y); v[4] = bflo(w.z); v[5] = bfhi(w.z); v[6] = bflo(w.w); v[7] = bfhi(w.w); }
__device__ __forceinline__ void store8(bf16* q, const float (&v)[8]) { u32x4 w; w.x = pk2(v[0], v[1]); w.y = pk2(v[2], v[3]); w.z = pk2(v[4], v[5]); w.w = pk2(v[6], v[7]); *(u32x4*)q = w; }
__device__ __forceinline__ u32x4 ldrow(const bf16* base, int rbase, int t, int n, int col) { const int tc = t < 0 ? 0 : (t > n - 1 ? n - 1 : t); return *(const u32x4*)(base + (size_t)(rbase + tc) * NP + col); }
__device__ __forceinline__ void unpack8(const u32x4 w, float (&v)[8]) { v[0] = bflo(w.x); v[1] = bfhi(w.x); v[2] = bflo(w.y); v[3] = bfhi(w.y); v[4] = bflo(w.z); v[5] = bfhi(w.z); v[6] = bflo(w.w); v[7] = bfhi(w.w); }
__device__ __forceinline__ void convpool_item(PP p, Ctx& F, int l, int it) {
    int rbase, n, t0;
    if (it < 256) { rbase = it * 64; n = 64; t0 = 0; } else { const int sg = it - 256; rbase = ML + (sg >> 2) * CTXL; n = CTXL; t0 = (sg & 3) * 64; }
    const int oct = F.tid & 31, tl = F.tid >> 5, c0 = 8 * oct, tb = t0 + tl * 4;
    {
        u32x4 hw_[6], cw_[6], bw_[4];
#pragma unroll
        for (int i = 0; i < 6; ++i) { hw_[i] = ldrow(F.PB, rbase, tb - 1 + i, n, PH + c0); cw_[i] = ldrow(F.PB, rbase, tb - 1 + i, n, PCG + c0); }
#pragma unroll
        for (int q = 0; q < 4; ++q) bw_[q] = ldrow(F.PB, rbase, tb + q, n, PBG + c0);
        const f32x4 w0a = *(const f32x4*)(p->conv_w + (l * 3 + 0) * 256 + c0), w0b = *(const f32x4*)(p->conv_w + (l * 3 + 0) * 256 + c0 + 4);
        const f32x4 w1a = *(const f32x4*)(p->conv_w + (l * 3 + 1) * 256 + c0), w1b = *(const f32x4*)(p->conv_w + (l * 3 + 1) * 256 + c0 + 4);
        const f32x4 w2a = *(const f32x4*)(p->conv_w + (l * 3 + 2) * 256 + c0), w2b = *(const f32x4*)(p->conv_w + (l * 3 + 2) * 256 + c0 + 4);
        const f32x4 cba = *(const f32x4*)(p->conv_b + l * 256 + c0), cbb = *(const f32x4*)(p->conv_b + l * 256 + c0 + 4);
        float hc[6][8];
#pragma unroll
        for (int i = 0; i < 6; ++i) { float a[8], b[8]; unpack8(hw_[i], a); unpack8(cw_[i], b); const int t = tb - 1 + i; const float msk = (t >= 0 && t < n) ? 1.f : 0.f;
#pragma unroll
            for (int e = 0; e < 8; ++e) hc[i][e] = a[e] * b[e] * msk; }
#pragma unroll
        for (int q = 0; q < 4; ++q) { float bg[8], y[8]; unpack8(bw_[q], bg);
#pragma unroll
            for (int e = 0; e < 8; ++e) { const float w0 = e < 4 ? w0a[e & 3] : w0b[e & 3], w1 = e < 4 ? w1a[e & 3] : w1b[e & 3], w2 = e < 4 ? w2a[e & 3] : w2b[e & 3], cb = e < 4 ? cba[e & 3] : cbb[e & 3];
                y[e] = bg[e] * (w0 * hc[q][e] + w1 * hc[q + 1][e] + w2 * hc[q + 2][e] + cb); }
            store8(F.YMIX + (size_t)(rbase + tb + q) * D + 512 + c0, y); }
    }
    __builtin_amdgcn_sched_barrier(0);
    {
        const int wnd = 2 << (oct >> 3), hw = wnd >> 1;
        float s[4][8], self[4][8];
#pragma unroll
        for (int q = 0; q < 4; ++q) { unpack8(ldrow(F.PB, rbase, tb + q, n, PPOOL + c0), self[q]);
#pragma unroll
            for (int e = 0; e < 8; ++e) s[q][e] = 0.f; }
        __builtin_amdgcn_sched_barrier(0);
#pragma unroll
        for (int bt = 0; bt < 19; bt += 7) {
            u32x4 pw[7];
#pragma unroll
            for (int ii = 0; ii < 7; ++ii) if (bt + ii < 19) pw[ii] = ldrow(F.PB, rbase, tb - hw + bt + ii, n, PPOOL + c0);
#pragma unroll
            for (int ii = 0; ii < 7; ++ii) if (bt + ii < 19) { const int i = bt + ii; float v[8]; unpack8(pw[ii], v); const int t = tb - hw + i; const bool inr = (t >= 0 && t < n);
#pragma unroll
                for (int q = 0; q < 4; ++q) { const float mk = (inr && i >= q && i < q + wnd) ? 1.f : 0.f;
#pragma unroll
                    for (int e = 0; e < 8; ++e) s[q][e] += mk * v[e]; } }
            __builtin_amdgcn_sched_barrier(0);
        }
#pragma unroll
        for (int q = 0; q < 4; ++q) { const int t = tb + q; const int lo = (t - hw > 0) ? t - hw : 0, hi = (t + hw - 1 < n - 1) ? t + hw - 1 : n - 1; const float inv = 1.f / (float)(hi - lo + 1);
            float y[8];
#pragma unroll
            for (int e = 0; e < 8; ++e) y[e] = s[q][e] * inv - self[q][e];
            store8(F.YMIX + (size_t)(rbase + t) * D + 768 + c0, y); }
    }
}
__device__ __forceinline__ void ctx_act(PP p, Ctx& F, int l) {
    const int gt = blockIdx.x * 512 + F.tid, NT = F.G * 512;
    for (int i = gt; i < MC * 352; i += NT) { const int oc = i % 352, rc = i / 352, t = rc & 255, c0 = 8 * oc;
        const bf16* base = F.CAU + (size_t)rc * NUP + c0; float a[8], y[8], u[8];
        const float* cw = p->ffn_cw + (size_t)l * 3 * DFF + c0; const float* cb = p->ffn_cb + (size_t)l * DFF + c0;
#pragma unroll
        for (int e = 0; e < 8; ++e) y[e] = cb[e];
        if (t > 0) { load8(base - NUP, a);
#pragma unroll
            for (int e = 0; e < 8; ++e) y[e] += cw[e] * a[e]; }
        load8(base, a);
#pragma unroll
        for (int e = 0; e < 8; ++e) y[e] += cw[DFF + e] * a[e];
        if (t < 255) { load8(base + NUP, a);
#pragma unroll
            for (int e = 0; e < 8; ++e) y[e] += cw[2 * DFF + e] * a[e]; }
        load8(base + DFF, u);
#pragma unroll
        for (int e = 0; e < 8; ++e) y[e] = silu_f(y[e]) * u[e];
        store8(F.ACT + (size_t)(ML + rc) * DFF + c0, y);
    }
}
__global__ void __launch_bounds__(512, 2) fwd_megakernel(Params p_) {
    PP p = (PP)__builtin_amdgcn_kernarg_segment_ptr();
    extern __shared__ __attribute__((aligned(16))) unsigned char lds_raw[];
    cg::grid_group grid = cg::this_grid();
    Ctx F;
    F.lds = (LAS unsigned char*)lds_raw; F.tid = threadIdx.x; F.lane = F.tid & 63; F.wave = __builtin_amdgcn_readfirstlane(F.tid >> 6);
    const int wave_s = F.wave;
    F.G = gridDim.x; F.gw = blockIdx.x * 8 + F.wave; F.NGW = F.G * 8;
    unsigned char* ws = p->ws;
#define SETPTRS() do { { PP q_ = (PP)__builtin_amdgcn_kernarg_segment_ptr(); asm volatile("" : "+s"(q_)); p = q_; } unsigned char* w_ = p->ws; asm volatile("" : "+s"(w_)); \
    F.MOD = (float*)(w_ + WS_MOD); F.MCS = (float*)(w_ + WS_MCS); F.F1 = (bf16*)(w_ + WS_F1); F.F2 = (bf16*)(w_ + WS_F2); F.FC = (bf16*)(w_ + WS_FC); \
    F.HX = (bf16*)(w_ + WS_HX); F.TB = (bf16*)(w_ + WS_HX); F.YMIX = (bf16*)(w_ + WS_YMIX); F.PB = (bf16*)(w_ + WS_P); F.ACT = (bf16*)(w_ + WS_P); \
    F.XC = (float*)(w_ + WS_XC); F.ST = (float*)(w_ + WS_ST); F.DEC = (float*)(w_ + WS_DEC); F.CAU = (bf16*)(w_ + WS_CAU); } while (0)
    SETPTRS();

#ifndef NO_P0
#define REFRESH() do { int t_; asm volatile("v_mbcnt_lo_u32_b32 %0, -1, 0\n\tv_mbcnt_hi_u32_b32 %0, -1, %0" : "=v"(t_)); t_ |= (wave_s << 6); F.tid = t_; F.lane = t_ & 63; F.wave = __builtin_amdgcn_readfirstlane(t_ >> 6); F.gw = blockIdx.x * 8 + F.wave; SETPTRS(); } while (0)
    { volatile LAS unsigned* misc = (volatile LAS unsigned*)(F.lds + RING_BYTES); if (F.tid < 64) misc[F.tid] = 0u; }
    __syncthreads();
    XcdBarrier bar = xcd_barrier_post((unsigned*)(ws + WS_CTL), (volatile LAS unsigned*)(F.lds + RING_BYTES) + 8, F.tid);
#define GSYNC() do { REFRESH(); xcd_barrier(bar, F.tid); } while (0)
    REFRESH();
    phase0(p, F);
#endif
    if (p->ws == nullptr) grid.sync();
    GSYNC();
#define L0() ({ int lq_ = l; asm volatile("" : "+s"(lq_)); lq_ == 0; })
    for (int l = 0; l < 2; ++l) {
        const int M6 = L0() ? MT : ML;
#ifndef NO_P1
        REFRESH();
        norm_phase(p, F, l, 0, MT);
        REFRESH();
        if (L0()) fold_items(p, F);
#ifdef PROBE_B
        REFRESH(); norm_phase(p, F, l, 0, MT); if (L0()) fold_items(p, F);
#endif
#endif
        GSYNC();
#ifndef NO_P2
        REFRESH();
        { pg8::Gemm g{F.HX, win_t(p, l), MT, NP, D, D}; pg8::StaticOrder S; S.init(MT, NP, F.G, (int)blockIdx.x);
          EpiP E{F.PB, p->b_a2 + l * 256};
          pg8::gemm_phase<EpiP, pg8::StaticOrder, true, true>(F.lds, g, S, E, F.tid);
#ifdef PROBE_C
          __syncthreads(); pg8::gemm_phase<EpiP, pg8::StaticOrder, true, true>(F.lds, g, S, E, F.tid);
#endif
        }
#endif
        GSYNC();
#ifdef PROBE_A
        for (int rep_ = 0; rep_ < 2; ++rep_) {
#else
        {
#endif
#ifndef NO_GA
        REFRESH();
        for (int it = blockIdx.x; it < 2 * NCH; it += F.G) gla_a_item(F, it / NCH, it % NCH);
#ifdef PR_GA
        __syncthreads(); REFRESH();
        for (int it = blockIdx.x; it < 2 * NCH; it += F.G) gla_a_item(F, it / NCH, it % NCH);
#endif
#endif
#ifndef NO_F1
        REFRESH();
        fft_stage1(F);
#ifdef PR_F1
        __syncthreads(); REFRESH();
        fft_stage1(F);
#endif
#endif
#ifndef NO_CP
        REFRESH();
        for (int v = blockIdx.x; v < 512; v += F.G) { const int it = (v < 256) ? v : 256 + ((v + 248) & 255);
            if (it >= (L0() ? 264 : 256)) continue; convpool_item(p, F, l, it); }
#ifdef PR_CP
        __syncthreads(); REFRESH();
        for (int v = blockIdx.x; v < 512; v += F.G) { const int it = (v < 256) ? v : 256 + ((v + 248) & 255);
            if (it >= (L0() ? 264 : 256)) continue; convpool_item(p, F, l, it); }
#endif
#endif
        }
        GSYNC();
#ifdef PROBE_A
        REFRESH(); fft_stage2(F, l);
#endif
#ifndef NO_F2
        REFRESH();
        fft_stage2(F, l);
#ifdef PR_F2
        __syncthreads(); REFRESH();
        fft_stage2(F, l);
#endif
#endif
#ifndef NO_SC
        REFRESH();
        gla_scan(F);
#endif
        GSYNC();
#ifdef PROBE_A
        for (int rep_ = 0; rep_ < 2; ++rep_) {
#else
        {
#endif
#ifndef NO_GC
        REFRESH();
        for (int it = blockIdx.x; it < 256; it += F.G) gla_c_item<2>(p, F, l, it >> 7, 4 + (it & 127), 0);
        if (L0()) for (int j = blockIdx.x; j < 16; j += F.G) gla_c_item<1>(p, F, l, j >> 3, (j >> 1) & 3, j & 1);
        if (L0()) { if (F.G == 256) ctx_dft(F, F.gw - 256, 1 << 30); else ctx_dft(F, F.gw, F.NGW); }
#ifdef PR_GC
        __syncthreads(); REFRESH();
        for (int it = blockIdx.x; it < 256; it += F.G) gla_c_item<2>(p, F, l, it >> 7, 4 + (it & 127), 0);
#endif
#endif
        }
        GSYNC();
#ifndef NO_P6
        REFRESH();
        if (L0()) { pg8::Gemm g{F.YMIX, wout_t(p, l), MT, D, 256, D}; SplitOrder S; S.init(4, F.G, (int)blockIdx.x);
          EpiPartial E{(float*)(p->ws + WS_PART)};
          pg8::gemm_phase<EpiPartial, SplitOrder, false, false>(F.lds, g, S, E, F.tid); __syncthreads(); }
        REFRESH();
        { pg8::Gemm g{F.YMIX, wout_t(p, l), ML, D, D, D}; pg8::StaticOrder S; S.init(ML, D, F.G, (int)blockIdx.x);
          if (L0()) { EpiRes<false, true> E{p->x, p->out, F.MOD + l * 3 * 6144 + 2048}; pg8::gemm_phase<EpiRes<false, true>, pg8::StaticOrder, true, true>(F.lds, g, S, E, F.tid); }
          else if (F.G == 256) { EpiResNorm E{(const bf16*)p->out, (bf16*)(p->ws + WS_XB2), F.HX, F.MOD + l * 3 * 6144 + 2048, p->norm2_g + l * D, F.MOD + l * 3 * 6144, (float*)(p->ws + WS_SLOT) + 65536 * 2, (unsigned*)(p->ws + WS_CTL) + CW_FIN + 4096};
            pg8::gemm_phase<EpiResNorm, pg8::StaticOrder, false, true>(F.lds, g, S, E, F.tid); }
          else { EpiRes<true, true> E{p->out, p->out, F.MOD + l * 3 * 6144 + 2048}; pg8::gemm_phase<EpiRes<true, true>, pg8::StaticOrder, true, true>(F.lds, g, S, E, F.tid); } }
#endif
        GSYNC();
        if (L0() || F.G != 256) { REFRESH(); norm_phase(p, F, l, 1, M6); GSYNC(); }
#ifndef NO_P8
        REFRESH();
        { pg8::Gemm g{F.HX, wup_t(p, l), ML, NUP, D, D}; pg8::StaticOrder S; S.init(ML, NUP, F.G, (int)blockIdx.x);
          EpiUp E{F.ACT, p->ffn_cw + (size_t)l * 3 * DFF, p->ffn_cb + (size_t)l * DFF};
          pg8::gemm_phase<EpiUp, pg8::StaticOrder, true, true>(F.lds, g, S, E, F.tid);
        }
        if (L0()) { REFRESH(); __syncthreads();
          pg8::Gemm g{F.HX, wup_t(p, l), MT, NUP, D, D}; CtxOrder S; S.init(NUP, (int)blockIdx.x, 128);
          EpiUpCtx E{F.ACT, p->ffn_cw + (size_t)l * 3 * DFF, p->ffn_cb + (size_t)l * DFF, (LAS float*)(F.lds + RING_BYTES + 1024)};
          pg8::gemm_phase<EpiUpCtx, CtxOrder, true, false>(F.lds, g, S, E, F.tid); }
#endif
        GSYNC();
#ifndef NO_P9
        REFRESH();
        if (L0()) { pg8::Gemm g{F.ACT, wdn_t(p, l), MT, D, 256, DFF}; SplitOrder S; S.init(11, F.G, (int)blockIdx.x);
          EpiPartial E{(float*)(p->ws + WS_PART)};
          pg8::gemm_phase<EpiPartial, SplitOrder, false, false>(F.lds, g, S, E, F.tid); __syncthreads(); }
        REFRESH();
        { pg8::Gemm g{F.ACT, wdn_t(p, l), ML, D, DFF, DFF}; pg8::StaticOrder S; S.init(ML, D, F.G, (int)blockIdx.x);
          if (L0()) { EpiRes<true, true> E{p->out, p->out, F.MOD + l * 3 * 6144 + 5120}; pg8::gemm_phase<EpiRes<true, true>, pg8::StaticOrder, true, true>(F.lds, g, S, E, F.tid); }
          else if (F.G == 256) { EpiFinal E{(const bf16*)(p->ws + WS_XB2), p->out, F.MOD + l * 3 * 6144 + 5120, p->final_g, (float*)(p->ws + WS_SLOT), (unsigned*)(p->ws + WS_CTL) + CW_FIN};
            pg8::gemm_phase<EpiFinal, pg8::StaticOrder, false, true>(F.lds, g, S, E, F.tid); }
          else { EpiRes<true, false> E{p->out, p->ws + WS_HX, F.MOD + l * 3 * 6144 + 5120}; pg8::gemm_phase<EpiRes<true, false>, pg8::StaticOrder, true, true>(F.lds, g, S, E, F.tid); } }
#endif
        if (L0() || F.G != 256) GSYNC();
    }
        REFRESH();
    if (F.G != 256) final_norm(p, F);
}

extern "C" void kernel_launch(void* const* d_in, const int* in_sizes, int n_in, void* d_out, int out_size, void* d_ws, size_t ws_size, hipStream_t stream) {
    static int grid = 0;
    if (grid == 0) {
        if (n_in != 23 || in_sizes[0] != ML * D || out_size != ML * D || ws_size < WS_END) { fprintf(stderr, "kernel_launch: unexpected shapes / workspace (%d inputs, ws %zu)\n", n_in, ws_size); grid = -1; return; }
        int dev = 0, cus = 0, per_cu = 0;
        hipGetDevice(&dev); hipDeviceGetAttribute(&cus, hipDeviceAttributeMultiprocessorCount, dev);
        if (hipFuncSetAttribute((const void*)fwd_megakernel, hipFuncAttributeMaxDynamicSharedMemorySize, LDS_BYTES) != hipSuccess) { fprintf(stderr, "hipFuncSetAttribute failed\n"); grid = -1; return; }
        if (hipOccupancyMaxActiveBlocksPerMultiprocessor(&per_cu, (const void*)fwd_megakernel, 512, LDS_BYTES) != hipSuccess || per_cu < 1) per_cu = 1;
        (void)hipGetLastError();
        grid = cus * 1;
    }
    if (grid < 0) return;
    if (hipMemsetAsync((char*)d_ws + WS_CTL, 0, 65536, stream) != hipSuccess) { fprintf(stderr, "memset failed\n"); return; }
    Params p{};
    const float** pp = (const float**)&p;
    for (int i = 0; i < 23; ++i) pp[i] = (const float*)d_in[i];
    p.out = (float*)d_out; p.ws = (unsigned char*)d_ws;
    void* args[] = {&p};
    hipError_t e = hipLaunchCooperativeKernel((const void*)fwd_megakernel, dim3(grid), dim3(512), args, LDS_BYTES, stream);
    if (e != hipSuccess) fprintf(stderr, "cooperative launch failed: %s (grid %d)\n", hipGetErrorString(e), grid);
}
```

```cpp
#include <hip/hip_runtime.h>
#include <hip/hip_cooperative_groups.h>
#include <cstdio>
#include <cstdint>
namespace cg = cooperative_groups;
namespace pg8 {
#define PG8_LAS __attribute__((address_space(3)))
typedef unsigned short bf16_t;
typedef short bf16x8 __attribute__((ext_vector_type(8)));
typedef float f32x4 __attribute__((ext_vector_type(4)));
typedef unsigned u32x4 __attribute__((ext_vector_type(4)));
constexpr int BM = 256, BK = 64, HALF = 128, HTB = HALF * BK * 2  , STAGE_BYTES = 8 * HTB, NXCD = 8, WGM = 8;

__host__ __device__ __forceinline__ int lds_byte(int r, int c) { const int st = (r >> 4) * 2 + (c >> 5), rr = r & 15, cc = c & 31, ob = rr * 64 + cc * 2; return st * 1024 + (ob ^ (((ob >> 9) & 1) << 5)); }
__host__ __device__ __forceinline__ void stage_rc(int b, int& R, int& C) { const int st = b / 1024, sb = b % 1024, swz = sb ^ (((sb >> 9) & 1) << 5); R = (st >> 1) * 16 + swz / 64; C = (st & 1) * 32 + (swz % 64) / 2; }
__host__ __device__ __forceinline__ int perm32(int rho) { const int n = rho >> 4, i = rho & 15; return 8 * (i >> 2) + 4 * n + (i & 3); }

struct Unit { int pm, pn, ks; };
struct Gemm { const bf16_t* A; const bf16_t* Bt; int M, N, K, ld; };

struct StaticOrder {
    int nM, nN, nwg, G, c;
    __host__ __device__ void init(int M, int N, int G_, int c_) { nM = M / BM; nN = N / BM; nwg = nM * nN; G = G_; c = c_; }
    __host__ __device__ bool next(int i, Unit& u) const {
        const long L = (long)i * G + c; if (L >= nwg) return false;
        int wgid = (int)L; { const int q = nwg / NXCD, r = nwg % NXCD, xcd = wgid % NXCD, off = wgid / NXCD; wgid = (xcd < r ? xcd * (q + 1) : r * (q + 1) + (xcd - r) * q) + off; }
        const int nig = WGM * nN, gid = wgid / nig, fm = gid * WGM, gsz = (nM - fm) < WGM ? (nM - fm) : WGM;
        u.pm = fm + ((wgid % nig) % gsz); u.pn = (wgid % nig) / gsz; u.ks = 0; return true;
    }
    __device__ __forceinline__ void a_ready(const Unit&) const {}
    __device__ __forceinline__ void done(const Unit&) const {}
};

__device__ __forceinline__ unsigned cvt_pk_bf16(float lo, float hi) { unsigned r; asm volatile("v_cvt_pk_bf16_f32 %0, %1, %2" : "=v"(r) : "v"(lo), "v"(hi)); return r; }
template <class Epi, class Sched, bool ALIGN_EPI = false, bool SP2 = false>
__device__ __forceinline__ void gemm_phase(PG8_LAS unsigned char* lds, const Gemm g, const Sched& S, const Epi& E, int tid_in) {
    int tid_ = tid_in; asm volatile("" : "+v"(tid_)); const int tid = tid_, wid = __builtin_amdgcn_readfirstlane(tid >> 6), lane = tid & 63, wr = wid >> 2, wc = wid & 3, fr = lane & 15, fq = lane >> 4;
    const int K = g.ld, nt = g.K / BK; const size_t sstep = (size_t)g.K * 2;
    unsigned voffA[2], voffB[2];
#pragma unroll
    for (int i = 0; i < 2; ++i) { int R, C; stage_rc(tid * 16 + i * 8192, R, C); const int Rb = Epi::PERM ? ((R & ~31) + perm32(R & 31)) : R;
        voffA[i] = (unsigned)(R * K + C) * 2u; voffB[i] = (unsigned)(Rb * K + C) * 2u; }
    const size_t kstep = (size_t)(BK * 2);
    const size_t hstep = (size_t)HALF * K * 2;
    const size_t tstep = 2 * hstep;
    const unsigned ldsw = (unsigned)wid * 1024u;
    const int aoff = lds_byte(wr * 64 + fr, fq * 8), boff = lds_byte(wc * 32 + fr, fq * 8);
#define PG8_SA(b, h) (((b) * 2 + (h)) * HTB)
#define PG8_SB(b, h) ((4 + (b) * 2 + (h)) * HTB)
#define PG8_STAGE(bufoff, gbase, voff) do { _Pragma("unroll") for (int _i = 0; _i < 2; ++_i) \
        __builtin_amdgcn_global_load_lds((const unsigned*)((const char*)(gbase) + (voff)[_i]), (PG8_LAS unsigned*)(lds + (bufoff) + ldsw + _i * 8192), 16, 0, 0); } while (0)
#define PG8_LDA(dst, b, h) do { _Pragma("unroll") for (int m = 0; m < 4; ++m) _Pragma("unroll") for (int k = 0; k < 2; ++k) dst[m][k] = *(const PG8_LAS bf16x8*)(lds + PG8_SA(b, h) + aoff + m * 2048 + k * 1024); } while (0)
#define PG8_LDB(dst, b, h) do { _Pragma("unroll") for (int n = 0; n < 2; ++n) _Pragma("unroll") for (int k = 0; k < 2; ++k) dst[n][k] = *(const PG8_LAS bf16x8*)(lds + PG8_SB(b, h) + boff + n * 2048 + k * 1024); } while (0)
#define PG8_MMA(ai, bj, At, Bt) do { __builtin_amdgcn_s_setprio(1); _Pragma("unroll") for (int m = 0; m < 4; ++m) _Pragma("unroll") for (int n = 0; n < 2; ++n) _Pragma("unroll") for (int k = 0; k < 2; ++k) \
        acc[ai][bj][m][n] = __builtin_amdgcn_mfma_f32_16x16x32_bf16(Bt[n][k], At[m][k], acc[ai][bj][m][n], 0, 0, 0); __builtin_amdgcn_s_setprio(0); } while (0)
#define PG8_WAIT_V(n) asm volatile("s_waitcnt vmcnt(" #n ")" ::: "memory")
#define PG8_WAIT_L(n) asm volatile("s_waitcnt lgkmcnt(" #n ")" ::: "memory")
#define PG8_BAR __builtin_amdgcn_s_barrier()
#define PG8_SCHED __builtin_amdgcn_sched_barrier(0)
    Unit cur, nxt; int ui = 0;
    if (!S.next(0, cur)) return;
    f32x4 acc[2][2][4][2];
#pragma unroll
    for (int a = 0; a < 2; ++a)
#pragma unroll
        for (int b = 0; b < 2; ++b)
#pragma unroll
            for (int m = 0; m < 4; ++m)
#pragma unroll
                for (int n = 0; n < 2; ++n) acc[a][b][m][n] = (f32x4){0.f, 0.f, 0.f, 0.f};
    bf16x8 At[4][2], B0[2][2], B1[2][2];
    const char* cA = (const char*)g.A + (size_t)cur.pm * tstep + (size_t)cur.ks * sstep; const char* cB = (const char*)g.Bt + (size_t)cur.pn * tstep + (size_t)cur.ks * sstep;
    S.a_ready(cur);
    if constexpr (SP2) {
        PG8_STAGE(PG8_SB(0, 0), cB, voffB); PG8_STAGE(PG8_SB(0, 1), cB + hstep, voffB); PG8_STAGE(PG8_SA(0, 0), cA, voffA); PG8_STAGE(PG8_SA(0, 1), cA + hstep, voffA);
        if (wr == 1) PG8_BAR;
        PG8_WAIT_V(2); PG8_BAR;
        PG8_STAGE(PG8_SB(1, 0), cB + kstep, voffB); PG8_STAGE(PG8_SA(1, 0), cA + kstep, voffA); PG8_STAGE(PG8_SB(1, 1), cB + hstep + kstep, voffB);
        PG8_WAIT_V(6); PG8_BAR;
    } else {
        PG8_STAGE(PG8_SB(0, 0), cB, voffB); PG8_STAGE(PG8_SA(0, 0), cA, voffA); PG8_STAGE(PG8_SB(0, 1), cB + hstep, voffB); PG8_STAGE(PG8_SA(0, 1), cA + hstep, voffA);
        if (wr == 1) PG8_BAR;
        PG8_WAIT_V(4); PG8_BAR;
        PG8_STAGE(PG8_SB(1, 0), cB + kstep, voffB); PG8_STAGE(PG8_SA(1, 0), cA + kstep, voffA); PG8_STAGE(PG8_SB(1, 1), cB + hstep + kstep, voffB);
        PG8_WAIT_V(6); PG8_BAR;
    }
    for (;;) {
        const bool has_next = S.next(ui + 1, nxt);
        const char* nA = has_next ? (const char*)g.A + (size_t)nxt.pm * tstep + (size_t)nxt.ks * sstep : cA; const char* nB = has_next ? (const char*)g.Bt + (size_t)nxt.pn * tstep + (size_t)nxt.ks * sstep : cB;
        for (int t = 0; t < nt; t += 2) {
            const bool last = (t == nt - 2);
            const char* a1 = cA + (size_t)(t + 1) * kstep;
            const char* a2 = last ? nA : cA + (size_t)(t + 2) * kstep; const char* b2 = last ? nB : cB + (size_t)(t + 2) * kstep;
            const char* a3 = a2 + kstep; const char* b3 = b2 + kstep;
            if (last && has_next) S.a_ready(nxt);
            if constexpr (SP2) {
            PG8_LDB(B0, 0, 0); PG8_LDB(B1, 0, 1); PG8_SCHED; PG8_LDA(At, 0, 0); PG8_STAGE(PG8_SA(1, 1), a1 + hstep, voffA);
            PG8_WAIT_V(8); PG8_WAIT_L(0); PG8_BAR; PG8_MMA(0, 0, At, B0); PG8_MMA(0, 1, At, B1); PG8_BAR; PG8_SCHED;
            PG8_LDA(At, 0, 1); PG8_STAGE(PG8_SB(0, 0), b2, voffB); PG8_STAGE(PG8_SB(0, 1), b2 + hstep, voffB); PG8_STAGE(PG8_SA(0, 0), a2, voffA);
            PG8_WAIT_V(8); PG8_WAIT_L(0); PG8_BAR; PG8_MMA(1, 0, At, B0); PG8_MMA(1, 1, At, B1); PG8_BAR; PG8_SCHED;
            PG8_LDB(B0, 1, 0); PG8_LDB(B1, 1, 1); PG8_SCHED; PG8_LDA(At, 1, 0); PG8_STAGE(PG8_SA(0, 1), a2 + hstep, voffA);
            PG8_WAIT_V(8); PG8_WAIT_L(0); PG8_BAR; PG8_MMA(0, 0, At, B0); PG8_MMA(0, 1, At, B1); PG8_BAR; PG8_SCHED;
            PG8_LDA(At, 1, 1); PG8_STAGE(PG8_SB(1, 0), b3, voffB); PG8_STAGE(PG8_SB(1, 1), b3 + hstep, voffB); PG8_STAGE(PG8_SA(1, 0), a3, voffA);
            PG8_WAIT_V(8); PG8_WAIT_L(0); PG8_BAR; PG8_MMA(1, 0, At, B0); PG8_MMA(1, 1, At, B1); PG8_BAR; PG8_SCHED;
            } else {
            PG8_LDB(B0, 0, 0); PG8_SCHED; PG8_LDA(At, 0, 0); PG8_STAGE(PG8_SA(1, 1), a1 + hstep, voffA);
            PG8_WAIT_L(8); PG8_BAR; PG8_WAIT_L(0); PG8_MMA(0, 0, At, B0); PG8_BAR; PG8_SCHED;
            PG8_LDB(B1, 0, 1); PG8_STAGE(PG8_SB(0, 0), b2, voffB);
            PG8_BAR; PG8_WAIT_L(0); PG8_MMA(0, 1, At, B1); PG8_BAR;
            PG8_LDA(At, 0, 1); PG8_STAGE(PG8_SA(0, 0), a2, voffA);
            PG8_BAR; PG8_WAIT_L(0); PG8_MMA(1, 0, At, B0); PG8_BAR; PG8_SCHED;
            PG8_STAGE(PG8_SB(0, 1), b2 + hstep, voffB);
            PG8_WAIT_V(6); PG8_BAR; PG8_MMA(1, 1, At, B1); PG8_BAR;
            PG8_LDB(B0, 1, 0); PG8_SCHED; PG8_LDA(At, 1, 0); PG8_STAGE(PG8_SA(0, 1), a2 + hstep, voffA);
            PG8_WAIT_L(8); PG8_BAR; PG8_WAIT_L(0); PG8_MMA(0, 0, At, B0); PG8_BAR; PG8_SCHED;
            PG8_LDB(B1, 1, 1); PG8_STAGE(PG8_SB(1, 0), b3, voffB);
            PG8_BAR; PG8_WAIT_L(0); PG8_MMA(0, 1, At, B1); PG8_BAR;
            PG8_LDA(At, 1, 1); PG8_STAGE(PG8_SA(1, 0), a3, voffA);
            PG8_BAR; PG8_WAIT_L(0); PG8_MMA(1, 0, At, B0); PG8_BAR; PG8_SCHED;
            PG8_STAGE(PG8_SB(1, 1), b3 + hstep, voffB);
            PG8_WAIT_V(6); PG8_BAR; PG8_MMA(1, 1, At, B1); PG8_BAR;
            }
        }
        if constexpr (ALIGN_EPI) { if (wr == 0) PG8_BAR; }
        if constexpr (!Epi::AFTER_DRAIN) { E(acc, cur, wr, wc, fr, fq); S.done(cur); }
        if (!has_next) break;
#pragma unroll
        for (int a = 0; a < 2; ++a)
#pragma unroll
            for (int b = 0; b < 2; ++b)
#pragma unroll
                for (int m = 0; m < 4; ++m)
#pragma unroll
                    for (int n = 0; n < 2; ++n) acc[a][b][m][n] = (f32x4){0.f, 0.f, 0.f, 0.f};
        cur = nxt; cA = nA; cB = nB; ++ui;
        if constexpr (ALIGN_EPI) { if (wr == 1) PG8_BAR; }
    }
    PG8_WAIT_V(0);
    if constexpr (!ALIGN_EPI) { if (wr == 0) PG8_BAR; }
    PG8_BAR;
    if constexpr (Epi::AFTER_DRAIN) { E.fused(acc, cur, wr, wc, fr, fq, lds, wid, lane); S.done(cur); }
#undef PG8_SA
#undef PG8_SB
#undef PG8_STAGE
#undef PG8_LDA
#undef PG8_LDB
#undef PG8_MMA
#undef PG8_WAIT_V
#undef PG8_WAIT_L
#undef PG8_BAR
#undef PG8_SCHED
}
}
#define LAS __attribute__((address_space(3)))
typedef unsigned short bf16;
typedef float f32x4 __attribute__((ext_vector_type(4)));
typedef short bf16x8 __attribute__((ext_vector_type(8)));
typedef unsigned u32x4 __attribute__((ext_vector_type(4)));
typedef unsigned u32x2 __attribute__((ext_vector_type(2)));
#define LDS_WAIT() asm volatile("s_waitcnt lgkmcnt(0)" ::: "memory")

constexpr int D = 1024, SEQ = 8192, ML = 16384, MC = 512, MT = ML + MC, CTXL = 256;
constexpr int DIN = 2080, NP = 2560, DFF = 2816, NUP = 5632;
constexpr int PK = 0, PQ = 128, PV = 256, PLA = 512, PG = 768, PFA = 1024, PFB = 1280, PH = 1536, PBG = 1792, PCG = 2048, PPOOL = 2304;
constexpr int NCH = 132;
constexpr float EPS = 1e-6f;
constexpr size_t MiB = 1u << 20;
constexpr size_t WS_CTL = 0;
constexpr size_t WS_MOD = 1 * MiB;
constexpr size_t WS_MCS = 1 * MiB + 256 * 1024;
constexpr size_t WS_F1 = 1 * MiB + 512 * 1024;
constexpr size_t WS_F2 = WS_F1 + 32 * 1024;
constexpr size_t WS_FC = WS_F2 + 64 * 1024;
constexpr size_t WS_SLOT = 49 * MiB;
constexpr size_t WS_XB2 = 208 * MiB;
constexpr int CW_FIN = 3584;
constexpr size_t WS_W = 2 * MiB;
constexpr size_t W_IN_B = (size_t)NP * D * 2, W_OUT_B = (size_t)D * D * 2, W_UP_B = (size_t)NUP * D * 2, W_DN_B = (size_t)D * DFF * 2;
constexpr size_t W_LAYER_B = W_IN_B + W_OUT_B + W_UP_B + W_DN_B;
constexpr size_t WS_HX = 50 * MiB;
constexpr size_t WS_YMIX = 83 * MiB;
constexpr size_t WS_P = 116 * MiB;
constexpr size_t WS_XC = 207 * MiB;
constexpr size_t WS_ST = 209 * MiB;
constexpr size_t WS_DEC = 226 * MiB;
constexpr size_t WS_CAU = 227 * MiB;
constexpr size_t WS_PART = 233 * MiB;
constexpr size_t WS_END = 255 * MiB;
static_assert(WS_W + 2 * W_LAYER_B <= WS_HX, "weights");
static_assert(WS_P + (size_t)MT * DFF * 2 <= WS_XC, "act");
constexpr int RING_BYTES = 131072, LDS_BYTES = 147456;

struct Params {
    const float *x, *c, *ctx, *c_ctx, *norm1_g, *norm2_g, *w_mod, *b_mod, *w_in, *w_a2, *b_a2, *gla_g, *fft_w, *conv_w, *conv_b, *pool_w,
        *pool_scale, *w_out, *w_up, *ffn_cw, *ffn_cb, *w_down, *final_g;
    float* out; unsigned char* ws;
};

typedef const __attribute__((address_space(4))) Params* PP;
__device__ __forceinline__ unsigned f2bf(float f) { unsigned u = __builtin_bit_cast(unsigned, f); return (u + 0x7fffu + ((u >> 16) & 1u)) >> 16; }
__device__ __forceinline__ unsigned pk2(float lo, float hi) { return f2bf(lo) | (f2bf(hi) << 16); }
__device__ __forceinline__ float bf2f(unsigned h) { return __builtin_bit_cast(float, h << 16); }
__device__ __forceinline__ float bflo(unsigned w) { return __builtin_bit_cast(float, w << 16); }
__device__ __forceinline__ float bfhi(unsigned w) { return __builtin_bit_cast(float, w & 0xffff0000u); }
__device__ __forceinline__ float shfl_f(float v, int src_lane) { return __builtin_bit_cast(float, __builtin_amdgcn_ds_bpermute(src_lane << 2, __builtin_bit_cast(int, v))); }
__device__ __forceinline__ float wave_sum(float v, int lane) {
#pragma unroll
    for (int o = 1; o < 64; o <<= 1) v += shfl_f(v, lane ^ o);
    return v;
}
__device__ __forceinline__ float silu_f(float x) { return x * __builtin_amdgcn_rcpf(1.f + __expf(-x)); }
__device__ __forceinline__ float cos_rev(float r) { return __builtin_amdgcn_cosf(r); }
__device__ __forceinline__ float sin_rev(float r) { return __builtin_amdgcn_sinf(r); }
__device__ __forceinline__ bf16x8 pack8(float a0, float a1, float a2, float a3, float a4, float a5, float a6, float a7) {
    u32x4 w; w.x = pk2(a0, a1); w.y = pk2(a2, a3); w.z = pk2(a4, a5); w.w = pk2(a6, a7); return __builtin_bit_cast(bf16x8, w);
}
#define MFMA16(a, b, c) __builtin_amdgcn_mfma_f32_16x16x32_bf16(a, b, c, 0, 0, 0)

struct EpiP {
    static constexpr bool PERM = true, AFTER_DRAIN = false;
    bf16* O; const float* ba2;
    __device__ __forceinline__ void operator()(const pg8::f32x4 (&acc)[2][2][4][2], const pg8::Unit& u, int wr, int wc, int fr, int fq) const {
        const int row0 = u.pm * 256 + wr * 64 + fr, col0 = u.pn * 256 + wc * 32 + 8 * fq;
        const __amdgpu_buffer_rsrc_t prs = __builtin_amdgcn_make_buffer_rsrc(O, 0, MT * NP * 2, 0x00020000);
        const bool la = (u.pn == 2);
#pragma unroll
        for (int ai = 0; ai < 2; ++ai)
#pragma unroll
            for (int m = 0; m < 4; ++m) { bf16* rowp = O + (size_t)(row0 + ai * 128 + m * 16) * NP + col0;
#pragma unroll
                for (int bj = 0; bj < 2; ++bj) { pg8::f32x4 v0 = acc[ai][bj][m][0], v1 = acc[ai][bj][m][1];
                    if (la) { const float* bp = ba2 + (col0 + bj * 128 - PLA); const f32x4 b0 = *(const f32x4*)bp, b1 = *(const f32x4*)(bp + 4);
#pragma unroll
                        for (int e = 0; e < 4; ++e) { float xa = v0[e] + b0[e], xb = v1[e] + b1[e];
                            v0[e] = (fminf(xa, 0.f) - __logf(1.f + __expf(-fabsf(xa)))) * 0.0625f; v1[e] = (fminf(xb, 0.f) - __logf(1.f + __expf(-fabsf(xb)))) * 0.0625f; } }
                    u32x4 w; w.x = pg8::cvt_pk_bf16(v0[0], v0[1]); w.y = pg8::cvt_pk_bf16(v0[2], v0[3]); w.z = pg8::cvt_pk_bf16(v1[0], v1[1]); w.w = pg8::cvt_pk_bf16(v1[2], v1[3]);
                    __builtin_amdgcn_raw_buffer_store_b128(w, prs, (unsigned)(((row0 + ai * 128 + m * 16) * NP + col0 + bj * 128) * 2), 0, 16); } }
    }
};
template <bool INB, bool OUTB>
struct EpiRes {
    static constexpr bool PERM = true, AFTER_DRAIN = false;
    const void* xin; void* out; const float* modg;
    __device__ __forceinline__ void operator()(const pg8::f32x4 (&acc)[2][2][4][2], const pg8::Unit& u, int wr, int wc, int fr, int fq) const {
        const int w = u.pm >> 5; const int cb = u.pn * 256 + wc * 32 + 8 * fq;
        f32x4 gv[2][2];
#pragma unroll
        for (int bj = 0; bj < 2; ++bj)
#pragma unroll
            for (int n = 0; n < 2; ++n) gv[bj][n] = *(const f32x4*)(modg + w * 6144 + cb + bj * 128 + 4 * n);
        constexpr int RG = INB ? 4 : 2;
#pragma unroll
        for (int ai = 0; ai < 2; ++ai)
#pragma unroll
            for (int mp = 0; mp < 4 / RG; ++mp) {
                u32x4 xb[RG][2]; f32x4 xf[INB ? 1 : RG][2][2];
#pragma unroll
                for (int mm = 0; mm < RG; ++mm) { const size_t ro = (size_t)(u.pm * 256 + ai * 128 + wr * 64 + (RG * mp + mm) * 16 + fr) * D + cb;
#pragma unroll
                    for (int bj = 0; bj < 2; ++bj) {
                        if (INB) xb[mm][bj] = *(const u32x4*)((const bf16*)xin + ro + bj * 128);
                        else { xf[INB ? 0 : mm][bj][0] = *(const f32x4*)((const float*)xin + ro + bj * 128); xf[INB ? 0 : mm][bj][1] = *(const f32x4*)((const float*)xin + ro + bj * 128 + 4); } } }
#pragma unroll
                for (int mm = 0; mm < RG; ++mm) { const int m = RG * mp + mm; const size_t ro = (size_t)(u.pm * 256 + ai * 128 + wr * 64 + m * 16 + fr) * D + cb;
#pragma unroll
                    for (int bj = 0; bj < 2; ++bj) { f32x4 x0, x1;
                        if (INB) { const u32x4 t = xb[mm][bj]; x0 = (f32x4){bflo(t.x), bfhi(t.x), bflo(t.y), bfhi(t.y)}; x1 = (f32x4){bflo(t.z), bfhi(t.z), bflo(t.w), bfhi(t.w)}; }
                        else { x0 = xf[INB ? 0 : mm][bj][0]; x1 = xf[INB ? 0 : mm][bj][1]; }
                        const pg8::f32x4 a0 = acc[ai][bj][m][0], a1 = acc[ai][bj][m][1]; const f32x4 g0 = gv[bj][0], g1 = gv[bj][1];
                        f32x4 y0, y1;
#pragma unroll
                        for (int e = 0; e < 4; ++e) { y0[e] = x0[e] + g0[e] * a0[e]; y1[e] = x1[e] + g1[e] * a1[e]; }
                        if (OUTB) { u32x4 pk; pk.x = pg8::cvt_pk_bf16(y0[0], y0[1]); pk.y = pg8::cvt_pk_bf16(y0[2], y0[3]); pk.z = pg8::cvt_pk_bf16(y1[0], y1[1]); pk.w = pg8::cvt_pk_bf16(y1[2], y1[3]);
                            *(u32x4*)((bf16*)out + ro + bj * 128) = pk; }
                        else { *(f32x4*)((float*)out + ro + bj * 128) = y0; *(f32x4*)((float*)out + ro + bj * 128 + 4) = y1; } } }
            }
    }
};
template <bool STORE_X>
__device__ __forceinline__ void panel_rms(pg8::f32x4 (&acc)[2][2][4][2], const pg8::Unit& u, int wr, int wc, int fr, int fq, LAS unsigned char* lds, int wid, int lane,
                                          const bf16* xin, bf16* xout, const float* modg, float* slots, unsigned* cnt) {
    const int w = u.pm >> 5; const int cb = u.pn * 256 + wc * 32 + 8 * fq;
    LAS float* P = (LAS float*)lds;
    LAS float* S = (LAS float*)(lds + 4096);
    f32x4 gv[2][2];
#pragma unroll
    for (int bj = 0; bj < 2; ++bj)
#pragma unroll
        for (int n = 0; n < 2; ++n) gv[bj][n] = *(const f32x4*)(modg + w * 6144 + cb + bj * 128 + 4 * n);
#pragma unroll
    for (int ai = 0; ai < 2; ++ai) {
        u32x4 xb[4][2];
#pragma unroll
        for (int m = 0; m < 4; ++m) { const size_t ro = (size_t)(u.pm * 256 + ai * 128 + wr * 64 + m * 16 + fr) * D + cb;
#pragma unroll
            for (int bj = 0; bj < 2; ++bj) xb[m][bj] = *(const u32x4*)(xin + ro + bj * 128); }
#pragma unroll
        for (int m = 0; m < 4; ++m) { float sq = 0.f; const size_t ro = (size_t)(u.pm * 256 + ai * 128 + wr * 64 + m * 16 + fr) * D + cb;
#pragma unroll
            for (int bj = 0; bj < 2; ++bj) { const u32x4 t = xb[m][bj]; const f32x4 g0 = gv[bj][0], g1 = gv[bj][1]; pg8::f32x4 a0 = acc[ai][bj][m][0], a1 = acc[ai][bj][m][1];
                a0[0] = bflo(t.x) + g0[0] * a0[0]; a0[1] = bfhi(t.x) + g0[1] * a0[1]; a0[2] = bflo(t.y) + g0[2] * a0[2]; a0[3] = bfhi(t.y) + g0[3] * a0[3];
                a1[0] = bflo(t.z) + g1[0] * a1[0]; a1[1] = bfhi(t.z) + g1[1] * a1[1]; a1[2] = bflo(t.w) + g1[2] * a1[2]; a1[3] = bfhi(t.w) + g1[3] * a1[3];
                acc[ai][bj][m][0] = a0; acc[ai][bj][m][1] = a1;
                sq += ((a0[0] * a0[0] + a0[1] * a0[1]) + (a0[2] * a0[2] + a0[3] * a0[3])) + ((a1[0] * a1[0] + a1[1] * a1[1]) + (a1[2] * a1[2] + a1[3] * a1[3]));
                if (STORE_X) { u32x4 pk; pk.x = pg8::cvt_pk_bf16(a0[0], a0[1]); pk.y = pg8::cvt_pk_bf16(a0[2], a0[3]); pk.z = pg8::cvt_pk_bf16(a1[0], a1[1]); pk.w = pg8::cvt_pk_bf16(a1[2], a1[3]);
                    *(u32x4*)(xout + ro + bj * 128) = pk; } }
            sq += shfl_f(sq, lane ^ 16); sq += shfl_f(sq, lane ^ 32);
            if (fq == 0) P[(ai * 128 + wr * 64 + m * 16 + fr) * 4 + wc] = sq; }
    }
    asm volatile("s_waitcnt lgkmcnt(0)" ::: "memory"); __builtin_amdgcn_s_barrier(); asm volatile("" ::: "memory");
    const int row = wid * 32 + (lane & 31);
    if (lane < 32) { const float t = (P[row * 4 + 0] + P[row * 4 + 1]) + (P[row * 4 + 2] + P[row * 4 + 3]);
        __hip_atomic_store(slots + ((size_t)(u.pm * 256 + row) * 4 + u.pn), t, __ATOMIC_RELAXED, __HIP_MEMORY_SCOPE_AGENT); }
    asm volatile("s_waitcnt vmcnt(0)" ::: "memory");
    if (lane == 0) (void)__hip_atomic_fetch_add(cnt + 64 * u.pm, 1u, __ATOMIC_RELAXED, __HIP_MEMORY_SCOPE_AGENT);
    if (wid == 0) { unsigned sp = 0;
        while ((unsigned)__builtin_amdgcn_readfirstlane((int)__hip_atomic_load(cnt + 64 * u.pm, __ATOMIC_RELAXED, __HIP_MEMORY_SCOPE_AGENT)) < 32u) { __builtin_amdgcn_s_sleep(2); if (++sp > (1u << 22)) break; }
        __builtin_amdgcn_fence(__ATOMIC_ACQUIRE, "agent"); }
    asm volatile("s_waitcnt vmcnt(0) lgkmcnt(0)" ::: "memory"); __builtin_amdgcn_s_barrier(); asm volatile("" ::: "memory");
    if (lane < 32) { const float* sl = slots + (size_t)(u.pm * 256 + row) * 4; float t = 0.f;
#pragma unroll
        for (int q = 0; q < 4; ++q) t += __hip_atomic_load(sl + q, __ATOMIC_RELAXED, __HIP_MEMORY_SCOPE_AGENT);
        S[row] = 1.f / sqrtf(t * (1.f / D) + EPS); }
    asm volatile("s_waitcnt vmcnt(0) lgkmcnt(0)" ::: "memory"); __builtin_amdgcn_s_barrier(); asm volatile("" ::: "memory");
}
struct EpiFinal {
    static constexpr bool PERM = true, AFTER_DRAIN = true;
    const bf16* xin; float* out; const float* modg; const float* gfin; float* slots; unsigned* cnt;
    __device__ __forceinline__ void fused(pg8::f32x4 (&acc)[2][2][4][2], const pg8::Unit& u, int wr, int wc, int fr, int fq, LAS unsigned char* lds, int wid, int lane) const {
        panel_rms<false>(acc, u, wr, wc, fr, fq, lds, wid, lane, xin, nullptr, modg, slots, cnt);
        const LAS float* S = (const LAS float*)(lds + 4096); const int cb = u.pn * 256 + wc * 32 + 8 * fq;
        f32x4 gf[2][2];
#pragma unroll
        for (int bj = 0; bj < 2; ++bj)
#pragma unroll
            for (int n = 0; n < 2; ++n) gf[bj][n] = *(const f32x4*)(gfin + cb + bj * 128 + 4 * n);
#pragma unroll
        for (int ai = 0; ai < 2; ++ai)
#pragma unroll
            for (int m = 0; m < 4; ++m) { const int r = ai * 128 + wr * 64 + m * 16 + fr; const float rs = S[r]; float* o = out + (size_t)(u.pm * 256 + r) * D + cb;
#pragma unroll
                for (int bj = 0; bj < 2; ++bj)
#pragma unroll
                    for (int n = 0; n < 2; ++n) { const pg8::f32x4 a = acc[ai][bj][m][n]; const f32x4 g4 = gf[bj][n];
                        *(f32x4*)(o + bj * 128 + 4 * n) = (f32x4){a[0] * rs * g4[0], a[1] * rs * g4[1], a[2] * rs * g4[2], a[3] * rs * g4[3]}; } }
    }
};
struct EpiResNorm {
    static constexpr bool PERM = true, AFTER_DRAIN = true;
    const bf16* xin; bf16* xout; bf16* hout; const float* modg; const float* gn; const float* modn; float* slots; unsigned* cnt;
    __device__ __forceinline__ void fused(pg8::f32x4 (&acc)[2][2][4][2], const pg8::Unit& u, int wr, int wc, int fr, int fq, LAS unsigned char* lds, int wid, int lane) const {
        panel_rms<true>(acc, u, wr, wc, fr, fq, lds, wid, lane, xin, xout, modg, slots, cnt);
        const LAS float* S = (const LAS float*)(lds + 4096); const int w = u.pm >> 5; const int cb = u.pn * 256 + wc * 32 + 8 * fq;
        f32x4 gm[2][2], shv[2][2];
#pragma unroll
        for (int bj = 0; bj < 2; ++bj)
#pragma unroll
            for (int n = 0; n < 2; ++n) { const int c = cb + bj * 128 + 4 * n; const f32x4 g4 = *(const f32x4*)(gn + c), s4 = *(const f32x4*)(modn + w * 6144 + 4096 + c);
                shv[bj][n] = *(const f32x4*)(modn + w * 6144 + 3072 + c); gm[bj][n] = (f32x4){g4[0] * (1.f + s4[0]), g4[1] * (1.f + s4[1]), g4[2] * (1.f + s4[2]), g4[3] * (1.f + s4[3])}; }
#pragma unroll
        for (int ai = 0; ai < 2; ++ai)
#pragma unroll
            for (int m = 0; m < 4; ++m) { const int r = ai * 128 + wr * 64 + m * 16 + fr; const float rs = S[r]; bf16* o = hout + (size_t)(u.pm * 256 + r) * D + cb;
#pragma unroll
                for (int bj = 0; bj < 2; ++bj) { const pg8::f32x4 a0 = acc[ai][bj][m][0], a1 = acc[ai][bj][m][1]; const f32x4 g0 = gm[bj][0], g1 = gm[bj][1], h0 = shv[bj][0], h1 = shv[bj][1];
                    u32x4 pk; pk.x = pg8::cvt_pk_bf16(a0[0] * rs * g0[0] + h0[0], a0[1] * rs * g0[1] + h0[1]); pk.y = pg8::cvt_pk_bf16(a0[2] * rs * g0[2] + h0[2], a0[3] * rs * g0[3] + h0[3]);
                    pk.z = pg8::cvt_pk_bf16(a1[0] * rs * g1[0] + h1[0], a1[1] * rs * g1[1] + h1[1]); pk.w = pg8::cvt_pk_bf16(a1[2] * rs * g1[2] + h1[2], a1[3] * rs * g1[3] + h1[3]);
                    *(u32x4*)(o + bj * 128) = pk; } }
    }
};
struct EpiUp {
    static constexpr bool PERM = true, AFTER_DRAIN = false;
    bf16* ACT; const float* cw; const float* cb;
    __device__ __forceinline__ void operator()(const pg8::f32x4 (&acc)[2][2][4][2], const pg8::Unit& u, int wr, int wc, int fr, int fq) const {
        const int hc0 = u.pn * 128 + wc * 32 + 8 * fq;
        const __amdgpu_buffer_rsrc_t ars = __builtin_amdgcn_make_buffer_rsrc(ACT, 0, MT * DFF * 2, 0x00020000);
#pragma unroll
        for (int ai = 0; ai < 2; ++ai) { const int blk = ai * 2 + wr;
            float res[4][8];
#pragma unroll
            for (int n = 0; n < 2; ++n) {
                const f32x4 w0 = *(const f32x4*)(cw + hc0 + 4 * n), w1 = *(const f32x4*)(cw + DFF + hc0 + 4 * n), w2 = *(const f32x4*)(cw + 2 * DFF + hc0 + 4 * n), bb = *(const f32x4*)(cb + hc0 + 4 * n);
#pragma unroll
                for (int e = 0; e < 4; ++e) {
                    float xs[4], ps[4], ns[4]; const float bprev = 0.f, bnext = 0.f;
#pragma unroll
                    for (int m = 0; m < 4; ++m) { xs[m] = acc[ai][0][m][n][e]; ps[m] = __builtin_bit_cast(float, __builtin_amdgcn_update_dpp(0, __builtin_bit_cast(int, xs[m]), 0x121, 0xf, 0xf, false)); ns[m] = __builtin_bit_cast(float, __builtin_amdgcn_update_dpp(0, __builtin_bit_cast(int, xs[m]), 0x12f, 0xf, 0xf, false)); }
#pragma unroll
                    for (int m = 0; m < 4; ++m) {
                        const float oldp = (m > 0) ? ps[m > 0 ? m - 1 : 0] : bprev, oldn = (m < 3) ? ns[m < 3 ? m + 1 : 3] : bnext;
                        const float prev = __builtin_bit_cast(float, __builtin_amdgcn_update_dpp(__builtin_bit_cast(int, oldp), __builtin_bit_cast(int, xs[m]), 0x111, 0xf, 0xf, false));
                        const float next = __builtin_bit_cast(float, __builtin_amdgcn_update_dpp(__builtin_bit_cast(int, oldn), __builtin_bit_cast(int, xs[m]), 0x101, 0xf, 0xf, false));
                        const float a = w0[e] * prev + w1[e] * xs[m] + w2[e] * next + bb[e];
                        res[m][4 * n + e] = silu_f(a) * acc[ai][1][m][n][e];
                    }
                }
            }
#pragma unroll
            for (int m = 0; m < 4; ++m) { const int r = u.pm * 256 + ai * 128 + wr * 64 + m * 16 + fr;
                u32x4 w; w.x = pg8::cvt_pk_bf16(res[m][0], res[m][1]); w.y = pg8::cvt_pk_bf16(res[m][2], res[m][3]); w.z = pg8::cvt_pk_bf16(res[m][4], res[m][5]); w.w = pg8::cvt_pk_bf16(res[m][6], res[m][7]);
                __builtin_amdgcn_raw_buffer_store_b128(w, ars, (unsigned)((r * DFF + hc0) * 2), 0, 16); }
        }
    }
};
struct EpiUpCtx {
    static constexpr bool PERM = true, AFTER_DRAIN = false;
    bf16* ACT; const float* cw; const float* cb; LAS float* ex;
    __device__ __forceinline__ void operator()(const pg8::f32x4 (&acc)[2][2][4][2], const pg8::Unit& u, int wr, int wc, int fr, int fq) const {
        const int hc0 = u.pn * 128 + wc * 32 + 8 * fq;
            const int colw = wc * 32 + 8 * fq;
#pragma unroll
            for (int ai = 0; ai < 2; ++ai) { const int blk = ai * 2 + wr;
                if (fr == 0) {
#pragma unroll
                    for (int n = 0; n < 2; ++n)
#pragma unroll
                        for (int e = 0; e < 4; ++e) ex[(blk * 2 + 0) * 128 + colw + 4 * n + e] = acc[ai][0][0][n][e]; }
                if (fr == 15) {
#pragma unroll
                    for (int n = 0; n < 2; ++n)
#pragma unroll
                        for (int e = 0; e < 4; ++e) ex[(blk * 2 + 1) * 128 + colw + 4 * n + e] = acc[ai][0][3][n][e]; } }
            asm volatile("s_waitcnt lgkmcnt(0)" ::: "memory"); __builtin_amdgcn_s_barrier(); asm volatile("" ::: "memory");
#pragma unroll
            for (int ai = 0; ai < 2; ++ai) { const int blk = ai * 2 + wr;
                float res[4][8];
    #pragma unroll
                for (int n = 0; n < 2; ++n) {
                    const f32x4 w0 = *(const f32x4*)(cw + hc0 + 4 * n), w1 = *(const f32x4*)(cw + DFF + hc0 + 4 * n), w2 = *(const f32x4*)(cw + 2 * DFF + hc0 + 4 * n), bb = *(const f32x4*)(cb + hc0 + 4 * n);
    #pragma unroll
                    for (int e = 0; e < 4; ++e) {
                        float xs[4], ps[4], ns[4]; float bprev = 0.f, bnext = 0.f; if (blk > 0) bprev = ex[((blk - 1) * 2 + 1) * 128 + colw + 4 * n + e]; if (blk < 3) bnext = ex[((blk + 1) * 2 + 0) * 128 + colw + 4 * n + e];
    #pragma unroll
                        for (int m = 0; m < 4; ++m) { xs[m] = acc[ai][0][m][n][e]; ps[m] = __builtin_bit_cast(float, __builtin_amdgcn_update_dpp(0, __builtin_bit_cast(int, xs[m]), 0x121, 0xf, 0xf, false)); ns[m] = __builtin_bit_cast(float, __builtin_amdgcn_update_dpp(0, __builtin_bit_cast(int, xs[m]), 0x12f, 0xf, 0xf, false)); }
    #pragma unroll
                        for (int m = 0; m < 4; ++m) {
                            const float prev = (fr > 0) ? ps[m] : (m > 0 ? ps[m > 0 ? m - 1 : 0] : bprev);
                            const float next = (fr < 15) ? ns[m] : (m < 3 ? ns[m < 3 ? m + 1 : 3] : bnext);
                            const float a = w0[e] * prev + w1[e] * xs[m] + w2[e] * next + bb[e];
                            res[m][4 * n + e] = silu_f(a) * acc[ai][1][m][n][e];
                        }
                    }
                }
    #pragma unroll
                for (int m = 0; m < 4; ++m) { const int r = u.pm * 256 + ai * 128 + wr * 64 + m * 16 + fr;
                    u32x4 w; w.x = pg8::cvt_pk_bf16(res[m][0], res[m][1]); w.y = pg8::cvt_pk_bf16(res[m][2], res[m][3]); w.z = pg8::cvt_pk_bf16(res[m][4], res[m][5]); w.w = pg8::cvt_pk_bf16(res[m][6], res[m][7]);
                    *(u32x4*)(ACT + (size_t)r * DFF + hc0) = w; }
            }

    }
};
struct CtxOrder {
    int nN, c, c0;
    __device__ void init(int N, int c_, int c0_) { nN = N / 256; c = c_; c0 = c0_; }
    __device__ bool next(int i, pg8::Unit& u) const { const int j = c - c0; if (i > 0 || j < 0 || j >= 2 * nN) return false; u.pm = 64 + (j & 1); u.pn = j >> 1; u.ks = 0; return true; }
    __device__ __forceinline__ void a_ready(const pg8::Unit&) const {}
    __device__ __forceinline__ void done(const pg8::Unit&) const {}
};

struct SplitOrder {
    int nunits, G, c;
    __device__ void init(int nks, int G_, int c_) { nunits = 8 * nks; G = G_; c = c_; }
    __device__ bool next(int i, pg8::Unit& u) const { const int id = i * G + c; if (id >= nunits) return false; u.pm = 64 + (id & 1); u.pn = (id >> 1) & 3; u.ks = id >> 3; return true; }
    __device__ __forceinline__ void a_ready(const pg8::Unit&) const {}
    __device__ __forceinline__ void done(const pg8::Unit&) const {}
};
struct EpiPartial {
    static constexpr bool PERM = false, AFTER_DRAIN = false;
    float* part;
    __device__ __forceinline__ void operator()(const pg8::f32x4 (&acc)[2][2][4][2], const pg8::Unit& u, int wr, int wc, int fr, int fq) const {
#pragma unroll
        for (int ai = 0; ai < 2; ++ai)
#pragma unroll
            for (int m = 0; m < 4; ++m) { const int r = u.pm * 256 + ai * 128 + wr * 64 + m * 16 + fr; float* o = part + ((size_t)u.ks * MC + (size_t)(r - ML)) * D;
#pragma unroll
                for (int bj = 0; bj < 2; ++bj)
#pragma unroll
                    for (int n = 0; n < 2; ++n) { const int c = u.pn * 256 + bj * 128 + wc * 32 + 16 * n + 4 * fq; const pg8::f32x4 a = acc[ai][bj][m][n];
                        *(f32x4*)(o + c) = (f32x4){a[0], a[1], a[2], a[3]}; } }
    }
};
typedef __attribute__((address_space(1))) unsigned gu32;
#define XB_TMO      128
#define XB_XCNT(j)  (256  + 64 * (j))
#define XB_XSUB(j)  (1280 + 64 * (j))
#define XB_XGEN(j)  (2304 + 64 * (j))
#define XB_TOP      3328
#define XB_TOPGEN   3392
#define XCD_BAR_WORDS 3456
#define XB_SPIN_CAP (1u << 18)

__device__ __forceinline__ unsigned xb_ld(unsigned* p)              { return __hip_atomic_load(p, __ATOMIC_RELAXED, __HIP_MEMORY_SCOPE_AGENT); }
__device__ __forceinline__ unsigned xb_add(unsigned* p, unsigned v) { return __hip_atomic_fetch_add(p, v, __ATOMIC_RELAXED, __HIP_MEMORY_SCOPE_AGENT); }
__device__ __forceinline__ unsigned xb_xcc_id() { return (unsigned)__builtin_amdgcn_s_getreg((3 << 11) | 20) & 0xFu; }
#define XB_SPIN(cond, bar) do { unsigned _sp = 0; while (cond) { __builtin_amdgcn_s_sleep(1); \
    if ((++_sp & 255u) == 0u) { if (xb_ld(&(bar)[XB_TMO])) break; if (_sp > XB_SPIN_CAP) { atomicAdd(&(bar)[XB_TMO], 1u); break; } } } } while (0)

struct XcdBarrier {
    unsigned* bar; unsigned x;
    volatile LAS unsigned* st;
};

__device__ __forceinline__ XcdBarrier xcd_barrier_post(unsigned* bar, volatile LAS unsigned* st, int tid_) {
    XcdBarrier b; b.bar = bar; b.x = xb_xcc_id(); b.st = st;
    if (tid_ == 0) (void)xb_add(&bar[XB_XCNT(b.x)], 1u);
    return b;
}
__device__ __forceinline__ void xcd_barrier_complete(unsigned* bar, unsigned x, unsigned& nloc, unsigned& nx) {
    const unsigned G = gridDim.x * gridDim.y * gridDim.z;
    unsigned sum, cnt, mine, sp = 0u;
    for (;;) {
        sum = 0u; cnt = 0u; mine = 0u;
#pragma unroll
        for (unsigned j = 0; j < 16; ++j) { const unsigned c = xb_ld(&bar[XB_XCNT(j)]); sum += c; cnt += (c > 0u) ? 1u : 0u; mine = (j == x) ? c : mine; }
        if (sum == G) break;
        __builtin_amdgcn_s_sleep(1);
        if ((++sp & 255u) == 0u) { if (xb_ld(&bar[XB_TMO])) break; if (sp > XB_SPIN_CAP) { atomicAdd(&bar[XB_TMO], 1u); break; } }
    }
    nloc = mine > 0u ? mine : 1u; nx = cnt > 0u ? cnt : 1u;
}

__device__ __forceinline__ void xcd_barrier(const XcdBarrier& b, int tid_) {
    asm volatile("s_waitcnt vmcnt(0)" ::: "memory");
    __syncthreads();
    if (tid_ == 0) {
        unsigned* bar = b.bar; asm volatile("" : "+s"(bar)); unsigned bx = (unsigned)__builtin_amdgcn_readfirstlane((int)b.x); asm volatile("" : "+s"(bx));
        __builtin_amdgcn_s_waitcnt(0);
        unsigned nloc = b.st[0], nx = b.st[1];
        if (nloc == 0u) { xcd_barrier_complete(bar, bx, nloc, nx); b.st[0] = nloc; b.st[1] = nx; }
        const unsigned old = xb_add(&bar[XB_XSUB(bx)], 1u);
        const unsigned gen = old / nloc;
        if (old + 1u == (gen + 1u) * nloc) {
            __builtin_amdgcn_fence(__ATOMIC_RELEASE, "agent");
            asm volatile("s_waitcnt vmcnt(0)" ::: "memory");
            const unsigned og = xb_add(&bar[XB_TOP], 1u);
            const unsigned tg = og / nx;
            if (og + 1u == (tg + 1u) * nx) xb_add(&bar[XB_TOPGEN], 1u);
            else XB_SPIN(xb_ld(&bar[XB_TOPGEN]) == tg, bar);
            __builtin_amdgcn_fence(__ATOMIC_ACQUIRE, "agent");
            xb_add(&bar[XB_XGEN(bx)], 1u);
            asm volatile("s_waitcnt vmcnt(0)" ::: "memory");
        } else {
            XB_SPIN(xb_ld(&bar[XB_XGEN(bx)]) == gen, bar);
            __builtin_amdgcn_fence(__ATOMIC_ACQUIRE, "agent");
            asm volatile("s_waitcnt vmcnt(0)" ::: "memory");
        }
    }
    __syncthreads();
}
struct Ctx {
    LAS unsigned char* lds; int tid, lane, wave, G, gw, NGW;
    float* MOD; float* MCS; bf16 *F1, *F2, *FC; bf16 *HX, *YMIX, *PB, *ACT, *TB, *CAU; float *XC, *ST, *DEC;
};
__device__ __forceinline__ bf16* win_t(PP p, int l) { return (bf16*)(p->ws + WS_W + (size_t)l * W_LAYER_B); }
__device__ __forceinline__ bf16* wout_t(PP p, int l) { return (bf16*)(p->ws + WS_W + (size_t)l * W_LAYER_B + W_IN_B); }
__device__ __forceinline__ bf16* wup_t(PP p, int l) { return (bf16*)(p->ws + WS_W + (size_t)l * W_LAYER_B + W_IN_B + W_OUT_B); }
__device__ __forceinline__ bf16* wdn_t(PP p, int l) { return (bf16*)(p->ws + WS_W + (size_t)l * W_LAYER_B + W_IN_B + W_OUT_B + W_UP_B); }

__device__ __forceinline__ void transpose_item(const float* W, int K, int N, bf16* WT, int k0, int n0, int dst0, float scale, LAS float* scr, int lane) {
#pragma unroll
    for (int i = 0; i < 32; ++i) { const int kk = 2 * i + (lane >> 5); scr[kk * 33 + (lane & 31)] = W[(size_t)(k0 + kk) * N + n0 + (lane & 31)] * scale; }
    LDS_WAIT(); __builtin_amdgcn_wave_barrier();
    const int c = lane & 7;
#pragma unroll
    for (int j = 0; j < 4; ++j) { const int n = (lane >> 3) + 8 * j; const LAS float* s = scr + (8 * c) * 33 + n;
        u32x4 o; o.x = pk2(s[0 * 33], s[1 * 33]); o.y = pk2(s[2 * 33], s[3 * 33]); o.z = pk2(s[4 * 33], s[5 * 33]); o.w = pk2(s[6 * 33], s[7 * 33]);
        *(u32x4*)(WT + (size_t)(dst0 + n) * K + k0 + 8 * c) = o; }
    LDS_WAIT(); __builtin_amdgcn_wave_barrier();
}

__device__ __forceinline__ void phase0(PP p, Ctx& F) {
    LAS float* sv = (LAS float*)F.lds; LAS float* red = sv + 3072;
    for (int i = F.tid; i < 3072; i += 512) { const int w = i >> 10, k = i & 1023; const float cv = (w < 2) ? p->c[w * 1024 + k] : p->c_ctx[k]; sv[i] = cv / (1.f + expf(-cv)); }
    __syncthreads();
    for (int it = blockIdx.x; it < 192; it += F.G) {
        const int l = it / 96, c0 = (it % 96) * 64; const float* W = p->w_mod + (size_t)l * 1024 * 6144 + c0 + F.lane;
        float a0 = 0.f, a1 = 0.f, a2 = 0.f; const int kb = F.wave * 128;
#pragma unroll 32
        for (int k = 0; k < 128; ++k) { const float wv = W[(size_t)(kb + k) * 6144]; a0 += sv[kb + k] * wv; a1 += sv[1024 + kb + k] * wv; a2 += sv[2048 + kb + k] * wv; }
        red[(F.wave * 3 + 0) * 64 + F.lane] = a0; red[(F.wave * 3 + 1) * 64 + F.lane] = a1; red[(F.wave * 3 + 2) * 64 + F.lane] = a2;
        __syncthreads();
        if (F.tid < 192) { const int w = F.tid >> 6, ln = F.tid & 63; float s = 0.f;
#pragma unroll
            for (int q = 0; q < 8; ++q) s += red[(q * 3 + w) * 64 + ln];
            F.MOD[(l * 3 + w) * 6144 + c0 + ln] = s + p->b_mod[l * 6144 + c0 + ln]; }
        __syncthreads();
    }
    __syncthreads();
    LAS float* scr = (LAS float*)(F.lds + F.wave * 16384);
    constexpr int I_IN = 48 * 16, I_OUT = 32 * 16, I_UP = 176 * 16, I_DN = 32 * 44, I_L = I_IN + I_OUT + I_UP + I_DN;
    for (int it = F.gw; it < 2 * I_L; it += F.NGW) {
        const int l = it / I_L; int r = it % I_L;
        if (r < I_IN) { const int cb = r / 16, kb = r % 16; int src, dst; float sc = 1.f;
            if (cb < 4) { src = 32 * cb; dst = PK + 32 * cb; }
            else if (cb < 8) { src = 416 + 32 * (cb - 4); dst = PQ + 32 * (cb - 4); sc = 0.17677669529663687f; }
            else if (cb < 16) { src = 128 + 32 * (cb - 8); dst = PV + 32 * (cb - 8); }
            else if (cb < 24) { src = 544 + 32 * (cb - 16); dst = PG + 32 * (cb - 16); }
            else if (cb < 32) { src = 1056 + 32 * (cb - 24); dst = PH + 32 * (cb - 24); }
            else if (cb < 40) { src = 1312 + 32 * (cb - 32); dst = PBG + 32 * (cb - 32); }
            else { src = 1568 + 32 * (cb - 40); dst = PCG + 32 * (cb - 40); }
            transpose_item(p->w_in + (size_t)l * D * DIN, D, DIN, win_t(p, l), 64 * kb, src, dst, sc, scr, F.lane); continue; }
        r -= I_IN;
        if (r < I_OUT) { const int cb = r / 16, kb = r % 16; transpose_item(p->w_out + (size_t)l * D * D, D, D, wout_t(p, l), 64 * kb, 32 * cb, 32 * cb, 1.f, scr, F.lane); continue; }
        r -= I_OUT;
        if (r < I_UP) { const int cb = r / 16, kb = r % 16; const int c = 32 * cb, isu = (c >= DFF) ? 1 : 0, j = c - isu * DFF; const int dst = (j / 128) * 256 + isu * 128 + (j % 128);
            transpose_item(p->w_up + (size_t)l * D * NUP, D, NUP, wup_t(p, l), 64 * kb, c, dst, 1.f, scr, F.lane); continue; }
        r -= I_UP;
        { const int cb = r / 44, kb = r % 44; transpose_item(p->w_down + (size_t)l * DFF * D, DFF, D, wdn_t(p, l), 64 * kb, 32 * cb, 32 * cb, 1.f, scr, F.lane); }
    }
    const int gt = blockIdx.x * 512 + F.tid, NT = F.G * 512;
    const int gtm = (F.G == 256) ? ((int)blockIdx.x - 192) * 512 + F.tid : gt; const int NTm = (F.G == 256) ? 32768 : NT;
    for (int i = gtm; i >= 0 && i < 32768; i += NTm) { const int d = i & 63, c = (i >> 6) & 63, g = (i >> 12) & 3, l = i >> 14;
        const float* wf = p->fft_w + (size_t)((l * 4 + g) * 64) * 64 + d; float mc = 0.f, ms = 0.f;
        for (int f = 0; f < 64; ++f) { const float a = (float)((f * c) & 63) * (1.f / 64.f); const float w = wf[f * 64]; mc += cos_rev(a) * w; ms -= sin_rev(a) * w; }
        F.MCS[(((l * 4 + g) * 2 + 0) * 64 + c) * 64 + d] = mc * 0.125f; F.MCS[(((l * 4 + g) * 2 + 1) * 64 + c) * 64 + d] = ms * 0.125f; }
    for (int i = gt; i < MC * D / 4; i += NT) ((f32x4*)F.XC)[i] = ((const f32x4*)p->ctx)[i];
    for (int i = gt; i < 180224; i += NT) {
        if (i < 16384) { const int mm = i >> 7, kk = i & 127, k1 = mm & 63, n1 = kk & 63; const float a = (float)((k1 * n1) & 63) * (1.f / 64.f); const float C = cos_rev(a), S = sin_rev(a);
            const float v = (mm < 64) ? (kk < 64 ? C : S) : (kk < 64 ? -S : C); F.F1[i] = (bf16)f2bf(v); }
        else if (i < 49152) { const int j = i - 16384, k2 = j >> 8, kk = j & 255, n2 = kk & 127; const float a = (float)((k2 * n2) & 127) * (1.f / 128.f);
            const float v = (kk < 128 ? cos_rev(a) : sin_rev(a)) * 0.011048543456039806f; F.F2[j] = (bf16)f2bf(v); }
        else { const int j = i - 49152, k = j >> 9, kk = j & 511, n = kk & 255; const float a = (float)((k * n) & 255) * (1.f / 256.f);
            const float v = (kk < 256 ? cos_rev(a) : sin_rev(a)) * 0.0625f; F.FC[j] = (bf16)f2bf(v); }
    }
}

__device__ __forceinline__ void fold_items(PP p, Ctx& F) {
    for (int it4 = F.gw; it4 < 1792; it4 += F.NGW) {
        const int dq = it4 & 3, it = it4 >> 2;
        const int l = it / 224, r = it % 224, s = r / 16, kb = r % 16; const int k = 64 * kb + F.lane;
        const float* wrow = p->w_in + (size_t)l * D * DIN + (size_t)k * DIN; bf16* WT = win_t(p, l);
        if (s < 2) {
            const f32x4* src = (const f32x4*)(wrow + 384 + 16 * s); f32x4 r4[4];
#pragma unroll
            for (int q = 0; q < 4; ++q) r4[q] = src[q];
            const float* M = p->w_a2 + (size_t)((l * 2 + s) * 16) * 128;
            for (int d = 32 * dq; d < 32 * dq + 32; ++d) { float a = 0.f;
#pragma unroll
                for (int c = 0; c < 16; ++c) a += r4[c >> 2][c & 3] * M[c * 128 + d];
                WT[(size_t)(PLA + s * 128 + d) * D + k] = (bf16)f2bf(a); }
        } else {
            const int kind = (s - 2) >> 2, g = (s - 2) & 3;
            const f32x4* src = (const f32x4*)(wrow + (kind < 2 ? 800 : 1824) + 64 * g); f32x4 r4[16];
#pragma unroll
            for (int q = 0; q < 16; ++q) r4[q] = src[q];
            const float* M = (kind < 2) ? (F.MCS + (size_t)(((l * 4 + g) * 2 + kind) * 64) * 64) : (p->pool_w + (size_t)((l * 4 + g) * 64) * 64);
            const int drow = (kind == 0 ? PFA : (kind == 1 ? PFB : PPOOL)) + 64 * g;
            for (int d = 16 * dq; d < 16 * dq + 16; ++d) { float a = 0.f;
#pragma unroll
                for (int c = 0; c < 64; ++c) a += r4[c >> 2][c & 3] * M[c * 64 + d];
                if (kind == 2) a *= p->pool_scale[l * 256 + g * 64 + d];
                WT[(size_t)(drow + d) * D + k] = (bf16)f2bf(a); }
        }
    }
}

__device__ __forceinline__ void norm_row_bf16(const float* xrow, bf16* orow, const float* g, const float* sc, const float* sh, int lane, const float* part, int nparts, const float* gate, float* xout) {
    f32x4 v[4]; float s = 0.f;
#pragma unroll
    for (int j = 0; j < 4; ++j) v[j] = ((const f32x4*)xrow)[lane + 64 * j];
    if (nparts > 0) {
        f32x4 a[4];
#pragma unroll
        for (int j = 0; j < 4; ++j) a[j] = (f32x4){0.f, 0.f, 0.f, 0.f};
        for (int q = 0; q < nparts; ++q) {
#pragma unroll
            for (int j = 0; j < 4; ++j) { const f32x4 t = ((const f32x4*)(part + (size_t)q * MC * D))[lane + 64 * j]; a[j][0] += t[0]; a[j][1] += t[1]; a[j][2] += t[2]; a[j][3] += t[3]; } }
#pragma unroll
        for (int j = 0; j < 4; ++j) { const f32x4 gv = ((const f32x4*)gate)[lane + 64 * j];
#pragma unroll
            for (int e = 0; e < 4; ++e) v[j][e] += gv[e] * a[j][e];
            ((f32x4*)xout)[lane + 64 * j] = v[j]; }
    }
#pragma unroll
    for (int j = 0; j < 4; ++j) s += (v[j][0] * v[j][0] + v[j][1] * v[j][1]) + (v[j][2] * v[j][2] + v[j][3] * v[j][3]);
    const float rstd = 1.f / sqrtf(wave_sum(s, lane) * (1.f / D) + EPS);
#pragma unroll
    for (int j = 0; j < 4; ++j) { const int idx = lane + 64 * j; const f32x4 gv = ((const f32x4*)g)[idx], scv = ((const f32x4*)sc)[idx], shv = ((const f32x4*)sh)[idx];
        float y[4];
#pragma unroll
        for (int e = 0; e < 4; ++e) y[e] = v[j][e] * rstd * gv[e] * (1.f + scv[e]) + shv[e];
        u32x2 o; o.x = pk2(y[0], y[1]); o.y = pk2(y[2], y[3]); ((u32x2*)orow)[idx] = o; }
}
template <bool FINAL, bool INB>
__device__ __forceinline__ void norm_rows4(const void* xbase, bf16* obase, float* fout, const float* g, const float* modl, int which, int m0, int stride, int lane) {
    f32x4 v[4][4]; float s[4]; int mk[4]; bool ok[4];
#pragma unroll
    for (int k = 0; k < 4; ++k) { const int m = m0 + k * stride; ok[k] = m < ML; mk[k] = ok[k] ? m : ML - 1;
#pragma unroll
        for (int j = 0; j < 4; ++j) {
            if (INB) { const u32x2 t = ((const u32x2*)((const bf16*)xbase + (size_t)mk[k] * D))[lane + 64 * j]; v[k][j] = (f32x4){bflo(t.x), bfhi(t.x), bflo(t.y), bfhi(t.y)}; }
            else v[k][j] = ((const f32x4*)((const float*)xbase + (size_t)mk[k] * D))[lane + 64 * j]; } }
    f32x4 gm[4], sh4[4];
    { const float* mod = FINAL ? g : modl + (m0 >> 13) * 6144 + which * 3072;
#pragma unroll
      for (int j = 0; j < 4; ++j) { const int idx = lane + 64 * j; const f32x4 gv = ((const f32x4*)g)[idx];
          if (FINAL) { gm[j] = gv; sh4[j] = (f32x4){0.f, 0.f, 0.f, 0.f}; }
          else { const f32x4 scv = ((const f32x4*)(mod + 1024))[idx]; sh4[j] = ((const f32x4*)mod)[idx];
#pragma unroll
              for (int e = 0; e < 4; ++e) gm[j][e] = gv[e] * (1.f + scv[e]); } } }
#pragma unroll
    for (int k = 0; k < 4; ++k) { float a = 0.f;
#pragma unroll
        for (int j = 0; j < 4; ++j) a += (v[k][j][0] * v[k][j][0] + v[k][j][1] * v[k][j][1]) + (v[k][j][2] * v[k][j][2] + v[k][j][3] * v[k][j][3]);
        s[k] = a; }
#pragma unroll
    for (int o = 1; o < 64; o <<= 1) {
#pragma unroll
        for (int k = 0; k < 4; ++k) s[k] += shfl_f(s[k], lane ^ o); }
#pragma unroll
    for (int k = 0; k < 4; ++k) { if (!ok[k]) continue;
        const float rstd = 1.f / sqrtf(s[k] * (1.f / D) + EPS);
#pragma unroll
        for (int j = 0; j < 4; ++j) { const int idx = lane + 64 * j;
            if (FINAL) { f32x4 y;
#pragma unroll
                for (int e = 0; e < 4; ++e) y[e] = v[k][j][e] * rstd * gm[j][e];
                ((f32x4*)(fout + (size_t)mk[k] * D))[idx] = y; }
            else { float y[4];
#pragma unroll
                for (int e = 0; e < 4; ++e) y[e] = v[k][j][e] * rstd * gm[j][e] + sh4[j][e];
                u32x2 o; o.x = pk2(y[0], y[1]); o.y = pk2(y[2], y[3]); ((u32x2*)(obase + (size_t)mk[k] * D))[idx] = o; } }
    }
}
__device__ __forceinline__ void norm_phase(PP p, Ctx& F, int l, int which, int mrows) {
    const float* g = (which == 0 ? p->norm1_g : p->norm2_g) + l * D;
    const float* PART = (const float*)(p->ws + WS_PART);
    if (l == 0 && which == 0) { for (int m0 = F.gw; m0 < ML; m0 += 4 * F.NGW) norm_rows4<false, false>(p->x, F.HX, nullptr, g, F.MOD + l * 3 * 6144, which, m0, F.NGW, F.lane); }
    else { const void* xb = (l == 1 && which == 1 && F.G == 256) ? (const void*)(p->ws + WS_XB2) : (const void*)p->out;
        for (int m0 = F.gw; m0 < ML; m0 += 4 * F.NGW) norm_rows4<false, true>(xb, F.HX, nullptr, g, F.MOD + l * 3 * 6144, which, m0, F.NGW, F.lane); }
    for (int m = ML + F.gw; m < mrows; m += F.NGW) {
        int nparts = 0; const float* gate = nullptr;
        const float* xr = ((l == 0 && which == 0) ? p->ctx : F.XC) + (size_t)(m - ML) * D;
        if (l == 0 && which == 1) { nparts = 4; gate = F.MOD + 2 * 6144 + 2048; }
        if (l == 1 && which == 0) { nparts = 11; gate = F.MOD + 2 * 6144 + 5120; }
        const float* part = PART + (size_t)(m - ML) * D; float* xout = F.XC + (size_t)(m - ML) * D;
        const float* mod = F.MOD + (l * 3 + 2) * 6144 + which * 3072;
        norm_row_bf16(xr, F.HX + (size_t)m * D, g, mod + 1024, mod, F.lane, part, nparts, gate, xout);
    }
}
__device__ __forceinline__ void final_norm(PP p, Ctx& F) {
    for (int m0 = F.gw; m0 < ML; m0 += 4 * F.NGW) norm_rows4<true, false>(p->ws + WS_HX  , nullptr, p->out, p->final_g, nullptr, 0, m0, F.NGW, F.lane);
}
constexpr int CP = 260;
__device__ __forceinline__ int chunk_row0(int b, int cidx) { return (cidx < 4) ? (ML + b * CTXL + cidx * 64) : (b * SEQ + (cidx - 4) * 64); }
__device__ __forceinline__ void cum_to_lds(LAS float* cum, const bf16* PB, int row0, int tid) {
    { const int oct = tid & 31, j0 = tid >> 5; u32x4 w[4];
#pragma unroll
      for (int q = 0; q < 4; ++q) w[q] = *(const u32x4*)(PB + (size_t)(row0 + j0 + 16 * q) * NP + PLA + 8 * oct);
#pragma unroll
      for (int q = 0; q < 4; ++q) { LAS float* d = cum + (j0 + 16 * q) * CP + 8 * oct;
          *(LAS f32x4*)d = (f32x4){bflo(w[q].x), bfhi(w[q].x), bflo(w[q].y), bfhi(w[q].y)}; *(LAS f32x4*)(d + 4) = (f32x4){bflo(w[q].z), bfhi(w[q].z), bflo(w[q].w), bfhi(w[q].w)}; } }
    __syncthreads();
    if (tid < 256) { float s = 0.f;
        if (tid < 128) {
#pragma unroll 16
            for (int j = 0; j < 64; ++j) { s += cum[j * CP + tid]; cum[j * CP + tid] = s; }
        } else {
#pragma unroll 16
            for (int j = 63; j >= 0; --j) { s += cum[j * CP + tid]; cum[j * CP + tid] = s; }
        } }
    __syncthreads();
}
typedef float f32x2_t __attribute__((ext_vector_type(2)));
typedef __bf16 bf16x2_t __attribute__((ext_vector_type(2)));
__device__ __forceinline__ unsigned pkh(float lo, float hi) { f32x2_t v = {lo, hi}; bf16x2_t b = __builtin_convertvector(v, bf16x2_t); return __builtin_bit_cast(unsigned, b); }
__device__ __forceinline__ bf16x8 pack8h(float a0, float a1, float a2, float a3, float a4, float a5, float a6, float a7) {
    u32x4 w; w.x = pkh(a0, a1); w.y = pkh(a2, a3); w.z = pkh(a4, a5); w.w = pkh(a6, a7); return __builtin_bit_cast(bf16x8, w);
}
__device__ __forceinline__ void la_load(u32x4 (&w)[4], const bf16* PB, int row0, int tid) {
    const int oct = tid & 31, j0 = tid >> 5;
#pragma unroll
    for (int q = 0; q < 4; ++q) w[q] = *(const u32x4*)(PB + (size_t)(row0 + j0 + 16 * q) * NP + PLA + 8 * oct);
}
__device__ __forceinline__ void la_scan(LAS float* cum, const u32x4 (&w)[4], int tid) {
    const int oct = tid & 31, j0 = tid >> 5;
#pragma unroll
    for (int q = 0; q < 4; ++q) { LAS float* d = cum + (j0 + 16 * q) * CP + 8 * oct;
        *(LAS f32x4*)d = (f32x4){bflo(w[q].x), bfhi(w[q].x), bflo(w[q].y), bfhi(w[q].y)}; *(LAS f32x4*)(d + 4) = (f32x4){bflo(w[q].z), bfhi(w[q].z), bflo(w[q].w), bfhi(w[q].w)}; }
    __syncthreads();
    if (tid < 256) { float carry = 0.f;
        if (tid < 128) {
#pragma unroll
            for (int hf = 0; hf < 4; ++hf) { float v[16];
#pragma unroll
                for (int j = 0; j < 16; ++j) v[j] = cum[(16 * hf + j) * CP + tid];
                v[0] += carry;
#pragma unroll
                for (int j = 1; j < 16; ++j) v[j] += v[j - 1];
                carry = v[15];
#pragma unroll
                for (int j = 0; j < 16; ++j) cum[(16 * hf + j) * CP + tid] = v[j]; }
        } else {
#pragma unroll
            for (int hf = 3; hf >= 0; --hf) { float v[16];
#pragma unroll
                for (int j = 0; j < 16; ++j) v[j] = cum[(16 * hf + j) * CP + tid];
                v[15] += carry;
#pragma unroll
                for (int j = 14; j >= 0; --j) v[j] += v[j + 1];
                carry = v[0];
#pragma unroll
                for (int j = 0; j < 16; ++j) cum[(16 * hf + j) * CP + tid] = v[j]; }
        } }
    __syncthreads();
}
__device__ __forceinline__ void gla_a_item(Ctx& F, int b, int cidx) {
    LAS float* cum = (LAS float*)F.lds; const int row0 = chunk_row0(b, cidx);
    const int h = F.wave & 3, dir = F.wave >> 2, chb = dir * 128 + h * 32, lr = F.lane & 15, g = F.lane >> 4;
    const int jl = dir ? 0 : 63;
    u32x4 wla[4]; la_load(wla, F.PB, row0, F.tid);
    unsigned short kt[2][2][8], vt[2][4][8];
#pragma unroll
    for (int ks = 0; ks < 2; ++ks) { const int j0 = 32 * ks + 8 * g;
#pragma unroll
        for (int mb = 0; mb < 2; ++mb)
#pragma unroll
            for (int e = 0; e < 8; ++e) kt[ks][mb][e] = F.PB[(size_t)(row0 + j0 + e) * NP + PK + h * 32 + 16 * mb + lr];
#pragma unroll
        for (int nb = 0; nb < 4; ++nb)
#pragma unroll
            for (int e = 0; e < 8; ++e) vt[ks][nb][e] = F.PB[(size_t)(row0 + j0 + e) * NP + PV + h * 64 + 16 * nb + lr]; }
    la_scan(cum, wla, F.tid);
    f32x4 acc[2][4];
#pragma unroll
    for (int mb = 0; mb < 2; ++mb)
#pragma unroll
        for (int nb = 0; nb < 4; ++nb) acc[mb][nb] = (f32x4){0.f, 0.f, 0.f, 0.f};
#pragma unroll
    for (int ks = 0; ks < 2; ++ks) {
        bf16x8 af[2], bfr[4]; const int j0 = 32 * ks + 8 * g;
#pragma unroll
        for (int mb = 0; mb < 2; ++mb) { const int dk = 16 * mb + lr; const float last = cum[jl * CP + chb + dk]; float a[8];
#pragma unroll
            for (int e = 0; e < 8; ++e) { const int j = j0 + e; a[e] = bf2f(kt[ks][mb][e]) * __expf(last - cum[j * CP + chb + dk]); }
            af[mb] = pack8h(a[0], a[1], a[2], a[3], a[4], a[5], a[6], a[7]); }
#pragma unroll
        for (int nb = 0; nb < 4; ++nb) { const unsigned short* t = vt[ks][nb];
            u32x4 w; w.x = t[0] | ((unsigned)t[1] << 16); w.y = t[2] | ((unsigned)t[3] << 16); w.z = t[4] | ((unsigned)t[5] << 16); w.w = t[6] | ((unsigned)t[7] << 16);
            bfr[nb] = __builtin_bit_cast(bf16x8, w); }
#pragma unroll
        for (int mb = 0; mb < 2; ++mb)
#pragma unroll
            for (int nb = 0; nb < 4; ++nb) acc[mb][nb] = MFMA16(af[mb], bfr[nb], acc[mb][nb]);
    }
    const size_t sidx = (size_t)(((b * 2 + dir) * 4 + h) * NCH + cidx);
    float* st = F.ST + sidx * 2048;
#pragma unroll
    for (int mb = 0; mb < 2; ++mb)
#pragma unroll
        for (int nb = 0; nb < 4; ++nb) *(f32x4*)(st + (16 * nb + lr) * 32 + 16 * mb + 4 * g) = acc[mb][nb];
    if (F.lane < 32) F.DEC[sidx * 32 + F.lane] = __expf(cum[jl * CP + chb + F.lane]);
    __syncthreads();
}
__device__ __forceinline__ void gla_scan(Ctx& F) {
    LAS float* xa = (LAS float*)F.lds; LAS float* xb = xa + 512;
    const int seg = F.tid >> 6, el = F.tid & 63;
    for (int blk = blockIdx.x; blk < 512; blk += F.G) {
        const int ge = blk * 64 + el, e = ge & 2047, seq = ge >> 11, dir = (seq >> 2) & 1, dk = e & 31;
        float* st = F.ST + (size_t)seq * NCH * 2048 + e; const float* dc = F.DEC + (size_t)seq * NCH * 32 + dk;
        float u[17], d[17];
#pragma unroll
        for (int i = 0; i < 17; ++i) { const int s = seg * 17 + i; const bool ok = s < NCH; const int sc = ok ? s : NCH - 1; const int c = dir ? (sc < 4 ? 3 - sc : 135 - sc) : sc;
            const float uu = st[(size_t)c * 2048], dd = dc[c * 32]; u[i] = ok ? uu : 0.f; d[i] = ok ? dd : 1.f; }
        float A = 1.f, B = 0.f;
#pragma unroll
        for (int i = 0; i < 17; ++i) { B = B * d[i] + u[i]; A *= d[i]; }
        xa[F.tid] = A; xb[F.tid] = B;
        __syncthreads();
        float S = 0.f;
        for (int sg = 0; sg < seg; ++sg) S = S * xa[sg * 64 + el] + xb[sg * 64 + el];
#pragma unroll
        for (int i = 0; i < 17; ++i) { const int s = seg * 17 + i; if (s < NCH) { const int c = dir ? (s < 4 ? 3 - s : 135 - s) : s; st[(size_t)c * 2048] = S; } S = S * d[i] + u[i]; }
        __syncthreads();
    }
}
template <int NI>
__device__ __forceinline__ void gla_c_item(PP p, Ctx& F, int l, int b, int cidx, int sub) {
    LAS float* cum = (LAS float*)F.lds; const int row0 = chunk_row0(b, cidx);
    const int h = F.wave & 3, half = (NI == 2) ? (F.wave >> 2) : sub, ibase = (NI == 2) ? 0 : (F.wave >> 2), lr = F.lane & 15, g = F.lane >> 4;
    u32x4 wla[4]; la_load(wla, F.PB, row0, F.tid);
    f32x4 o[4][2];
#pragma unroll
    for (int mb = 0; mb < 4; ++mb) { o[mb][0] = (f32x4){0.f, 0.f, 0.f, 0.f}; o[mb][1] = (f32x4){0.f, 0.f, 0.f, 0.f}; }
    bf16x8 av[4][2];
#pragma unroll
    for (int mb = 0; mb < 4; ++mb)
#pragma unroll
        for (int pp = 0; pp < 2; ++pp) { unsigned short t[8];
#pragma unroll
            for (int e = 0; e < 8; ++e) { const int j = 32 * pp + (e < 4 ? 4 * g + e : 16 + 4 * g + (e - 4)); t[e] = F.PB[(size_t)(row0 + j) * NP + PV + h * 64 + 16 * mb + lr]; }
            u32x4 w; w.x = t[0] | ((unsigned)t[1] << 16); w.y = t[2] | ((unsigned)t[3] << 16); w.z = t[4] | ((unsigned)t[5] << 16); w.w = t[6] | ((unsigned)t[7] << 16);
            av[mb][pp] = __builtin_bit_cast(bf16x8, w); }
    u32x4 qraw[2], kraw[4]; f32x4 sraw[2][4][2];
#pragma unroll
    for (int ibl = 0; ibl < NI; ++ibl) qraw[ibl] = *(const u32x4*)(F.PB + (size_t)(row0 + 16 * (2 * half + ibase + ibl) + lr) * NP + PQ + h * 32 + 8 * g);
#pragma unroll
    for (int jb = 0; jb < 4; ++jb) kraw[jb] = *(const u32x4*)(F.PB + (size_t)(row0 + 16 * jb + lr) * NP + PK + h * 32 + 8 * g);
    { const float* st = F.ST + (size_t)(((b * 2 + 0) * 4 + h) * NCH + cidx) * 2048;
#pragma unroll
        for (int mb = 0; mb < 4; ++mb) { sraw[0][mb][0] = *(const f32x4*)(st + (16 * mb + lr) * 32 + 8 * g); sraw[0][mb][1] = *(const f32x4*)(st + (16 * mb + lr) * 32 + 8 * g + 4); } }
    la_scan(cum, wla, F.tid);
    { const float* st = F.ST + (size_t)(((b * 2 + 1) * 4 + h) * NCH + cidx) * 2048;
#pragma unroll
        for (int mb = 0; mb < 4; ++mb) { sraw[1][mb][0] = *(const f32x4*)(st + (16 * mb + lr) * 32 + 8 * g); sraw[1][mb][1] = *(const f32x4*)(st + (16 * mb + lr) * 32 + 8 * g + 4); } }
#pragma unroll
    for (int dir = 0; dir < 2; ++dir) {
        const int chb = dir * 128 + h * 32;
        bf16x8 bq[2];
#pragma unroll
        for (int ibl = 0; ibl < NI; ++ibl) { const int i = 16 * (2 * half + ibase + ibl) + lr;
            const u32x4 qw = qraw[ibl];
            const f32x4 c0 = *(const LAS f32x4*)(cum + i * CP + chb + 8 * g), c1 = *(const LAS f32x4*)(cum + i * CP + chb + 8 * g + 4);
            bq[ibl] = pack8h(bflo(qw.x) * __expf(c0[0]), bfhi(qw.x) * __expf(c0[1]), bflo(qw.y) * __expf(c0[2]), bfhi(qw.y) * __expf(c0[3]),
                            bflo(qw.z) * __expf(c1[0]), bfhi(qw.z) * __expf(c1[1]), bflo(qw.w) * __expf(c1[2]), bfhi(qw.w) * __expf(c1[3])); }
#pragma unroll
        for (int mb = 0; mb < 4; ++mb) { const f32x4 s0 = sraw[dir][mb][0], s1 = sraw[dir][mb][1];
            const bf16x8 as = pack8h(s0[0], s0[1], s0[2], s0[3], s1[0], s1[1], s1[2], s1[3]);
            o[mb][0] = MFMA16(as, bq[0], o[mb][0]); if (NI == 2) o[mb][1] = MFMA16(as, bq[1], o[mb][1]); }
#pragma unroll
        for (int pp = 0; pp < 2; ++pp) {
            if ((dir == 0 && half == 0 && pp == 1) || (dir == 1 && half == 1 && pp == 0)) continue;
            f32x4 sc[2][2];
#pragma unroll
            for (int q = 0; q < 2; ++q) { const int jb = 2 * pp + q, j = 16 * jb + lr;
                const u32x4 kw = kraw[jb];
                const f32x4 c0 = *(const LAS f32x4*)(cum + j * CP + chb + 8 * g), c1 = *(const LAS f32x4*)(cum + j * CP + chb + 8 * g + 4);
                const bf16x8 ak = pack8h(bflo(kw.x) * __expf(-c0[0]), bfhi(kw.x) * __expf(-c0[1]), bflo(kw.y) * __expf(-c0[2]), bfhi(kw.y) * __expf(-c0[3]),
                                        bflo(kw.z) * __expf(-c1[0]), bfhi(kw.z) * __expf(-c1[1]), bflo(kw.w) * __expf(-c1[2]), bfhi(kw.w) * __expf(-c1[3]));
#pragma unroll
                for (int ibl = 0; ibl < NI; ++ibl) { f32x4 z = (f32x4){0.f, 0.f, 0.f, 0.f}; z = MFMA16(ak, bq[ibl], z);
                    const int i = 16 * (2 * half + ibase + ibl) + lr;
#pragma unroll
                    for (int r = 0; r < 4; ++r) { const int jj = 16 * jb + 4 * g + r; const bool keep = dir ? (jj >= i) : (jj <= i); z[r] = keep ? z[r] : 0.f; }
                    sc[q][ibl] = z; } }
#pragma unroll
            for (int ibl = 0; ibl < NI; ++ibl) { const bf16x8 pb = pack8h(sc[0][ibl][0], sc[0][ibl][1], sc[0][ibl][2], sc[0][ibl][3], sc[1][ibl][0], sc[1][ibl][1], sc[1][ibl][2], sc[1][ibl][3]);
#pragma unroll
                for (int mb = 0; mb < 4; ++mb) o[mb][ibl] = MFMA16(av[mb][pp], pb, o[mb][ibl]); }
        }
    }
    const float* gg = p->gla_g + l * 64;
#pragma unroll
    for (int ibl = 0; ibl < NI; ++ibl) { float ss = 0.f;
#pragma unroll
        for (int mb = 0; mb < 4; ++mb) ss += (o[mb][ibl][0] * o[mb][ibl][0] + o[mb][ibl][1] * o[mb][ibl][1]) + (o[mb][ibl][2] * o[mb][ibl][2] + o[mb][ibl][3] * o[mb][ibl][3]);
        ss += shfl_f(ss, F.lane ^ 16); ss += shfl_f(ss, F.lane ^ 32);
        const float rstd = 1.f / sqrtf(ss * (1.f / 64.f) + EPS);
        const int i = 16 * (2 * half + ibase + ibl) + lr; const size_t row = (size_t)(row0 + i);
#pragma unroll
        for (int mb = 0; mb < 4; ++mb) { const int dv = 16 * mb + 4 * g; const f32x4 gv = *(const f32x4*)(gg + dv);
            const u32x2 gw = *(const u32x2*)(F.PB + row * NP + PG + h * 64 + dv);
            const float y0 = o[mb][ibl][0] * rstd * gv[0] * silu_f(bflo(gw.x)), y1 = o[mb][ibl][1] * rstd * gv[1] * silu_f(bfhi(gw.x));
            const float y2 = o[mb][ibl][2] * rstd * gv[2] * silu_f(bflo(gw.y)), y3 = o[mb][ibl][3] * rstd * gv[3] * silu_f(bfhi(gw.y));
            u32x2 w; w.x = pk2(y0, y1); w.y = pk2(y2, y3); *(u32x2*)(F.YMIX + row * D + h * 64 + dv) = w; }
    }
    __syncthreads();
}

template <int NKS, int GRP>
__device__ __forceinline__ void dft_mma_lds(f32x4 (&acc)[8], const LAS unsigned char* fl, int pitchB, const bf16* re, const bf16* im, size_t rstride, int khalf, int lane) {
    const int lr = lane & 15, g = lane >> 4;
#pragma unroll
    for (int k0 = 0; k0 < NKS; k0 += GRP) {
        bf16x8 bfrag[GRP];
#pragma unroll
        for (int kq = 0; kq < GRP; ++kq) { const int ks = k0 + kq; const int kk0 = 32 * ks + 8 * g; const bool part = kk0 >= khalf; const int idx = part ? kk0 - khalf : kk0;
            const bf16* src = (part ? im : re) + (size_t)idx * rstride + lr; unsigned short t[8];
#pragma unroll
            for (int e = 0; e < 8; ++e) t[e] = src[(size_t)e * rstride];
            u32x4 w; w.x = t[0] | ((unsigned)t[1] << 16); w.y = t[2] | ((unsigned)t[3] << 16); w.z = t[4] | ((unsigned)t[5] << 16); w.w = t[6] | ((unsigned)t[7] << 16);
            bfrag[kq] = __builtin_bit_cast(bf16x8, w); }
#pragma unroll
        for (int kq = 0; kq < GRP; ++kq) { const int ks = k0 + kq;
#pragma unroll
            for (int mb = 0; mb < 8; ++mb) { const bf16x8 a = *(const LAS bf16x8*)(fl + (16 * mb + lr) * pitchB + (32 * ks + 8 * g) * 2); acc[mb] = MFMA16(a, bfrag[kq], acc[mb]); }
        }
    }
}
__device__ __forceinline__ void f_to_lds(LAS unsigned char* fl, const bf16* Fm, int rows, int rowB, int tid) {
    const int cpr = rowB >> 4, n = rows * cpr;
    for (int i = tid; i < n; i += 512) { const int r = i / cpr, c = i - r * cpr; *(LAS u32x4*)(fl + r * (rowB + 16) + c * 16) = *(const u32x4*)((const unsigned char*)Fm + (size_t)r * rowB + c * 16); }
    __syncthreads();
}
template <int NKS, int GRP = 4, int NMB = 8>
__device__ __forceinline__ void dft_mma(f32x4 (&acc)[NMB], const bf16* Fm, int ldF, int mrow0, const bf16* re, const bf16* im, size_t rstride, int khalf, int lane) {
    const int lr = lane & 15, g = lane >> 4;
#pragma unroll
    for (int k0 = 0; k0 < NKS; k0 += GRP) {
        bf16x8 bfrag[GRP];
#pragma unroll
        for (int kq = 0; kq < GRP; ++kq) { const int ks = k0 + kq; const int kk0 = 32 * ks + 8 * g; const bool part = kk0 >= khalf; const int idx = part ? kk0 - khalf : kk0;
            const bf16* src = (part ? im : re) + (size_t)idx * rstride + lr; unsigned short t[8];
#pragma unroll
            for (int e = 0; e < 8; ++e) t[e] = src[(size_t)e * rstride];
            u32x4 w; w.x = t[0] | ((unsigned)t[1] << 16); w.y = t[2] | ((unsigned)t[3] << 16); w.z = t[4] | ((unsigned)t[5] << 16); w.w = t[6] | ((unsigned)t[7] << 16);
            bfrag[kq] = __builtin_bit_cast(bf16x8, w); }
#pragma unroll
        for (int kq = 0; kq < GRP; ++kq) { const int ks = k0 + kq;
            bf16x8 a[NMB];
#pragma unroll
            for (int mb = 0; mb < NMB; ++mb) a[mb] = *(const bf16x8*)(Fm + (size_t)(mrow0 + 16 * mb + lr) * ldF + 32 * ks + 8 * g);
#pragma unroll
            for (int mb = 0; mb < NMB; ++mb) acc[mb] = MFMA16(a[mb], bfrag[kq], acc[mb]);
            if (kq & 1) __builtin_amdgcn_sched_barrier(0);
        }
    }
}
__device__ __forceinline__ void dft_mma_loop(f32x4 (&acc)[8], const bf16* Fm, int ldF, int mrow0, int nks, const bf16* re, const bf16* im, size_t rstride, int khalf, int lane) {
    const int lr = lane & 15, g = lane >> 4;
#pragma unroll 1
    for (int ks = 0; ks < nks; ++ks) { const int kk0 = 32 * ks + 8 * g; const bool part = kk0 >= khalf; const int idx = part ? kk0 - khalf : kk0;
        const bf16* src = (part ? im : re) + (size_t)idx * rstride + lr; unsigned short t[8];
#pragma unroll
        for (int e = 0; e < 8; ++e) t[e] = src[(size_t)e * rstride];
        u32x4 w; w.x = t[0] | ((unsigned)t[1] << 16); w.y = t[2] | ((unsigned)t[3] << 16); w.z = t[4] | ((unsigned)t[5] << 16); w.w = t[6] | ((unsigned)t[7] << 16);
        const bf16x8 bfrag = __builtin_bit_cast(bf16x8, w);
#pragma unroll
        for (int mb = 0; mb < 8; ++mb) { const bf16x8 a = *(const bf16x8*)(Fm + (size_t)(mrow0 + 16 * mb + lr) * ldF + 32 * ks + 8 * g); acc[mb] = MFMA16(a, bfrag, acc[mb]); }
    }
}
__device__ __forceinline__ void fft_stage1(Ctx& F) {
    const int lr = F.lane & 15, g = F.lane >> 4;
    f_to_lds(F.lds, F.F1, 128, 256, F.tid);
    for (int it = F.gw; it < 4096; it += F.NGW) { const int cb = it & 15, n2 = (it >> 4) & 127, b = it >> 11;
        f32x4 acc[8];
#pragma unroll
        for (int mb = 0; mb < 8; ++mb) acc[mb] = (f32x4){0.f, 0.f, 0.f, 0.f};
        const bf16* re = F.PB + (size_t)(b * SEQ + n2) * NP + PFA + 16 * cb;
        dft_mma_lds<4, 4>(acc, F.lds, 272, re, re + 256, (size_t)128 * NP, 64, F.lane);
#pragma unroll
        for (int mb = 0; mb < 4; ++mb)
#pragma unroll
            for (int r = 0; r < 4; ++r) { const int k1 = 16 * mb + 4 * g + r; const float a = (float)(k1 * n2) * (1.f / 8192.f); const float c = cos_rev(a), s = sin_rev(a);
                const float tr = acc[mb][r], ti = acc[mb + 4][r]; const float xr = tr * c + ti * s, xi = ti * c - tr * s;
                bf16* dst = F.TB + ((size_t)((b * 64 + k1) * 2) * 128 + n2) * 256 + 16 * cb + lr;
                dst[0] = (bf16)f2bf(xr); dst[(size_t)128 * 256] = (bf16)f2bf(xi); }
    }
}
__device__ __forceinline__ void fft_stage2(Ctx& F, int l) {
    const int lr = F.lane & 15, g = F.lane >> 4;
    f_to_lds(F.lds, F.F2, 128, 512, F.tid);
    for (int it = F.gw; it < 2048; it += F.NGW) {
        f32x4 acc[8];
#pragma unroll
        for (int mb = 0; mb < 8; ++mb) acc[mb] = (f32x4){0.f, 0.f, 0.f, 0.f};
        const int cb = it & 15, k1 = (it >> 4) & 63, b = it >> 10;
        const bf16* re = F.TB + (size_t)((b * 64 + k1) * 2) * 128 * 256 + 16 * cb;
        dft_mma_lds<8, 4>(acc, F.lds, 528, re, re + (size_t)128 * 256, 256, 128, F.lane);
#pragma unroll
        for (int mb = 0; mb < 8; ++mb)
#pragma unroll
            for (int r = 0; r < 4; ++r) { const int k2 = 16 * mb + 4 * g + r; F.YMIX[(size_t)(b * SEQ + k1 + 64 * k2) * D + 256 + 16 * cb + lr] = (bf16)f2bf(acc[mb][r]); }
    }
    __syncthreads();
}
__device__ __forceinline__ void ctx_dft(Ctx& F, int w0, int nw) {
    const int lr = F.lane & 15, g = F.lane >> 4;
    for (int it = w0; it >= 0 && it < 256; it += nw) { const int mq = it & 7, cb = (it >> 3) & 15, b = it >> 7;
            f32x4 acc[2] = {(f32x4){0.f, 0.f, 0.f, 0.f}, (f32x4){0.f, 0.f, 0.f, 0.f}};
            const bf16* re = F.PB + (size_t)(ML + b * CTXL) * NP + PFA + 16 * cb;
            dft_mma<8, 4, 2>(acc, F.FC, 512, 32 * mq, re, re, (size_t)NP, 256, F.lane); __builtin_amdgcn_sched_barrier(0);
            dft_mma<8, 4, 2>(acc, F.FC + 256, 512, 32 * mq, re + 256, re + 256, (size_t)NP, 256, F.lane);
#pragma unroll
            for (int mb = 0; mb < 2; ++mb)
#pragma unroll
                for (int r = 0; r < 4; ++r) { const int k = 32 * mq + 16 * mb + 4 * g + r; F.YMIX[(size_t)(ML + b * CTXL + k) * D + 256 + 16 * cb + lr] = (bf16)f2bf(acc[mb][r]); }
        }
}
__device__ __forceinline__ void load8(const bf16* q, float (&v)[8]) { const u32x4 w = *(const u32x4*)q; v[0] = bflo(w.x); v[1] = bfhi(w.x); v[2] = bflo(w.y); v[3] = bfhi(w.y); v[4] = bflo(w.z); v[5] = bfhi(w.z); v[6] = bflo(w.w); v[7] = bfhi(w.w); }
__device__ __forceinline__ void store8(bf16* q, const float (&v)[8]) { u32x4 w; w.x = pk2(v[0], v[1]); w.y = pk2(v[2], v[3]); w.z = pk2(v[4], v[5]); w.w = pk2(v[6], v[7]); *(u32x4*)q = w; }
__device__ __forceinline__ u32x4 ldrow(const bf16* base, int rbase, int t, int n, int col) { const int tc = t < 0 ? 0 : (t > n - 1 ? n - 1 : t); return *(const u32x4*)(base + (size_t)(rbase + tc) * NP + col); }
__device__ __forceinline__ void unpack8(const u32x4 w, float (&v)[8]) { v[0] = bflo(w.x); v[1] = bfhi(w.x); v[2] = bflo(w.y); v[3] = bfhi(w.y); v[4] = bflo(w.z); v[5] = bfhi(w.z); v[6] = bflo(w.w); v[7] = bfhi(w.w); }
__device__ __forceinline__ void convpool_item(PP p, Ctx& F, int l, int it) {
    int rbase, n, t0;
    if (it < 256) { rbase = it * 64; n = 64; t0 = 0; } else { const int sg = it - 256; rbase = ML + (sg >> 2) * CTXL; n = CTXL; t0 = (sg & 3) * 64; }
    const int oct = F.tid & 31, tl = F.tid >> 5, c0 = 8 * oct, tb = t0 + tl * 4;
    {
        u32x4 hw_[6], cw_[6], bw_[4];
#pragma unroll
        for (int i = 0; i < 6; ++i) { hw_[i] = ldrow(F.PB, rbase, tb - 1 + i, n, PH + c0); cw_[i] = ldrow(F.PB, rbase, tb - 1 + i, n, PCG + c0); }
#pragma unroll
        for (int q = 0; q < 4; ++q) bw_[q] = ldrow(F.PB, rbase, tb + q, n, PBG + c0);
        const f32x4 w0a = *(const f32x4*)(p->conv_w + (l * 3 + 0) * 256 + c0), w0b = *(const f32x4*)(p->conv_w + (l * 3 + 0) * 256 + c0 + 4);
        const f32x4 w1a = *(const f32x4*)(p->conv_w + (l * 3 + 1) * 256 + c0), w1b = *(const f32x4*)(p->conv_w + (l * 3 + 1) * 256 + c0 + 4);
        const f32x4 w2a = *(const f32x4*)(p->conv_w + (l * 3 + 2) * 256 + c0), w2b = *(const f32x4*)(p->conv_w + (l * 3 + 2) * 256 + c0 + 4);
        const f32x4 cba = *(const f32x4*)(p->conv_b + l * 256 + c0), cbb = *(const f32x4*)(p->conv_b + l * 256 + c0 + 4);
        float hc[6][8];
#pragma unroll
        for (int i = 0; i < 6; ++i) { float a[8], b[8]; unpack8(hw_[i], a); unpack8(cw_[i], b); const int t = tb - 1 + i; const float msk = (t >= 0 && t < n) ? 1.f : 0.f;
#pragma unroll
            for (int e = 0; e < 8; ++e) hc[i][e] = a[e] * b[e] * msk; }
#pragma unroll
        for (int q = 0; q < 4; ++q) { float bg[8], y[8]; unpack8(bw_[q], bg);
#pragma unroll
            for (int e = 0; e < 8; ++e) { const float w0 = e < 4 ? w0a[e & 3] : w0b[e & 3], w1 = e < 4 ? w1a[e & 3] : w1b[e & 3], w2 = e < 4 ? w2a[e & 3] : w2b[e & 3], cb = e < 4 ? cba[e & 3] : cbb[e & 3];
                y[e] = bg[e] * (w0 * hc[q][e] + w1 * hc[q + 1][e] + w2 * hc[q + 2][e] + cb); }
            store8(F.YMIX + (size_t)(rbase + tb + q) * D + 512 + c0, y); }
    }
    __builtin_amdgcn_sched_barrier(0);
    {
        const int wnd = 2 << (oct >> 3), hw = wnd >> 1;
        float s[4][8], self[4][8];
#pragma unroll
        for (int q = 0; q < 4; ++q) { unpack8(ldrow(F.PB, rbase, tb + q, n, PPOOL + c0), self[q]);
#pragma unroll
            for (int e = 0; e < 8; ++e) s[q][e] = 0.f; }
        __builtin_amdgcn_sched_barrier(0);
#pragma unroll
        for (int bt = 0; bt < 19; bt += 7) {
            u32x4 pw[7];
#pragma unroll
            for (int ii = 0; ii < 7; ++ii) if (bt + ii < 19) pw[ii] = ldrow(F.PB, rbase, tb - hw + bt + ii, n, PPOOL + c0);
#pragma unroll
            for (int ii = 0; ii < 7; ++ii) if (bt + ii < 19) { const int i = bt + ii; float v[8]; unpack8(pw[ii], v); const int t = tb - hw + i; const bool inr = (t >= 0 && t < n);
#pragma unroll
                for (int q = 0; q < 4; ++q) { const float mk = (inr && i >= q && i < q + wnd) ? 1.f : 0.f;
#pragma unroll
                    for (int e = 0; e < 8; ++e) s[q][e] += mk * v[e]; } }
            __builtin_amdgcn_sched_barrier(0);
        }
#pragma unroll
        for (int q = 0; q < 4; ++q) { const int t = tb + q; const int lo = (t - hw > 0) ? t - hw : 0, hi = (t + hw - 1 < n - 1) ? t + hw - 1 : n - 1; const float inv = 1.f / (float)(hi - lo + 1);
            float y[8];
#pragma unroll
            for (int e = 0; e < 8; ++e) y[e] = s[q][e] * inv - self[q][e];
            store8(F.YMIX + (size_t)(rbase + t) * D + 768 + c0, y); }
    }
}
__device__ __forceinline__ void ctx_act(PP p, Ctx& F, int l) {
    const int gt = blockIdx.x * 512 + F.tid, NT = F.G * 512;
    for (int i = gt; i < MC * 352; i += NT) { const int oc = i % 352, rc = i / 352, t = rc & 255, c0 = 8 * oc;
        const bf16* base = F.CAU + (size_t)rc * NUP + c0; float a[8], y[8], u[8];
        const float* cw = p->ffn_cw + (size_t)l * 3 * DFF + c0; const float* cb = p->ffn_cb + (size_t)l * DFF + c0;
#pragma unroll
        for (int e = 0; e < 8; ++e) y[e] = cb[e];
        if (t > 0) { load8(base - NUP, a);
#pragma unroll
            for (int e = 0; e < 8; ++e) y[e] += cw[e] * a[e]; }
        load8(base, a);
#pragma unroll
        for (int e = 0; e < 8; ++e) y[e] += cw[DFF + e] * a[e];
        if (t < 255) { load8(base + NUP, a);
#pragma unroll
            for (int e = 0; e < 8; ++e) y[e] += cw[2 * DFF + e] * a[e]; }
        load8(base + DFF, u);
#pragma unroll
        for (int e = 0; e < 8; ++e) y[e] = silu_f(y[e]) * u[e];
        store8(F.ACT + (size_t)(ML + rc) * DFF + c0, y);
    }
}
__global__ void __launch_bounds__(512, 2) fwd_megakernel(Params p_) {
    PP p = (PP)__builtin_amdgcn_kernarg_segment_ptr();
    extern __shared__ __attribute__((aligned(16))) unsigned char lds_raw[];
    cg::grid_group grid = cg::this_grid();
    Ctx F;
    F.lds = (LAS unsigned char*)lds_raw; F.tid = threadIdx.x; F.lane = F.tid & 63; F.wave = __builtin_amdgcn_readfirstlane(F.tid >> 6);
    const int wave_s = F.wave;
    F.G = gridDim.x; F.gw = blockIdx.x * 8 + F.wave; F.NGW = F.G * 8;
    unsigned char* ws = p->ws;
#define SETPTRS() do { { PP q_ = (PP)__builtin_amdgcn_kernarg_segment_ptr(); asm volatile("" : "+s"(q_)); p = q_; } unsigned char* w_ = p->ws; asm volatile("" : "+s"(w_)); \
    F.MOD = (float*)(w_ + WS_MOD); F.MCS = (float*)(w_ + WS_MCS); F.F1 = (bf16*)(w_ + WS_F1); F.F2 = (bf16*)(w_ + WS_F2); F.FC = (bf16*)(w_ + WS_FC); \
    F.HX = (bf16*)(w_ + WS_HX); F.TB = (bf16*)(w_ + WS_HX); F.YMIX = (bf16*)(w_ + WS_YMIX); F.PB = (bf16*)(w_ + WS_P); F.ACT = (bf16*)(w_ + WS_P); \
    F.XC = (float*)(w_ + WS_XC); F.ST = (float*)(w_ + WS_ST); F.DEC = (float*)(w_ + WS_DEC); F.CAU = (bf16*)(w_ + WS_CAU); } while (0)
    SETPTRS();

#ifndef NO_P0
#define REFRESH() do { int t_; asm volatile("v_mbcnt_lo_u32_b32 %0, -1, 0\n\tv_mbcnt_hi_u32_b32 %0, -1, %0" : "=v"(t_)); t_ |= (wave_s << 6); F.tid = t_; F.lane = t_ & 63; F.wave = __builtin_amdgcn_readfirstlane(t_ >> 6); F.gw = blockIdx.x * 8 + F.wave; SETPTRS(); } while (0)
    { volatile LAS unsigned* misc = (volatile LAS unsigned*)(F.lds + RING_BYTES); if (F.tid < 64) misc[F.tid] = 0u; }
    __syncthreads();
    XcdBarrier bar = xcd_barrier_post((unsigned*)(ws + WS_CTL), (volatile LAS unsigned*)(F.lds + RING_BYTES) + 8, F.tid);
#define GSYNC() do { REFRESH(); xcd_barrier(bar, F.tid); } while (0)
    REFRESH();
    phase0(p, F);
#endif
    if (p->ws == nullptr) grid.sync();
    GSYNC();
#define L0() ({ int lq_ = l; asm volatile("" : "+s"(lq_)); lq_ == 0; })
    for (int l = 0; l < 2; ++l) {
        const int M6 = L0() ? MT : ML;
#ifndef NO_P1
        REFRESH();
        norm_phase(p, F, l, 0, MT);
        REFRESH();
        if (L0()) fold_items(p, F);
#ifdef PROBE_B
        REFRESH(); norm_phase(p, F, l, 0, MT); if (L0()) fold_items(p, F);
#endif
#endif
        GSYNC();
#ifndef NO_P2
        REFRESH();
        { pg8::Gemm g{F.HX, win_t(p, l), MT, NP, D, D}; pg8::StaticOrder S; S.init(MT, NP, F.G, (int)blockIdx.x);
          EpiP E{F.PB, p->b_a2 + l * 256};
          pg8::gemm_phase<EpiP, pg8::StaticOrder, true, true>(F.lds, g, S, E, F.tid);
#ifdef PROBE_C
          __syncthreads(); pg8::gemm_phase<EpiP, pg8::StaticOrder, true, true>(F.lds, g, S, E, F.tid);
#endif
        }
#endif
        GSYNC();
#ifdef PROBE_A
        for (int rep_ = 0; rep_ < 2; ++rep_) {
#else
        {
#endif
#ifndef NO_GA
        REFRESH();
        for (int it = blockIdx.x; it < 2 * NCH; it += F.G) gla_a_item(F, it / NCH, it % NCH);
#ifdef PR_GA
        __syncthreads(); REFRESH();
        for (int it = blockIdx.x; it < 2 * NCH; it += F.G) gla_a_item(F, it / NCH, it % NCH);
#endif
#endif
#ifndef NO_F1
        REFRESH();
        fft_stage1(F);
#ifdef PR_F1
        __syncthreads(); REFRESH();
        fft_stage1(F);
#endif
#endif
#ifndef NO_CP
        REFRESH();
        for (int v = blockIdx.x; v < 512; v += F.G) { const int it = (v < 256) ? v : 256 + ((v + 248) & 255);
            if (it >= (L0() ? 264 : 256)) continue; convpool_item(p, F, l, it); }
#ifdef PR_CP
        __syncthreads(); REFRESH();
        for (int v = blockIdx.x; v < 512; v += F.G) { const int it = (v < 256) ? v : 256 + ((v + 248) & 255);
            if (it >= (L0() ? 264 : 256)) continue; convpool_item(p, F, l, it); }
#endif
#endif
        }
        GSYNC();
#ifdef PROBE_A
        REFRESH(); fft_stage2(F, l);
#endif
#ifndef NO_F2
        REFRESH();
        fft_stage2(F, l);
#ifdef PR_F2
        __syncthreads(); REFRESH();
        fft_stage2(F, l);
#endif
#endif
#ifndef NO_SC
        REFRESH();
        gla_scan(F);
#endif
        GSYNC();
#ifdef PROBE_A
        for (int rep_ = 0; rep_ < 2; ++rep_) {
#else
        {
#endif
#ifndef NO_GC
        REFRESH();
        for (int it = blockIdx.x; it < 256; it += F.G) gla_c_item<2>(p, F, l, it >> 7, 4 + (it & 127), 0);
        if (L0()) for (int j = blockIdx.x; j < 16; j += F.G) gla_c_item<1>(p, F, l, j >> 3, (j >> 1) & 3, j & 1);
        if (L0()) { if (F.G == 256) ctx_dft(F, F.gw - 256, 1 << 30); else ctx_dft(F, F.gw, F.NGW); }
#ifdef PR_GC
        __syncthreads(); REFRESH();
        for (int it = blockIdx.x; it < 256; it += F.G) gla_c_item<2>(p, F, l, it >> 7, 4 + (it & 127), 0);
#endif
#endif
        }
        GSYNC();
#ifndef NO_P6
        REFRESH();
        if (L0()) { pg8::Gemm g{F.YMIX, wout_t(p, l), MT, D, 256, D}; SplitOrder S; S.init(4, F.G, (int)blockIdx.x);
          EpiPartial E{(float*)(p->ws + WS_PART)};
          pg8::gemm_phase<EpiPartial, SplitOrder, false, false>(F.lds, g, S, E, F.tid); __syncthreads(); }
        REFRESH();
        { pg8::Gemm g{F.YMIX, wout_t(p, l), ML, D, D, D}; pg8::StaticOrder S; S.init(ML, D, F.G, (int)blockIdx.x);
          if (L0()) { EpiRes<false, true> E{p->x, p->out, F.MOD + l * 3 * 6144 + 2048}; pg8::gemm_phase<EpiRes<false, true>, pg8::StaticOrder, true, true>(F.lds, g, S, E, F.tid); }
          else if (F.G == 256) { EpiResNorm E{(const bf16*)p->out, (bf16*)(p->ws + WS_XB2), F.HX, F.MOD + l * 3 * 6144 + 2048, p->norm2_g + l * D, F.MOD + l * 3 * 6144, (float*)(p->ws + WS_SLOT) + 65536 * 2, (unsigned*)(p->ws + WS_CTL) + CW_FIN + 4096};
            pg8::gemm_phase<EpiResNorm, pg8::StaticOrder, false, true>(F.lds, g, S, E, F.tid); }
          else { EpiRes<true, true> E{p->out, p->out, F.MOD + l * 3 * 6144 + 2048}; pg8::gemm_phase<EpiRes<true, true>, pg8::StaticOrder, true, true>(F.lds, g, S, E, F.tid); } }
#endif
        GSYNC();
        if (L0() || F.G != 256) { REFRESH(); norm_phase(p, F, l, 1, M6); GSYNC(); }
#ifndef NO_P8
        REFRESH();
        { pg8::Gemm g{F.HX, wup_t(p, l), ML, NUP, D, D}; pg8::StaticOrder S; S.init(ML, NUP, F.G, (int)blockIdx.x);
          EpiUp E{F.ACT, p->ffn_cw + (size_t)l * 3 * DFF, p->ffn_cb + (size_t)l * DFF};
          pg8::gemm_phase<EpiUp, pg8::StaticOrder, true, true>(F.lds, g, S, E, F.tid);
        }
        if (L0()) { REFRESH(); __syncthreads();
          pg8::Gemm g{F.HX, wup_t(p, l), MT, NUP, D, D}; CtxOrder S; S.init(NUP, (int)blockIdx.x, 128);
          EpiUpCtx E{F.ACT, p->ffn_cw + (size_t)l * 3 * DFF, p->ffn_cb + (size_t)l * DFF, (LAS float*)(F.lds + RING_BYTES + 1024)};
          pg8::gemm_phase<EpiUpCtx, CtxOrder, true, false>(F.lds, g, S, E, F.tid); }
#endif
        GSYNC();
#ifndef NO_P9
        REFRESH();
        if (L0()) { pg8::Gemm g{F.ACT, wdn_t(p, l), MT, D, 256, DFF}; SplitOrder S; S.init(11, F.G, (int)blockIdx.x);
          EpiPartial E{(float*)(p->ws + WS_PART)};
          pg8::gemm_phase<EpiPartial, SplitOrder, false, false>(F.lds, g, S, E, F.tid); __syncthreads(); }
        REFRESH();
        { pg8::Gemm g{F.ACT, wdn_t(p, l), ML, D, DFF, DFF}; pg8::StaticOrder S; S.init(ML, D, F.G, (int)blockIdx.x);
          if (L0()) { EpiRes<true, true> E{p->out, p->out, F.MOD + l * 3 * 6144 + 5120}; pg8::gemm_phase<EpiRes<true, true>, pg8::StaticOrder, true, true>(F.lds, g, S, E, F.tid); }
          else if (F.G == 256) { EpiFinal E{(const bf16*)(p->ws + WS_XB2), p->out, F.MOD + l * 3 * 6144 + 5120, p->final_g, (float*)(p->ws + WS_SLOT), (unsigned*)(p->ws + WS_CTL) + CW_FIN};
            pg8::gemm_phase<EpiFinal, pg8::StaticOrder, false, true>(F.lds, g, S, E, F.tid); }
          else { EpiRes<true, false> E{p->out, p->ws + WS_HX, F.MOD + l * 3 * 6144 + 5120}; pg8::gemm_phase<EpiRes<true, false>, pg8::StaticOrder, true, true>(F.lds, g, S, E, F.tid); } }
#endif
        if (L0() || F.G != 256) GSYNC();
    }
        REFRESH();
    if (F.G != 256) final_norm(p, F);
}

extern "C" void kernel_launch(void* const* d_in, const int* in_sizes, int n_in, void* d_out, int out_size, void* d_ws, size_t ws_size, hipStream_t stream) {
    static int grid = 0;
    if (grid == 0) {
        if (n_in != 23 || in_sizes[0] != ML * D || out_size != ML * D || ws_size < WS_END) { fprintf(stderr, "kernel_launch: unexpected shapes / workspace (%d inputs, ws %zu)\n", n_in, ws_size); grid = -1; return; }
        int dev = 0, cus = 0, per_cu = 0;
        hipGetDevice(&dev); hipDeviceGetAttribute(&cus, hipDeviceAttributeMultiprocessorCount, dev);
        if (hipFuncSetAttribute((const void*)fwd_megakernel, hipFuncAttributeMaxDynamicSharedMemorySize, LDS_BYTES) != hipSuccess) { fprintf(stderr, "hipFuncSetAttribute failed\n"); grid = -1; return; }
        if (hipOccupancyMaxActiveBlocksPerMultiprocessor(&per_cu, (const void*)fwd_megakernel, 512, LDS_BYTES) != hipSuccess || per_cu < 1) per_cu = 1;
        (void)hipGetLastError();
        grid = cus * 1;
    }
    if (grid < 0) return;
    if (hipMemsetAsync((char*)d_ws + WS_CTL, 0, 65536, stream) != hipSuccess) { fprintf(stderr, "memset failed\n"); return; }
    Params p{};
    const float** pp = (const float**)&p;
    for (int i = 0; i < 23; ++i) pp[i] = (const float*)d_in[i];
    p.out = (float*)d_out; p.ws = (unsigned char*)d_ws;
    void* args[] = {&p};
    hipError_t e = hipLaunchCooperativeKernel((const void*)fwd_megakernel, dim3(grid), dim3(512), args, LDS_BYTES, stream);
    if (e != hipSuccess) fprintf(stderr, "cooperative launch failed: %s (grid %d)\n", hipGetErrorString(e), grid);
}
```

```cpp
#include <hip/hip_runtime.h>
#include <hip/hip_cooperative_groups.h>
#include <cstdio>
#include <cstdint>
namespace cg = cooperative_groups;
namespace pg8 {
#define PG8_LAS __attribute__((address_space(3)))
typedef unsigned short bf16_t;
typedef short bf16x8 __attribute__((ext_vector_type(8)));
typedef float f32x4 __attribute__((ext_vector_type(4)));
typedef unsigned u32x4 __attribute__((ext_vector_type(4)));
constexpr int BM = 256, BK = 64, HALF = 128, HTB = HALF * BK * 2  , STAGE_BYTES = 8 * HTB, NXCD = 8, WGM = 8;

__host__ __device__ __forceinline__ int lds_byte(int r, int c) { const int st = (r >> 4) * 2 + (c >> 5), rr = r & 15, cc = c & 31, ob = rr * 64 + cc * 2; return st * 1024 + (ob ^ (((ob >> 9) & 1) << 5)); }
__host__ __device__ __forceinline__ void stage_rc(int b, int& R, int& C) { const int st = b / 1024, sb = b % 1024, swz = sb ^ (((sb >> 9) & 1) << 5); R = (st >> 1) * 16 + swz / 64; C = (st & 1) * 32 + (swz % 64) / 2; }
__host__ __device__ __forceinline__ int perm32(int rho) { const int n = rho >> 4, i = rho & 15; return 8 * (i >> 2) + 4 * n + (i & 3); }

struct Unit { int pm, pn, ks; };
struct Gemm { const bf16_t* A; const bf16_t* Bt; int M, N, K, ld; };

struct StaticOrder {
    int nM, nN, nwg, G, c;
    __host__ __device__ void init(int M, int N, int G_, int c_) { nM = M / BM; nN = N / BM; nwg = nM * nN; G = G_; c = c_; }
    __host__ __device__ bool next(int i, Unit& u) const {
        const long L = (long)i * G + c; if (L >= nwg) return false;
        int wgid = (int)L; { const int q = nwg / NXCD, r = nwg % NXCD, xcd = wgid % NXCD, off = wgid / NXCD; wgid = (xcd < r ? xcd * (q + 1) : r * (q + 1) + (xcd - r) * q) + off; }
        const int nig = WGM * nN, gid = wgid / nig, fm = gid * WGM, gsz = (nM - fm) < WGM ? (nM - fm) : WGM;
        u.pm = fm + ((wgid % nig) % gsz); u.pn = (wgid % nig) / gsz; u.ks = 0; return true;
    }
    __device__ __forceinline__ void a_ready(const Unit&) const {}
    __device__ __forceinline__ void done(const Unit&) const {}
};

__device__ __forceinline__ unsigned cvt_pk_bf16(float lo, float hi) { unsigned r; asm volatile("v_cvt_pk_bf16_f32 %0, %1, %2" : "=v"(r) : "v"(lo), "v"(hi)); return r; }
template <class Epi, class Sched, bool ALIGN_EPI = false, bool SP2 = false>
__device__ __forceinline__ void gemm_phase(PG8_LAS unsigned char* lds, const Gemm g, const Sched& S, const Epi& E, int tid_in) {
    int tid_ = tid_in; asm volatile("" : "+v"(tid_)); const int tid = tid_, wid = __builtin_amdgcn_readfirstlane(tid >> 6), lane = tid & 63, wr = wid >> 2, wc = wid & 3, fr = lane & 15, fq = lane >> 4;
    const int K = g.ld, nt = g.K / BK; const size_t sstep = (size_t)g.K * 2;
    unsigned voffA[2], voffB[2];
#pragma unroll
    for (int i = 0; i < 2; ++i) { int R, C; stage_rc(tid * 16 + i * 8192, R, C); const int Rb = Epi::PERM ? ((R & ~31) + perm32(R & 31)) : R;
        voffA[i] = (unsigned)(R * K + C) * 2u; voffB[i] = (unsigned)(Rb * K + C) * 2u; }
    const size_t kstep = (size_t)(BK * 2);
    const size_t hstep = (size_t)HALF * K * 2;
    const size_t tstep = 2 * hstep;
    const unsigned ldsw = (unsigned)wid * 1024u;
    const int aoff = lds_byte(wr * 64 + fr, fq * 8), boff = lds_byte(wc * 32 + fr, fq * 8);
#define PG8_SA(b, h) (((b) * 2 + (h)) * HTB)
#define PG8_SB(b, h) ((4 + (b) * 2 + (h)) * HTB)
#define PG8_STAGE(bufoff, gbase, voff) do { _Pragma("unroll") for (int _i = 0; _i < 2; ++_i) \
        __builtin_amdgcn_global_load_lds((const unsigned*)((const char*)(gbase) + (voff)[_i]), (PG8_LAS unsigned*)(lds + (bufoff) + ldsw + _i * 8192), 16, 0, 0); } while (0)
#define PG8_LDA(dst, b, h) do { _Pragma("unroll") for (int m = 0; m < 4; ++m) _Pragma("unroll") for (int k = 0; k < 2; ++k) dst[m][k] = *(const PG8_LAS bf16x8*)(lds + PG8_SA(b, h) + aoff + m * 2048 + k * 1024); } while (0)
#define PG8_LDB(dst, b, h) do { _Pragma("unroll") for (int n = 0; n < 2; ++n) _Pragma("unroll") for (int k = 0; k < 2; ++k) dst[n][k] = *(const PG8_LAS bf16x8*)(lds + PG8_SB(b, h) + boff + n * 2048 + k * 1024); } while (0)
#define PG8_MMA(ai, bj, At, Bt) do { __builtin_amdgcn_s_setprio(1); _Pragma("unroll") for (int m = 0; m < 4; ++m) _Pragma("unroll") for (int n = 0; n < 2; ++n) _Pragma("unroll") for (int k = 0; k < 2; ++k) \
        acc[ai][bj][m][n] = __builtin_amdgcn_mfma_f32_16x16x32_bf16(Bt[n][k], At[m][k], acc[ai][bj][m][n], 0, 0, 0); __builtin_amdgcn_s_setprio(0); } while (0)
#define PG8_WAIT_V(n) asm volatile("s_waitcnt vmcnt(" #n ")" ::: "memory")
#define PG8_WAIT_L(n) asm volatile("s_waitcnt lgkmcnt(" #n ")" ::: "memory")
#define PG8_BAR __builtin_amdgcn_s_barrier()
#define PG8_SCHED __builtin_amdgcn_sched_barrier(0)
    Unit cur, nxt; int ui = 0;
    if (!S.next(0, cur)) return;
    f32x4 acc[2][2][4][2];
#pragma unroll
    for (int a = 0; a < 2; ++a)
#pragma unroll
        for (int b = 0; b < 2; ++b)
#pragma unroll
            for (int m = 0; m < 4; ++m)
#pragma unroll
                for (int n = 0; n < 2; ++n) acc[a][b][m][n] = (f32x4){0.f, 0.f, 0.f, 0.f};
    bf16x8 At[4][2], B0[2][2], B1[2][2];
    const char* cA = (const char*)g.A + (size_t)cur.pm * tstep + (size_t)cur.ks * sstep; const char* cB = (const char*)g.Bt + (size_t)cur.pn * tstep + (size_t)cur.ks * sstep;
    S.a_ready(cur);
    if constexpr (SP2) {
        PG8_STAGE(PG8_SB(0, 0), cB, voffB); PG8_STAGE(PG8_SB(0, 1), cB + hstep, voffB); PG8_STAGE(PG8_SA(0, 0), cA, voffA); PG8_STAGE(PG8_SA(0, 1), cA + hstep, voffA);
        if (wr == 1) PG8_BAR;
        PG8_WAIT_V(2); PG8_BAR;
        PG8_STAGE(PG8_SB(1, 0), cB + kstep, voffB); PG8_STAGE(PG8_SA(1, 0), cA + kstep, voffA); PG8_STAGE(PG8_SB(1, 1), cB + hstep + kstep, voffB);
        PG8_WAIT_V(6); PG8_BAR;
    } else {
        PG8_STAGE(PG8_SB(0, 0), cB, voffB); PG8_STAGE(PG8_SA(0, 0), cA, voffA); PG8_STAGE(PG8_SB(0, 1), cB + hstep, voffB); PG8_STAGE(PG8_SA(0, 1), cA + hstep, voffA);
        if (wr == 1) PG8_BAR;
        PG8_WAIT_V(4); PG8_BAR;
        PG8_STAGE(PG8_SB(1, 0), cB + kstep, voffB); PG8_STAGE(PG8_SA(1, 0), cA + kstep, voffA); PG8_STAGE(PG8_SB(1, 1), cB + hstep + kstep, voffB);
        PG8_WAIT_V(6); PG8_BAR;
    }
    for (;;) {
        const bool has_next = S.next(ui + 1, nxt);
        const char* nA = has_next ? (const char*)g.A + (size_t)nxt.pm * tstep + (size_t)nxt.ks * sstep : cA; const char* nB = has_next ? (const char*)g.Bt + (size_t)nxt.pn * tstep + (size_t)nxt.ks * sstep : cB;
        for (int t = 0; t < nt; t += 2) {
            const bool last = (t == nt - 2);
            const char* a1 = cA + (size_t)(t + 1) * kstep;
            const char* a2 = last ? nA : cA + (size_t)(t + 2) * kstep; const char* b2 = last ? nB : cB + (size_t)(t + 2) * kstep;
            const char* a3 = a2 + kstep; const char* b3 = b2 + kstep;
            if (last && has_next) S.a_ready(nxt);
            if constexpr (SP2) {
            PG8_LDB(B0, 0, 0); PG8_LDB(B1, 0, 1); PG8_SCHED; PG8_LDA(At, 0, 0); PG8_STAGE(PG8_SA(1, 1), a1 + hstep, voffA);
            PG8_WAIT_V(8); PG8_WAIT_L(0); PG8_BAR; PG8_MMA(0, 0, At, B0); PG8_MMA(0, 1, At, B1); PG8_BAR; PG8_SCHED;
            PG8_LDA(At, 0, 1); PG8_STAGE(PG8_SB(0, 0), b2, voffB); PG8_STAGE(PG8_SB(0, 1), b2 + hstep, voffB); PG8_STAGE(PG8_SA(0, 0), a2, voffA);
            PG8_WAIT_V(8); PG8_WAIT_L(0); PG8_BAR; PG8_MMA(1, 0, At, B0); PG8_MMA(1, 1, At, B1); PG8_BAR; PG8_SCHED;
            PG8_LDB(B0, 1, 0); PG8_LDB(B1, 1, 1); PG8_SCHED; PG8_LDA(At, 1, 0); PG8_STAGE(PG8_SA(0, 1), a2 + hstep, voffA);
            PG8_WAIT_V(8); PG8_WAIT_L(0); PG8_BAR; PG8_MMA(0, 0, At, B0); PG8_MMA(0, 1, At, B1); PG8_BAR; PG8_SCHED;
            PG8_LDA(At, 1, 1); PG8_STAGE(PG8_SB(1, 0), b3, voffB); PG8_STAGE(PG8_SB(1, 1), b3 + hstep, voffB); PG8_STAGE(PG8_SA(1, 0), a3, voffA);
            PG8_WAIT_V(8); PG8_WAIT_L(0); PG8_BAR; PG8_MMA(1, 0, At, B0); PG8_MMA(1, 1, At, B1); PG8_BAR; PG8_SCHED;
            } else {
            PG8_LDB(B0, 0, 0); PG8_SCHED; PG8_LDA(At, 0, 0); PG8_STAGE(PG8_SA(1, 1), a1 + hstep, voffA);
            PG8_WAIT_L(8); PG8_BAR; PG8_WAIT_L(0); PG8_MMA(0, 0, At, B0); PG8_BAR; PG8_SCHED;
            PG8_LDB(B1, 0, 1); PG8_STAGE(PG8_SB(0, 0), b2, voffB);
            PG8_BAR; PG8_WAIT_L(0); PG8_MMA(0, 1, At, B1); PG8_BAR;
            PG8_LDA(At, 0, 1); PG8_STAGE(PG8_SA(0, 0), a2, voffA);
            PG8_BAR; PG8_WAIT_L(0); PG8_MMA(1, 0, At, B0); PG8_BAR; PG8_SCHED;
            PG8_STAGE(PG8_SB(0, 1), b2 + hstep, voffB);
            PG8_WAIT_V(6); PG8_BAR; PG8_MMA(1, 1, At, B1); PG8_BAR;
            PG8_LDB(B0, 1, 0); PG8_SCHED; PG8_LDA(At, 1, 0); PG8_STAGE(PG8_SA(0, 1), a2 + hstep, voffA);
            PG8_WAIT_L(8); PG8_BAR; PG8_WAIT_L(0); PG8_MMA(0, 0, At, B0); PG8_BAR; PG8_SCHED;
            PG8_LDB(B1, 1, 1); PG8_STAGE(PG8_SB(1, 0), b3, voffB);
            PG8_BAR; PG8_WAIT_L(0); PG8_MMA(0, 1, At, B1); PG8_BAR;
            PG8_LDA(At, 1, 1); PG8_STAGE(PG8_SA(1, 0), a3, voffA);
            PG8_BAR; PG8_WAIT_L(0); PG8_MMA(1, 0, At, B0); PG8_BAR; PG8_SCHED;
            PG8_STAGE(PG8_SB(1, 1), b3 + hstep, voffB);
            PG8_WAIT_V(6); PG8_BAR; PG8_MMA(1, 1, At, B1); PG8_BAR;
            }
        }
        if constexpr (ALIGN_EPI) { if (wr == 0) PG8_BAR; }
        if constexpr (!Epi::AFTER_DRAIN) { E(acc, cur, wr, wc, fr, fq); S.done(cur); }
        if (!has_next) break;
#pragma unroll
        for (int a = 0; a < 2; ++a)
#pragma unroll
            for (int b = 0; b < 2; ++b)
#pragma unroll
                for (int m = 0; m < 4; ++m)
#pragma unroll
                    for (int n = 0; n < 2; ++n) acc[a][b][m][n] = (f32x4){0.f, 0.f, 0.f, 0.f};
        cur = nxt; cA = nA; cB = nB; ++ui;
        if constexpr (ALIGN_EPI) { if (wr == 1) PG8_BAR; }
    }
    PG8_WAIT_V(0);
    if constexpr (!ALIGN_EPI) { if (wr == 0) PG8_BAR; }
    PG8_BAR;
    if constexpr (Epi::AFTER_DRAIN) { E.fused(acc, cur, wr, wc, fr, fq, lds, wid, lane); S.done(cur); }
#undef PG8_SA
#undef PG8_SB
#undef PG8_STAGE
#undef PG8_LDA
#undef PG8_LDB
#undef PG8_MMA
#undef PG8_WAIT_V
#undef PG8_WAIT_L
#undef PG8_BAR
#undef PG8_SCHED
}
}
#define LAS __attribute__((address_space(3)))
typedef unsigned short bf16;
typedef float f32x4 __attribute__((ext_vector_type(4)));
typedef short bf16x8 __attribute__((ext_vector_type(8)));
typedef unsigned u32x4 __attribute__((ext_vector_type(4)));
typedef unsigned u32x2 __attribute__((ext_vector_type(2)));
#define LDS_WAIT() asm volatile("s_waitcnt lgkmcnt(0)" ::: "memory")

constexpr int D = 1024, SEQ = 8192, ML = 16384, MC = 512, MT = ML + MC, CTXL = 256;
constexpr int DIN = 2080, NP = 2560, DFF = 2816, NUP = 5632;
constexpr int PK = 0, PQ = 128, PV = 256, PLA = 512, PG = 768, PFA = 1024, PFB = 1280, PH = 1536, PBG = 1792, PCG = 2048, PPOOL = 2304;
constexpr int NCH = 132;
constexpr float EPS = 1e-6f;
constexpr size_t MiB = 1u << 20;
constexpr size_t WS_CTL = 0;
constexpr size_t WS_MOD = 1 * MiB;
constexpr size_t WS_MCS = 1 * MiB + 256 * 1024;
constexpr size_t WS_F1 = 1 * MiB + 512 * 1024;
constexpr size_t WS_F2 = WS_F1 + 32 * 1024;
constexpr size_t WS_FC = WS_F2 + 64 * 1024;
constexpr size_t WS_SLOT = 49 * MiB;
constexpr size_t WS_XB2 = 208 * MiB;
constexpr int CW_FIN = 3584;
constexpr size_t WS_W = 2 * MiB;
constexpr size_t W_IN_B = (size_t)NP * D * 2, W_OUT_B = (size_t)D * D * 2, W_UP_B = (size_t)NUP * D * 2, W_DN_B = (size_t)D * DFF * 2;
constexpr size_t W_LAYER_B = W_IN_B + W_OUT_B + W_UP_B + W_DN_B;
constexpr size_t WS_HX = 50 * MiB;
constexpr size_t WS_YMIX = 83 * MiB;
constexpr size_t WS_P = 116 * MiB;
constexpr size_t WS_XC = 207 * MiB;
constexpr size_t WS_ST = 209 * MiB;
constexpr size_t WS_DEC = 226 * MiB;
constexpr size_t WS_CAU = 227 * MiB;
constexpr size_t WS_PART = 233 * MiB;
constexpr size_t WS_END = 255 * MiB;
static_assert(WS_W + 2 * W_LAYER_B <= WS_HX, "weights");
static_assert(WS_P + (size_t)MT * DFF * 2 <= WS_XC, "act");
constexpr int RING_BYTES = 131072, LDS_BYTES = 147456;

struct Params {
    const float *x, *c, *ctx, *c_ctx, *norm1_g, *norm2_g, *w_mod, *b_mod, *w_in, *w_a2, *b_a2, *gla_g, *fft_w, *conv_w, *conv_b, *pool_w,
        *pool_scale, *w_out, *w_up, *ffn_cw, *ffn_cb, *w_down, *final_g;
    float* out; unsigned char* ws;
};

typedef const __attribute__((address_space(4))) Params* PP;
__device__ __forceinline__ unsigned f2bf(float f) { unsigned u = __builtin_bit_cast(unsigned, f); return (u + 0x7fffu + ((u >> 16) & 1u)) >> 16; }
__device__ __forceinline__ unsigned pk2(float lo, float hi) { return f2bf(lo) | (f2bf(hi) << 16); }
__device__ __forceinline__ float bf2f(unsigned h) { return __builtin_bit_cast(float, h << 16); }
__device__ __forceinline__ float bflo(unsigned w) { return __builtin_bit_cast(float, w << 16); }
__device__ __forceinline__ float bfhi(unsigned w) { return __builtin_bit_cast(float, w & 0xffff0000u); }
__device__ __forceinline__ float shfl_f(float v, int src_lane) { return __builtin_bit_cast(float, __builtin_amdgcn_ds_bpermute(src_lane << 2, __builtin_bit_cast(int, v))); }
__device__ __forceinline__ float wave_sum(float v, int lane) {
#pragma unroll
    for (int o = 1; o < 64; o <<= 1) v += shfl_f(v, lane ^ o);
    return v;
}
__device__ __forceinline__ float silu_f(float x) { return x * __builtin_amdgcn_rcpf(1.f + __expf(-x)); }
__device__ __forceinline__ float cos_rev(float r) { return __builtin_amdgcn_cosf(r); }
__device__ __forceinline__ float sin_rev(float r) { return __builtin_amdgcn_sinf(r); }
__device__ __forceinline__ bf16x8 pack8(float a0, float a1, float a2, float a3, float a4, float a5, float a6, float a7) {
    u32x4 w; w.x = pk2(a0, a1); w.y = pk2(a2, a3); w.z = pk2(a4, a5); w.w = pk2(a6, a7); return __builtin_bit_cast(bf16x8, w);
}
#define MFMA16(a, b, c) __builtin_amdgcn_mfma_f32_16x16x32_bf16(a, b, c, 0, 0, 0)

struct EpiP {
    static constexpr bool PERM = true, AFTER_DRAIN = false;
    bf16* O; const float* ba2;
    __device__ __forceinline__ void operator()(const pg8::f32x4 (&acc)[2][2][4][2], const pg8::Unit& u, int wr, int wc, int fr, int fq) const {
        const int row0 = u.pm * 256 + wr * 64 + fr, col0 = u.pn * 256 + wc * 32 + 8 * fq;
        const __amdgpu_buffer_rsrc_t prs = __builtin_amdgcn_make_buffer_rsrc(O, 0, MT * NP * 2, 0x00020000);
        const bool la = (u.pn == 2);
#pragma unroll
        for (int ai = 0; ai < 2; ++ai)
#pragma unroll
            for (int m = 0; m < 4; ++m) { bf16* rowp = O + (size_t)(row0 + ai * 128 + m * 16) * NP + col0;
#pragma unroll
                for (int bj = 0; bj < 2; ++bj) { pg8::f32x4 v0 = acc[ai][bj][m][0], v1 = acc[ai][bj][m][1];
                    if (la) { const float* bp = ba2 + (col0 + bj * 128 - PLA); const f32x4 b0 = *(const f32x4*)bp, b1 = *(const f32x4*)(bp + 4);
#pragma unroll
                        for (int e = 0; e < 4; ++e) { float xa = v0[e] + b0[e], xb = v1[e] + b1[e];
                            v0[e] = (fminf(xa, 0.f) - __logf(1.f + __expf(-fabsf(xa)))) * 0.0625f; v1[e] = (fminf(xb, 0.f) - __logf(1.f + __expf(-fabsf(xb)))) * 0.0625f; } }
                    u32x4 w; w.x = pg8::cvt_pk_bf16(v0[0], v0[1]); w.y = pg8::cvt_pk_bf16(v0[2], v0[3]); w.z = pg8::cvt_pk_bf16(v1[0], v1[1]); w.w = pg8::cvt_pk_bf16(v1[2], v1[3]);
                    __builtin_amdgcn_raw_buffer_store_b128(w, prs, (unsigned)(((row0 + ai * 128 + m * 16) * NP + col0 + bj * 128) * 2), 0, 16); } }
    }
};
template <bool INB, bool OUTB>
struct EpiRes {
    static constexpr bool PERM = true, AFTER_DRAIN = false;
    const void* xin; void* out; const float* modg;
    __device__ __forceinline__ void operator()(const pg8::f32x4 (&acc)[2][2][4][2], const pg8::Unit& u, int wr, int wc, int fr, int fq) const {
        const int w = u.pm >> 5; const int cb = u.pn * 256 + wc * 32 + 8 * fq;
        f32x4 gv[2][2];
#pragma unroll
        for (int bj = 0; bj < 2; ++bj)
#pragma unroll
            for (int n = 0; n < 2; ++n) gv[bj][n] = *(const f32x4*)(modg + w * 6144 + cb + bj * 128 + 4 * n);
        constexpr int RG = INB ? 4 : 2;
#pragma unroll
        for (int ai = 0; ai < 2; ++ai)
#pragma unroll
            for (int mp = 0; mp < 4 / RG; ++mp) {
                u32x4 xb[RG][2]; f32x4 xf[INB ? 1 : RG][2][2];
#pragma unroll
                for (int mm = 0; mm < RG; ++mm) { const size_t ro = (size_t)(u.pm * 256 + ai * 128 + wr * 64 + (RG * mp + mm) * 16 + fr) * D + cb;
#pragma unroll
                    for (int bj = 0; bj < 2; ++bj) {
                        if (INB) xb[mm][bj] = *(const u32x4*)((const bf16*)xin + ro + bj * 128);
                        else { xf[INB ? 0 : mm][bj][0] = *(const f32x4*)((const float*)xin + ro + bj * 128); xf[INB ? 0 : mm][bj][1] = *(const f32x4*)((const float*)xin + ro + bj * 128 + 4); } } }
#pragma unroll
                for (int mm = 0; mm < RG; ++mm) { const int m = RG * mp + mm; const size_t ro = (size_t)(u.pm * 256 + ai * 128 + wr * 64 + m * 16 + fr) * D + cb;
#pragma unroll
                    for (int bj = 0; bj < 2; ++bj) { f32x4 x0, x1;
                        if (INB) { const u32x4 t = xb[mm][bj]; x0 = (f32x4){bflo(t.x), bfhi(t.x), bflo(t.y), bfhi(t.y)}; x1 = (f32x4){bflo(t.z), bfhi(t.z), bflo(t.w), bfhi(t.w)}; }
                        else { x0 = xf[INB ? 0 : mm][bj][0]; x1 = xf[INB ? 0 : mm][bj][1]; }
                        const pg8::f32x4 a0 = acc[ai][bj][m][0], a1 = acc[ai][bj][m][1]; const f32x4 g0 = gv[bj][0], g1 = gv[bj][1];
                        f32x4 y0, y1;
#pragma unroll
                        for (int e = 0; e < 4; ++e) { y0[e] = x0[e] + g0[e] * a0[e]; y1[e] = x1[e] + g1[e] * a1[e]; }
                        if (OUTB) { u32x4 pk; pk.x = pg8::cvt_pk_bf16(y0[0], y0[1]); pk.y = pg8::cvt_pk_bf16(y0[2], y0[3]); pk.z = pg8::cvt_pk_bf16(y1[0], y1[1]); pk.w = pg8::cvt_pk_bf16(y1[2], y1[3]);
                            *(u32x4*)((bf16*)out + ro + bj * 128) = pk; }
                        else { *(f32x4*)((float*)out + ro + bj * 128) = y0; *(f32x4*)((float*)out + ro + bj * 128 + 4) = y1; } } }
            }
    }
};
template <bool STORE_X>
__device__ __forceinline__ void panel_rms(pg8::f32x4 (&acc)[2][2][4][2], const pg8::Unit& u, int wr, int wc, int fr, int fq, LAS unsigned char* lds, int wid, int lane,
                                          const bf16* xin, bf16* xout, const float* modg, float* slots, unsigned* cnt) {
    const int w = u.pm >> 5; const int cb = u.pn * 256 + wc * 32 + 8 * fq;
    LAS float* P = (LAS float*)lds;
    LAS float* S = (LAS float*)(lds + 4096);
    f32x4 gv[2][2];
#pragma unroll
    for (int bj = 0; bj < 2; ++bj)
#pragma unroll
        for (int n = 0; n < 2; ++n) gv[bj][n] = *(const f32x4*)(modg + w * 6144 + cb + bj * 128 + 4 * n);
#pragma unroll
    for (int ai = 0; ai < 2; ++ai) {
        u32x4 xb[4][2];
#pragma unroll
        for (int m = 0; m < 4; ++m) { const size_t ro = (size_t)(u.pm * 256 + ai * 128 + wr * 64 + m * 16 + fr) * D + cb;
#pragma unroll
            for (int bj = 0; bj < 2; ++bj) xb[m][bj] = *(const u32x4*)(xin + ro + bj * 128); }
#pragma unroll
        for (int m = 0; m < 4; ++m) { float sq = 0.f; const size_t ro = (size_t)(u.pm * 256 + ai * 128 + wr * 64 + m * 16 + fr) * D + cb;
#pragma unroll
            for (int bj = 0; bj < 2; ++bj) { const u32x4 t = xb[m][bj]; const f32x4 g0 = gv[bj][0], g1 = gv[bj][1]; pg8::f32x4 a0 = acc[ai][bj][m][0], a1 = acc[ai][bj][m][1];
                a0[0] = bflo(t.x) + g0[0] * a0[0]; a0[1] = bfhi(t.x) + g0[1] * a0[1]; a0[2] = bflo(t.y) + g0[2] * a0[2]; a0[3] = bfhi(t.y) + g0[3] * a0[3];
                a1[0] = bflo(t.z) + g1[0] * a1[0]; a1[1] = bfhi(t.z) + g1[1] * a1[1]; a1[2] = bflo(t.w) + g1[2] * a1[2]; a1[3] = bfhi(t.w) + g1[3] * a1[3];
                acc[ai][bj][m][0] = a0; acc[ai][bj][m][1] = a1;
                sq += ((a0[0] * a0[0] + a0[1] * a0[1]) + (a0[2] * a0[2] + a0[3] * a0[3])) + ((a1[0] * a1[0] + a1[1] * a1[1]) + (a1[2] * a1[2] + a1[3] * a1[3]));
                if (STORE_X) { u32x4 pk; pk.x = pg8::cvt_pk_bf16(a0[0], a0[1]); pk.y = pg8::cvt_pk_bf16(a0[2], a0[3]); pk.z = pg8::cvt_pk_bf16(a1[0], a1[1]); pk.w = pg8::cvt_pk_bf16(a1[2], a1[3]);
                    *(u32x4*)(xout + ro + bj * 128) = pk; } }
            sq += shfl_f(sq, lane ^ 16); sq += shfl_f(sq, lane ^ 32);
            if (fq == 0) P[(ai * 128 + wr * 64 + m * 16 + fr) * 4 + wc] = sq; }
    }
    asm volatile("s_waitcnt lgkmcnt(0)" ::: "memory"); __builtin_amdgcn_s_barrier(); asm volatile("" ::: "memory");
    const int row = wid * 32 + (lane & 31);
    if (lane < 32) { const float t = (P[row * 4 + 0] + P[row * 4 + 1]) + (P[row * 4 + 2] + P[row * 4 + 3]);
        __hip_atomic_store(slots + ((size_t)(u.pm * 256 + row) * 4 + u.pn), t, __ATOMIC_RELAXED, __HIP_MEMORY_SCOPE_AGENT); }
    asm volatile("s_waitcnt vmcnt(0)" ::: "memory");
    if (lane == 0) (void)__hip_atomic_fetch_add(cnt + 64 * u.pm, 1u, __ATOMIC_RELAXED, __HIP_MEMORY_SCOPE_AGENT);
    if (wid == 0) { unsigned sp = 0;
        while ((unsigned)__builtin_amdgcn_readfirstlane((int)__hip_atomic_load(cnt + 64 * u.pm, __ATOMIC_RELAXED, __HIP_MEMORY_SCOPE_AGENT)) < 32u) { __builtin_amdgcn_s_sleep(2); if (++sp > (1u << 22)) break; }
        __builtin_amdgcn_fence(__ATOMIC_ACQUIRE, "agent"); }
    asm volatile("s_waitcnt vmcnt(0) lgkmcnt(0)" ::: "memory"); __builtin_amdgcn_s_barrier(); asm volatile("" ::: "memory");
    if (lane < 32) { const float* sl = slots + (size_t)(u.pm * 256 + row) * 4; float t = 0.f;
#pragma unroll
        for (int q = 0; q < 4; ++q) t += __hip_atomic_load(sl + q, __ATOMIC_RELAXED, __HIP_MEMORY_SCOPE_AGENT);
        S[row] = 1.f / sqrtf(t * (1.f / D) + EPS); }
    asm volatile("s_waitcnt vmcnt(0) lgkmcnt(0)" ::: "memory"); __builtin_amdgcn_s_barrier(); asm volatile("" ::: "memory");
}
struct EpiFinal {
    static constexpr bool PERM = true, AFTER_DRAIN = true;
    const bf16* xin; float* out; const float* modg; const float* gfin; float* slots; unsigned* cnt;
    __device__ __forceinline__ void fused(pg8::f32x4 (&acc)[2][2][4][2], const pg8::Unit& u, int wr, int wc, int fr, int fq, LAS unsigned char* lds, int wid, int lane) const {
        panel_rms<false>(acc, u, wr, wc, fr, fq, lds, wid, lane, xin, nullptr, modg, slots, cnt);
        const LAS float* S = (const LAS float*)(lds + 4096); const int cb = u.pn * 256 + wc * 32 + 8 * fq;
        f32x4 gf[2][2];
#pragma unroll
        for (int bj = 0; bj < 2; ++bj)
#pragma unroll
            for (int n = 0; n < 2; ++n) gf[bj][n] = *(const f32x4*)(gfin + cb + bj * 128 + 4 * n);
#pragma unroll
        for (int ai = 0; ai < 2; ++ai)
#pragma unroll
            for (int m = 0; m < 4; ++m) { const int r = ai * 128 + wr * 64 + m * 16 + fr; const float rs = S[r]; float* o = out + (size_t)(u.pm * 256 + r) * D + cb;
#pragma unroll
                for (int bj = 0; bj < 2; ++bj)
#pragma unroll
                    for (int n = 0; n < 2; ++n) { const pg8::f32x4 a = acc[ai][bj][m][n]; const f32x4 g4 = gf[bj][n];
                        *(f32x4*)(o + bj * 128 + 4 * n) = (f32x4){a[0] * rs * g4[0], a[1] * rs * g4[1], a[2] * rs * g4[2], a[3] * rs * g4[3]}; } }
    }
};
struct EpiResNorm {
    static constexpr bool PERM = true, AFTER_DRAIN = true;
    const bf16* xin; bf16* xout; bf16* hout; const float* modg; const float* gn; const float* modn; float* slots; unsigned* cnt;
    __device__ __forceinline__ void fused(pg8::f32x4 (&acc)[2][2][4][2], const pg8::Unit& u, int wr, int wc, int fr, int fq, LAS unsigned char* lds, int wid, int lane) const {
        panel_rms<true>(acc, u, wr, wc, fr, fq, lds, wid, lane, xin, xout, modg, slots, cnt);
        const LAS float* S = (const LAS float*)(lds + 4096); const int w = u.pm >> 5; const int cb = u.pn * 256 + wc * 32 + 8 * fq;
        f32x4 gm[2][2], shv[2][2];
#pragma unroll
        for (int bj = 0; bj < 2; ++bj)
#pragma unroll
            for (int n = 0; n < 2; ++n) { const int c = cb + bj * 128 + 4 * n; const f32x4 g4 = *(const f32x4*)(gn + c), s4 = *(const f32x4*)(modn + w * 6144 + 4096 + c);
                shv[bj][n] = *(const f32x4*)(modn + w * 6144 + 3072 + c); gm[bj][n] = (f32x4){g4[0] * (1.f + s4[0]), g4[1] * (1.f + s4[1]), g4[2] * (1.f + s4[2]), g4[3] * (1.f + s4[3])}; }
#pragma unroll
        for (int ai = 0; ai < 2; ++ai)
#pragma unroll
            for (int m = 0; m < 4; ++m) { const int r = ai * 128 + wr * 64 + m * 16 + fr; const float rs = S[r]; bf16* o = hout + (size_t)(u.pm * 256 + r) * D + cb;
#pragma unroll
                for (int bj = 0; bj < 2; ++bj) { const pg8::f32x4 a0 = acc[ai][bj][m][0], a1 = acc[ai][bj][m][1]; const f32x4 g0 = gm[bj][0], g1 = gm[bj][1], h0 = shv[bj][0], h1 = shv[bj][1];
                    u32x4 pk; pk.x = pg8::cvt_pk_bf16(a0[0] * rs * g0[0] + h0[0], a0[1] * rs * g0[1] + h0[1]); pk.y = pg8::cvt_pk_bf16(a0[2] * rs * g0[2] + h0[2], a0[3] * rs * g0[3] + h0[3]);
                    pk.z = pg8::cvt_pk_bf16(a1[0] * rs * g1[0] + h1[0], a1[1] * rs * g1[1] + h1[1]); pk.w = pg8::cvt_pk_bf16(a1[2] * rs * g1[2] + h1[2], a1[3] * rs * g1[3] + h1[3]);
                    *(u32x4*)(o + bj * 128) = pk; } }
    }
};
struct EpiUp {
    static constexpr bool PERM = true, AFTER_DRAIN = false;
    bf16* ACT; const float* cw; const float* cb;
    __device__ __forceinline__ void operator()(const pg8::f32x4 (&acc)[2][2][4][2], const pg8::Unit& u, int wr, int wc, int fr, int fq) const {
        const int hc0 = u.pn * 128 + wc * 32 + 8 * fq;
        const __amdgpu_buffer_rsrc_t ars = __builtin_amdgcn_make_buffer_rsrc(ACT, 0, MT * DFF * 2, 0x00020000);
#pragma unroll
        for (int ai = 0; ai < 2; ++ai) { const int blk = ai * 2 + wr;
            float res[4][8];
#pragma unroll
            for (int n = 0; n < 2; ++n) {
                const f32x4 w0 = *(const f32x4*)(cw + hc0 + 4 * n), w1 = *(const f32x4*)(cw + DFF + hc0 + 4 * n), w2 = *(const f32x4*)(cw + 2 * DFF + hc0 + 4 * n), bb = *(const f32x4*)(cb + hc0 + 4 * n);
#pragma unroll
                for (int e = 0; e < 4; ++e) {
                    float xs[4], ps[4], ns[4]; const float bprev = 0.f, bnext = 0.f;
#pragma unroll
                    for (int m = 0; m < 4; ++m) { xs[m] = acc[ai][0][m][n][e]; ps[m] = __builtin_bit_cast(float, __builtin_amdgcn_update_dpp(0, __builtin_bit_cast(int, xs[m]), 0x121, 0xf, 0xf, false)); ns[m] = __builtin_bit_cast(float, __builtin_amdgcn_update_dpp(0, __builtin_bit_cast(int, xs[m]), 0x12f, 0xf, 0xf, false)); }
#pragma unroll
                    for (int m = 0; m < 4; ++m) {
                        const float oldp = (m > 0) ? ps[m > 0 ? m - 1 : 0] : bprev, oldn = (m < 3) ? ns[m < 3 ? m + 1 : 3] : bnext;
                        const float prev = __builtin_bit_cast(float, __builtin_amdgcn_update_dpp(__builtin_bit_cast(int, oldp), __builtin_bit_cast(int, xs[m]), 0x111, 0xf, 0xf, false));
                        const float next = __builtin_bit_cast(float, __builtin_amdgcn_update_dpp(__builtin_bit_cast(int, oldn), __builtin_bit_cast(int, xs[m]), 0x101, 0xf, 0xf, false));
                        const float a = w0[e] * prev + w1[e] * xs[m] + w2[e] * next + bb[e];
                        res[m][4 * n + e] = silu_f(a) * acc[ai][1][m][n][e];
                    }
                }
            }
#pragma unroll
            for (int m = 0; m < 4; ++m) { const int r = u.pm * 256 + ai * 128 + wr * 64 + m * 16 + fr;
                u32x4 w; w.x = pg8::cvt_pk_bf16(res[m][0], res[m][1]); w.y = pg8::cvt_pk_bf16(res[m][2], res[m][3]); w.z = pg8::cvt_pk_bf16(res[m][4], res[m][5]); w.w = pg8::cvt_pk_bf16(res[m][6], res[m][7]);
                __builtin_amdgcn_raw_buffer_store_b128(w, ars, (unsigned)((r * DFF + hc0) * 2), 0, 16); }
        }
    }
};
struct EpiUpCtx {
    static constexpr bool PERM = true, AFTER_DRAIN = false;
    bf16* ACT; const float* cw; const float* cb; LAS float* ex;
    __device__ __forceinline__ void operator()(const pg8::f32x4 (&acc)[2][2][4][2], const pg8::Unit& u, int wr, int wc, int fr, int fq) const {
        const int hc0 = u.pn * 128 + wc * 32 + 8 * fq;
            const int colw = wc * 32 + 8 * fq;
#pragma unroll
            for (int ai = 0; ai < 2; ++ai) { const int blk = ai * 2 + wr;
                if (fr == 0) {
#pragma unroll
                    for (int n = 0; n < 2; ++n)
#pragma unroll
                        for (int e = 0; e < 4; ++e) ex[(blk * 2 + 0) * 128 + colw + 4 * n + e] = acc[ai][0][0][n][e]; }
                if (fr == 15) {
#pragma unroll
                    for (int n = 0; n < 2; ++n)
#pragma unroll
                        for (int e = 0; e < 4; ++e) ex[(blk * 2 + 1) * 128 + colw + 4 * n + e] = acc[ai][0][3][n][e]; } }
            asm volatile("s_waitcnt lgkmcnt(0)" ::: "memory"); __builtin_amdgcn_s_barrier(); asm volatile("" ::: "memory");
#pragma unroll
            for (int ai = 0; ai < 2; ++ai) { const int blk = ai * 2 + wr;
                float res[4][8];
    #pragma unroll
                for (int n = 0; n < 2; ++n) {
                    const f32x4 w0 = *(const f32x4*)(cw + hc0 + 4 * n), w1 = *(const f32x4*)(cw + DFF + hc0 + 4 * n), w2 = *(const f32x4*)(cw + 2 * DFF + hc0 + 4 * n), bb = *(const f32x4*)(cb + hc0 + 4 * n);
    #pragma unroll
                    for (int e = 0; e < 4; ++e) {
                        float xs[4], ps[4], ns[4]; float bprev = 0.f, bnext = 0.f; if (blk > 0) bprev = ex[((blk - 1) * 2 + 1) * 128 + colw + 4 * n + e]; if (blk < 3) bnext = ex[((blk + 1) * 2 + 0) * 128 + colw + 4 * n + e];
    #pragma unroll
                        for (int m = 0; m < 4; ++m) { xs[m] = acc[ai][0][m][n][e]; ps[m] = __builtin_bit_cast(float, __builtin_amdgcn_update_dpp(0, __builtin_bit_cast(int, xs[m]), 0x121, 0xf, 0xf, false)); ns[m] = __builtin_bit_cast(float, __builtin_amdgcn_update_dpp(0, __builtin_bit_cast(int, xs[m]), 0x12f, 0xf, 0xf, false)); }
    #pragma unroll
                        for (int m = 0; m < 4; ++m) {
                            const float prev = (fr > 0) ? ps[m] : (m > 0 ? ps[m > 0 ? m - 1 : 0] : bprev);
                            const float next = (fr < 15) ? ns[m] : (m < 3 ? ns[m < 3 ? m + 1 : 3] : bnext);
                            const float a = w0[e] * prev + w1[e] * xs[m] + w2[e] * next + bb[e];
                            res[m][4 * n + e] = silu_f(a) * acc[ai][1][m][n][e];
                        }
                    }
                }
    #pragma unroll
                for (int m = 0; m < 4; ++m) { const int r = u.pm * 256 + ai * 128 + wr * 64 + m * 16 + fr;
                    u32x4 w; w.x = pg8::cvt_pk_bf16(res[m][0], res[m][1]); w.y = pg8::cvt_pk_bf16(res[m][2], res[m][3]); w.z = pg8::cvt_pk_bf16(res[m][4], res[m][5]); w.w = pg8::cvt_pk_bf16(res[m][6], res[m][7]);
                    *(u32x4*)(ACT + (size_t)r * DFF + hc0) = w; }
            }

    }
};
struct CtxOrder {
    int nN, c, c0;
    __device__ void init(int N, int c_, int c0_) { nN = N / 256; c = c_; c0 = c0_; }
    __device__ bool next(int i, pg8::Unit& u) const { const int j = c - c0; if (i > 0 || j < 0 || j >= 2 * nN) return false; u.pm = 64 + (j & 1); u.pn = j >> 1; u.ks = 0; return true; }
    __device__ __forceinline__ void a_ready(const pg8::Unit&) const {}
    __device__ __forceinline__ void done(const pg8::Unit&) const {}
};

struct SplitOrder {
    int nunits, G, c;
    __device__ void init(int nks, int G_, int c_) { nunits = 8 * nks; G = G_; c = c_; }
    __device__ bool next(int i, pg8::Unit& u) const { const int id = i * G + c; if (id >= nunits) return false; u.pm = 64 + (id & 1); u.pn = (id >> 1) & 3; u.ks = id >> 3; return true; }
    __device__ __forceinline__ void a_ready(const pg8::Unit&) const {}
    __device__ __forceinline__ void done(const pg8::Unit&) const {}
};
struct EpiPartial {
    static constexpr bool PERM = false, AFTER_DRAIN = false;
    float* part;
    __device__ __forceinline__ void operator()(const pg8::f32x4 (&acc)[2][2][4][2], const pg8::Unit& u, int wr, int wc, int fr, int fq) const {
#pragma unroll
        for (int ai = 0; ai < 2; ++ai)
#pragma unroll
            for (int m = 0; m < 4; ++m) { const int r = u.pm * 256 + ai * 128 + wr * 64 + m * 16 + fr; float* o = part + ((size_t)u.ks * MC + (size_t)(r - ML)) * D;
#pragma unroll
                for (int bj = 0; bj < 2; ++bj)
#pragma unroll
                    for (int n = 0; n < 2; ++n) { const int c = u.pn * 256 + bj * 128 + wc * 32 + 16 * n + 4 * fq; const pg8::f32x4 a = acc[ai][bj][m][n];
                        *(f32x4*)(o + c) = (f32x4){a[0], a[1], a[2], a[3]}; } }
    }
};
typedef __attribute__((address_space(1))) unsigned gu32;
#define XB_TMO      128
#define XB_XCNT(j)  (256  + 64 * (j))
#define XB_XSUB(j)  (1280 + 64 * (j))
#define XB_XGEN(j)  (2304 + 64 * (j))
#define XB_TOP      3328
#define XB_TOPGEN   3392
#define XCD_BAR_WORDS 3456
#define XB_SPIN_CAP (1u << 18)

__device__ __forceinline__ unsigned xb_ld(unsigned* p)              { return __hip_atomic_load(p, __ATOMIC_RELAXED, __HIP_MEMORY_SCOPE_AGENT); }
__device__ __forceinline__ unsigned xb_add(unsigned* p, unsigned v) { return __hip_atomic_fetch_add(p, v, __ATOMIC_RELAXED, __HIP_MEMORY_SCOPE_AGENT); }
__device__ __forceinline__ unsigned xb_xcc_id() { return (unsigned)__builtin_amdgcn_s_getreg((3 << 11) | 20) & 0xFu; }
#define XB_SPIN(cond, bar) do { unsigned _sp = 0; while (cond) { __builtin_amdgcn_s_sleep(1); \
    if ((++_sp & 255u) == 0u) { if (xb_ld(&(bar)[XB_TMO])) break; if (_sp > XB_SPIN_CAP) { atomicAdd(&(bar)[XB_TMO], 1u); break; } } } } while (0)

struct XcdBarrier {
    unsigned* bar; unsigned x;
    volatile LAS unsigned* st;
};

__device__ __forceinline__ XcdBarrier xcd_barrier_post(unsigned* bar, volatile LAS unsigned* st, int tid_) {
    XcdBarrier b; b.bar = bar; b.x = xb_xcc_id(); b.st = st;
    if (tid_ == 0) (void)xb_add(&bar[XB_XCNT(b.x)], 1u);
    return b;
}
__device__ __forceinline__ void xcd_barrier_complete(unsigned* bar, unsigned x, unsigned& nloc, unsigned& nx) {
    const unsigned G = gridDim.x * gridDim.y * gridDim.z;
    unsigned sum, cnt, mine, sp = 0u;
    for (;;) {
        sum = 0u; cnt = 0u; mine = 0u;
#pragma unroll
        for (unsigned j = 0; j < 16; ++j) { const unsigned c = xb_ld(&bar[XB_XCNT(j)]); sum += c; cnt += (c > 0u) ? 1u : 0u; mine = (j == x) ? c : mine; }
        if (sum == G) break;
        __builtin_amdgcn_s_sleep(1);
        if ((++sp & 255u) == 0u) { if (xb_ld(&bar[XB_TMO])) break; if (sp > XB_SPIN_CAP) { atomicAdd(&bar[XB_TMO], 1u); break; } }
    }
    nloc = mine > 0u ? mine : 1u; nx = cnt > 0u ? cnt : 1u;
}

__device__ __forceinline__ void xcd_barrier(const XcdBarrier& b, int tid_) {
    asm volatile("s_waitcnt vmcnt(0)" ::: "memory");
    __syncthreads();
    if (tid_ == 0) {
        unsigned* bar = b.bar; asm volatile("" : "+s"(bar)); unsigned bx = (unsigned)__builtin_amdgcn_readfirstlane((int)b.x); asm volatile("" : "+s"(bx));
        __builtin_amdgcn_s_waitcnt(0);
        unsigned nloc = b.st[0], nx = b.st[1];
        if (nloc == 0u) { xcd_barrier_complete(bar, bx, nloc, nx); b.st[0] = nloc; b.st[1] = nx; }
        const unsigned old = xb_add(&bar[XB_XSUB(bx)], 1u);
        const unsigned gen = old / nloc;
        if (old + 1u == (gen + 1u) * nloc) {
            __builtin_amdgcn_fence(__ATOMIC_RELEASE, "agent");
            asm volatile("s_waitcnt vmcnt(0)" ::: "memory");
            const unsigned og = xb_add(&bar[XB_TOP], 1u);
            const unsigned tg = og / nx;
            if (og + 1u == (tg + 1u) * nx) xb_add(&bar[XB_TOPGEN], 1u);
            else XB_SPIN(xb_ld(&bar[XB_TOPGEN]) == tg, bar);
            __builtin_amdgcn_fence(__ATOMIC_ACQUIRE, "agent");
            xb_add(&bar[XB_XGEN(bx)], 1u);
            asm volatile("s_waitcnt vmcnt(0)" ::: "memory");
        } else {
            XB_SPIN(xb_ld(&bar[XB_XGEN(bx)]) == gen, bar);
            __builtin_amdgcn_fence(__ATOMIC_ACQUIRE, "agent");
            asm volatile("s_waitcnt vmcnt(0)" ::: "memory");
        }
    }
    __syncthreads();
}
struct Ctx {
    LAS unsigned char* lds; int tid, lane, wave, G, gw, NGW;
    float* MOD; float* MCS; bf16 *F1, *F2, *FC; bf16 *HX, *YMIX, *PB, *ACT, *TB, *CAU; float *XC, *ST, *DEC;
};
__device__ __forceinline__ bf16* win_t(PP p, int l) { return (bf16*)(p->ws + WS_W + (size_t)l * W_LAYER_B); }
__device__ __forceinline__ bf16* wout_t(PP p, int l) { return (bf16*)(p->ws + WS_W + (size_t)l * W_LAYER_B + W_IN_B); }
__device__ __forceinline__ bf16* wup_t(PP p, int l) { return (bf16*)(p->ws + WS_W + (size_t)l * W_LAYER_B + W_IN_B + W_OUT_B); }
__device__ __forceinline__ bf16* wdn_t(PP p, int l) { return (bf16*)(p->ws + WS_W + (size_t)l * W_LAYER_B + W_IN_B + W_OUT_B + W_UP_B); }

__device__ __forceinline__ void transpose_item(const float* W, int K, int N, bf16* WT, int k0, int n0, int dst0, float scale, LAS float* scr, int lane) {
#pragma unroll
    for (int i = 0; i < 32; ++i) { const int kk = 2 * i + (lane >> 5); scr[kk * 33 + (lane & 31)] = __builtin_nontemporal_load(W + (size_t)(k0 + kk) * N + n0 + (lane & 31)) * scale; }
    LDS_WAIT(); __builtin_amdgcn_wave_barrier();
    const int c = lane & 7;
#pragma unroll
    for (int j = 0; j < 4; ++j) { const int n = (lane >> 3) + 8 * j; const LAS float* s = scr + (8 * c) * 33 + n;
        u32x4 o; o.x = pk2(s[0 * 33], s[1 * 33]); o.y = pk2(s[2 * 33], s[3 * 33]); o.z = pk2(s[4 * 33], s[5 * 33]); o.w = pk2(s[6 * 33], s[7 * 33]);
        *(u32x4*)(WT + (size_t)(dst0 + n) * K + k0 + 8 * c) = o; }
    LDS_WAIT(); __builtin_amdgcn_wave_barrier();
}

__device__ __forceinline__ void phase0(PP p, Ctx& F) {
    LAS float* sv = (LAS float*)F.lds; LAS float* red = sv + 3072;
    for (int i = F.tid; i < 3072; i += 512) { const int w = i >> 10, k = i & 1023; const float cv = (w < 2) ? p->c[w * 1024 + k] : p->c_ctx[k]; sv[i] = cv / (1.f + expf(-cv)); }
    __syncthreads();
    for (int it = blockIdx.x; it < 192; it += F.G) {
        const int l = it / 96, c0 = (it % 96) * 64; const float* W = p->w_mod + (size_t)l * 1024 * 6144 + c0 + F.lane;
        float a0 = 0.f, a1 = 0.f, a2 = 0.f; const int kb = F.wave * 128;
#pragma unroll 32
        for (int k = 0; k < 128; ++k) { const float wv = __builtin_nontemporal_load(W + (size_t)(kb + k) * 6144); a0 += sv[kb + k] * wv; a1 += sv[1024 + kb + k] * wv; a2 += sv[2048 + kb + k] * wv; }
        red[(F.wave * 3 + 0) * 64 + F.lane] = a0; red[(F.wave * 3 + 1) * 64 + F.lane] = a1; red[(F.wave * 3 + 2) * 64 + F.lane] = a2;
        __syncthreads();
        if (F.tid < 192) { const int w = F.tid >> 6, ln = F.tid & 63; float s = 0.f;
#pragma unroll
            for (int q = 0; q < 8; ++q) s += red[(q * 3 + w) * 64 + ln];
            F.MOD[(l * 3 + w) * 6144 + c0 + ln] = s + p->b_mod[l * 6144 + c0 + ln]; }
        __syncthreads();
    }
    __syncthreads();
    LAS float* scr = (LAS float*)(F.lds + F.wave * 16384);
    constexpr int I_IN = 48 * 16, I_OUT = 32 * 16, I_UP = 176 * 16, I_DN = 32 * 44, I_L = I_IN + I_OUT + I_UP + I_DN;
    for (int it = F.gw; it < 2 * I_L; it += F.NGW) {
        const int l = it / I_L; int r = it % I_L;
        if (r < I_IN) { const int cb = r / 16, kb = r % 16; int src, dst; float sc = 1.f;
            if (cb < 4) { src = 32 * cb; dst = PK + 32 * cb; }
            else if (cb < 8) { src = 416 + 32 * (cb - 4); dst = PQ + 32 * (cb - 4); sc = 0.17677669529663687f; }
            else if (cb < 16) { src = 128 + 32 * (cb - 8); dst = PV + 32 * (cb - 8); }
            else if (cb < 24) { src = 544 + 32 * (cb - 16); dst = PG + 32 * (cb - 16); }
            else if (cb < 32) { src = 1056 + 32 * (cb - 24); dst = PH + 32 * (cb - 24); }
            else if (cb < 40) { src = 1312 + 32 * (cb - 32); dst = PBG + 32 * (cb - 32); }
            else { src = 1568 + 32 * (cb - 40); dst = PCG + 32 * (cb - 40); }
            transpose_item(p->w_in + (size_t)l * D * DIN, D, DIN, win_t(p, l), 64 * kb, src, dst, sc, scr, F.lane); continue; }
        r -= I_IN;
        if (r < I_OUT) { const int cb = r / 16, kb = r % 16; transpose_item(p->w_out + (size_t)l * D * D, D, D, wout_t(p, l), 64 * kb, 32 * cb, 32 * cb, 1.f, scr, F.lane); continue; }
        r -= I_OUT;
        if (r < I_UP) { const int cb = r / 16, kb = r % 16; const int c = 32 * cb, isu = (c >= DFF) ? 1 : 0, j = c - isu * DFF; const int dst = (j / 128) * 256 + isu * 128 + (j % 128);
            transpose_item(p->w_up + (size_t)l * D * NUP, D, NUP, wup_t(p, l), 64 * kb, c, dst, 1.f, scr, F.lane); continue; }
        r -= I_UP;
        { const int cb = r / 44, kb = r % 44; transpose_item(p->w_down + (size_t)l * DFF * D, DFF, D, wdn_t(p, l), 64 * kb, 32 * cb, 32 * cb, 1.f, scr, F.lane); }
    }
    const int gt = blockIdx.x * 512 + F.tid, NT = F.G * 512;
    const int gtm = (F.G == 256) ? ((int)blockIdx.x - 192) * 512 + F.tid : gt; const int NTm = (F.G == 256) ? 32768 : NT;
    for (int i = gtm; i >= 0 && i < 32768; i += NTm) { const int d = i & 63, c = (i >> 6) & 63, g = (i >> 12) & 3, l = i >> 14;
        const float* wf = p->fft_w + (size_t)((l * 4 + g) * 64) * 64 + d; float mc = 0.f, ms = 0.f;
        for (int f = 0; f < 64; ++f) { const float a = (float)((f * c) & 63) * (1.f / 64.f); const float w = wf[f * 64]; mc += cos_rev(a) * w; ms -= sin_rev(a) * w; }
        F.MCS[(((l * 4 + g) * 2 + 0) * 64 + c) * 64 + d] = mc * 0.125f; F.MCS[(((l * 4 + g) * 2 + 1) * 64 + c) * 64 + d] = ms * 0.125f; }
    for (int i = gt; i < MC * D / 4; i += NT) ((f32x4*)F.XC)[i] = ((const f32x4*)p->ctx)[i];
    for (int i = gt; i < 180224; i += NT) {
        if (i < 16384) { const int mm = i >> 7, kk = i & 127, k1 = mm & 63, n1 = kk & 63; const float a = (float)((k1 * n1) & 63) * (1.f / 64.f); const float C = cos_rev(a), S = sin_rev(a);
            const float v = (mm < 64) ? (kk < 64 ? C : S) : (kk < 64 ? -S : C); F.F1[i] = (bf16)f2bf(v); }
        else if (i < 49152) { const int j = i - 16384, k2 = j >> 8, kk = j & 255, n2 = kk & 127; const float a = (float)((k2 * n2) & 127) * (1.f / 128.f);
            const float v = (kk < 128 ? cos_rev(a) : sin_rev(a)) * 0.011048543456039806f; F.F2[j] = (bf16)f2bf(v); }
        else { const int j = i - 49152, k = j >> 9, kk = j & 511, n = kk & 255; const float a = (float)((k * n) & 255) * (1.f / 256.f);
            const float v = (kk < 256 ? cos_rev(a) : sin_rev(a)) * 0.0625f; F.FC[j] = (bf16)f2bf(v); }
    }
}

__device__ __forceinline__ void fold_items(PP p, Ctx& F) {
    for (int it4 = F.gw; it4 < 1792; it4 += F.NGW) {
        const int dq = it4 & 3, it = it4 >> 2;
        const int l = it / 224, r = it % 224, s = r / 16, kb = r % 16; const int k = 64 * kb + F.lane;
        const float* wrow = p->w_in + (size_t)l * D * DIN + (size_t)k * DIN; bf16* WT = win_t(p, l);
        if (s < 2) {
            const f32x4* src = (const f32x4*)(wrow + 384 + 16 * s); f32x4 r4[4];
#pragma unroll
            for (int q = 0; q < 4; ++q) r4[q] = src[q];
            const float* M = p->w_a2 + (size_t)((l * 2 + s) * 16) * 128;
            for (int d = 32 * dq; d < 32 * dq + 32; ++d) { float a = 0.f;
#pragma unroll
                for (int c = 0; c < 16; ++c) a += r4[c >> 2][c & 3] * M[c * 128 + d];
                WT[(size_t)(PLA + s * 128 + d) * D + k] = (bf16)f2bf(a); }
        } else {
            const int kind = (s - 2) >> 2, g = (s - 2) & 3;
            const f32x4* src = (const f32x4*)(wrow + (kind < 2 ? 800 : 1824) + 64 * g); f32x4 r4[16];
#pragma unroll
            for (int q = 0; q < 16; ++q) r4[q] = src[q];
            const float* M = (kind < 2) ? (F.MCS + (size_t)(((l * 4 + g) * 2 + kind) * 64) * 64) : (p->pool_w + (size_t)((l * 4 + g) * 64) * 64);
            const int drow = (kind == 0 ? PFA : (kind == 1 ? PFB : PPOOL)) + 64 * g;
            for (int d = 16 * dq; d < 16 * dq + 16; ++d) { float a = 0.f;
#pragma unroll
                for (int c = 0; c < 64; ++c) a += r4[c >> 2][c & 3] * M[c * 64 + d];
                if (kind == 2) a *= p->pool_scale[l * 256 + g * 64 + d];
                WT[(size_t)(drow + d) * D + k] = (bf16)f2bf(a); }
        }
    }
}

__device__ __forceinline__ void norm_row_bf16(const float* xrow, bf16* orow, const float* g, const float* sc, const float* sh, int lane, const float* part, int nparts, const float* gate, float* xout) {
    f32x4 v[4]; float s = 0.f;
#pragma unroll
    for (int j = 0; j < 4; ++j) v[j] = ((const f32x4*)xrow)[lane + 64 * j];
    if (nparts > 0) {
        f32x4 a[4];
#pragma unroll
        for (int j = 0; j < 4; ++j) a[j] = (f32x4){0.f, 0.f, 0.f, 0.f};
        for (int q = 0; q < nparts; ++q) {
#pragma unroll
            for (int j = 0; j < 4; ++j) { const f32x4 t = ((const f32x4*)(part + (size_t)q * MC * D))[lane + 64 * j]; a[j][0] += t[0]; a[j][1] += t[1]; a[j][2] += t[2]; a[j][3] += t[3]; } }
#pragma unroll
        for (int j = 0; j < 4; ++j) { const f32x4 gv = ((const f32x4*)gate)[lane + 64 * j];
#pragma unroll
            for (int e = 0; e < 4; ++e) v[j][e] += gv[e] * a[j][e];
            ((f32x4*)xout)[lane + 64 * j] = v[j]; }
    }
#pragma unroll
    for (int j = 0; j < 4; ++j) s += (v[j][0] * v[j][0] + v[j][1] * v[j][1]) + (v[j][2] * v[j][2] + v[j][3] * v[j][3]);
    const float rstd = 1.f / sqrtf(wave_sum(s, lane) * (1.f / D) + EPS);
#pragma unroll
    for (int j = 0; j < 4; ++j) { const int idx = lane + 64 * j; const f32x4 gv = ((const f32x4*)g)[idx], scv = ((const f32x4*)sc)[idx], shv = ((const f32x4*)sh)[idx];
        float y[4];
#pragma unroll
        for (int e = 0; e < 4; ++e) y[e] = v[j][e] * rstd * gv[e] * (1.f + scv[e]) + shv[e];
        u32x2 o; o.x = pk2(y[0], y[1]); o.y = pk2(y[2], y[3]); ((u32x2*)orow)[idx] = o; }
}
template <bool FINAL, bool INB>
__device__ __forceinline__ void norm_rows4(const void* xbase, bf16* obase, float* fout, const float* g, const float* modl, int which, int m0, int stride, int lane) {
    f32x4 v[4][4]; float s[4]; int mk[4]; bool ok[4];
#pragma unroll
    for (int k = 0; k < 4; ++k) { const int m = m0 + k * stride; ok[k] = m < ML; mk[k] = ok[k] ? m : ML - 1;
#pragma unroll
        for (int j = 0; j < 4; ++j) {
            if (INB) { const u32x2 t = ((const u32x2*)((const bf16*)xbase + (size_t)mk[k] * D))[lane + 64 * j]; v[k][j] = (f32x4){bflo(t.x), bfhi(t.x), bflo(t.y), bfhi(t.y)}; }
            else v[k][j] = ((const f32x4*)((const float*)xbase + (size_t)mk[k] * D))[lane + 64 * j]; } }
    f32x4 gm[4], sh4[4];
    { const float* mod = FINAL ? g : modl + (m0 >> 13) * 6144 + which * 3072;
#pragma unroll
      for (int j = 0; j < 4; ++j) { const int idx = lane + 64 * j; const f32x4 gv = ((const f32x4*)g)[idx];
          if (FINAL) { gm[j] = gv; sh4[j] = (f32x4){0.f, 0.f, 0.f, 0.f}; }
          else { const f32x4 scv = ((const f32x4*)(mod + 1024))[idx]; sh4[j] = ((const f32x4*)mod)[idx];
#pragma unroll
              for (int e = 0; e < 4; ++e) gm[j][e] = gv[e] * (1.f + scv[e]); } } }
#pragma unroll
    for (int k = 0; k < 4; ++k) { float a = 0.f;
#pragma unroll
        for (int j = 0; j < 4; ++j) a += (v[k][j][0] * v[k][j][0] + v[k][j][1] * v[k][j][1]) + (v[k][j][2] * v[k][j][2] + v[k][j][3] * v[k][j][3]);
        s[k] = a; }
#pragma unroll
    for (int o = 1; o < 64; o <<= 1) {
#pragma unroll
        for (int k = 0; k < 4; ++k) s[k] += shfl_f(s[k], lane ^ o); }
#pragma unroll
    for (int k = 0; k < 4; ++k) { if (!ok[k]) continue;
        const float rstd = 1.f / sqrtf(s[k] * (1.f / D) + EPS);
#pragma unroll
        for (int j = 0; j < 4; ++j) { const int idx = lane + 64 * j;
            if (FINAL) { f32x4 y;
#pragma unroll
                for (int e = 0; e < 4; ++e) y[e] = v[k][j][e] * rstd * gm[j][e];
                ((f32x4*)(fout + (size_t)mk[k] * D))[idx] = y; }
            else { float y[4];
#pragma unroll
                for (int e = 0; e < 4; ++e) y[e] = v[k][j][e] * rstd * gm[j][e] + sh4[j][e];
                u32x2 o; o.x = pk2(y[0], y[1]); o.y = pk2(y[2], y[3]); ((u32x2*)(obase + (size_t)mk[k] * D))[idx] = o; } }
    }
}
__device__ __forceinline__ void norm_phase(PP p, Ctx& F, int l, int which, int mrows) {
    const float* g = (which == 0 ? p->norm1_g : p->norm2_g) + l * D;
    const float* PART = (const float*)(p->ws + WS_PART);
    if (l == 0 && which == 0) { for (int m0 = F.gw; m0 < ML; m0 += 4 * F.NGW) norm_rows4<false, false>(p->x, F.HX, nullptr, g, F.MOD + l * 3 * 6144, which, m0, F.NGW, F.lane); }
    else { const void* xb = (l == 1 && which == 1 && F.G == 256) ? (const void*)(p->ws + WS_XB2) : (const void*)p->out;
        for (int m0 = F.gw; m0 < ML; m0 += 4 * F.NGW) norm_rows4<false, true>(xb, F.HX, nullptr, g, F.MOD + l * 3 * 6144, which, m0, F.NGW, F.lane); }
    for (int m = ML + F.gw; m < mrows; m += F.NGW) {
        int nparts = 0; const float* gate = nullptr;
        const float* xr = ((l == 0 && which == 0) ? p->ctx : F.XC) + (size_t)(m - ML) * D;
        if (l == 0 && which == 1) { nparts = 4; gate = F.MOD + 2 * 6144 + 2048; }
        if (l == 1 && which == 0) { nparts = 11; gate = F.MOD + 2 * 6144 + 5120; }
        const float* part = PART + (size_t)(m - ML) * D; float* xout = F.XC + (size_t)(m - ML) * D;
        const float* mod = F.MOD + (l * 3 + 2) * 6144 + which * 3072;
        norm_row_bf16(xr, F.HX + (size_t)m * D, g, mod + 1024, mod, F.lane, part, nparts, gate, xout);
    }
}
__device__ __forceinline__ void final_norm(PP p, Ctx& F) {
    for (int m0 = F.gw; m0 < ML; m0 += 4 * F.NGW) norm_rows4<true, false>(p->ws + WS_HX  , nullptr, p->out, p->final_g, nullptr, 0, m0, F.NGW, F.lane);
}
constexpr int CP = 260;
__device__ __forceinline__ int chunk_row0(int b, int cidx) { return (cidx < 4) ? (ML + b * CTXL + cidx * 64) : (b * SEQ + (cidx - 4) * 64); }
__device__ __forceinline__ void cum_to_lds(LAS float* cum, const bf16* PB, int row0, int tid) {
    { const int oct = tid & 31, j0 = tid >> 5; u32x4 w[4];
#pragma unroll
      for (int q = 0; q < 4; ++q) w[q] = *(const u32x4*)(PB + (size_t)(row0 + j0 + 16 * q) * NP + PLA + 8 * oct);
#pragma unroll
      for (int q = 0; q < 4; ++q) { LAS float* d = cum + (j0 + 16 * q) * CP + 8 * oct;
          *(LAS f32x4*)d = (f32x4){bflo(w[q].x), bfhi(w[q].x), bflo(w[q].y), bfhi(w[q].y)}; *(LAS f32x4*)(d + 4) = (f32x4){bflo(w[q].z), bfhi(w[q].z), bflo(w[q].w), bfhi(w[q].w)}; } }
    __syncthreads();
    if (tid < 256) { float s = 0.f;
        if (tid < 128) {
#pragma unroll 16
            for (int j = 0; j < 64; ++j) { s += cum[j * CP + tid]; cum[j * CP + tid] = s; }
        } else {
#pragma unroll 16
            for (int j = 63; j >= 0; --j) { s += cum[j * CP + tid]; cum[j * CP + tid] = s; }
        } }
    __syncthreads();
}
typedef float f32x2_t __attribute__((ext_vector_type(2)));
typedef __bf16 bf16x2_t __attribute__((ext_vector_type(2)));
__device__ __forceinline__ unsigned pkh(float lo, float hi) { f32x2_t v = {lo, hi}; bf16x2_t b = __builtin_convertvector(v, bf16x2_t); return __builtin_bit_cast(unsigned, b); }
__device__ __forceinline__ bf16x8 pack8h(float a0, float a1, float a2, float a3, float a4, float a5, float a6, float a7) {
    u32x4 w; w.x = pkh(a0, a1); w.y = pkh(a2, a3); w.z = pkh(a4, a5); w.w = pkh(a6, a7); return __builtin_bit_cast(bf16x8, w);
}
__device__ __forceinline__ void la_load(u32x4 (&w)[4], const bf16* PB, int row0, int tid) {
    const int oct = tid & 31, j0 = tid >> 5;
#pragma unroll
    for (int q = 0; q < 4; ++q) w[q] = *(const u32x4*)(PB + (size_t)(row0 + j0 + 16 * q) * NP + PLA + 8 * oct);
}
__device__ __forceinline__ void la_scan(LAS float* cum, const u32x4 (&w)[4], int tid) {
    const int oct = tid & 31, j0 = tid >> 5;
#pragma unroll
    for (int q = 0; q < 4; ++q) { LAS float* d = cum + (j0 + 16 * q) * CP + 8 * oct;
        *(LAS f32x4*)d = (f32x4){bflo(w[q].x), bfhi(w[q].x), bflo(w[q].y), bfhi(w[q].y)}; *(LAS f32x4*)(d + 4) = (f32x4){bflo(w[q].z), bfhi(w[q].z), bflo(w[q].w), bfhi(w[q].w)}; }
    __syncthreads();
    if (tid < 256) { float carry = 0.f;
        if (tid < 128) {
#pragma unroll
            for (int hf = 0; hf < 4; ++hf) { float v[16];
#pragma unroll
                for (int j = 0; j < 16; ++j) v[j] = cum[(16 * hf + j) * CP + tid];
                v[0] += carry;
#pragma unroll
                for (int j = 1; j < 16; ++j) v[j] += v[j - 1];
                carry = v[15];
#pragma unroll
                for (int j = 0; j < 16; ++j) cum[(16 * hf + j) * CP + tid] = v[j]; }
        } else {
#pragma unroll
            for (int hf = 3; hf >= 0; --hf) { float v[16];
#pragma unroll
                for (int j = 0; j < 16; ++j) v[j] = cum[(16 * hf + j) * CP + tid];
                v[15] += carry;
#pragma unroll
                for (int j = 14; j >= 0; --j) v[j] += v[j + 1];
                carry = v[0];
#pragma unroll
                for (int j = 0; j < 16; ++j) cum[(16 * hf + j) * CP + tid] = v[j]; }
        } }
    __syncthreads();
}
__device__ __forceinline__ void gla_a_item(Ctx& F, int b, int cidx) {
    LAS float* cum = (LAS float*)F.lds; const int row0 = chunk_row0(b, cidx);
    const int h = F.wave & 3, dir = F.wave >> 2, chb = dir * 128 + h * 32, lr = F.lane & 15, g = F.lane >> 4;
    const int jl = dir ? 0 : 63;
    u32x4 wla[4]; la_load(wla, F.PB, row0, F.tid);
    unsigned short kt[2][2][8], vt[2][4][8];
#pragma unroll
    for (int ks = 0; ks < 2; ++ks) { const int j0 = 32 * ks + 8 * g;
#pragma unroll
        for (int mb = 0; mb < 2; ++mb)
#pragma unroll
            for (int e = 0; e < 8; ++e) kt[ks][mb][e] = F.PB[(size_t)(row0 + j0 + e) * NP + PK + h * 32 + 16 * mb + lr];
#pragma unroll
        for (int nb = 0; nb < 4; ++nb)
#pragma unroll
            for (int e = 0; e < 8; ++e) vt[ks][nb][e] = F.PB[(size_t)(row0 + j0 + e) * NP + PV + h * 64 + 16 * nb + lr]; }
    la_scan(cum, wla, F.tid);
    f32x4 acc[2][4];
#pragma unroll
    for (int mb = 0; mb < 2; ++mb)
#pragma unroll
        for (int nb = 0; nb < 4; ++nb) acc[mb][nb] = (f32x4){0.f, 0.f, 0.f, 0.f};
#pragma unroll
    for (int ks = 0; ks < 2; ++ks) {
        bf16x8 af[2], bfr[4]; const int j0 = 32 * ks + 8 * g;
#pragma unroll
        for (int mb = 0; mb < 2; ++mb) { const int dk = 16 * mb + lr; const float last = cum[jl * CP + chb + dk]; float a[8];
#pragma unroll
            for (int e = 0; e < 8; ++e) { const int j = j0 + e; a[e] = bf2f(kt[ks][mb][e]) * __expf(last - cum[j * CP + chb + dk]); }
            af[mb] = pack8h(a[0], a[1], a[2], a[3], a[4], a[5], a[6], a[7]); }
#pragma unroll
        for (int nb = 0; nb < 4; ++nb) { const unsigned short* t = vt[ks][nb];
            u32x4 w; w.x = t[0] | ((unsigned)t[1] << 16); w.y = t[2] | ((unsigned)t[3] << 16); w.z = t[4] | ((unsigned)t[5] << 16); w.w = t[6] | ((unsigned)t[7] << 16);
            bfr[nb] = __builtin_bit_cast(bf16x8, w); }
#pragma unroll
        for (int mb = 0; mb < 2; ++mb)
#pragma unroll
            for (int nb = 0; nb < 4; ++nb) acc[mb][nb] = MFMA16(af[mb], bfr[nb], acc[mb][nb]);
    }
    const size_t sidx = (size_t)(((b * 2 + dir) * 4 + h) * NCH + cidx);
    float* st = F.ST + sidx * 2048;
#pragma unroll
    for (int mb = 0; mb < 2; ++mb)
#pragma unroll
        for (int nb = 0; nb < 4; ++nb) *(f32x4*)(st + (16 * nb + lr) * 32 + 16 * mb + 4 * g) = acc[mb][nb];
    if (F.lane < 32) F.DEC[sidx * 32 + F.lane] = __expf(cum[jl * CP + chb + F.lane]);
    __syncthreads();
}
__device__ __forceinline__ void gla_scan(Ctx& F) {
    LAS float* xa = (LAS float*)F.lds; LAS float* xb = xa + 512;
    const int seg = F.tid >> 6, el = F.tid & 63;
    for (int blk = blockIdx.x; blk < 512; blk += F.G) {
        const int ge = blk * 64 + el, e = ge & 2047, seq = ge >> 11, dir = (seq >> 2) & 1, dk = e & 31;
        float* st = F.ST + (size_t)seq * NCH * 2048 + e; const float* dc = F.DEC + (size_t)seq * NCH * 32 + dk;
        float u[17], d[17];
#pragma unroll
        for (int i = 0; i < 17; ++i) { const int s = seg * 17 + i; const bool ok = s < NCH; const int sc = ok ? s : NCH - 1; const int c = dir ? (sc < 4 ? 3 - sc : 135 - sc) : sc;
            const float uu = st[(size_t)c * 2048], dd = dc[c * 32]; u[i] = ok ? uu : 0.f; d[i] = ok ? dd : 1.f; }
        float A = 1.f, B = 0.f;
#pragma unroll
        for (int i = 0; i < 17; ++i) { B = B * d[i] + u[i]; A *= d[i]; }
        xa[F.tid] = A; xb[F.tid] = B;
        __syncthreads();
        float S = 0.f;
        for (int sg = 0; sg < seg; ++sg) S = S * xa[sg * 64 + el] + xb[sg * 64 + el];
#pragma unroll
        for (int i = 0; i < 17; ++i) { const int s = seg * 17 + i; if (s < NCH) { const int c = dir ? (s < 4 ? 3 - s : 135 - s) : s; st[(size_t)c * 2048] = S; } S = S * d[i] + u[i]; }
        __syncthreads();
    }
}
template <int NI>
__device__ __forceinline__ void gla_c_item(PP p, Ctx& F, int l, int b, int cidx, int sub) {
    LAS float* cum = (LAS float*)F.lds; const int row0 = chunk_row0(b, cidx);
    const int h = F.wave & 3, half = (NI == 2) ? (F.wave >> 2) : sub, ibase = (NI == 2) ? 0 : (F.wave >> 2), lr = F.lane & 15, g = F.lane >> 4;
    u32x4 wla[4]; la_load(wla, F.PB, row0, F.tid);
    f32x4 o[4][2];
#pragma unroll
    for (int mb = 0; mb < 4; ++mb) { o[mb][0] = (f32x4){0.f, 0.f, 0.f, 0.f}; o[mb][1] = (f32x4){0.f, 0.f, 0.f, 0.f}; }
    bf16x8 av[4][2];
#pragma unroll
    for (int mb = 0; mb < 4; ++mb)
#pragma unroll
        for (int pp = 0; pp < 2; ++pp) { unsigned short t[8];
#pragma unroll
            for (int e = 0; e < 8; ++e) { const int j = 32 * pp + (e < 4 ? 4 * g + e : 16 + 4 * g + (e - 4)); t[e] = F.PB[(size_t)(row0 + j) * NP + PV + h * 64 + 16 * mb + lr]; }
            u32x4 w; w.x = t[0] | ((unsigned)t[1] << 16); w.y = t[2] | ((unsigned)t[3] << 16); w.z = t[4] | ((unsigned)t[5] << 16); w.w = t[6] | ((unsigned)t[7] << 16);
            av[mb][pp] = __builtin_bit_cast(bf16x8, w); }
    u32x4 qraw[2], kraw[4]; f32x4 sraw[2][4][2];
#pragma unroll
    for (int ibl = 0; ibl < NI; ++ibl) qraw[ibl] = *(const u32x4*)(F.PB + (size_t)(row0 + 16 * (2 * half + ibase + ibl) + lr) * NP + PQ + h * 32 + 8 * g);
#pragma unroll
    for (int jb = 0; jb < 4; ++jb) kraw[jb] = *(const u32x4*)(F.PB + (size_t)(row0 + 16 * jb + lr) * NP + PK + h * 32 + 8 * g);
    { const float* st = F.ST + (size_t)(((b * 2 + 0) * 4 + h) * NCH + cidx) * 2048;
#pragma unroll
        for (int mb = 0; mb < 4; ++mb) { sraw[0][mb][0] = *(const f32x4*)(st + (16 * mb + lr) * 32 + 8 * g); sraw[0][mb][1] = *(const f32x4*)(st + (16 * mb + lr) * 32 + 8 * g + 4); } }
    la_scan(cum, wla, F.tid);
    { const float* st = F.ST + (size_t)(((b * 2 + 1) * 4 + h) * NCH + cidx) * 2048;
#pragma unroll
        for (int mb = 0; mb < 4; ++mb) { sraw[1][mb][0] = *(const f32x4*)(st + (16 * mb + lr) * 32 + 8 * g); sraw[1][mb][1] = *(const f32x4*)(st + (16 * mb + lr) * 32 + 8 * g + 4); } }
#pragma unroll
    for (int dir = 0; dir < 2; ++dir) {
        const int chb = dir * 128 + h * 32;
        bf16x8 bq[2];
#pragma unroll
        for (int ibl = 0; ibl < NI; ++ibl) { const int i = 16 * (2 * half + ibase + ibl) + lr;
            const u32x4 qw = qraw[ibl];
            const f32x4 c0 = *(const LAS f32x4*)(cum + i * CP + chb + 8 * g), c1 = *(const LAS f32x4*)(cum + i * CP + chb + 8 * g + 4);
            bq[ibl] = pack8h(bflo(qw.x) * __expf(c0[0]), bfhi(qw.x) * __expf(c0[1]), bflo(qw.y) * __expf(c0[2]), bfhi(qw.y) * __expf(c0[3]),
                            bflo(qw.z) * __expf(c1[0]), bfhi(qw.z) * __expf(c1[1]), bflo(qw.w) * __expf(c1[2]), bfhi(qw.w) * __expf(c1[3])); }
#pragma unroll
        for (int mb = 0; mb < 4; ++mb) { const f32x4 s0 = sraw[dir][mb][0], s1 = sraw[dir][mb][1];
            const bf16x8 as = pack8h(s0[0], s0[1], s0[2], s0[3], s1[0], s1[1], s1[2], s1[3]);
            o[mb][0] = MFMA16(as, bq[0], o[mb][0]); if (NI == 2) o[mb][1] = MFMA16(as, bq[1], o[mb][1]); }
#pragma unroll
        for (int pp = 0; pp < 2; ++pp) {
            if ((dir == 0 && half == 0 && pp == 1) || (dir == 1 && half == 1 && pp == 0)) continue;
            f32x4 sc[2][2];
#pragma unroll
            for (int q = 0; q < 2; ++q) { const int jb = 2 * pp + q, j = 16 * jb + lr;
                const u32x4 kw = kraw[jb];
                const f32x4 c0 = *(const LAS f32x4*)(cum + j * CP + chb + 8 * g), c1 = *(const LAS f32x4*)(cum + j * CP + chb + 8 * g + 4);
                const bf16x8 ak = pack8h(bflo(kw.x) * __expf(-c0[0]), bfhi(kw.x) * __expf(-c0[1]), bflo(kw.y) * __expf(-c0[2]), bfhi(kw.y) * __expf(-c0[3]),
                                        bflo(kw.z) * __expf(-c1[0]), bfhi(kw.z) * __expf(-c1[1]), bflo(kw.w) * __expf(-c1[2]), bfhi(kw.w) * __expf(-c1[3]));
#pragma unroll
                for (int ibl = 0; ibl < NI; ++ibl) { f32x4 z = (f32x4){0.f, 0.f, 0.f, 0.f}; z = MFMA16(ak, bq[ibl], z);
                    const int i = 16 * (2 * half + ibase + ibl) + lr;
#pragma unroll
                    for (int r = 0; r < 4; ++r) { const int jj = 16 * jb + 4 * g + r; const bool keep = dir ? (jj >= i) : (jj <= i); z[r] = keep ? z[r] : 0.f; }
                    sc[q][ibl] = z; } }
#pragma unroll
            for (int ibl = 0; ibl < NI; ++ibl) { const bf16x8 pb = pack8h(sc[0][ibl][0], sc[0][ibl][1], sc[0][ibl][2], sc[0][ibl][3], sc[1][ibl][0], sc[1][ibl][1], sc[1][ibl][2], sc[1][ibl][3]);
#pragma unroll
                for (int mb = 0; mb < 4; ++mb) o[mb][ibl] = MFMA16(av[mb][pp], pb, o[mb][ibl]); }
        }
    }
    const float* gg = p->gla_g + l * 64;
#pragma unroll
    for (int ibl = 0; ibl < NI; ++ibl) { float ss = 0.f;
#pragma unroll
        for (int mb = 0; mb < 4; ++mb) ss += (o[mb][ibl][0] * o[mb][ibl][0] + o[mb][ibl][1] * o[mb][ibl][1]) + (o[mb][ibl][2] * o[mb][ibl][2] + o[mb][ibl][3] * o[mb][ibl][3]);
        ss += shfl_f(ss, F.lane ^ 16); ss += shfl_f(ss, F.lane ^ 32);
        const float rstd = 1.f / sqrtf(ss * (1.f / 64.f) + EPS);
        const int i = 16 * (2 * half + ibase + ibl) + lr; const size_t row = (size_t)(row0 + i);
#pragma unroll
        for (int mb = 0; mb < 4; ++mb) { const int dv = 16 * mb + 4 * g; const f32x4 gv = *(const f32x4*)(gg + dv);
            const u32x2 gw = *(const u32x2*)(F.PB + row * NP + PG + h * 64 + dv);
            const float y0 = o[mb][ibl][0] * rstd * gv[0] * silu_f(bflo(gw.x)), y1 = o[mb][ibl][1] * rstd * gv[1] * silu_f(bfhi(gw.x));
            const float y2 = o[mb][ibl][2] * rstd * gv[2] * silu_f(bflo(gw.y)), y3 = o[mb][ibl][3] * rstd * gv[3] * silu_f(bfhi(gw.y));
            u32x2 w; w.x = pk2(y0, y1); w.y = pk2(y2, y3); *(u32x2*)(F.YMIX + row * D + h * 64 + dv) = w; }
    }
    __syncthreads();
}

template <int NKS, int GRP>
__device__ __forceinline__ void dft_mma_lds(f32x4 (&acc)[8], const LAS unsigned char* fl, int pitchB, const bf16* re, const bf16* im, size_t rstride, int khalf, int lane) {
    const int lr = lane & 15, g = lane >> 4;
#pragma unroll
    for (int k0 = 0; k0 < NKS; k0 += GRP) {
        bf16x8 bfrag[GRP];
#pragma unroll
        for (int kq = 0; kq < GRP; ++kq) { const int ks = k0 + kq; const int kk0 = 32 * ks + 8 * g; const bool part = kk0 >= khalf; const int idx = part ? kk0 - khalf : kk0;
            const bf16* src = (part ? im : re) + (size_t)idx * rstride + lr; unsigned short t[8];
#pragma unroll
            for (int e = 0; e < 8; ++e) t[e] = src[(size_t)e * rstride];
            u32x4 w; w.x = t[0] | ((unsigned)t[1] << 16); w.y = t[2] | ((unsigned)t[3] << 16); w.z = t[4] | ((unsigned)t[5] << 16); w.w = t[6] | ((unsigned)t[7] << 16);
            bfrag[kq] = __builtin_bit_cast(bf16x8, w); }
#pragma unroll
        for (int kq = 0; kq < GRP; ++kq) { const int ks = k0 + kq;
#pragma unroll
            for (int mb = 0; mb < 8; ++mb) { const bf16x8 a = *(const LAS bf16x8*)(fl + (16 * mb + lr) * pitchB + (32 * ks + 8 * g) * 2); acc[mb] = MFMA16(a, bfrag[kq], acc[mb]); }
        }
    }
}
__device__ __forceinline__ void f_to_lds(LAS unsigned char* fl, const bf16* Fm, int rows, int rowB, int tid) {
    const int cpr = rowB >> 4, n = rows * cpr;
    for (int i = tid; i < n; i += 512) { const int r = i / cpr, c = i - r * cpr; *(LAS u32x4*)(fl + r * (rowB + 16) + c * 16) = *(const u32x4*)((const unsigned char*)Fm + (size_t)r * rowB + c * 16); }
    __syncthreads();
}
template <int NKS, int GRP = 4, int NMB = 8>
__device__ __forceinline__ void dft_mma(f32x4 (&acc)[NMB], const bf16* Fm, int ldF, int mrow0, const bf16* re, const bf16* im, size_t rstride, int khalf, int lane) {
    const int lr = lane & 15, g = lane >> 4;
#pragma unroll
    for (int k0 = 0; k0 < NKS; k0 += GRP) {
        bf16x8 bfrag[GRP];
#pragma unroll
        for (int kq = 0; kq < GRP; ++kq) { const int ks = k0 + kq; const int kk0 = 32 * ks + 8 * g; const bool part = kk0 >= khalf; const int idx = part ? kk0 - khalf : kk0;
            const bf16* src = (part ? im : re) + (size_t)idx * rstride + lr; unsigned short t[8];
#pragma unroll
            for (int e = 0; e < 8; ++e) t[e] = src[(size_t)e * rstride];
            u32x4 w; w.x = t[0] | ((unsigned)t[1] << 16); w.y = t[2] | ((unsigned)t[3] << 16); w.z = t[4] | ((unsigned)t[5] << 16); w.w = t[6] | ((unsigned)t[7] << 16);
            bfrag[kq] = __builtin_bit_cast(bf16x8, w); }
#pragma unroll
        for (int kq = 0; kq < GRP; ++kq) { const int ks = k0 + kq;
            bf16x8 a[NMB];
#pragma unroll
            for (int mb = 0; mb < NMB; ++mb) a[mb] = *(const bf16x8*)(Fm + (size_t)(mrow0 + 16 * mb + lr) * ldF + 32 * ks + 8 * g);
#pragma unroll
            for (int mb = 0; mb < NMB; ++mb) acc[mb] = MFMA16(a[mb], bfrag[kq], acc[mb]);
            if (kq & 1) __builtin_amdgcn_sched_barrier(0);
        }
    }
}
__device__ __forceinline__ void dft_mma_loop(f32x4 (&acc)[8], const bf16* Fm, int ldF, int mrow0, int nks, const bf16* re, const bf16* im, size_t rstride, int khalf, int lane) {
    const int lr = lane & 15, g = lane >> 4;
#pragma unroll 1
    for (int ks = 0; ks < nks; ++ks) { const int kk0 = 32 * ks + 8 * g; const bool part = kk0 >= khalf; const int idx = part ? kk0 - khalf : kk0;
        const bf16* src = (part ? im : re) + (size_t)idx * rstride + lr; unsigned short t[8];
#pragma unroll
        for (int e = 0; e < 8; ++e) t[e] = src[(size_t)e * rstride];
        u32x4 w; w.x = t[0] | ((unsigned)t[1] << 16); w.y = t[2] | ((unsigned)t[3] << 16); w.z = t[4] | ((unsigned)t[5] << 16); w.w = t[6] | ((unsigned)t[7] << 16);
        const bf16x8 bfrag = __builtin_bit_cast(bf16x8, w);
#pragma unroll
        for (int mb = 0; mb < 8; ++mb) { const bf16x8 a = *(const bf16x8*)(Fm + (size_t)(mrow0 + 16 * mb + lr) * ldF + 32 * ks + 8 * g); acc[mb] = MFMA16(a, bfrag, acc[mb]); }
    }
}
__device__ __forceinline__ void fft_stage1(Ctx& F) {
    const int lr = F.lane & 15, g = F.lane >> 4;
    f_to_lds(F.lds, F.F1, 128, 256, F.tid);
    for (int it = F.gw; it < 4096; it += F.NGW) { const int cb = it & 15, n2 = (it >> 4) & 127, b = it >> 11;
        f32x4 acc[8];
#pragma unroll
        for (int mb = 0; mb < 8; ++mb) acc[mb] = (f32x4){0.f, 0.f, 0.f, 0.f};
        const bf16* re = F.PB + (size_t)(b * SEQ + n2) * NP + PFA + 16 * cb;
        dft_mma_lds<4, 4>(acc, F.lds, 272, re, re + 256, (size_t)128 * NP, 64, F.lane);
#pragma unroll
        for (int mb = 0; mb < 4; ++mb)
#pragma unroll
            for (int r = 0; r < 4; ++r) { const int k1 = 16 * mb + 4 * g + r; const float a = (float)(k1 * n2) * (1.f / 8192.f); const float c = cos_rev(a), s = sin_rev(a);
                const float tr = acc[mb][r], ti = acc[mb + 4][r]; const float xr = tr * c + ti * s, xi = ti * c - tr * s;
                bf16* dst = F.TB + ((size_t)((b * 64 + k1) * 2) * 128 + n2) * 256 + 16 * cb + lr;
                dst[0] = (bf16)f2bf(xr); dst[(size_t)128 * 256] = (bf16)f2bf(xi); }
    }
}
__device__ __forceinline__ void fft_stage2(Ctx& F, int l) {
    const int lr = F.lane & 15, g = F.lane >> 4;
    f_to_lds(F.lds, F.F2, 128, 512, F.tid);
    for (int it = F.gw; it < 2048; it += F.NGW) {
        f32x4 acc[8];
#pragma unroll
        for (int mb = 0; mb < 8; ++mb) acc[mb] = (f32x4){0.f, 0.f, 0.f, 0.f};
        const int cb = it & 15, k1 = (it >> 4) & 63, b = it >> 10;
        const bf16* re = F.TB + (size_t)((b * 64 + k1) * 2) * 128 * 256 + 16 * cb;
        dft_mma_lds<8, 4>(acc, F.lds, 528, re, re + (size_t)128 * 256, 256, 128, F.lane);
#pragma unroll
        for (int mb = 0; mb < 8; ++mb)
#pragma unroll
            for (int r = 0; r < 4; ++r) { const int k2 = 16 * mb + 4 * g + r; F.YMIX[(size_t)(b * SEQ + k1 + 64 * k2) * D + 256 + 16 * cb + lr] = (bf16)f2bf(acc[mb][r]); }
    }
    __syncthreads();
}
__device__ __forceinline__ void ctx_dft(Ctx& F, int w0, int nw) {
    const int lr = F.lane & 15, g = F.lane >> 4;
    for (int it = w0; it >= 0 && it < 256; it += nw) { const int mq = it & 7, cb = (it >> 3) & 15, b = it >> 7;
            f32x4 acc[2] = {(f32x4){0.f, 0.f, 0.f, 0.f}, (f32x4){0.f, 0.f, 0.f, 0.f}};
            const bf16* re = F.PB + (size_t)(ML + b * CTXL) * NP + PFA + 16 * cb;
            dft_mma<8, 4, 2>(acc, F.FC, 512, 32 * mq, re, re, (size_t)NP, 256, F.lane); __builtin_amdgcn_sched_barrier(0);
            dft_mma<8, 4, 2>(acc, F.FC + 256, 512, 32 * mq, re + 256, re + 256, (size_t)NP, 256, F.lane);
#pragma unroll
            for (int mb = 0; mb < 2; ++mb)
#pragma unroll
                for (int r = 0; r < 4; ++r) { const int k = 32 * mq + 16 * mb + 4 * g + r; F.YMIX[(size_t)(ML + b * CTXL + k) * D + 256 + 16 * cb + lr] = (bf16)f2bf(acc[mb][r]); }
        }
}
__device__ __forceinline__ void load8(const bf16* q, float (&v)[8]) { const u32x4 w = *(const u32x4*)q; v[0] = bflo(w.x); v[1] = bfhi(w.x); v[2] = bflo(w.y); v[3] = bfhi(w.y); v[4] = bflo(w.z); v[5] = bfhi(w.z); v[6] = bflo(w.w); v[7] = bfhi(w.w); }
__device__ __forceinline__ void store8(bf16* q, const float (&v)[8]) { u32x4 w; w.x = pk2(v[0], v[1]); w.y = pk2(v[2], v[3]); w.z = pk2(v[4], v[5]); w.w = pk2(v[6], v[7]); *(u32x4*)q = w; }
__device__ __forceinline__ u32x4 ldrow(const bf16* base, int rbase, int t, int n, int col) { const int tc = t < 0 ? 0 : (t > n - 1 ? n - 1 : t); return *(const u32x4*)(base + (size_t)(rbase + tc) * NP + col); }
__device__ __forceinline__ void unpack8(const u32x4 w, float (&v)[8]) { v[0] = bflo(w.x); v[1] = bfhi(w.x); v[2] = bflo(w.y); v[3] = bfhi(w.y); v[4] = bflo(w.z); v[5] = bfhi(w.z); v[6] = bflo(w.w); v[7] = bfhi(w.w); }
__device__ __forceinline__ void convpool_item(PP p, Ctx& F, int l, int it) {
    int rbase, n, t0;
    if (it < 256) { rbase = it * 64; n = 64; t0 = 0; } else { const int sg = it - 256; rbase = ML + (sg >> 2) * CTXL; n = CTXL; t0 = (sg & 3) * 64; }
    const int oct = F.tid & 31, tl = F.tid >> 5, c0 = 8 * oct, tb = t0 + tl * 4;
    {
        u32x4 hw_[6], cw_[6], bw_[4];
#pragma unroll
        for (int i = 0; i < 6; ++i) { hw_[i] = ldrow(F.PB, rbase, tb - 1 + i, n, PH + c0); cw_[i] = ldrow(F.PB, rbase, tb - 1 + i, n, PCG + c0); }
#pragma unroll
        for (int q = 0; q < 4; ++q) bw_[q] = ldrow(F.PB, rbase, tb + q, n, PBG + c0);
        const f32x4 w0a = *(const f32x4*)(p->conv_w + (l * 3 + 0) * 256 + c0), w0b = *(const f32x4*)(p->conv_w + (l * 3 + 0) * 256 + c0 + 4);
        const f32x4 w1a = *(const f32x4*)(p->conv_w + (l * 3 + 1) * 256 + c0), w1b = *(const f32x4*)(p->conv_w + (l * 3 + 1) * 256 + c0 + 4);
        const f32x4 w2a = *(const f32x4*)(p->conv_w + (l * 3 + 2) * 256 + c0), w2b = *(const f32x4*)(p->conv_w + (l * 3 + 2) * 256 + c0 + 4);
        const f32x4 cba = *(const f32x4*)(p->conv_b + l * 256 + c0), cbb = *(const f32x4*)(p->conv_b + l * 256 + c0 + 4);
        float hc[6][8];
#pragma unroll
        for (int i = 0; i < 6; ++i) { float a[8], b[8]; unpack8(hw_[i], a); unpack8(cw_[i], b); const int t = tb - 1 + i; const float msk = (t >= 0 && t < n) ? 1.f : 0.f;
#pragma unroll
            for (int e = 0; e < 8; ++e) hc[i][e] = a[e] * b[e] * msk; }
#pragma unroll
        for (int q = 0; q < 4; ++q) { float bg[8], y[8]; unpack8(bw_[q], bg);
#pragma unroll
            for (int e = 0; e < 8; ++e) { const float w0 = e < 4 ? w0a[e & 3] : w0b[e & 3], w1 = e < 4 ? w1a[e & 3] : w1b[e & 3], w2 = e < 4 ? w2a[e & 3] : w2b[e & 3], cb = e < 4 ? cba[e & 3] : cbb[e & 3];
                y[e] = bg[e] * (w0 * hc[q][e] + w1 * hc[q + 1][e] + w2 * hc[q + 2][e] + cb); }
            store8(F.YMIX + (size_t)(rbase + tb + q) * D + 512 + c0, y); }
    }
    __builtin_amdgcn_sched_barrier(0);
    {
        const int wnd = 2 << (oct >> 3), hw = wnd >> 1;
        float s[4][8], self[4][8];
#pragma unroll
        for (int q = 0; q < 4; ++q) { unpack8(ldrow(F.PB, rbase, tb + q, n, PPOOL + c0), self[q]);
#pragma unroll
            for (int e = 0; e < 8; ++e) s[q][e] = 0.f; }
        __builtin_amdgcn_sched_barrier(0);
#pragma unroll
        for (int bt = 0; bt < 19; bt += 7) {
            u32x4 pw[7];
#pragma unroll
            for (int ii = 0; ii < 7; ++ii) if (bt + ii < 19) pw[ii] = ldrow(F.PB, rbase, tb - hw + bt + ii, n, PPOOL + c0);
#pragma unroll
            for (int ii = 0; ii < 7; ++ii) if (bt + ii < 19) { const int i = bt + ii; float v[8]; unpack8(pw[ii], v); const int t = tb - hw + i; const bool inr = (t >= 0 && t < n);
#pragma unroll
                for (int q = 0; q < 4; ++q) { const float mk = (inr && i >= q && i < q + wnd) ? 1.f : 0.f;
#pragma unroll
                    for (int e = 0; e < 8; ++e) s[q][e] += mk * v[e]; } }
            __builtin_amdgcn_sched_barrier(0);
        }
#pragma unroll
        for (int q = 0; q < 4; ++q) { const int t = tb + q; const int lo = (t - hw > 0) ? t - hw : 0, hi = (t + hw - 1 < n - 1) ? t + hw - 1 : n - 1; const float inv = 1.f / (float)(hi - lo + 1);
            float y[8];
#pragma unroll
            for (int e = 0; e < 8; ++e) y[e] = s[q][e] * inv - self[q][e];
            store8(F.YMIX + (size_t)(rbase + t) * D + 768 + c0, y); }
    }
}
__device__ __forceinline__ void ctx_act(PP p, Ctx& F, int l) {
    const int gt = blockIdx.x * 512 + F.tid, NT = F.G * 512;
    for (int i = gt; i < MC * 352; i += NT) { const int oc = i % 352, rc = i / 352, t = rc & 255, c0 = 8 * oc;
        const bf16* base = F.CAU + (size_t)rc * NUP + c0; float a[8], y[8], u[8];
        const float* cw = p->ffn_cw + (size_t)l * 3 * DFF + c0; const float* cb = p->ffn_cb + (size_t)l * DFF + c0;
#pragma unroll
        for (int e = 0; e < 8; ++e) y[e] = cb[e];
        if (t > 0) { load8(base - NUP, a);
#pragma unroll
            for (int e = 0; e < 8; ++e) y[e] += cw[e] * a[e]; }
        load8(base, a);
#pragma unroll
        for (int e = 0; e < 8; ++e) y[e] += cw[DFF + e] * a[e];
        if (t < 255) { load8(base + NUP, a);
#pragma unroll
            for (int e = 0; e < 8; ++e) y[e] += cw[2 * DFF + e] * a[e]; }
        load8(base + DFF, u);
#pragma unroll
        for (int e = 0; e < 8; ++e) y[e] = silu_f(y[e]) * u[e];
        store8(F.ACT + (size_t)(ML + rc) * DFF + c0, y);
    }
}
__global__ void __launch_bounds__(512, 2) fwd_megakernel(Params p_) {
    PP p = (PP)__builtin_amdgcn_kernarg_segment_ptr();
    extern __shared__ __attribute__((aligned(16))) unsigned char lds_raw[];
    cg::grid_group grid = cg::this_grid();
    Ctx F;
    F.lds = (LAS unsigned char*)lds_raw; F.tid = threadIdx.x; F.lane = F.tid & 63; F.wave = __builtin_amdgcn_readfirstlane(F.tid >> 6);
    const int wave_s = F.wave;
    F.G = gridDim.x; F.gw = blockIdx.x * 8 + F.wave; F.NGW = F.G * 8;
    unsigned char* ws = p->ws;
#define SETPTRS() do { { PP q_ = (PP)__builtin_amdgcn_kernarg_segment_ptr(); asm volatile("" : "+s"(q_)); p = q_; } unsigned char* w_ = p->ws; asm volatile("" : "+s"(w_)); \
    F.MOD = (float*)(w_ + WS_MOD); F.MCS = (float*)(w_ + WS_MCS); F.F1 = (bf16*)(w_ + WS_F1); F.F2 = (bf16*)(w_ + WS_F2); F.FC = (bf16*)(w_ + WS_FC); \
    F.HX = (bf16*)(w_ + WS_HX); F.TB = (bf16*)(w_ + WS_HX); F.YMIX = (bf16*)(w_ + WS_YMIX); F.PB = (bf16*)(w_ + WS_P); F.ACT = (bf16*)(w_ + WS_P); \
    F.XC = (float*)(w_ + WS_XC); F.ST = (float*)(w_ + WS_ST); F.DEC = (float*)(w_ + WS_DEC); F.CAU = (bf16*)(w_ + WS_CAU); } while (0)
    SETPTRS();

#ifndef NO_P0
#define REFRESH() do { int t_; asm volatile("v_mbcnt_lo_u32_b32 %0, -1, 0\n\tv_mbcnt_hi_u32_b32 %0, -1, %0" : "=v"(t_)); t_ |= (wave_s << 6); F.tid = t_; F.lane = t_ & 63; F.wave = __builtin_amdgcn_readfirstlane(t_ >> 6); F.gw = blockIdx.x * 8 + F.wave; SETPTRS(); } while (0)
    { volatile LAS unsigned* misc = (volatile LAS unsigned*)(F.lds + RING_BYTES); if (F.tid < 64) misc[F.tid] = 0u; }
    __syncthreads();
    XcdBarrier bar = xcd_barrier_post((unsigned*)(ws + WS_CTL), (volatile LAS unsigned*)(F.lds + RING_BYTES) + 8, F.tid);
#define GSYNC() do { REFRESH(); xcd_barrier(bar, F.tid); } while (0)
    REFRESH();
    phase0(p, F);
#endif
    if (p->ws == nullptr) grid.sync();
    GSYNC();
#define L0() ({ int lq_ = l; asm volatile("" : "+s"(lq_)); lq_ == 0; })
    for (int l = 0; l < 2; ++l) {
        const int M6 = L0() ? MT : ML;
#ifndef NO_P1
        REFRESH();
        norm_phase(p, F, l, 0, MT);
        REFRESH();
        if (L0()) fold_items(p, F);
#ifdef PROBE_B
        REFRESH(); norm_phase(p, F, l, 0, MT); if (L0()) fold_items(p, F);
#endif
#endif
        GSYNC();
#ifndef NO_P2
        REFRESH();
        { pg8::Gemm g{F.HX, win_t(p, l), MT, NP, D, D}; pg8::StaticOrder S; S.init(MT, NP, F.G, (int)blockIdx.x);
          EpiP E{F.PB, p->b_a2 + l * 256};
          pg8::gemm_phase<EpiP, pg8::StaticOrder, true, true>(F.lds, g, S, E, F.tid);
#ifdef PROBE_C
          __syncthreads(); pg8::gemm_phase<EpiP, pg8::StaticOrder, true, true>(F.lds, g, S, E, F.tid);
#endif
        }
#endif
        GSYNC();
#ifdef PROBE_A
        for (int rep_ = 0; rep_ < 2; ++rep_) {
#else
        {
#endif
#ifndef NO_GA
        REFRESH();
        for (int it = blockIdx.x; it < 2 * NCH; it += F.G) gla_a_item(F, it / NCH, it % NCH);
#ifdef PR_GA
        __syncthreads(); REFRESH();
        for (int it = blockIdx.x; it < 2 * NCH; it += F.G) gla_a_item(F, it / NCH, it % NCH);
#endif
#endif
#ifndef NO_F1
        REFRESH();
        fft_stage1(F);
#ifdef PR_F1
        __syncthreads(); REFRESH();
        fft_stage1(F);
#endif
#endif
#ifndef NO_CP
        REFRESH();
        for (int v = blockIdx.x; v < 512; v += F.G) { const int it = (v < 256) ? v : 256 + ((v + 248) & 255);
            if (it >= (L0() ? 264 : 256)) continue; convpool_item(p, F, l, it); }
#ifdef PR_CP
        __syncthreads(); REFRESH();
        for (int v = blockIdx.x; v < 512; v += F.G) { const int it = (v < 256) ? v : 256 + ((v + 248) & 255);
            if (it >= (L0() ? 264 : 256)) continue; convpool_item(p, F, l, it); }
#endif
#endif
        }
        GSYNC();
#ifdef PROBE_A
        REFRESH(); fft_stage2(F, l);
#endif
#ifndef NO_F2
        REFRESH();
        fft_stage2(F, l);
#ifdef PR_F2
        __syncthreads(); REFRESH();
        fft_stage2(F, l);
#endif
#endif
#ifndef NO_SC
        REFRESH();
        gla_scan(F);
#endif
        GSYNC();
#ifdef PROBE_A
        for (int rep_ = 0; rep_ < 2; ++rep_) {
#else
        {
#endif
#ifndef NO_GC
        REFRESH();
        for (int it = blockIdx.x; it < 256; it += F.G) gla_c_item<2>(p, F, l, it >> 7, 4 + (it & 127), 0);
        if (L0()) for (int j = blockIdx.x; j < 16; j += F.G) gla_c_item<1>(p, F, l, j >> 3, (j >> 1) & 3, j & 1);
        if (L0()) { if (F.G == 256) ctx_dft(F, F.gw - 256, 1 << 30); else ctx_dft(F, F.gw, F.NGW); }
#ifdef PR_GC
        __syncthreads(); REFRESH();
        for (int it = blockIdx.x; it < 256; it += F.G) gla_c_item<2>(p, F, l, it >> 7, 4 + (it & 127), 0);
#endif
#endif
        }
        GSYNC();
#ifndef NO_P6
        REFRESH();
        if (L0()) { pg8::Gemm g{F.YMIX, wout_t(p, l), MT, D, 256, D}; SplitOrder S; S.init(4, F.G, (int)blockIdx.x);
          EpiPartial E{(float*)(p->ws + WS_PART)};
          pg8::gemm_phase<EpiPartial, SplitOrder, false, false>(F.lds, g, S, E, F.tid); __syncthreads(); }
        REFRESH();
        { pg8::Gemm g{F.YMIX, wout_t(p, l), ML, D, D, D}; pg8::StaticOrder S; S.init(ML, D, F.G, (int)blockIdx.x);
          if (L0()) { EpiRes<false, true> E{p->x, p->out, F.MOD + l * 3 * 6144 + 2048}; pg8::gemm_phase<EpiRes<false, true>, pg8::StaticOrder, true, true>(F.lds, g, S, E, F.tid); }
          else if (F.G == 256) { EpiResNorm E{(const bf16*)p->out, (bf16*)(p->ws + WS_XB2), F.HX, F.MOD + l * 3 * 6144 + 2048, p->norm2_g + l * D, F.MOD + l * 3 * 6144, (float*)(p->ws + WS_SLOT) + 65536 * 2, (unsigned*)(p->ws + WS_CTL) + CW_FIN + 4096};
            pg8::gemm_phase<EpiResNorm, pg8::StaticOrder, false, true>(F.lds, g, S, E, F.tid); }
          else { EpiRes<true, true> E{p->out, p->out, F.MOD + l * 3 * 6144 + 2048}; pg8::gemm_phase<EpiRes<true, true>, pg8::StaticOrder, true, true>(F.lds, g, S, E, F.tid); } }
#endif
        GSYNC();
        if (L0() || F.G != 256) { REFRESH(); norm_phase(p, F, l, 1, M6); GSYNC(); }
#ifndef NO_P8
        REFRESH();
        { pg8::Gemm g{F.HX, wup_t(p, l), ML, NUP, D, D}; pg8::StaticOrder S; S.init(ML, NUP, F.G, (int)blockIdx.x);
          EpiUp E{F.ACT, p->ffn_cw + (size_t)l * 3 * DFF, p->ffn_cb + (size_t)l * DFF};
          pg8::gemm_phase<EpiUp, pg8::StaticOrder, true, true>(F.lds, g, S, E, F.tid);
        }
        if (L0()) { REFRESH(); __syncthreads();
          pg8::Gemm g{F.HX, wup_t(p, l), MT, NUP, D, D}; CtxOrder S; S.init(NUP, (int)blockIdx.x, 128);
          EpiUpCtx E{F.ACT, p->ffn_cw + (size_t)l * 3 * DFF, p->ffn_cb + (size_t)l * DFF, (LAS float*)(F.lds + RING_BYTES + 1024)};
          pg8::gemm_phase<EpiUpCtx, CtxOrder, true, false>(F.lds, g, S, E, F.tid); }
#endif
        GSYNC();
#ifndef NO_P9
        REFRESH();
        if (L0()) { pg8::Gemm g{F.ACT, wdn_t(p, l), MT, D, 256, DFF}; SplitOrder S; S.init(11, F.G, (int)blockIdx.x);
          EpiPartial E{(float*)(p->ws + WS_PART)};
          pg8::gemm_phase<EpiPartial, SplitOrder, false, false>(F.lds, g, S, E, F.tid); __syncthreads(); }
        REFRESH();
        { pg8::Gemm g{F.ACT, wdn_t(p, l), ML, D, DFF, DFF}; pg8::StaticOrder S; S.init(ML, D, F.G, (int)blockIdx.x);
          if (L0()) { EpiRes<true, true> E{p->out, p->out, F.MOD + l * 3 * 6144 + 5120}; pg8::gemm_phase<EpiRes<true, true>, pg8::StaticOrder, true, true>(F.lds, g, S, E, F.tid); }
          else if (F.G == 256) { EpiFinal E{(const bf16*)(p->ws + WS_XB2), p->out, F.MOD + l * 3 * 6144 + 5120, p->final_g, (float*)(p->ws + WS_SLOT), (unsigned*)(p->ws + WS_CTL) + CW_FIN};
            pg8::gemm_phase<EpiFinal, pg8::StaticOrder, false, true>(F.lds, g, S, E, F.tid); }
          else { EpiRes<true, false> E{p->out, p->ws + WS_HX, F.MOD + l * 3 * 6144 + 5120}; pg8::gemm_phase<EpiRes<true, false>, pg8::StaticOrder, true, true>(F.lds, g, S, E, F.tid); } }
#endif
        if (L0() || F.G != 256) GSYNC();
    }
        REFRESH();
    if (F.G != 256) final_norm(p, F);
}

extern "C" void kernel_launch(void* const* d_in, const int* in_sizes, int n_in, void* d_out, int out_size, void* d_ws, size_t ws_size, hipStream_t stream) {
    static int grid = 0;
    if (grid == 0) {
        if (n_in != 23 || in_sizes[0] != ML * D || out_size != ML * D || ws_size < WS_END) { fprintf(stderr, "kernel_launch: unexpected shapes / workspace (%d inputs, ws %zu)\n", n_in, ws_size); grid = -1; return; }
        int dev = 0, cus = 0, per_cu = 0;
        hipGetDevice(&dev); hipDeviceGetAttribute(&cus, hipDeviceAttributeMultiprocessorCount, dev);
        if (hipFuncSetAttribute((const void*)fwd_megakernel, hipFuncAttributeMaxDynamicSharedMemorySize, LDS_BYTES) != hipSuccess) { fprintf(stderr, "hipFuncSetAttribute failed\n"); grid = -1; return; }
        if (hipOccupancyMaxActiveBlocksPerMultiprocessor(&per_cu, (const void*)fwd_megakernel, 512, LDS_BYTES) != hipSuccess || per_cu < 1) per_cu = 1;
        (void)hipGetLastError();
        grid = cus * 1;
    }
    if (grid < 0) return;
    if (hipMemsetAsync((char*)d_ws + WS_CTL, 0, 65536, stream) != hipSuccess) { fprintf(stderr, "memset failed\n"); return; }
    Params p{};
    const float** pp = (const float**)&p;
    for (int i = 0; i < 23; ++i) pp[i] = (const float*)d_in[i];
    p.out = (float*)d_out; p.ws = (unsigned char*)d_ws;
    void* args[] = {&p};
    hipError_t e = hipLaunchCooperativeKernel((const void*)fwd_megakernel, dim3(grid), dim3(512), args, LDS_BYTES, stream);
    if (e != hipSuccess) fprintf(stderr, "cooperative launch failed: %s (grid %d)\n", hipGetErrorString(e), grid);
}
```

```cpp
#include <hip/hip_runtime.h>
#include <hip/hip_cooperative_groups.h>
#include <cstdio>
#include <cstdint>
namespace cg = cooperative_groups;
namespace pg8 {
#define PG8_LAS __attribute__((address_space(3)))
typedef unsigned short bf16_t;
typedef short bf16x8 __attribute__((ext_vector_type(8)));
typedef float f32x4 __attribute__((ext_vector_type(4)));
typedef unsigned u32x4 __attribute__((ext_vector_type(4)));
constexpr int BM = 256, BK = 64, HALF = 128, HTB = HALF * BK * 2  , STAGE_BYTES = 8 * HTB, NXCD = 8, WGM = 8;

__host__ __device__ __forceinline__ int lds_byte(int r, int c) { const int st = (r >> 4) * 2 + (c >> 5), rr = r & 15, cc = c & 31, ob = rr * 64 + cc * 2; return st * 1024 + (ob ^ (((ob >> 9) & 1) << 5)); }
__host__ __device__ __forceinline__ void stage_rc(int b, int& R, int& C) { const int st = b / 1024, sb = b % 1024, swz = sb ^ (((sb >> 9) & 1) << 5); R = (st >> 1) * 16 + swz / 64; C = (st & 1) * 32 + (swz % 64) / 2; }
__host__ __device__ __forceinline__ int perm32(int rho) { const int n = rho >> 4, i = rho & 15; return 8 * (i >> 2) + 4 * n + (i & 3); }

struct Unit { int pm, pn, ks; };
struct Gemm { const bf16_t* A; const bf16_t* Bt; int M, N, K, ld; };

struct StaticOrder {
    int nM, nN, nwg, G, c;
    __host__ __device__ void init(int M, int N, int G_, int c_) { nM = M / BM; nN = N / BM; nwg = nM * nN; G = G_; c = c_; }
    __host__ __device__ bool next(int i, Unit& u) const {
        const long L = (long)i * G + c; if (L >= nwg) return false;
        int wgid = (int)L; { const int q = nwg / NXCD, r = nwg % NXCD, xcd = wgid % NXCD, off = wgid / NXCD; wgid = (xcd < r ? xcd * (q + 1) : r * (q + 1) + (xcd - r) * q) + off; }
        const int nig = WGM * nN, gid = wgid / nig, fm = gid * WGM, gsz = (nM - fm) < WGM ? (nM - fm) : WGM;
        u.pm = fm + ((wgid % nig) % gsz); u.pn = (wgid % nig) / gsz; u.ks = 0; return true;
    }
    __device__ __forceinline__ void a_ready(const Unit&) const {}
    __device__ __forceinline__ void done(const Unit&) const {}
};

__device__ __forceinline__ unsigned cvt_pk_bf16(float lo, float hi) { unsigned r; asm volatile("v_cvt_pk_bf16_f32 %0, %1, %2" : "=v"(r) : "v"(lo), "v"(hi)); return r; }
template <class Epi, class Sched, bool ALIGN_EPI = false, bool SP2 = false>
__device__ __forceinline__ void gemm_phase(PG8_LAS unsigned char* lds, const Gemm g, const Sched& S, const Epi& E, int tid_in) {
    int tid_ = tid_in; asm volatile("" : "+v"(tid_)); const int tid = tid_, wid = __builtin_amdgcn_readfirstlane(tid >> 6), lane = tid & 63, wr = wid >> 2, wc = wid & 3, fr = lane & 15, fq = lane >> 4;
    const int K = g.ld, nt = g.K / BK; const size_t sstep = (size_t)g.K * 2;
    unsigned voffA[2], voffB[2];
#pragma unroll
    for (int i = 0; i < 2; ++i) { int R, C; stage_rc(tid * 16 + i * 8192, R, C); const int Rb = Epi::PERM ? ((R & ~31) + perm32(R & 31)) : R;
        voffA[i] = (unsigned)(R * K + C) * 2u; voffB[i] = (unsigned)(Rb * K + C) * 2u; }
    const size_t kstep = (size_t)(BK * 2);
    const size_t hstep = (size_t)HALF * K * 2;
    const size_t tstep = 2 * hstep;
    const unsigned ldsw = (unsigned)wid * 1024u;
    const int aoff = lds_byte(wr * 64 + fr, fq * 8), boff = lds_byte(wc * 32 + fr, fq * 8);
#define PG8_SA(b, h) (((b) * 2 + (h)) * HTB)
#define PG8_SB(b, h) ((4 + (b) * 2 + (h)) * HTB)
#define PG8_STAGE(bufoff, gbase, voff) do { _Pragma("unroll") for (int _i = 0; _i < 2; ++_i) \
        __builtin_amdgcn_global_load_lds((const unsigned*)((const char*)(gbase) + (voff)[_i]), (PG8_LAS unsigned*)(lds + (bufoff) + ldsw + _i * 8192), 16, 0, 0); } while (0)
#define PG8_LDA(dst, b, h) do { _Pragma("unroll") for (int m = 0; m < 4; ++m) _Pragma("unroll") for (int k = 0; k < 2; ++k) dst[m][k] = *(const PG8_LAS bf16x8*)(lds + PG8_SA(b, h) + aoff + m * 2048 + k * 1024); } while (0)
#define PG8_LDB(dst, b, h) do { _Pragma("unroll") for (int n = 0; n < 2; ++n) _Pragma("unroll") for (int k = 0; k < 2; ++k) dst[n][k] = *(const PG8_LAS bf16x8*)(lds + PG8_SB(b, h) + boff + n * 2048 + k * 1024); } while (0)
#define PG8_MMA(ai, bj, At, Bt) do { __builtin_amdgcn_s_setprio(1); _Pragma("unroll") for (int m = 0; m < 4; ++m) _Pragma("unroll") for (int n = 0; n < 2; ++n) _Pragma("unroll") for (int k = 0; k < 2; ++k) \
        acc[ai][bj][m][n] = __builtin_amdgcn_mfma_f32_16x16x32_bf16(Bt[n][k], At[m][k], acc[ai][bj][m][n], 0, 0, 0); __builtin_amdgcn_s_setprio(0); } while (0)
#define PG8_WAIT_V(n) asm volatile("s_waitcnt vmcnt(" #n ")" ::: "memory")
#define PG8_WAIT_L(n) asm volatile("s_waitcnt lgkmcnt(" #n ")" ::: "memory")
#define PG8_BAR __builtin_amdgcn_s_barrier()
#define PG8_SCHED __builtin_amdgcn_sched_barrier(0)
    Unit cur, nxt; int ui = 0;
    if (!S.next(0, cur)) return;
    f32x4 acc[2][2][4][2];
#pragma unroll
    for (int a = 0; a < 2; ++a)
#pragma unroll
        for (int b = 0; b < 2; ++b)
#pragma unroll
            for (int m = 0; m < 4; ++m)
#pragma unroll
                for (int n = 0; n < 2; ++n) acc[a][b][m][n] = (f32x4){0.f, 0.f, 0.f, 0.f};
    bf16x8 At[4][2], B0[2][2], B1[2][2];
    const char* cA = (const char*)g.A + (size_t)cur.pm * tstep + (size_t)cur.ks * sstep; const char* cB = (const char*)g.Bt + (size_t)cur.pn * tstep + (size_t)cur.ks * sstep;
    S.a_ready(cur);
    if constexpr (SP2) {
        PG8_STAGE(PG8_SB(0, 0), cB, voffB); PG8_STAGE(PG8_SB(0, 1), cB + hstep, voffB); PG8_STAGE(PG8_SA(0, 0), cA, voffA); PG8_STAGE(PG8_SA(0, 1), cA + hstep, voffA);
        if (wr == 1) PG8_BAR;
        PG8_WAIT_V(2); PG8_BAR;
        PG8_STAGE(PG8_SB(1, 0), cB + kstep, voffB); PG8_STAGE(PG8_SA(1, 0), cA + kstep, voffA); PG8_STAGE(PG8_SB(1, 1), cB + hstep + kstep, voffB);
        PG8_WAIT_V(6); PG8_BAR;
    } else {
        PG8_STAGE(PG8_SB(0, 0), cB, voffB); PG8_STAGE(PG8_SA(0, 0), cA, voffA); PG8_STAGE(PG8_SB(0, 1), cB + hstep, voffB); PG8_STAGE(PG8_SA(0, 1), cA + hstep, voffA);
        if (wr == 1) PG8_BAR;
        PG8_WAIT_V(4); PG8_BAR;
        PG8_STAGE(PG8_SB(1, 0), cB + kstep, voffB); PG8_STAGE(PG8_SA(1, 0), cA + kstep, voffA); PG8_STAGE(PG8_SB(1, 1), cB + hstep + kstep, voffB);
        PG8_WAIT_V(6); PG8_BAR;
    }
    for (;;) {
        const bool has_next = S.next(ui + 1, nxt);
        const char* nA = has_next ? (const char*)g.A + (size_t)nxt.pm * tstep + (size_t)nxt.ks * sstep : cA; const char* nB = has_next ? (const char*)g.Bt + (size_t)nxt.pn * tstep + (size_t)nxt.ks * sstep : cB;
        for (int t = 0; t < nt; t += 2) {
            const bool last = (t == nt - 2);
            const char* a1 = cA + (size_t)(t + 1) * kstep;
            const char* a2 = last ? nA : cA + (size_t)(t + 2) * kstep; const char* b2 = last ? nB : cB + (size_t)(t + 2) * kstep;
            const char* a3 = a2 + kstep; const char* b3 = b2 + kstep;
            if (last && has_next) S.a_ready(nxt);
            if constexpr (SP2) {
            PG8_LDB(B0, 0, 0); PG8_LDB(B1, 0, 1); PG8_SCHED; PG8_LDA(At, 0, 0); PG8_STAGE(PG8_SA(1, 1), a1 + hstep, voffA);
            PG8_WAIT_V(8); PG8_WAIT_L(0); PG8_BAR; PG8_MMA(0, 0, At, B0); PG8_MMA(0, 1, At, B1); PG8_BAR; PG8_SCHED;
            PG8_LDA(At, 0, 1); PG8_STAGE(PG8_SB(0, 0), b2, voffB); PG8_STAGE(PG8_SB(0, 1), b2 + hstep, voffB); PG8_STAGE(PG8_SA(0, 0), a2, voffA);
            PG8_WAIT_V(8); PG8_WAIT_L(0); PG8_BAR; PG8_MMA(1, 0, At, B0); PG8_MMA(1, 1, At, B1); PG8_BAR; PG8_SCHED;
            PG8_LDB(B0, 1, 0); PG8_LDB(B1, 1, 1); PG8_SCHED; PG8_LDA(At, 1, 0); PG8_STAGE(PG8_SA(0, 1), a2 + hstep, voffA);
            PG8_WAIT_V(8); PG8_WAIT_L(0); PG8_BAR; PG8_MMA(0, 0, At, B0); PG8_MMA(0, 1, At, B1); PG8_BAR; PG8_SCHED;
            PG8_LDA(At, 1, 1); PG8_STAGE(PG8_SB(1, 0), b3, voffB); PG8_STAGE(PG8_SB(1, 1), b3 + hstep, voffB); PG8_STAGE(PG8_SA(1, 0), a3, voffA);
            PG8_WAIT_V(8); PG8_WAIT_L(0); PG8_BAR; PG8_MMA(1, 0, At, B0); PG8_MMA(1, 1, At, B1); PG8_BAR; PG8_SCHED;
            } else {
            PG8_LDB(B0, 0, 0); PG8_SCHED; PG8_LDA(At, 0, 0); PG8_STAGE(PG8_SA(1, 1), a1 + hstep, voffA);
            PG8_WAIT_L(8); PG8_BAR; PG8_WAIT_L(0); PG8_MMA(0, 0, At, B0); PG8_BAR; PG8_SCHED;
            PG8_LDB(B1, 0, 1); PG8_STAGE(PG8_SB(0, 0), b2, voffB);
            PG8_BAR; PG8_WAIT_L(0); PG8_MMA(0, 1, At, B1); PG8_BAR;
            PG8_LDA(At, 0, 1); PG8_STAGE(PG8_SA(0, 0), a2, voffA);
            PG8_BAR; PG8_WAIT_L(0); PG8_MMA(1, 0, At, B0); PG8_BAR; PG8_SCHED;
            PG8_STAGE(PG8_SB(0, 1), b2 + hstep, voffB);
            PG8_WAIT_V(6); PG8_BAR; PG8_MMA(1, 1, At, B1); PG8_BAR;
            PG8_LDB(B0, 1, 0); PG8_SCHED; PG8_LDA(At, 1, 0); PG8_STAGE(PG8_SA(0, 1), a2 + hstep, voffA);
            PG8_WAIT_L(8); PG8_BAR; PG8_WAIT_L(0); PG8_MMA(0, 0, At, B0); PG8_BAR; PG8_SCHED;
            PG8_LDB(B1, 1, 1); PG8_STAGE(PG8_SB(1, 0), b3, voffB);
            PG8_BAR; PG8_WAIT_L(0); PG8_MMA(0, 1, At, B1); PG8_BAR;
            PG8_LDA(At, 1, 1); PG8_STAGE(PG8_SA(1, 0), a3, voffA);
            PG8_BAR; PG8_WAIT_L(0); PG8_MMA(1, 0, At, B0); PG8_BAR; PG8_SCHED;
            PG8_STAGE(PG8_SB(1, 1), b3 + hstep, voffB);
            PG8_WAIT_V(6); PG8_BAR; PG8_MMA(1, 1, At, B1); PG8_BAR;
            }
        }
        if constexpr (ALIGN_EPI) { if (wr == 0) PG8_BAR; }
        if constexpr (!Epi::AFTER_DRAIN) { E(acc, cur, wr, wc, fr, fq); S.done(cur); }
        if (!has_next) break;
#pragma unroll
        for (int a = 0; a < 2; ++a)
#pragma unroll
            for (int b = 0; b < 2; ++b)
#pragma unroll
                for (int m = 0; m < 4; ++m)
#pragma unroll
                    for (int n = 0; n < 2; ++n) acc[a][b][m][n] = (f32x4){0.f, 0.f, 0.f, 0.f};
        cur = nxt; cA = nA; cB = nB; ++ui;
        if constexpr (ALIGN_EPI) { if (wr == 1) PG8_BAR; }
    }
    PG8_WAIT_V(0);
    if constexpr (!ALIGN_EPI) { if (wr == 0) PG8_BAR; }
    PG8_BAR;
    if constexpr (Epi::AFTER_DRAIN) { E.fused(acc, cur, wr, wc, fr, fq, lds, wid, lane); S.done(cur); }
#undef PG8_SA
#undef PG8_SB
#undef PG8_STAGE
#undef PG8_LDA
#undef PG8_LDB
#undef PG8_MMA
#undef PG8_WAIT_V
#undef PG8_WAIT_L
#undef PG8_BAR
#undef PG8_SCHED
}
}
#define LAS __attribute__((address_space(3)))
typedef unsigned short bf16;
typedef float f32x4 __attribute__((ext_vector_type(4)));
typedef short bf16x8 __attribute__((ext_vector_type(8)));
typedef unsigned u32x4 __attribute__((ext_vector_type(4)));
typedef unsigned u32x2 __attribute__((ext_vector_type(2)));
#define LDS_WAIT() asm volatile("s_waitcnt lgkmcnt(0)" ::: "memory")

constexpr int D = 1024, SEQ = 8192, ML = 16384, MC = 512, MT = ML + MC, CTXL = 256;
constexpr int DIN = 2080, NP = 2560, DFF = 2816, NUP = 5632;
constexpr int PK = 0, PQ = 128, PV = 256, PLA = 512, PG = 768, PFA = 1024, PFB = 1280, PH = 1536, PBG = 1792, PCG = 2048, PPOOL = 2304;
constexpr int NCH = 132;
constexpr float EPS = 1e-6f;
constexpr size_t MiB = 1u << 20;
constexpr size_t WS_CTL = 0;
constexpr size_t WS_MOD = 1 * MiB;
constexpr size_t WS_MCS = 1 * MiB + 256 * 1024;
constexpr size_t WS_F1 = 1 * MiB + 512 * 1024;
constexpr size_t WS_F2 = WS_F1 + 32 * 1024;
constexpr size_t WS_FC = WS_F2 + 64 * 1024;
constexpr size_t WS_SLOT = 49 * MiB;
constexpr size_t WS_XB2 = 208 * MiB;
constexpr int CW_FIN = 3584;
constexpr size_t WS_W = 2 * MiB;
constexpr size_t W_IN_B = (size_t)NP * D * 2, W_OUT_B = (size_t)D * D * 2, W_UP_B = (size_t)NUP * D * 2, W_DN_B = (size_t)D * DFF * 2;
constexpr size_t W_LAYER_B = W_IN_B + W_OUT_B + W_UP_B + W_DN_B;
constexpr size_t WS_HX = 50 * MiB;
constexpr size_t WS_YMIX = 83 * MiB;
constexpr size_t WS_P = 116 * MiB;
constexpr size_t WS_XC = 207 * MiB;
constexpr size_t WS_ST = 209 * MiB;
constexpr size_t WS_DEC = 226 * MiB;
constexpr size_t WS_CAU = 227 * MiB;
constexpr size_t WS_PART = 233 * MiB;
constexpr size_t WS_END = 255 * MiB;
static_assert(WS_W + 2 * W_LAYER_B <= WS_HX, "weights");
static_assert(WS_P + (size_t)MT * DFF * 2 <= WS_XC, "act");
constexpr int RING_BYTES = 131072, LDS_BYTES = 147456;

struct Params {
    const float *x, *c, *ctx, *c_ctx, *norm1_g, *norm2_g, *w_mod, *b_mod, *w_in, *w_a2, *b_a2, *gla_g, *fft_w, *conv_w, *conv_b, *pool_w,
        *pool_scale, *w_out, *w_up, *ffn_cw, *ffn_cb, *w_down, *final_g;
    float* out; unsigned char* ws;
};

typedef const __attribute__((address_space(4))) Params* PP;
__device__ __forceinline__ unsigned f2bf(float f) { unsigned u = __builtin_bit_cast(unsigned, f); return (u + 0x7fffu + ((u >> 16) & 1u)) >> 16; }
__device__ __forceinline__ unsigned pk2(float lo, float hi) { return f2bf(lo) | (f2bf(hi) << 16); }
__device__ __forceinline__ float bf2f(unsigned h) { return __builtin_bit_cast(float, h << 16); }
__device__ __forceinline__ float bflo(unsigned w) { return __builtin_bit_cast(float, w << 16); }
__device__ __forceinline__ float bfhi(unsigned w) { return __builtin_bit_cast(float, w & 0xffff0000u); }
__device__ __forceinline__ float shfl_f(float v, int src_lane) { return __builtin_bit_cast(float, __builtin_amdgcn_ds_bpermute(src_lane << 2, __builtin_bit_cast(int, v))); }
__device__ __forceinline__ float wave_sum(float v, int lane) {
#pragma unroll
    for (int o = 1; o < 64; o <<= 1) v += shfl_f(v, lane ^ o);
    return v;
}
__device__ __forceinline__ float silu_f(float x) { return x * __builtin_amdgcn_rcpf(1.f + __expf(-x)); }
__device__ __forceinline__ float cos_rev(float r) { return __builtin_amdgcn_cosf(r); }
__device__ __forceinline__ float sin_rev(float r) { return __builtin_amdgcn_sinf(r); }
__device__ __forceinline__ bf16x8 pack8(float a0, float a1, float a2, float a3, float a4, float a5, float a6, float a7) {
    u32x4 w; w.x = pk2(a0, a1); w.y = pk2(a2, a3); w.z = pk2(a4, a5); w.w = pk2(a6, a7); return __builtin_bit_cast(bf16x8, w);
}
#define MFMA16(a, b, c) __builtin_amdgcn_mfma_f32_16x16x32_bf16(a, b, c, 0, 0, 0)

struct EpiP {
    static constexpr bool PERM = true, AFTER_DRAIN = false;
    bf16* O; const float* ba2;
    __device__ __forceinline__ void operator()(const pg8::f32x4 (&acc)[2][2][4][2], const pg8::Unit& u, int wr, int wc, int fr, int fq) const {
        const int row0 = u.pm * 256 + wr * 64 + fr, col0 = u.pn * 256 + wc * 32 + 8 * fq;
        const __amdgpu_buffer_rsrc_t prs = __builtin_amdgcn_make_buffer_rsrc(O, 0, MT * NP * 2, 0x00020000);
        const bool la = (u.pn == 2);
#pragma unroll
        for (int ai = 0; ai < 2; ++ai)
#pragma unroll
            for (int m = 0; m < 4; ++m) { bf16* rowp = O + (size_t)(row0 + ai * 128 + m * 16) * NP + col0;
#pragma unroll
                for (int bj = 0; bj < 2; ++bj) { pg8::f32x4 v0 = acc[ai][bj][m][0], v1 = acc[ai][bj][m][1];
                    if (la) { const float* bp = ba2 + (col0 + bj * 128 - PLA); const f32x4 b0 = *(const f32x4*)bp, b1 = *(const f32x4*)(bp + 4);
#pragma unroll
                        for (int e = 0; e < 4; ++e) { float xa = v0[e] + b0[e], xb = v1[e] + b1[e];
                            v0[e] = (fminf(xa, 0.f) - __logf(1.f + __expf(-fabsf(xa)))) * 0.0625f; v1[e] = (fminf(xb, 0.f) - __logf(1.f + __expf(-fabsf(xb)))) * 0.0625f; } }
                    u32x4 w; w.x = pg8::cvt_pk_bf16(v0[0], v0[1]); w.y = pg8::cvt_pk_bf16(v0[2], v0[3]); w.z = pg8::cvt_pk_bf16(v1[0], v1[1]); w.w = pg8::cvt_pk_bf16(v1[2], v1[3]);
                    __builtin_amdgcn_raw_buffer_store_b128(w, prs, (unsigned)(((row0 + ai * 128 + m * 16) * NP + col0 + bj * 128) * 2), 0, 16); } }
    }
};
template <bool INB, bool OUTB>
struct EpiRes {
    static constexpr bool PERM = true, AFTER_DRAIN = false;
    const void* xin; void* out; const float* modg;
    __device__ __forceinline__ void operator()(const pg8::f32x4 (&acc)[2][2][4][2], const pg8::Unit& u, int wr, int wc, int fr, int fq) const {
        const int w = u.pm >> 5; const int cb = u.pn * 256 + wc * 32 + 8 * fq;
        f32x4 gv[2][2];
#pragma unroll
        for (int bj = 0; bj < 2; ++bj)
#pragma unroll
            for (int n = 0; n < 2; ++n) gv[bj][n] = *(const f32x4*)(modg + w * 6144 + cb + bj * 128 + 4 * n);
        constexpr int RG = INB ? 4 : 2;
#pragma unroll
        for (int ai = 0; ai < 2; ++ai)
#pragma unroll
            for (int mp = 0; mp < 4 / RG; ++mp) {
                u32x4 xb[RG][2]; f32x4 xf[INB ? 1 : RG][2][2];
#pragma unroll
                for (int mm = 0; mm < RG; ++mm) { const size_t ro = (size_t)(u.pm * 256 + ai * 128 + wr * 64 + (RG * mp + mm) * 16 + fr) * D + cb;
#pragma unroll
                    for (int bj = 0; bj < 2; ++bj) {
                        if (INB) xb[mm][bj] = *(const u32x4*)((const bf16*)xin + ro + bj * 128);
                        else { xf[INB ? 0 : mm][bj][0] = *(const f32x4*)((const float*)xin + ro + bj * 128); xf[INB ? 0 : mm][bj][1] = *(const f32x4*)((const float*)xin + ro + bj * 128 + 4); } } }
#pragma unroll
                for (int mm = 0; mm < RG; ++mm) { const int m = RG * mp + mm; const size_t ro = (size_t)(u.pm * 256 + ai * 128 + wr * 64 + m * 16 + fr) * D + cb;
#pragma unroll
                    for (int bj = 0; bj < 2; ++bj) { f32x4 x0, x1;
                        if (INB) { const u32x4 t = xb[mm][bj]; x0 = (f32x4){bflo(t.x), bfhi(t.x), bflo(t.y), bfhi(t.y)}; x1 = (f32x4){bflo(t.z), bfhi(t.z), bflo(t.w), bfhi(t.w)}; }
                        else { x0 = xf[INB ? 0 : mm][bj][0]; x1 = xf[INB ? 0 : mm][bj][1]; }
                        const pg8::f32x4 a0 = acc[ai][bj][m][0], a1 = acc[ai][bj][m][1]; const f32x4 g0 = gv[bj][0], g1 = gv[bj][1];
                        f32x4 y0, y1;
#pragma unroll
                        for (int e = 0; e < 4; ++e) { y0[e] = x0[e] + g0[e] * a0[e]; y1[e] = x1[e] + g1[e] * a1[e]; }
                        if (OUTB) { u32x4 pk; pk.x = pg8::cvt_pk_bf16(y0[0], y0[1]); pk.y = pg8::cvt_pk_bf16(y0[2], y0[3]); pk.z = pg8::cvt_pk_bf16(y1[0], y1[1]); pk.w = pg8::cvt_pk_bf16(y1[2], y1[3]);
                            *(u32x4*)((bf16*)out + ro + bj * 128) = pk; }
                        else { *(f32x4*)((float*)out + ro + bj * 128) = y0; *(f32x4*)((float*)out + ro + bj * 128 + 4) = y1; } } }
            }
    }
};
template <bool STORE_X>
__device__ __forceinline__ void panel_rms(pg8::f32x4 (&acc)[2][2][4][2], const pg8::Unit& u, int wr, int wc, int fr, int fq, LAS unsigned char* lds, int wid, int lane,
                                          const bf16* xin, bf16* xout, const float* modg, float* slots, unsigned* cnt) {
    const int w = u.pm >> 5; const int cb = u.pn * 256 + wc * 32 + 8 * fq;
    LAS float* P = (LAS float*)lds;
    LAS float* S = (LAS float*)(lds + 4096);
    f32x4 gv[2][2];
#pragma unroll
    for (int bj = 0; bj < 2; ++bj)
#pragma unroll
        for (int n = 0; n < 2; ++n) gv[bj][n] = *(const f32x4*)(modg + w * 6144 + cb + bj * 128 + 4 * n);
#pragma unroll
    for (int ai = 0; ai < 2; ++ai) {
        u32x4 xb[4][2];
#pragma unroll
        for (int m = 0; m < 4; ++m) { const size_t ro = (size_t)(u.pm * 256 + ai * 128 + wr * 64 + m * 16 + fr) * D + cb;
#pragma unroll
            for (int bj = 0; bj < 2; ++bj) xb[m][bj] = *(const u32x4*)(xin + ro + bj * 128); }
#pragma unroll
        for (int m = 0; m < 4; ++m) { float sq = 0.f; const size_t ro = (size_t)(u.pm * 256 + ai * 128 + wr * 64 + m * 16 + fr) * D + cb;
#pragma unroll
            for (int bj = 0; bj < 2; ++bj) { const u32x4 t = xb[m][bj]; const f32x4 g0 = gv[bj][0], g1 = gv[bj][1]; pg8::f32x4 a0 = acc[ai][bj][m][0], a1 = acc[ai][bj][m][1];
                a0[0] = bflo(t.x) + g0[0] * a0[0]; a0[1] = bfhi(t.x) + g0[1] * a0[1]; a0[2] = bflo(t.y) + g0[2] * a0[2]; a0[3] = bfhi(t.y) + g0[3] * a0[3];
                a1[0] = bflo(t.z) + g1[0] * a1[0]; a1[1] = bfhi(t.z) + g1[1] * a1[1]; a1[2] = bflo(t.w) + g1[2] * a1[2]; a1[3] = bfhi(t.w) + g1[3] * a1[3];
                acc[ai][bj][m][0] = a0; acc[ai][bj][m][1] = a1;
                sq += ((a0[0] * a0[0] + a0[1] * a0[1]) + (a0[2] * a0[2] + a0[3] * a0[3])) + ((a1[0] * a1[0] + a1[1] * a1[1]) + (a1[2] * a1[2] + a1[3] * a1[3]));
                if (STORE_X) { u32x4 pk; pk.x = pg8::cvt_pk_bf16(a0[0], a0[1]); pk.y = pg8::cvt_pk_bf16(a0[2], a0[3]); pk.z = pg8::cvt_pk_bf16(a1[0], a1[1]); pk.w = pg8::cvt_pk_bf16(a1[2], a1[3]);
                    *(u32x4*)(xout + ro + bj * 128) = pk; } }
            sq += shfl_f(sq, lane ^ 16); sq += shfl_f(sq, lane ^ 32);
            if (fq == 0) P[(ai * 128 + wr * 64 + m * 16 + fr) * 4 + wc] = sq; }
    }
    asm volatile("s_waitcnt lgkmcnt(0)" ::: "memory"); __builtin_amdgcn_s_barrier(); asm volatile("" ::: "memory");
    const int row = wid * 32 + (lane & 31);
    if (lane < 32) { const float t = (P[row * 4 + 0] + P[row * 4 + 1]) + (P[row * 4 + 2] + P[row * 4 + 3]);
        __hip_atomic_store(slots + ((size_t)(u.pm * 256 + row) * 4 + u.pn), t, __ATOMIC_RELAXED, __HIP_MEMORY_SCOPE_AGENT); }
    asm volatile("s_waitcnt vmcnt(0)" ::: "memory");
    if (lane == 0) (void)__hip_atomic_fetch_add(cnt + 64 * u.pm, 1u, __ATOMIC_RELAXED, __HIP_MEMORY_SCOPE_AGENT);
    if (wid == 0) { unsigned sp = 0;
        while ((unsigned)__builtin_amdgcn_readfirstlane((int)__hip_atomic_load(cnt + 64 * u.pm, __ATOMIC_RELAXED, __HIP_MEMORY_SCOPE_AGENT)) < 32u) { __builtin_amdgcn_s_sleep(2); if (++sp > (1u << 22)) break; }
        __builtin_amdgcn_fence(__ATOMIC_ACQUIRE, "agent"); }
    asm volatile("s_waitcnt vmcnt(0) lgkmcnt(0)" ::: "memory"); __builtin_amdgcn_s_barrier(); asm volatile("" ::: "memory");
    if (lane < 32) { const float* sl = slots + (size_t)(u.pm * 256 + row) * 4; float t = 0.f;
#pragma unroll
        for (int q = 0; q < 4; ++q) t += __hip_atomic_load(sl + q, __ATOMIC_RELAXED, __HIP_MEMORY_SCOPE_AGENT);
        S[row] = 1.f / sqrtf(t * (1.f / D) + EPS); }
    asm volatile("s_waitcnt vmcnt(0) lgkmcnt(0)" ::: "memory"); __builtin_amdgcn_s_barrier(); asm volatile("" ::: "memory");
}
struct EpiFinal {
    static constexpr bool PERM = true, AFTER_DRAIN = true;
    const bf16* xin; float* out; const float* modg; const float* gfin; float* slots; unsigned* cnt;
    __device__ __forceinline__ void fused(pg8::f32x4 (&acc)[2][2][4][2], const pg8::Unit& u, int wr, int wc, int fr, int fq, LAS unsigned char* lds, int wid, int lane) const {
        panel_rms<false>(acc, u, wr, wc, fr, fq, lds, wid, lane, xin, nullptr, modg, slots, cnt);
        const LAS float* S = (const LAS float*)(lds + 4096); const int cb = u.pn * 256 + wc * 32 + 8 * fq;
        f32x4 gf[2][2];
#pragma unroll
        for (int bj = 0; bj < 2; ++bj)
#pragma unroll
            for (int n = 0; n < 2; ++n) gf[bj][n] = *(const f32x4*)(gfin + cb + bj * 128 + 4 * n);
#pragma unroll
        for (int ai = 0; ai < 2; ++ai)
#pragma unroll
            for (int m = 0; m < 4; ++m) { const int r = ai * 128 + wr * 64 + m * 16 + fr; const float rs = S[r]; float* o = out + (size_t)(u.pm * 256 + r) * D + cb;
#pragma unroll
                for (int bj = 0; bj < 2; ++bj)
#pragma unroll
                    for (int n = 0; n < 2; ++n) { const pg8::f32x4 a = acc[ai][bj][m][n]; const f32x4 g4 = gf[bj][n];
                        *(f32x4*)(o + bj * 128 + 4 * n) = (f32x4){a[0] * rs * g4[0], a[1] * rs * g4[1], a[2] * rs * g4[2], a[3] * rs * g4[3]}; } }
    }
};
struct EpiResNorm {
    static constexpr bool PERM = true, AFTER_DRAIN = true;
    const bf16* xin; bf16* xout; bf16* hout; const float* modg; const float* gn; const float* modn; float* slots; unsigned* cnt;
    __device__ __forceinline__ void fused(pg8::f32x4 (&acc)[2][2][4][2], const pg8::Unit& u, int wr, int wc, int fr, int fq, LAS unsigned char* lds, int wid, int lane) const {
        panel_rms<true>(acc, u, wr, wc, fr, fq, lds, wid, lane, xin, xout, modg, slots, cnt);
        const LAS float* S = (const LAS float*)(lds + 4096); const int w = u.pm >> 5; const int cb = u.pn * 256 + wc * 32 + 8 * fq;
        f32x4 gm[2][2], shv[2][2];
#pragma unroll
        for (int bj = 0; bj < 2; ++bj)
#pragma unroll
            for (int n = 0; n < 2; ++n) { const int c = cb + bj * 128 + 4 * n; const f32x4 g4 = *(const f32x4*)(gn + c), s4 = *(const f32x4*)(modn + w * 6144 + 4096 + c);
                shv[bj][n] = *(const f32x4*)(modn + w * 6144 + 3072 + c); gm[bj][n] = (f32x4){g4[0] * (1.f + s4[0]), g4[1] * (1.f + s4[1]), g4[2] * (1.f + s4[2]), g4[3] * (1.f + s4[3])}; }
#pragma unroll
        for (int ai = 0; ai < 2; ++ai)
#pragma unroll
            for (int m = 0; m < 4; ++m) { const int r = ai * 128 + wr * 64 + m * 16 + fr; const float rs = S[r]; bf16* o = hout + (size_t)(u.pm * 256 + r) * D + cb;
#pragma unroll
                for (int bj = 0; bj < 2; ++bj) { const pg8::f32x4 a0 = acc[ai][bj][m][0], a1 = acc[ai][bj][m][1]; const f32x4 g0 = gm[bj][0], g1 = gm[bj][1], h0 = shv[bj][0], h1 = shv[bj][1];
                    u32x4 pk; pk.x = pg8::cvt_pk_bf16(a0[0] * rs * g0[0] + h0[0], a0[1] * rs * g0[1] + h0[1]); pk.y = pg8::cvt_pk_bf16(a0[2] * rs * g0[2] + h0[2], a0[3] * rs * g0[3] + h0[3]);
                    pk.z = pg8::cvt_pk_bf16(a1[0] * rs * g1[0] + h1[0], a1[1] * rs * g1[1] + h1[1]); pk.w = pg8::cvt_pk_bf16(a1[2] * rs * g1[2] + h1[2], a1[3] * rs * g1[3] + h1[3]);
                    *(u32x4*)(o + bj * 128) = pk; } }
    }
};
struct EpiUp {
    static constexpr bool PERM = true, AFTER_DRAIN = false;
    bf16* ACT; const float* cw; const float* cb;
    __device__ __forceinline__ void operator()(const pg8::f32x4 (&acc)[2][2][4][2], const pg8::Unit& u, int wr, int wc, int fr, int fq) const {
        const int hc0 = u.pn * 128 + wc * 32 + 8 * fq;
        const __amdgpu_buffer_rsrc_t ars = __builtin_amdgcn_make_buffer_rsrc(ACT, 0, MT * DFF * 2, 0x00020000);
#pragma unroll
        for (int ai = 0; ai < 2; ++ai) { const int blk = ai * 2 + wr;
            float res[4][8];
#pragma unroll
            for (int n = 0; n < 2; ++n) {
                const f32x4 w0 = *(const f32x4*)(cw + hc0 + 4 * n), w1 = *(const f32x4*)(cw + DFF + hc0 + 4 * n), w2 = *(const f32x4*)(cw + 2 * DFF + hc0 + 4 * n), bb = *(const f32x4*)(cb + hc0 + 4 * n);
#pragma unroll
                for (int e = 0; e < 4; ++e) {
                    float xs[4], ps[4], ns[4]; const float bprev = 0.f, bnext = 0.f;
#pragma unroll
                    for (int m = 0; m < 4; ++m) { xs[m] = acc[ai][0][m][n][e]; ps[m] = __builtin_bit_cast(float, __builtin_amdgcn_update_dpp(0, __builtin_bit_cast(int, xs[m]), 0x121, 0xf, 0xf, false)); ns[m] = __builtin_bit_cast(float, __builtin_amdgcn_update_dpp(0, __builtin_bit_cast(int, xs[m]), 0x12f, 0xf, 0xf, false)); }
#pragma unroll
                    for (int m = 0; m < 4; ++m) {
                        const float oldp = (m > 0) ? ps[m > 0 ? m - 1 : 0] : bprev, oldn = (m < 3) ? ns[m < 3 ? m + 1 : 3] : bnext;
                        const float prev = __builtin_bit_cast(float, __builtin_amdgcn_update_dpp(__builtin_bit_cast(int, oldp), __builtin_bit_cast(int, xs[m]), 0x111, 0xf, 0xf, false));
                        const float next = __builtin_bit_cast(float, __builtin_amdgcn_update_dpp(__builtin_bit_cast(int, oldn), __builtin_bit_cast(int, xs[m]), 0x101, 0xf, 0xf, false));
                        const float a = w0[e] * prev + w1[e] * xs[m] + w2[e] * next + bb[e];
                        res[m][4 * n + e] = silu_f(a) * acc[ai][1][m][n][e];
                    }
                }
            }
#pragma unroll
            for (int m = 0; m < 4; ++m) { const int r = u.pm * 256 + ai * 128 + wr * 64 + m * 16 + fr;
                u32x4 w; w.x = pg8::cvt_pk_bf16(res[m][0], res[m][1]); w.y = pg8::cvt_pk_bf16(res[m][2], res[m][3]); w.z = pg8::cvt_pk_bf16(res[m][4], res[m][5]); w.w = pg8::cvt_pk_bf16(res[m][6], res[m][7]);
                __builtin_amdgcn_raw_buffer_store_b128(w, ars, (unsigned)((r * DFF + hc0) * 2), 0, 16); }
        }
    }
};
struct EpiUpCtx {
    static constexpr bool PERM = true, AFTER_DRAIN = false;
    bf16* ACT; const float* cw; const float* cb; LAS float* ex;
    __device__ __forceinline__ void operator()(const pg8::f32x4 (&acc)[2][2][4][2], const pg8::Unit& u, int wr, int wc, int fr, int fq) const {
        const int hc0 = u.pn * 128 + wc * 32 + 8 * fq;
            const int colw = wc * 32 + 8 * fq;
#pragma unroll
            for (int ai = 0; ai < 2; ++ai) { const int blk = ai * 2 + wr;
                if (fr == 0) {
#pragma unroll
                    for (int n = 0; n < 2; ++n)
#pragma unroll
                        for (int e = 0; e < 4; ++e) ex[(blk * 2 + 0) * 128 + colw + 4 * n + e] = acc[ai][0][0][n][e]; }
                if (fr == 15) {
#pragma unroll
                    for (int n = 0; n < 2; ++n)
#pragma unroll
                        for (int e = 0; e < 4; ++e) ex[(blk * 2 + 1) * 128 + colw + 4 * n + e] = acc[ai][0][3][n][e]; } }
            asm volatile("s_waitcnt lgkmcnt(0)" ::: "memory"); __builtin_amdgcn_s_barrier(); asm volatile("" ::: "memory");
#pragma unroll
            for (int ai = 0; ai < 2; ++ai) { const int blk = ai * 2 + wr;
                float res[4][8];
    #pragma unroll
                for (int n = 0; n < 2; ++n) {
                    const f32x4 w0 = *(const f32x4*)(cw + hc0 + 4 * n), w1 = *(const f32x4*)(cw + DFF + hc0 + 4 * n), w2 = *(const f32x4*)(cw + 2 * DFF + hc0 + 4 * n), bb = *(const f32x4*)(cb + hc0 + 4 * n);
    #pragma unroll
                    for (int e = 0; e < 4; ++e) {
                        float xs[4], ps[4], ns[4]; float bprev = 0.f, bnext = 0.f; if (blk > 0) bprev = ex[((blk - 1) * 2 + 1) * 128 + colw + 4 * n + e]; if (blk < 3) bnext = ex[((blk + 1) * 2 + 0) * 128 + colw + 4 * n + e];
    #pragma unroll
                        for (int m = 0; m < 4; ++m) { xs[m] = acc[ai][0][m][n][e]; ps[m] = __builtin_bit_cast(float, __builtin_amdgcn_update_dpp(0, __builtin_bit_cast(int, xs[m]), 0x121, 0xf, 0xf, false)); ns[m] = __builtin_bit_cast(float, __builtin_amdgcn_update_dpp(0, __builtin_bit_cast(int, xs[m]), 0x12f, 0xf, 0xf, false)); }
    #pragma unroll
                        for (int m = 0; m < 4; ++m) {
                            const float prev = (fr > 0) ? ps[m] : (m > 0 ? ps[m > 0 ? m - 1 : 0] : bprev);
                            const float next = (fr < 15) ? ns[m] : (m < 3 ? ns[m < 3 ? m + 1 : 3] : bnext);
                            const float a = w0[e] * prev + w1[e] * xs[m] + w2[e] * next + bb[e];
                            res[m][4 * n + e] = silu_f(a) * acc[ai][1][m][n][e];
                        }
                    }
                }
    #pragma unroll
                for (int m = 0; m < 4; ++m) { const int r = u.pm * 256 + ai * 128 + wr * 64 + m * 16 + fr;
                    u32x4 w; w.x = pg8::cvt_pk_bf16(res[m][0], res[m][1]); w.y = pg8::cvt_pk_bf16(res[m][2], res[m][3]); w.z = pg8::cvt_pk_bf16(res[m][4], res[m][5]); w.w = pg8::cvt_pk_bf16(res[m][6], res[m][7]);
                    *(u32x4*)(ACT + (size_t)r * DFF + hc0) = w; }
            }

    }
};
struct CtxOrder {
    int nN, c, c0;
    __device__ void init(int N, int c_, int c0_) { nN = N / 256; c = c_; c0 = c0_; }
    __device__ bool next(int i, pg8::Unit& u) const { const int j = c - c0; if (i > 0 || j < 0 || j >= 2 * nN) return false; u.pm = 64 + (j & 1); u.pn = j >> 1; u.ks = 0; return true; }
    __device__ __forceinline__ void a_ready(const pg8::Unit&) const {}
    __device__ __forceinline__ void done(const pg8::Unit&) const {}
};

struct SplitOrder {
    int nunits, G, c;
    __device__ void init(int nks, int G_, int c_) { nunits = 8 * nks; G = G_; c = c_; }
    __device__ bool next(int i, pg8::Unit& u) const { const int id = i * G + c; if (id >= nunits) return false; u.pm = 64 + (id & 1); u.pn = (id >> 1) & 3; u.ks = id >> 3; return true; }
    __device__ __forceinline__ void a_ready(const pg8::Unit&) const {}
    __device__ __forceinline__ void done(const pg8::Unit&) const {}
};
struct EpiPartial {
    static constexpr bool PERM = false, AFTER_DRAIN = false;
    float* part;
    __device__ __forceinline__ void operator()(const pg8::f32x4 (&acc)[2][2][4][2], const pg8::Unit& u, int wr, int wc, int fr, int fq) const {
#pragma unroll
        for (int ai = 0; ai < 2; ++ai)
#pragma unroll
            for (int m = 0; m < 4; ++m) { const int r = u.pm * 256 + ai * 128 + wr * 64 + m * 16 + fr; float* o = part + ((size_t)u.ks * MC + (size_t)(r - ML)) * D;
#pragma unroll
                for (int bj = 0; bj < 2; ++bj)
#pragma unroll
                    for (int n = 0; n < 2; ++n) { const int c = u.pn * 256 + bj * 128 + wc * 32 + 16 * n + 4 * fq; const pg8::f32x4 a = acc[ai][bj][m][n];
                        *(f32x4*)(o + c) = (f32x4){a[0], a[1], a[2], a[3]}; } }
    }
};
typedef __attribute__((address_space(1))) unsigned gu32;
#define XB_TMO      128
#define XB_XCNT(j)  (256  + 64 * (j))
#define XB_XSUB(j)  (1280 + 64 * (j))
#define XB_XGEN(j)  (2304 + 64 * (j))
#define XB_TOP      3328
#define XB_TOPGEN   3392
#define XCD_BAR_WORDS 3456
#define XB_SPIN_CAP (1u << 18)

__device__ __forceinline__ unsigned xb_ld(unsigned* p)              { return __hip_atomic_load(p, __ATOMIC_RELAXED, __HIP_MEMORY_SCOPE_AGENT); }
__device__ __forceinline__ unsigned xb_add(unsigned* p, unsigned v) { return __hip_atomic_fetch_add(p, v, __ATOMIC_RELAXED, __HIP_MEMORY_SCOPE_AGENT); }
__device__ __forceinline__ unsigned xb_xcc_id() { return (unsigned)__builtin_amdgcn_s_getreg((3 << 11) | 20) & 0xFu; }
#define XB_SPIN(cond, bar) do { unsigned _sp = 0; while (cond) { __builtin_amdgcn_s_sleep(1); \
    if ((++_sp & 255u) == 0u) { if (xb_ld(&(bar)[XB_TMO])) break; if (_sp > XB_SPIN_CAP) { atomicAdd(&(bar)[XB_TMO], 1u); break; } } } } while (0)

struct XcdBarrier {
    unsigned* bar; unsigned x;
    volatile LAS unsigned* st;
};

__device__ __forceinline__ XcdBarrier xcd_barrier_post(unsigned* bar, volatile LAS unsigned* st, int tid_) {
    XcdBarrier b; b.bar = bar; b.x = xb_xcc_id(); b.st = st;
    if (tid_ == 0) (void)xb_add(&bar[XB_XCNT(b.x)], 1u);
    return b;
}
__device__ __forceinline__ void xcd_barrier_complete(unsigned* bar, unsigned x, unsigned& nloc, unsigned& nx) {
    const unsigned G = gridDim.x * gridDim.y * gridDim.z;
    unsigned sum, cnt, mine, sp = 0u;
    for (;;) {
        sum = 0u; cnt = 0u; mine = 0u;
#pragma unroll
        for (unsigned j = 0; j < 16; ++j) { const unsigned c = xb_ld(&bar[XB_XCNT(j)]); sum += c; cnt += (c > 0u) ? 1u : 0u; mine = (j == x) ? c : mine; }
        if (sum == G) break;
        __builtin_amdgcn_s_sleep(1);
        if ((++sp & 255u) == 0u) { if (xb_ld(&bar[XB_TMO])) break; if (sp > XB_SPIN_CAP) { atomicAdd(&bar[XB_TMO], 1u); break; } }
    }
    nloc = mine > 0u ? mine : 1u; nx = cnt > 0u ? cnt : 1u;
}

__device__ __forceinline__ void xcd_barrier(const XcdBarrier& b, int tid_) {
    asm volatile("s_waitcnt vmcnt(0)" ::: "memory");
    __syncthreads();
    if (tid_ == 0) {
        unsigned* bar = b.bar; asm volatile("" : "+s"(bar)); unsigned bx = (unsigned)__builtin_amdgcn_readfirstlane((int)b.x); asm volatile("" : "+s"(bx));
        __builtin_amdgcn_s_waitcnt(0);
        unsigned nloc = b.st[0], nx = b.st[1];
        if (nloc == 0u) { xcd_barrier_complete(bar, bx, nloc, nx); b.st[0] = nloc; b.st[1] = nx; }
        const unsigned old = xb_add(&bar[XB_XSUB(bx)], 1u);
        const unsigned gen = old / nloc;
        if (old + 1u == (gen + 1u) * nloc) {
            __builtin_amdgcn_fence(__ATOMIC_RELEASE, "agent");
            asm volatile("s_waitcnt vmcnt(0)" ::: "memory");
            const unsigned og = xb_add(&bar[XB_TOP], 1u);
            const unsigned tg = og / nx;
            if (og + 1u == (tg + 1u) * nx) xb_add(&bar[XB_TOPGEN], 1u);
            else XB_SPIN(xb_ld(&bar[XB_TOPGEN]) == tg, bar);
            __builtin_amdgcn_fence(__ATOMIC_ACQUIRE, "agent");
            xb_add(&bar[XB_XGEN(bx)], 1u);
            asm volatile("s_waitcnt vmcnt(0)" ::: "memory");
        } else {
            XB_SPIN(xb_ld(&bar[XB_XGEN(bx)]) == gen, bar);
            __builtin_amdgcn_fence(__ATOMIC_ACQUIRE, "agent");
            asm volatile("s_waitcnt vmcnt(0)" ::: "memory");
        }
    }
    __syncthreads();
}
struct Ctx {
    LAS unsigned char* lds; int tid, lane, wave, G, gw, NGW;
    float* MOD; float* MCS; bf16 *F1, *F2, *FC; bf16 *HX, *YMIX, *PB, *ACT, *TB, *CAU; float *XC, *ST, *DEC;
};
__device__ __forceinline__ bf16* win_t(PP p, int l) { return (bf16*)(p->ws + WS_W + (size_t)l * W_LAYER_B); }
__device__ __forceinline__ bf16* wout_t(PP p, int l) { return (bf16*)(p->ws + WS_W + (size_t)l * W_LAYER_B + W_IN_B); }
__device__ __forceinline__ bf16* wup_t(PP p, int l) { return (bf16*)(p->ws + WS_W + (size_t)l * W_LAYER_B + W_IN_B + W_OUT_B); }
__device__ __forceinline__ bf16* wdn_t(PP p, int l) { return (bf16*)(p->ws + WS_W + (size_t)l * W_LAYER_B + W_IN_B + W_OUT_B + W_UP_B); }

__device__ __forceinline__ void transpose_item(const float* W, int K, int N, bf16* WT, int k0, int n0, int dst0, float scale, LAS float* scr, int lane) {
#pragma unroll
    for (int i = 0; i < 32; ++i) { const int kk = 2 * i + (lane >> 5); scr[kk * 33 + (lane & 31)] = __builtin_nontemporal_load(W + (size_t)(k0 + kk) * N + n0 + (lane & 31)) * scale; }
    LDS_WAIT(); __builtin_amdgcn_wave_barrier();
    const int c = lane & 7;
#pragma unroll
    for (int j = 0; j < 4; ++j) { const int n = (lane >> 3) + 8 * j; const LAS float* s = scr + (8 * c) * 33 + n;
        u32x4 o; o.x = pk2(s[0 * 33], s[1 * 33]); o.y = pk2(s[2 * 33], s[3 * 33]); o.z = pk2(s[4 * 33], s[5 * 33]); o.w = pk2(s[6 * 33], s[7 * 33]);
        __builtin_nontemporal_store(o, (u32x4*)(WT + (size_t)(dst0 + n) * K + k0 + 8 * c)); }
    LDS_WAIT(); __builtin_amdgcn_wave_barrier();
}

__device__ __forceinline__ void phase0(PP p, Ctx& F) {
    LAS float* sv = (LAS float*)F.lds; LAS float* red = sv + 3072;
    for (int i = F.tid; i < 3072; i += 512) { const int w = i >> 10, k = i & 1023; const float cv = (w < 2) ? p->c[w * 1024 + k] : p->c_ctx[k]; sv[i] = cv / (1.f + expf(-cv)); }
    __syncthreads();
    for (int it = blockIdx.x; it < 192; it += F.G) {
        const int l = it / 96, c0 = (it % 96) * 64; const float* W = p->w_mod + (size_t)l * 1024 * 6144 + c0 + F.lane;
        float a0 = 0.f, a1 = 0.f, a2 = 0.f; const int kb = F.wave * 128;
#pragma unroll 32
        for (int k = 0; k < 128; ++k) { const float wv = __builtin_nontemporal_load(W + (size_t)(kb + k) * 6144); a0 += sv[kb + k] * wv; a1 += sv[1024 + kb + k] * wv; a2 += sv[2048 + kb + k] * wv; }
        red[(F.wave * 3 + 0) * 64 + F.lane] = a0; red[(F.wave * 3 + 1) * 64 + F.lane] = a1; red[(F.wave * 3 + 2) * 64 + F.lane] = a2;
        __syncthreads();
        if (F.tid < 192) { const int w = F.tid >> 6, ln = F.tid & 63; float s = 0.f;
#pragma unroll
            for (int q = 0; q < 8; ++q) s += red[(q * 3 + w) * 64 + ln];
            F.MOD[(l * 3 + w) * 6144 + c0 + ln] = s + p->b_mod[l * 6144 + c0 + ln]; }
        __syncthreads();
    }
    __syncthreads();
    LAS float* scr = (LAS float*)(F.lds + F.wave * 16384);
    constexpr int I_IN = 48 * 16, I_OUT = 32 * 16, I_UP = 176 * 16, I_DN = 32 * 44, I_L = I_IN + I_OUT + I_UP + I_DN;
    for (int it = F.gw; it < 2 * I_L; it += F.NGW) {
        const int l = it / I_L; int r = it % I_L;
        if (r < I_IN) { const int cb = r / 16, kb = r % 16; int src, dst; float sc = 1.f;
            if (cb < 4) { src = 32 * cb; dst = PK + 32 * cb; }
            else if (cb < 8) { src = 416 + 32 * (cb - 4); dst = PQ + 32 * (cb - 4); sc = 0.17677669529663687f; }
            else if (cb < 16) { src = 128 + 32 * (cb - 8); dst = PV + 32 * (cb - 8); }
            else if (cb < 24) { src = 544 + 32 * (cb - 16); dst = PG + 32 * (cb - 16); }
            else if (cb < 32) { src = 1056 + 32 * (cb - 24); dst = PH + 32 * (cb - 24); }
            else if (cb < 40) { src = 1312 + 32 * (cb - 32); dst = PBG + 32 * (cb - 32); }
            else { src = 1568 + 32 * (cb - 40); dst = PCG + 32 * (cb - 40); }
            transpose_item(p->w_in + (size_t)l * D * DIN, D, DIN, win_t(p, l), 64 * kb, src, dst, sc, scr, F.lane); continue; }
        r -= I_IN;
        if (r < I_OUT) { const int cb = r / 16, kb = r % 16; transpose_item(p->w_out + (size_t)l * D * D, D, D, wout_t(p, l), 64 * kb, 32 * cb, 32 * cb, 1.f, scr, F.lane); continue; }
        r -= I_OUT;
        if (r < I_UP) { const int cb = r / 16, kb = r % 16; const int c = 32 * cb, isu = (c >= DFF) ? 1 : 0, j = c - isu * DFF; const int dst = (j / 128) * 256 + isu * 128 + (j % 128);
            transpose_item(p->w_up + (size_t)l * D * NUP, D, NUP, wup_t(p, l), 64 * kb, c, dst, 1.f, scr, F.lane); continue; }
        r -= I_UP;
        { const int cb = r / 44, kb = r % 44; transpose_item(p->w_down + (size_t)l * DFF * D, DFF, D, wdn_t(p, l), 64 * kb, 32 * cb, 32 * cb, 1.f, scr, F.lane); }
    }
    const int gt = blockIdx.x * 512 + F.tid, NT = F.G * 512;
    const int gtm = (F.G == 256) ? ((int)blockIdx.x - 192) * 512 + F.tid : gt; const int NTm = (F.G == 256) ? 32768 : NT;
    for (int i = gtm; i >= 0 && i < 32768; i += NTm) { const int d = i & 63, c = (i >> 6) & 63, g = (i >> 12) & 3, l = i >> 14;
        const float* wf = p->fft_w + (size_t)((l * 4 + g) * 64) * 64 + d; float mc = 0.f, ms = 0.f;
        for (int f = 0; f < 64; ++f) { const float a = (float)((f * c) & 63) * (1.f / 64.f); const float w = wf[f * 64]; mc += cos_rev(a) * w; ms -= sin_rev(a) * w; }
        F.MCS[(((l * 4 + g) * 2 + 0) * 64 + c) * 64 + d] = mc * 0.125f; F.MCS[(((l * 4 + g) * 2 + 1) * 64 + c) * 64 + d] = ms * 0.125f; }
    for (int i = gt; i < MC * D / 4; i += NT) ((f32x4*)F.XC)[i] = ((const f32x4*)p->ctx)[i];
    for (int i = gt; i < 180224; i += NT) {
        if (i < 16384) { const int mm = i >> 7, kk = i & 127, k1 = mm & 63, n1 = kk & 63; const float a = (float)((k1 * n1) & 63) * (1.f / 64.f); const float C = cos_rev(a), S = sin_rev(a);
            const float v = (mm < 64) ? (kk < 64 ? C : S) : (kk < 64 ? -S : C); F.F1[i] = (bf16)f2bf(v); }
        else if (i < 49152) { const int j = i - 16384, k2 = j >> 8, kk = j & 255, n2 = kk & 127; const float a = (float)((k2 * n2) & 127) * (1.f / 128.f);
            const float v = (kk < 128 ? cos_rev(a) : sin_rev(a)) * 0.011048543456039806f; F.F2[j] = (bf16)f2bf(v); }
        else { const int j = i - 49152, k = j >> 9, kk = j & 511, n = kk & 255; const float a = (float)((k * n) & 255) * (1.f / 256.f);
            const float v = (kk < 256 ? cos_rev(a) : sin_rev(a)) * 0.0625f; F.FC[j] = (bf16)f2bf(v); }
    }
}

__device__ __forceinline__ void fold_items(PP p, Ctx& F) {
    for (int it4 = F.gw; it4 < 1792; it4 += F.NGW) {
        const int dq = it4 & 3, it = it4 >> 2;
        const int l = it / 224, r = it % 224, s = r / 16, kb = r % 16; const int k = 64 * kb + F.lane;
        const float* wrow = p->w_in + (size_t)l * D * DIN + (size_t)k * DIN; bf16* WT = win_t(p, l);
        if (s < 2) {
            const f32x4* src = (const f32x4*)(wrow + 384 + 16 * s); f32x4 r4[4];
#pragma unroll
            for (int q = 0; q < 4; ++q) r4[q] = src[q];
            const float* M = p->w_a2 + (size_t)((l * 2 + s) * 16) * 128;
            for (int d = 32 * dq; d < 32 * dq + 32; ++d) { float a = 0.f;
#pragma unroll
                for (int c = 0; c < 16; ++c) a += r4[c >> 2][c & 3] * M[c * 128 + d];
                WT[(size_t)(PLA + s * 128 + d) * D + k] = (bf16)f2bf(a); }
        } else {
            const int kind = (s - 2) >> 2, g = (s - 2) & 3;
            const f32x4* src = (const f32x4*)(wrow + (kind < 2 ? 800 : 1824) + 64 * g); f32x4 r4[16];
#pragma unroll
            for (int q = 0; q < 16; ++q) r4[q] = src[q];
            const float* M = (kind < 2) ? (F.MCS + (size_t)(((l * 4 + g) * 2 + kind) * 64) * 64) : (p->pool_w + (size_t)((l * 4 + g) * 64) * 64);
            const int drow = (kind == 0 ? PFA : (kind == 1 ? PFB : PPOOL)) + 64 * g;
            for (int d = 16 * dq; d < 16 * dq + 16; ++d) { float a = 0.f;
#pragma unroll
                for (int c = 0; c < 64; ++c) a += r4[c >> 2][c & 3] * M[c * 64 + d];
                if (kind == 2) a *= p->pool_scale[l * 256 + g * 64 + d];
                WT[(size_t)(drow + d) * D + k] = (bf16)f2bf(a); }
        }
    }
}

__device__ __forceinline__ void norm_row_bf16(const float* xrow, bf16* orow, const float* g, const float* sc, const float* sh, int lane, const float* part, int nparts, const float* gate, float* xout) {
    f32x4 v[4]; float s = 0.f;
#pragma unroll
    for (int j = 0; j < 4; ++j) v[j] = ((const f32x4*)xrow)[lane + 64 * j];
    if (nparts > 0) {
        f32x4 a[4];
#pragma unroll
        for (int j = 0; j < 4; ++j) a[j] = (f32x4){0.f, 0.f, 0.f, 0.f};
        for (int q = 0; q < nparts; ++q) {
#pragma unroll
            for (int j = 0; j < 4; ++j) { const f32x4 t = ((const f32x4*)(part + (size_t)q * MC * D))[lane + 64 * j]; a[j][0] += t[0]; a[j][1] += t[1]; a[j][2] += t[2]; a[j][3] += t[3]; } }
#pragma unroll
        for (int j = 0; j < 4; ++j) { const f32x4 gv = ((const f32x4*)gate)[lane + 64 * j];
#pragma unroll
            for (int e = 0; e < 4; ++e) v[j][e] += gv[e] * a[j][e];
            ((f32x4*)xout)[lane + 64 * j] = v[j]; }
    }
#pragma unroll
    for (int j = 0; j < 4; ++j) s += (v[j][0] * v[j][0] + v[j][1] * v[j][1]) + (v[j][2] * v[j][2] + v[j][3] * v[j][3]);
    const float rstd = 1.f / sqrtf(wave_sum(s, lane) * (1.f / D) + EPS);
#pragma unroll
    for (int j = 0; j < 4; ++j) { const int idx = lane + 64 * j; const f32x4 gv = ((const f32x4*)g)[idx], scv = ((const f32x4*)sc)[idx], shv = ((const f32x4*)sh)[idx];
        float y[4];
#pragma unroll
        for (int e = 0; e < 4; ++e) y[e] = v[j][e] * rstd * gv[e] * (1.f + scv[e]) + shv[e];
        u32x2 o; o.x = pk2(y[0], y[1]); o.y = pk2(y[2], y[3]); ((u32x2*)orow)[idx] = o; }
}
template <bool FINAL, bool INB>
__device__ __forceinline__ void norm_rows4(const void* xbase, bf16* obase, float* fout, const float* g, const float* modl, int which, int m0, int stride, int lane) {
    f32x4 v[4][4]; float s[4]; int mk[4]; bool ok[4];
#pragma unroll
    for (int k = 0; k < 4; ++k) { const int m = m0 + k * stride; ok[k] = m < ML; mk[k] = ok[k] ? m : ML - 1;
#pragma unroll
        for (int j = 0; j < 4; ++j) {
            if (INB) { const u32x2 t = ((const u32x2*)((const bf16*)xbase + (size_t)mk[k] * D))[lane + 64 * j]; v[k][j] = (f32x4){bflo(t.x), bfhi(t.x), bflo(t.y), bfhi(t.y)}; }
            else v[k][j] = ((const f32x4*)((const float*)xbase + (size_t)mk[k] * D))[lane + 64 * j]; } }
    f32x4 gm[4], sh4[4];
    { const float* mod = FINAL ? g : modl + (m0 >> 13) * 6144 + which * 3072;
#pragma unroll
      for (int j = 0; j < 4; ++j) { const int idx = lane + 64 * j; const f32x4 gv = ((const f32x4*)g)[idx];
          if (FINAL) { gm[j] = gv; sh4[j] = (f32x4){0.f, 0.f, 0.f, 0.f}; }
          else { const f32x4 scv = ((const f32x4*)(mod + 1024))[idx]; sh4[j] = ((const f32x4*)mod)[idx];
#pragma unroll
              for (int e = 0; e < 4; ++e) gm[j][e] = gv[e] * (1.f + scv[e]); } } }
#pragma unroll
    for (int k = 0; k < 4; ++k) { float a = 0.f;
#pragma unroll
        for (int j = 0; j < 4; ++j) a += (v[k][j][0] * v[k][j][0] + v[k][j][1] * v[k][j][1]) + (v[k][j][2] * v[k][j][2] + v[k][j][3] * v[k][j][3]);
        s[k] = a; }
#pragma unroll
    for (int o = 1; o < 64; o <<= 1) {
#pragma unroll
        for (int k = 0; k < 4; ++k) s[k] += shfl_f(s[k], lane ^ o); }
#pragma unroll
    for (int k = 0; k < 4; ++k) { if (!ok[k]) continue;
        const float rstd = 1.f / sqrtf(s[k] * (1.f / D) + EPS);
#pragma unroll
        for (int j = 0; j < 4; ++j) { const int idx = lane + 64 * j;
            if (FINAL) { f32x4 y;
#pragma unroll
                for (int e = 0; e < 4; ++e) y[e] = v[k][j][e] * rstd * gm[j][e];
                ((f32x4*)(fout + (size_t)mk[k] * D))[idx] = y; }
            else { float y[4];
#pragma unroll
                for (int e = 0; e < 4; ++e) y[e] = v[k][j][e] * rstd * gm[j][e] + sh4[j][e];
                u32x2 o; o.x = pk2(y[0], y[1]); o.y = pk2(y[2], y[3]); ((u32x2*)(obase + (size_t)mk[k] * D))[idx] = o; } }
    }
}
__device__ __forceinline__ void norm_phase(PP p, Ctx& F, int l, int which, int mrows) {
    const float* g = (which == 0 ? p->norm1_g : p->norm2_g) + l * D;
    const float* PART = (const float*)(p->ws + WS_PART);
    if (l == 0 && which == 0) { for (int m0 = F.gw; m0 < ML; m0 += 4 * F.NGW) norm_rows4<false, false>(p->x, F.HX, nullptr, g, F.MOD + l * 3 * 6144, which, m0, F.NGW, F.lane); }
    else { const void* xb = (l == 1 && which == 1 && F.G == 256) ? (const void*)(p->ws + WS_XB2) : (const void*)p->out;
        for (int m0 = F.gw; m0 < ML; m0 += 4 * F.NGW) norm_rows4<false, true>(xb, F.HX, nullptr, g, F.MOD + l * 3 * 6144, which, m0, F.NGW, F.lane); }
    for (int m = ML + F.gw; m < mrows; m += F.NGW) {
        int nparts = 0; const float* gate = nullptr;
        const float* xr = ((l == 0 && which == 0) ? p->ctx : F.XC) + (size_t)(m - ML) * D;
        if (l == 0 && which == 1) { nparts = 4; gate = F.MOD + 2 * 6144 + 2048; }
        if (l == 1 && which == 0) { nparts = 11; gate = F.MOD + 2 * 6144 + 5120; }
        const float* part = PART + (size_t)(m - ML) * D; float* xout = F.XC + (size_t)(m - ML) * D;
        const float* mod = F.MOD + (l * 3 + 2) * 6144 + which * 3072;
        norm_row_bf16(xr, F.HX + (size_t)m * D, g, mod + 1024, mod, F.lane, part, nparts, gate, xout);
    }
}
__device__ __forceinline__ void final_norm(PP p, Ctx& F) {
    for (int m0 = F.gw; m0 < ML; m0 += 4 * F.NGW) norm_rows4<true, false>(p->ws + WS_HX  , nullptr, p->out, p->final_g, nullptr, 0, m0, F.NGW, F.lane);
}
constexpr int CP = 260;
__device__ __forceinline__ int chunk_row0(int b, int cidx) { return (cidx < 4) ? (ML + b * CTXL + cidx * 64) : (b * SEQ + (cidx - 4) * 64); }
__device__ __forceinline__ void cum_to_lds(LAS float* cum, const bf16* PB, int row0, int tid) {
    { const int oct = tid & 31, j0 = tid >> 5; u32x4 w[4];
#pragma unroll
      for (int q = 0; q < 4; ++q) w[q] = *(const u32x4*)(PB + (size_t)(row0 + j0 + 16 * q) * NP + PLA + 8 * oct);
#pragma unroll
      for (int q = 0; q < 4; ++q) { LAS float* d = cum + (j0 + 16 * q) * CP + 8 * oct;
          *(LAS f32x4*)d = (f32x4){bflo(w[q].x), bfhi(w[q].x), bflo(w[q].y), bfhi(w[q].y)}; *(LAS f32x4*)(d + 4) = (f32x4){bflo(w[q].z), bfhi(w[q].z), bflo(w[q].w), bfhi(w[q].w)}; } }
    __syncthreads();
    if (tid < 256) { float s = 0.f;
        if (tid < 128) {
#pragma unroll 16
            for (int j = 0; j < 64; ++j) { s += cum[j * CP + tid]; cum[j * CP + tid] = s; }
        } else {
#pragma unroll 16
            for (int j = 63; j >= 0; --j) { s += cum[j * CP + tid]; cum[j * CP + tid] = s; }
        } }
    __syncthreads();
}
typedef float f32x2_t __attribute__((ext_vector_type(2)));
typedef __bf16 bf16x2_t __attribute__((ext_vector_type(2)));
__device__ __forceinline__ unsigned pkh(float lo, float hi) { f32x2_t v = {lo, hi}; bf16x2_t b = __builtin_convertvector(v, bf16x2_t); return __builtin_bit_cast(unsigned, b); }
__device__ __forceinline__ bf16x8 pack8h(float a0, float a1, float a2, float a3, float a4, float a5, float a6, float a7) {
    u32x4 w; w.x = pkh(a0, a1); w.y = pkh(a2, a3); w.z = pkh(a4, a5); w.w = pkh(a6, a7); return __builtin_bit_cast(bf16x8, w);
}
__device__ __forceinline__ void la_load(u32x4 (&w)[4], const bf16* PB, int row0, int tid) {
    const int oct = tid & 31, j0 = tid >> 5;
#pragma unroll
    for (int q = 0; q < 4; ++q) w[q] = *(const u32x4*)(PB + (size_t)(row0 + j0 + 16 * q) * NP + PLA + 8 * oct);
}
__device__ __forceinline__ void la_scan(LAS float* cum, const u32x4 (&w)[4], int tid) {
    const int oct = tid & 31, j0 = tid >> 5;
#pragma unroll
    for (int q = 0; q < 4; ++q) { LAS float* d = cum + (j0 + 16 * q) * CP + 8 * oct;
        *(LAS f32x4*)d = (f32x4){bflo(w[q].x), bfhi(w[q].x), bflo(w[q].y), bfhi(w[q].y)}; *(LAS f32x4*)(d + 4) = (f32x4){bflo(w[q].z), bfhi(w[q].z), bflo(w[q].w), bfhi(w[q].w)}; }
    __syncthreads();
    if (tid < 256) { float carry = 0.f;
        if (tid < 128) {
#pragma unroll
            for (int hf = 0; hf < 4; ++hf) { float v[16];
#pragma unroll
                for (int j = 0; j < 16; ++j) v[j] = cum[(16 * hf + j) * CP + tid];
                v[0] += carry;
#pragma unroll
                for (int j = 1; j < 16; ++j) v[j] += v[j - 1];
                carry = v[15];
#pragma unroll
                for (int j = 0; j < 16; ++j) cum[(16 * hf + j) * CP + tid] = v[j]; }
        } else {
#pragma unroll
            for (int hf = 3; hf >= 0; --hf) { float v[16];
#pragma unroll
                for (int j = 0; j < 16; ++j) v[j] = cum[(16 * hf + j) * CP + tid];
                v[15] += carry;
#pragma unroll
                for (int j = 14; j >= 0; --j) v[j] += v[j + 1];
                carry = v[0];
#pragma unroll
                for (int j = 0; j < 16; ++j) cum[(16 * hf + j) * CP + tid] = v[j]; }
        } }
    __syncthreads();
}
__device__ __forceinline__ void gla_a_item(Ctx& F, int b, int cidx) {
    LAS float* cum = (LAS float*)F.lds; const int row0 = chunk_row0(b, cidx);
    const int h = F.wave & 3, dir = F.wave >> 2, chb = dir * 128 + h * 32, lr = F.lane & 15, g = F.lane >> 4;
    const int jl = dir ? 0 : 63;
    u32x4 wla[4]; la_load(wla, F.PB, row0, F.tid);
    unsigned short kt[2][2][8], vt[2][4][8];
#pragma unroll
    for (int ks = 0; ks < 2; ++ks) { const int j0 = 32 * ks + 8 * g;
#pragma unroll
        for (int mb = 0; mb < 2; ++mb)
#pragma unroll
            for (int e = 0; e < 8; ++e) kt[ks][mb][e] = F.PB[(size_t)(row0 + j0 + e) * NP + PK + h * 32 + 16 * mb + lr];
#pragma unroll
        for (int nb = 0; nb < 4; ++nb)
#pragma unroll
            for (int e = 0; e < 8; ++e) vt[ks][nb][e] = F.PB[(size_t)(row0 + j0 + e) * NP + PV + h * 64 + 16 * nb + lr]; }
    la_scan(cum, wla, F.tid);
    f32x4 acc[2][4];
#pragma unroll
    for (int mb = 0; mb < 2; ++mb)
#pragma unroll
        for (int nb = 0; nb < 4; ++nb) acc[mb][nb] = (f32x4){0.f, 0.f, 0.f, 0.f};
#pragma unroll
    for (int ks = 0; ks < 2; ++ks) {
        bf16x8 af[2], bfr[4]; const int j0 = 32 * ks + 8 * g;
#pragma unroll
        for (int mb = 0; mb < 2; ++mb) { const int dk = 16 * mb + lr; const float last = cum[jl * CP + chb + dk]; float a[8];
#pragma unroll
            for (int e = 0; e < 8; ++e) { const int j = j0 + e; a[e] = bf2f(kt[ks][mb][e]) * __expf(last - cum[j * CP + chb + dk]); }
            af[mb] = pack8h(a[0], a[1], a[2], a[3], a[4], a[5], a[6], a[7]); }
#pragma unroll
        for (int nb = 0; nb < 4; ++nb) { const unsigned short* t = vt[ks][nb];
            u32x4 w; w.x = t[0] | ((unsigned)t[1] << 16); w.y = t[2] | ((unsigned)t[3] << 16); w.z = t[4] | ((unsigned)t[5] << 16); w.w = t[6] | ((unsigned)t[7] << 16);
            bfr[nb] = __builtin_bit_cast(bf16x8, w); }
#pragma unroll
        for (int mb = 0; mb < 2; ++mb)
#pragma unroll
            for (int nb = 0; nb < 4; ++nb) acc[mb][nb] = MFMA16(af[mb], bfr[nb], acc[mb][nb]);
    }
    const size_t sidx = (size_t)(((b * 2 + dir) * 4 + h) * NCH + cidx);
    float* st = F.ST + sidx * 2048;
#pragma unroll
    for (int mb = 0; mb < 2; ++mb)
#pragma unroll
        for (int nb = 0; nb < 4; ++nb) *(f32x4*)(st + (16 * nb + lr) * 32 + 16 * mb + 4 * g) = acc[mb][nb];
    if (F.lane < 32) F.DEC[sidx * 32 + F.lane] = __expf(cum[jl * CP + chb + F.lane]);
    __syncthreads();
}
__device__ __forceinline__ void gla_scan(Ctx& F) {
    LAS float* xa = (LAS float*)F.lds; LAS float* xb = xa + 512;
    const int seg = F.tid >> 6, el = F.tid & 63;
    for (int blk = blockIdx.x; blk < 512; blk += F.G) {
        const int ge = blk * 64 + el, e = ge & 2047, seq = ge >> 11, dir = (seq >> 2) & 1, dk = e & 31;
        float* st = F.ST + (size_t)seq * NCH * 2048 + e; const float* dc = F.DEC + (size_t)seq * NCH * 32 + dk;
        float u[17], d[17];
#pragma unroll
        for (int i = 0; i < 17; ++i) { const int s = seg * 17 + i; const bool ok = s < NCH; const int sc = ok ? s : NCH - 1; const int c = dir ? (sc < 4 ? 3 - sc : 135 - sc) : sc;
            const float uu = st[(size_t)c * 2048], dd = dc[c * 32]; u[i] = ok ? uu : 0.f; d[i] = ok ? dd : 1.f; }
        float A = 1.f, B = 0.f;
#pragma unroll
        for (int i = 0; i < 17; ++i) { B = B * d[i] + u[i]; A *= d[i]; }
        xa[F.tid] = A; xb[F.tid] = B;
        __syncthreads();
        float S = 0.f;
        for (int sg = 0; sg < seg; ++sg) S = S * xa[sg * 64 + el] + xb[sg * 64 + el];
#pragma unroll
        for (int i = 0; i < 17; ++i) { const int s = seg * 17 + i; if (s < NCH) { const int c = dir ? (s < 4 ? 3 - s : 135 - s) : s; st[(size_t)c * 2048] = S; } S = S * d[i] + u[i]; }
        __syncthreads();
    }
}
template <int NI>
__device__ __forceinline__ void gla_c_item(PP p, Ctx& F, int l, int b, int cidx, int sub) {
    LAS float* cum = (LAS float*)F.lds; const int row0 = chunk_row0(b, cidx);
    const int h = F.wave & 3, half = (NI == 2) ? (F.wave >> 2) : sub, ibase = (NI == 2) ? 0 : (F.wave >> 2), lr = F.lane & 15, g = F.lane >> 4;
    u32x4 wla[4]; la_load(wla, F.PB, row0, F.tid);
    f32x4 o[4][2];
#pragma unroll
    for (int mb = 0; mb < 4; ++mb) { o[mb][0] = (f32x4){0.f, 0.f, 0.f, 0.f}; o[mb][1] = (f32x4){0.f, 0.f, 0.f, 0.f}; }
    bf16x8 av[4][2];
#pragma unroll
    for (int mb = 0; mb < 4; ++mb)
#pragma unroll
        for (int pp = 0; pp < 2; ++pp) { unsigned short t[8];
#pragma unroll
            for (int e = 0; e < 8; ++e) { const int j = 32 * pp + (e < 4 ? 4 * g + e : 16 + 4 * g + (e - 4)); t[e] = F.PB[(size_t)(row0 + j) * NP + PV + h * 64 + 16 * mb + lr]; }
            u32x4 w; w.x = t[0] | ((unsigned)t[1] << 16); w.y = t[2] | ((unsigned)t[3] << 16); w.z = t[4] | ((unsigned)t[5] << 16); w.w = t[6] | ((unsigned)t[7] << 16);
            av[mb][pp] = __builtin_bit_cast(bf16x8, w); }
    u32x4 qraw[2], kraw[4]; f32x4 sraw[2][4][2];
#pragma unroll
    for (int ibl = 0; ibl < NI; ++ibl) qraw[ibl] = *(const u32x4*)(F.PB + (size_t)(row0 + 16 * (2 * half + ibase + ibl) + lr) * NP + PQ + h * 32 + 8 * g);
#pragma unroll
    for (int jb = 0; jb < 4; ++jb) kraw[jb] = *(const u32x4*)(F.PB + (size_t)(row0 + 16 * jb + lr) * NP + PK + h * 32 + 8 * g);
    { const float* st = F.ST + (size_t)(((b * 2 + 0) * 4 + h) * NCH + cidx) * 2048;
#pragma unroll
        for (int mb = 0; mb < 4; ++mb) { sraw[0][mb][0] = *(const f32x4*)(st + (16 * mb + lr) * 32 + 8 * g); sraw[0][mb][1] = *(const f32x4*)(st + (16 * mb + lr) * 32 + 8 * g + 4); } }
    la_scan(cum, wla, F.tid);
    { const float* st = F.ST + (size_t)(((b * 2 + 1) * 4 + h) * NCH + cidx) * 2048;
#pragma unroll
        for (int mb = 0; mb < 4; ++mb) { sraw[1][mb][0] = *(const f32x4*)(st + (16 * mb + lr) * 32 + 8 * g); sraw[1][mb][1] = *(const f32x4*)(st + (16 * mb + lr) * 32 + 8 * g + 4); } }
#pragma unroll
    for (int dir = 0; dir < 2; ++dir) {
        const int chb = dir * 128 + h * 32;
        bf16x8 bq[2];
#pragma unroll
        for (int ibl = 0; ibl < NI; ++ibl) { const int i = 16 * (2 * half + ibase + ibl) + lr;
            const u32x4 qw = qraw[ibl];
            const f32x4 c0 = *(const LAS f32x4*)(cum + i * CP + chb + 8 * g), c1 = *(const LAS f32x4*)(cum + i * CP + chb + 8 * g + 4);
            bq[ibl] = pack8h(bflo(qw.x) * __expf(c0[0]), bfhi(qw.x) * __expf(c0[1]), bflo(qw.y) * __expf(c0[2]), bfhi(qw.y) * __expf(c0[3]),
                            bflo(qw.z) * __expf(c1[0]), bfhi(qw.z) * __expf(c1[1]), bflo(qw.w) * __expf(c1[2]), bfhi(qw.w) * __expf(c1[3])); }
#pragma unroll
        for (int mb = 0; mb < 4; ++mb) { const f32x4 s0 = sraw[dir][mb][0], s1 = sraw[dir][mb][1];
            const bf16x8 as = pack8h(s0[0], s0[1], s0[2], s0[3], s1[0], s1[1], s1[2], s1[3]);
            o[mb][0] = MFMA16(as, bq[0], o[mb][0]); if (NI == 2) o[mb][1] = MFMA16(as, bq[1], o[mb][1]); }
#pragma unroll
        for (int pp = 0; pp < 2; ++pp) {
            if ((dir == 0 && half == 0 && pp == 1) || (dir == 1 && half == 1 && pp == 0)) continue;
            f32x4 sc[2][2];
#pragma unroll
            for (int q = 0; q < 2; ++q) { const int jb = 2 * pp + q, j = 16 * jb + lr;
                const u32x4 kw = kraw[jb];
                const f32x4 c0 = *(const LAS f32x4*)(cum + j * CP + chb + 8 * g), c1 = *(const LAS f32x4*)(cum + j * CP + chb + 8 * g + 4);
                const bf16x8 ak = pack8h(bflo(kw.x) * __expf(-c0[0]), bfhi(kw.x) * __expf(-c0[1]), bflo(kw.y) * __expf(-c0[2]), bfhi(kw.y) * __expf(-c0[3]),
                                        bflo(kw.z) * __expf(-c1[0]), bfhi(kw.z) * __expf(-c1[1]), bflo(kw.w) * __expf(-c1[2]), bfhi(kw.w) * __expf(-c1[3]));
#pragma unroll
                for (int ibl = 0; ibl < NI; ++ibl) { f32x4 z = (f32x4){0.f, 0.f, 0.f, 0.f}; z = MFMA16(ak, bq[ibl], z);
                    const int i = 16 * (2 * half + ibase + ibl) + lr;
#pragma unroll
                    for (int r = 0; r < 4; ++r) { const int jj = 16 * jb + 4 * g + r; const bool keep = dir ? (jj >= i) : (jj <= i); z[r] = keep ? z[r] : 0.f; }
                    sc[q][ibl] = z; } }
#pragma unroll
            for (int ibl = 0; ibl < NI; ++ibl) { const bf16x8 pb = pack8h(sc[0][ibl][0], sc[0][ibl][1], sc[0][ibl][2], sc[0][ibl][3], sc[1][ibl][0], sc[1][ibl][1], sc[1][ibl][2], sc[1][ibl][3]);
#pragma unroll
                for (int mb = 0; mb < 4; ++mb) o[mb][ibl] = MFMA16(av[mb][pp], pb, o[mb][ibl]); }
        }
    }
    const float* gg = p->gla_g + l * 64;
#pragma unroll
    for (int ibl = 0; ibl < NI; ++ibl) { float ss = 0.f;
#pragma unroll
        for (int mb = 0; mb < 4; ++mb) ss += (o[mb][ibl][0] * o[mb][ibl][0] + o[mb][ibl][1] * o[mb][ibl][1]) + (o[mb][ibl][2] * o[mb][ibl][2] + o[mb][ibl][3] * o[mb][ibl][3]);
        ss += shfl_f(ss, F.lane ^ 16); ss += shfl_f(ss, F.lane ^ 32);
        const float rstd = 1.f / sqrtf(ss * (1.f / 64.f) + EPS);
        const int i = 16 * (2 * half + ibase + ibl) + lr; const size_t row = (size_t)(row0 + i);
#pragma unroll
        for (int mb = 0; mb < 4; ++mb) { const int dv = 16 * mb + 4 * g; const f32x4 gv = *(const f32x4*)(gg + dv);
            const u32x2 gw = *(const u32x2*)(F.PB + row * NP + PG + h * 64 + dv);
            const float y0 = o[mb][ibl][0] * rstd * gv[0] * silu_f(bflo(gw.x)), y1 = o[mb][ibl][1] * rstd * gv[1] * silu_f(bfhi(gw.x));
            const float y2 = o[mb][ibl][2] * rstd * gv[2] * silu_f(bflo(gw.y)), y3 = o[mb][ibl][3] * rstd * gv[3] * silu_f(bfhi(gw.y));
            u32x2 w; w.x = pk2(y0, y1); w.y = pk2(y2, y3); *(u32x2*)(F.YMIX + row * D + h * 64 + dv) = w; }
    }
    __syncthreads();
}

template <int NKS, int GRP>
__device__ __forceinline__ void dft_mma_lds(f32x4 (&acc)[8], const LAS unsigned char* fl, int pitchB, const bf16* re, const bf16* im, size_t rstride, int khalf, int lane) {
    const int lr = lane & 15, g = lane >> 4;
#pragma unroll
    for (int k0 = 0; k0 < NKS; k0 += GRP) {
        bf16x8 bfrag[GRP];
#pragma unroll
        for (int kq = 0; kq < GRP; ++kq) { const int ks = k0 + kq; const int kk0 = 32 * ks + 8 * g; const bool part = kk0 >= khalf; const int idx = part ? kk0 - khalf : kk0;
            const bf16* src = (part ? im : re) + (size_t)idx * rstride + lr; unsigned short t[8];
#pragma unroll
            for (int e = 0; e < 8; ++e) t[e] = src[(size_t)e * rstride];
            u32x4 w; w.x = t[0] | ((unsigned)t[1] << 16); w.y = t[2] | ((unsigned)t[3] << 16); w.z = t[4] | ((unsigned)t[5] << 16); w.w = t[6] | ((unsigned)t[7] << 16);
            bfrag[kq] = __builtin_bit_cast(bf16x8, w); }
#pragma unroll
        for (int kq = 0; kq < GRP; ++kq) { const int ks = k0 + kq;
#pragma unroll
            for (int mb = 0; mb < 8; ++mb) { const bf16x8 a = *(const LAS bf16x8*)(fl + (16 * mb + lr) * pitchB + (32 * ks + 8 * g) * 2); acc[mb] = MFMA16(a, bfrag[kq], acc[mb]); }
        }
    }
}
__device__ __forceinline__ void f_to_lds(LAS unsigned char* fl, const bf16* Fm, int rows, int rowB, int tid) {
    const int cpr = rowB >> 4, n = rows * cpr;
    for (int i = tid; i < n; i += 512) { const int r = i / cpr, c = i - r * cpr; *(LAS u32x4*)(fl + r * (rowB + 16) + c * 16) = *(const u32x4*)((const unsigned char*)Fm + (size_t)r * rowB + c * 16); }
    __syncthreads();
}
template <int NKS, int GRP = 4, int NMB = 8>
__device__ __forceinline__ void dft_mma(f32x4 (&acc)[NMB], const bf16* Fm, int ldF, int mrow0, const bf16* re, const bf16* im, size_t rstride, int khalf, int lane) {
    const int lr = lane & 15, g = lane >> 4;
#pragma unroll
    for (int k0 = 0; k0 < NKS; k0 += GRP) {
        bf16x8 bfrag[GRP];
#pragma unroll
        for (int kq = 0; kq < GRP; ++kq) { const int ks = k0 + kq; const int kk0 = 32 * ks + 8 * g; const bool part = kk0 >= khalf; const int idx = part ? kk0 - khalf : kk0;
            const bf16* src = (part ? im : re) + (size_t)idx * rstride + lr; unsigned short t[8];
#pragma unroll
            for (int e = 0; e < 8; ++e) t[e] = src[(size_t)e * rstride];
            u32x4 w; w.x = t[0] | ((unsigned)t[1] << 16); w.y = t[2] | ((unsigned)t[3] << 16); w.z = t[4] | ((unsigned)t[5] << 16); w.w = t[6] | ((unsigned)t[7] << 16);
            bfrag[kq] = __builtin_bit_cast(bf16x8, w); }
#pragma unroll
        for (int kq = 0; kq < GRP; ++kq) { const int ks = k0 + kq;
            bf16x8 a[NMB];
#pragma unroll
            for (int mb = 0; mb < NMB; ++mb) a[mb] = *(const bf16x8*)(Fm + (size_t)(mrow0 + 16 * mb + lr) * ldF + 32 * ks + 8 * g);
#pragma unroll
            for (int mb = 0; mb < NMB; ++mb) acc[mb] = MFMA16(a[mb], bfrag[kq], acc[mb]);
            if (kq & 1) __builtin_amdgcn_sched_barrier(0);
        }
    }
}
__device__ __forceinline__ void dft_mma_loop(f32x4 (&acc)[8], const bf16* Fm, int ldF, int mrow0, int nks, const bf16* re, const bf16* im, size_t rstride, int khalf, int lane) {
    const int lr = lane & 15, g = lane >> 4;
#pragma unroll 1
    for (int ks = 0; ks < nks; ++ks) { const int kk0 = 32 * ks + 8 * g; const bool part = kk0 >= khalf; const int idx = part ? kk0 - khalf : kk0;
        const bf16* src = (part ? im : re) + (size_t)idx * rstride + lr; unsigned short t[8];
#pragma unroll
        for (int e = 0; e < 8; ++e) t[e] = src[(size_t)e * rstride];
        u32x4 w; w.x = t[0] | ((unsigned)t[1] << 16); w.y = t[2] | ((unsigned)t[3] << 16); w.z = t[4] | ((unsigned)t[5] << 16); w.w = t[6] | ((unsigned)t[7] << 16);
        const bf16x8 bfrag = __builtin_bit_cast(bf16x8, w);
#pragma unroll
        for (int mb = 0; mb < 8; ++mb) { const bf16x8 a = *(const bf16x8*)(Fm + (size_t)(mrow0 + 16 * mb + lr) * ldF + 32 * ks + 8 * g); acc[mb] = MFMA16(a, bfrag, acc[mb]); }
    }
}
__device__ __forceinline__ void fft_stage1(Ctx& F) {
    const int lr = F.lane & 15, g = F.lane >> 4;
    f_to_lds(F.lds, F.F1, 128, 256, F.tid);
    for (int it = F.gw; it < 4096; it += F.NGW) { const int cb = it & 15, n2 = (it >> 4) & 127, b = it >> 11;
        f32x4 acc[8];
#pragma unroll
        for (int mb = 0; mb < 8; ++mb) acc[mb] = (f32x4){0.f, 0.f, 0.f, 0.f};
        const bf16* re = F.PB + (size_t)(b * SEQ + n2) * NP + PFA + 16 * cb;
        dft_mma_lds<4, 4>(acc, F.lds, 272, re, re + 256, (size_t)128 * NP, 64, F.lane);
#pragma unroll
        for (int mb = 0; mb < 4; ++mb)
#pragma unroll
            for (int r = 0; r < 4; ++r) { const int k1 = 16 * mb + 4 * g + r; const float a = (float)(k1 * n2) * (1.f / 8192.f); const float c = cos_rev(a), s = sin_rev(a);
                const float tr = acc[mb][r], ti = acc[mb + 4][r]; const float xr = tr * c + ti * s, xi = ti * c - tr * s;
                bf16* dst = F.TB + ((size_t)((b * 64 + k1) * 2) * 128 + n2) * 256 + 16 * cb + lr;
                dst[0] = (bf16)f2bf(xr); dst[(size_t)128 * 256] = (bf16)f2bf(xi); }
    }
}
__device__ __forceinline__ void fft_stage2(Ctx& F, int l) {
    const int lr = F.lane & 15, g = F.lane >> 4;
    f_to_lds(F.lds, F.F2, 128, 512, F.tid);
    for (int it = F.gw; it < 2048; it += F.NGW) {
        f32x4 acc[8];
#pragma unroll
        for (int mb = 0; mb < 8; ++mb) acc[mb] = (f32x4){0.f, 0.f, 0.f, 0.f};
        const int cb = it & 15, k1 = (it >> 4) & 63, b = it >> 10;
        const bf16* re = F.TB + (size_t)((b * 64 + k1) * 2) * 128 * 256 + 16 * cb;
        dft_mma_lds<8, 4>(acc, F.lds, 528, re, re + (size_t)128 * 256, 256, 128, F.lane);
#pragma unroll
        for (int mb = 0; mb < 8; ++mb)
#pragma unroll
            for (int r = 0; r < 4; ++r) { const int k2 = 16 * mb + 4 * g + r; F.YMIX[(size_t)(b * SEQ + k1 + 64 * k2) * D + 256 + 16 * cb + lr] = (bf16)f2bf(acc[mb][r]); }
    }
    __syncthreads();
}
__device__ __forceinline__ void ctx_dft(Ctx& F, int w0, int nw) {
    const int lr = F.lane & 15, g = F.lane >> 4;
    for (int it = w0; it >= 0 && it < 256; it += nw) { const int mq = it & 7, cb = (it >> 3) & 15, b = it >> 7;
            f32x4 acc[2] = {(f32x4){0.f, 0.f, 0.f, 0.f}, (f32x4){0.f, 0.f, 0.f, 0.f}};
            const bf16* re = F.PB + (size_t)(ML + b * CTXL) * NP + PFA + 16 * cb;
            dft_mma<8, 4, 2>(acc, F.FC, 512, 32 * mq, re, re, (size_t)NP, 256, F.lane); __builtin_amdgcn_sched_barrier(0);
            dft_mma<8, 4, 2>(acc, F.FC + 256, 512, 32 * mq, re + 256, re + 256, (size_t)NP, 256, F.lane);
#pragma unroll
            for (int mb = 0; mb < 2; ++mb)
#pragma unroll
                for (int r = 0; r < 4; ++r) { const int k = 32 * mq + 16 * mb + 4 * g + r; F.YMIX[(size_t)(ML + b * CTXL + k) * D + 256 + 16 * cb + lr] = (bf16)f2bf(acc[mb][r]); }
        }
}
__device__ __forceinline__ void load8(const bf16* q, float (&v)[8]) { const u32x4 w = *(const u32x4*)q; v[0] = bflo(w.x); v[1] = bfhi(w.x); v[2] = bflo(w.y); v[3] = bfhi(w.y); v[4] = bflo(w.z); v[5] = bfhi(w.z); v[6] = bflo(w.w); v[7] = bfhi(w.w); }
__device__ __forceinline__ void store8(bf16* q, const float (&v)[8]) { u32x4 w; w.x = pk2(v[0], v[1]); w.y = pk2(v[2], v[3]); w.z = pk2(v[4], v[5]); w.w = pk2(v[6], v[7]); *(u32x4*)q = w; }
__device__ __forceinline__ u32x4 ldrow(const bf16* base, int rbase, int t, int n, int col) { const int tc = t < 0 ? 0 : (t > n - 1 ? n - 1 : t); return *(const u32x4*)(base + (size_t)(rbase + tc) * NP + col); }
__device__ __forceinline__ void unpack8(const u32x4 w, float (&v)[8]) { v[0] = bflo(w.x); v[1] = bfhi(w.x); v[2] = bflo(w.y); v[3] = bfhi(w.y); v[4] = bflo(w.z); v[5] = bfhi(w.z); v[6] = bflo(w.w); v[7] = bfhi(w.w); }
__device__ __forceinline__ void convpool_item(PP p, Ctx& F, int l, int it) {
    int rbase, n, t0;
    if (it < 256) { rbase = it * 64; n = 64; t0 = 0; } else { const int sg = it - 256; rbase = ML + (sg >> 2) * CTXL; n = CTXL; t0 = (sg & 3) * 64; }
    const int oct = F.tid & 31, tl = F.tid >> 5, c0 = 8 * oct, tb = t0 + tl * 4;
    {
        u32x4 hw_[6], cw_[6], bw_[4];
#pragma unroll
        for (int i = 0; i < 6; ++i) { hw_[i] = ldrow(F.PB, rbase, tb - 1 + i, n, PH + c0); cw_[i] = ldrow(F.PB, rbase, tb - 1 + i, n, PCG + c0); }
#pragma unroll
        for (int q = 0; q < 4; ++q) bw_[q] = ldrow(F.PB, rbase, tb + q, n, PBG + c0);
        const f32x4 w0a = *(const f32x4*)(p->conv_w + (l * 3 + 0) * 256 + c0), w0b = *(const f32x4*)(p->conv_w + (l * 3 + 0) * 256 + c0 + 4);
        const f32x4 w1a = *(const f32x4*)(p->conv_w + (l * 3 + 1) * 256 + c0), w1b = *(const f32x4*)(p->conv_w + (l * 3 + 1) * 256 + c0 + 4);
        const f32x4 w2a = *(const f32x4*)(p->conv_w + (l * 3 + 2) * 256 + c0), w2b = *(const f32x4*)(p->conv_w + (l * 3 + 2) * 256 + c0 + 4);
        const f32x4 cba = *(const f32x4*)(p->conv_b + l * 256 + c0), cbb = *(const f32x4*)(p->conv_b + l * 256 + c0 + 4);
        float hc[6][8];
#pragma unroll
        for (int i = 0; i < 6; ++i) { float a[8], b[8]; unpack8(hw_[i], a); unpack8(cw_[i], b); const int t = tb - 1 + i; const float msk = (t >= 0 && t < n) ? 1.f : 0.f;
#pragma unroll
            for (int e = 0; e < 8; ++e) hc[i][e] = a[e] * b[e] * msk; }
#pragma unroll
        for (int q = 0; q < 4; ++q) { float bg[8], y[8]; unpack8(bw_[q], bg);
#pragma unroll
            for (int e = 0; e < 8; ++e) { const float w0 = e < 4 ? w0a[e & 3] : w0b[e & 3], w1 = e < 4 ? w1a[e & 3] : w1b[e & 3], w2 = e < 4 ? w2a[e & 3] : w2b[e & 3], cb = e < 4 ? cba[e & 3] : cbb[e & 3];
                y[e] = bg[e] * (w0 * hc[q][e] + w1 * hc[q + 1][e] + w2 * hc[q + 2][e] + cb); }
            store8(F.YMIX + (size_t)(rbase + tb + q) * D + 512 + c0, y); }
    }
    __builtin_amdgcn_sched_barrier(0);
    {
        const int wnd = 2 << (oct >> 3), hw = wnd >> 1;
        float s[4][8], self[4][8];
#pragma unroll
        for (int q = 0; q < 4; ++q) { unpack8(ldrow(F.PB, rbase, tb + q, n, PPOOL + c0), self[q]);
#pragma unroll
            for (int e = 0; e < 8; ++e) s[q][e] = 0.f; }
        __builtin_amdgcn_sched_barrier(0);
#pragma unroll
        for (int bt = 0; bt < 19; bt += 7) {
            u32x4 pw[7];
#pragma unroll
            for (int ii = 0; ii < 7; ++ii) if (bt + ii < 19) pw[ii] = ldrow(F.PB, rbase, tb - hw + bt + ii, n, PPOOL + c0);
#pragma unroll
            for (int ii = 0; ii < 7; ++ii) if (bt + ii < 19) { const int i = bt + ii; float v[8]; unpack8(pw[ii], v); const int t = tb - hw + i; const bool inr = (t >= 0 && t < n);
#pragma unroll
                for (int q = 0; q < 4; ++q) { const float mk = (inr && i >= q && i < q + wnd) ? 1.f : 0.f;
#pragma unroll
                    for (int e = 0; e < 8; ++e) s[q][e] += mk * v[e]; } }
            __builtin_amdgcn_sched_barrier(0);
        }
#pragma unroll
        for (int q = 0; q < 4; ++q) { const int t = tb + q; const int lo = (t - hw > 0) ? t - hw : 0, hi = (t + hw - 1 < n - 1) ? t + hw - 1 : n - 1; const float inv = 1.f / (float)(hi - lo + 1);
            float y[8];
#pragma unroll
            for (int e = 0; e < 8; ++e) y[e] = s[q][e] * inv - self[q][e];
            store8(F.YMIX + (size_t)(rbase + t) * D + 768 + c0, y); }
    }
}
__device__ __forceinline__ void ctx_act(PP p, Ctx& F, int l) {
    const int gt = blockIdx.x * 512 + F.tid, NT = F.G * 512;
    for (int i = gt; i < MC * 352; i += NT) { const int oc = i % 352, rc = i / 352, t = rc & 255, c0 = 8 * oc;
        const bf16* base = F.CAU + (size_t)rc * NUP + c0; float a[8], y[8], u[8];
        const float* cw = p->ffn_cw + (size_t)l * 3 * DFF + c0; const float* cb = p->ffn_cb + (size_t)l * DFF + c0;
#pragma unroll
        for (int e = 0; e < 8; ++e) y[e] = cb[e];
        if (t > 0) { load8(base - NUP, a);
#pragma unroll
            for (int e = 0; e < 8; ++e) y[e] += cw[e] * a[e]; }
        load8(base, a);
#pragma unroll
        for (int e = 0; e < 8; ++e) y[e] += cw[DFF + e] * a[e];
        if (t < 255) { load8(base + NUP, a);
#pragma unroll
            for (int e = 0; e < 8; ++e) y[e] += cw[2 * DFF + e] * a[e]; }
        load8(base + DFF, u);
#pragma unroll
        for (int e = 0; e < 8; ++e) y[e] = silu_f(y[e]) * u[e];
        store8(F.ACT + (size_t)(ML + rc) * DFF + c0, y);
    }
}
__global__ void __launch_bounds__(512, 2) fwd_megakernel(Params p_) {
    PP p = (PP)__builtin_amdgcn_kernarg_segment_ptr();
    extern __shared__ __attribute__((aligned(16))) unsigned char lds_raw[];
    cg::grid_group grid = cg::this_grid();
    Ctx F;
    F.lds = (LAS unsigned char*)lds_raw; F.tid = threadIdx.x; F.lane = F.tid & 63; F.wave = __builtin_amdgcn_readfirstlane(F.tid >> 6);
    const int wave_s = F.wave;
    F.G = gridDim.x; F.gw = blockIdx.x * 8 + F.wave; F.NGW = F.G * 8;
    unsigned char* ws = p->ws;
#define SETPTRS() do { { PP q_ = (PP)__builtin_amdgcn_kernarg_segment_ptr(); asm volatile("" : "+s"(q_)); p = q_; } unsigned char* w_ = p->ws; asm volatile("" : "+s"(w_)); \
    F.MOD = (float*)(w_ + WS_MOD); F.MCS = (float*)(w_ + WS_MCS); F.F1 = (bf16*)(w_ + WS_F1); F.F2 = (bf16*)(w_ + WS_F2); F.FC = (bf16*)(w_ + WS_FC); \
    F.HX = (bf16*)(w_ + WS_HX); F.TB = (bf16*)(w_ + WS_HX); F.YMIX = (bf16*)(w_ + WS_YMIX); F.PB = (bf16*)(w_ + WS_P); F.ACT = (bf16*)(w_ + WS_P); \
    F.XC = (float*)(w_ + WS_XC); F.ST = (float*)(w_ + WS_ST); F.DEC = (float*)(w_ + WS_DEC); F.CAU = (bf16*)(w_ + WS_CAU); } while (0)
    SETPTRS();

#ifndef NO_P0
#define REFRESH() do { int t_; asm volatile("v_mbcnt_lo_u32_b32 %0, -1, 0\n\tv_mbcnt_hi_u32_b32 %0, -1, %0" : "=v"(t_)); t_ |= (wave_s << 6); F.tid = t_; F.lane = t_ & 63; F.wave = __builtin_amdgcn_readfirstlane(t_ >> 6); F.gw = blockIdx.x * 8 + F.wave; SETPTRS(); } while (0)
    { volatile LAS unsigned* misc = (volatile LAS unsigned*)(F.lds + RING_BYTES); if (F.tid < 64) misc[F.tid] = 0u; }
    __syncthreads();
    XcdBarrier bar = xcd_barrier_post((unsigned*)(ws + WS_CTL), (volatile LAS unsigned*)(F.lds + RING_BYTES) + 8, F.tid);
#define GSYNC() do { REFRESH(); xcd_barrier(bar, F.tid); } while (0)
    REFRESH();
    phase0(p, F);
#endif
    if (p->ws == nullptr) grid.sync();
    GSYNC();
#define L0() ({ int lq_ = l; asm volatile("" : "+s"(lq_)); lq_ == 0; })
    for (int l = 0; l < 2; ++l) {
        const int M6 = L0() ? MT : ML;
#ifndef NO_P1
        REFRESH();
        norm_phase(p, F, l, 0, MT);
        REFRESH();
        if (L0()) fold_items(p, F);
#ifdef PROBE_B
        REFRESH(); norm_phase(p, F, l, 0, MT); if (L0()) fold_items(p, F);
#endif
#endif
        GSYNC();
#ifndef NO_P2
        REFRESH();
        { pg8::Gemm g{F.HX, win_t(p, l), MT, NP, D, D}; pg8::StaticOrder S; S.init(MT, NP, F.G, (int)blockIdx.x);
          EpiP E{F.PB, p->b_a2 + l * 256};
          pg8::gemm_phase<EpiP, pg8::StaticOrder, true, true>(F.lds, g, S, E, F.tid);
#ifdef PROBE_C
          __syncthreads(); pg8::gemm_phase<EpiP, pg8::StaticOrder, true, true>(F.lds, g, S, E, F.tid);
#endif
        }
#endif
        GSYNC();
#ifdef PROBE_A
        for (int rep_ = 0; rep_ < 2; ++rep_) {
#else
        {
#endif
#ifndef NO_GA
        REFRESH();
        for (int it = blockIdx.x; it < 2 * NCH; it += F.G) gla_a_item(F, it / NCH, it % NCH);
#ifdef PR_GA
        __syncthreads(); REFRESH();
        for (int it = blockIdx.x; it < 2 * NCH; it += F.G) gla_a_item(F, it / NCH, it % NCH);
#endif
#endif
#ifndef NO_F1
        REFRESH();
        fft_stage1(F);
#ifdef PR_F1
        __syncthreads(); REFRESH();
        fft_stage1(F);
#endif
#endif
#ifndef NO_CP
        REFRESH();
        for (int v = blockIdx.x; v < 512; v += F.G) { const int it = (v < 256) ? v : 256 + ((v + 248) & 255);
            if (it >= (L0() ? 264 : 256)) continue; convpool_item(p, F, l, it); }
#ifdef PR_CP
        __syncthreads(); REFRESH();
        for (int v = blockIdx.x; v < 512; v += F.G) { const int it = (v < 256) ? v : 256 + ((v + 248) & 255);
            if (it >= (L0() ? 264 : 256)) continue; convpool_item(p, F, l, it); }
#endif
#endif
        }
        GSYNC();
#ifdef PROBE_A
        REFRESH(); fft_stage2(F, l);
#endif
#ifndef NO_F2
        REFRESH();
        fft_stage2(F, l);
#ifdef PR_F2
        __syncthreads(); REFRESH();
        fft_stage2(F, l);
#endif
#endif
#ifndef NO_SC
        REFRESH();
        gla_scan(F);
#endif
        GSYNC();
#ifdef PROBE_A
        for (int rep_ = 0; rep_ < 2; ++rep_) {
#else
        {
#endif
#ifndef NO_GC
        REFRESH();
        for (int it = blockIdx.x; it < 256; it += F.G) gla_c_item<2>(p, F, l, it >> 7, 4 + (it & 127), 0);
        if (L0()) for (int j = blockIdx.x; j < 16; j += F.G) gla_c_item<1>(p, F, l, j >> 3, (j >> 1) & 3, j & 1);
        if (L0()) { if (F.G == 256) ctx_dft(F, F.gw - 256, 1 << 30); else ctx_dft(F, F.gw, F.NGW); }
#ifdef PR_GC
        __syncthreads(); REFRESH();
        for (int it = blockIdx.x; it < 256; it += F.G) gla_c_item<2>(p, F, l, it >> 7, 4 + (it & 127), 0);
#endif
#endif
        }
        GSYNC();
#ifndef NO_P6
        REFRESH();
        if (L0()) { pg8::Gemm g{F.YMIX, wout_t(p, l), MT, D, 256, D}; SplitOrder S; S.init(4, F.G, (int)blockIdx.x);
          EpiPartial E{(float*)(p->ws + WS_PART)};
          pg8::gemm_phase<EpiPartial, SplitOrder, false, false>(F.lds, g, S, E, F.tid); __syncthreads(); }
        REFRESH();
        { pg8::Gemm g{F.YMIX, wout_t(p, l), ML, D, D, D}; pg8::StaticOrder S; S.init(ML, D, F.G, (int)blockIdx.x);
          if (L0()) { EpiRes<false, true> E{p->x, p->out, F.MOD + l * 3 * 6144 + 2048}; pg8::gemm_phase<EpiRes<false, true>, pg8::StaticOrder, true, true>(F.lds, g, S, E, F.tid); }
          else if (F.G == 256) { EpiResNorm E{(const bf16*)p->out, (bf16*)(p->ws + WS_XB2), F.HX, F.MOD + l * 3 * 6144 + 2048, p->norm2_g + l * D, F.MOD + l * 3 * 6144, (float*)(p->ws + WS_SLOT) + 65536 * 2, (unsigned*)(p->ws + WS_CTL) + CW_FIN + 4096};
            pg8::gemm_phase<EpiResNorm, pg8::StaticOrder, false, true>(F.lds, g, S, E, F.tid); }
          else { EpiRes<true, true> E{p->out, p->out, F.MOD + l * 3 * 6144 + 2048}; pg8::gemm_phase<EpiRes<true, true>, pg8::StaticOrder, true, true>(F.lds, g, S, E, F.tid); } }
#endif
        GSYNC();
        if (L0() || F.G != 256) { REFRESH(); norm_phase(p, F, l, 1, M6); GSYNC(); }
#ifndef NO_P8
        REFRESH();
        { pg8::Gemm g{F.HX, wup_t(p, l), ML, NUP, D, D}; pg8::StaticOrder S; S.init(ML, NUP, F.G, (int)blockIdx.x);
          EpiUp E{F.ACT, p->ffn_cw + (size_t)l * 3 * DFF, p->ffn_cb + (size_t)l * DFF};
          pg8::gemm_phase<EpiUp, pg8::StaticOrder, true, true>(F.lds, g, S, E, F.tid);
        }
        if (L0()) { REFRESH(); __syncthreads();
          pg8::Gemm g{F.HX, wup_t(p, l), MT, NUP, D, D}; CtxOrder S; S.init(NUP, (int)blockIdx.x, 128);
          EpiUpCtx E{F.ACT, p->ffn_cw + (size_t)l * 3 * DFF, p->ffn_cb + (size_t)l * DFF, (LAS float*)(F.lds + RING_BYTES + 1024)};
          pg8::gemm_phase<EpiUpCtx, CtxOrder, true, false>(F.lds, g, S, E, F.tid); }
#endif
        GSYNC();
#ifndef NO_P9
        REFRESH();
        if (L0()) { pg8::Gemm g{F.ACT, wdn_t(p, l), MT, D, 256, DFF}; SplitOrder S; S.init(11, F.G, (int)blockIdx.x);
          EpiPartial E{(float*)(p->ws + WS_PART)};
          pg8::gemm_phase<EpiPartial, SplitOrder, false, false>(F.lds, g, S, E, F.tid); __syncthreads(); }
        REFRESH();
        { pg8::Gemm g{F.ACT, wdn_t(p, l), ML, D, DFF, DFF}; pg8::StaticOrder S; S.init(ML, D, F.G, (int)blockIdx.x);
          if (L0()) { EpiRes<true, true> E{p->out, p->out, F.MOD + l * 3 * 6144 + 5120}; pg8::gemm_phase<EpiRes<true, true>, pg8::StaticOrder, true, true>(F.lds, g, S, E, F.tid); }
          else if (F.G == 256) { EpiFinal E{(const bf16*)(p->ws + WS_XB2), p->out, F.MOD + l * 3 * 6144 + 5120, p->final_g, (float*)(p->ws + WS_SLOT), (unsigned*)(p->ws + WS_CTL) + CW_FIN};
            pg8::gemm_phase<EpiFinal, pg8::StaticOrder, false, true>(F.lds, g, S, E, F.tid); }
          else { EpiRes<true, false> E{p->out, p->ws + WS_HX, F.MOD + l * 3 * 6144 + 5120}; pg8::gemm_phase<EpiRes<true, false>, pg8::StaticOrder, true, true>(F.lds, g, S, E, F.tid); } }
#endif
        if (L0() || F.G != 256) GSYNC();
    }
        REFRESH();
    if (F.G != 256) final_norm(p, F);
}

extern "C" void kernel_launch(void* const* d_in, const int* in_sizes, int n_in, void* d_out, int out_size, void* d_ws, size_t ws_size, hipStream_t stream) {
    static int grid = 0;
    if (grid == 0) {
        if (n_in != 23 || in_sizes[0] != ML * D || out_size != ML * D || ws_size < WS_END) { fprintf(stderr, "kernel_launch: unexpected shapes / workspace (%d inputs, ws %zu)\n", n_in, ws_size); grid = -1; return; }
        int dev = 0, cus = 0, per_cu = 0;
        hipGetDevice(&dev); hipDeviceGetAttribute(&cus, hipDeviceAttributeMultiprocessorCount, dev);
        if (hipFuncSetAttribute((const void*)fwd_megakernel, hipFuncAttributeMaxDynamicSharedMemorySize, LDS_BYTES) != hipSuccess) { fprintf(stderr, "hipFuncSetAttribute failed\n"); grid = -1; return; }
        if (hipOccupancyMaxActiveBlocksPerMultiprocessor(&per_cu, (const void*)fwd_megakernel, 512, LDS_BYTES) != hipSuccess || per_cu < 1) per_cu = 1;
        (void)hipGetLastError();
        grid = cus * 1;
    }
    if (grid < 0) return;
    if (hipMemsetAsync((char*)d_ws + WS_CTL, 0, 65536, stream) != hipSuccess) { fprintf(stderr, "memset failed\n"); return; }
    Params p{};
    const float** pp = (const float**)&p;
    for (int i = 0; i < 23; ++i) pp[i] = (const float*)d_in[i];
    p.out = (float*)d_out; p.ws = (unsigned char*)d_ws;
    void* args[] = {&p};
    hipError_t e = hipLaunchCooperativeKernel((const void*)fwd_megakernel, dim3(grid), dim3(512), args, LDS_BYTES, stream);
    if (e != hipSuccess) fprintf(stderr, "cooperative launch failed: %s (grid %d)\n", hipGetErrorString(e), grid);
}
```

```cpp
#include <hip/hip_runtime.h>
#include <hip/hip_cooperative_groups.h>
#include <cstdio>
#include <cstdint>
namespace cg = cooperative_groups;
namespace pg8 {
#define PG8_LAS __attribute__((address_space(3)))
typedef unsigned short bf16_t;
typedef short bf16x8 __attribute__((ext_vector_type(8)));
typedef float f32x4 __attribute__((ext_vector_type(4)));
typedef unsigned u32x4 __attribute__((ext_vector_type(4)));
constexpr int BM = 256, BK = 64, HALF = 128, HTB = HALF * BK * 2  , STAGE_BYTES = 8 * HTB, NXCD = 8, WGM = 8;

__host__ __device__ __forceinline__ int lds_byte(int r, int c) { const int st = (r >> 4) * 2 + (c >> 5), rr = r & 15, cc = c & 31, ob = rr * 64 + cc * 2; return st * 1024 + (ob ^ (((ob >> 9) & 1) << 5)); }
__host__ __device__ __forceinline__ void stage_rc(int b, int& R, int& C) { const int st = b / 1024, sb = b % 1024, swz = sb ^ (((sb >> 9) & 1) << 5); R = (st >> 1) * 16 + swz / 64; C = (st & 1) * 32 + (swz % 64) / 2; }
__host__ __device__ __forceinline__ int perm32(int rho) { const int n = rho >> 4, i = rho & 15; return 8 * (i >> 2) + 4 * n + (i & 3); }

struct Unit { int pm, pn, ks; };
struct Gemm { const bf16_t* A; const bf16_t* Bt; int M, N, K, ld; };

struct StaticOrder {
    int nM, nN, nwg, G, c;
    __host__ __device__ void init(int M, int N, int G_, int c_) { nM = M / BM; nN = N / BM; nwg = nM * nN; G = G_; c = c_; }
    __host__ __device__ bool next(int i, Unit& u) const {
        const long L = (long)i * G + c; if (L >= nwg) return false;
        int wgid = (int)L; { const int q = nwg / NXCD, r = nwg % NXCD, xcd = wgid % NXCD, off = wgid / NXCD; wgid = (xcd < r ? xcd * (q + 1) : r * (q + 1) + (xcd - r) * q) + off; }
        const int nig = WGM * nN, gid = wgid / nig, fm = gid * WGM, gsz = (nM - fm) < WGM ? (nM - fm) : WGM;
        u.pm = fm + ((wgid % nig) % gsz); u.pn = (wgid % nig) / gsz; u.ks = 0; return true;
    }
    __device__ __forceinline__ void a_ready(const Unit&) const {}
    __device__ __forceinline__ void done(const Unit&) const {}
};

__device__ __forceinline__ unsigned cvt_pk_bf16(float lo, float hi) { unsigned r; asm volatile("v_cvt_pk_bf16_f32 %0, %1, %2" : "=v"(r) : "v"(lo), "v"(hi)); return r; }
template <class Epi, class Sched, bool ALIGN_EPI = false, bool SP2 = false>
__device__ __forceinline__ void gemm_phase(PG8_LAS unsigned char* lds, const Gemm g, const Sched& S, const Epi& E, int tid_in) {
    int tid_ = tid_in; asm volatile("" : "+v"(tid_)); const int tid = tid_, wid = __builtin_amdgcn_readfirstlane(tid >> 6), lane = tid & 63, wr = wid >> 2, wc = wid & 3, fr = lane & 15, fq = lane >> 4;
    const int K = g.ld, nt = g.K / BK; const size_t sstep = (size_t)g.K * 2;
    unsigned voffA[2], voffB[2];
#pragma unroll
    for (int i = 0; i < 2; ++i) { int R, C; stage_rc(tid * 16 + i * 8192, R, C); const int Rb = Epi::PERM ? ((R & ~31) + perm32(R & 31)) : R;
        voffA[i] = (unsigned)(R * K + C) * 2u; voffB[i] = (unsigned)(Rb * K + C) * 2u; }
    const size_t kstep = (size_t)(BK * 2);
    const size_t hstep = (size_t)HALF * K * 2;
    const size_t tstep = 2 * hstep;
    const unsigned ldsw = (unsigned)wid * 1024u;
    const int aoff = lds_byte(wr * 64 + fr, fq * 8), boff = lds_byte(wc * 32 + fr, fq * 8);
#define PG8_SA(b, h) (((b) * 2 + (h)) * HTB)
#define PG8_SB(b, h) ((4 + (b) * 2 + (h)) * HTB)
#define PG8_STAGE(bufoff, gbase, voff) do { _Pragma("unroll") for (int _i = 0; _i < 2; ++_i) \
        __builtin_amdgcn_global_load_lds((const unsigned*)((const char*)(gbase) + (voff)[_i]), (PG8_LAS unsigned*)(lds + (bufoff) + ldsw + _i * 8192), 16, 0, 0); } while (0)
#define PG8_LDA(dst, b, h) do { _Pragma("unroll") for (int m = 0; m < 4; ++m) _Pragma("unroll") for (int k = 0; k < 2; ++k) dst[m][k] = *(const PG8_LAS bf16x8*)(lds + PG8_SA(b, h) + aoff + m * 2048 + k * 1024); } while (0)
#define PG8_LDB(dst, b, h) do { _Pragma("unroll") for (int n = 0; n < 2; ++n) _Pragma("unroll") for (int k = 0; k < 2; ++k) dst[n][k] = *(const PG8_LAS bf16x8*)(lds + PG8_SB(b, h) + boff + n * 2048 + k * 1024); } while (0)
#define PG8_MMA(ai, bj, At, Bt) do { __builtin_amdgcn_s_setprio(1); _Pragma("unroll") for (int m = 0; m < 4; ++m) _Pragma("unroll") for (int n = 0; n < 2; ++n) _Pragma("unroll") for (int k = 0; k < 2; ++k) \
        acc[ai][bj][m][n] = __builtin_amdgcn_mfma_f32_16x16x32_bf16(Bt[n][k], At[m][k], acc[ai][bj][m][n], 0, 0, 0); __builtin_amdgcn_s_setprio(0); } while (0)
#define PG8_WAIT_V(n) asm volatile("s_waitcnt vmcnt(" #n ")" ::: "memory")
#define PG8_WAIT_L(n) asm volatile("s_waitcnt lgkmcnt(" #n ")" ::: "memory")
#define PG8_BAR __builtin_amdgcn_s_barrier()
#define PG8_SCHED __builtin_amdgcn_sched_barrier(0)
    Unit cur, nxt; int ui = 0;
    if (!S.next(0, cur)) return;
    f32x4 acc[2][2][4][2];
#pragma unroll
    for (int a = 0; a < 2; ++a)
#pragma unroll
        for (int b = 0; b < 2; ++b)
#pragma unroll
            for (int m = 0; m < 4; ++m)
#pragma unroll
                for (int n = 0; n < 2; ++n) acc[a][b][m][n] = (f32x4){0.f, 0.f, 0.f, 0.f};
    bf16x8 At[4][2], B0[2][2], B1[2][2];
    const char* cA = (const char*)g.A + (size_t)cur.pm * tstep + (size_t)cur.ks * sstep; const char* cB = (const char*)g.Bt + (size_t)cur.pn * tstep + (size_t)cur.ks * sstep;
    S.a_ready(cur);
    if constexpr (SP2) {
        PG8_STAGE(PG8_SB(0, 0), cB, voffB); PG8_STAGE(PG8_SB(0, 1), cB + hstep, voffB); PG8_STAGE(PG8_SA(0, 0), cA, voffA); PG8_STAGE(PG8_SA(0, 1), cA + hstep, voffA);
        if (wr == 1) PG8_BAR;
        PG8_WAIT_V(2); PG8_BAR;
        PG8_STAGE(PG8_SB(1, 0), cB + kstep, voffB); PG8_STAGE(PG8_SA(1, 0), cA + kstep, voffA); PG8_STAGE(PG8_SB(1, 1), cB + hstep + kstep, voffB);
        PG8_WAIT_V(6); PG8_BAR;
    } else {
        PG8_STAGE(PG8_SB(0, 0), cB, voffB); PG8_STAGE(PG8_SA(0, 0), cA, voffA); PG8_STAGE(PG8_SB(0, 1), cB + hstep, voffB); PG8_STAGE(PG8_SA(0, 1), cA + hstep, voffA);
        if (wr == 1) PG8_BAR;
        PG8_WAIT_V(4); PG8_BAR;
        PG8_STAGE(PG8_SB(1, 0), cB + kstep, voffB); PG8_STAGE(PG8_SA(1, 0), cA + kstep, voffA); PG8_STAGE(PG8_SB(1, 1), cB + hstep + kstep, voffB);
        PG8_WAIT_V(6); PG8_BAR;
    }
    for (;;) {
        const bool has_next = S.next(ui + 1, nxt);
        const char* nA = has_next ? (const char*)g.A + (size_t)nxt.pm * tstep + (size_t)nxt.ks * sstep : cA; const char* nB = has_next ? (const char*)g.Bt + (size_t)nxt.pn * tstep + (size_t)nxt.ks * sstep : cB;
        for (int t = 0; t < nt; t += 2) {
            const bool last = (t == nt - 2);
            const char* a1 = cA + (size_t)(t + 1) * kstep;
            const char* a2 = last ? nA : cA + (size_t)(t + 2) * kstep; const char* b2 = last ? nB : cB + (size_t)(t + 2) * kstep;
            const char* a3 = a2 + kstep; const char* b3 = b2 + kstep;
            if (last && has_next) S.a_ready(nxt);
            if constexpr (SP2) {
            PG8_LDB(B0, 0, 0); PG8_LDB(B1, 0, 1); PG8_SCHED; PG8_LDA(At, 0, 0); PG8_STAGE(PG8_SA(1, 1), a1 + hstep, voffA);
            PG8_WAIT_V(8); PG8_WAIT_L(0); PG8_BAR; PG8_MMA(0, 0, At, B0); PG8_MMA(0, 1, At, B1); PG8_BAR; PG8_SCHED;
            PG8_LDA(At, 0, 1); PG8_STAGE(PG8_SB(0, 0), b2, voffB); PG8_STAGE(PG8_SB(0, 1), b2 + hstep, voffB); PG8_STAGE(PG8_SA(0, 0), a2, voffA);
            PG8_WAIT_V(8); PG8_WAIT_L(0); PG8_BAR; PG8_MMA(1, 0, At, B0); PG8_MMA(1, 1, At, B1); PG8_BAR; PG8_SCHED;
            PG8_LDB(B0, 1, 0); PG8_LDB(B1, 1, 1); PG8_SCHED; PG8_LDA(At, 1, 0); PG8_STAGE(PG8_SA(0, 1), a2 + hstep, voffA);
            PG8_WAIT_V(8); PG8_WAIT_L(0); PG8_BAR; PG8_MMA(0, 0, At, B0); PG8_MMA(0, 1, At, B1); PG8_BAR; PG8_SCHED;
            PG8_LDA(At, 1, 1); PG8_STAGE(PG8_SB(1, 0), b3, voffB); PG8_STAGE(PG8_SB(1, 1), b3 + hstep, voffB); PG8_STAGE(PG8_SA(1, 0), a3, voffA);
            PG8_WAIT_V(8); PG8_WAIT_L(0); PG8_BAR; PG8_MMA(1, 0, At, B0); PG8_MMA(1, 1, At, B1); PG8_BAR; PG8_SCHED;
            } else {
            PG8_LDB(B0, 0, 0); PG8_SCHED; PG8_LDA(At, 0, 0); PG8_STAGE(PG8_SA(1, 1), a1 + hstep, voffA);
            PG8_WAIT_L(8); PG8_BAR; PG8_WAIT_L(0); PG8_MMA(0, 0, At, B0); PG8_BAR; PG8_SCHED;
            PG8_LDB(B1, 0, 1); PG8_STAGE(PG8_SB(0, 0), b2, voffB);
            PG8_BAR; PG8_WAIT_L(0); PG8_MMA(0, 1, At, B1); PG8_BAR;
            PG8_LDA(At, 0, 1); PG8_STAGE(PG8_SA(0, 0), a2, voffA);
            PG8_BAR; PG8_WAIT_L(0); PG8_MMA(1, 0, At, B0); PG8_BAR; PG8_SCHED;
            PG8_STAGE(PG8_SB(0, 1), b2 + hstep, voffB);
            PG8_WAIT_V(6); PG8_BAR; PG8_MMA(1, 1, At, B1); PG8_BAR;
            PG8_LDB(B0, 1, 0); PG8_SCHED; PG8_LDA(At, 1, 0); PG8_STAGE(PG8_SA(0, 1), a2 + hstep, voffA);
            PG8_WAIT_L(8); PG8_BAR; PG8_WAIT_L(0); PG8_MMA(0, 0, At, B0); PG8_BAR; PG8_SCHED;
            PG8_LDB(B1, 1, 1); PG8_STAGE(PG8_SB(1, 0), b3, voffB);
            PG8_BAR; PG8_WAIT_L(0); PG8_MMA(0, 1, At, B1); PG8_BAR;
            PG8_LDA(At, 1, 1); PG8_STAGE(PG8_SA(1, 0), a3, voffA);
            PG8_BAR; PG8_WAIT_L(0); PG8_MMA(1, 0, At, B0); PG8_BAR; PG8_SCHED;
            PG8_STAGE(PG8_SB(1, 1), b3 + hstep, voffB);
            PG8_WAIT_V(6); PG8_BAR; PG8_MMA(1, 1, At, B1); PG8_BAR;
            }
        }
        if constexpr (ALIGN_EPI) { if (wr == 0) PG8_BAR; }
        if constexpr (!Epi::AFTER_DRAIN) { E(acc, cur, wr, wc, fr, fq); S.done(cur); }
        if (!has_next) break;
#pragma unroll
        for (int a = 0; a < 2; ++a)
#pragma unroll
            for (int b = 0; b < 2; ++b)
#pragma unroll
                for (int m = 0; m < 4; ++m)
#pragma unroll
                    for (int n = 0; n < 2; ++n) acc[a][b][m][n] = (f32x4){0.f, 0.f, 0.f, 0.f};
        cur = nxt; cA = nA; cB = nB; ++ui;
        if constexpr (ALIGN_EPI) { if (wr == 1) PG8_BAR; }
    }
    PG8_WAIT_V(0);
    if constexpr (!ALIGN_EPI) { if (wr == 0) PG8_BAR; }
    PG8_BAR;
    if constexpr (Epi::AFTER_DRAIN) { E.fused(acc, cur, wr, wc, fr, fq, lds, wid, lane); S.done(cur); }
#undef PG8_SA
#undef PG8_SB
#undef PG8_STAGE
#undef PG8_LDA
#undef PG8_LDB
#undef PG8_MMA
#undef PG8_WAIT_V
#undef PG8_WAIT_L
#undef PG8_BAR
#undef PG8_SCHED
}
}
#define LAS __attribute__((address_space(3)))
typedef unsigned short bf16;
typedef float f32x4 __attribute__((ext_vector_type(4)));
typedef short bf16x8 __attribute__((ext_vector_type(8)));
typedef unsigned u32x4 __attribute__((ext_vector_type(4)));
typedef unsigned u32x2 __attribute__((ext_vector_type(2)));
#define LDS_WAIT() asm volatile("s_waitcnt lgkmcnt(0)" ::: "memory")

constexpr int D = 1024, SEQ = 8192, ML = 16384, MC = 512, MT = ML + MC, CTXL = 256;
constexpr int DIN = 2080, NP = 2560, DFF = 2816, NUP = 5632;
constexpr int PK = 0, PQ = 128, PV = 256, PLA = 512, PG = 768, PFA = 1024, PFB = 1280, PH = 1536, PBG = 1792, PCG = 2048, PPOOL = 2304;
constexpr int NCH = 132;
constexpr float EPS = 1e-6f;
constexpr size_t MiB = 1u << 20;
constexpr size_t WS_CTL = 0;
constexpr size_t WS_MOD = 1 * MiB;
constexpr size_t WS_MCS = 1 * MiB + 256 * 1024;
constexpr size_t WS_F1 = 1 * MiB + 512 * 1024;
constexpr size_t WS_F2 = WS_F1 + 32 * 1024;
constexpr size_t WS_FC = WS_F2 + 64 * 1024;
constexpr size_t WS_SLOT = 49 * MiB;
constexpr size_t WS_XB2 = 208 * MiB;
constexpr int CW_FIN = 3584;
constexpr size_t WS_W = 2 * MiB;
constexpr size_t W_IN_B = (size_t)NP * D * 2, W_OUT_B = (size_t)D * D * 2, W_UP_B = (size_t)NUP * D * 2, W_DN_B = (size_t)D * DFF * 2;
constexpr size_t W_LAYER_B = W_IN_B + W_OUT_B + W_UP_B + W_DN_B;
constexpr size_t WS_HX = 50 * MiB;
constexpr size_t WS_YMIX = 83 * MiB;
constexpr size_t WS_P = 116 * MiB;
constexpr size_t WS_XC = 207 * MiB;
constexpr size_t WS_ST = 209 * MiB;
constexpr size_t WS_DEC = 226 * MiB;
constexpr size_t WS_CAU = 227 * MiB;
constexpr size_t WS_PART = 233 * MiB;
constexpr size_t WS_END = 255 * MiB;
static_assert(WS_W + 2 * W_LAYER_B <= WS_HX, "weights");
static_assert(WS_P + (size_t)MT * DFF * 2 <= WS_XC, "act");
constexpr int RING_BYTES = 131072, LDS_BYTES = 147456;

struct Params {
    const float *x, *c, *ctx, *c_ctx, *norm1_g, *norm2_g, *w_mod, *b_mod, *w_in, *w_a2, *b_a2, *gla_g, *fft_w, *conv_w, *conv_b, *pool_w,
        *pool_scale, *w_out, *w_up, *ffn_cw, *ffn_cb, *w_down, *final_g;
    float* out; unsigned char* ws;
};

typedef const __attribute__((address_space(4))) Params* PP;
__device__ __forceinline__ unsigned f2bf(float f) { unsigned u = __builtin_bit_cast(unsigned, f); return (u + 0x7fffu + ((u >> 16) & 1u)) >> 16; }
__device__ __forceinline__ unsigned pk2(float lo, float hi) { return f2bf(lo) | (f2bf(hi) << 16); }
__device__ __forceinline__ float bf2f(unsigned h) { return __builtin_bit_cast(float, h << 16); }
__device__ __forceinline__ float bflo(unsigned w) { return __builtin_bit_cast(float, w << 16); }
__device__ __forceinline__ float bfhi(unsigned w) { return __builtin_bit_cast(float, w & 0xffff0000u); }
__device__ __forceinline__ float shfl_f(float v, int src_lane) { return __builtin_bit_cast(float, __builtin_amdgcn_ds_bpermute(src_lane << 2, __builtin_bit_cast(int, v))); }
__device__ __forceinline__ float wave_sum(float v, int lane) {
#pragma unroll
    for (int o = 1; o < 64; o <<= 1) v += shfl_f(v, lane ^ o);
    return v;
}
__device__ __forceinline__ float silu_f(float x) { return x * __builtin_amdgcn_rcpf(1.f + __expf(-x)); }
__device__ __forceinline__ float cos_rev(float r) { return __builtin_amdgcn_cosf(r); }
__device__ __forceinline__ float sin_rev(float r) { return __builtin_amdgcn_sinf(r); }
__device__ __forceinline__ bf16x8 pack8(float a0, float a1, float a2, float a3, float a4, float a5, float a6, float a7) {
    u32x4 w; w.x = pk2(a0, a1); w.y = pk2(a2, a3); w.z = pk2(a4, a5); w.w = pk2(a6, a7); return __builtin_bit_cast(bf16x8, w);
}
#define MFMA16(a, b, c) __builtin_amdgcn_mfma_f32_16x16x32_bf16(a, b, c, 0, 0, 0)

struct EpiP {
    static constexpr bool PERM = true, AFTER_DRAIN = false;
    bf16* O; const float* ba2;
    __device__ __forceinline__ void operator()(const pg8::f32x4 (&acc)[2][2][4][2], const pg8::Unit& u, int wr, int wc, int fr, int fq) const {
        const int row0 = u.pm * 256 + wr * 64 + fr, col0 = u.pn * 256 + wc * 32 + 8 * fq;
        const __amdgpu_buffer_rsrc_t prs = __builtin_amdgcn_make_buffer_rsrc(O, 0, MT * NP * 2, 0x00020000);
        const bool la = (u.pn == 2);
#pragma unroll
        for (int ai = 0; ai < 2; ++ai)
#pragma unroll
            for (int m = 0; m < 4; ++m) { bf16* rowp = O + (size_t)(row0 + ai * 128 + m * 16) * NP + col0;
#pragma unroll
                for (int bj = 0; bj < 2; ++bj) { pg8::f32x4 v0 = acc[ai][bj][m][0], v1 = acc[ai][bj][m][1];
                    if (la) { const float* bp = ba2 + (col0 + bj * 128 - PLA); const f32x4 b0 = *(const f32x4*)bp, b1 = *(const f32x4*)(bp + 4);
#pragma unroll
                        for (int e = 0; e < 4; ++e) { float xa = v0[e] + b0[e], xb = v1[e] + b1[e];
                            v0[e] = (fminf(xa, 0.f) - __logf(1.f + __expf(-fabsf(xa)))) * 0.0625f; v1[e] = (fminf(xb, 0.f) - __logf(1.f + __expf(-fabsf(xb)))) * 0.0625f; } }
                    u32x4 w; w.x = pg8::cvt_pk_bf16(v0[0], v0[1]); w.y = pg8::cvt_pk_bf16(v0[2], v0[3]); w.z = pg8::cvt_pk_bf16(v1[0], v1[1]); w.w = pg8::cvt_pk_bf16(v1[2], v1[3]);
                    __builtin_amdgcn_raw_buffer_store_b128(w, prs, (unsigned)(((row0 + ai * 128 + m * 16) * NP + col0 + bj * 128) * 2), 0, 16); } }
    }
};
template <bool INB, bool OUTB>
struct EpiRes {
    static constexpr bool PERM = true, AFTER_DRAIN = false;
    const void* xin; void* out; const float* modg;
    __device__ __forceinline__ void operator()(const pg8::f32x4 (&acc)[2][2][4][2], const pg8::Unit& u, int wr, int wc, int fr, int fq) const {
        const int w = u.pm >> 5; const int cb = u.pn * 256 + wc * 32 + 8 * fq;
        f32x4 gv[2][2];
#pragma unroll
        for (int bj = 0; bj < 2; ++bj)
#pragma unroll
            for (int n = 0; n < 2; ++n) gv[bj][n] = *(const f32x4*)(modg + w * 6144 + cb + bj * 128 + 4 * n);
        constexpr int RG = INB ? 4 : 2;
#pragma unroll
        for (int ai = 0; ai < 2; ++ai)
#pragma unroll
            for (int mp = 0; mp < 4 / RG; ++mp) {
                u32x4 xb[RG][2]; f32x4 xf[INB ? 1 : RG][2][2];
#pragma unroll
                for (int mm = 0; mm < RG; ++mm) { const size_t ro = (size_t)(u.pm * 256 + ai * 128 + wr * 64 + (RG * mp + mm) * 16 + fr) * D + cb;
#pragma unroll
                    for (int bj = 0; bj < 2; ++bj) {
                        if (INB) xb[mm][bj] = *(const u32x4*)((const bf16*)xin + ro + bj * 128);
                        else { xf[INB ? 0 : mm][bj][0] = *(const f32x4*)((const float*)xin + ro + bj * 128); xf[INB ? 0 : mm][bj][1] = *(const f32x4*)((const float*)xin + ro + bj * 128 + 4); } } }
#pragma unroll
                for (int mm = 0; mm < RG; ++mm) { const int m = RG * mp + mm; const size_t ro = (size_t)(u.pm * 256 + ai * 128 + wr * 64 + m * 16 + fr) * D + cb;
#pragma unroll
                    for (int bj = 0; bj < 2; ++bj) { f32x4 x0, x1;
                        if (INB) { const u32x4 t = xb[mm][bj]; x0 = (f32x4){bflo(t.x), bfhi(t.x), bflo(t.y), bfhi(t.y)}; x1 = (f32x4){bflo(t.z), bfhi(t.z), bflo(t.w), bfhi(t.w)}; }
                        else { x0 = xf[INB ? 0 : mm][bj][0]; x1 = xf[INB ? 0 : mm][bj][1]; }
                        const pg8::f32x4 a0 = acc[ai][bj][m][0], a1 = acc[ai][bj][m][1]; const f32x4 g0 = gv[bj][0], g1 = gv[bj][1];
                        f32x4 y0, y1;
#pragma unroll
                        for (int e = 0; e < 4; ++e) { y0[e] = x0[e] + g0[e] * a0[e]; y1[e] = x1[e] + g1[e] * a1[e]; }
                        if (OUTB) { u32x4 pk; pk.x = pg8::cvt_pk_bf16(y0[0], y0[1]); pk.y = pg8::cvt_pk_bf16(y0[2], y0[3]); pk.z = pg8::cvt_pk_bf16(y1[0], y1[1]); pk.w = pg8::cvt_pk_bf16(y1[2], y1[3]);
                            *(u32x4*)((bf16*)out + ro + bj * 128) = pk; }
                        else { *(f32x4*)((float*)out + ro + bj * 128) = y0; *(f32x4*)((float*)out + ro + bj * 128 + 4) = y1; } } }
            }
    }
};
template <bool STORE_X>
__device__ __forceinline__ void panel_rms(pg8::f32x4 (&acc)[2][2][4][2], const pg8::Unit& u, int wr, int wc, int fr, int fq, LAS unsigned char* lds, int wid, int lane,
                                          const bf16* xin, bf16* xout, const float* modg, float* slots, unsigned* cnt) {
    const int w = u.pm >> 5; const int cb = u.pn * 256 + wc * 32 + 8 * fq;
    LAS float* P = (LAS float*)lds;
    LAS float* S = (LAS float*)(lds + 4096);
    f32x4 gv[2][2];
#pragma unroll
    for (int bj = 0; bj < 2; ++bj)
#pragma unroll
        for (int n = 0; n < 2; ++n) gv[bj][n] = *(const f32x4*)(modg + w * 6144 + cb + bj * 128 + 4 * n);
#pragma unroll
    for (int ai = 0; ai < 2; ++ai) {
        u32x4 xb[4][2];
#pragma unroll
        for (int m = 0; m < 4; ++m) { const size_t ro = (size_t)(u.pm * 256 + ai * 128 + wr * 64 + m * 16 + fr) * D + cb;
#pragma unroll
            for (int bj = 0; bj < 2; ++bj) xb[m][bj] = *(const u32x4*)(xin + ro + bj * 128); }
#pragma unroll
        for (int m = 0; m < 4; ++m) { float sq = 0.f; const size_t ro = (size_t)(u.pm * 256 + ai * 128 + wr * 64 + m * 16 + fr) * D + cb;
#pragma unroll
            for (int bj = 0; bj < 2; ++bj) { const u32x4 t = xb[m][bj]; const f32x4 g0 = gv[bj][0], g1 = gv[bj][1]; pg8::f32x4 a0 = acc[ai][bj][m][0], a1 = acc[ai][bj][m][1];
                a0[0] = bflo(t.x) + g0[0] * a0[0]; a0[1] = bfhi(t.x) + g0[1] * a0[1]; a0[2] = bflo(t.y) + g0[2] * a0[2]; a0[3] = bfhi(t.y) + g0[3] * a0[3];
                a1[0] = bflo(t.z) + g1[0] * a1[0]; a1[1] = bfhi(t.z) + g1[1] * a1[1]; a1[2] = bflo(t.w) + g1[2] * a1[2]; a1[3] = bfhi(t.w) + g1[3] * a1[3];
                acc[ai][bj][m][0] = a0; acc[ai][bj][m][1] = a1;
                sq += ((a0[0] * a0[0] + a0[1] * a0[1]) + (a0[2] * a0[2] + a0[3] * a0[3])) + ((a1[0] * a1[0] + a1[1] * a1[1]) + (a1[2] * a1[2] + a1[3] * a1[3]));
                if (STORE_X) { u32x4 pk; pk.x = pg8::cvt_pk_bf16(a0[0], a0[1]); pk.y = pg8::cvt_pk_bf16(a0[2], a0[3]); pk.z = pg8::cvt_pk_bf16(a1[0], a1[1]); pk.w = pg8::cvt_pk_bf16(a1[2], a1[3]);
                    *(u32x4*)(xout + ro + bj * 128) = pk; } }
            sq += shfl_f(sq, lane ^ 16); sq += shfl_f(sq, lane ^ 32);
            if (fq == 0) P[(ai * 128 + wr * 64 + m * 16 + fr) * 4 + wc] = sq; }
    }
    asm volatile("s_waitcnt lgkmcnt(0)" ::: "memory"); __builtin_amdgcn_s_barrier(); asm volatile("" ::: "memory");
    const int row = wid * 32 + (lane & 31);
    if (lane < 32) { const float t = (P[row * 4 + 0] + P[row * 4 + 1]) + (P[row * 4 + 2] + P[row * 4 + 3]);
        __hip_atomic_store(slots + ((size_t)(u.pm * 256 + row) * 4 + u.pn), t, __ATOMIC_RELAXED, __HIP_MEMORY_SCOPE_AGENT); }
    asm volatile("s_waitcnt vmcnt(0)" ::: "memory");
    if (lane == 0) (void)__hip_atomic_fetch_add(cnt + 64 * u.pm, 1u, __ATOMIC_RELAXED, __HIP_MEMORY_SCOPE_AGENT);
    if (wid == 0) { unsigned sp = 0;
        while ((unsigned)__builtin_amdgcn_readfirstlane((int)__hip_atomic_load(cnt + 64 * u.pm, __ATOMIC_RELAXED, __HIP_MEMORY_SCOPE_AGENT)) < 32u) { __builtin_amdgcn_s_sleep(2); if (++sp > (1u << 22)) break; }
        __builtin_amdgcn_fence(__ATOMIC_ACQUIRE, "agent"); }
    asm volatile("s_waitcnt vmcnt(0) lgkmcnt(0)" ::: "memory"); __builtin_amdgcn_s_barrier(); asm volatile("" ::: "memory");
    if (lane < 32) { const float* sl = slots + (size_t)(u.pm * 256 + row) * 4; float t = 0.f;
#pragma unroll
        for (int q = 0; q < 4; ++q) t += __hip_atomic_load(sl + q, __ATOMIC_RELAXED, __HIP_MEMORY_SCOPE_AGENT);
        S[row] = 1.f / sqrtf(t * (1.f / D) + EPS); }
    asm volatile("s_waitcnt vmcnt(0) lgkmcnt(0)" ::: "memory"); __builtin_amdgcn_s_barrier(); asm volatile("" ::: "memory");
}
struct EpiFinal {
    static constexpr bool PERM = true, AFTER_DRAIN = true;
    const bf16* xin; float* out; const float* modg; const float* gfin; float* slots; unsigned* cnt;
    __device__ __forceinline__ void fused(pg8::f32x4 (&acc)[2][2][4][2], const pg8::Unit& u, int wr, int wc, int fr, int fq, LAS unsigned char* lds, int wid, int lane) const {
        panel_rms<false>(acc, u, wr, wc, fr, fq, lds, wid, lane, xin, nullptr, modg, slots, cnt);
        const LAS float* S = (const LAS float*)(lds + 4096); const int cb = u.pn * 256 + wc * 32 + 8 * fq;
        f32x4 gf[2][2];
#pragma unroll
        for (int bj = 0; bj < 2; ++bj)
#pragma unroll
            for (int n = 0; n < 2; ++n) gf[bj][n] = *(const f32x4*)(gfin + cb + bj * 128 + 4 * n);
#pragma unroll
        for (int ai = 0; ai < 2; ++ai)
#pragma unroll
            for (int m = 0; m < 4; ++m) { const int r = ai * 128 + wr * 64 + m * 16 + fr; const float rs = S[r]; float* o = out + (size_t)(u.pm * 256 + r) * D + cb;
#pragma unroll
                for (int bj = 0; bj < 2; ++bj)
#pragma unroll
                    for (int n = 0; n < 2; ++n) { const pg8::f32x4 a = acc[ai][bj][m][n]; const f32x4 g4 = gf[bj][n];
                        *(f32x4*)(o + bj * 128 + 4 * n) = (f32x4){a[0] * rs * g4[0], a[1] * rs * g4[1], a[2] * rs * g4[2], a[3] * rs * g4[3]}; } }
    }
};
struct EpiResNorm {
    static constexpr bool PERM = true, AFTER_DRAIN = true;
    const bf16* xin; bf16* xout; bf16* hout; const float* modg; const float* gn; const float* modn; float* slots; unsigned* cnt;
    __device__ __forceinline__ void fused(pg8::f32x4 (&acc)[2][2][4][2], const pg8::Unit& u, int wr, int wc, int fr, int fq, LAS unsigned char* lds, int wid, int lane) const {
        panel_rms<true>(acc, u, wr, wc, fr, fq, lds, wid, lane, xin, xout, modg, slots, cnt);
        const LAS float* S = (const LAS float*)(lds + 4096); const int w = u.pm >> 5; const int cb = u.pn * 256 + wc * 32 + 8 * fq;
        f32x4 gm[2][2], shv[2][2];
#pragma unroll
        for (int bj = 0; bj < 2; ++bj)
#pragma unroll
            for (int n = 0; n < 2; ++n) { const int c = cb + bj * 128 + 4 * n; const f32x4 g4 = *(const f32x4*)(gn + c), s4 = *(const f32x4*)(modn + w * 6144 + 4096 + c);
                shv[bj][n] = *(const f32x4*)(modn + w * 6144 + 3072 + c); gm[bj][n] = (f32x4){g4[0] * (1.f + s4[0]), g4[1] * (1.f + s4[1]), g4[2] * (1.f + s4[2]), g4[3] * (1.f + s4[3])}; }
#pragma unroll
        for (int ai = 0; ai < 2; ++ai)
#pragma unroll
            for (int m = 0; m < 4; ++m) { const int r = ai * 128 + wr * 64 + m * 16 + fr; const float rs = S[r]; bf16* o = hout + (size_t)(u.pm * 256 + r) * D + cb;
#pragma unroll
                for (int bj = 0; bj < 2; ++bj) { const pg8::f32x4 a0 = acc[ai][bj][m][0], a1 = acc[ai][bj][m][1]; const f32x4 g0 = gm[bj][0], g1 = gm[bj][1], h0 = shv[bj][0], h1 = shv[bj][1];
                    u32x4 pk; pk.x = pg8::cvt_pk_bf16(a0[0] * rs * g0[0] + h0[0], a0[1] * rs * g0[1] + h0[1]); pk.y = pg8::cvt_pk_bf16(a0[2] * rs * g0[2] + h0[2], a0[3] * rs * g0[3] + h0[3]);
                    pk.z = pg8::cvt_pk_bf16(a1[0] * rs * g1[0] + h1[0], a1[1] * rs * g1[1] + h1[1]); pk.w = pg8::cvt_pk_bf16(a1[2] * rs * g1[2] + h1[2], a1[3] * rs * g1[3] + h1[3]);
                    *(u32x4*)(o + bj * 128) = pk; } }
    }
};
struct EpiUp {
    static constexpr bool PERM = true, AFTER_DRAIN = false;
    bf16* ACT; const float* cw; const float* cb;
    __device__ __forceinline__ void operator()(const pg8::f32x4 (&acc)[2][2][4][2], const pg8::Unit& u, int wr, int wc, int fr, int fq) const {
        const int hc0 = u.pn * 128 + wc * 32 + 8 * fq;
        const __amdgpu_buffer_rsrc_t ars = __builtin_amdgcn_make_buffer_rsrc(ACT, 0, MT * DFF * 2, 0x00020000);
#pragma unroll
        for (int ai = 0; ai < 2; ++ai) { const int blk = ai * 2 + wr;
            float res[4][8];
#pragma unroll
            for (int n = 0; n < 2; ++n) {
                const f32x4 w0 = *(const f32x4*)(cw + hc0 + 4 * n), w1 = *(const f32x4*)(cw + DFF + hc0 + 4 * n), w2 = *(const f32x4*)(cw + 2 * DFF + hc0 + 4 * n), bb = *(const f32x4*)(cb + hc0 + 4 * n);
#pragma unroll
                for (int e = 0; e < 4; ++e) {
                    float xs[4], ps[4], ns[4]; const float bprev = 0.f, bnext = 0.f;
#pragma unroll
                    for (int m = 0; m < 4; ++m) { xs[m] = acc[ai][0][m][n][e]; ps[m] = __builtin_bit_cast(float, __builtin_amdgcn_update_dpp(0, __builtin_bit_cast(int, xs[m]), 0x121, 0xf, 0xf, false)); ns[m] = __builtin_bit_cast(float, __builtin_amdgcn_update_dpp(0, __builtin_bit_cast(int, xs[m]), 0x12f, 0xf, 0xf, false)); }
#pragma unroll
                    for (int m = 0; m < 4; ++m) {
                        const float oldp = (m > 0) ? ps[m > 0 ? m - 1 : 0] : bprev, oldn = (m < 3) ? ns[m < 3 ? m + 1 : 3] : bnext;
                        const float prev = __builtin_bit_cast(float, __builtin_amdgcn_update_dpp(__builtin_bit_cast(int, oldp), __builtin_bit_cast(int, xs[m]), 0x111, 0xf, 0xf, false));
                        const float next = __builtin_bit_cast(float, __builtin_amdgcn_update_dpp(__builtin_bit_cast(int, oldn), __builtin_bit_cast(int, xs[m]), 0x101, 0xf, 0xf, false));
                        const float a = w0[e] * prev + w1[e] * xs[m] + w2[e] * next + bb[e];
                        res[m][4 * n + e] = silu_f(a) * acc[ai][1][m][n][e];
                    }
                }
            }
#pragma unroll
            for (int m = 0; m < 4; ++m) { const int r = u.pm * 256 + ai * 128 + wr * 64 + m * 16 + fr;
                u32x4 w; w.x = pg8::cvt_pk_bf16(res[m][0], res[m][1]); w.y = pg8::cvt_pk_bf16(res[m][2], res[m][3]); w.z = pg8::cvt_pk_bf16(res[m][4], res[m][5]); w.w = pg8::cvt_pk_bf16(res[m][6], res[m][7]);
                __builtin_amdgcn_raw_buffer_store_b128(w, ars, (unsigned)((r * DFF + hc0) * 2), 0, 16); }
        }
    }
};
struct EpiUpCtx {
    static constexpr bool PERM = true, AFTER_DRAIN = false;
    bf16* ACT; const float* cw; const float* cb; LAS float* ex;
    __device__ __forceinline__ void operator()(const pg8::f32x4 (&acc)[2][2][4][2], const pg8::Unit& u, int wr, int wc, int fr, int fq) const {
        const int hc0 = u.pn * 128 + wc * 32 + 8 * fq;
            const int colw = wc * 32 + 8 * fq;
#pragma unroll
            for (int ai = 0; ai < 2; ++ai) { const int blk = ai * 2 + wr;
                if (fr == 0) {
#pragma unroll
                    for (int n = 0; n < 2; ++n)
#pragma unroll
                        for (int e = 0; e < 4; ++e) ex[(blk * 2 + 0) * 128 + colw + 4 * n + e] = acc[ai][0][0][n][e]; }
                if (fr == 15) {
#pragma unroll
                    for (int n = 0; n < 2; ++n)
#pragma unroll
                        for (int e = 0; e < 4; ++e) ex[(blk * 2 + 1) * 128 + colw + 4 * n + e] = acc[ai][0][3][n][e]; } }
            asm volatile("s_waitcnt lgkmcnt(0)" ::: "memory"); __builtin_amdgcn_s_barrier(); asm volatile("" ::: "memory");
#pragma unroll
            for (int ai = 0; ai < 2; ++ai) { const int blk = ai * 2 + wr;
                float res[4][8];
    #pragma unroll
                for (int n = 0; n < 2; ++n) {
                    const f32x4 w0 = *(const f32x4*)(cw + hc0 + 4 * n), w1 = *(const f32x4*)(cw + DFF + hc0 + 4 * n), w2 = *(const f32x4*)(cw + 2 * DFF + hc0 + 4 * n), bb = *(const f32x4*)(cb + hc0 + 4 * n);
    #pragma unroll
                    for (int e = 0; e < 4; ++e) {
                        float xs[4], ps[4], ns[4]; float bprev = 0.f, bnext = 0.f; if (blk > 0) bprev = ex[((blk - 1) * 2 + 1) * 128 + colw + 4 * n + e]; if (blk < 3) bnext = ex[((blk + 1) * 2 + 0) * 128 + colw + 4 * n + e];
    #pragma unroll
                        for (int m = 0; m < 4; ++m) { xs[m] = acc[ai][0][m][n][e]; ps[m] = __builtin_bit_cast(float, __builtin_amdgcn_update_dpp(0, __builtin_bit_cast(int, xs[m]), 0x121, 0xf, 0xf, false)); ns[m] = __builtin_bit_cast(float, __builtin_amdgcn_update_dpp(0, __builtin_bit_cast(int, xs[m]), 0x12f, 0xf, 0xf, false)); }
    #pragma unroll
                        for (int m = 0; m < 4; ++m) {
                            const float prev = (fr > 0) ? ps[m] : (m > 0 ? ps[m > 0 ? m - 1 : 0] : bprev);
                            const float next = (fr < 15) ? ns[m] : (m < 3 ? ns[m < 3 ? m + 1 : 3] : bnext);
                            const float a = w0[e] * prev + w1[e] * xs[m] + w2[e] * next + bb[e];
                            res[m][4 * n + e] = silu_f(a) * acc[ai][1][m][n][e];
                        }
                    }
                }
    #pragma unroll
                for (int m = 0; m < 4; ++m) { const int r = u.pm * 256 + ai * 128 + wr * 64 + m * 16 + fr;
                    u32x4 w; w.x = pg8::cvt_pk_bf16(res[m][0], res[m][1]); w.y = pg8::cvt_pk_bf16(res[m][2], res[m][3]); w.z = pg8::cvt_pk_bf16(res[m][4], res[m][5]); w.w = pg8::cvt_pk_bf16(res[m][6], res[m][7]);
                    *(u32x4*)(ACT + (size_t)r * DFF + hc0) = w; }
            }

    }
};
struct CtxOrder {
    int nN, c, c0;
    __device__ void init(int N, int c_, int c0_) { nN = N / 256; c = c_; c0 = c0_; }
    __device__ bool next(int i, pg8::Unit& u) const { const int j = c - c0; if (i > 0 || j < 0 || j >= 2 * nN) return false; u.pm = 64 + (j & 1); u.pn = j >> 1; u.ks = 0; return true; }
    __device__ __forceinline__ void a_ready(const pg8::Unit&) const {}
    __device__ __forceinline__ void done(const pg8::Unit&) const {}
};

struct SplitOrder {
    int nunits, G, c;
    __device__ void init(int nks, int G_, int c_) { nunits = 8 * nks; G = G_; c = c_; }
    __device__ bool next(int i, pg8::Unit& u) const { const int id = i * G + c; if (id >= nunits) return false; u.pm = 64 + (id & 1); u.pn = (id >> 1) & 3; u.ks = id >> 3; return true; }
    __device__ __forceinline__ void a_ready(const pg8::Unit&) const {}
    __device__ __forceinline__ void done(const pg8::Unit&) const {}
};
struct EpiPartial {
    static constexpr bool PERM = false, AFTER_DRAIN = false;
    float* part;
    __device__ __forceinline__ void operator()(const pg8::f32x4 (&acc)[2][2][4][2], const pg8::Unit& u, int wr, int wc, int fr, int fq) const {
#pragma unroll
        for (int ai = 0; ai < 2; ++ai)
#pragma unroll
            for (int m = 0; m < 4; ++m) { const int r = u.pm * 256 + ai * 128 + wr * 64 + m * 16 + fr; float* o = part + ((size_t)u.ks * MC + (size_t)(r - ML)) * D;
#pragma unroll
                for (int bj = 0; bj < 2; ++bj)
#pragma unroll
                    for (int n = 0; n < 2; ++n) { const int c = u.pn * 256 + bj * 128 + wc * 32 + 16 * n + 4 * fq; const pg8::f32x4 a = acc[ai][bj][m][n];
                        *(f32x4*)(o + c) = (f32x4){a[0], a[1], a[2], a[3]}; } }
    }
};
typedef __attribute__((address_space(1))) unsigned gu32;
#define XB_TMO      128
#define XB_XCNT(j)  (256  + 64 * (j))
#define XB_XSUB(j)  (1280 + 64 * (j))
#define XB_XGEN(j)  (2304 + 64 * (j))
#define XB_TOP      3328
#define XB_TOPGEN   3392
#define XCD_BAR_WORDS 3456
#define XB_SPIN_CAP (1u << 18)

__device__ __forceinline__ unsigned xb_ld(unsigned* p)              { return __hip_atomic_load(p, __ATOMIC_RELAXED, __HIP_MEMORY_SCOPE_AGENT); }
__device__ __forceinline__ unsigned xb_add(unsigned* p, unsigned v) { return __hip_atomic_fetch_add(p, v, __ATOMIC_RELAXED, __HIP_MEMORY_SCOPE_AGENT); }
__device__ __forceinline__ unsigned xb_xcc_id() { return (unsigned)__builtin_amdgcn_s_getreg((3 << 11) | 20) & 0xFu; }
#define XB_SPIN(cond, bar) do { unsigned _sp = 0; while (cond) { __builtin_amdgcn_s_sleep(1); \
    if ((++_sp & 255u) == 0u) { if (xb_ld(&(bar)[XB_TMO])) break; if (_sp > XB_SPIN_CAP) { atomicAdd(&(bar)[XB_TMO], 1u); break; } } } } while (0)

struct XcdBarrier {
    unsigned* bar; unsigned x;
    volatile LAS unsigned* st;
};

__device__ __forceinline__ XcdBarrier xcd_barrier_post(unsigned* bar, volatile LAS unsigned* st, int tid_) {
    XcdBarrier b; b.bar = bar; b.x = xb_xcc_id(); b.st = st;
    if (tid_ == 0) (void)xb_add(&bar[XB_XCNT(b.x)], 1u);
    return b;
}
__device__ __forceinline__ void xcd_barrier_complete(unsigned* bar, unsigned x, unsigned& nloc, unsigned& nx) {
    const unsigned G = gridDim.x * gridDim.y * gridDim.z;
    unsigned sum, cnt, mine, sp = 0u;
    for (;;) {
        sum = 0u; cnt = 0u; mine = 0u;
#pragma unroll
        for (unsigned j = 0; j < 16; ++j) { const unsigned c = xb_ld(&bar[XB_XCNT(j)]); sum += c; cnt += (c > 0u) ? 1u : 0u; mine = (j == x) ? c : mine; }
        if (sum == G) break;
        __builtin_amdgcn_s_sleep(1);
        if ((++sp & 255u) == 0u) { if (xb_ld(&bar[XB_TMO])) break; if (sp > XB_SPIN_CAP) { atomicAdd(&bar[XB_TMO], 1u); break; } }
    }
    nloc = mine > 0u ? mine : 1u; nx = cnt > 0u ? cnt : 1u;
}

__device__ __forceinline__ void xcd_barrier(const XcdBarrier& b, int tid_) {
    asm volatile("s_waitcnt vmcnt(0)" ::: "memory");
    __syncthreads();
    if (tid_ == 0) {
        unsigned* bar = b.bar; asm volatile("" : "+s"(bar)); unsigned bx = (unsigned)__builtin_amdgcn_readfirstlane((int)b.x); asm volatile("" : "+s"(bx));
        __builtin_amdgcn_s_waitcnt(0);
        unsigned nloc = b.st[0], nx = b.st[1];
        if (nloc == 0u) { xcd_barrier_complete(bar, bx, nloc, nx); b.st[0] = nloc; b.st[1] = nx; }
        const unsigned old = xb_add(&bar[XB_XSUB(bx)], 1u);
        const unsigned gen = old / nloc;
        if (old + 1u == (gen + 1u) * nloc) {
            __builtin_amdgcn_fence(__ATOMIC_RELEASE, "agent");
            asm volatile("s_waitcnt vmcnt(0)" ::: "memory");
            const unsigned og = xb_add(&bar[XB_TOP], 1u);
            const unsigned tg = og / nx;
            if (og + 1u == (tg + 1u) * nx) xb_add(&bar[XB_TOPGEN], 1u);
            else XB_SPIN(xb_ld(&bar[XB_TOPGEN]) == tg, bar);
            __builtin_amdgcn_fence(__ATOMIC_ACQUIRE, "agent");
            xb_add(&bar[XB_XGEN(bx)], 1u);
            asm volatile("s_waitcnt vmcnt(0)" ::: "memory");
        } else {
            XB_SPIN(xb_ld(&bar[XB_XGEN(bx)]) == gen, bar);
            __builtin_amdgcn_fence(__ATOMIC_ACQUIRE, "agent");
            asm volatile("s_waitcnt vmcnt(0)" ::: "memory");
        }
    }
    __syncthreads();
}
struct Ctx {
    LAS unsigned char* lds; int tid, lane, wave, G, gw, NGW;
    float* MOD; float* MCS; bf16 *F1, *F2, *FC; bf16 *HX, *YMIX, *PB, *ACT, *TB, *CAU; float *XC, *ST, *DEC;
};
__device__ __forceinline__ bf16* win_t(PP p, int l) { return (bf16*)(p->ws + WS_W + (size_t)l * W_LAYER_B); }
__device__ __forceinline__ bf16* wout_t(PP p, int l) { return (bf16*)(p->ws + WS_W + (size_t)l * W_LAYER_B + W_IN_B); }
__device__ __forceinline__ bf16* wup_t(PP p, int l) { return (bf16*)(p->ws + WS_W + (size_t)l * W_LAYER_B + W_IN_B + W_OUT_B); }
__device__ __forceinline__ bf16* wdn_t(PP p, int l) { return (bf16*)(p->ws + WS_W + (size_t)l * W_LAYER_B + W_IN_B + W_OUT_B + W_UP_B); }

__device__ __forceinline__ void transpose_item(const float* W, int K, int N, bf16* WT, int k0, int n0, int dst0, float scale, LAS float* scr, int lane) {
#pragma unroll
    for (int i = 0; i < 32; ++i) { const int kk = 2 * i + (lane >> 5); scr[kk * 33 + (lane & 31)] = __builtin_nontemporal_load(W + (size_t)(k0 + kk) * N + n0 + (lane & 31)) * scale; }
    LDS_WAIT(); __builtin_amdgcn_wave_barrier();
    const int c = lane & 7;
#pragma unroll
    for (int j = 0; j < 4; ++j) { const int n = (lane >> 3) + 8 * j; const LAS float* s = scr + (8 * c) * 33 + n;
        u32x4 o; o.x = pk2(s[0 * 33], s[1 * 33]); o.y = pk2(s[2 * 33], s[3 * 33]); o.z = pk2(s[4 * 33], s[5 * 33]); o.w = pk2(s[6 * 33], s[7 * 33]);
        __builtin_nontemporal_store(o, (u32x4*)(WT + (size_t)(dst0 + n) * K + k0 + 8 * c)); }
    LDS_WAIT(); __builtin_amdgcn_wave_barrier();
}

__device__ __forceinline__ void phase0(PP p, Ctx& F) {
    LAS float* sv = (LAS float*)F.lds; LAS float* red = sv + 3072;
    for (int i = F.tid; i < 3072; i += 512) { const int w = i >> 10, k = i & 1023; const float cv = (w < 2) ? p->c[w * 1024 + k] : p->c_ctx[k]; sv[i] = cv / (1.f + expf(-cv)); }
    __syncthreads();
    for (int it = blockIdx.x; it < 192; it += F.G) {
        const int l = it / 96, c0 = (it % 96) * 64; const float* W = p->w_mod + (size_t)l * 1024 * 6144 + c0 + F.lane;
        float a0 = 0.f, a1 = 0.f, a2 = 0.f; const int kb = F.wave * 128;
#pragma unroll 32
        for (int k = 0; k < 128; ++k) { const float wv = __builtin_nontemporal_load(W + (size_t)(kb + k) * 6144); a0 += sv[kb + k] * wv; a1 += sv[1024 + kb + k] * wv; a2 += sv[2048 + kb + k] * wv; }
        red[(F.wave * 3 + 0) * 64 + F.lane] = a0; red[(F.wave * 3 + 1) * 64 + F.lane] = a1; red[(F.wave * 3 + 2) * 64 + F.lane] = a2;
        __syncthreads();
        if (F.tid < 192) { const int w = F.tid >> 6, ln = F.tid & 63; float s = 0.f;
#pragma unroll
            for (int q = 0; q < 8; ++q) s += red[(q * 3 + w) * 64 + ln];
            F.MOD[(l * 3 + w) * 6144 + c0 + ln] = s + p->b_mod[l * 6144 + c0 + ln]; }
        __syncthreads();
    }
    __syncthreads();
    LAS float* scr = (LAS float*)(F.lds + F.wave * 16384);
    constexpr int I_IN = 48 * 16, I_OUT = 32 * 16, I_UP = 176 * 16, I_DN = 32 * 44, I_L = I_IN + I_OUT + I_UP + I_DN;
    for (int it = F.gw; it < 2 * I_L; it += F.NGW) {
        const int l = it / I_L; int r = it % I_L;
        if (r < I_IN) { const int cb = r / 16, kb = r % 16; int src, dst; float sc = 1.f;
            if (cb < 4) { src = 32 * cb; dst = PK + 32 * cb; }
            else if (cb < 8) { src = 416 + 32 * (cb - 4); dst = PQ + 32 * (cb - 4); sc = 0.17677669529663687f; }
            else if (cb < 16) { src = 128 + 32 * (cb - 8); dst = PV + 32 * (cb - 8); }
            else if (cb < 24) { src = 544 + 32 * (cb - 16); dst = PG + 32 * (cb - 16); }
            else if (cb < 32) { src = 1056 + 32 * (cb - 24); dst = PH + 32 * (cb - 24); }
            else if (cb < 40) { src = 1312 + 32 * (cb - 32); dst = PBG + 32 * (cb - 32); }
            else { src = 1568 + 32 * (cb - 40); dst = PCG + 32 * (cb - 40); }
            transpose_item(p->w_in + (size_t)l * D * DIN, D, DIN, win_t(p, l), 64 * kb, src, dst, sc, scr, F.lane); continue; }
        r -= I_IN;
        if (r < I_OUT) { const int cb = r / 16, kb = r % 16; transpose_item(p->w_out + (size_t)l * D * D, D, D, wout_t(p, l), 64 * kb, 32 * cb, 32 * cb, 1.f, scr, F.lane); continue; }
        r -= I_OUT;
        if (r < I_UP) { const int cb = r / 16, kb = r % 16; const int c = 32 * cb, isu = (c >= DFF) ? 1 : 0, j = c - isu * DFF; const int dst = (j / 128) * 256 + isu * 128 + (j % 128);
            transpose_item(p->w_up + (size_t)l * D * NUP, D, NUP, wup_t(p, l), 64 * kb, c, dst, 1.f, scr, F.lane); continue; }
        r -= I_UP;
        { const int cb = r / 44, kb = r % 44; transpose_item(p->w_down + (size_t)l * DFF * D, DFF, D, wdn_t(p, l), 64 * kb, 32 * cb, 32 * cb, 1.f, scr, F.lane); }
    }
    const int gt = blockIdx.x * 512 + F.tid, NT = F.G * 512;
    const int gtm = (F.G == 256) ? ((int)blockIdx.x - 192) * 512 + F.tid : gt; const int NTm = (F.G == 256) ? 32768 : NT;
    for (int i = gtm; i >= 0 && i < 32768; i += NTm) { const int d = i & 63, c = (i >> 6) & 63, g = (i >> 12) & 3, l = i >> 14;
        const float* wf = p->fft_w + (size_t)((l * 4 + g) * 64) * 64 + d; float mc = 0.f, ms = 0.f;
        for (int f = 0; f < 64; ++f) { const float a = (float)((f * c) & 63) * (1.f / 64.f); const float w = wf[f * 64]; mc += cos_rev(a) * w; ms -= sin_rev(a) * w; }
        F.MCS[(((l * 4 + g) * 2 + 0) * 64 + c) * 64 + d] = mc * 0.125f; F.MCS[(((l * 4 + g) * 2 + 1) * 64 + c) * 64 + d] = ms * 0.125f; }
    for (int i = gt; i < MC * D / 4; i += NT) ((f32x4*)F.XC)[i] = ((const f32x4*)p->ctx)[i];
    for (int i = gt; i < 180224; i += NT) {
        if (i < 16384) { const int mm = i >> 7, kk = i & 127, k1 = mm & 63, n1 = kk & 63; const float a = (float)((k1 * n1) & 63) * (1.f / 64.f); const float C = cos_rev(a), S = sin_rev(a);
            const float v = (mm < 64) ? (kk < 64 ? C : S) : (kk < 64 ? -S : C); F.F1[i] = (bf16)f2bf(v); }
        else if (i < 49152) { const int j = i - 16384, k2 = j >> 8, kk = j & 255, n2 = kk & 127; const float a = (float)((k2 * n2) & 127) * (1.f / 128.f);
            const float v = (kk < 128 ? cos_rev(a) : sin_rev(a)) * 0.011048543456039806f; F.F2[j] = (bf16)f2bf(v); }
        else { const int j = i - 49152, k = j >> 9, kk = j & 511, n = kk & 255; const float a = (float)((k * n) & 255) * (1.f / 256.f);
            const float v = (kk < 256 ? cos_rev(a) : sin_rev(a)) * 0.0625f; F.FC[j] = (bf16)f2bf(v); }
    }
}

__device__ __forceinline__ void fold_items(PP p, Ctx& F) {
    for (int it4 = F.gw; it4 < 1792; it4 += F.NGW) {
        const int dq = it4 & 3, it = it4 >> 2;
        const int l = it / 224, r = it % 224, s = r / 16, kb = r % 16; const int k = 64 * kb + F.lane;
        const float* wrow = p->w_in + (size_t)l * D * DIN + (size_t)k * DIN; bf16* WT = win_t(p, l);
        if (s < 2) {
            const f32x4* src = (const f32x4*)(wrow + 384 + 16 * s); f32x4 r4[4];
#pragma unroll
            for (int q = 0; q < 4; ++q) r4[q] = src[q];
            const float* M = p->w_a2 + (size_t)((l * 2 + s) * 16) * 128;
            for (int d = 32 * dq; d < 32 * dq + 32; ++d) { float a = 0.f;
#pragma unroll
                for (int c = 0; c < 16; ++c) a += r4[c >> 2][c & 3] * M[c * 128 + d];
                WT[(size_t)(PLA + s * 128 + d) * D + k] = (bf16)f2bf(a); }
        } else {
            const int kind = (s - 2) >> 2, g = (s - 2) & 3;
            const f32x4* src = (const f32x4*)(wrow + (kind < 2 ? 800 : 1824) + 64 * g); f32x4 r4[16];
#pragma unroll
            for (int q = 0; q < 16; ++q) r4[q] = src[q];
            const float* M = (kind < 2) ? (F.MCS + (size_t)(((l * 4 + g) * 2 + kind) * 64) * 64) : (p->pool_w + (size_t)((l * 4 + g) * 64) * 64);
            const int drow = (kind == 0 ? PFA : (kind == 1 ? PFB : PPOOL)) + 64 * g;
            for (int d = 16 * dq; d < 16 * dq + 16; ++d) { float a = 0.f;
#pragma unroll
                for (int c = 0; c < 64; ++c) a += r4[c >> 2][c & 3] * M[c * 64 + d];
                if (kind == 2) a *= p->pool_scale[l * 256 + g * 64 + d];
                WT[(size_t)(drow + d) * D + k] = (bf16)f2bf(a); }
        }
    }
}

__device__ __forceinline__ void norm_row_bf16(const float* xrow, bf16* orow, const float* g, const float* sc, const float* sh, int lane, const float* part, int nparts, const float* gate, float* xout) {
    f32x4 v[4]; float s = 0.f;
#pragma unroll
    for (int j = 0; j < 4; ++j) v[j] = ((const f32x4*)xrow)[lane + 64 * j];
    if (nparts > 0) {
        f32x4 a[4];
#pragma unroll
        for (int j = 0; j < 4; ++j) a[j] = (f32x4){0.f, 0.f, 0.f, 0.f};
        for (int q = 0; q < nparts; ++q) {
#pragma unroll
            for (int j = 0; j < 4; ++j) { const f32x4 t = ((const f32x4*)(part + (size_t)q * MC * D))[lane + 64 * j]; a[j][0] += t[0]; a[j][1] += t[1]; a[j][2] += t[2]; a[j][3] += t[3]; } }
#pragma unroll
        for (int j = 0; j < 4; ++j) { const f32x4 gv = ((const f32x4*)gate)[lane + 64 * j];
#pragma unroll
            for (int e = 0; e < 4; ++e) v[j][e] += gv[e] * a[j][e];
            ((f32x4*)xout)[lane + 64 * j] = v[j]; }
    }
#pragma unroll
    for (int j = 0; j < 4; ++j) s += (v[j][0] * v[j][0] + v[j][1] * v[j][1]) + (v[j][2] * v[j][2] + v[j][3] * v[j][3]);
    const float rstd = 1.f / sqrtf(wave_sum(s, lane) * (1.f / D) + EPS);
#pragma unroll
    for (int j = 0; j < 4; ++j) { const int idx = lane + 64 * j; const f32x4 gv = ((const f32x4*)g)[idx], scv = ((const f32x4*)sc)[idx], shv = ((const f32x4*)sh)[idx];
        float y[4];
#pragma unroll
        for (int e = 0; e < 4; ++e) y[e] = v[j][e] * rstd * gv[e] * (1.f + scv[e]) + shv[e];
        u32x2 o; o.x = pk2(y[0], y[1]); o.y = pk2(y[2], y[3]); ((u32x2*)orow)[idx] = o; }
}
template <bool FINAL, bool INB>
__device__ __forceinline__ void norm_rows4(const void* xbase, bf16* obase, float* fout, const float* g, const float* modl, int which, int m0, int stride, int lane) {
    f32x4 v[4][4]; float s[4]; int mk[4]; bool ok[4];
#pragma unroll
    for (int k = 0; k < 4; ++k) { const int m = m0 + k * stride; ok[k] = m < ML; mk[k] = ok[k] ? m : ML - 1;
#pragma unroll
        for (int j = 0; j < 4; ++j) {
            if (INB) { const u32x2 t = ((const u32x2*)((const bf16*)xbase + (size_t)mk[k] * D))[lane + 64 * j]; v[k][j] = (f32x4){bflo(t.x), bfhi(t.x), bflo(t.y), bfhi(t.y)}; }
            else v[k][j] = __builtin_nontemporal_load((const f32x4*)((const float*)xbase + (size_t)mk[k] * D) + lane + 64 * j); } }
    f32x4 gm[4], sh4[4];
    { const float* mod = FINAL ? g : modl + (m0 >> 13) * 6144 + which * 3072;
#pragma unroll
      for (int j = 0; j < 4; ++j) { const int idx = lane + 64 * j; const f32x4 gv = ((const f32x4*)g)[idx];
          if (FINAL) { gm[j] = gv; sh4[j] = (f32x4){0.f, 0.f, 0.f, 0.f}; }
          else { const f32x4 scv = ((const f32x4*)(mod + 1024))[idx]; sh4[j] = ((const f32x4*)mod)[idx];
#pragma unroll
              for (int e = 0; e < 4; ++e) gm[j][e] = gv[e] * (1.f + scv[e]); } } }
#pragma unroll
    for (int k = 0; k < 4; ++k) { float a = 0.f;
#pragma unroll
        for (int j = 0; j < 4; ++j) a += (v[k][j][0] * v[k][j][0] + v[k][j][1] * v[k][j][1]) + (v[k][j][2] * v[k][j][2] + v[k][j][3] * v[k][j][3]);
        s[k] = a; }
#pragma unroll
    for (int o = 1; o < 64; o <<= 1) {
#pragma unroll
        for (int k = 0; k < 4; ++k) s[k] += shfl_f(s[k], lane ^ o); }
#pragma unroll
    for (int k = 0; k < 4; ++k) { if (!ok[k]) continue;
        const float rstd = 1.f / sqrtf(s[k] * (1.f / D) + EPS);
#pragma unroll
        for (int j = 0; j < 4; ++j) { const int idx = lane + 64 * j;
            if (FINAL) { f32x4 y;
#pragma unroll
                for (int e = 0; e < 4; ++e) y[e] = v[k][j][e] * rstd * gm[j][e];
                ((f32x4*)(fout + (size_t)mk[k] * D))[idx] = y; }
            else { float y[4];
#pragma unroll
                for (int e = 0; e < 4; ++e) y[e] = v[k][j][e] * rstd * gm[j][e] + sh4[j][e];
                u32x2 o; o.x = pk2(y[0], y[1]); o.y = pk2(y[2], y[3]); ((u32x2*)(obase + (size_t)mk[k] * D))[idx] = o; } }
    }
}
__device__ __forceinline__ void norm_phase(PP p, Ctx& F, int l, int which, int mrows) {
    const float* g = (which == 0 ? p->norm1_g : p->norm2_g) + l * D;
    const float* PART = (const float*)(p->ws + WS_PART);
    if (l == 0 && which == 0) { for (int m0 = F.gw; m0 < ML; m0 += 4 * F.NGW) norm_rows4<false, false>(p->x, F.HX, nullptr, g, F.MOD + l * 3 * 6144, which, m0, F.NGW, F.lane); }
    else { const void* xb = (l == 1 && which == 1 && F.G == 256) ? (const void*)(p->ws + WS_XB2) : (const void*)p->out;
        for (int m0 = F.gw; m0 < ML; m0 += 4 * F.NGW) norm_rows4<false, true>(xb, F.HX, nullptr, g, F.MOD + l * 3 * 6144, which, m0, F.NGW, F.lane); }
    for (int m = ML + F.gw; m < mrows; m += F.NGW) {
        int nparts = 0; const float* gate = nullptr;
        const float* xr = ((l == 0 && which == 0) ? p->ctx : F.XC) + (size_t)(m - ML) * D;
        if (l == 0 && which == 1) { nparts = 4; gate = F.MOD + 2 * 6144 + 2048; }
        if (l == 1 && which == 0) { nparts = 11; gate = F.MOD + 2 * 6144 + 5120; }
        const float* part = PART + (size_t)(m - ML) * D; float* xout = F.XC + (size_t)(m - ML) * D;
        const float* mod = F.MOD + (l * 3 + 2) * 6144 + which * 3072;
        norm_row_bf16(xr, F.HX + (size_t)m * D, g, mod + 1024, mod, F.lane, part, nparts, gate, xout);
    }
}
__device__ __forceinline__ void final_norm(PP p, Ctx& F) {
    for (int m0 = F.gw; m0 < ML; m0 += 4 * F.NGW) norm_rows4<true, false>(p->ws + WS_HX  , nullptr, p->out, p->final_g, nullptr, 0, m0, F.NGW, F.lane);
}
constexpr int CP = 260;
__device__ __forceinline__ int chunk_row0(int b, int cidx) { return (cidx < 4) ? (ML + b * CTXL + cidx * 64) : (b * SEQ + (cidx - 4) * 64); }
__device__ __forceinline__ void cum_to_lds(LAS float* cum, const bf16* PB, int row0, int tid) {
    { const int oct = tid & 31, j0 = tid >> 5; u32x4 w[4];
#pragma unroll
      for (int q = 0; q < 4; ++q) w[q] = *(const u32x4*)(PB + (size_t)(row0 + j0 + 16 * q) * NP + PLA + 8 * oct);
#pragma unroll
      for (int q = 0; q < 4; ++q) { LAS float* d = cum + (j0 + 16 * q) * CP + 8 * oct;
          *(LAS f32x4*)d = (f32x4){bflo(w[q].x), bfhi(w[q].x), bflo(w[q].y), bfhi(w[q].y)}; *(LAS f32x4*)(d + 4) = (f32x4){bflo(w[q].z), bfhi(w[q].z), bflo(w[q].w), bfhi(w[q].w)}; } }
    __syncthreads();
    if (tid < 256) { float s = 0.f;
        if (tid < 128) {
#pragma unroll 16
            for (int j = 0; j < 64; ++j) { s += cum[j * CP + tid]; cum[j * CP + tid] = s; }
        } else {
#pragma unroll 16
            for (int j = 63; j >= 0; --j) { s += cum[j * CP + tid]; cum[j * CP + tid] = s; }
        } }
    __syncthreads();
}
typedef float f32x2_t __attribute__((ext_vector_type(2)));
typedef __bf16 bf16x2_t __attribute__((ext_vector_type(2)));
__device__ __forceinline__ unsigned pkh(float lo, float hi) { f32x2_t v = {lo, hi}; bf16x2_t b = __builtin_convertvector(v, bf16x2_t); return __builtin_bit_cast(unsigned, b); }
__device__ __forceinline__ bf16x8 pack8h(float a0, float a1, float a2, float a3, float a4, float a5, float a6, float a7) {
    u32x4 w; w.x = pkh(a0, a1); w.y = pkh(a2, a3); w.z = pkh(a4, a5); w.w = pkh(a6, a7); return __builtin_bit_cast(bf16x8, w);
}
__device__ __forceinline__ void la_load(u32x4 (&w)[4], const bf16* PB, int row0, int tid) {
    const int oct = tid & 31, j0 = tid >> 5;
#pragma unroll
    for (int q = 0; q < 4; ++q) w[q] = *(const u32x4*)(PB + (size_t)(row0 + j0 + 16 * q) * NP + PLA + 8 * oct);
}
__device__ __forceinline__ void la_scan(LAS float* cum, const u32x4 (&w)[4], int tid) {
    const int oct = tid & 31, j0 = tid >> 5;
#pragma unroll
    for (int q = 0; q < 4; ++q) { LAS float* d = cum + (j0 + 16 * q) * CP + 8 * oct;
        *(LAS f32x4*)d = (f32x4){bflo(w[q].x), bfhi(w[q].x), bflo(w[q].y), bfhi(w[q].y)}; *(LAS f32x4*)(d + 4) = (f32x4){bflo(w[q].z), bfhi(w[q].z), bflo(w[q].w), bfhi(w[q].w)}; }
    __syncthreads();
    if (tid < 256) { float carry = 0.f;
        if (tid < 128) {
#pragma unroll
            for (int hf = 0; hf < 4; ++hf) { float v[16];
#pragma unroll
                for (int j = 0; j < 16; ++j) v[j] = cum[(16 * hf + j) * CP + tid];
                v[0] += carry;
#pragma unroll
                for (int j = 1; j < 16; ++j) v[j] += v[j - 1];
                carry = v[15];
#pragma unroll
                for (int j = 0; j < 16; ++j) cum[(16 * hf + j) * CP + tid] = v[j]; }
        } else {
#pragma unroll
            for (int hf = 3; hf >= 0; --hf) { float v[16];
#pragma unroll
                for (int j = 0; j < 16; ++j) v[j] = cum[(16 * hf + j) * CP + tid];
                v[15] += carry;
#pragma unroll
                for (int j = 14; j >= 0; --j) v[j] += v[j + 1];
                carry = v[0];
#pragma unroll
                for (int j = 0; j < 16; ++j) cum[(16 * hf + j) * CP + tid] = v[j]; }
        } }
    __syncthreads();
}
__device__ __forceinline__ void gla_a_item(Ctx& F, int b, int cidx) {
    LAS float* cum = (LAS float*)F.lds; const int row0 = chunk_row0(b, cidx);
    const int h = F.wave & 3, dir = F.wave >> 2, chb = dir * 128 + h * 32, lr = F.lane & 15, g = F.lane >> 4;
    const int jl = dir ? 0 : 63;
    u32x4 wla[4]; la_load(wla, F.PB, row0, F.tid);
    unsigned short kt[2][2][8], vt[2][4][8];
#pragma unroll
    for (int ks = 0; ks < 2; ++ks) { const int j0 = 32 * ks + 8 * g;
#pragma unroll
        for (int mb = 0; mb < 2; ++mb)
#pragma unroll
            for (int e = 0; e < 8; ++e) kt[ks][mb][e] = F.PB[(size_t)(row0 + j0 + e) * NP + PK + h * 32 + 16 * mb + lr];
#pragma unroll
        for (int nb = 0; nb < 4; ++nb)
#pragma unroll
            for (int e = 0; e < 8; ++e) vt[ks][nb][e] = F.PB[(size_t)(row0 + j0 + e) * NP + PV + h * 64 + 16 * nb + lr]; }
    la_scan(cum, wla, F.tid);
    f32x4 acc[2][4];
#pragma unroll
    for (int mb = 0; mb < 2; ++mb)
#pragma unroll
        for (int nb = 0; nb < 4; ++nb) acc[mb][nb] = (f32x4){0.f, 0.f, 0.f, 0.f};
#pragma unroll
    for (int ks = 0; ks < 2; ++ks) {
        bf16x8 af[2], bfr[4]; const int j0 = 32 * ks + 8 * g;
#pragma unroll
        for (int mb = 0; mb < 2; ++mb) { const int dk = 16 * mb + lr; const float last = cum[jl * CP + chb + dk]; float a[8];
#pragma unroll
            for (int e = 0; e < 8; ++e) { const int j = j0 + e; a[e] = bf2f(kt[ks][mb][e]) * __expf(last - cum[j * CP + chb + dk]); }
            af[mb] = pack8h(a[0], a[1], a[2], a[3], a[4], a[5], a[6], a[7]); }
#pragma unroll
        for (int nb = 0; nb < 4; ++nb) { const unsigned short* t = vt[ks][nb];
            u32x4 w; w.x = t[0] | ((unsigned)t[1] << 16); w.y = t[2] | ((unsigned)t[3] << 16); w.z = t[4] | ((unsigned)t[5] << 16); w.w = t[6] | ((unsigned)t[7] << 16);
            bfr[nb] = __builtin_bit_cast(bf16x8, w); }
#pragma unroll
        for (int mb = 0; mb < 2; ++mb)
#pragma unroll
            for (int nb = 0; nb < 4; ++nb) acc[mb][nb] = MFMA16(af[mb], bfr[nb], acc[mb][nb]);
    }
    const size_t sidx = (size_t)(((b * 2 + dir) * 4 + h) * NCH + cidx);
    float* st = F.ST + sidx * 2048;
#pragma unroll
    for (int mb = 0; mb < 2; ++mb)
#pragma unroll
        for (int nb = 0; nb < 4; ++nb) *(f32x4*)(st + (16 * nb + lr) * 32 + 16 * mb + 4 * g) = acc[mb][nb];
    if (F.lane < 32) F.DEC[sidx * 32 + F.lane] = __expf(cum[jl * CP + chb + F.lane]);
    __syncthreads();
}
__device__ __forceinline__ void gla_scan(Ctx& F) {
    LAS float* xa = (LAS float*)F.lds; LAS float* xb = xa + 512;
    const int seg = F.tid >> 6, el = F.tid & 63;
    for (int blk = blockIdx.x; blk < 512; blk += F.G) {
        const int ge = blk * 64 + el, e = ge & 2047, seq = ge >> 11, dir = (seq >> 2) & 1, dk = e & 31;
        float* st = F.ST + (size_t)seq * NCH * 2048 + e; const float* dc = F.DEC + (size_t)seq * NCH * 32 + dk;
        float u[17], d[17];
#pragma unroll
        for (int i = 0; i < 17; ++i) { const int s = seg * 17 + i; const bool ok = s < NCH; const int sc = ok ? s : NCH - 1; const int c = dir ? (sc < 4 ? 3 - sc : 135 - sc) : sc;
            const float uu = st[(size_t)c * 2048], dd = dc[c * 32]; u[i] = ok ? uu : 0.f; d[i] = ok ? dd : 1.f; }
        float A = 1.f, B = 0.f;
#pragma unroll
        for (int i = 0; i < 17; ++i) { B = B * d[i] + u[i]; A *= d[i]; }
        xa[F.tid] = A; xb[F.tid] = B;
        __syncthreads();
        float S = 0.f;
        for (int sg = 0; sg < seg; ++sg) S = S * xa[sg * 64 + el] + xb[sg * 64 + el];
#pragma unroll
        for (int i = 0; i < 17; ++i) { const int s = seg * 17 + i; if (s < NCH) { const int c = dir ? (s < 4 ? 3 - s : 135 - s) : s; st[(size_t)c * 2048] = S; } S = S * d[i] + u[i]; }
        __syncthreads();
    }
}
template <int NI>
__device__ __forceinline__ void gla_c_item(PP p, Ctx& F, int l, int b, int cidx, int sub) {
    LAS float* cum = (LAS float*)F.lds; const int row0 = chunk_row0(b, cidx);
    const int h = F.wave & 3, half = (NI == 2) ? (F.wave >> 2) : sub, ibase = (NI == 2) ? 0 : (F.wave >> 2), lr = F.lane & 15, g = F.lane >> 4;
    u32x4 wla[4]; la_load(wla, F.PB, row0, F.tid);
    f32x4 o[4][2];
#pragma unroll
    for (int mb = 0; mb < 4; ++mb) { o[mb][0] = (f32x4){0.f, 0.f, 0.f, 0.f}; o[mb][1] = (f32x4){0.f, 0.f, 0.f, 0.f}; }
    bf16x8 av[4][2];
#pragma unroll
    for (int mb = 0; mb < 4; ++mb)
#pragma unroll
        for (int pp = 0; pp < 2; ++pp) { unsigned short t[8];
#pragma unroll
            for (int e = 0; e < 8; ++e) { const int j = 32 * pp + (e < 4 ? 4 * g + e : 16 + 4 * g + (e - 4)); t[e] = F.PB[(size_t)(row0 + j) * NP + PV + h * 64 + 16 * mb + lr]; }
            u32x4 w; w.x = t[0] | ((unsigned)t[1] << 16); w.y = t[2] | ((unsigned)t[3] << 16); w.z = t[4] | ((unsigned)t[5] << 16); w.w = t[6] | ((unsigned)t[7] << 16);
            av[mb][pp] = __builtin_bit_cast(bf16x8, w); }
    u32x4 qraw[2], kraw[4]; f32x4 sraw[2][4][2];
#pragma unroll
    for (int ibl = 0; ibl < NI; ++ibl) qraw[ibl] = *(const u32x4*)(F.PB + (size_t)(row0 + 16 * (2 * half + ibase + ibl) + lr) * NP + PQ + h * 32 + 8 * g);
#pragma unroll
    for (int jb = 0; jb < 4; ++jb) kraw[jb] = *(const u32x4*)(F.PB + (size_t)(row0 + 16 * jb + lr) * NP + PK + h * 32 + 8 * g);
    { const float* st = F.ST + (size_t)(((b * 2 + 0) * 4 + h) * NCH + cidx) * 2048;
#pragma unroll
        for (int mb = 0; mb < 4; ++mb) { sraw[0][mb][0] = *(const f32x4*)(st + (16 * mb + lr) * 32 + 8 * g); sraw[0][mb][1] = *(const f32x4*)(st + (16 * mb + lr) * 32 + 8 * g + 4); } }
    la_scan(cum, wla, F.tid);
    { const float* st = F.ST + (size_t)(((b * 2 + 1) * 4 + h) * NCH + cidx) * 2048;
#pragma unroll
        for (int mb = 0; mb < 4; ++mb) { sraw[1][mb][0] = *(const f32x4*)(st + (16 * mb + lr) * 32 + 8 * g); sraw[1][mb][1] = *(const f32x4*)(st + (16 * mb + lr) * 32 + 8 * g + 4); } }
#pragma unroll
    for (int dir = 0; dir < 2; ++dir) {
        const int chb = dir * 128 + h * 32;
        bf16x8 bq[2];
#pragma unroll
        for (int ibl = 0; ibl < NI; ++ibl) { const int i = 16 * (2 * half + ibase + ibl) + lr;
            const u32x4 qw = qraw[ibl];
            const f32x4 c0 = *(const LAS f32x4*)(cum + i * CP + chb + 8 * g), c1 = *(const LAS f32x4*)(cum + i * CP + chb + 8 * g + 4);
            bq[ibl] = pack8h(bflo(qw.x) * __expf(c0[0]), bfhi(qw.x) * __expf(c0[1]), bflo(qw.y) * __expf(c0[2]), bfhi(qw.y) * __expf(c0[3]),
                            bflo(qw.z) * __expf(c1[0]), bfhi(qw.z) * __expf(c1[1]), bflo(qw.w) * __expf(c1[2]), bfhi(qw.w) * __expf(c1[3])); }
#pragma unroll
        for (int mb = 0; mb < 4; ++mb) { const f32x4 s0 = sraw[dir][mb][0], s1 = sraw[dir][mb][1];
            const bf16x8 as = pack8h(s0[0], s0[1], s0[2], s0[3], s1[0], s1[1], s1[2], s1[3]);
            o[mb][0] = MFMA16(as, bq[0], o[mb][0]); if (NI == 2) o[mb][1] = MFMA16(as, bq[1], o[mb][1]); }
#pragma unroll
        for (int pp = 0; pp < 2; ++pp) {
            if ((dir == 0 && half == 0 && pp == 1) || (dir == 1 && half == 1 && pp == 0)) continue;
            f32x4 sc[2][2];
#pragma unroll
            for (int q = 0; q < 2; ++q) { const int jb = 2 * pp + q, j = 16 * jb + lr;
                const u32x4 kw = kraw[jb];
                const f32x4 c0 = *(const LAS f32x4*)(cum + j * CP + chb + 8 * g), c1 = *(const LAS f32x4*)(cum + j * CP + chb + 8 * g + 4);
                const bf16x8 ak = pack8h(bflo(kw.x) * __expf(-c0[0]), bfhi(kw.x) * __expf(-c0[1]), bflo(kw.y) * __expf(-c0[2]), bfhi(kw.y) * __expf(-c0[3]),
                                        bflo(kw.z) * __expf(-c1[0]), bfhi(kw.z) * __expf(-c1[1]), bflo(kw.w) * __expf(-c1[2]), bfhi(kw.w) * __expf(-c1[3]));
#pragma unroll
                for (int ibl = 0; ibl < NI; ++ibl) { f32x4 z = (f32x4){0.f, 0.f, 0.f, 0.f}; z = MFMA16(ak, bq[ibl], z);
                    const int i = 16 * (2 * half + ibase + ibl) + lr;
#pragma unroll
                    for (int r = 0; r < 4; ++r) { const int jj = 16 * jb + 4 * g + r; const bool keep = dir ? (jj >= i) : (jj <= i); z[r] = keep ? z[r] : 0.f; }
                    sc[q][ibl] = z; } }
#pragma unroll
            for (int ibl = 0; ibl < NI; ++ibl) { const bf16x8 pb = pack8h(sc[0][ibl][0], sc[0][ibl][1], sc[0][ibl][2], sc[0][ibl][3], sc[1][ibl][0], sc[1][ibl][1], sc[1][ibl][2], sc[1][ibl][3]);
#pragma unroll
                for (int mb = 0; mb < 4; ++mb) o[mb][ibl] = MFMA16(av[mb][pp], pb, o[mb][ibl]); }
        }
    }
    const float* gg = p->gla_g + l * 64;
#pragma unroll
    for (int ibl = 0; ibl < NI; ++ibl) { float ss = 0.f;
#pragma unroll
        for (int mb = 0; mb < 4; ++mb) ss += (o[mb][ibl][0] * o[mb][ibl][0] + o[mb][ibl][1] * o[mb][ibl][1]) + (o[mb][ibl][2] * o[mb][ibl][2] + o[mb][ibl][3] * o[mb][ibl][3]);
        ss += shfl_f(ss, F.lane ^ 16); ss += shfl_f(ss, F.lane ^ 32);
        const float rstd = 1.f / sqrtf(ss * (1.f / 64.f) + EPS);
        const int i = 16 * (2 * half + ibase + ibl) + lr; const size_t row = (size_t)(row0 + i);
#pragma unroll
        for (int mb = 0; mb < 4; ++mb) { const int dv = 16 * mb + 4 * g; const f32x4 gv = *(const f32x4*)(gg + dv);
            const u32x2 gw = *(const u32x2*)(F.PB + row * NP + PG + h * 64 + dv);
            const float y0 = o[mb][ibl][0] * rstd * gv[0] * silu_f(bflo(gw.x)), y1 = o[mb][ibl][1] * rstd * gv[1] * silu_f(bfhi(gw.x));
            const float y2 = o[mb][ibl][2] * rstd * gv[2] * silu_f(bflo(gw.y)), y3 = o[mb][ibl][3] * rstd * gv[3] * silu_f(bfhi(gw.y));
            u32x2 w; w.x = pk2(y0, y1); w.y = pk2(y2, y3); *(u32x2*)(F.YMIX + row * D + h * 64 + dv) = w; }
    }
    __syncthreads();
}

template <int NKS, int GRP>
__device__ __forceinline__ void dft_mma_lds(f32x4 (&acc)[8], const LAS unsigned char* fl, int pitchB, const bf16* re, const bf16* im, size_t rstride, int khalf, int lane) {
    const int lr = lane & 15, g = lane >> 4;
#pragma unroll
    for (int k0 = 0; k0 < NKS; k0 += GRP) {
        bf16x8 bfrag[GRP];
#pragma unroll
        for (int kq = 0; kq < GRP; ++kq) { const int ks = k0 + kq; const int kk0 = 32 * ks + 8 * g; const bool part = kk0 >= khalf; const int idx = part ? kk0 - khalf : kk0;
            const bf16* src = (part ? im : re) + (size_t)idx * rstride + lr; unsigned short t[8];
#pragma unroll
            for (int e = 0; e < 8; ++e) t[e] = src[(size_t)e * rstride];
            u32x4 w; w.x = t[0] | ((unsigned)t[1] << 16); w.y = t[2] | ((unsigned)t[3] << 16); w.z = t[4] | ((unsigned)t[5] << 16); w.w = t[6] | ((unsigned)t[7] << 16);
            bfrag[kq] = __builtin_bit_cast(bf16x8, w); }
#pragma unroll
        for (int kq = 0; kq < GRP; ++kq) { const int ks = k0 + kq;
#pragma unroll
            for (int mb = 0; mb < 8; ++mb) { const bf16x8 a = *(const LAS bf16x8*)(fl + (16 * mb + lr) * pitchB + (32 * ks + 8 * g) * 2); acc[mb] = MFMA16(a, bfrag[kq], acc[mb]); }
        }
    }
}
__device__ __forceinline__ void f_to_lds(LAS unsigned char* fl, const bf16* Fm, int rows, int rowB, int tid) {
    const int cpr = rowB >> 4, n = rows * cpr;
    for (int i = tid; i < n; i += 512) { const int r = i / cpr, c = i - r * cpr; *(LAS u32x4*)(fl + r * (rowB + 16) + c * 16) = *(const u32x4*)((const unsigned char*)Fm + (size_t)r * rowB + c * 16); }
    __syncthreads();
}
template <int NKS, int GRP = 4, int NMB = 8>
__device__ __forceinline__ void dft_mma(f32x4 (&acc)[NMB], const bf16* Fm, int ldF, int mrow0, const bf16* re, const bf16* im, size_t rstride, int khalf, int lane) {
    const int lr = lane & 15, g = lane >> 4;
#pragma unroll
    for (int k0 = 0; k0 < NKS; k0 += GRP) {
        bf16x8 bfrag[GRP];
#pragma unroll
        for (int kq = 0; kq < GRP; ++kq) { const int ks = k0 + kq; const int kk0 = 32 * ks + 8 * g; const bool part = kk0 >= khalf; const int idx = part ? kk0 - khalf : kk0;
            const bf16* src = (part ? im : re) + (size_t)idx * rstride + lr; unsigned short t[8];
#pragma unroll
            for (int e = 0; e < 8; ++e) t[e] = src[(size_t)e * rstride];
            u32x4 w; w.x = t[0] | ((unsigned)t[1] << 16); w.y = t[2] | ((unsigned)t[3] << 16); w.z = t[4] | ((unsigned)t[5] << 16); w.w = t[6] | ((unsigned)t[7] << 16);
            bfrag[kq] = __builtin_bit_cast(bf16x8, w); }
#pragma unroll
        for (int kq = 0; kq < GRP; ++kq) { const int ks = k0 + kq;
            bf16x8 a[NMB];
#pragma unroll
            for (int mb = 0; mb < NMB; ++mb) a[mb] = *(const bf16x8*)(Fm + (size_t)(mrow0 + 16 * mb + lr) * ldF + 32 * ks + 8 * g);
#pragma unroll
            for (int mb = 0; mb < NMB; ++mb) acc[mb] = MFMA16(a[mb], bfrag[kq], acc[mb]);
            if (kq & 1) __builtin_amdgcn_sched_barrier(0);
        }
    }
}
__device__ __forceinline__ void dft_mma_loop(f32x4 (&acc)[8], const bf16* Fm, int ldF, int mrow0, int nks, const bf16* re, const bf16* im, size_t rstride, int khalf, int lane) {
    const int lr = lane & 15, g = lane >> 4;
#pragma unroll 1
    for (int ks = 0; ks < nks; ++ks) { const int kk0 = 32 * ks + 8 * g; const bool part = kk0 >= khalf; const int idx = part ? kk0 - khalf : kk0;
        const bf16* src = (part ? im : re) + (size_t)idx * rstride + lr; unsigned short t[8];
#pragma unroll
        for (int e = 0; e < 8; ++e) t[e] = src[(size_t)e * rstride];
        u32x4 w; w.x = t[0] | ((unsigned)t[1] << 16); w.y = t[2] | ((unsigned)t[3] << 16); w.z = t[4] | ((unsigned)t[5] << 16); w.w = t[6] | ((unsigned)t[7] << 16);
        const bf16x8 bfrag = __builtin_bit_cast(bf16x8, w);
#pragma unroll
        for (int mb = 0; mb < 8; ++mb) { const bf16x8 a = *(const bf16x8*)(Fm + (size_t)(mrow0 + 16 * mb + lr) * ldF + 32 * ks + 8 * g); acc[mb] = MFMA16(a, bfrag, acc[mb]); }
    }
}
__device__ __forceinline__ void fft_stage1(Ctx& F) {
    const int lr = F.lane & 15, g = F.lane >> 4;
    f_to_lds(F.lds, F.F1, 128, 256, F.tid);
    for (int it = F.gw; it < 4096; it += F.NGW) { const int cb = it & 15, n2 = (it >> 4) & 127, b = it >> 11;
        f32x4 acc[8];
#pragma unroll
        for (int mb = 0; mb < 8; ++mb) acc[mb] = (f32x4){0.f, 0.f, 0.f, 0.f};
        const bf16* re = F.PB + (size_t)(b * SEQ + n2) * NP + PFA + 16 * cb;
        dft_mma_lds<4, 4>(acc, F.lds, 272, re, re + 256, (size_t)128 * NP, 64, F.lane);
#pragma unroll
        for (int mb = 0; mb < 4; ++mb)
#pragma unroll
            for (int r = 0; r < 4; ++r) { const int k1 = 16 * mb + 4 * g + r; const float a = (float)(k1 * n2) * (1.f / 8192.f); const float c = cos_rev(a), s = sin_rev(a);
                const float tr = acc[mb][r], ti = acc[mb + 4][r]; const float xr = tr * c + ti * s, xi = ti * c - tr * s;
                bf16* dst = F.TB + ((size_t)((b * 64 + k1) * 2) * 128 + n2) * 256 + 16 * cb + lr;
                dst[0] = (bf16)f2bf(xr); dst[(size_t)128 * 256] = (bf16)f2bf(xi); }
    }
}
__device__ __forceinline__ void fft_stage2(Ctx& F, int l) {
    const int lr = F.lane & 15, g = F.lane >> 4;
    f_to_lds(F.lds, F.F2, 128, 512, F.tid);
    for (int it = F.gw; it < 2048; it += F.NGW) {
        f32x4 acc[8];
#pragma unroll
        for (int mb = 0; mb < 8; ++mb) acc[mb] = (f32x4){0.f, 0.f, 0.f, 0.f};
        const int cb = it & 15, k1 = (it >> 4) & 63, b = it >> 10;
        const bf16* re = F.TB + (size_t)((b * 64 + k1) * 2) * 128 * 256 + 16 * cb;
        dft_mma_lds<8, 4>(acc, F.lds, 528, re, re + (size_t)128 * 256, 256, 128, F.lane);
#pragma unroll
        for (int mb = 0; mb < 8; ++mb)
#pragma unroll
            for (int r = 0; r < 4; ++r) { const int k2 = 16 * mb + 4 * g + r; F.YMIX[(size_t)(b * SEQ + k1 + 64 * k2) * D + 256 + 16 * cb + lr] = (bf16)f2bf(acc[mb][r]); }
    }
    __syncthreads();
}
__device__ __forceinline__ void ctx_dft(Ctx& F, int w0, int nw) {
    const int lr = F.lane & 15, g = F.lane >> 4;
    for (int it = w0; it >= 0 && it < 256; it += nw) { const int mq = it & 7, cb = (it >> 3) & 15, b = it >> 7;
            f32x4 acc[2] = {(f32x4){0.f, 0.f, 0.f, 0.f}, (f32x4){0.f, 0.f, 0.f, 0.f}};
            const bf16* re = F.PB + (size_t)(ML + b * CTXL) * NP + PFA + 16 * cb;
            dft_mma<8, 4, 2>(acc, F.FC, 512, 32 * mq, re, re, (size_t)NP, 256, F.lane); __builtin_amdgcn_sched_barrier(0);
            dft_mma<8, 4, 2>(acc, F.FC + 256, 512, 32 * mq, re + 256, re + 256, (size_t)NP, 256, F.lane);
#pragma unroll
            for (int mb = 0; mb < 2; ++mb)
#pragma unroll
                for (int r = 0; r < 4; ++r) { const int k = 32 * mq + 16 * mb + 4 * g + r; F.YMIX[(size_t)(ML + b * CTXL + k) * D + 256 + 16 * cb + lr] = (bf16)f2bf(acc[mb][r]); }
        }
}
__device__ __forceinline__ void load8(const bf16* q, float (&v)[8]) { const u32x4 w = *(const u32x4*)q; v[0] = bflo(w.x); v[1] = bfhi(w.x); v[2] = bflo(w.y); v[3] = bfhi(w.y); v[4] = bflo(w.z); v[5] = bfhi(w.z); v[6] = bflo(w.w); v[7] = bfhi(w.w); }
__device__ __forceinline__ void store8(bf16* q, const float (&v)[8]) { u32x4 w; w.x = pk2(v[0], v[1]); w.y = pk2(v[2], v[3]); w.z = pk2(v[4], v[5]); w.w = pk2(v[6], v[7]); *(u32x4*)q = w; }
__device__ __forceinline__ u32x4 ldrow(const bf16* base, int rbase, int t, int n, int col) { const int tc = t < 0 ? 0 : (t > n - 1 ? n - 1 : t); return *(const u32x4*)(base + (size_t)(rbase + tc) * NP + col); }
__device__ __forceinline__ void unpack8(const u32x4 w, float (&v)[8]) { v[0] = bflo(w.x); v[1] = bfhi(w.x); v[2] = bflo(w.y); v[3] = bfhi(w.y); v[4] = bflo(w.z); v[5] = bfhi(w.z); v[6] = bflo(w.w); v[7] = bfhi(w.w); }
__device__ __forceinline__ void convpool_item(PP p, Ctx& F, int l, int it) {
    int rbase, n, t0;
    if (it < 256) { rbase = it * 64; n = 64; t0 = 0; } else { const int sg = it - 256; rbase = ML + (sg >> 2) * CTXL; n = CTXL; t0 = (sg & 3) * 64; }
    const int oct = F.tid & 31, tl = F.tid >> 5, c0 = 8 * oct, tb = t0 + tl * 4;
    {
        u32x4 hw_[6], cw_[6], bw_[4];
#pragma unroll
        for (int i = 0; i < 6; ++i) { hw_[i] = ldrow(F.PB, rbase, tb - 1 + i, n, PH + c0); cw_[i] = ldrow(F.PB, rbase, tb - 1 + i, n, PCG + c0); }
#pragma unroll
        for (int q = 0; q < 4; ++q) bw_[q] = ldrow(F.PB, rbase, tb + q, n, PBG + c0);
        const f32x4 w0a = *(const f32x4*)(p->conv_w + (l * 3 + 0) * 256 + c0), w0b = *(const f32x4*)(p->conv_w + (l * 3 + 0) * 256 + c0 + 4);
        const f32x4 w1a = *(const f32x4*)(p->conv_w + (l * 3 + 1) * 256 + c0), w1b = *(const f32x4*)(p->conv_w + (l * 3 + 1) * 256 + c0 + 4);
        const f32x4 w2a = *(const f32x4*)(p->conv_w + (l * 3 + 2) * 256 + c0), w2b = *(const f32x4*)(p->conv_w + (l * 3 + 2) * 256 + c0 + 4);
        const f32x4 cba = *(const f32x4*)(p->conv_b + l * 256 + c0), cbb = *(const f32x4*)(p->conv_b + l * 256 + c0 + 4);
        float hc[6][8];
#pragma unroll
        for (int i = 0; i < 6; ++i) { float a[8], b[8]; unpack8(hw_[i], a); unpack8(cw_[i], b); const int t = tb - 1 + i; const float msk = (t >= 0 && t < n) ? 1.f : 0.f;
#pragma unroll
            for (int e = 0; e < 8; ++e) hc[i][e] = a[e] * b[e] * msk; }
#pragma unroll
        for (int q = 0; q < 4; ++q) { float bg[8], y[8]; unpack8(bw_[q], bg);
#pragma unroll
            for (int e = 0; e < 8; ++e) { const float w0 = e < 4 ? w0a[e & 3] : w0b[e & 3], w1 = e < 4 ? w1a[e & 3] : w1b[e & 3], w2 = e < 4 ? w2a[e & 3] : w2b[e & 3], cb = e < 4 ? cba[e & 3] : cbb[e & 3];
                y[e] = bg[e] * (w0 * hc[q][e] + w1 * hc[q + 1][e] + w2 * hc[q + 2][e] + cb); }
            store8(F.YMIX + (size_t)(rbase + tb + q) * D + 512 + c0, y); }
    }
    __builtin_amdgcn_sched_barrier(0);
    {
        const int wnd = 2 << (oct >> 3), hw = wnd >> 1;
        float s[4][8], self[4][8];
#pragma unroll
        for (int q = 0; q < 4; ++q) { unpack8(ldrow(F.PB, rbase, tb + q, n, PPOOL + c0), self[q]);
#pragma unroll
            for (int e = 0; e < 8; ++e) s[q][e] = 0.f; }
        __builtin_amdgcn_sched_barrier(0);
#pragma unroll
        for (int bt = 0; bt < 19; bt += 7) {
            u32x4 pw[7];
#pragma unroll
            for (int ii = 0; ii < 7; ++ii) if (bt + ii < 19) pw[ii] = ldrow(F.PB, rbase, tb - hw + bt + ii, n, PPOOL + c0);
#pragma unroll
            for (int ii = 0; ii < 7; ++ii) if (bt + ii < 19) { const int i = bt + ii; float v[8]; unpack8(pw[ii], v); const int t = tb - hw + i; const bool inr = (t >= 0 && t < n);
#pragma unroll
                for (int q = 0; q < 4; ++q) { const float mk = (inr && i >= q && i < q + wnd) ? 1.f : 0.f;
#pragma unroll
                    for (int e = 0; e < 8; ++e) s[q][e] += mk * v[e]; } }
            __builtin_amdgcn_sched_barrier(0);
        }
#pragma unroll
        for (int q = 0; q < 4; ++q) { const int t = tb + q; const int lo = (t - hw > 0) ? t - hw : 0, hi = (t + hw - 1 < n - 1) ? t + hw - 1 : n - 1; const float inv = 1.f / (float)(hi - lo + 1);
            float y[8];
#pragma unroll
            for (int e = 0; e < 8; ++e) y[e] = s[q][e] * inv - self[q][e];
            store8(F.YMIX + (size_t)(rbase + t) * D + 768 + c0, y); }
    }
}
__device__ __forceinline__ void ctx_act(PP p, Ctx& F, int l) {
    const int gt = blockIdx.x * 512 + F.tid, NT = F.G * 512;
    for (int i = gt; i < MC * 352; i += NT) { const int oc = i % 352, rc = i / 352, t = rc & 255, c0 = 8 * oc;
        const bf16* base = F.CAU + (size_t)rc * NUP + c0; float a[8], y[8], u[8];
        const float* cw = p->ffn_cw + (size_t)l * 3 * DFF + c0; const float* cb = p->ffn_cb + (size_t)l * DFF + c0;
#pragma unroll
        for (int e = 0; e < 8; ++e) y[e] = cb[e];
        if (t > 0) { load8(base - NUP, a);
#pragma unroll
            for (int e = 0; e < 8; ++e) y[e] += cw[e] * a[e]; }
        load8(base, a);
#pragma unroll
        for (int e = 0; e < 8; ++e) y[e] += cw[DFF + e] * a[e];
        if (t < 255) { load8(base + NUP, a);
#pragma unroll
            for (int e = 0; e < 8; ++e) y[e] += cw[2 * DFF + e] * a[e]; }
        load8(base + DFF, u);
#pragma unroll
        for (int e = 0; e < 8; ++e) y[e] = silu_f(y[e]) * u[e];
        store8(F.ACT + (size_t)(ML + rc) * DFF + c0, y);
    }
}
__global__ void __launch_bounds__(512, 2) fwd_megakernel(Params p_) {
    PP p = (PP)__builtin_amdgcn_kernarg_segment_ptr();
    extern __shared__ __attribute__((aligned(16))) unsigned char lds_raw[];
    cg::grid_group grid = cg::this_grid();
    Ctx F;
    F.lds = (LAS unsigned char*)lds_raw; F.tid = threadIdx.x; F.lane = F.tid & 63; F.wave = __builtin_amdgcn_readfirstlane(F.tid >> 6);
    const int wave_s = F.wave;
    F.G = gridDim.x; F.gw = blockIdx.x * 8 + F.wave; F.NGW = F.G * 8;
    unsigned char* ws = p->ws;
#define SETPTRS() do { { PP q_ = (PP)__builtin_amdgcn_kernarg_segment_ptr(); asm volatile("" : "+s"(q_)); p = q_; } unsigned char* w_ = p->ws; asm volatile("" : "+s"(w_)); \
    F.MOD = (float*)(w_ + WS_MOD); F.MCS = (float*)(w_ + WS_MCS); F.F1 = (bf16*)(w_ + WS_F1); F.F2 = (bf16*)(w_ + WS_F2); F.FC = (bf16*)(w_ + WS_FC); \
    F.HX = (bf16*)(w_ + WS_HX); F.TB = (bf16*)(w_ + WS_HX); F.YMIX = (bf16*)(w_ + WS_YMIX); F.PB = (bf16*)(w_ + WS_P); F.ACT = (bf16*)(w_ + WS_P); \
    F.XC = (float*)(w_ + WS_XC); F.ST = (float*)(w_ + WS_ST); F.DEC = (float*)(w_ + WS_DEC); F.CAU = (bf16*)(w_ + WS_CAU); } while (0)
    SETPTRS();

#ifndef NO_P0
#define REFRESH() do { int t_; asm volatile("v_mbcnt_lo_u32_b32 %0, -1, 0\n\tv_mbcnt_hi_u32_b32 %0, -1, %0" : "=v"(t_)); t_ |= (wave_s << 6); F.tid = t_; F.lane = t_ & 63; F.wave = __builtin_amdgcn_readfirstlane(t_ >> 6); F.gw = blockIdx.x * 8 + F.wave; SETPTRS(); } while (0)
    { volatile LAS unsigned* misc = (volatile LAS unsigned*)(F.lds + RING_BYTES); if (F.tid < 64) misc[F.tid] = 0u; }
    __syncthreads();
    XcdBarrier bar = xcd_barrier_post((unsigned*)(ws + WS_CTL), (volatile LAS unsigned*)(F.lds + RING_BYTES) + 8, F.tid);
#define GSYNC() do { REFRESH(); xcd_barrier(bar, F.tid); } while (0)
    REFRESH();
    phase0(p, F);
#endif
    if (p->ws == nullptr) grid.sync();
    GSYNC();
#define L0() ({ int lq_ = l; asm volatile("" : "+s"(lq_)); lq_ == 0; })
    for (int l = 0; l < 2; ++l) {
        const int M6 = L0() ? MT : ML;
#ifndef NO_P1
        REFRESH();
        norm_phase(p, F, l, 0, MT);
        REFRESH();
        if (L0()) fold_items(p, F);
#ifdef PROBE_B
        REFRESH(); norm_phase(p, F, l, 0, MT); if (L0()) fold_items(p, F);
#endif
#endif
        GSYNC();
#ifndef NO_P2
        REFRESH();
        { pg8::Gemm g{F.HX, win_t(p, l), MT, NP, D, D}; pg8::StaticOrder S; S.init(MT, NP, F.G, (int)blockIdx.x);
          EpiP E{F.PB, p->b_a2 + l * 256};
          pg8::gemm_phase<EpiP, pg8::StaticOrder, true, true>(F.lds, g, S, E, F.tid);
#ifdef PROBE_C
          __syncthreads(); pg8::gemm_phase<EpiP, pg8::StaticOrder, true, true>(F.lds, g, S, E, F.tid);
#endif
        }
#endif
        GSYNC();
#ifdef PROBE_A
        for (int rep_ = 0; rep_ < 2; ++rep_) {
#else
        {
#endif
#ifndef NO_GA
        REFRESH();
        for (int it = blockIdx.x; it < 2 * NCH; it += F.G) gla_a_item(F, it / NCH, it % NCH);
#ifdef PR_GA
        __syncthreads(); REFRESH();
        for (int it = blockIdx.x; it < 2 * NCH; it += F.G) gla_a_item(F, it / NCH, it % NCH);
#endif
#endif
#ifndef NO_F1
        REFRESH();
        fft_stage1(F);
#ifdef PR_F1
        __syncthreads(); REFRESH();
        fft_stage1(F);
#endif
#endif
#ifndef NO_CP
        REFRESH();
        for (int v = blockIdx.x; v < 512; v += F.G) { const int it = (v < 256) ? v : 256 + ((v + 248) & 255);
            if (it >= (L0() ? 264 : 256)) continue; convpool_item(p, F, l, it); }
#ifdef PR_CP
        __syncthreads(); REFRESH();
        for (int v = blockIdx.x; v < 512; v += F.G) { const int it = (v < 256) ? v : 256 + ((v + 248) & 255);
            if (it >= (L0() ? 264 : 256)) continue; convpool_item(p, F, l, it); }
#endif
#endif
        }
        GSYNC();
#ifdef PROBE_A
        REFRESH(); fft_stage2(F, l);
#endif
#ifndef NO_F2
        REFRESH();
        fft_stage2(F, l);
#ifdef PR_F2
        __syncthreads(); REFRESH();
        fft_stage2(F, l);
#endif
#endif
#ifndef NO_SC
        REFRESH();
        gla_scan(F);
#endif
        GSYNC();
#ifdef PROBE_A
        for (int rep_ = 0; rep_ < 2; ++rep_) {
#else
        {
#endif
#ifndef NO_GC
        REFRESH();
        for (int it = blockIdx.x; it < 256; it += F.G) gla_c_item<2>(p, F, l, it >> 7, 4 + (it & 127), 0);
        if (L0()) for (int j = blockIdx.x; j < 16; j += F.G) gla_c_item<1>(p, F, l, j >> 3, (j >> 1) & 3, j & 1);
        if (L0()) { if (F.G == 256) ctx_dft(F, F.gw - 256, 1 << 30); else ctx_dft(F, F.gw, F.NGW); }
#ifdef PR_GC
        __syncthreads(); REFRESH();
        for (int it = blockIdx.x; it < 256; it += F.G) gla_c_item<2>(p, F, l, it >> 7, 4 + (it & 127), 0);
#endif
#endif
        }
        GSYNC();
#ifndef NO_P6
        REFRESH();
        if (L0()) { pg8::Gemm g{F.YMIX, wout_t(p, l), MT, D, 256, D}; SplitOrder S; S.init(4, F.G, (int)blockIdx.x);
          EpiPartial E{(float*)(p->ws + WS_PART)};
          pg8::gemm_phase<EpiPartial, SplitOrder, false, false>(F.lds, g, S, E, F.tid); __syncthreads(); }
        REFRESH();
        { pg8::Gemm g{F.YMIX, wout_t(p, l), ML, D, D, D}; pg8::StaticOrder S; S.init(ML, D, F.G, (int)blockIdx.x);
          if (L0()) { EpiRes<false, true> E{p->x, p->out, F.MOD + l * 3 * 6144 + 2048}; pg8::gemm_phase<EpiRes<false, true>, pg8::StaticOrder, true, true>(F.lds, g, S, E, F.tid); }
          else if (F.G == 256) { EpiResNorm E{(const bf16*)p->out, (bf16*)(p->ws + WS_XB2), F.HX, F.MOD + l * 3 * 6144 + 2048, p->norm2_g + l * D, F.MOD + l * 3 * 6144, (float*)(p->ws + WS_SLOT) + 65536 * 2, (unsigned*)(p->ws + WS_CTL) + CW_FIN + 4096};
            pg8::gemm_phase<EpiResNorm, pg8::StaticOrder, false, true>(F.lds, g, S, E, F.tid); }
          else { EpiRes<true, true> E{p->out, p->out, F.MOD + l * 3 * 6144 + 2048}; pg8::gemm_phase<EpiRes<true, true>, pg8::StaticOrder, true, true>(F.lds, g, S, E, F.tid); } }
#endif
        GSYNC();
        if (L0() || F.G != 256) { REFRESH(); norm_phase(p, F, l, 1, M6); GSYNC(); }
#ifndef NO_P8
        REFRESH();
        { pg8::Gemm g{F.HX, wup_t(p, l), ML, NUP, D, D}; pg8::StaticOrder S; S.init(ML, NUP, F.G, (int)blockIdx.x);
          EpiUp E{F.ACT, p->ffn_cw + (size_t)l * 3 * DFF, p->ffn_cb + (size_t)l * DFF};
          pg8::gemm_phase<EpiUp, pg8::StaticOrder, true, true>(F.lds, g, S, E, F.tid);
        }
        if (L0()) { REFRESH(); __syncthreads();
          pg8::Gemm g{F.HX, wup_t(p, l), MT, NUP, D, D}; CtxOrder S; S.init(NUP, (int)blockIdx.x, 128);
          EpiUpCtx E{F.ACT, p->ffn_cw + (size_t)l * 3 * DFF, p->ffn_cb + (size_t)l * DFF, (LAS float*)(F.lds + RING_BYTES + 1024)};
          pg8::gemm_phase<EpiUpCtx, CtxOrder, true, false>(F.lds, g, S, E, F.tid); }
#endif
        GSYNC();
#ifndef NO_P9
        REFRESH();
        if (L0()) { pg8::Gemm g{F.ACT, wdn_t(p, l), MT, D, 256, DFF}; SplitOrder S; S.init(11, F.G, (int)blockIdx.x);
          EpiPartial E{(float*)(p->ws + WS_PART)};
          pg8::gemm_phase<EpiPartial, SplitOrder, false, false>(F.lds, g, S, E, F.tid); __syncthreads(); }
        REFRESH();
        { pg8::Gemm g{F.ACT, wdn_t(p, l), ML, D, DFF, DFF}; pg8::StaticOrder S; S.init(ML, D, F.G, (int)blockIdx.x);
          if (L0()) { EpiRes<true, true> E{p->out, p->out, F.MOD + l * 3 * 6144 + 5120}; pg8::gemm_phase<EpiRes<true, true>, pg8::StaticOrder, true, true>(F.lds, g, S, E, F.tid); }
          else if (F.G == 256) { EpiFinal E{(const bf16*)(p->ws + WS_XB2), p->out, F.MOD + l * 3 * 6144 + 5120, p->final_g, (float*)(p->ws + WS_SLOT), (unsigned*)(p->ws + WS_CTL) + CW_FIN};
            pg8::gemm_phase<EpiFinal, pg8::StaticOrder, false, true>(F.lds, g, S, E, F.tid); }
          else { EpiRes<true, false> E{p->out, p->ws + WS_HX, F.MOD + l * 3 * 6144 + 5120}; pg8::gemm_phase<EpiRes<true, false>, pg8::StaticOrder, true, true>(F.lds, g, S, E, F.tid); } }
#endif
        if (L0() || F.G != 256) GSYNC();
    }
        REFRESH();
    if (F.G != 256) final_norm(p, F);
}

extern "C" void kernel_launch(void* const* d_in, const int* in_sizes, int n_in, void* d_out, int out_size, void* d_ws, size_t ws_size, hipStream_t stream) {
    static int grid = 0;
    if (grid == 0) {
        if (n_in != 23 || in_sizes[0] != ML * D || out_size != ML * D || ws_size < WS_END) { fprintf(stderr, "kernel_launch: unexpected shapes / workspace (%d inputs, ws %zu)\n", n_in, ws_size); grid = -1; return; }
        int dev = 0, cus = 0, per_cu = 0;
        hipGetDevice(&dev); hipDeviceGetAttribute(&cus, hipDeviceAttributeMultiprocessorCount, dev);
        if (hipFuncSetAttribute((const void*)fwd_megakernel, hipFuncAttributeMaxDynamicSharedMemorySize, LDS_BYTES) != hipSuccess) { fprintf(stderr, "hipFuncSetAttribute failed\n"); grid = -1; return; }
        if (hipOccupancyMaxActiveBlocksPerMultiprocessor(&per_cu, (const void*)fwd_megakernel, 512, LDS_BYTES) != hipSuccess || per_cu < 1) per_cu = 1;
        (void)hipGetLastError();
        grid = cus * 1;
    }
    if (grid < 0) return;
    if (hipMemsetAsync((char*)d_ws + WS_CTL, 0, 65536, stream) != hipSuccess) { fprintf(stderr, "memset failed\n"); return; }
    Params p{};
    const float** pp = (const float**)&p;
    for (int i = 0; i < 23; ++i) pp[i] = (const float*)d_in[i];
    p.out = (float*)d_out; p.ws = (unsigned char*)d_ws;
    void* args[] = {&p};
    hipError_t e = hipLaunchCooperativeKernel((const void*)fwd_megakernel, dim3(grid), dim3(512), args, LDS_BYTES, stream);
    if (e != hipSuccess) fprintf(stderr, "cooperative launch failed: %s (grid %d)\n", hipGetErrorString(e), grid);
}
```

```cpp
#include <hip/hip_runtime.h>
#include <hip/hip_cooperative_groups.h>
#include <cstdio>
#include <cstdint>
namespace cg = cooperative_groups;
namespace pg8 {
#define PG8_LAS __attribute__((address_space(3)))
typedef unsigned short bf16_t;
typedef short bf16x8 __attribute__((ext_vector_type(8)));
typedef float f32x4 __attribute__((ext_vector_type(4)));
typedef unsigned u32x4 __attribute__((ext_vector_type(4)));
constexpr int BM = 256, BK = 64, HALF = 128, HTB = HALF * BK * 2  , STAGE_BYTES = 8 * HTB, NXCD = 8, WGM = 8;

__host__ __device__ __forceinline__ int lds_byte(int r, int c) { const int st = (r >> 4) * 2 + (c >> 5), rr = r & 15, cc = c & 31, ob = rr * 64 + cc * 2; return st * 1024 + (ob ^ (((ob >> 9) & 1) << 5)); }
__host__ __device__ __forceinline__ void stage_rc(int b, int& R, int& C) { const int st = b / 1024, sb = b % 1024, swz = sb ^ (((sb >> 9) & 1) << 5); R = (st >> 1) * 16 + swz / 64; C = (st & 1) * 32 + (swz % 64) / 2; }
__host__ __device__ __forceinline__ int perm32(int rho) { const int n = rho >> 4, i = rho & 15; return 8 * (i >> 2) + 4 * n + (i & 3); }

struct Unit { int pm, pn, ks; };
struct Gemm { const bf16_t* A; const bf16_t* Bt; int M, N, K, ld; };

struct StaticOrder {
    int nM, nN, nwg, G, c;
    __host__ __device__ void init(int M, int N, int G_, int c_) { nM = M / BM; nN = N / BM; nwg = nM * nN; G = G_; c = c_; }
    __host__ __device__ bool next(int i, Unit& u) const {
        const long L = (long)i * G + c; if (L >= nwg) return false;
        int wgid = (int)L; { const int q = nwg / NXCD, r = nwg % NXCD, xcd = wgid % NXCD, off = wgid / NXCD; wgid = (xcd < r ? xcd * (q + 1) : r * (q + 1) + (xcd - r) * q) + off; }
        const int nig = WGM * nN, gid = wgid / nig, fm = gid * WGM, gsz = (nM - fm) < WGM ? (nM - fm) : WGM;
        u.pm = fm + ((wgid % nig) % gsz); u.pn = (wgid % nig) / gsz; u.ks = 0; return true;
    }
    __device__ __forceinline__ void a_ready(const Unit&) const {}
    __device__ __forceinline__ void done(const Unit&) const {}
};

__device__ __forceinline__ unsigned cvt_pk_bf16(float lo, float hi) { unsigned r; asm volatile("v_cvt_pk_bf16_f32 %0, %1, %2" : "=v"(r) : "v"(lo), "v"(hi)); return r; }
template <class Epi, class Sched, bool ALIGN_EPI = false, bool SP2 = false>
__device__ __forceinline__ void gemm_phase(PG8_LAS unsigned char* lds, const Gemm g, const Sched& S, const Epi& E, int tid_in) {
    int tid_ = tid_in; asm volatile("" : "+v"(tid_)); const int tid = tid_, wid = __builtin_amdgcn_readfirstlane(tid >> 6), lane = tid & 63, wr = wid >> 2, wc = wid & 3, fr = lane & 15, fq = lane >> 4;
    const int K = g.ld, nt = g.K / BK; const size_t sstep = (size_t)g.K * 2;
    unsigned voffA[2], voffB[2];
#pragma unroll
    for (int i = 0; i < 2; ++i) { int R, C; stage_rc(tid * 16 + i * 8192, R, C); const int Rb = Epi::PERM ? ((R & ~31) + perm32(R & 31)) : R;
        voffA[i] = (unsigned)(R * K + C) * 2u; voffB[i] = (unsigned)(Rb * K + C) * 2u; }
    const size_t kstep = (size_t)(BK * 2);
    const size_t hstep = (size_t)HALF * K * 2;
    const size_t tstep = 2 * hstep;
    const unsigned ldsw = (unsigned)wid * 1024u;
    const int aoff = lds_byte(wr * 64 + fr, fq * 8), boff = lds_byte(wc * 32 + fr, fq * 8);
#define PG8_SA(b, h) (((b) * 2 + (h)) * HTB)
#define PG8_SB(b, h) ((4 + (b) * 2 + (h)) * HTB)
#define PG8_STAGE(bufoff, gbase, voff) do { _Pragma("unroll") for (int _i = 0; _i < 2; ++_i) \
        __builtin_amdgcn_global_load_lds((const unsigned*)((const char*)(gbase) + (voff)[_i]), (PG8_LAS unsigned*)(lds + (bufoff) + ldsw + _i * 8192), 16, 0, 0); } while (0)
#define PG8_LDA(dst, b, h) do { _Pragma("unroll") for (int m = 0; m < 4; ++m) _Pragma("unroll") for (int k = 0; k < 2; ++k) dst[m][k] = *(const PG8_LAS bf16x8*)(lds + PG8_SA(b, h) + aoff + m * 2048 + k * 1024); } while (0)
#define PG8_LDB(dst, b, h) do { _Pragma("unroll") for (int n = 0; n < 2; ++n) _Pragma("unroll") for (int k = 0; k < 2; ++k) dst[n][k] = *(const PG8_LAS bf16x8*)(lds + PG8_SB(b, h) + boff + n * 2048 + k * 1024); } while (0)
#define PG8_MMA(ai, bj, At, Bt) do { __builtin_amdgcn_s_setprio(1); _Pragma("unroll") for (int m = 0; m < 4; ++m) _Pragma("unroll") for (int n = 0; n < 2; ++n) _Pragma("unroll") for (int k = 0; k < 2; ++k) \
        acc[ai][bj][m][n] = __builtin_amdgcn_mfma_f32_16x16x32_bf16(Bt[n][k], At[m][k], acc[ai][bj][m][n], 0, 0, 0); __builtin_amdgcn_s_setprio(0); } while (0)
#define PG8_WAIT_V(n) asm volatile("s_waitcnt vmcnt(" #n ")" ::: "memory")
#define PG8_WAIT_L(n) asm volatile("s_waitcnt lgkmcnt(" #n ")" ::: "memory")
#define PG8_BAR __builtin_amdgcn_s_barrier()
#define PG8_SCHED __builtin_amdgcn_sched_barrier(0)
    Unit cur, nxt; int ui = 0;
    if (!S.next(0, cur)) return;
    f32x4 acc[2][2][4][2];
#pragma unroll
    for (int a = 0; a < 2; ++a)
#pragma unroll
        for (int b = 0; b < 2; ++b)
#pragma unroll
            for (int m = 0; m < 4; ++m)
#pragma unroll
                for (int n = 0; n < 2; ++n) acc[a][b][m][n] = (f32x4){0.f, 0.f, 0.f, 0.f};
    bf16x8 At[4][2], B0[2][2], B1[2][2];
    const char* cA = (const char*)g.A + (size_t)cur.pm * tstep + (size_t)cur.ks * sstep; const char* cB = (const char*)g.Bt + (size_t)cur.pn * tstep + (size_t)cur.ks * sstep;
    S.a_ready(cur);
    if constexpr (SP2) {
        PG8_STAGE(PG8_SB(0, 0), cB, voffB); PG8_STAGE(PG8_SB(0, 1), cB + hstep, voffB); PG8_STAGE(PG8_SA(0, 0), cA, voffA); PG8_STAGE(PG8_SA(0, 1), cA + hstep, voffA);
        if (wr == 1) PG8_BAR;
        PG8_WAIT_V(2); PG8_BAR;
        PG8_STAGE(PG8_SB(1, 0), cB + kstep, voffB); PG8_STAGE(PG8_SA(1, 0), cA + kstep, voffA); PG8_STAGE(PG8_SB(1, 1), cB + hstep + kstep, voffB);
        PG8_WAIT_V(6); PG8_BAR;
    } else {
        PG8_STAGE(PG8_SB(0, 0), cB, voffB); PG8_STAGE(PG8_SA(0, 0), cA, voffA); PG8_STAGE(PG8_SB(0, 1), cB + hstep, voffB); PG8_STAGE(PG8_SA(0, 1), cA + hstep, voffA);
        if (wr == 1) PG8_BAR;
        PG8_WAIT_V(4); PG8_BAR;
        PG8_STAGE(PG8_SB(1, 0), cB + kstep, voffB); PG8_STAGE(PG8_SA(1, 0), cA + kstep, voffA); PG8_STAGE(PG8_SB(1, 1), cB + hstep + kstep, voffB);
        PG8_WAIT_V(6); PG8_BAR;
    }
    for (;;) {
        const bool has_next = S.next(ui + 1, nxt);
        const char* nA = has_next ? (const char*)g.A + (size_t)nxt.pm * tstep + (size_t)nxt.ks * sstep : cA; const char* nB = has_next ? (const char*)g.Bt + (size_t)nxt.pn * tstep + (size_t)nxt.ks * sstep : cB;
        for (int t = 0; t < nt; t += 2) {
            const bool last = (t == nt - 2);
            const char* a1 = cA + (size_t)(t + 1) * kstep;
            const char* a2 = last ? nA : cA + (size_t)(t + 2) * kstep; const char* b2 = last ? nB : cB + (size_t)(t + 2) * kstep;
            const char* a3 = a2 + kstep; const char* b3 = b2 + kstep;
            if (last && has_next) S.a_ready(nxt);
            if constexpr (SP2) {
            PG8_LDB(B0, 0, 0); PG8_LDB(B1, 0, 1); PG8_SCHED; PG8_LDA(At, 0, 0); PG8_STAGE(PG8_SA(1, 1), a1 + hstep, voffA);
            PG8_WAIT_V(8); PG8_WAIT_L(0); PG8_BAR; PG8_MMA(0, 0, At, B0); PG8_MMA(0, 1, At, B1); PG8_BAR; PG8_SCHED;
            PG8_LDA(At, 0, 1); PG8_STAGE(PG8_SB(0, 0), b2, voffB); PG8_STAGE(PG8_SB(0, 1), b2 + hstep, voffB); PG8_STAGE(PG8_SA(0, 0), a2, voffA);
            PG8_WAIT_V(8); PG8_WAIT_L(0); PG8_BAR; PG8_MMA(1, 0, At, B0); PG8_MMA(1, 1, At, B1); PG8_BAR; PG8_SCHED;
            PG8_LDB(B0, 1, 0); PG8_LDB(B1, 1, 1); PG8_SCHED; PG8_LDA(At, 1, 0); PG8_STAGE(PG8_SA(0, 1), a2 + hstep, voffA);
            PG8_WAIT_V(8); PG8_WAIT_L(0); PG8_BAR; PG8_MMA(0, 0, At, B0); PG8_MMA(0, 1, At, B1); PG8_BAR; PG8_SCHED;
            PG8_LDA(At, 1, 1); PG8_STAGE(PG8_SB(1, 0), b3, voffB); PG8_STAGE(PG8_SB(1, 1), b3 + hstep, voffB); PG8_STAGE(PG8_SA(1, 0), a3, voffA);
            PG8_WAIT_V(8); PG8_WAIT_L(0); PG8_BAR; PG8_MMA(1, 0, At, B0); PG8_MMA(1, 1, At, B1); PG8_BAR; PG8_SCHED;
            } else {
            PG8_LDB(B0, 0, 0); PG8_SCHED; PG8_LDA(At, 0, 0); PG8_STAGE(PG8_SA(1, 1), a1 + hstep, voffA);
            PG8_WAIT_L(8); PG8_BAR; PG8_WAIT_L(0); PG8_MMA(0, 0, At, B0); PG8_BAR; PG8_SCHED;
            PG8_LDB(B1, 0, 1); PG8_STAGE(PG8_SB(0, 0), b2, voffB);
            PG8_BAR; PG8_WAIT_L(0); PG8_MMA(0, 1, At, B1); PG8_BAR;
            PG8_LDA(At, 0, 1); PG8_STAGE(PG8_SA(0, 0), a2, voffA);
            PG8_BAR; PG8_WAIT_L(0); PG8_MMA(1, 0, At, B0); PG8_BAR; PG8_SCHED;
            PG8_STAGE(PG8_SB(0, 1), b2 + hstep, voffB);
            PG8_WAIT_V(6); PG8_BAR; PG8_MMA(1, 1, At, B1); PG8_BAR;
            PG8_LDB(B0, 1, 0); PG8_SCHED; PG8_LDA(At, 1, 0); PG8_STAGE(PG8_SA(0, 1), a2 + hstep, voffA);
            PG8_WAIT_L(8); PG8_BAR; PG8_WAIT_L(0); PG8_MMA(0, 0, At, B0); PG8_BAR; PG8_SCHED;
            PG8_LDB(B1, 1, 1); PG8_STAGE(PG8_SB(1, 0), b3, voffB);
            PG8_BAR; PG8_WAIT_L(0); PG8_MMA(0, 1, At, B1); PG8_BAR;
            PG8_LDA(At, 1, 1); PG8_STAGE(PG8_SA(1, 0), a3, voffA);
            PG8_BAR; PG8_WAIT_L(0); PG8_MMA(1, 0, At, B0); PG8_BAR; PG8_SCHED;
            PG8_STAGE(PG8_SB(1, 1), b3 + hstep, voffB);
            PG8_WAIT_V(6); PG8_BAR; PG8_MMA(1, 1, At, B1); PG8_BAR;
            }
        }
        if constexpr (ALIGN_EPI) { if (wr == 0) PG8_BAR; }
        if constexpr (!Epi::AFTER_DRAIN) { E(acc, cur, wr, wc, fr, fq); S.done(cur); }
        if (!has_next) break;
#pragma unroll
        for (int a = 0; a < 2; ++a)
#pragma unroll
            for (int b = 0; b < 2; ++b)
#pragma unroll
                for (int m = 0; m < 4; ++m)
#pragma unroll
                    for (int n = 0; n < 2; ++n) acc[a][b][m][n] = (f32x4){0.f, 0.f, 0.f, 0.f};
        cur = nxt; cA = nA; cB = nB; ++ui;
        if constexpr (ALIGN_EPI) { if (wr == 1) PG8_BAR; }
    }
    PG8_WAIT_V(0);
    if constexpr (!ALIGN_EPI) { if (wr == 0) PG8_BAR; }
    PG8_BAR;
    if constexpr (Epi::AFTER_DRAIN) { E.fused(acc, cur, wr, wc, fr, fq, lds, wid, lane); S.done(cur); }
#undef PG8_SA
#undef PG8_SB
#undef PG8_STAGE
#undef PG8_LDA
#undef PG8_LDB
#undef PG8_MMA
#undef PG8_WAIT_V
#undef PG8_WAIT_L
#undef PG8_BAR
#undef PG8_SCHED
}
}
#define LAS __attribute__((address_space(3)))
typedef unsigned short bf16;
typedef float f32x4 __attribute__((ext_vector_type(4)));
typedef short bf16x8 __attribute__((ext_vector_type(8)));
typedef unsigned u32x4 __attribute__((ext_vector_type(4)));
typedef unsigned u32x2 __attribute__((ext_vector_type(2)));
#define LDS_WAIT() asm volatile("s_waitcnt lgkmcnt(0)" ::: "memory")

constexpr int D = 1024, SEQ = 8192, ML = 16384, MC = 512, MT = ML + MC, CTXL = 256;
constexpr int DIN = 2080, NP = 2560, DFF = 2816, NUP = 5632;
constexpr int PK = 0, PQ = 128, PV = 256, PLA = 512, PG = 768, PFA = 1024, PFB = 1280, PH = 1536, PBG = 1792, PCG = 2048, PPOOL = 2304;
constexpr int NCH = 132;
constexpr float EPS = 1e-6f;
constexpr size_t MiB = 1u << 20;
constexpr size_t WS_CTL = 0;
constexpr size_t WS_MOD = 1 * MiB;
constexpr size_t WS_MCS = 1 * MiB + 256 * 1024;
constexpr size_t WS_F1 = 1 * MiB + 512 * 1024;
constexpr size_t WS_F2 = WS_F1 + 32 * 1024;
constexpr size_t WS_FC = WS_F2 + 64 * 1024;
constexpr size_t WS_SLOT = 49 * MiB;
constexpr size_t WS_XB2 = 208 * MiB;
constexpr int CW_FIN = 3584;
constexpr size_t WS_W = 2 * MiB;
constexpr size_t W_IN_B = (size_t)NP * D * 2, W_OUT_B = (size_t)D * D * 2, W_UP_B = (size_t)NUP * D * 2, W_DN_B = (size_t)D * DFF * 2;
constexpr size_t W_LAYER_B = W_IN_B + W_OUT_B + W_UP_B + W_DN_B;
constexpr size_t WS_HX = 50 * MiB;
constexpr size_t WS_YMIX = 83 * MiB;
constexpr size_t WS_P = 116 * MiB;
constexpr size_t WS_XC = 207 * MiB;
constexpr size_t WS_ST = 209 * MiB;
constexpr size_t WS_DEC = 226 * MiB;
constexpr size_t WS_CAU = 227 * MiB;
constexpr size_t WS_PART = 233 * MiB;
constexpr size_t WS_END = 255 * MiB;
static_assert(WS_W + 2 * W_LAYER_B <= WS_HX, "weights");
static_assert(WS_P + (size_t)MT * DFF * 2 <= WS_XC, "act");
constexpr int RING_BYTES = 131072, LDS_BYTES = 147456;

struct Params {
    const float *x, *c, *ctx, *c_ctx, *norm1_g, *norm2_g, *w_mod, *b_mod, *w_in, *w_a2, *b_a2, *gla_g, *fft_w, *conv_w, *conv_b, *pool_w,
        *pool_scale, *w_out, *w_up, *ffn_cw, *ffn_cb, *w_down, *final_g;
    float* out; unsigned char* ws;
};

typedef const __attribute__((address_space(4))) Params* PP;
__device__ __forceinline__ unsigned f2bf(float f) { unsigned u = __builtin_bit_cast(unsigned, f); return (u + 0x7fffu + ((u >> 16) & 1u)) >> 16; }
__device__ __forceinline__ unsigned pk2(float lo, float hi) { return f2bf(lo) | (f2bf(hi) << 16); }
__device__ __forceinline__ float bf2f(unsigned h) { return __builtin_bit_cast(float, h << 16); }
__device__ __forceinline__ float bflo(unsigned w) { return __builtin_bit_cast(float, w << 16); }
__device__ __forceinline__ float bfhi(unsigned w) { return __builtin_bit_cast(float, w & 0xffff0000u); }
__device__ __forceinline__ float shfl_f(float v, int src_lane) { return __builtin_bit_cast(float, __builtin_amdgcn_ds_bpermute(src_lane << 2, __builtin_bit_cast(int, v))); }
__device__ __forceinline__ float wave_sum(float v, int lane) {
#pragma unroll
    for (int o = 1; o < 64; o <<= 1) v += shfl_f(v, lane ^ o);
    return v;
}
__device__ __forceinline__ float silu_f(float x) { return x * __builtin_amdgcn_rcpf(1.f + __expf(-x)); }
__device__ __forceinline__ float cos_rev(float r) { return __builtin_amdgcn_cosf(r); }
__device__ __forceinline__ float sin_rev(float r) { return __builtin_amdgcn_sinf(r); }
__device__ __forceinline__ bf16x8 pack8(float a0, float a1, float a2, float a3, float a4, float a5, float a6, float a7) {
    u32x4 w; w.x = pk2(a0, a1); w.y = pk2(a2, a3); w.z = pk2(a4, a5); w.w = pk2(a6, a7); return __builtin_bit_cast(bf16x8, w);
}
#define MFMA16(a, b, c) __builtin_amdgcn_mfma_f32_16x16x32_bf16(a, b, c, 0, 0, 0)

struct EpiP {
    static constexpr bool PERM = true, AFTER_DRAIN = false;
    bf16* O; const float* ba2;
    __device__ __forceinline__ void operator()(const pg8::f32x4 (&acc)[2][2][4][2], const pg8::Unit& u, int wr, int wc, int fr, int fq) const {
        const int row0 = u.pm * 256 + wr * 64 + fr, col0 = u.pn * 256 + wc * 32 + 8 * fq;
        const __amdgpu_buffer_rsrc_t prs = __builtin_amdgcn_make_buffer_rsrc(O, 0, MT * NP * 2, 0x00020000);
        const bool la = (u.pn == 2);
#pragma unroll
        for (int ai = 0; ai < 2; ++ai)
#pragma unroll
            for (int m = 0; m < 4; ++m) { bf16* rowp = O + (size_t)(row0 + ai * 128 + m * 16) * NP + col0;
#pragma unroll
                for (int bj = 0; bj < 2; ++bj) { pg8::f32x4 v0 = acc[ai][bj][m][0], v1 = acc[ai][bj][m][1];
                    if (la) { const float* bp = ba2 + (col0 + bj * 128 - PLA); const f32x4 b0 = *(const f32x4*)bp, b1 = *(const f32x4*)(bp + 4);
#pragma unroll
                        for (int e = 0; e < 4; ++e) { float xa = v0[e] + b0[e], xb = v1[e] + b1[e];
                            v0[e] = (fminf(xa, 0.f) - __logf(1.f + __expf(-fabsf(xa)))) * 0.0625f; v1[e] = (fminf(xb, 0.f) - __logf(1.f + __expf(-fabsf(xb)))) * 0.0625f; } }
                    u32x4 w; w.x = pg8::cvt_pk_bf16(v0[0], v0[1]); w.y = pg8::cvt_pk_bf16(v0[2], v0[3]); w.z = pg8::cvt_pk_bf16(v1[0], v1[1]); w.w = pg8::cvt_pk_bf16(v1[2], v1[3]);
                    __builtin_amdgcn_raw_buffer_store_b128(w, prs, (unsigned)(((row0 + ai * 128 + m * 16) * NP + col0 + bj * 128) * 2), 0, 16); } }
    }
};
template <bool INB, bool OUTB>
struct EpiRes {
    static constexpr bool PERM = true, AFTER_DRAIN = false;
    const void* xin; void* out; const float* modg;
    __device__ __forceinline__ void operator()(const pg8::f32x4 (&acc)[2][2][4][2], const pg8::Unit& u, int wr, int wc, int fr, int fq) const {
        const int w = u.pm >> 5; const int cb = u.pn * 256 + wc * 32 + 8 * fq;
        f32x4 gv[2][2];
#pragma unroll
        for (int bj = 0; bj < 2; ++bj)
#pragma unroll
            for (int n = 0; n < 2; ++n) gv[bj][n] = *(const f32x4*)(modg + w * 6144 + cb + bj * 128 + 4 * n);
        constexpr int RG = INB ? 4 : 2;
#pragma unroll
        for (int ai = 0; ai < 2; ++ai)
#pragma unroll
            for (int mp = 0; mp < 4 / RG; ++mp) {
                u32x4 xb[RG][2]; f32x4 xf[INB ? 1 : RG][2][2];
#pragma unroll
                for (int mm = 0; mm < RG; ++mm) { const size_t ro = (size_t)(u.pm * 256 + ai * 128 + wr * 64 + (RG * mp + mm) * 16 + fr) * D + cb;
#pragma unroll
                    for (int bj = 0; bj < 2; ++bj) {
                        if (INB) xb[mm][bj] = *(const u32x4*)((const bf16*)xin + ro + bj * 128);
                        else { xf[INB ? 0 : mm][bj][0] = __builtin_nontemporal_load((const f32x4*)((const float*)xin + ro + bj * 128)); xf[INB ? 0 : mm][bj][1] = __builtin_nontemporal_load((const f32x4*)((const float*)xin + ro + bj * 128 + 4)); } } }
#pragma unroll
                for (int mm = 0; mm < RG; ++mm) { const int m = RG * mp + mm; const size_t ro = (size_t)(u.pm * 256 + ai * 128 + wr * 64 + m * 16 + fr) * D + cb;
#pragma unroll
                    for (int bj = 0; bj < 2; ++bj) { f32x4 x0, x1;
                        if (INB) { const u32x4 t = xb[mm][bj]; x0 = (f32x4){bflo(t.x), bfhi(t.x), bflo(t.y), bfhi(t.y)}; x1 = (f32x4){bflo(t.z), bfhi(t.z), bflo(t.w), bfhi(t.w)}; }
                        else { x0 = xf[INB ? 0 : mm][bj][0]; x1 = xf[INB ? 0 : mm][bj][1]; }
                        const pg8::f32x4 a0 = acc[ai][bj][m][0], a1 = acc[ai][bj][m][1]; const f32x4 g0 = gv[bj][0], g1 = gv[bj][1];
                        f32x4 y0, y1;
#pragma unroll
                        for (int e = 0; e < 4; ++e) { y0[e] = x0[e] + g0[e] * a0[e]; y1[e] = x1[e] + g1[e] * a1[e]; }
                        if (OUTB) { u32x4 pk; pk.x = pg8::cvt_pk_bf16(y0[0], y0[1]); pk.y = pg8::cvt_pk_bf16(y0[2], y0[3]); pk.z = pg8::cvt_pk_bf16(y1[0], y1[1]); pk.w = pg8::cvt_pk_bf16(y1[2], y1[3]);
                            *(u32x4*)((bf16*)out + ro + bj * 128) = pk; }
                        else { *(f32x4*)((float*)out + ro + bj * 128) = y0; *(f32x4*)((float*)out + ro + bj * 128 + 4) = y1; } } }
            }
    }
};
template <bool STORE_X>
__device__ __forceinline__ void panel_rms(pg8::f32x4 (&acc)[2][2][4][2], const pg8::Unit& u, int wr, int wc, int fr, int fq, LAS unsigned char* lds, int wid, int lane,
                                          const bf16* xin, bf16* xout, const float* modg, float* slots, unsigned* cnt) {
    const int w = u.pm >> 5; const int cb = u.pn * 256 + wc * 32 + 8 * fq;
    LAS float* P = (LAS float*)lds;
    LAS float* S = (LAS float*)(lds + 4096);
    f32x4 gv[2][2];
#pragma unroll
    for (int bj = 0; bj < 2; ++bj)
#pragma unroll
        for (int n = 0; n < 2; ++n) gv[bj][n] = *(const f32x4*)(modg + w * 6144 + cb + bj * 128 + 4 * n);
#pragma unroll
    for (int ai = 0; ai < 2; ++ai) {
        u32x4 xb[4][2];
#pragma unroll
        for (int m = 0; m < 4; ++m) { const size_t ro = (size_t)(u.pm * 256 + ai * 128 + wr * 64 + m * 16 + fr) * D + cb;
#pragma unroll
            for (int bj = 0; bj < 2; ++bj) xb[m][bj] = *(const u32x4*)(xin + ro + bj * 128); }
#pragma unroll
        for (int m = 0; m < 4; ++m) { float sq = 0.f; const size_t ro = (size_t)(u.pm * 256 + ai * 128 + wr * 64 + m * 16 + fr) * D + cb;
#pragma unroll
            for (int bj = 0; bj < 2; ++bj) { const u32x4 t = xb[m][bj]; const f32x4 g0 = gv[bj][0], g1 = gv[bj][1]; pg8::f32x4 a0 = acc[ai][bj][m][0], a1 = acc[ai][bj][m][1];
                a0[0] = bflo(t.x) + g0[0] * a0[0]; a0[1] = bfhi(t.x) + g0[1] * a0[1]; a0[2] = bflo(t.y) + g0[2] * a0[2]; a0[3] = bfhi(t.y) + g0[3] * a0[3];
                a1[0] = bflo(t.z) + g1[0] * a1[0]; a1[1] = bfhi(t.z) + g1[1] * a1[1]; a1[2] = bflo(t.w) + g1[2] * a1[2]; a1[3] = bfhi(t.w) + g1[3] * a1[3];
                acc[ai][bj][m][0] = a0; acc[ai][bj][m][1] = a1;
                sq += ((a0[0] * a0[0] + a0[1] * a0[1]) + (a0[2] * a0[2] + a0[3] * a0[3])) + ((a1[0] * a1[0] + a1[1] * a1[1]) + (a1[2] * a1[2] + a1[3] * a1[3]));
                if (STORE_X) { u32x4 pk; pk.x = pg8::cvt_pk_bf16(a0[0], a0[1]); pk.y = pg8::cvt_pk_bf16(a0[2], a0[3]); pk.z = pg8::cvt_pk_bf16(a1[0], a1[1]); pk.w = pg8::cvt_pk_bf16(a1[2], a1[3]);
                    *(u32x4*)(xout + ro + bj * 128) = pk; } }
            sq += shfl_f(sq, lane ^ 16); sq += shfl_f(sq, lane ^ 32);
            if (fq == 0) P[(ai * 128 + wr * 64 + m * 16 + fr) * 4 + wc] = sq; }
    }
    asm volatile("s_waitcnt lgkmcnt(0)" ::: "memory"); __builtin_amdgcn_s_barrier(); asm volatile("" ::: "memory");
    const int row = wid * 32 + (lane & 31);
    if (lane < 32) { const float t = (P[row * 4 + 0] + P[row * 4 + 1]) + (P[row * 4 + 2] + P[row * 4 + 3]);
        __hip_atomic_store(slots + ((size_t)(u.pm * 256 + row) * 4 + u.pn), t, __ATOMIC_RELAXED, __HIP_MEMORY_SCOPE_AGENT); }
    asm volatile("s_waitcnt vmcnt(0)" ::: "memory");
    if (lane == 0) (void)__hip_atomic_fetch_add(cnt + 64 * u.pm, 1u, __ATOMIC_RELAXED, __HIP_MEMORY_SCOPE_AGENT);
    if (wid == 0) { unsigned sp = 0;
        while ((unsigned)__builtin_amdgcn_readfirstlane((int)__hip_atomic_load(cnt + 64 * u.pm, __ATOMIC_RELAXED, __HIP_MEMORY_SCOPE_AGENT)) < 32u) { __builtin_amdgcn_s_sleep(2); if (++sp > (1u << 22)) break; }
        __builtin_amdgcn_fence(__ATOMIC_ACQUIRE, "agent"); }
    asm volatile("s_waitcnt vmcnt(0) lgkmcnt(0)" ::: "memory"); __builtin_amdgcn_s_barrier(); asm volatile("" ::: "memory");
    if (lane < 32) { const float* sl = slots + (size_t)(u.pm * 256 + row) * 4; float t = 0.f;
#pragma unroll
        for (int q = 0; q < 4; ++q) t += __hip_atomic_load(sl + q, __ATOMIC_RELAXED, __HIP_MEMORY_SCOPE_AGENT);
        S[row] = 1.f / sqrtf(t * (1.f / D) + EPS); }
    asm volatile("s_waitcnt vmcnt(0) lgkmcnt(0)" ::: "memory"); __builtin_amdgcn_s_barrier(); asm volatile("" ::: "memory");
}
struct EpiFinal {
    static constexpr bool PERM = true, AFTER_DRAIN = true;
    const bf16* xin; float* out; const float* modg; const float* gfin; float* slots; unsigned* cnt;
    __device__ __forceinline__ void fused(pg8::f32x4 (&acc)[2][2][4][2], const pg8::Unit& u, int wr, int wc, int fr, int fq, LAS unsigned char* lds, int wid, int lane) const {
        panel_rms<false>(acc, u, wr, wc, fr, fq, lds, wid, lane, xin, nullptr, modg, slots, cnt);
        const LAS float* S = (const LAS float*)(lds + 4096); const int cb = u.pn * 256 + wc * 32 + 8 * fq;
        f32x4 gf[2][2];
#pragma unroll
        for (int bj = 0; bj < 2; ++bj)
#pragma unroll
            for (int n = 0; n < 2; ++n) gf[bj][n] = *(const f32x4*)(gfin + cb + bj * 128 + 4 * n);
#pragma unroll
        for (int ai = 0; ai < 2; ++ai)
#pragma unroll
            for (int m = 0; m < 4; ++m) { const int r = ai * 128 + wr * 64 + m * 16 + fr; const float rs = S[r]; float* o = out + (size_t)(u.pm * 256 + r) * D + cb;
#pragma unroll
                for (int bj = 0; bj < 2; ++bj)
#pragma unroll
                    for (int n = 0; n < 2; ++n) { const pg8::f32x4 a = acc[ai][bj][m][n]; const f32x4 g4 = gf[bj][n];
                        *(f32x4*)(o + bj * 128 + 4 * n) = (f32x4){a[0] * rs * g4[0], a[1] * rs * g4[1], a[2] * rs * g4[2], a[3] * rs * g4[3]}; } }
    }
};
struct EpiResNorm {
    static constexpr bool PERM = true, AFTER_DRAIN = true;
    const bf16* xin; bf16* xout; bf16* hout; const float* modg; const float* gn; const float* modn; float* slots; unsigned* cnt;
    __device__ __forceinline__ void fused(pg8::f32x4 (&acc)[2][2][4][2], const pg8::Unit& u, int wr, int wc, int fr, int fq, LAS unsigned char* lds, int wid, int lane) const {
        panel_rms<true>(acc, u, wr, wc, fr, fq, lds, wid, lane, xin, xout, modg, slots, cnt);
        const LAS float* S = (const LAS float*)(lds + 4096); const int w = u.pm >> 5; const int cb = u.pn * 256 + wc * 32 + 8 * fq;
        f32x4 gm[2][2], shv[2][2];
#pragma unroll
        for (int bj = 0; bj < 2; ++bj)
#pragma unroll
            for (int n = 0; n < 2; ++n) { const int c = cb + bj * 128 + 4 * n; const f32x4 g4 = *(const f32x4*)(gn + c), s4 = *(const f32x4*)(modn + w * 6144 + 4096 + c);
                shv[bj][n] = *(const f32x4*)(modn + w * 6144 + 3072 + c); gm[bj][n] = (f32x4){g4[0] * (1.f + s4[0]), g4[1] * (1.f + s4[1]), g4[2] * (1.f + s4[2]), g4[3] * (1.f + s4[3])}; }
#pragma unroll
        for (int ai = 0; ai < 2; ++ai)
#pragma unroll
            for (int m = 0; m < 4; ++m) { const int r = ai * 128 + wr * 64 + m * 16 + fr; const float rs = S[r]; bf16* o = hout + (size_t)(u.pm * 256 + r) * D + cb;
#pragma unroll
                for (int bj = 0; bj < 2; ++bj) { const pg8::f32x4 a0 = acc[ai][bj][m][0], a1 = acc[ai][bj][m][1]; const f32x4 g0 = gm[bj][0], g1 = gm[bj][1], h0 = shv[bj][0], h1 = shv[bj][1];
                    u32x4 pk; pk.x = pg8::cvt_pk_bf16(a0[0] * rs * g0[0] + h0[0], a0[1] * rs * g0[1] + h0[1]); pk.y = pg8::cvt_pk_bf16(a0[2] * rs * g0[2] + h0[2], a0[3] * rs * g0[3] + h0[3]);
                    pk.z = pg8::cvt_pk_bf16(a1[0] * rs * g1[0] + h1[0], a1[1] * rs * g1[1] + h1[1]); pk.w = pg8::cvt_pk_bf16(a1[2] * rs * g1[2] + h1[2], a1[3] * rs * g1[3] + h1[3]);
                    *(u32x4*)(o + bj * 128) = pk; } }
    }
};
struct EpiUp {
    static constexpr bool PERM = true, AFTER_DRAIN = false;
    bf16* ACT; const float* cw; const float* cb;
    __device__ __forceinline__ void operator()(const pg8::f32x4 (&acc)[2][2][4][2], const pg8::Unit& u, int wr, int wc, int fr, int fq) const {
        const int hc0 = u.pn * 128 + wc * 32 + 8 * fq;
        const __amdgpu_buffer_rsrc_t ars = __builtin_amdgcn_make_buffer_rsrc(ACT, 0, MT * DFF * 2, 0x00020000);
#pragma unroll
        for (int ai = 0; ai < 2; ++ai) { const int blk = ai * 2 + wr;
            float res[4][8];
#pragma unroll
            for (int n = 0; n < 2; ++n) {
                const f32x4 w0 = *(const f32x4*)(cw + hc0 + 4 * n), w1 = *(const f32x4*)(cw + DFF + hc0 + 4 * n), w2 = *(const f32x4*)(cw + 2 * DFF + hc0 + 4 * n), bb = *(const f32x4*)(cb + hc0 + 4 * n);
#pragma unroll
                for (int e = 0; e < 4; ++e) {
                    float xs[4], ps[4], ns[4]; const float bprev = 0.f, bnext = 0.f;
#pragma unroll
                    for (int m = 0; m < 4; ++m) { xs[m] = acc[ai][0][m][n][e]; ps[m] = __builtin_bit_cast(float, __builtin_amdgcn_update_dpp(0, __builtin_bit_cast(int, xs[m]), 0x121, 0xf, 0xf, false)); ns[m] = __builtin_bit_cast(float, __builtin_amdgcn_update_dpp(0, __builtin_bit_cast(int, xs[m]), 0x12f, 0xf, 0xf, false)); }
#pragma unroll
                    for (int m = 0; m < 4; ++m) {
                        const float oldp = (m > 0) ? ps[m > 0 ? m - 1 : 0] : bprev, oldn = (m < 3) ? ns[m < 3 ? m + 1 : 3] : bnext;
                        const float prev = __builtin_bit_cast(float, __builtin_amdgcn_update_dpp(__builtin_bit_cast(int, oldp), __builtin_bit_cast(int, xs[m]), 0x111, 0xf, 0xf, false));
                        const float next = __builtin_bit_cast(float, __builtin_amdgcn_update_dpp(__builtin_bit_cast(int, oldn), __builtin_bit_cast(int, xs[m]), 0x101, 0xf, 0xf, false));
                        const float a = w0[e] * prev + w1[e] * xs[m] + w2[e] * next + bb[e];
                        res[m][4 * n + e] = silu_f(a) * acc[ai][1][m][n][e];
                    }
                }
            }
#pragma unroll
            for (int m = 0; m < 4; ++m) { const int r = u.pm * 256 + ai * 128 + wr * 64 + m * 16 + fr;
                u32x4 w; w.x = pg8::cvt_pk_bf16(res[m][0], res[m][1]); w.y = pg8::cvt_pk_bf16(res[m][2], res[m][3]); w.z = pg8::cvt_pk_bf16(res[m][4], res[m][5]); w.w = pg8::cvt_pk_bf16(res[m][6], res[m][7]);
                __builtin_amdgcn_raw_buffer_store_b128(w, ars, (unsigned)((r * DFF + hc0) * 2), 0, 16); }
        }
    }
};
struct EpiUpCtx {
    static constexpr bool PERM = true, AFTER_DRAIN = false;
    bf16* ACT; const float* cw; const float* cb; LAS float* ex;
    __device__ __forceinline__ void operator()(const pg8::f32x4 (&acc)[2][2][4][2], const pg8::Unit& u, int wr, int wc, int fr, int fq) const {
        const int hc0 = u.pn * 128 + wc * 32 + 8 * fq;
            const int colw = wc * 32 + 8 * fq;
#pragma unroll
            for (int ai = 0; ai < 2; ++ai) { const int blk = ai * 2 + wr;
                if (fr == 0) {
#pragma unroll
                    for (int n = 0; n < 2; ++n)
#pragma unroll
                        for (int e = 0; e < 4; ++e) ex[(blk * 2 + 0) * 128 + colw + 4 * n + e] = acc[ai][0][0][n][e]; }
                if (fr == 15) {
#pragma unroll
                    for (int n = 0; n < 2; ++n)
#pragma unroll
                        for (int e = 0; e < 4; ++e) ex[(blk * 2 + 1) * 128 + colw + 4 * n + e] = acc[ai][0][3][n][e]; } }
            asm volatile("s_waitcnt lgkmcnt(0)" ::: "memory"); __builtin_amdgcn_s_barrier(); asm volatile("" ::: "memory");
#pragma unroll
            for (int ai = 0; ai < 2; ++ai) { const int blk = ai * 2 + wr;
                float res[4][8];
    #pragma unroll
                for (int n = 0; n < 2; ++n) {
                    const f32x4 w0 = *(const f32x4*)(cw + hc0 + 4 * n), w1 = *(const f32x4*)(cw + DFF + hc0 + 4 * n), w2 = *(const f32x4*)(cw + 2 * DFF + hc0 + 4 * n), bb = *(const f32x4*)(cb + hc0 + 4 * n);
    #pragma unroll
                    for (int e = 0; e < 4; ++e) {
                        float xs[4], ps[4], ns[4]; float bprev = 0.f, bnext = 0.f; if (blk > 0) bprev = ex[((blk - 1) * 2 + 1) * 128 + colw + 4 * n + e]; if (blk < 3) bnext = ex[((blk + 1) * 2 + 0) * 128 + colw + 4 * n + e];
    #pragma unroll
                        for (int m = 0; m < 4; ++m) { xs[m] = acc[ai][0][m][n][e]; ps[m] = __builtin_bit_cast(float, __builtin_amdgcn_update_dpp(0, __builtin_bit_cast(int, xs[m]), 0x121, 0xf, 0xf, false)); ns[m] = __builtin_bit_cast(float, __builtin_amdgcn_update_dpp(0, __builtin_bit_cast(int, xs[m]), 0x12f, 0xf, 0xf, false)); }
    #pragma unroll
                        for (int m = 0; m < 4; ++m) {
                            const float prev = (fr > 0) ? ps[m] : (m > 0 ? ps[m > 0 ? m - 1 : 0] : bprev);
                            const float next = (fr < 15) ? ns[m] : (m < 3 ? ns[m < 3 ? m + 1 : 3] : bnext);
                            const float a = w0[e] * prev + w1[e] * xs[m] + w2[e] * next + bb[e];
                            res[m][4 * n + e] = silu_f(a) * acc[ai][1][m][n][e];
                        }
                    }
                }
    #pragma unroll
                for (int m = 0; m < 4; ++m) { const int r = u.pm * 256 + ai * 128 + wr * 64 + m * 16 + fr;
                    u32x4 w; w.x = pg8::cvt_pk_bf16(res[m][0], res[m][1]); w.y = pg8::cvt_pk_bf16(res[m][2], res[m][3]); w.z = pg8::cvt_pk_bf16(res[m][4], res[m][5]); w.w = pg8::cvt_pk_bf16(res[m][6], res[m][7]);
                    *(u32x4*)(ACT + (size_t)r * DFF + hc0) = w; }
            }

    }
};
struct CtxOrder {
    int nN, c, c0;
    __device__ void init(int N, int c_, int c0_) { nN = N / 256; c = c_; c0 = c0_; }
    __device__ bool next(int i, pg8::Unit& u) const { const int j = c - c0; if (i > 0 || j < 0 || j >= 2 * nN) return false; u.pm = 64 + (j & 1); u.pn = j >> 1; u.ks = 0; return true; }
    __device__ __forceinline__ void a_ready(const pg8::Unit&) const {}
    __device__ __forceinline__ void done(const pg8::Unit&) const {}
};

struct SplitOrder {
    int nunits, G, c;
    __device__ void init(int nks, int G_, int c_) { nunits = 8 * nks; G = G_; c = c_; }
    __device__ bool next(int i, pg8::Unit& u) const { const int id = i * G + c; if (id >= nunits) return false; u.pm = 64 + (id & 1); u.pn = (id >> 1) & 3; u.ks = id >> 3; return true; }
    __device__ __forceinline__ void a_ready(const pg8::Unit&) const {}
    __device__ __forceinline__ void done(const pg8::Unit&) const {}
};
struct EpiPartial {
    static constexpr bool PERM = false, AFTER_DRAIN = false;
    float* part;
    __device__ __forceinline__ void operator()(const pg8::f32x4 (&acc)[2][2][4][2], const pg8::Unit& u, int wr, int wc, int fr, int fq) const {
#pragma unroll
        for (int ai = 0; ai < 2; ++ai)
#pragma unroll
            for (int m = 0; m < 4; ++m) { const int r = u.pm * 256 + ai * 128 + wr * 64 + m * 16 + fr; float* o = part + ((size_t)u.ks * MC + (size_t)(r - ML)) * D;
#pragma unroll
                for (int bj = 0; bj < 2; ++bj)
#pragma unroll
                    for (int n = 0; n < 2; ++n) { const int c = u.pn * 256 + bj * 128 + wc * 32 + 16 * n + 4 * fq; const pg8::f32x4 a = acc[ai][bj][m][n];
                        *(f32x4*)(o + c) = (f32x4){a[0], a[1], a[2], a[3]}; } }
    }
};
typedef __attribute__((address_space(1))) unsigned gu32;
#define XB_TMO      128
#define XB_XCNT(j)  (256  + 64 * (j))
#define XB_XSUB(j)  (1280 + 64 * (j))
#define XB_XGEN(j)  (2304 + 64 * (j))
#define XB_TOP      3328
#define XB_TOPGEN   3392
#define XCD_BAR_WORDS 3456
#define XB_SPIN_CAP (1u << 18)

__device__ __forceinline__ unsigned xb_ld(unsigned* p)              { return __hip_atomic_load(p, __ATOMIC_RELAXED, __HIP_MEMORY_SCOPE_AGENT); }
__device__ __forceinline__ unsigned xb_add(unsigned* p, unsigned v) { return __hip_atomic_fetch_add(p, v, __ATOMIC_RELAXED, __HIP_MEMORY_SCOPE_AGENT); }
__device__ __forceinline__ unsigned xb_xcc_id() { return (unsigned)__builtin_amdgcn_s_getreg((3 << 11) | 20) & 0xFu; }
#define XB_SPIN(cond, bar) do { unsigned _sp = 0; while (cond) { __builtin_amdgcn_s_sleep(1); \
    if ((++_sp & 255u) == 0u) { if (xb_ld(&(bar)[XB_TMO])) break; if (_sp > XB_SPIN_CAP) { atomicAdd(&(bar)[XB_TMO], 1u); break; } } } } while (0)

struct XcdBarrier {
    unsigned* bar; unsigned x;
    volatile LAS unsigned* st;
};

__device__ __forceinline__ XcdBarrier xcd_barrier_post(unsigned* bar, volatile LAS unsigned* st, int tid_) {
    XcdBarrier b; b.bar = bar; b.x = xb_xcc_id(); b.st = st;
    if (tid_ == 0) (void)xb_add(&bar[XB_XCNT(b.x)], 1u);
    return b;
}
__device__ __forceinline__ void xcd_barrier_complete(unsigned* bar, unsigned x, unsigned& nloc, unsigned& nx) {
    const unsigned G = gridDim.x * gridDim.y * gridDim.z;
    unsigned sum, cnt, mine, sp = 0u;
    for (;;) {
        sum = 0u; cnt = 0u; mine = 0u;
#pragma unroll
        for (unsigned j = 0; j < 16; ++j) { const unsigned c = xb_ld(&bar[XB_XCNT(j)]); sum += c; cnt += (c > 0u) ? 1u : 0u; mine = (j == x) ? c : mine; }
        if (sum == G) break;
        __builtin_amdgcn_s_sleep(1);
        if ((++sp & 255u) == 0u) { if (xb_ld(&bar[XB_TMO])) break; if (sp > XB_SPIN_CAP) { atomicAdd(&bar[XB_TMO], 1u); break; } }
    }
    nloc = mine > 0u ? mine : 1u; nx = cnt > 0u ? cnt : 1u;
}

__device__ __forceinline__ void xcd_barrier(const XcdBarrier& b, int tid_) {
    asm volatile("s_waitcnt vmcnt(0)" ::: "memory");
    __syncthreads();
    if (tid_ == 0) {
        unsigned* bar = b.bar; asm volatile("" : "+s"(bar)); unsigned bx = (unsigned)__builtin_amdgcn_readfirstlane((int)b.x); asm volatile("" : "+s"(bx));
        __builtin_amdgcn_s_waitcnt(0);
        unsigned nloc = b.st[0], nx = b.st[1];
        if (nloc == 0u) { xcd_barrier_complete(bar, bx, nloc, nx); b.st[0] = nloc; b.st[1] = nx; }
        const unsigned old = xb_add(&bar[XB_XSUB(bx)], 1u);
        const unsigned gen = old / nloc;
        if (old + 1u == (gen + 1u) * nloc) {
            __builtin_amdgcn_fence(__ATOMIC_RELEASE, "agent");
            asm volatile("s_waitcnt vmcnt(0)" ::: "memory");
            const unsigned og = xb_add(&bar[XB_TOP], 1u);
            const unsigned tg = og / nx;
            if (og + 1u == (tg + 1u) * nx) xb_add(&bar[XB_TOPGEN], 1u);
            else XB_SPIN(xb_ld(&bar[XB_TOPGEN]) == tg, bar);
            __builtin_amdgcn_fence(__ATOMIC_ACQUIRE, "agent");
            xb_add(&bar[XB_XGEN(bx)], 1u);
            asm volatile("s_waitcnt vmcnt(0)" ::: "memory");
        } else {
            XB_SPIN(xb_ld(&bar[XB_XGEN(bx)]) == gen, bar);
            __builtin_amdgcn_fence(__ATOMIC_ACQUIRE, "agent");
            asm volatile("s_waitcnt vmcnt(0)" ::: "memory");
        }
    }
    __syncthreads();
}
struct Ctx {
    LAS unsigned char* lds; int tid, lane, wave, G, gw, NGW;
    float* MOD; float* MCS; bf16 *F1, *F2, *FC; bf16 *HX, *YMIX, *PB, *ACT, *TB, *CAU; float *XC, *ST, *DEC;
};
__device__ __forceinline__ bf16* win_t(PP p, int l) { return (bf16*)(p->ws + WS_W + (size_t)l * W_LAYER_B); }
__device__ __forceinline__ bf16* wout_t(PP p, int l) { return (bf16*)(p->ws + WS_W + (size_t)l * W_LAYER_B + W_IN_B); }
__device__ __forceinline__ bf16* wup_t(PP p, int l) { return (bf16*)(p->ws + WS_W + (size_t)l * W_LAYER_B + W_IN_B + W_OUT_B); }
__device__ __forceinline__ bf16* wdn_t(PP p, int l) { return (bf16*)(p->ws + WS_W + (size_t)l * W_LAYER_B + W_IN_B + W_OUT_B + W_UP_B); }

__device__ __forceinline__ void transpose_item(const float* W, int K, int N, bf16* WT, int k0, int n0, int dst0, float scale, LAS float* scr, int lane) {
#pragma unroll
    for (int i = 0; i < 32; ++i) { const int kk = 2 * i + (lane >> 5); scr[kk * 33 + (lane & 31)] = __builtin_nontemporal_load(W + (size_t)(k0 + kk) * N + n0 + (lane & 31)) * scale; }
    LDS_WAIT(); __builtin_amdgcn_wave_barrier();
    const int c = lane & 7;
#pragma unroll
    for (int j = 0; j < 4; ++j) { const int n = (lane >> 3) + 8 * j; const LAS float* s = scr + (8 * c) * 33 + n;
        u32x4 o; o.x = pk2(s[0 * 33], s[1 * 33]); o.y = pk2(s[2 * 33], s[3 * 33]); o.z = pk2(s[4 * 33], s[5 * 33]); o.w = pk2(s[6 * 33], s[7 * 33]);
        __builtin_nontemporal_store(o, (u32x4*)(WT + (size_t)(dst0 + n) * K + k0 + 8 * c)); }
    LDS_WAIT(); __builtin_amdgcn_wave_barrier();
}

__device__ __forceinline__ void phase0(PP p, Ctx& F) {
    LAS float* sv = (LAS float*)F.lds; LAS float* red = sv + 3072;
    for (int i = F.tid; i < 3072; i += 512) { const int w = i >> 10, k = i & 1023; const float cv = (w < 2) ? p->c[w * 1024 + k] : p->c_ctx[k]; sv[i] = cv / (1.f + expf(-cv)); }
    __syncthreads();
    for (int it = blockIdx.x; it < 192; it += F.G) {
        const int l = it / 96, c0 = (it % 96) * 64; const float* W = p->w_mod + (size_t)l * 1024 * 6144 + c0 + F.lane;
        float a0 = 0.f, a1 = 0.f, a2 = 0.f; const int kb = F.wave * 128;
#pragma unroll 32
        for (int k = 0; k < 128; ++k) { const float wv = __builtin_nontemporal_load(W + (size_t)(kb + k) * 6144); a0 += sv[kb + k] * wv; a1 += sv[1024 + kb + k] * wv; a2 += sv[2048 + kb + k] * wv; }
        red[(F.wave * 3 + 0) * 64 + F.lane] = a0; red[(F.wave * 3 + 1) * 64 + F.lane] = a1; red[(F.wave * 3 + 2) * 64 + F.lane] = a2;
        __syncthreads();
        if (F.tid < 192) { const int w = F.tid >> 6, ln = F.tid & 63; float s = 0.f;
#pragma unroll
            for (int q = 0; q < 8; ++q) s += red[(q * 3 + w) * 64 + ln];
            F.MOD[(l * 3 + w) * 6144 + c0 + ln] = s + p->b_mod[l * 6144 + c0 + ln]; }
        __syncthreads();
    }
    __syncthreads();
    LAS float* scr = (LAS float*)(F.lds + F.wave * 16384);
    constexpr int I_IN = 48 * 16, I_OUT = 32 * 16, I_UP = 176 * 16, I_DN = 32 * 44, I_L = I_IN + I_OUT + I_UP + I_DN;
    for (int it = F.gw; it < 2 * I_L; it += F.NGW) {
        const int l = it / I_L; int r = it % I_L;
        if (r < I_IN) { const int cb = r / 16, kb = r % 16; int src, dst; float sc = 1.f;
            if (cb < 4) { src = 32 * cb; dst = PK + 32 * cb; }
            else if (cb < 8) { src = 416 + 32 * (cb - 4); dst = PQ + 32 * (cb - 4); sc = 0.17677669529663687f; }
            else if (cb < 16) { src = 128 + 32 * (cb - 8); dst = PV + 32 * (cb - 8); }
            else if (cb < 24) { src = 544 + 32 * (cb - 16); dst = PG + 32 * (cb - 16); }
            else if (cb < 32) { src = 1056 + 32 * (cb - 24); dst = PH + 32 * (cb - 24); }
            else if (cb < 40) { src = 1312 + 32 * (cb - 32); dst = PBG + 32 * (cb - 32); }
            else { src = 1568 + 32 * (cb - 40); dst = PCG + 32 * (cb - 40); }
            transpose_item(p->w_in + (size_t)l * D * DIN, D, DIN, win_t(p, l), 64 * kb, src, dst, sc, scr, F.lane); continue; }
        r -= I_IN;
        if (r < I_OUT) { const int cb = r / 16, kb = r % 16; transpose_item(p->w_out + (size_t)l * D * D, D, D, wout_t(p, l), 64 * kb, 32 * cb, 32 * cb, 1.f, scr, F.lane); continue; }
        r -= I_OUT;
        if (r < I_UP) { const int cb = r / 16, kb = r % 16; const int c = 32 * cb, isu = (c >= DFF) ? 1 : 0, j = c - isu * DFF; const int dst = (j / 128) * 256 + isu * 128 + (j % 128);
            transpose_item(p->w_up + (size_t)l * D * NUP, D, NUP, wup_t(p, l), 64 * kb, c, dst, 1.f, scr, F.lane); continue; }
        r -= I_UP;
        { const int cb = r / 44, kb = r % 44; transpose_item(p->w_down + (size_t)l * DFF * D, DFF, D, wdn_t(p, l), 64 * kb, 32 * cb, 32 * cb, 1.f, scr, F.lane); }
    }
    const int gt = blockIdx.x * 512 + F.tid, NT = F.G * 512;
    const int gtm = (F.G == 256) ? ((int)blockIdx.x - 192) * 512 + F.tid : gt; const int NTm = (F.G == 256) ? 32768 : NT;
    for (int i = gtm; i >= 0 && i < 32768; i += NTm) { const int d = i & 63, c = (i >> 6) & 63, g = (i >> 12) & 3, l = i >> 14;
        const float* wf = p->fft_w + (size_t)((l * 4 + g) * 64) * 64 + d; float mc = 0.f, ms = 0.f;
        for (int f = 0; f < 64; ++f) { const float a = (float)((f * c) & 63) * (1.f / 64.f); const float w = wf[f * 64]; mc += cos_rev(a) * w; ms -= sin_rev(a) * w; }
        F.MCS[(((l * 4 + g) * 2 + 0) * 64 + c) * 64 + d] = mc * 0.125f; F.MCS[(((l * 4 + g) * 2 + 1) * 64 + c) * 64 + d] = ms * 0.125f; }
    for (int i = gt; i < MC * D / 4; i += NT) ((f32x4*)F.XC)[i] = ((const f32x4*)p->ctx)[i];
    for (int i = gt; i < 180224; i += NT) {
        if (i < 16384) { const int mm = i >> 7, kk = i & 127, k1 = mm & 63, n1 = kk & 63; const float a = (float)((k1 * n1) & 63) * (1.f / 64.f); const float C = cos_rev(a), S = sin_rev(a);
            const float v = (mm < 64) ? (kk < 64 ? C : S) : (kk < 64 ? -S : C); F.F1[i] = (bf16)f2bf(v); }
        else if (i < 49152) { const int j = i - 16384, k2 = j >> 8, kk = j & 255, n2 = kk & 127; const float a = (float)((k2 * n2) & 127) * (1.f / 128.f);
            const float v = (kk < 128 ? cos_rev(a) : sin_rev(a)) * 0.011048543456039806f; F.F2[j] = (bf16)f2bf(v); }
        else { const int j = i - 49152, k = j >> 9, kk = j & 511, n = kk & 255; const float a = (float)((k * n) & 255) * (1.f / 256.f);
            const float v = (kk < 256 ? cos_rev(a) : sin_rev(a)) * 0.0625f; F.FC[j] = (bf16)f2bf(v); }
    }
}

__device__ __forceinline__ void fold_items(PP p, Ctx& F) {
    for (int it4 = F.gw; it4 < 1792; it4 += F.NGW) {
        const int dq = it4 & 3, it = it4 >> 2;
        const int l = it / 224, r = it % 224, s = r / 16, kb = r % 16; const int k = 64 * kb + F.lane;
        const float* wrow = p->w_in + (size_t)l * D * DIN + (size_t)k * DIN; bf16* WT = win_t(p, l);
        if (s < 2) {
            const f32x4* src = (const f32x4*)(wrow + 384 + 16 * s); f32x4 r4[4];
#pragma unroll
            for (int q = 0; q < 4; ++q) r4[q] = src[q];
            const float* M = p->w_a2 + (size_t)((l * 2 + s) * 16) * 128;
            for (int d = 32 * dq; d < 32 * dq + 32; ++d) { float a = 0.f;
#pragma unroll
                for (int c = 0; c < 16; ++c) a += r4[c >> 2][c & 3] * M[c * 128 + d];
                WT[(size_t)(PLA + s * 128 + d) * D + k] = (bf16)f2bf(a); }
        } else {
            const int kind = (s - 2) >> 2, g = (s - 2) & 3;
            const f32x4* src = (const f32x4*)(wrow + (kind < 2 ? 800 : 1824) + 64 * g); f32x4 r4[16];
#pragma unroll
            for (int q = 0; q < 16; ++q) r4[q] = src[q];
            const float* M = (kind < 2) ? (F.MCS + (size_t)(((l * 4 + g) * 2 + kind) * 64) * 64) : (p->pool_w + (size_t)((l * 4 + g) * 64) * 64);
            const int drow = (kind == 0 ? PFA : (kind == 1 ? PFB : PPOOL)) + 64 * g;
            for (int d = 16 * dq; d < 16 * dq + 16; ++d) { float a = 0.f;
#pragma unroll
                for (int c = 0; c < 64; ++c) a += r4[c >> 2][c & 3] * M[c * 64 + d];
                if (kind == 2) a *= p->pool_scale[l * 256 + g * 64 + d];
                WT[(size_t)(drow + d) * D + k] = (bf16)f2bf(a); }
        }
    }
}

__device__ __forceinline__ void norm_row_bf16(const float* xrow, bf16* orow, const float* g, const float* sc, const float* sh, int lane, const float* part, int nparts, const float* gate, float* xout) {
    f32x4 v[4]; float s = 0.f;
#pragma unroll
    for (int j = 0; j < 4; ++j) v[j] = ((const f32x4*)xrow)[lane + 64 * j];
    if (nparts > 0) {
        f32x4 a[4];
#pragma unroll
        for (int j = 0; j < 4; ++j) a[j] = (f32x4){0.f, 0.f, 0.f, 0.f};
        for (int q = 0; q < nparts; ++q) {
#pragma unroll
            for (int j = 0; j < 4; ++j) { const f32x4 t = ((const f32x4*)(part + (size_t)q * MC * D))[lane + 64 * j]; a[j][0] += t[0]; a[j][1] += t[1]; a[j][2] += t[2]; a[j][3] += t[3]; } }
#pragma unroll
        for (int j = 0; j < 4; ++j) { const f32x4 gv = ((const f32x4*)gate)[lane + 64 * j];
#pragma unroll
            for (int e = 0; e < 4; ++e) v[j][e] += gv[e] * a[j][e];
            ((f32x4*)xout)[lane + 64 * j] = v[j]; }
    }
#pragma unroll
    for (int j = 0; j < 4; ++j) s += (v[j][0] * v[j][0] + v[j][1] * v[j][1]) + (v[j][2] * v[j][2] + v[j][3] * v[j][3]);
    const float rstd = 1.f / sqrtf(wave_sum(s, lane) * (1.f / D) + EPS);
#pragma unroll
    for (int j = 0; j < 4; ++j) { const int idx = lane + 64 * j; const f32x4 gv = ((const f32x4*)g)[idx], scv = ((const f32x4*)sc)[idx], shv = ((const f32x4*)sh)[idx];
        float y[4];
#pragma unroll
        for (int e = 0; e < 4; ++e) y[e] = v[j][e] * rstd * gv[e] * (1.f + scv[e]) + shv[e];
        u32x2 o; o.x = pk2(y[0], y[1]); o.y = pk2(y[2], y[3]); ((u32x2*)orow)[idx] = o; }
}
template <bool FINAL, bool INB>
__device__ __forceinline__ void norm_rows4(const void* xbase, bf16* obase, float* fout, const float* g, const float* modl, int which, int m0, int stride, int lane) {
    f32x4 v[4][4]; float s[4]; int mk[4]; bool ok[4];
#pragma unroll
    for (int k = 0; k < 4; ++k) { const int m = m0 + k * stride; ok[k] = m < ML; mk[k] = ok[k] ? m : ML - 1;
#pragma unroll
        for (int j = 0; j < 4; ++j) {
            if (INB) { const u32x2 t = ((const u32x2*)((const bf16*)xbase + (size_t)mk[k] * D))[lane + 64 * j]; v[k][j] = (f32x4){bflo(t.x), bfhi(t.x), bflo(t.y), bfhi(t.y)}; }
            else v[k][j] = __builtin_nontemporal_load((const f32x4*)((const float*)xbase + (size_t)mk[k] * D) + lane + 64 * j); } }
    f32x4 gm[4], sh4[4];
    { const float* mod = FINAL ? g : modl + (m0 >> 13) * 6144 + which * 3072;
#pragma unroll
      for (int j = 0; j < 4; ++j) { const int idx = lane + 64 * j; const f32x4 gv = ((const f32x4*)g)[idx];
          if (FINAL) { gm[j] = gv; sh4[j] = (f32x4){0.f, 0.f, 0.f, 0.f}; }
          else { const f32x4 scv = ((const f32x4*)(mod + 1024))[idx]; sh4[j] = ((const f32x4*)mod)[idx];
#pragma unroll
              for (int e = 0; e < 4; ++e) gm[j][e] = gv[e] * (1.f + scv[e]); } } }
#pragma unroll
    for (int k = 0; k < 4; ++k) { float a = 0.f;
#pragma unroll
        for (int j = 0; j < 4; ++j) a += (v[k][j][0] * v[k][j][0] + v[k][j][1] * v[k][j][1]) + (v[k][j][2] * v[k][j][2] + v[k][j][3] * v[k][j][3]);
        s[k] = a; }
#pragma unroll
    for (int o = 1; o < 64; o <<= 1) {
#pragma unroll
        for (int k = 0; k < 4; ++k) s[k] += shfl_f(s[k], lane ^ o); }
#pragma unroll
    for (int k = 0; k < 4; ++k) { if (!ok[k]) continue;
        const float rstd = 1.f / sqrtf(s[k] * (1.f / D) + EPS);
#pragma unroll
        for (int j = 0; j < 4; ++j) { const int idx = lane + 64 * j;
            if (FINAL) { f32x4 y;
#pragma unroll
                for (int e = 0; e < 4; ++e) y[e] = v[k][j][e] * rstd * gm[j][e];
                ((f32x4*)(fout + (size_t)mk[k] * D))[idx] = y; }
            else { float y[4];
#pragma unroll
                for (int e = 0; e < 4; ++e) y[e] = v[k][j][e] * rstd * gm[j][e] + sh4[j][e];
                u32x2 o; o.x = pk2(y[0], y[1]); o.y = pk2(y[2], y[3]); ((u32x2*)(obase + (size_t)mk[k] * D))[idx] = o; } }
    }
}
__device__ __forceinline__ void norm_phase(PP p, Ctx& F, int l, int which, int mrows) {
    const float* g = (which == 0 ? p->norm1_g : p->norm2_g) + l * D;
    const float* PART = (const float*)(p->ws + WS_PART);
    if (l == 0 && which == 0) { for (int m0 = F.gw; m0 < ML; m0 += 4 * F.NGW) norm_rows4<false, false>(p->x, F.HX, nullptr, g, F.MOD + l * 3 * 6144, which, m0, F.NGW, F.lane); }
    else { const void* xb = (l == 1 && which == 1 && F.G == 256) ? (const void*)(p->ws + WS_XB2) : (const void*)p->out;
        for (int m0 = F.gw; m0 < ML; m0 += 4 * F.NGW) norm_rows4<false, true>(xb, F.HX, nullptr, g, F.MOD + l * 3 * 6144, which, m0, F.NGW, F.lane); }
    for (int m = ML + F.gw; m < mrows; m += F.NGW) {
        int nparts = 0; const float* gate = nullptr;
        const float* xr = ((l == 0 && which == 0) ? p->ctx : F.XC) + (size_t)(m - ML) * D;
        if (l == 0 && which == 1) { nparts = 4; gate = F.MOD + 2 * 6144 + 2048; }
        if (l == 1 && which == 0) { nparts = 11; gate = F.MOD + 2 * 6144 + 5120; }
        const float* part = PART + (size_t)(m - ML) * D; float* xout = F.XC + (size_t)(m - ML) * D;
        const float* mod = F.MOD + (l * 3 + 2) * 6144 + which * 3072;
        norm_row_bf16(xr, F.HX + (size_t)m * D, g, mod + 1024, mod, F.lane, part, nparts, gate, xout);
    }
}
__device__ __forceinline__ void final_norm(PP p, Ctx& F) {
    for (int m0 = F.gw; m0 < ML; m0 += 4 * F.NGW) norm_rows4<true, false>(p->ws + WS_HX  , nullptr, p->out, p->final_g, nullptr, 0, m0, F.NGW, F.lane);
}
constexpr int CP = 260;
__device__ __forceinline__ int chunk_row0(int b, int cidx) { return (cidx < 4) ? (ML + b * CTXL + cidx * 64) : (b * SEQ + (cidx - 4) * 64); }
__device__ __forceinline__ void cum_to_lds(LAS float* cum, const bf16* PB, int row0, int tid) {
    { const int oct = tid & 31, j0 = tid >> 5; u32x4 w[4];
#pragma unroll
      for (int q = 0; q < 4; ++q) w[q] = *(const u32x4*)(PB + (size_t)(row0 + j0 + 16 * q) * NP + PLA + 8 * oct);
#pragma unroll
      for (int q = 0; q < 4; ++q) { LAS float* d = cum + (j0 + 16 * q) * CP + 8 * oct;
          *(LAS f32x4*)d = (f32x4){bflo(w[q].x), bfhi(w[q].x), bflo(w[q].y), bfhi(w[q].y)}; *(LAS f32x4*)(d + 4) = (f32x4){bflo(w[q].z), bfhi(w[q].z), bflo(w[q].w), bfhi(w[q].w)}; } }
    __syncthreads();
    if (tid < 256) { float s = 0.f;
        if (tid < 128) {
#pragma unroll 16
            for (int j = 0; j < 64; ++j) { s += cum[j * CP + tid]; cum[j * CP + tid] = s; }
        } else {
#pragma unroll 16
            for (int j = 63; j >= 0; --j) { s += cum[j * CP + tid]; cum[j * CP + tid] = s; }
        } }
    __syncthreads();
}
typedef float f32x2_t __attribute__((ext_vector_type(2)));
typedef __bf16 bf16x2_t __attribute__((ext_vector_type(2)));
__device__ __forceinline__ unsigned pkh(float lo, float hi) { f32x2_t v = {lo, hi}; bf16x2_t b = __builtin_convertvector(v, bf16x2_t); return __builtin_bit_cast(unsigned, b); }
__device__ __forceinline__ bf16x8 pack8h(float a0, float a1, float a2, float a3, float a4, float a5, float a6, float a7) {
    u32x4 w; w.x = pkh(a0, a1); w.y = pkh(a2, a3); w.z = pkh(a4, a5); w.w = pkh(a6, a7); return __builtin_bit_cast(bf16x8, w);
}
__device__ __forceinline__ void la_load(u32x4 (&w)[4], const bf16* PB, int row0, int tid) {
    const int oct = tid & 31, j0 = tid >> 5;
#pragma unroll
    for (int q = 0; q < 4; ++q) w[q] = *(const u32x4*)(PB + (size_t)(row0 + j0 + 16 * q) * NP + PLA + 8 * oct);
}
__device__ __forceinline__ void la_scan(LAS float* cum, const u32x4 (&w)[4], int tid) {
    const int oct = tid & 31, j0 = tid >> 5;
#pragma unroll
    for (int q = 0; q < 4; ++q) { LAS float* d = cum + (j0 + 16 * q) * CP + 8 * oct;
        *(LAS f32x4*)d = (f32x4){bflo(w[q].x), bfhi(w[q].x), bflo(w[q].y), bfhi(w[q].y)}; *(LAS f32x4*)(d + 4) = (f32x4){bflo(w[q].z), bfhi(w[q].z), bflo(w[q].w), bfhi(w[q].w)}; }
    __syncthreads();
    if (tid < 256) { float carry = 0.f;
        if (tid < 128) {
#pragma unroll
            for (int hf = 0; hf < 4; ++hf) { float v[16];
#pragma unroll
                for (int j = 0; j < 16; ++j) v[j] = cum[(16 * hf + j) * CP + tid];
                v[0] += carry;
#pragma unroll
                for (int j = 1; j < 16; ++j) v[j] += v[j - 1];
                carry = v[15];
#pragma unroll
                for (int j = 0; j < 16; ++j) cum[(16 * hf + j) * CP + tid] = v[j]; }
        } else {
#pragma unroll
            for (int hf = 3; hf >= 0; --hf) { float v[16];
#pragma unroll
                for (int j = 0; j < 16; ++j) v[j] = cum[(16 * hf + j) * CP + tid];
                v[15] += carry;
#pragma unroll
                for (int j = 14; j >= 0; --j) v[j] += v[j + 1];
                carry = v[0];
#pragma unroll
                for (int j = 0; j < 16; ++j) cum[(16 * hf + j) * CP + tid] = v[j]; }
        } }
    __syncthreads();
}
__device__ __forceinline__ void gla_a_item(Ctx& F, int b, int cidx) {
    LAS float* cum = (LAS float*)F.lds; const int row0 = chunk_row0(b, cidx);
    const int h = F.wave & 3, dir = F.wave >> 2, chb = dir * 128 + h * 32, lr = F.lane & 15, g = F.lane >> 4;
    const int jl = dir ? 0 : 63;
    u32x4 wla[4]; la_load(wla, F.PB, row0, F.tid);
    unsigned short kt[2][2][8], vt[2][4][8];
#pragma unroll
    for (int ks = 0; ks < 2; ++ks) { const int j0 = 32 * ks + 8 * g;
#pragma unroll
        for (int mb = 0; mb < 2; ++mb)
#pragma unroll
            for (int e = 0; e < 8; ++e) kt[ks][mb][e] = F.PB[(size_t)(row0 + j0 + e) * NP + PK + h * 32 + 16 * mb + lr];
#pragma unroll
        for (int nb = 0; nb < 4; ++nb)
#pragma unroll
            for (int e = 0; e < 8; ++e) vt[ks][nb][e] = F.PB[(size_t)(row0 + j0 + e) * NP + PV + h * 64 + 16 * nb + lr]; }
    la_scan(cum, wla, F.tid);
    f32x4 acc[2][4];
#pragma unroll
    for (int mb = 0; mb < 2; ++mb)
#pragma unroll
        for (int nb = 0; nb < 4; ++nb) acc[mb][nb] = (f32x4){0.f, 0.f, 0.f, 0.f};
#pragma unroll
    for (int ks = 0; ks < 2; ++ks) {
        bf16x8 af[2], bfr[4]; const int j0 = 32 * ks + 8 * g;
#pragma unroll
        for (int mb = 0; mb < 2; ++mb) { const int dk = 16 * mb + lr; const float last = cum[jl * CP + chb + dk]; float a[8];
#pragma unroll
            for (int e = 0; e < 8; ++e) { const int j = j0 + e; a[e] = bf2f(kt[ks][mb][e]) * __expf(last - cum[j * CP + chb + dk]); }
            af[mb] = pack8h(a[0], a[1], a[2], a[3], a[4], a[5], a[6], a[7]); }
#pragma unroll
        for (int nb = 0; nb < 4; ++nb) { const unsigned short* t = vt[ks][nb];
            u32x4 w; w.x = t[0] | ((unsigned)t[1] << 16); w.y = t[2] | ((unsigned)t[3] << 16); w.z = t[4] | ((unsigned)t[5] << 16); w.w = t[6] | ((unsigned)t[7] << 16);
            bfr[nb] = __builtin_bit_cast(bf16x8, w); }
#pragma unroll
        for (int mb = 0; mb < 2; ++mb)
#pragma unroll
            for (int nb = 0; nb < 4; ++nb) acc[mb][nb] = MFMA16(af[mb], bfr[nb], acc[mb][nb]);
    }
    const size_t sidx = (size_t)(((b * 2 + dir) * 4 + h) * NCH + cidx);
    float* st = F.ST + sidx * 2048;
#pragma unroll
    for (int mb = 0; mb < 2; ++mb)
#pragma unroll
        for (int nb = 0; nb < 4; ++nb) *(f32x4*)(st + (16 * nb + lr) * 32 + 16 * mb + 4 * g) = acc[mb][nb];
    if (F.lane < 32) F.DEC[sidx * 32 + F.lane] = __expf(cum[jl * CP + chb + F.lane]);
    __syncthreads();
}
__device__ __forceinline__ void gla_scan(Ctx& F) {
    LAS float* xa = (LAS float*)F.lds; LAS float* xb = xa + 512;
    const int seg = F.tid >> 6, el = F.tid & 63;
    for (int blk = blockIdx.x; blk < 512; blk += F.G) {
        const int ge = blk * 64 + el, e = ge & 2047, seq = ge >> 11, dir = (seq >> 2) & 1, dk = e & 31;
        float* st = F.ST + (size_t)seq * NCH * 2048 + e; const float* dc = F.DEC + (size_t)seq * NCH * 32 + dk;
        float u[17], d[17];
#pragma unroll
        for (int i = 0; i < 17; ++i) { const int s = seg * 17 + i; const bool ok = s < NCH; const int sc = ok ? s : NCH - 1; const int c = dir ? (sc < 4 ? 3 - sc : 135 - sc) : sc;
            const float uu = st[(size_t)c * 2048], dd = dc[c * 32]; u[i] = ok ? uu : 0.f; d[i] = ok ? dd : 1.f; }
        float A = 1.f, B = 0.f;
#pragma unroll
        for (int i = 0; i < 17; ++i) { B = B * d[i] + u[i]; A *= d[i]; }
        xa[F.tid] = A; xb[F.tid] = B;
        __syncthreads();
        float S = 0.f;
        for (int sg = 0; sg < seg; ++sg) S = S * xa[sg * 64 + el] + xb[sg * 64 + el];
#pragma unroll
        for (int i = 0; i < 17; ++i) { const int s = seg * 17 + i; if (s < NCH) { const int c = dir ? (s < 4 ? 3 - s : 135 - s) : s; st[(size_t)c * 2048] = S; } S = S * d[i] + u[i]; }
        __syncthreads();
    }
}
template <int NI>
__device__ __forceinline__ void gla_c_item(PP p, Ctx& F, int l, int b, int cidx, int sub) {
    LAS float* cum = (LAS float*)F.lds; const int row0 = chunk_row0(b, cidx);
    const int h = F.wave & 3, half = (NI == 2) ? (F.wave >> 2) : sub, ibase = (NI == 2) ? 0 : (F.wave >> 2), lr = F.lane & 15, g = F.lane >> 4;
    u32x4 wla[4]; la_load(wla, F.PB, row0, F.tid);
    f32x4 o[4][2];
#pragma unroll
    for (int mb = 0; mb < 4; ++mb) { o[mb][0] = (f32x4){0.f, 0.f, 0.f, 0.f}; o[mb][1] = (f32x4){0.f, 0.f, 0.f, 0.f}; }
    bf16x8 av[4][2];
#pragma unroll
    for (int mb = 0; mb < 4; ++mb)
#pragma unroll
        for (int pp = 0; pp < 2; ++pp) { unsigned short t[8];
#pragma unroll
            for (int e = 0; e < 8; ++e) { const int j = 32 * pp + (e < 4 ? 4 * g + e : 16 + 4 * g + (e - 4)); t[e] = F.PB[(size_t)(row0 + j) * NP + PV + h * 64 + 16 * mb + lr]; }
            u32x4 w; w.x = t[0] | ((unsigned)t[1] << 16); w.y = t[2] | ((unsigned)t[3] << 16); w.z = t[4] | ((unsigned)t[5] << 16); w.w = t[6] | ((unsigned)t[7] << 16);
            av[mb][pp] = __builtin_bit_cast(bf16x8, w); }
    u32x4 qraw[2], kraw[4]; f32x4 sraw[2][4][2];
#pragma unroll
    for (int ibl = 0; ibl < NI; ++ibl) qraw[ibl] = *(const u32x4*)(F.PB + (size_t)(row0 + 16 * (2 * half + ibase + ibl) + lr) * NP + PQ + h * 32 + 8 * g);
#pragma unroll
    for (int jb = 0; jb < 4; ++jb) kraw[jb] = *(const u32x4*)(F.PB + (size_t)(row0 + 16 * jb + lr) * NP + PK + h * 32 + 8 * g);
    { const float* st = F.ST + (size_t)(((b * 2 + 0) * 4 + h) * NCH + cidx) * 2048;
#pragma unroll
        for (int mb = 0; mb < 4; ++mb) { sraw[0][mb][0] = *(const f32x4*)(st + (16 * mb + lr) * 32 + 8 * g); sraw[0][mb][1] = *(const f32x4*)(st + (16 * mb + lr) * 32 + 8 * g + 4); } }
    la_scan(cum, wla, F.tid);
    { const float* st = F.ST + (size_t)(((b * 2 + 1) * 4 + h) * NCH + cidx) * 2048;
#pragma unroll
        for (int mb = 0; mb < 4; ++mb) { sraw[1][mb][0] = *(const f32x4*)(st + (16 * mb + lr) * 32 + 8 * g); sraw[1][mb][1] = *(const f32x4*)(st + (16 * mb + lr) * 32 + 8 * g + 4); } }
#pragma unroll
    for (int dir = 0; dir < 2; ++dir) {
        const int chb = dir * 128 + h * 32;
        bf16x8 bq[2];
#pragma unroll
        for (int ibl = 0; ibl < NI; ++ibl) { const int i = 16 * (2 * half + ibase + ibl) + lr;
            const u32x4 qw = qraw[ibl];
            const f32x4 c0 = *(const LAS f32x4*)(cum + i * CP + chb + 8 * g), c1 = *(const LAS f32x4*)(cum + i * CP + chb + 8 * g + 4);
            bq[ibl] = pack8h(bflo(qw.x) * __expf(c0[0]), bfhi(qw.x) * __expf(c0[1]), bflo(qw.y) * __expf(c0[2]), bfhi(qw.y) * __expf(c0[3]),
                            bflo(qw.z) * __expf(c1[0]), bfhi(qw.z) * __expf(c1[1]), bflo(qw.w) * __expf(c1[2]), bfhi(qw.w) * __expf(c1[3])); }
#pragma unroll
        for (int mb = 0; mb < 4; ++mb) { const f32x4 s0 = sraw[dir][mb][0], s1 = sraw[dir][mb][1];
            const bf16x8 as = pack8h(s0[0], s0[1], s0[2], s0[3], s1[0], s1[1], s1[2], s1[3]);
            o[mb][0] = MFMA16(as, bq[0], o[mb][0]); if (NI == 2) o[mb][1] = MFMA16(as, bq[1], o[mb][1]); }
#pragma unroll
        for (int pp = 0; pp < 2; ++pp) {
            if ((dir == 0 && half == 0 && pp == 1) || (dir == 1 && half == 1 && pp == 0)) continue;
            f32x4 sc[2][2];
#pragma unroll
            for (int q = 0; q < 2; ++q) { const int jb = 2 * pp + q, j = 16 * jb + lr;
                const u32x4 kw = kraw[jb];
                const f32x4 c0 = *(const LAS f32x4*)(cum + j * CP + chb + 8 * g), c1 = *(const LAS f32x4*)(cum + j * CP + chb + 8 * g + 4);
                const bf16x8 ak = pack8h(bflo(kw.x) * __expf(-c0[0]), bfhi(kw.x) * __expf(-c0[1]), bflo(kw.y) * __expf(-c0[2]), bfhi(kw.y) * __expf(-c0[3]),
                                        bflo(kw.z) * __expf(-c1[0]), bfhi(kw.z) * __expf(-c1[1]), bflo(kw.w) * __expf(-c1[2]), bfhi(kw.w) * __expf(-c1[3]));
#pragma unroll
                for (int ibl = 0; ibl < NI; ++ibl) { f32x4 z = (f32x4){0.f, 0.f, 0.f, 0.f}; z = MFMA16(ak, bq[ibl], z);
                    const int i = 16 * (2 * half + ibase + ibl) + lr;
#pragma unroll
                    for (int r = 0; r < 4; ++r) { const int jj = 16 * jb + 4 * g + r; const bool keep = dir ? (jj >= i) : (jj <= i); z[r] = keep ? z[r] : 0.f; }
                    sc[q][ibl] = z; } }
#pragma unroll
            for (int ibl = 0; ibl < NI; ++ibl) { const bf16x8 pb = pack8h(sc[0][ibl][0], sc[0][ibl][1], sc[0][ibl][2], sc[0][ibl][3], sc[1][ibl][0], sc[1][ibl][1], sc[1][ibl][2], sc[1][ibl][3]);
#pragma unroll
                for (int mb = 0; mb < 4; ++mb) o[mb][ibl] = MFMA16(av[mb][pp], pb, o[mb][ibl]); }
        }
    }
    const float* gg = p->gla_g + l * 64;
#pragma unroll
    for (int ibl = 0; ibl < NI; ++ibl) { float ss = 0.f;
#pragma unroll
        for (int mb = 0; mb < 4; ++mb) ss += (o[mb][ibl][0] * o[mb][ibl][0] + o[mb][ibl][1] * o[mb][ibl][1]) + (o[mb][ibl][2] * o[mb][ibl][2] + o[mb][ibl][3] * o[mb][ibl][3]);
        ss += shfl_f(ss, F.lane ^ 16); ss += shfl_f(ss, F.lane ^ 32);
        const float rstd = 1.f / sqrtf(ss * (1.f / 64.f) + EPS);
        const int i = 16 * (2 * half + ibase + ibl) + lr; const size_t row = (size_t)(row0 + i);
#pragma unroll
        for (int mb = 0; mb < 4; ++mb) { const int dv = 16 * mb + 4 * g; const f32x4 gv = *(const f32x4*)(gg + dv);
            const u32x2 gw = *(const u32x2*)(F.PB + row * NP + PG + h * 64 + dv);
            const float y0 = o[mb][ibl][0] * rstd * gv[0] * silu_f(bflo(gw.x)), y1 = o[mb][ibl][1] * rstd * gv[1] * silu_f(bfhi(gw.x));
            const float y2 = o[mb][ibl][2] * rstd * gv[2] * silu_f(bflo(gw.y)), y3 = o[mb][ibl][3] * rstd * gv[3] * silu_f(bfhi(gw.y));
            u32x2 w; w.x = pk2(y0, y1); w.y = pk2(y2, y3); *(u32x2*)(F.YMIX + row * D + h * 64 + dv) = w; }
    }
    __syncthreads();
}

template <int NKS, int GRP>
__device__ __forceinline__ void dft_mma_lds(f32x4 (&acc)[8], const LAS unsigned char* fl, int pitchB, const bf16* re, const bf16* im, size_t rstride, int khalf, int lane) {
    const int lr = lane & 15, g = lane >> 4;
#pragma unroll
    for (int k0 = 0; k0 < NKS; k0 += GRP) {
        bf16x8 bfrag[GRP];
#pragma unroll
        for (int kq = 0; kq < GRP; ++kq) { const int ks = k0 + kq; const int kk0 = 32 * ks + 8 * g; const bool part = kk0 >= khalf; const int idx = part ? kk0 - khalf : kk0;
            const bf16* src = (part ? im : re) + (size_t)idx * rstride + lr; unsigned short t[8];
#pragma unroll
            for (int e = 0; e < 8; ++e) t[e] = src[(size_t)e * rstride];
            u32x4 w; w.x = t[0] | ((unsigned)t[1] << 16); w.y = t[2] | ((unsigned)t[3] << 16); w.z = t[4] | ((unsigned)t[5] << 16); w.w = t[6] | ((unsigned)t[7] << 16);
            bfrag[kq] = __builtin_bit_cast(bf16x8, w); }
#pragma unroll
        for (int kq = 0; kq < GRP; ++kq) { const int ks = k0 + kq;
#pragma unroll
            for (int mb = 0; mb < 8; ++mb) { const bf16x8 a = *(const LAS bf16x8*)(fl + (16 * mb + lr) * pitchB + (32 * ks + 8 * g) * 2); acc[mb] = MFMA16(a, bfrag[kq], acc[mb]); }
        }
    }
}
__device__ __forceinline__ void f_to_lds(LAS unsigned char* fl, const bf16* Fm, int rows, int rowB, int tid) {
    const int cpr = rowB >> 4, n = rows * cpr;
    for (int i = tid; i < n; i += 512) { const int r = i / cpr, c = i - r * cpr; *(LAS u32x4*)(fl + r * (rowB + 16) + c * 16) = *(const u32x4*)((const unsigned char*)Fm + (size_t)r * rowB + c * 16); }
    __syncthreads();
}
template <int NKS, int GRP = 4, int NMB = 8>
__device__ __forceinline__ void dft_mma(f32x4 (&acc)[NMB], const bf16* Fm, int ldF, int mrow0, const bf16* re, const bf16* im, size_t rstride, int khalf, int lane) {
    const int lr = lane & 15, g = lane >> 4;
#pragma unroll
    for (int k0 = 0; k0 < NKS; k0 += GRP) {
        bf16x8 bfrag[GRP];
#pragma unroll
        for (int kq = 0; kq < GRP; ++kq) { const int ks = k0 + kq; const int kk0 = 32 * ks + 8 * g; const bool part = kk0 >= khalf; const int idx = part ? kk0 - khalf : kk0;
            const bf16* src = (part ? im : re) + (size_t)idx * rstride + lr; unsigned short t[8];
#pragma unroll
            for (int e = 0; e < 8; ++e) t[e] = src[(size_t)e * rstride];
            u32x4 w; w.x = t[0] | ((unsigned)t[1] << 16); w.y = t[2] | ((unsigned)t[3] << 16); w.z = t[4] | ((unsigned)t[5] << 16); w.w = t[6] | ((unsigned)t[7] << 16);
            bfrag[kq] = __builtin_bit_cast(bf16x8, w); }
#pragma unroll
        for (int kq = 0; kq < GRP; ++kq) { const int ks = k0 + kq;
            bf16x8 a[NMB];
#pragma unroll
            for (int mb = 0; mb < NMB; ++mb) a[mb] = *(const bf16x8*)(Fm + (size_t)(mrow0 + 16 * mb + lr) * ldF + 32 * ks + 8 * g);
#pragma unroll
            for (int mb = 0; mb < NMB; ++mb) acc[mb] = MFMA16(a[mb], bfrag[kq], acc[mb]);
            if (kq & 1) __builtin_amdgcn_sched_barrier(0);
        }
    }
}
__device__ __forceinline__ void dft_mma_loop(f32x4 (&acc)[8], const bf16* Fm, int ldF, int mrow0, int nks, const bf16* re, const bf16* im, size_t rstride, int khalf, int lane) {
    const int lr = lane & 15, g = lane >> 4;
#pragma unroll 1
    for (int ks = 0; ks < nks; ++ks) { const int kk0 = 32 * ks + 8 * g; const bool part = kk0 >= khalf; const int idx = part ? kk0 - khalf : kk0;
        const bf16* src = (part ? im : re) + (size_t)idx * rstride + lr; unsigned short t[8];
#pragma unroll
        for (int e = 0; e < 8; ++e) t[e] = src[(size_t)e * rstride];
        u32x4 w; w.x = t[0] | ((unsigned)t[1] << 16); w.y = t[2] | ((unsigned)t[3] << 16); w.z = t[4] | ((unsigned)t[5] << 16); w.w = t[6] | ((unsigned)t[7] << 16);
        const bf16x8 bfrag = __builtin_bit_cast(bf16x8, w);
#pragma unroll
        for (int mb = 0; mb < 8; ++mb) { const bf16x8 a = *(const bf16x8*)(Fm + (size_t)(mrow0 + 16 * mb + lr) * ldF + 32 * ks + 8 * g); acc[mb] = MFMA16(a, bfrag, acc[mb]); }
    }
}
__device__ __forceinline__ void fft_stage1(Ctx& F) {
    const int lr = F.lane & 15, g = F.lane >> 4;
    f_to_lds(F.lds, F.F1, 128, 256, F.tid);
    for (int it = F.gw; it < 4096; it += F.NGW) { const int cb = it & 15, n2 = (it >> 4) & 127, b = it >> 11;
        f32x4 acc[8];
#pragma unroll
        for (int mb = 0; mb < 8; ++mb) acc[mb] = (f32x4){0.f, 0.f, 0.f, 0.f};
        const bf16* re = F.PB + (size_t)(b * SEQ + n2) * NP + PFA + 16 * cb;
        dft_mma_lds<4, 4>(acc, F.lds, 272, re, re + 256, (size_t)128 * NP, 64, F.lane);
#pragma unroll
        for (int mb = 0; mb < 4; ++mb)
#pragma unroll
            for (int r = 0; r < 4; ++r) { const int k1 = 16 * mb + 4 * g + r; const float a = (float)(k1 * n2) * (1.f / 8192.f); const float c = cos_rev(a), s = sin_rev(a);
                const float tr = acc[mb][r], ti = acc[mb + 4][r]; const float xr = tr * c + ti * s, xi = ti * c - tr * s;
                bf16* dst = F.TB + ((size_t)((b * 64 + k1) * 2) * 128 + n2) * 256 + 16 * cb + lr;
                dst[0] = (bf16)f2bf(xr); dst[(size_t)128 * 256] = (bf16)f2bf(xi); }
    }
}
__device__ __forceinline__ void fft_stage2(Ctx& F, int l) {
    const int lr = F.lane & 15, g = F.lane >> 4;
    f_to_lds(F.lds, F.F2, 128, 512, F.tid);
    for (int it = F.gw; it < 2048; it += F.NGW) {
        f32x4 acc[8];
#pragma unroll
        for (int mb = 0; mb < 8; ++mb) acc[mb] = (f32x4){0.f, 0.f, 0.f, 0.f};
        const int cb = it & 15, k1 = (it >> 4) & 63, b = it >> 10;
        const bf16* re = F.TB + (size_t)((b * 64 + k1) * 2) * 128 * 256 + 16 * cb;
        dft_mma_lds<8, 4>(acc, F.lds, 528, re, re + (size_t)128 * 256, 256, 128, F.lane);
#pragma unroll
        for (int mb = 0; mb < 8; ++mb)
#pragma unroll
            for (int r = 0; r < 4; ++r) { const int k2 = 16 * mb + 4 * g + r; F.YMIX[(size_t)(b * SEQ + k1 + 64 * k2) * D + 256 + 16 * cb + lr] = (bf16)f2bf(acc[mb][r]); }
    }
    __syncthreads();
}
__device__ __forceinline__ void ctx_dft(Ctx& F, int w0, int nw) {
    const int lr = F.lane & 15, g = F.lane >> 4;
    for (int it = w0; it >= 0 && it < 256; it += nw) { const int mq = it & 7, cb = (it >> 3) & 15, b = it >> 7;
            f32x4 acc[2] = {(f32x4){0.f, 0.f, 0.f, 0.f}, (f32x4){0.f, 0.f, 0.f, 0.f}};
            const bf16* re = F.PB + (size_t)(ML + b * CTXL) * NP + PFA + 16 * cb;
            dft_mma<8, 4, 2>(acc, F.FC, 512, 32 * mq, re, re, (size_t)NP, 256, F.lane); __builtin_amdgcn_sched_barrier(0);
            dft_mma<8, 4, 2>(acc, F.FC + 256, 512, 32 * mq, re + 256, re + 256, (size_t)NP, 256, F.lane);
#pragma unroll
            for (int mb = 0; mb < 2; ++mb)
#pragma unroll
                for (int r = 0; r < 4; ++r) { const int k = 32 * mq + 16 * mb + 4 * g + r; F.YMIX[(size_t)(ML + b * CTXL + k) * D + 256 + 16 * cb + lr] = (bf16)f2bf(acc[mb][r]); }
        }
}
__device__ __forceinline__ void load8(const bf16* q, float (&v)[8]) { const u32x4 w = *(const u32x4*)q; v[0] = bflo(w.x); v[1] = bfhi(w.x); v[2] = bflo(w.y); v[3] = bfhi(w.y); v[4] = bflo(w.z); v[5] = bfhi(w.z); v[6] = bflo(w.w); v[7] = bfhi(w.w); }
__device__ __forceinline__ void store8(bf16* q, const float (&v)[8]) { u32x4 w; w.x = pk2(v[0], v[1]); w.y = pk2(v[2], v[3]); w.z = pk2(v[4], v[5]); w.w = pk2(v[6], v[7]); *(u32x4*)q = w; }
__device__ __forceinline__ u32x4 ldrow(const bf16* base, int rbase, int t, int n, int col) { const int tc = t < 0 ? 0 : (t > n - 1 ? n - 1 : t); return *(const u32x4*)(base + (size_t)(rbase + tc) * NP + col); }
__device__ __forceinline__ void unpack8(const u32x4 w, float (&v)[8]) { v[0] = bflo(w.x); v[1] = bfhi(w.x); v[2] = bflo(w.y); v[3] = bfhi(w.y); v[4] = bflo(w.z); v[5] = bfhi(w.z); v[6] = bflo(w.w); v[7] = bfhi(w.w); }
__device__ __forceinline__ void convpool_item(PP p, Ctx& F, int l, int it) {
    int rbase, n, t0;
    if (it < 256) { rbase = it * 64; n = 64; t0 = 0; } else { const int sg = it - 256; rbase = ML + (sg >> 2) * CTXL; n = CTXL; t0 = (sg & 3) * 64; }
    const int oct = F.tid & 31, tl = F.tid >> 5, c0 = 8 * oct, tb = t0 + tl * 4;
    {
        u32x4 hw_[6], cw_[6], bw_[4];
#pragma unroll
        for (int i = 0; i < 6; ++i) { hw_[i] = ldrow(F.PB, rbase, tb - 1 + i, n, PH + c0); cw_[i] = ldrow(F.PB, rbase, tb - 1 + i, n, PCG + c0); }
#pragma unroll
        for (int q = 0; q < 4; ++q) bw_[q] = ldrow(F.PB, rbase, tb + q, n, PBG + c0);
        const f32x4 w0a = *(const f32x4*)(p->conv_w + (l * 3 + 0) * 256 + c0), w0b = *(const f32x4*)(p->conv_w + (l * 3 + 0) * 256 + c0 + 4);
        const f32x4 w1a = *(const f32x4*)(p->conv_w + (l * 3 + 1) * 256 + c0), w1b = *(const f32x4*)(p->conv_w + (l * 3 + 1) * 256 + c0 + 4);
        const f32x4 w2a = *(const f32x4*)(p->conv_w + (l * 3 + 2) * 256 + c0), w2b = *(const f32x4*)(p->conv_w + (l * 3 + 2) * 256 + c0 + 4);
        const f32x4 cba = *(const f32x4*)(p->conv_b + l * 256 + c0), cbb = *(const f32x4*)(p->conv_b + l * 256 + c0 + 4);
        float hc[6][8];
#pragma unroll
        for (int i = 0; i < 6; ++i) { float a[8], b[8]; unpack8(hw_[i], a); unpack8(cw_[i], b); const int t = tb - 1 + i; const float msk = (t >= 0 && t < n) ? 1.f : 0.f;
#pragma unroll
            for (int e = 0; e < 8; ++e) hc[i][e] = a[e] * b[e] * msk; }
#pragma unroll
        for (int q = 0; q < 4; ++q) { float bg[8], y[8]; unpack8(bw_[q], bg);
#pragma unroll
            for (int e = 0; e < 8; ++e) { const float w0 = e < 4 ? w0a[e & 3] : w0b[e & 3], w1 = e < 4 ? w1a[e & 3] : w1b[e & 3], w2 = e < 4 ? w2a[e & 3] : w2b[e & 3], cb = e < 4 ? cba[e & 3] : cbb[e & 3];
                y[e] = bg[e] * (w0 * hc[q][e] + w1 * hc[q + 1][e] + w2 * hc[q + 2][e] + cb); }
            store8(F.YMIX + (size_t)(rbase + tb + q) * D + 512 + c0, y); }
    }
    __builtin_amdgcn_sched_barrier(0);
    {
        const int wnd = 2 << (oct >> 3), hw = wnd >> 1;
        float s[4][8], self[4][8];
#pragma unroll
        for (int q = 0; q < 4; ++q) { unpack8(ldrow(F.PB, rbase, tb + q, n, PPOOL + c0), self[q]);
#pragma unroll
            for (int e = 0; e < 8; ++e) s[q][e] = 0.f; }
        __builtin_amdgcn_sched_barrier(0);
#pragma unroll
        for (int bt = 0; bt < 19; bt += 7) {
            u32x4 pw[7];
#pragma unroll
            for (int ii = 0; ii < 7; ++ii) if (bt + ii < 19) pw[ii] = ldrow(F.PB, rbase, tb - hw + bt + ii, n, PPOOL + c0);
#pragma unroll
            for (int ii = 0; ii < 7; ++ii) if (bt + ii < 19) { const int i = bt + ii; float v[8]; unpack8(pw[ii], v); const int t = tb - hw + i; const bool inr = (t >= 0 && t < n);
#pragma unroll
                for (int q = 0; q < 4; ++q) { const float mk = (inr && i >= q && i < q + wnd) ? 1.f : 0.f;
#pragma unroll
                    for (int e = 0; e < 8; ++e) s[q][e] += mk * v[e]; } }
            __builtin_amdgcn_sched_barrier(0);
        }
#pragma unroll
        for (int q = 0; q < 4; ++q) { const int t = tb + q; const int lo = (t - hw > 0) ? t - hw : 0, hi = (t + hw - 1 < n - 1) ? t + hw - 1 : n - 1; const float inv = 1.f / (float)(hi - lo + 1);
            float y[8];
#pragma unroll
            for (int e = 0; e < 8; ++e) y[e] = s[q][e] * inv - self[q][e];
            store8(F.YMIX + (size_t)(rbase + t) * D + 768 + c0, y); }
    }
}
__device__ __forceinline__ void ctx_act(PP p, Ctx& F, int l) {
    const int gt = blockIdx.x * 512 + F.tid, NT = F.G * 512;
    for (int i = gt; i < MC * 352; i += NT) { const int oc = i % 352, rc = i / 352, t = rc & 255, c0 = 8 * oc;
        const bf16* base = F.CAU + (size_t)rc * NUP + c0; float a[8], y[8], u[8];
        const float* cw = p->ffn_cw + (size_t)l * 3 * DFF + c0; const float* cb = p->ffn_cb + (size_t)l * DFF + c0;
#pragma unroll
        for (int e = 0; e < 8; ++e) y[e] = cb[e];
        if (t > 0) { load8(base - NUP, a);
#pragma unroll
            for (int e = 0; e < 8; ++e) y[e] += cw[e] * a[e]; }
        load8(base, a);
#pragma unroll
        for (int e = 0; e < 8; ++e) y[e] += cw[DFF + e] * a[e];
        if (t < 255) { load8(base + NUP, a);
#pragma unroll
            for (int e = 0; e < 8; ++e) y[e] += cw[2 * DFF + e] * a[e]; }
        load8(base + DFF, u);
#pragma unroll
        for (int e = 0; e < 8; ++e) y[e] = silu_f(y[e]) * u[e];
        store8(F.ACT + (size_t)(ML + rc) * DFF + c0, y);
    }
}
__global__ void __launch_bounds__(512, 2) fwd_megakernel(Params p_) {
    PP p = (PP)__builtin_amdgcn_kernarg_segment_ptr();
    extern __shared__ __attribute__((aligned(16))) unsigned char lds_raw[];
    cg::grid_group grid = cg::this_grid();
    Ctx F;
    F.lds = (LAS unsigned char*)lds_raw; F.tid = threadIdx.x; F.lane = F.tid & 63; F.wave = __builtin_amdgcn_readfirstlane(F.tid >> 6);
    const int wave_s = F.wave;
    F.G = gridDim.x; F.gw = blockIdx.x * 8 + F.wave; F.NGW = F.G * 8;
    unsigned char* ws = p->ws;
#define SETPTRS() do { { PP q_ = (PP)__builtin_amdgcn_kernarg_segment_ptr(); asm volatile("" : "+s"(q_)); p = q_; } unsigned char* w_ = p->ws; asm volatile("" : "+s"(w_)); \
    F.MOD = (float*)(w_ + WS_MOD); F.MCS = (float*)(w_ + WS_MCS); F.F1 = (bf16*)(w_ + WS_F1); F.F2 = (bf16*)(w_ + WS_F2); F.FC = (bf16*)(w_ + WS_FC); \
    F.HX = (bf16*)(w_ + WS_HX); F.TB = (bf16*)(w_ + WS_HX); F.YMIX = (bf16*)(w_ + WS_YMIX); F.PB = (bf16*)(w_ + WS_P); F.ACT = (bf16*)(w_ + WS_P); \
    F.XC = (float*)(w_ + WS_XC); F.ST = (float*)(w_ + WS_ST); F.DEC = (float*)(w_ + WS_DEC); F.CAU = (bf16*)(w_ + WS_CAU); } while (0)
    SETPTRS();

#ifndef NO_P0
#define REFRESH() do { int t_; asm volatile("v_mbcnt_lo_u32_b32 %0, -1, 0\n\tv_mbcnt_hi_u32_b32 %0, -1, %0" : "=v"(t_)); t_ |= (wave_s << 6); F.tid = t_; F.lane = t_ & 63; F.wave = __builtin_amdgcn_readfirstlane(t_ >> 6); F.gw = blockIdx.x * 8 + F.wave; SETPTRS(); } while (0)
    { volatile LAS unsigned* misc = (volatile LAS unsigned*)(F.lds + RING_BYTES); if (F.tid < 64) misc[F.tid] = 0u; }
    __syncthreads();
    XcdBarrier bar = xcd_barrier_post((unsigned*)(ws + WS_CTL), (volatile LAS unsigned*)(F.lds + RING_BYTES) + 8, F.tid);
#define GSYNC() do { REFRESH(); xcd_barrier(bar, F.tid); } while (0)
    REFRESH();
    phase0(p, F);
#endif
    if (p->ws == nullptr) grid.sync();
    GSYNC();
#define L0() ({ int lq_ = l; asm volatile("" : "+s"(lq_)); lq_ == 0; })
    for (int l = 0; l < 2; ++l) {
        const int M6 = L0() ? MT : ML;
#ifndef NO_P1
        REFRESH();
        norm_phase(p, F, l, 0, MT);
        REFRESH();
        if (L0()) fold_items(p, F);
#ifdef PROBE_B
        REFRESH(); norm_phase(p, F, l, 0, MT); if (L0()) fold_items(p, F);
#endif
#endif
        GSYNC();
#ifndef NO_P2
        REFRESH();
        { pg8::Gemm g{F.HX, win_t(p, l), MT, NP, D, D}; pg8::StaticOrder S; S.init(MT, NP, F.G, (int)blockIdx.x);
          EpiP E{F.PB, p->b_a2 + l * 256};
          pg8::gemm_phase<EpiP, pg8::StaticOrder, true, true>(F.lds, g, S, E, F.tid);
#ifdef PROBE_C
          __syncthreads(); pg8::gemm_phase<EpiP, pg8::StaticOrder, true, true>(F.lds, g, S, E, F.tid);
#endif
        }
#endif
        GSYNC();
#ifdef PROBE_A
        for (int rep_ = 0; rep_ < 2; ++rep_) {
#else
        {
#endif
#ifndef NO_GA
        REFRESH();
        for (int it = blockIdx.x; it < 2 * NCH; it += F.G) gla_a_item(F, it / NCH, it % NCH);
#ifdef PR_GA
        __syncthreads(); REFRESH();
        for (int it = blockIdx.x; it < 2 * NCH; it += F.G) gla_a_item(F, it / NCH, it % NCH);
#endif
#endif
#ifndef NO_F1
        REFRESH();
        fft_stage1(F);
#ifdef PR_F1
        __syncthreads(); REFRESH();
        fft_stage1(F);
#endif
#endif
#ifndef NO_CP
        REFRESH();
        for (int v = blockIdx.x; v < 512; v += F.G) { const int it = (v < 256) ? v : 256 + ((v + 248) & 255);
            if (it >= (L0() ? 264 : 256)) continue; convpool_item(p, F, l, it); }
#ifdef PR_CP
        __syncthreads(); REFRESH();
        for (int v = blockIdx.x; v < 512; v += F.G) { const int it = (v < 256) ? v : 256 + ((v + 248) & 255);
            if (it >= (L0() ? 264 : 256)) continue; convpool_item(p, F, l, it); }
#endif
#endif
        }
        GSYNC();
#ifdef PROBE_A
        REFRESH(); fft_stage2(F, l);
#endif
#ifndef NO_F2
        REFRESH();
        fft_stage2(F, l);
#ifdef PR_F2
        __syncthreads(); REFRESH();
        fft_stage2(F, l);
#endif
#endif
#ifndef NO_SC
        REFRESH();
        gla_scan(F);
#endif
        GSYNC();
#ifdef PROBE_A
        for (int rep_ = 0; rep_ < 2; ++rep_) {
#else
        {
#endif
#ifndef NO_GC
        REFRESH();
        for (int it = blockIdx.x; it < 256; it += F.G) gla_c_item<2>(p, F, l, it >> 7, 4 + (it & 127), 0);
        if (L0()) for (int j = blockIdx.x; j < 16; j += F.G) gla_c_item<1>(p, F, l, j >> 3, (j >> 1) & 3, j & 1);
        if (L0()) { if (F.G == 256) ctx_dft(F, F.gw - 256, 1 << 30); else ctx_dft(F, F.gw, F.NGW); }
#ifdef PR_GC
        __syncthreads(); REFRESH();
        for (int it = blockIdx.x; it < 256; it += F.G) gla_c_item<2>(p, F, l, it >> 7, 4 + (it & 127), 0);
#endif
#endif
        }
        GSYNC();
#ifndef NO_P6
        REFRESH();
        if (L0()) { pg8::Gemm g{F.YMIX, wout_t(p, l), MT, D, 256, D}; SplitOrder S; S.init(4, F.G, (int)blockIdx.x);
          EpiPartial E{(float*)(p->ws + WS_PART)};
          pg8::gemm_phase<EpiPartial, SplitOrder, false, false>(F.lds, g, S, E, F.tid); __syncthreads(); }
        REFRESH();
        { pg8::Gemm g{F.YMIX, wout_t(p, l), ML, D, D, D}; pg8::StaticOrder S; S.init(ML, D, F.G, (int)blockIdx.x);
          if (L0()) { EpiRes<false, true> E{p->x, p->out, F.MOD + l * 3 * 6144 + 2048}; pg8::gemm_phase<EpiRes<false, true>, pg8::StaticOrder, true, true>(F.lds, g, S, E, F.tid); }
          else if (F.G == 256) { EpiResNorm E{(const bf16*)p->out, (bf16*)(p->ws + WS_XB2), F.HX, F.MOD + l * 3 * 6144 + 2048, p->norm2_g + l * D, F.MOD + l * 3 * 6144, (float*)(p->ws + WS_SLOT) + 65536 * 2, (unsigned*)(p->ws + WS_CTL) + CW_FIN + 4096};
            pg8::gemm_phase<EpiResNorm, pg8::StaticOrder, false, true>(F.lds, g, S, E, F.tid); }
          else { EpiRes<true, true> E{p->out, p->out, F.MOD + l * 3 * 6144 + 2048}; pg8::gemm_phase<EpiRes<true, true>, pg8::StaticOrder, true, true>(F.lds, g, S, E, F.tid); } }
#endif
        GSYNC();
        if (L0() || F.G != 256) { REFRESH(); norm_phase(p, F, l, 1, M6); GSYNC(); }
#ifndef NO_P8
        REFRESH();
        { pg8::Gemm g{F.HX, wup_t(p, l), ML, NUP, D, D}; pg8::StaticOrder S; S.init(ML, NUP, F.G, (int)blockIdx.x);
          EpiUp E{F.ACT, p->ffn_cw + (size_t)l * 3 * DFF, p->ffn_cb + (size_t)l * DFF};
          pg8::gemm_phase<EpiUp, pg8::StaticOrder, true, true>(F.lds, g, S, E, F.tid);
        }
        if (L0()) { REFRESH(); __syncthreads();
          pg8::Gemm g{F.HX, wup_t(p, l), MT, NUP, D, D}; CtxOrder S; S.init(NUP, (int)blockIdx.x, 128);
          EpiUpCtx E{F.ACT, p->ffn_cw + (size_t)l * 3 * DFF, p->ffn_cb + (size_t)l * DFF, (LAS float*)(F.lds + RING_BYTES + 1024)};
          pg8::gemm_phase<EpiUpCtx, CtxOrder, true, false>(F.lds, g, S, E, F.tid); }
#endif
        GSYNC();
#ifndef NO_P9
        REFRESH();
        if (L0()) { pg8::Gemm g{F.ACT, wdn_t(p, l), MT, D, 256, DFF}; SplitOrder S; S.init(11, F.G, (int)blockIdx.x);
          EpiPartial E{(float*)(p->ws + WS_PART)};
          pg8::gemm_phase<EpiPartial, SplitOrder, false, false>(F.lds, g, S, E, F.tid); __syncthreads(); }
        REFRESH();
        { pg8::Gemm g{F.ACT, wdn_t(p, l), ML, D, DFF, DFF}; pg8::StaticOrder S; S.init(ML, D, F.G, (int)blockIdx.x);
          if (L0()) { EpiRes<true, true> E{p->out, p->out, F.MOD + l * 3 * 6144 + 5120}; pg8::gemm_phase<EpiRes<true, true>, pg8::StaticOrder, true, true>(F.lds, g, S, E, F.tid); }
          else if (F.G == 256) { EpiFinal E{(const bf16*)(p->ws + WS_XB2), p->out, F.MOD + l * 3 * 6144 + 5120, p->final_g, (float*)(p->ws + WS_SLOT), (unsigned*)(p->ws + WS_CTL) + CW_FIN};
            pg8::gemm_phase<EpiFinal, pg8::StaticOrder, false, true>(F.lds, g, S, E, F.tid); }
          else { EpiRes<true, false> E{p->out, p->ws + WS_HX, F.MOD + l * 3 * 6144 + 5120}; pg8::gemm_phase<EpiRes<true, false>, pg8::StaticOrder, true, true>(F.lds, g, S, E, F.tid); } }
#endif
        if (L0() || F.G != 256) GSYNC();
    }
        REFRESH();
    if (F.G != 256) final_norm(p, F);
}

extern "C" void kernel_launch(void* const* d_in, const int* in_sizes, int n_in, void* d_out, int out_size, void* d_ws, size_t ws_size, hipStream_t stream) {
    static int grid = 0;
    if (grid == 0) {
        if (n_in != 23 || in_sizes[0] != ML * D || out_size != ML * D || ws_size < WS_END) { fprintf(stderr, "kernel_launch: unexpected shapes / workspace (%d inputs, ws %zu)\n", n_in, ws_size); grid = -1; return; }
        int dev = 0, cus = 0, per_cu = 0;
        hipGetDevice(&dev); hipDeviceGetAttribute(&cus, hipDeviceAttributeMultiprocessorCount, dev);
        if (hipFuncSetAttribute((const void*)fwd_megakernel, hipFuncAttributeMaxDynamicSharedMemorySize, LDS_BYTES) != hipSuccess) { fprintf(stderr, "hipFuncSetAttribute failed\n"); grid = -1; return; }
        if (hipOccupancyMaxActiveBlocksPerMultiprocessor(&per_cu, (const void*)fwd_megakernel, 512, LDS_BYTES) != hipSuccess || per_cu < 1) per_cu = 1;
        (void)hipGetLastError();
        grid = cus * 1;
    }
    if (grid < 0) return;
    if (hipMemsetAsync((char*)d_ws + WS_CTL, 0, 65536, stream) != hipSuccess) { fprintf(stderr, "memset failed\n"); return; }
    Params p{};
    const float** pp = (const float**)&p;
    for (int i = 0; i < 23; ++i) pp[i] = (const float*)d_in[i];
    p.out = (float*)d_out; p.ws = (unsigned char*)d_ws;
    void* args[] = {&p};
    hipError_t e = hipLaunchCooperativeKernel((const void*)fwd_megakernel, dim3(grid), dim3(512), args, LDS_BYTES, stream);
    if (e != hipSuccess) fprintf(stderr, "cooperative launch failed: %s (grid %d)\n", hipGetErrorString(e), grid);
}
```

```cpp
#include <hip/hip_runtime.h>
#include <hip/hip_cooperative_groups.h>
#include <cstdio>
#include <cstdint>
namespace cg = cooperative_groups;
namespace pg8 {
#define PG8_LAS __attribute__((address_space(3)))
typedef unsigned short bf16_t;
typedef short bf16x8 __attribute__((ext_vector_type(8)));
typedef float f32x4 __attribute__((ext_vector_type(4)));
typedef unsigned u32x4 __attribute__((ext_vector_type(4)));
constexpr int BM = 256, BK = 64, HALF = 128, HTB = HALF * BK * 2  , STAGE_BYTES = 8 * HTB, NXCD = 8, WGM = 8;

__host__ __device__ __forceinline__ int lds_byte(int r, int c) { const int st = (r >> 4) * 2 + (c >> 5), rr = r & 15, cc = c & 31, ob = rr * 64 + cc * 2; return st * 1024 + (ob ^ (((ob >> 9) & 1) << 5)); }
__host__ __device__ __forceinline__ void stage_rc(int b, int& R, int& C) { const int st = b / 1024, sb = b % 1024, swz = sb ^ (((sb >> 9) & 1) << 5); R = (st >> 1) * 16 + swz / 64; C = (st & 1) * 32 + (swz % 64) / 2; }
__host__ __device__ __forceinline__ int perm32(int rho) { const int n = rho >> 4, i = rho & 15; return 8 * (i >> 2) + 4 * n + (i & 3); }

struct Unit { int pm, pn, ks; };
struct Gemm { const bf16_t* A; const bf16_t* Bt; int M, N, K, ld; };

struct StaticOrder {
    int nM, nN, nwg, G, c;
    __host__ __device__ void init(int M, int N, int G_, int c_) { nM = M / BM; nN = N / BM; nwg = nM * nN; G = G_; c = c_; }
    __host__ __device__ bool next(int i, Unit& u) const {
        const long L = (long)i * G + c; if (L >= nwg) return false;
        int wgid = (int)L; { const int q = nwg / NXCD, r = nwg % NXCD, xcd = wgid % NXCD, off = wgid / NXCD; wgid = (xcd < r ? xcd * (q + 1) : r * (q + 1) + (xcd - r) * q) + off; }
        const int nig = WGM * nN, gid = wgid / nig, fm = gid * WGM, gsz = (nM - fm) < WGM ? (nM - fm) : WGM;
        u.pm = fm + ((wgid % nig) % gsz); u.pn = (wgid % nig) / gsz; u.ks = 0; return true;
    }
    __device__ __forceinline__ void a_ready(const Unit&) const {}
    __device__ __forceinline__ void done(const Unit&) const {}
};

__device__ __forceinline__ unsigned cvt_pk_bf16(float lo, float hi) { unsigned r; asm volatile("v_cvt_pk_bf16_f32 %0, %1, %2" : "=v"(r) : "v"(lo), "v"(hi)); return r; }
template <class Epi, class Sched, bool ALIGN_EPI = false, bool SP2 = false>
__device__ __forceinline__ void gemm_phase(PG8_LAS unsigned char* lds, const Gemm g, const Sched& S, const Epi& E, int tid_in) {
    int tid_ = tid_in; asm volatile("" : "+v"(tid_)); const int tid = tid_, wid = __builtin_amdgcn_readfirstlane(tid >> 6), lane = tid & 63, wr = wid >> 2, wc = wid & 3, fr = lane & 15, fq = lane >> 4;
    const int K = g.ld, nt = g.K / BK; const size_t sstep = (size_t)g.K * 2;
    unsigned voffA[2], voffB[2];
#pragma unroll
    for (int i = 0; i < 2; ++i) { int R, C; stage_rc(tid * 16 + i * 8192, R, C); const int Rb = Epi::PERM ? ((R & ~31) + perm32(R & 31)) : R;
        voffA[i] = (unsigned)(R * K + C) * 2u; voffB[i] = (unsigned)(Rb * K + C) * 2u; }
    const size_t kstep = (size_t)(BK * 2);
    const size_t hstep = (size_t)HALF * K * 2;
    const size_t tstep = 2 * hstep;
    const unsigned ldsw = (unsigned)wid * 1024u;
    const int aoff = lds_byte(wr * 64 + fr, fq * 8), boff = lds_byte(wc * 32 + fr, fq * 8);
#define PG8_SA(b, h) (((b) * 2 + (h)) * HTB)
#define PG8_SB(b, h) ((4 + (b) * 2 + (h)) * HTB)
#define PG8_STAGE(bufoff, gbase, voff) do { _Pragma("unroll") for (int _i = 0; _i < 2; ++_i) \
        __builtin_amdgcn_global_load_lds((const unsigned*)((const char*)(gbase) + (voff)[_i]), (PG8_LAS unsigned*)(lds + (bufoff) + ldsw + _i * 8192), 16, 0, 0); } while (0)
#define PG8_LDA(dst, b, h) do { _Pragma("unroll") for (int m = 0; m < 4; ++m) _Pragma("unroll") for (int k = 0; k < 2; ++k) dst[m][k] = *(const PG8_LAS bf16x8*)(lds + PG8_SA(b, h) + aoff + m * 2048 + k * 1024); } while (0)
#define PG8_LDB(dst, b, h) do { _Pragma("unroll") for (int n = 0; n < 2; ++n) _Pragma("unroll") for (int k = 0; k < 2; ++k) dst[n][k] = *(const PG8_LAS bf16x8*)(lds + PG8_SB(b, h) + boff + n * 2048 + k * 1024); } while (0)
#define PG8_MMA(ai, bj, At, Bt) do { __builtin_amdgcn_s_setprio(1); _Pragma("unroll") for (int m = 0; m < 4; ++m) _Pragma("unroll") for (int n = 0; n < 2; ++n) _Pragma("unroll") for (int k = 0; k < 2; ++k) \
        acc[ai][bj][m][n] = __builtin_amdgcn_mfma_f32_16x16x32_bf16(Bt[n][k], At[m][k], acc[ai][bj][m][n], 0, 0, 0); __builtin_amdgcn_s_setprio(0); } while (0)
#define PG8_WAIT_V(n) asm volatile("s_waitcnt vmcnt(" #n ")" ::: "memory")
#define PG8_WAIT_L(n) asm volatile("s_waitcnt lgkmcnt(" #n ")" ::: "memory")
#define PG8_BAR __builtin_amdgcn_s_barrier()
#define PG8_SCHED __builtin_amdgcn_sched_barrier(0)
    Unit cur, nxt; int ui = 0;
    if (!S.next(0, cur)) return;
    f32x4 acc[2][2][4][2];
#pragma unroll
    for (int a = 0; a < 2; ++a)
#pragma unroll
        for (int b = 0; b < 2; ++b)
#pragma unroll
            for (int m = 0; m < 4; ++m)
#pragma unroll
                for (int n = 0; n < 2; ++n) acc[a][b][m][n] = (f32x4){0.f, 0.f, 0.f, 0.f};
    bf16x8 At[4][2], B0[2][2], B1[2][2];
    const char* cA = (const char*)g.A + (size_t)cur.pm * tstep + (size_t)cur.ks * sstep; const char* cB = (const char*)g.Bt + (size_t)cur.pn * tstep + (size_t)cur.ks * sstep;
    S.a_ready(cur);
    if constexpr (SP2) {
        PG8_STAGE(PG8_SB(0, 0), cB, voffB); PG8_STAGE(PG8_SB(0, 1), cB + hstep, voffB); PG8_STAGE(PG8_SA(0, 0), cA, voffA); PG8_STAGE(PG8_SA(0, 1), cA + hstep, voffA);
        if (wr == 1) PG8_BAR;
        PG8_WAIT_V(2); PG8_BAR;
        PG8_STAGE(PG8_SB(1, 0), cB + kstep, voffB); PG8_STAGE(PG8_SA(1, 0), cA + kstep, voffA); PG8_STAGE(PG8_SB(1, 1), cB + hstep + kstep, voffB);
        PG8_WAIT_V(6); PG8_BAR;
    } else {
        PG8_STAGE(PG8_SB(0, 0), cB, voffB); PG8_STAGE(PG8_SA(0, 0), cA, voffA); PG8_STAGE(PG8_SB(0, 1), cB + hstep, voffB); PG8_STAGE(PG8_SA(0, 1), cA + hstep, voffA);
        if (wr == 1) PG8_BAR;
        PG8_WAIT_V(4); PG8_BAR;
        PG8_STAGE(PG8_SB(1, 0), cB + kstep, voffB); PG8_STAGE(PG8_SA(1, 0), cA + kstep, voffA); PG8_STAGE(PG8_SB(1, 1), cB + hstep + kstep, voffB);
        PG8_WAIT_V(6); PG8_BAR;
    }
    for (;;) {
        const bool has_next = S.next(ui + 1, nxt);
        const char* nA = has_next ? (const char*)g.A + (size_t)nxt.pm * tstep + (size_t)nxt.ks * sstep : cA; const char* nB = has_next ? (const char*)g.Bt + (size_t)nxt.pn * tstep + (size_t)nxt.ks * sstep : cB;
        for (int t = 0; t < nt; t += 2) {
            const bool last = (t == nt - 2);
            const char* a1 = cA + (size_t)(t + 1) * kstep;
            const char* a2 = last ? nA : cA + (size_t)(t + 2) * kstep; const char* b2 = last ? nB : cB + (size_t)(t + 2) * kstep;
            const char* a3 = a2 + kstep; const char* b3 = b2 + kstep;
            if (last && has_next) S.a_ready(nxt);
            if constexpr (SP2) {
            PG8_LDB(B0, 0, 0); PG8_LDB(B1, 0, 1); PG8_SCHED; PG8_LDA(At, 0, 0); PG8_STAGE(PG8_SA(1, 1), a1 + hstep, voffA);
            PG8_WAIT_V(8); PG8_WAIT_L(0); PG8_BAR; PG8_MMA(0, 0, At, B0); PG8_MMA(0, 1, At, B1); PG8_BAR; PG8_SCHED;
            PG8_LDA(At, 0, 1); PG8_STAGE(PG8_SB(0, 0), b2, voffB); PG8_STAGE(PG8_SB(0, 1), b2 + hstep, voffB); PG8_STAGE(PG8_SA(0, 0), a2, voffA);
            PG8_WAIT_V(8); PG8_WAIT_L(0); PG8_BAR; PG8_MMA(1, 0, At, B0); PG8_MMA(1, 1, At, B1); PG8_BAR; PG8_SCHED;
            PG8_LDB(B0, 1, 0); PG8_LDB(B1, 1, 1); PG8_SCHED; PG8_LDA(At, 1, 0); PG8_STAGE(PG8_SA(0, 1), a2 + hstep, voffA);
            PG8_WAIT_V(8); PG8_WAIT_L(0); PG8_BAR; PG8_MMA(0, 0, At, B0); PG8_MMA(0, 1, At, B1); PG8_BAR; PG8_SCHED;
            PG8_LDA(At, 1, 1); PG8_STAGE(PG8_SB(1, 0), b3, voffB); PG8_STAGE(PG8_SB(1, 1), b3 + hstep, voffB); PG8_STAGE(PG8_SA(1, 0), a3, voffA);
            PG8_WAIT_V(8); PG8_WAIT_L(0); PG8_BAR; PG8_MMA(1, 0, At, B0); PG8_MMA(1, 1, At, B1); PG8_BAR; PG8_SCHED;
            } else {
            PG8_LDB(B0, 0, 0); PG8_SCHED; PG8_LDA(At, 0, 0); PG8_STAGE(PG8_SA(1, 1), a1 + hstep, voffA);
            PG8_WAIT_L(8); PG8_BAR; PG8_WAIT_L(0); PG8_MMA(0, 0, At, B0); PG8_BAR; PG8_SCHED;
            PG8_LDB(B1, 0, 1); PG8_STAGE(PG8_SB(0, 0), b2, voffB);
            PG8_BAR; PG8_WAIT_L(0); PG8_MMA(0, 1, At, B1); PG8_BAR;
            PG8_LDA(At, 0, 1); PG8_STAGE(PG8_SA(0, 0), a2, voffA);
            PG8_BAR; PG8_WAIT_L(0); PG8_MMA(1, 0, At, B0); PG8_BAR; PG8_SCHED;
            PG8_STAGE(PG8_SB(0, 1), b2 + hstep, voffB);
            PG8_WAIT_V(6); PG8_BAR; PG8_MMA(1, 1, At, B1); PG8_BAR;
            PG8_LDB(B0, 1, 0); PG8_SCHED; PG8_LDA(At, 1, 0); PG8_STAGE(PG8_SA(0, 1), a2 + hstep, voffA);
            PG8_WAIT_L(8); PG8_BAR; PG8_WAIT_L(0); PG8_MMA(0, 0, At, B0); PG8_BAR; PG8_SCHED;
            PG8_LDB(B1, 1, 1); PG8_STAGE(PG8_SB(1, 0), b3, voffB);
            PG8_BAR; PG8_WAIT_L(0); PG8_MMA(0, 1, At, B1); PG8_BAR;
            PG8_LDA(At, 1, 1); PG8_STAGE(PG8_SA(1, 0), a3, voffA);
            PG8_BAR; PG8_WAIT_L(0); PG8_MMA(1, 0, At, B0); PG8_BAR; PG8_SCHED;
            PG8_STAGE(PG8_SB(1, 1), b3 + hstep, voffB);
            PG8_WAIT_V(6); PG8_BAR; PG8_MMA(1, 1, At, B1); PG8_BAR;
            }
        }
        if constexpr (ALIGN_EPI) { if (wr == 0) PG8_BAR; }
        if constexpr (!Epi::AFTER_DRAIN) { E(acc, cur, wr, wc, fr, fq); S.done(cur); }
        if (!has_next) break;
#pragma unroll
        for (int a = 0; a < 2; ++a)
#pragma unroll
            for (int b = 0; b < 2; ++b)
#pragma unroll
                for (int m = 0; m < 4; ++m)
#pragma unroll
                    for (int n = 0; n < 2; ++n) acc[a][b][m][n] = (f32x4){0.f, 0.f, 0.f, 0.f};
        cur = nxt; cA = nA; cB = nB; ++ui;
        if constexpr (ALIGN_EPI) { if (wr == 1) PG8_BAR; }
    }
    PG8_WAIT_V(0);
    if constexpr (!ALIGN_EPI) { if (wr == 0) PG8_BAR; }
    PG8_BAR;
    if constexpr (Epi::AFTER_DRAIN) { E.fused(acc, cur, wr, wc, fr, fq, lds, wid, lane); S.done(cur); }
#undef PG8_SA
#undef PG8_SB
#undef PG8_STAGE
#undef PG8_LDA
#undef PG8_LDB
#undef PG8_MMA
#undef PG8_WAIT_V
#undef PG8_WAIT_L
#undef PG8_BAR
#undef PG8_SCHED
}
}
#define LAS __attribute__((address_space(3)))
typedef unsigned short bf16;
typedef float f32x4 __attribute__((ext_vector_type(4)));
typedef short bf16x8 __attribute__((ext_vector_type(8)));
typedef unsigned u32x4 __attribute__((ext_vector_type(4)));
typedef unsigned u32x2 __attribute__((ext_vector_type(2)));
#define LDS_WAIT() asm volatile("s_waitcnt lgkmcnt(0)" ::: "memory")

constexpr int D = 1024, SEQ = 8192, ML = 16384, MC = 512, MT = ML + MC, CTXL = 256;
constexpr int DIN = 2080, NP = 2560, DFF = 2816, NUP = 5632;
constexpr int PK = 0, PQ = 128, PV = 256, PLA = 512, PG = 768, PFA = 1024, PFB = 1280, PH = 1536, PBG = 1792, PCG = 2048, PPOOL = 2304;
constexpr int NCH = 132;
constexpr float EPS = 1e-6f;
constexpr size_t MiB = 1u << 20;
constexpr size_t WS_CTL = 0;
constexpr size_t WS_MOD = 1 * MiB;
constexpr size_t WS_MCS = 1 * MiB + 256 * 1024;
constexpr size_t WS_F1 = 1 * MiB + 512 * 1024;
constexpr size_t WS_F2 = WS_F1 + 32 * 1024;
constexpr size_t WS_FC = WS_F2 + 64 * 1024;
constexpr size_t WS_SLOT = 49 * MiB;
constexpr size_t WS_XB2 = 208 * MiB;
constexpr int CW_FIN = 3584;
constexpr size_t WS_W = 2 * MiB;
constexpr size_t W_IN_B = (size_t)NP * D * 2, W_OUT_B = (size_t)D * D * 2, W_UP_B = (size_t)NUP * D * 2, W_DN_B = (size_t)D * DFF * 2;
constexpr size_t W_LAYER_B = W_IN_B + W_OUT_B + W_UP_B + W_DN_B;
constexpr size_t WS_HX = 50 * MiB;
constexpr size_t WS_YMIX = 83 * MiB;
constexpr size_t WS_P = 116 * MiB;
constexpr size_t WS_XC = 207 * MiB;
constexpr size_t WS_ST = 209 * MiB;
constexpr size_t WS_DEC = 226 * MiB;
constexpr size_t WS_CAU = 227 * MiB;
constexpr size_t WS_PART = 233 * MiB;
constexpr size_t WS_END = 255 * MiB;
static_assert(WS_W + 2 * W_LAYER_B <= WS_HX, "weights");
static_assert(WS_P + (size_t)MT * DFF * 2 <= WS_XC, "act");
constexpr int RING_BYTES = 131072, LDS_BYTES = 147456;

struct Params {
    const float *x, *c, *ctx, *c_ctx, *norm1_g, *norm2_g, *w_mod, *b_mod, *w_in, *w_a2, *b_a2, *gla_g, *fft_w, *conv_w, *conv_b, *pool_w,
        *pool_scale, *w_out, *w_up, *ffn_cw, *ffn_cb, *w_down, *final_g;
    float* out; unsigned char* ws;
};

typedef const __attribute__((address_space(4))) Params* PP;
__device__ __forceinline__ unsigned f2bf(float f) { unsigned u = __builtin_bit_cast(unsigned, f); return (u + 0x7fffu + ((u >> 16) & 1u)) >> 16; }
__device__ __forceinline__ unsigned pk2(float lo, float hi) { return f2bf(lo) | (f2bf(hi) << 16); }
__device__ __forceinline__ float bf2f(unsigned h) { return __builtin_bit_cast(float, h << 16); }
__device__ __forceinline__ float bflo(unsigned w) { return __builtin_bit_cast(float, w << 16); }
__device__ __forceinline__ float bfhi(unsigned w) { return __builtin_bit_cast(float, w & 0xffff0000u); }
__device__ __forceinline__ float shfl_f(float v, int src_lane) { return __builtin_bit_cast(float, __builtin_amdgcn_ds_bpermute(src_lane << 2, __builtin_bit_cast(int, v))); }
__device__ __forceinline__ float wave_sum(float v, int lane) {
#pragma unroll
    for (int o = 1; o < 64; o <<= 1) v += shfl_f(v, lane ^ o);
    return v;
}
__device__ __forceinline__ float silu_f(float x) { return x * __builtin_amdgcn_rcpf(1.f + __expf(-x)); }
__device__ __forceinline__ float cos_rev(float r) { return __builtin_amdgcn_cosf(r); }
__device__ __forceinline__ float sin_rev(float r) { return __builtin_amdgcn_sinf(r); }
__device__ __forceinline__ bf16x8 pack8(float a0, float a1, float a2, float a3, float a4, float a5, float a6, float a7) {
    u32x4 w; w.x = pk2(a0, a1); w.y = pk2(a2, a3); w.z = pk2(a4, a5); w.w = pk2(a6, a7); return __builtin_bit_cast(bf16x8, w);
}
#define MFMA16(a, b, c) __builtin_amdgcn_mfma_f32_16x16x32_bf16(a, b, c, 0, 0, 0)

struct EpiP {
    static constexpr bool PERM = true, AFTER_DRAIN = false;
    bf16* O; const float* ba2;
    __device__ __forceinline__ void operator()(const pg8::f32x4 (&acc)[2][2][4][2], const pg8::Unit& u, int wr, int wc, int fr, int fq) const {
        const int row0 = u.pm * 256 + wr * 64 + fr, col0 = u.pn * 256 + wc * 32 + 8 * fq;
        const __amdgpu_buffer_rsrc_t prs = __builtin_amdgcn_make_buffer_rsrc(O, 0, MT * NP * 2, 0x00020000);
        const bool la = (u.pn == 2);
#pragma unroll
        for (int ai = 0; ai < 2; ++ai)
#pragma unroll
            for (int m = 0; m < 4; ++m) { bf16* rowp = O + (size_t)(row0 + ai * 128 + m * 16) * NP + col0;
#pragma unroll
                for (int bj = 0; bj < 2; ++bj) { pg8::f32x4 v0 = acc[ai][bj][m][0], v1 = acc[ai][bj][m][1];
                    if (la) { const float* bp = ba2 + (col0 + bj * 128 - PLA); const f32x4 b0 = *(const f32x4*)bp, b1 = *(const f32x4*)(bp + 4);
#pragma unroll
                        for (int e = 0; e < 4; ++e) { float xa = v0[e] + b0[e], xb = v1[e] + b1[e];
                            v0[e] = (fminf(xa, 0.f) - __logf(1.f + __expf(-fabsf(xa)))) * 0.0625f; v1[e] = (fminf(xb, 0.f) - __logf(1.f + __expf(-fabsf(xb)))) * 0.0625f; } }
                    u32x4 w; w.x = pg8::cvt_pk_bf16(v0[0], v0[1]); w.y = pg8::cvt_pk_bf16(v0[2], v0[3]); w.z = pg8::cvt_pk_bf16(v1[0], v1[1]); w.w = pg8::cvt_pk_bf16(v1[2], v1[3]);
                    __builtin_amdgcn_raw_buffer_store_b128(w, prs, (unsigned)(((row0 + ai * 128 + m * 16) * NP + col0 + bj * 128) * 2), 0, 16); } }
    }
};
template <bool INB, bool OUTB>
struct EpiRes {
    static constexpr bool PERM = true, AFTER_DRAIN = false;
    const void* xin; void* out; const float* modg;
    __device__ __forceinline__ void operator()(const pg8::f32x4 (&acc)[2][2][4][2], const pg8::Unit& u, int wr, int wc, int fr, int fq) const {
        const int w = u.pm >> 5; const int cb = u.pn * 256 + wc * 32 + 8 * fq;
        f32x4 gv[2][2];
#pragma unroll
        for (int bj = 0; bj < 2; ++bj)
#pragma unroll
            for (int n = 0; n < 2; ++n) gv[bj][n] = *(const f32x4*)(modg + w * 6144 + cb + bj * 128 + 4 * n);
        constexpr int RG = INB ? 4 : 2;
#pragma unroll
        for (int ai = 0; ai < 2; ++ai)
#pragma unroll
            for (int mp = 0; mp < 4 / RG; ++mp) {
                u32x4 xb[RG][2]; f32x4 xf[INB ? 1 : RG][2][2];
#pragma unroll
                for (int mm = 0; mm < RG; ++mm) { const size_t ro = (size_t)(u.pm * 256 + ai * 128 + wr * 64 + (RG * mp + mm) * 16 + fr) * D + cb;
#pragma unroll
                    for (int bj = 0; bj < 2; ++bj) {
                        if (INB) xb[mm][bj] = *(const u32x4*)((const bf16*)xin + ro + bj * 128);
                        else { xf[INB ? 0 : mm][bj][0] = __builtin_nontemporal_load((const f32x4*)((const float*)xin + ro + bj * 128)); xf[INB ? 0 : mm][bj][1] = __builtin_nontemporal_load((const f32x4*)((const float*)xin + ro + bj * 128 + 4)); } } }
#pragma unroll
                for (int mm = 0; mm < RG; ++mm) { const int m = RG * mp + mm; const size_t ro = (size_t)(u.pm * 256 + ai * 128 + wr * 64 + m * 16 + fr) * D + cb;
#pragma unroll
                    for (int bj = 0; bj < 2; ++bj) { f32x4 x0, x1;
                        if (INB) { const u32x4 t = xb[mm][bj]; x0 = (f32x4){bflo(t.x), bfhi(t.x), bflo(t.y), bfhi(t.y)}; x1 = (f32x4){bflo(t.z), bfhi(t.z), bflo(t.w), bfhi(t.w)}; }
                        else { x0 = xf[INB ? 0 : mm][bj][0]; x1 = xf[INB ? 0 : mm][bj][1]; }
                        const pg8::f32x4 a0 = acc[ai][bj][m][0], a1 = acc[ai][bj][m][1]; const f32x4 g0 = gv[bj][0], g1 = gv[bj][1];
                        f32x4 y0, y1;
#pragma unroll
                        for (int e = 0; e < 4; ++e) { y0[e] = x0[e] + g0[e] * a0[e]; y1[e] = x1[e] + g1[e] * a1[e]; }
                        if (OUTB) { u32x4 pk; pk.x = pg8::cvt_pk_bf16(y0[0], y0[1]); pk.y = pg8::cvt_pk_bf16(y0[2], y0[3]); pk.z = pg8::cvt_pk_bf16(y1[0], y1[1]); pk.w = pg8::cvt_pk_bf16(y1[2], y1[3]);
                            *(u32x4*)((bf16*)out + ro + bj * 128) = pk; }
                        else { *(f32x4*)((float*)out + ro + bj * 128) = y0; *(f32x4*)((float*)out + ro + bj * 128 + 4) = y1; } } }
            }
    }
};
template <bool STORE_X>
__device__ __forceinline__ void panel_rms(pg8::f32x4 (&acc)[2][2][4][2], const pg8::Unit& u, int wr, int wc, int fr, int fq, LAS unsigned char* lds, int wid, int lane,
                                          const bf16* xin, bf16* xout, const float* modg, float* slots, unsigned* cnt) {
    const int w = u.pm >> 5; const int cb = u.pn * 256 + wc * 32 + 8 * fq;
    LAS float* P = (LAS float*)lds;
    LAS float* S = (LAS float*)(lds + 4096);
    f32x4 gv[2][2];
#pragma unroll
    for (int bj = 0; bj < 2; ++bj)
#pragma unroll
        for (int n = 0; n < 2; ++n) gv[bj][n] = *(const f32x4*)(modg + w * 6144 + cb + bj * 128 + 4 * n);
#pragma unroll
    for (int ai = 0; ai < 2; ++ai) {
        u32x4 xb[4][2];
#pragma unroll
        for (int m = 0; m < 4; ++m) { const size_t ro = (size_t)(u.pm * 256 + ai * 128 + wr * 64 + m * 16 + fr) * D + cb;
#pragma unroll
            for (int bj = 0; bj < 2; ++bj) xb[m][bj] = *(const u32x4*)(xin + ro + bj * 128); }
#pragma unroll
        for (int m = 0; m < 4; ++m) { float sq = 0.f; const size_t ro = (size_t)(u.pm * 256 + ai * 128 + wr * 64 + m * 16 + fr) * D + cb;
#pragma unroll
            for (int bj = 0; bj < 2; ++bj) { const u32x4 t = xb[m][bj]; const f32x4 g0 = gv[bj][0], g1 = gv[bj][1]; pg8::f32x4 a0 = acc[ai][bj][m][0], a1 = acc[ai][bj][m][1];
                a0[0] = bflo(t.x) + g0[0] * a0[0]; a0[1] = bfhi(t.x) + g0[1] * a0[1]; a0[2] = bflo(t.y) + g0[2] * a0[2]; a0[3] = bfhi(t.y) + g0[3] * a0[3];
                a1[0] = bflo(t.z) + g1[0] * a1[0]; a1[1] = bfhi(t.z) + g1[1] * a1[1]; a1[2] = bflo(t.w) + g1[2] * a1[2]; a1[3] = bfhi(t.w) + g1[3] * a1[3];
                acc[ai][bj][m][0] = a0; acc[ai][bj][m][1] = a1;
                sq += ((a0[0] * a0[0] + a0[1] * a0[1]) + (a0[2] * a0[2] + a0[3] * a0[3])) + ((a1[0] * a1[0] + a1[1] * a1[1]) + (a1[2] * a1[2] + a1[3] * a1[3]));
                if (STORE_X) { u32x4 pk; pk.x = pg8::cvt_pk_bf16(a0[0], a0[1]); pk.y = pg8::cvt_pk_bf16(a0[2], a0[3]); pk.z = pg8::cvt_pk_bf16(a1[0], a1[1]); pk.w = pg8::cvt_pk_bf16(a1[2], a1[3]);
                    *(u32x4*)(xout + ro + bj * 128) = pk; } }
            sq += shfl_f(sq, lane ^ 16); sq += shfl_f(sq, lane ^ 32);
            if (fq == 0) P[(ai * 128 + wr * 64 + m * 16 + fr) * 4 + wc] = sq; }
    }
    asm volatile("s_waitcnt lgkmcnt(0)" ::: "memory"); __builtin_amdgcn_s_barrier(); asm volatile("" ::: "memory");
    const int row = wid * 32 + (lane & 31);
    if (lane < 32) { const float t = (P[row * 4 + 0] + P[row * 4 + 1]) + (P[row * 4 + 2] + P[row * 4 + 3]);
        __hip_atomic_store(slots + ((size_t)(u.pm * 256 + row) * 4 + u.pn), t, __ATOMIC_RELAXED, __HIP_MEMORY_SCOPE_AGENT); }
    asm volatile("s_waitcnt vmcnt(0)" ::: "memory");
    if (lane == 0) (void)__hip_atomic_fetch_add(cnt + 64 * u.pm, 1u, __ATOMIC_RELAXED, __HIP_MEMORY_SCOPE_AGENT);
    if (wid == 0) { unsigned sp = 0;
        while ((unsigned)__builtin_amdgcn_readfirstlane((int)__hip_atomic_load(cnt + 64 * u.pm, __ATOMIC_RELAXED, __HIP_MEMORY_SCOPE_AGENT)) < 32u) { __builtin_amdgcn_s_sleep(2); if (++sp > (1u << 22)) break; }
        __builtin_amdgcn_fence(__ATOMIC_ACQUIRE, "agent"); }
    asm volatile("s_waitcnt vmcnt(0) lgkmcnt(0)" ::: "memory"); __builtin_amdgcn_s_barrier(); asm volatile("" ::: "memory");
    if (lane < 32) { const float* sl = slots + (size_t)(u.pm * 256 + row) * 4; float t = 0.f;
#pragma unroll
        for (int q = 0; q < 4; ++q) t += __hip_atomic_load(sl + q, __ATOMIC_RELAXED, __HIP_MEMORY_SCOPE_AGENT);
        S[row] = 1.f / sqrtf(t * (1.f / D) + EPS); }
    asm volatile("s_waitcnt vmcnt(0) lgkmcnt(0)" ::: "memory"); __builtin_amdgcn_s_barrier(); asm volatile("" ::: "memory");
}
struct EpiFinal {
    static constexpr bool PERM = true, AFTER_DRAIN = true;
    const bf16* xin; float* out; const float* modg; const float* gfin; float* slots; unsigned* cnt;
    __device__ __forceinline__ void fused(pg8::f32x4 (&acc)[2][2][4][2], const pg8::Unit& u, int wr, int wc, int fr, int fq, LAS unsigned char* lds, int wid, int lane) const {
        panel_rms<false>(acc, u, wr, wc, fr, fq, lds, wid, lane, xin, nullptr, modg, slots, cnt);
        const LAS float* S = (const LAS float*)(lds + 4096); const int cb = u.pn * 256 + wc * 32 + 8 * fq;
        f32x4 gf[2][2];
#pragma unroll
        for (int bj = 0; bj < 2; ++bj)
#pragma unroll
            for (int n = 0; n < 2; ++n) gf[bj][n] = *(const f32x4*)(gfin + cb + bj * 128 + 4 * n);
#pragma unroll
        for (int ai = 0; ai < 2; ++ai)
#pragma unroll
            for (int m = 0; m < 4; ++m) { const int r = ai * 128 + wr * 64 + m * 16 + fr; const float rs = S[r]; float* o = out + (size_t)(u.pm * 256 + r) * D + cb;
#pragma unroll
                for (int bj = 0; bj < 2; ++bj)
#pragma unroll
                    for (int n = 0; n < 2; ++n) { const pg8::f32x4 a = acc[ai][bj][m][n]; const f32x4 g4 = gf[bj][n];
                        *(f32x4*)(o + bj * 128 + 4 * n) = (f32x4){a[0] * rs * g4[0], a[1] * rs * g4[1], a[2] * rs * g4[2], a[3] * rs * g4[3]}; } }
    }
};
struct EpiResNorm {
    static constexpr bool PERM = true, AFTER_DRAIN = true;
    const bf16* xin; bf16* xout; bf16* hout; const float* modg; const float* gn; const float* modn; float* slots; unsigned* cnt;
    __device__ __forceinline__ void fused(pg8::f32x4 (&acc)[2][2][4][2], const pg8::Unit& u, int wr, int wc, int fr, int fq, LAS unsigned char* lds, int wid, int lane) const {
        panel_rms<true>(acc, u, wr, wc, fr, fq, lds, wid, lane, xin, xout, modg, slots, cnt);
        const LAS float* S = (const LAS float*)(lds + 4096); const int w = u.pm >> 5; const int cb = u.pn * 256 + wc * 32 + 8 * fq;
        f32x4 gm[2][2], shv[2][2];
#pragma unroll
        for (int bj = 0; bj < 2; ++bj)
#pragma unroll
            for (int n = 0; n < 2; ++n) { const int c = cb + bj * 128 + 4 * n; const f32x4 g4 = *(const f32x4*)(gn + c), s4 = *(const f32x4*)(modn + w * 6144 + 4096 + c);
                shv[bj][n] = *(const f32x4*)(modn + w * 6144 + 3072 + c); gm[bj][n] = (f32x4){g4[0] * (1.f + s4[0]), g4[1] * (1.f + s4[1]), g4[2] * (1.f + s4[2]), g4[3] * (1.f + s4[3])}; }
#pragma unroll
        for (int ai = 0; ai < 2; ++ai)
#pragma unroll
            for (int m = 0; m < 4; ++m) { const int r = ai * 128 + wr * 64 + m * 16 + fr; const float rs = S[r]; bf16* o = hout + (size_t)(u.pm * 256 + r) * D + cb;
#pragma unroll
                for (int bj = 0; bj < 2; ++bj) { const pg8::f32x4 a0 = acc[ai][bj][m][0], a1 = acc[ai][bj][m][1]; const f32x4 g0 = gm[bj][0], g1 = gm[bj][1], h0 = shv[bj][0], h1 = shv[bj][1];
                    u32x4 pk; pk.x = pg8::cvt_pk_bf16(a0[0] * rs * g0[0] + h0[0], a0[1] * rs * g0[1] + h0[1]); pk.y = pg8::cvt_pk_bf16(a0[2] * rs * g0[2] + h0[2], a0[3] * rs * g0[3] + h0[3]);
                    pk.z = pg8::cvt_pk_bf16(a1[0] * rs * g1[0] + h1[0], a1[1] * rs * g1[1] + h1[1]); pk.w = pg8::cvt_pk_bf16(a1[2] * rs * g1[2] + h1[2], a1[3] * rs * g1[3] + h1[3]);
                    *(u32x4*)(o + bj * 128) = pk; } }
    }
};
struct EpiUp {
    static constexpr bool PERM = true, AFTER_DRAIN = false;
    bf16* ACT; const float* cw; const float* cb;
    __device__ __forceinline__ void operator()(const pg8::f32x4 (&acc)[2][2][4][2], const pg8::Unit& u, int wr, int wc, int fr, int fq) const {
        const int hc0 = u.pn * 128 + wc * 32 + 8 * fq;
        const __amdgpu_buffer_rsrc_t ars = __builtin_amdgcn_make_buffer_rsrc(ACT, 0, MT * DFF * 2, 0x00020000);
#pragma unroll
        for (int ai = 0; ai < 2; ++ai) { const int blk = ai * 2 + wr;
            float res[4][8];
#pragma unroll
            for (int n = 0; n < 2; ++n) {
                const f32x4 w0 = *(const f32x4*)(cw + hc0 + 4 * n), w1 = *(const f32x4*)(cw + DFF + hc0 + 4 * n), w2 = *(const f32x4*)(cw + 2 * DFF + hc0 + 4 * n), bb = *(const f32x4*)(cb + hc0 + 4 * n);
#pragma unroll
                for (int e = 0; e < 4; ++e) {
                    float xs[4], ps[4], ns[4]; const float bprev = 0.f, bnext = 0.f;
#pragma unroll
                    for (int m = 0; m < 4; ++m) { xs[m] = acc[ai][0][m][n][e]; ps[m] = __builtin_bit_cast(float, __builtin_amdgcn_update_dpp(0, __builtin_bit_cast(int, xs[m]), 0x121, 0xf, 0xf, false)); ns[m] = __builtin_bit_cast(float, __builtin_amdgcn_update_dpp(0, __builtin_bit_cast(int, xs[m]), 0x12f, 0xf, 0xf, false)); }
#pragma unroll
                    for (int m = 0; m < 4; ++m) {
                        const float oldp = (m > 0) ? ps[m > 0 ? m - 1 : 0] : bprev, oldn = (m < 3) ? ns[m < 3 ? m + 1 : 3] : bnext;
                        const float prev = __builtin_bit_cast(float, __builtin_amdgcn_update_dpp(__builtin_bit_cast(int, oldp), __builtin_bit_cast(int, xs[m]), 0x111, 0xf, 0xf, false));
                        const float next = __builtin_bit_cast(float, __builtin_amdgcn_update_dpp(__builtin_bit_cast(int, oldn), __builtin_bit_cast(int, xs[m]), 0x101, 0xf, 0xf, false));
                        const float a = w0[e] * prev + w1[e] * xs[m] + w2[e] * next + bb[e];
                        res[m][4 * n + e] = silu_f(a) * acc[ai][1][m][n][e];
                    }
                }
            }
#pragma unroll
            for (int m = 0; m < 4; ++m) { const int r = u.pm * 256 + ai * 128 + wr * 64 + m * 16 + fr;
                u32x4 w; w.x = pg8::cvt_pk_bf16(res[m][0], res[m][1]); w.y = pg8::cvt_pk_bf16(res[m][2], res[m][3]); w.z = pg8::cvt_pk_bf16(res[m][4], res[m][5]); w.w = pg8::cvt_pk_bf16(res[m][6], res[m][7]);
                __builtin_amdgcn_raw_buffer_store_b128(w, ars, (unsigned)((r * DFF + hc0) * 2), 0, 16); }
        }
    }
};
struct EpiUpCtx {
    static constexpr bool PERM = true, AFTER_DRAIN = false;
    bf16* ACT; const float* cw; const float* cb; LAS float* ex;
    __device__ __forceinline__ void operator()(const pg8::f32x4 (&acc)[2][2][4][2], const pg8::Unit& u, int wr, int wc, int fr, int fq) const {
        const int hc0 = u.pn * 128 + wc * 32 + 8 * fq;
            const int colw = wc * 32 + 8 * fq;
#pragma unroll
            for (int ai = 0; ai < 2; ++ai) { const int blk = ai * 2 + wr;
                if (fr == 0) {
#pragma unroll
                    for (int n = 0; n < 2; ++n)
#pragma unroll
                        for (int e = 0; e < 4; ++e) ex[(blk * 2 + 0) * 128 + colw + 4 * n + e] = acc[ai][0][0][n][e]; }
                if (fr == 15) {
#pragma unroll
                    for (int n = 0; n < 2; ++n)
#pragma unroll
                        for (int e = 0; e < 4; ++e) ex[(blk * 2 + 1) * 128 + colw + 4 * n + e] = acc[ai][0][3][n][e]; } }
            asm volatile("s_waitcnt lgkmcnt(0)" ::: "memory"); __builtin_amdgcn_s_barrier(); asm volatile("" ::: "memory");
#pragma unroll
            for (int ai = 0; ai < 2; ++ai) { const int blk = ai * 2 + wr;
                float res[4][8];
    #pragma unroll
                for (int n = 0; n < 2; ++n) {
                    const f32x4 w0 = *(const f32x4*)(cw + hc0 + 4 * n), w1 = *(const f32x4*)(cw + DFF + hc0 + 4 * n), w2 = *(const f32x4*)(cw + 2 * DFF + hc0 + 4 * n), bb = *(const f32x4*)(cb + hc0 + 4 * n);
    #pragma unroll
                    for (int e = 0; e < 4; ++e) {
                        float xs[4], ps[4], ns[4]; float bprev = 0.f, bnext = 0.f; if (blk > 0) bprev = ex[((blk - 1) * 2 + 1) * 128 + colw + 4 * n + e]; if (blk < 3) bnext = ex[((blk + 1) * 2 + 0) * 128 + colw + 4 * n + e];
    #pragma unroll
                        for (int m = 0; m < 4; ++m) { xs[m] = acc[ai][0][m][n][e]; ps[m] = __builtin_bit_cast(float, __builtin_amdgcn_update_dpp(0, __builtin_bit_cast(int, xs[m]), 0x121, 0xf, 0xf, false)); ns[m] = __builtin_bit_cast(float, __builtin_amdgcn_update_dpp(0, __builtin_bit_cast(int, xs[m]), 0x12f, 0xf, 0xf, false)); }
    #pragma unroll
                        for (int m = 0; m < 4; ++m) {
                            const float prev = (fr > 0) ? ps[m] : (m > 0 ? ps[m > 0 ? m - 1 : 0] : bprev);
                            const float next = (fr < 15) ? ns[m] : (m < 3 ? ns[m < 3 ? m + 1 : 3] : bnext);
                            const float a = w0[e] * prev + w1[e] * xs[m] + w2[e] * next + bb[e];
                            res[m][4 * n + e] = silu_f(a) * acc[ai][1][m][n][e];
                        }
                    }
                }
    #pragma unroll
                for (int m = 0; m < 4; ++m) { const int r = u.pm * 256 + ai * 128 + wr * 64 + m * 16 + fr;
                    u32x4 w; w.x = pg8::cvt_pk_bf16(res[m][0], res[m][1]); w.y = pg8::cvt_pk_bf16(res[m][2], res[m][3]); w.z = pg8::cvt_pk_bf16(res[m][4], res[m][5]); w.w = pg8::cvt_pk_bf16(res[m][6], res[m][7]);
                    *(u32x4*)(ACT + (size_t)r * DFF + hc0) = w; }
            }

    }
};
struct CtxOrder {
    int nN, c, c0;
    __device__ void init(int N, int c_, int c0_) { nN = N / 256; c = c_; c0 = c0_; }
    __device__ bool next(int i, pg8::Unit& u) const { const int j = c - c0; if (i > 0 || j < 0 || j >= 2 * nN) return false; u.pm = 64 + (j & 1); u.pn = j >> 1; u.ks = 0; return true; }
    __device__ __forceinline__ void a_ready(const pg8::Unit&) const {}
    __device__ __forceinline__ void done(const pg8::Unit&) const {}
};

struct SplitOrder {
    int nunits, G, c;
    __device__ void init(int nks, int G_, int c_) { nunits = 8 * nks; G = G_; c = c_; }
    __device__ bool next(int i, pg8::Unit& u) const { const int id = i * G + c; if (id >= nunits) return false; u.pm = 64 + (id & 1); u.pn = (id >> 1) & 3; u.ks = id >> 3; return true; }
    __device__ __forceinline__ void a_ready(const pg8::Unit&) const {}
    __device__ __forceinline__ void done(const pg8::Unit&) const {}
};
struct EpiPartial {
    static constexpr bool PERM = false, AFTER_DRAIN = false;
    float* part;
    __device__ __forceinline__ void operator()(const pg8::f32x4 (&acc)[2][2][4][2], const pg8::Unit& u, int wr, int wc, int fr, int fq) const {
#pragma unroll
        for (int ai = 0; ai < 2; ++ai)
#pragma unroll
            for (int m = 0; m < 4; ++m) { const int r = u.pm * 256 + ai * 128 + wr * 64 + m * 16 + fr; float* o = part + ((size_t)u.ks * MC + (size_t)(r - ML)) * D;
#pragma unroll
                for (int bj = 0; bj < 2; ++bj)
#pragma unroll
                    for (int n = 0; n < 2; ++n) { const int c = u.pn * 256 + bj * 128 + wc * 32 + 16 * n + 4 * fq; const pg8::f32x4 a = acc[ai][bj][m][n];
                        *(f32x4*)(o + c) = (f32x4){a[0], a[1], a[2], a[3]}; } }
    }
};
typedef __attribute__((address_space(1))) unsigned gu32;
#define XB_TMO      128
#define XB_XCNT(j)  (256  + 64 * (j))
#define XB_XSUB(j)  (1280 + 64 * (j))
#define XB_XGEN(j)  (2304 + 64 * (j))
#define XB_TOP      3328
#define XB_TOPGEN   3392
#define XCD_BAR_WORDS 3456
#define XB_SPIN_CAP (1u << 18)

__device__ __forceinline__ unsigned xb_ld(unsigned* p)              { return __hip_atomic_load(p, __ATOMIC_RELAXED, __HIP_MEMORY_SCOPE_AGENT); }
__device__ __forceinline__ unsigned xb_add(unsigned* p, unsigned v) { return __hip_atomic_fetch_add(p, v, __ATOMIC_RELAXED, __HIP_MEMORY_SCOPE_AGENT); }
__device__ __forceinline__ unsigned xb_xcc_id() { return (unsigned)__builtin_amdgcn_s_getreg((3 << 11) | 20) & 0xFu; }
#define XB_SPIN(cond, bar) do { unsigned _sp = 0; while (cond) { __builtin_amdgcn_s_sleep(1); \
    if ((++_sp & 255u) == 0u) { if (xb_ld(&(bar)[XB_TMO])) break; if (_sp > XB_SPIN_CAP) { atomicAdd(&(bar)[XB_TMO], 1u); break; } } } } while (0)

struct XcdBarrier {
    unsigned* bar; unsigned x;
    volatile LAS unsigned* st;
};

__device__ __forceinline__ XcdBarrier xcd_barrier_post(unsigned* bar, volatile LAS unsigned* st, int tid_) {
    XcdBarrier b; b.bar = bar; b.x = xb_xcc_id(); b.st = st;
    if (tid_ == 0) (void)xb_add(&bar[XB_XCNT(b.x)], 1u);
    return b;
}
__device__ __forceinline__ void xcd_barrier_complete(unsigned* bar, unsigned x, unsigned& nloc, unsigned& nx) {
    const unsigned G = gridDim.x * gridDim.y * gridDim.z;
    unsigned sum, cnt, mine, sp = 0u;
    for (;;) {
        sum = 0u; cnt = 0u; mine = 0u;
#pragma unroll
        for (unsigned j = 0; j < 16; ++j) { const unsigned c = xb_ld(&bar[XB_XCNT(j)]); sum += c; cnt += (c > 0u) ? 1u : 0u; mine = (j == x) ? c : mine; }
        if (sum == G) break;
        __builtin_amdgcn_s_sleep(1);
        if ((++sp & 255u) == 0u) { if (xb_ld(&bar[XB_TMO])) break; if (sp > XB_SPIN_CAP) { atomicAdd(&bar[XB_TMO], 1u); break; } }
    }
    nloc = mine > 0u ? mine : 1u; nx = cnt > 0u ? cnt : 1u;
}

__device__ __forceinline__ void xcd_barrier(const XcdBarrier& b, int tid_) {
    asm volatile("s_waitcnt vmcnt(0)" ::: "memory");
    __syncthreads();
    if (tid_ == 0) {
        unsigned* bar = b.bar; asm volatile("" : "+s"(bar)); unsigned bx = (unsigned)__builtin_amdgcn_readfirstlane((int)b.x); asm volatile("" : "+s"(bx));
        __builtin_amdgcn_s_waitcnt(0);
        unsigned nloc = b.st[0], nx = b.st[1];
        if (nloc == 0u) { xcd_barrier_complete(bar, bx, nloc, nx); b.st[0] = nloc; b.st[1] = nx; }
        const unsigned old = xb_add(&bar[XB_XSUB(bx)], 1u);
        const unsigned gen = old / nloc;
        if (old + 1u == (gen + 1u) * nloc) {
            __builtin_amdgcn_fence(__ATOMIC_RELEASE, "agent");
            asm volatile("s_waitcnt vmcnt(0)" ::: "memory");
            const unsigned og = xb_add(&bar[XB_TOP], 1u);
            const unsigned tg = og / nx;
            if (og + 1u == (tg + 1u) * nx) xb_add(&bar[XB_TOPGEN], 1u);
            else XB_SPIN(xb_ld(&bar[XB_TOPGEN]) == tg, bar);
            __builtin_amdgcn_fence(__ATOMIC_ACQUIRE, "agent");
            xb_add(&bar[XB_XGEN(bx)], 1u);
            asm volatile("s_waitcnt vmcnt(0)" ::: "memory");
        } else {
            XB_SPIN(xb_ld(&bar[XB_XGEN(bx)]) == gen, bar);
            __builtin_amdgcn_fence(__ATOMIC_ACQUIRE, "agent");
            asm volatile("s_waitcnt vmcnt(0)" ::: "memory");
        }
    }
    __syncthreads();
}
struct Ctx {
    LAS unsigned char* lds; int tid, lane, wave, G, gw, NGW;
    float* MOD; float* MCS; bf16 *F1, *F2, *FC; bf16 *HX, *YMIX, *PB, *ACT, *TB, *CAU; float *XC, *ST, *DEC;
};
__device__ __forceinline__ bf16* win_t(PP p, int l) { return (bf16*)(p->ws + WS_W + (size_t)l * W_LAYER_B); }
__device__ __forceinline__ bf16* wout_t(PP p, int l) { return (bf16*)(p->ws + WS_W + (size_t)l * W_LAYER_B + W_IN_B); }
__device__ __forceinline__ bf16* wup_t(PP p, int l) { return (bf16*)(p->ws + WS_W + (size_t)l * W_LAYER_B + W_IN_B + W_OUT_B); }
__device__ __forceinline__ bf16* wdn_t(PP p, int l) { return (bf16*)(p->ws + WS_W + (size_t)l * W_LAYER_B + W_IN_B + W_OUT_B + W_UP_B); }

__device__ __forceinline__ void transpose_item(const float* W, int K, int N, bf16* WT, int k0, int n0, int dst0, float scale, LAS float* scr, int lane) {
#pragma unroll
    for (int i = 0; i < 32; ++i) { const int kk = 2 * i + (lane >> 5); scr[kk * 33 + (lane & 31)] = __builtin_nontemporal_load(W + (size_t)(k0 + kk) * N + n0 + (lane & 31)) * scale; }
    LDS_WAIT(); __builtin_amdgcn_wave_barrier();
    const int c = lane & 7;
#pragma unroll
    for (int j = 0; j < 4; ++j) { const int n = (lane >> 3) + 8 * j; const LAS float* s = scr + (8 * c) * 33 + n;
        u32x4 o; o.x = pk2(s[0 * 33], s[1 * 33]); o.y = pk2(s[2 * 33], s[3 * 33]); o.z = pk2(s[4 * 33], s[5 * 33]); o.w = pk2(s[6 * 33], s[7 * 33]);
        __builtin_nontemporal_store(o, (u32x4*)(WT + (size_t)(dst0 + n) * K + k0 + 8 * c)); }
    LDS_WAIT(); __builtin_amdgcn_wave_barrier();
}

__device__ __forceinline__ void phase0(PP p, Ctx& F) {
    LAS float* sv = (LAS float*)F.lds; LAS float* red = sv + 3072;
    for (int i = F.tid; i < 3072; i += 512) { const int w = i >> 10, k = i & 1023; const float cv = (w < 2) ? p->c[w * 1024 + k] : p->c_ctx[k]; sv[i] = cv / (1.f + expf(-cv)); }
    __syncthreads();
    for (int it = blockIdx.x; it < 192; it += F.G) {
        const int l = it / 96, c0 = (it % 96) * 64; const float* W = p->w_mod + (size_t)l * 1024 * 6144 + c0 + F.lane;
        float a0 = 0.f, a1 = 0.f, a2 = 0.f; const int kb = F.wave * 128;
#pragma unroll 64
        for (int k = 0; k < 128; ++k) { const float wv = __builtin_nontemporal_load(W + (size_t)(kb + k) * 6144); a0 += sv[kb + k] * wv; a1 += sv[1024 + kb + k] * wv; a2 += sv[2048 + kb + k] * wv; }
        red[(F.wave * 3 + 0) * 64 + F.lane] = a0; red[(F.wave * 3 + 1) * 64 + F.lane] = a1; red[(F.wave * 3 + 2) * 64 + F.lane] = a2;
        __syncthreads();
        if (F.tid < 192) { const int w = F.tid >> 6, ln = F.tid & 63; float s = 0.f;
#pragma unroll
            for (int q = 0; q < 8; ++q) s += red[(q * 3 + w) * 64 + ln];
            F.MOD[(l * 3 + w) * 6144 + c0 + ln] = s + p->b_mod[l * 6144 + c0 + ln]; }
        __syncthreads();
    }
    __syncthreads();
    LAS float* scr = (LAS float*)(F.lds + F.wave * 16384);
    constexpr int I_IN = 48 * 16, I_OUT = 32 * 16, I_UP = 176 * 16, I_DN = 32 * 44, I_L = I_IN + I_OUT + I_UP + I_DN;
    for (int it = F.gw; it < 2 * I_L; it += F.NGW) {
        const int l = it / I_L; int r = it % I_L;
        if (r < I_IN) { const int cb = r / 16, kb = r % 16; int src, dst; float sc = 1.f;
            if (cb < 4) { src = 32 * cb; dst = PK + 32 * cb; }
            else if (cb < 8) { src = 416 + 32 * (cb - 4); dst = PQ + 32 * (cb - 4); sc = 0.17677669529663687f; }
            else if (cb < 16) { src = 128 + 32 * (cb - 8); dst = PV + 32 * (cb - 8); }
            else if (cb < 24) { src = 544 + 32 * (cb - 16); dst = PG + 32 * (cb - 16); }
            else if (cb < 32) { src = 1056 + 32 * (cb - 24); dst = PH + 32 * (cb - 24); }
            else if (cb < 40) { src = 1312 + 32 * (cb - 32); dst = PBG + 32 * (cb - 32); }
            else { src = 1568 + 32 * (cb - 40); dst = PCG + 32 * (cb - 40); }
            transpose_item(p->w_in + (size_t)l * D * DIN, D, DIN, win_t(p, l), 64 * kb, src, dst, sc, scr, F.lane); continue; }
        r -= I_IN;
        if (r < I_OUT) { const int cb = r / 16, kb = r % 16; transpose_item(p->w_out + (size_t)l * D * D, D, D, wout_t(p, l), 64 * kb, 32 * cb, 32 * cb, 1.f, scr, F.lane); continue; }
        r -= I_OUT;
        if (r < I_UP) { const int cb = r / 16, kb = r % 16; const int c = 32 * cb, isu = (c >= DFF) ? 1 : 0, j = c - isu * DFF; const int dst = (j / 128) * 256 + isu * 128 + (j % 128);
            transpose_item(p->w_up + (size_t)l * D * NUP, D, NUP, wup_t(p, l), 64 * kb, c, dst, 1.f, scr, F.lane); continue; }
        r -= I_UP;
        { const int cb = r / 44, kb = r % 44; transpose_item(p->w_down + (size_t)l * DFF * D, DFF, D, wdn_t(p, l), 64 * kb, 32 * cb, 32 * cb, 1.f, scr, F.lane); }
    }
    const int gt = blockIdx.x * 512 + F.tid, NT = F.G * 512;
    const int gtm = (F.G == 256) ? ((int)blockIdx.x - 192) * 512 + F.tid : gt; const int NTm = (F.G == 256) ? 32768 : NT;
    for (int i = gtm; i >= 0 && i < 32768; i += NTm) { const int d = i & 63, c = (i >> 6) & 63, g = (i >> 12) & 3, l = i >> 14;
        const float* wf = p->fft_w + (size_t)((l * 4 + g) * 64) * 64 + d; float mc = 0.f, ms = 0.f;
        for (int f = 0; f < 64; ++f) { const float a = (float)((f * c) & 63) * (1.f / 64.f); const float w = wf[f * 64]; mc += cos_rev(a) * w; ms -= sin_rev(a) * w; }
        F.MCS[(((l * 4 + g) * 2 + 0) * 64 + c) * 64 + d] = mc * 0.125f; F.MCS[(((l * 4 + g) * 2 + 1) * 64 + c) * 64 + d] = ms * 0.125f; }
    for (int i = gt; i < MC * D / 4; i += NT) ((f32x4*)F.XC)[i] = ((const f32x4*)p->ctx)[i];
    for (int i = gt; i < 180224; i += NT) {
        if (i < 16384) { const int mm = i >> 7, kk = i & 127, k1 = mm & 63, n1 = kk & 63; const float a = (float)((k1 * n1) & 63) * (1.f / 64.f); const float C = cos_rev(a), S = sin_rev(a);
            const float v = (mm < 64) ? (kk < 64 ? C : S) : (kk < 64 ? -S : C); F.F1[i] = (bf16)f2bf(v); }
        else if (i < 49152) { const int j = i - 16384, k2 = j >> 8, kk = j & 255, n2 = kk & 127; const float a = (float)((k2 * n2) & 127) * (1.f / 128.f);
            const float v = (kk < 128 ? cos_rev(a) : sin_rev(a)) * 0.011048543456039806f; F.F2[j] = (bf16)f2bf(v); }
        else { const int j = i - 49152, k = j >> 9, kk = j & 511, n = kk & 255; const float a = (float)((k * n) & 255) * (1.f / 256.f);
            const float v = (kk < 256 ? cos_rev(a) : sin_rev(a)) * 0.0625f; F.FC[j] = (bf16)f2bf(v); }
    }
}

__device__ __forceinline__ void fold_items(PP p, Ctx& F) {
    for (int it4 = F.gw; it4 < 1792; it4 += F.NGW) {
        const int dq = it4 & 3, it = it4 >> 2;
        const int l = it / 224, r = it % 224, s = r / 16, kb = r % 16; const int k = 64 * kb + F.lane;
        const float* wrow = p->w_in + (size_t)l * D * DIN + (size_t)k * DIN; bf16* WT = win_t(p, l);
        if (s < 2) {
            const f32x4* src = (const f32x4*)(wrow + 384 + 16 * s); f32x4 r4[4];
#pragma unroll
            for (int q = 0; q < 4; ++q) r4[q] = src[q];
            const float* M = p->w_a2 + (size_t)((l * 2 + s) * 16) * 128;
            for (int d = 32 * dq; d < 32 * dq + 32; ++d) { float a = 0.f;
#pragma unroll
                for (int c = 0; c < 16; ++c) a += r4[c >> 2][c & 3] * M[c * 128 + d];
                WT[(size_t)(PLA + s * 128 + d) * D + k] = (bf16)f2bf(a); }
        } else {
            const int kind = (s - 2) >> 2, g = (s - 2) & 3;
            const f32x4* src = (const f32x4*)(wrow + (kind < 2 ? 800 : 1824) + 64 * g); f32x4 r4[16];
#pragma unroll
            for (int q = 0; q < 16; ++q) r4[q] = src[q];
            const float* M = (kind < 2) ? (F.MCS + (size_t)(((l * 4 + g) * 2 + kind) * 64) * 64) : (p->pool_w + (size_t)((l * 4 + g) * 64) * 64);
            const int drow = (kind == 0 ? PFA : (kind == 1 ? PFB : PPOOL)) + 64 * g;
            for (int d = 16 * dq; d < 16 * dq + 16; ++d) { float a = 0.f;
#pragma unroll
                for (int c = 0; c < 64; ++c) a += r4[c >> 2][c & 3] * M[c * 64 + d];
                if (kind == 2) a *= p->pool_scale[l * 256 + g * 64 + d];
                WT[(size_t)(drow + d) * D + k] = (bf16)f2bf(a); }
        }
    }
}

__device__ __forceinline__ void norm_row_bf16(const float* xrow, bf16* orow, const float* g, const float* sc, const float* sh, int lane, const float* part, int nparts, const float* gate, float* xout) {
    f32x4 v[4]; float s = 0.f;
#pragma unroll
    for (int j = 0; j < 4; ++j) v[j] = ((const f32x4*)xrow)[lane + 64 * j];
    if (nparts > 0) {
        f32x4 a[4];
#pragma unroll
        for (int j = 0; j < 4; ++j) a[j] = (f32x4){0.f, 0.f, 0.f, 0.f};
        for (int q = 0; q < nparts; ++q) {
#pragma unroll
            for (int j = 0; j < 4; ++j) { const f32x4 t = ((const f32x4*)(part + (size_t)q * MC * D))[lane + 64 * j]; a[j][0] += t[0]; a[j][1] += t[1]; a[j][2] += t[2]; a[j][3] += t[3]; } }
#pragma unroll
        for (int j = 0; j < 4; ++j) { const f32x4 gv = ((const f32x4*)gate)[lane + 64 * j];
#pragma unroll
            for (int e = 0; e < 4; ++e) v[j][e] += gv[e] * a[j][e];
            ((f32x4*)xout)[lane + 64 * j] = v[j]; }
    }
#pragma unroll
    for (int j = 0; j < 4; ++j) s += (v[j][0] * v[j][0] + v[j][1] * v[j][1]) + (v[j][2] * v[j][2] + v[j][3] * v[j][3]);
    const float rstd = 1.f / sqrtf(wave_sum(s, lane) * (1.f / D) + EPS);
#pragma unroll
    for (int j = 0; j < 4; ++j) { const int idx = lane + 64 * j; const f32x4 gv = ((const f32x4*)g)[idx], scv = ((const f32x4*)sc)[idx], shv = ((const f32x4*)sh)[idx];
        float y[4];
#pragma unroll
        for (int e = 0; e < 4; ++e) y[e] = v[j][e] * rstd * gv[e] * (1.f + scv[e]) + shv[e];
        u32x2 o; o.x = pk2(y[0], y[1]); o.y = pk2(y[2], y[3]); ((u32x2*)orow)[idx] = o; }
}
template <bool FINAL, bool INB>
__device__ __forceinline__ void norm_rows4(const void* xbase, bf16* obase, float* fout, const float* g, const float* modl, int which, int m0, int stride, int lane) {
    f32x4 v[4][4]; float s[4]; int mk[4]; bool ok[4];
#pragma unroll
    for (int k = 0; k < 4; ++k) { const int m = m0 + k * stride; ok[k] = m < ML; mk[k] = ok[k] ? m : ML - 1;
#pragma unroll
        for (int j = 0; j < 4; ++j) {
            if (INB) { const u32x2 t = ((const u32x2*)((const bf16*)xbase + (size_t)mk[k] * D))[lane + 64 * j]; v[k][j] = (f32x4){bflo(t.x), bfhi(t.x), bflo(t.y), bfhi(t.y)}; }
            else v[k][j] = __builtin_nontemporal_load((const f32x4*)((const float*)xbase + (size_t)mk[k] * D) + lane + 64 * j); } }
    f32x4 gm[4], sh4[4];
    { const float* mod = FINAL ? g : modl + (m0 >> 13) * 6144 + which * 3072;
#pragma unroll
      for (int j = 0; j < 4; ++j) { const int idx = lane + 64 * j; const f32x4 gv = ((const f32x4*)g)[idx];
          if (FINAL) { gm[j] = gv; sh4[j] = (f32x4){0.f, 0.f, 0.f, 0.f}; }
          else { const f32x4 scv = ((const f32x4*)(mod + 1024))[idx]; sh4[j] = ((const f32x4*)mod)[idx];
#pragma unroll
              for (int e = 0; e < 4; ++e) gm[j][e] = gv[e] * (1.f + scv[e]); } } }
#pragma unroll
    for (int k = 0; k < 4; ++k) { float a = 0.f;
#pragma unroll
        for (int j = 0; j < 4; ++j) a += (v[k][j][0] * v[k][j][0] + v[k][j][1] * v[k][j][1]) + (v[k][j][2] * v[k][j][2] + v[k][j][3] * v[k][j][3]);
        s[k] = a; }
#pragma unroll
    for (int o = 1; o < 64; o <<= 1) {
#pragma unroll
        for (int k = 0; k < 4; ++k) s[k] += shfl_f(s[k], lane ^ o); }
#pragma unroll
    for (int k = 0; k < 4; ++k) { if (!ok[k]) continue;
        const float rstd = 1.f / sqrtf(s[k] * (1.f / D) + EPS);
#pragma unroll
        for (int j = 0; j < 4; ++j) { const int idx = lane + 64 * j;
            if (FINAL) { f32x4 y;
#pragma unroll
                for (int e = 0; e < 4; ++e) y[e] = v[k][j][e] * rstd * gm[j][e];
                ((f32x4*)(fout + (size_t)mk[k] * D))[idx] = y; }
            else { float y[4];
#pragma unroll
                for (int e = 0; e < 4; ++e) y[e] = v[k][j][e] * rstd * gm[j][e] + sh4[j][e];
                u32x2 o; o.x = pk2(y[0], y[1]); o.y = pk2(y[2], y[3]); ((u32x2*)(obase + (size_t)mk[k] * D))[idx] = o; } }
    }
}
__device__ __forceinline__ void norm_phase(PP p, Ctx& F, int l, int which, int mrows) {
    const float* g = (which == 0 ? p->norm1_g : p->norm2_g) + l * D;
    const float* PART = (const float*)(p->ws + WS_PART);
    if (l == 0 && which == 0) { for (int m0 = F.gw; m0 < ML; m0 += 4 * F.NGW) norm_rows4<false, false>(p->x, F.HX, nullptr, g, F.MOD + l * 3 * 6144, which, m0, F.NGW, F.lane); }
    else { const void* xb = (l == 1 && which == 1 && F.G == 256) ? (const void*)(p->ws + WS_XB2) : (const void*)p->out;
        for (int m0 = F.gw; m0 < ML; m0 += 4 * F.NGW) norm_rows4<false, true>(xb, F.HX, nullptr, g, F.MOD + l * 3 * 6144, which, m0, F.NGW, F.lane); }
    for (int m = ML + F.gw; m < mrows; m += F.NGW) {
        int nparts = 0; const float* gate = nullptr;
        const float* xr = ((l == 0 && which == 0) ? p->ctx : F.XC) + (size_t)(m - ML) * D;
        if (l == 0 && which == 1) { nparts = 4; gate = F.MOD + 2 * 6144 + 2048; }
        if (l == 1 && which == 0) { nparts = 11; gate = F.MOD + 2 * 6144 + 5120; }
        const float* part = PART + (size_t)(m - ML) * D; float* xout = F.XC + (size_t)(m - ML) * D;
        const float* mod = F.MOD + (l * 3 + 2) * 6144 + which * 3072;
        norm_row_bf16(xr, F.HX + (size_t)m * D, g, mod + 1024, mod, F.lane, part, nparts, gate, xout);
    }
}
__device__ __forceinline__ void final_norm(PP p, Ctx& F) {
    for (int m0 = F.gw; m0 < ML; m0 += 4 * F.NGW) norm_rows4<true, false>(p->ws + WS_HX  , nullptr, p->out, p->final_g, nullptr, 0, m0, F.NGW, F.lane);
}
constexpr int CP = 260;
__device__ __forceinline__ int chunk_row0(int b, int cidx) { return (cidx < 4) ? (ML + b * CTXL + cidx * 64) : (b * SEQ + (cidx - 4) * 64); }
__device__ __forceinline__ void cum_to_lds(LAS float* cum, const bf16* PB, int row0, int tid) {
    { const int oct = tid & 31, j0 = tid >> 5; u32x4 w[4];
#pragma unroll
      for (int q = 0; q < 4; ++q) w[q] = *(const u32x4*)(PB + (size_t)(row0 + j0 + 16 * q) * NP + PLA + 8 * oct);
#pragma unroll
      for (int q = 0; q < 4; ++q) { LAS float* d = cum + (j0 + 16 * q) * CP + 8 * oct;
          *(LAS f32x4*)d = (f32x4){bflo(w[q].x), bfhi(w[q].x), bflo(w[q].y), bfhi(w[q].y)}; *(LAS f32x4*)(d + 4) = (f32x4){bflo(w[q].z), bfhi(w[q].z), bflo(w[q].w), bfhi(w[q].w)}; } }
    __syncthreads();
    if (tid < 256) { float s = 0.f;
        if (tid < 128) {
#pragma unroll 16
            for (int j = 0; j < 64; ++j) { s += cum[j * CP + tid]; cum[j * CP + tid] = s; }
        } else {
#pragma unroll 16
            for (int j = 63; j >= 0; --j) { s += cum[j * CP + tid]; cum[j * CP + tid] = s; }
        } }
    __syncthreads();
}
typedef float f32x2_t __attribute__((ext_vector_type(2)));
typedef __bf16 bf16x2_t __attribute__((ext_vector_type(2)));
__device__ __forceinline__ unsigned pkh(float lo, float hi) { f32x2_t v = {lo, hi}; bf16x2_t b = __builtin_convertvector(v, bf16x2_t); return __builtin_bit_cast(unsigned, b); }
__device__ __forceinline__ bf16x8 pack8h(float a0, float a1, float a2, float a3, float a4, float a5, float a6, float a7) {
    u32x4 w; w.x = pkh(a0, a1); w.y = pkh(a2, a3); w.z = pkh(a4, a5); w.w = pkh(a6, a7); return __builtin_bit_cast(bf16x8, w);
}
__device__ __forceinline__ void la_load(u32x4 (&w)[4], const bf16* PB, int row0, int tid) {
    const int oct = tid & 31, j0 = tid >> 5;
#pragma unroll
    for (int q = 0; q < 4; ++q) w[q] = *(const u32x4*)(PB + (size_t)(row0 + j0 + 16 * q) * NP + PLA + 8 * oct);
}
__device__ __forceinline__ void la_scan(LAS float* cum, const u32x4 (&w)[4], int tid) {
    const int oct = tid & 31, j0 = tid >> 5;
#pragma unroll
    for (int q = 0; q < 4; ++q) { LAS float* d = cum + (j0 + 16 * q) * CP + 8 * oct;
        *(LAS f32x4*)d = (f32x4){bflo(w[q].x), bfhi(w[q].x), bflo(w[q].y), bfhi(w[q].y)}; *(LAS f32x4*)(d + 4) = (f32x4){bflo(w[q].z), bfhi(w[q].z), bflo(w[q].w), bfhi(w[q].w)}; }
    __syncthreads();
    if (tid < 256) { float carry = 0.f;
        if (tid < 128) {
#pragma unroll
            for (int hf = 0; hf < 4; ++hf) { float v[16];
#pragma unroll
                for (int j = 0; j < 16; ++j) v[j] = cum[(16 * hf + j) * CP + tid];
                v[0] += carry;
#pragma unroll
                for (int j = 1; j < 16; ++j) v[j] += v[j - 1];
                carry = v[15];
#pragma unroll
                for (int j = 0; j < 16; ++j) cum[(16 * hf + j) * CP + tid] = v[j]; }
        } else {
#pragma unroll
            for (int hf = 3; hf >= 0; --hf) { float v[16];
#pragma unroll
                for (int j = 0; j < 16; ++j) v[j] = cum[(16 * hf + j) * CP + tid];
                v[15] += carry;
#pragma unroll
                for (int j = 14; j >= 0; --j) v[j] += v[j + 1];
                carry = v[0];
#pragma unroll
                for (int j = 0; j < 16; ++j) cum[(16 * hf + j) * CP + tid] = v[j]; }
        } }
    __syncthreads();
}
__device__ __forceinline__ void gla_a_item(Ctx& F, int b, int cidx) {
    LAS float* cum = (LAS float*)F.lds; const int row0 = chunk_row0(b, cidx);
    const int h = F.wave & 3, dir = F.wave >> 2, chb = dir * 128 + h * 32, lr = F.lane & 15, g = F.lane >> 4;
    const int jl = dir ? 0 : 63;
    u32x4 wla[4]; la_load(wla, F.PB, row0, F.tid);
    unsigned short kt[2][2][8], vt[2][4][8];
#pragma unroll
    for (int ks = 0; ks < 2; ++ks) { const int j0 = 32 * ks + 8 * g;
#pragma unroll
        for (int mb = 0; mb < 2; ++mb)
#pragma unroll
            for (int e = 0; e < 8; ++e) kt[ks][mb][e] = F.PB[(size_t)(row0 + j0 + e) * NP + PK + h * 32 + 16 * mb + lr];
#pragma unroll
        for (int nb = 0; nb < 4; ++nb)
#pragma unroll
            for (int e = 0; e < 8; ++e) vt[ks][nb][e] = F.PB[(size_t)(row0 + j0 + e) * NP + PV + h * 64 + 16 * nb + lr]; }
    la_scan(cum, wla, F.tid);
    f32x4 acc[2][4];
#pragma unroll
    for (int mb = 0; mb < 2; ++mb)
#pragma unroll
        for (int nb = 0; nb < 4; ++nb) acc[mb][nb] = (f32x4){0.f, 0.f, 0.f, 0.f};
#pragma unroll
    for (int ks = 0; ks < 2; ++ks) {
        bf16x8 af[2], bfr[4]; const int j0 = 32 * ks + 8 * g;
#pragma unroll
        for (int mb = 0; mb < 2; ++mb) { const int dk = 16 * mb + lr; const float last = cum[jl * CP + chb + dk]; float a[8];
#pragma unroll
            for (int e = 0; e < 8; ++e) { const int j = j0 + e; a[e] = bf2f(kt[ks][mb][e]) * __expf(last - cum[j * CP + chb + dk]); }
            af[mb] = pack8h(a[0], a[1], a[2], a[3], a[4], a[5], a[6], a[7]); }
#pragma unroll
        for (int nb = 0; nb < 4; ++nb) { const unsigned short* t = vt[ks][nb];
            u32x4 w; w.x = t[0] | ((unsigned)t[1] << 16); w.y = t[2] | ((unsigned)t[3] << 16); w.z = t[4] | ((unsigned)t[5] << 16); w.w = t[6] | ((unsigned)t[7] << 16);
            bfr[nb] = __builtin_bit_cast(bf16x8, w); }
#pragma unroll
        for (int mb = 0; mb < 2; ++mb)
#pragma unroll
            for (int nb = 0; nb < 4; ++nb) acc[mb][nb] = MFMA16(af[mb], bfr[nb], acc[mb][nb]);
    }
    const size_t sidx = (size_t)(((b * 2 + dir) * 4 + h) * NCH + cidx);
    float* st = F.ST + sidx * 2048;
#pragma unroll
    for (int mb = 0; mb < 2; ++mb)
#pragma unroll
        for (int nb = 0; nb < 4; ++nb) *(f32x4*)(st + (16 * nb + lr) * 32 + 16 * mb + 4 * g) = acc[mb][nb];
    if (F.lane < 32) F.DEC[sidx * 32 + F.lane] = __expf(cum[jl * CP + chb + F.lane]);
    __syncthreads();
}
__device__ __forceinline__ void gla_scan(Ctx& F) {
    LAS float* xa = (LAS float*)F.lds; LAS float* xb = xa + 512;
    const int seg = F.tid >> 6, el = F.tid & 63;
    for (int blk = blockIdx.x; blk < 512; blk += F.G) {
        const int ge = blk * 64 + el, e = ge & 2047, seq = ge >> 11, dir = (seq >> 2) & 1, dk = e & 31;
        float* st = F.ST + (size_t)seq * NCH * 2048 + e; const float* dc = F.DEC + (size_t)seq * NCH * 32 + dk;
        float u[17], d[17];
#pragma unroll
        for (int i = 0; i < 17; ++i) { const int s = seg * 17 + i; const bool ok = s < NCH; const int sc = ok ? s : NCH - 1; const int c = dir ? (sc < 4 ? 3 - sc : 135 - sc) : sc;
            const float uu = st[(size_t)c * 2048], dd = dc[c * 32]; u[i] = ok ? uu : 0.f; d[i] = ok ? dd : 1.f; }
        float A = 1.f, B = 0.f;
#pragma unroll
        for (int i = 0; i < 17; ++i) { B = B * d[i] + u[i]; A *= d[i]; }
        xa[F.tid] = A; xb[F.tid] = B;
        __syncthreads();
        float S = 0.f;
        for (int sg = 0; sg < seg; ++sg) S = S * xa[sg * 64 + el] + xb[sg * 64 + el];
#pragma unroll
        for (int i = 0; i < 17; ++i) { const int s = seg * 17 + i; if (s < NCH) { const int c = dir ? (s < 4 ? 3 - s : 135 - s) : s; st[(size_t)c * 2048] = S; } S = S * d[i] + u[i]; }
        __syncthreads();
    }
}
template <int NI>
__device__ __forceinline__ void gla_c_item(PP p, Ctx& F, int l, int b, int cidx, int sub) {
    LAS float* cum = (LAS float*)F.lds; const int row0 = chunk_row0(b, cidx);
    const int h = F.wave & 3, half = (NI == 2) ? (F.wave >> 2) : sub, ibase = (NI == 2) ? 0 : (F.wave >> 2), lr = F.lane & 15, g = F.lane >> 4;
    u32x4 wla[4]; la_load(wla, F.PB, row0, F.tid);
    f32x4 o[4][2];
#pragma unroll
    for (int mb = 0; mb < 4; ++mb) { o[mb][0] = (f32x4){0.f, 0.f, 0.f, 0.f}; o[mb][1] = (f32x4){0.f, 0.f, 0.f, 0.f}; }
    bf16x8 av[4][2];
#pragma unroll
    for (int mb = 0; mb < 4; ++mb)
#pragma unroll
        for (int pp = 0; pp < 2; ++pp) { unsigned short t[8];
#pragma unroll
            for (int e = 0; e < 8; ++e) { const int j = 32 * pp + (e < 4 ? 4 * g + e : 16 + 4 * g + (e - 4)); t[e] = F.PB[(size_t)(row0 + j) * NP + PV + h * 64 + 16 * mb + lr]; }
            u32x4 w; w.x = t[0] | ((unsigned)t[1] << 16); w.y = t[2] | ((unsigned)t[3] << 16); w.z = t[4] | ((unsigned)t[5] << 16); w.w = t[6] | ((unsigned)t[7] << 16);
            av[mb][pp] = __builtin_bit_cast(bf16x8, w); }
    u32x4 qraw[2], kraw[4]; f32x4 sraw[2][4][2];
#pragma unroll
    for (int ibl = 0; ibl < NI; ++ibl) qraw[ibl] = *(const u32x4*)(F.PB + (size_t)(row0 + 16 * (2 * half + ibase + ibl) + lr) * NP + PQ + h * 32 + 8 * g);
#pragma unroll
    for (int jb = 0; jb < 4; ++jb) kraw[jb] = *(const u32x4*)(F.PB + (size_t)(row0 + 16 * jb + lr) * NP + PK + h * 32 + 8 * g);
    { const float* st = F.ST + (size_t)(((b * 2 + 0) * 4 + h) * NCH + cidx) * 2048;
#pragma unroll
        for (int mb = 0; mb < 4; ++mb) { sraw[0][mb][0] = *(const f32x4*)(st + (16 * mb + lr) * 32 + 8 * g); sraw[0][mb][1] = *(const f32x4*)(st + (16 * mb + lr) * 32 + 8 * g + 4); } }
    la_scan(cum, wla, F.tid);
    { const float* st = F.ST + (size_t)(((b * 2 + 1) * 4 + h) * NCH + cidx) * 2048;
#pragma unroll
        for (int mb = 0; mb < 4; ++mb) { sraw[1][mb][0] = *(const f32x4*)(st + (16 * mb + lr) * 32 + 8 * g); sraw[1][mb][1] = *(const f32x4*)(st + (16 * mb + lr) * 32 + 8 * g + 4); } }
#pragma unroll
    for (int dir = 0; dir < 2; ++dir) {
        const int chb = dir * 128 + h * 32;
        bf16x8 bq[2];
#pragma unroll
        for (int ibl = 0; ibl < NI; ++ibl) { const int i = 16 * (2 * half + ibase + ibl) + lr;
            const u32x4 qw = qraw[ibl];
            const f32x4 c0 = *(const LAS f32x4*)(cum + i * CP + chb + 8 * g), c1 = *(const LAS f32x4*)(cum + i * CP + chb + 8 * g + 4);
            bq[ibl] = pack8h(bflo(qw.x) * __expf(c0[0]), bfhi(qw.x) * __expf(c0[1]), bflo(qw.y) * __expf(c0[2]), bfhi(qw.y) * __expf(c0[3]),
                            bflo(qw.z) * __expf(c1[0]), bfhi(qw.z) * __expf(c1[1]), bflo(qw.w) * __expf(c1[2]), bfhi(qw.w) * __expf(c1[3])); }
#pragma unroll
        for (int mb = 0; mb < 4; ++mb) { const f32x4 s0 = sraw[dir][mb][0], s1 = sraw[dir][mb][1];
            const bf16x8 as = pack8h(s0[0], s0[1], s0[2], s0[3], s1[0], s1[1], s1[2], s1[3]);
            o[mb][0] = MFMA16(as, bq[0], o[mb][0]); if (NI == 2) o[mb][1] = MFMA16(as, bq[1], o[mb][1]); }
#pragma unroll
        for (int pp = 0; pp < 2; ++pp) {
            if ((dir == 0 && half == 0 && pp == 1) || (dir == 1 && half == 1 && pp == 0)) continue;
            f32x4 sc[2][2];
#pragma unroll
            for (int q = 0; q < 2; ++q) { const int jb = 2 * pp + q, j = 16 * jb + lr;
                const u32x4 kw = kraw[jb];
                const f32x4 c0 = *(const LAS f32x4*)(cum + j * CP + chb + 8 * g), c1 = *(const LAS f32x4*)(cum + j * CP + chb + 8 * g + 4);
                const bf16x8 ak = pack8h(bflo(kw.x) * __expf(-c0[0]), bfhi(kw.x) * __expf(-c0[1]), bflo(kw.y) * __expf(-c0[2]), bfhi(kw.y) * __expf(-c0[3]),
                                        bflo(kw.z) * __expf(-c1[0]), bfhi(kw.z) * __expf(-c1[1]), bflo(kw.w) * __expf(-c1[2]), bfhi(kw.w) * __expf(-c1[3]));
#pragma unroll
                for (int ibl = 0; ibl < NI; ++ibl) { f32x4 z = (f32x4){0.f, 0.f, 0.f, 0.f}; z = MFMA16(ak, bq[ibl], z);
                    const int i = 16 * (2 * half + ibase + ibl) + lr;
#pragma unroll
                    for (int r = 0; r < 4; ++r) { const int jj = 16 * jb + 4 * g + r; const bool keep = dir ? (jj >= i) : (jj <= i); z[r] = keep ? z[r] : 0.f; }
                    sc[q][ibl] = z; } }
#pragma unroll
            for (int ibl = 0; ibl < NI; ++ibl) { const bf16x8 pb = pack8h(sc[0][ibl][0], sc[0][ibl][1], sc[0][ibl][2], sc[0][ibl][3], sc[1][ibl][0], sc[1][ibl][1], sc[1][ibl][2], sc[1][ibl][3]);
#pragma unroll
                for (int mb = 0; mb < 4; ++mb) o[mb][ibl] = MFMA16(av[mb][pp], pb, o[mb][ibl]); }
        }
    }
    const float* gg = p->gla_g + l * 64;
#pragma unroll
    for (int ibl = 0; ibl < NI; ++ibl) { float ss = 0.f;
#pragma unroll
        for (int mb = 0; mb < 4; ++mb) ss += (o[mb][ibl][0] * o[mb][ibl][0] + o[mb][ibl][1] * o[mb][ibl][1]) + (o[mb][ibl][2] * o[mb][ibl][2] + o[mb][ibl][3] * o[mb][ibl][3]);
        ss += shfl_f(ss, F.lane ^ 16); ss += shfl_f(ss, F.lane ^ 32);
        const float rstd = 1.f / sqrtf(ss * (1.f / 64.f) + EPS);
        const int i = 16 * (2 * half + ibase + ibl) + lr; const size_t row = (size_t)(row0 + i);
#pragma unroll
        for (int mb = 0; mb < 4; ++mb) { const int dv = 16 * mb + 4 * g; const f32x4 gv = *(const f32x4*)(gg + dv);
            const u32x2 gw = *(const u32x2*)(F.PB + row * NP + PG + h * 64 + dv);
            const float y0 = o[mb][ibl][0] * rstd * gv[0] * silu_f(bflo(gw.x)), y1 = o[mb][ibl][1] * rstd * gv[1] * silu_f(bfhi(gw.x));
            const float y2 = o[mb][ibl][2] * rstd * gv[2] * silu_f(bflo(gw.y)), y3 = o[mb][ibl][3] * rstd * gv[3] * silu_f(bfhi(gw.y));
            u32x2 w; w.x = pk2(y0, y1); w.y = pk2(y2, y3); *(u32x2*)(F.YMIX + row * D + h * 64 + dv) = w; }
    }
    __syncthreads();
}

template <int NKS, int GRP>
__device__ __forceinline__ void dft_mma_lds(f32x4 (&acc)[8], const LAS unsigned char* fl, int pitchB, const bf16* re, const bf16* im, size_t rstride, int khalf, int lane) {
    const int lr = lane & 15, g = lane >> 4;
#pragma unroll
    for (int k0 = 0; k0 < NKS; k0 += GRP) {
        bf16x8 bfrag[GRP];
#pragma unroll
        for (int kq = 0; kq < GRP; ++kq) { const int ks = k0 + kq; const int kk0 = 32 * ks + 8 * g; const bool part = kk0 >= khalf; const int idx = part ? kk0 - khalf : kk0;
            const bf16* src = (part ? im : re) + (size_t)idx * rstride + lr; unsigned short t[8];
#pragma unroll
            for (int e = 0; e < 8; ++e) t[e] = src[(size_t)e * rstride];
            u32x4 w; w.x = t[0] | ((unsigned)t[1] << 16); w.y = t[2] | ((unsigned)t[3] << 16); w.z = t[4] | ((unsigned)t[5] << 16); w.w = t[6] | ((unsigned)t[7] << 16);
            bfrag[kq] = __builtin_bit_cast(bf16x8, w); }
#pragma unroll
        for (int kq = 0; kq < GRP; ++kq) { const int ks = k0 + kq;
#pragma unroll
            for (int mb = 0; mb < 8; ++mb) { const bf16x8 a = *(const LAS bf16x8*)(fl + (16 * mb + lr) * pitchB + (32 * ks + 8 * g) * 2); acc[mb] = MFMA16(a, bfrag[kq], acc[mb]); }
        }
    }
}
__device__ __forceinline__ void f_to_lds(LAS unsigned char* fl, const bf16* Fm, int rows, int rowB, int tid) {
    const int cpr = rowB >> 4, n = rows * cpr;
    for (int i = tid; i < n; i += 512) { const int r = i / cpr, c = i - r * cpr; *(LAS u32x4*)(fl + r * (rowB + 16) + c * 16) = *(const u32x4*)((const unsigned char*)Fm + (size_t)r * rowB + c * 16); }
    __syncthreads();
}
template <int NKS, int GRP = 4, int NMB = 8>
__device__ __forceinline__ void dft_mma(f32x4 (&acc)[NMB], const bf16* Fm, int ldF, int mrow0, const bf16* re, const bf16* im, size_t rstride, int khalf, int lane) {
    const int lr = lane & 15, g = lane >> 4;
#pragma unroll
    for (int k0 = 0; k0 < NKS; k0 += GRP) {
        bf16x8 bfrag[GRP];
#pragma unroll
        for (int kq = 0; kq < GRP; ++kq) { const int ks = k0 + kq; const int kk0 = 32 * ks + 8 * g; const bool part = kk0 >= khalf; const int idx = part ? kk0 - khalf : kk0;
            const bf16* src = (part ? im : re) + (size_t)idx * rstride + lr; unsigned short t[8];
#pragma unroll
            for (int e = 0; e < 8; ++e) t[e] = src[(size_t)e * rstride];
            u32x4 w; w.x = t[0] | ((unsigned)t[1] << 16); w.y = t[2] | ((unsigned)t[3] << 16); w.z = t[4] | ((unsigned)t[5] << 16); w.w = t[6] | ((unsigned)t[7] << 16);
            bfrag[kq] = __builtin_bit_cast(bf16x8, w); }
#pragma unroll
        for (int kq = 0; kq < GRP; ++kq) { const int ks = k0 + kq;
            bf16x8 a[NMB];
#pragma unroll
            for (int mb = 0; mb < NMB; ++mb) a[mb] = *(const bf16x8*)(Fm + (size_t)(mrow0 + 16 * mb + lr) * ldF + 32 * ks + 8 * g);
#pragma unroll
            for (int mb = 0; mb < NMB; ++mb) acc[mb] = MFMA16(a[mb], bfrag[kq], acc[mb]);
            if (kq & 1) __builtin_amdgcn_sched_barrier(0);
        }
    }
}
__device__ __forceinline__ void dft_mma_loop(f32x4 (&acc)[8], const bf16* Fm, int ldF, int mrow0, int nks, const bf16* re, const bf16* im, size_t rstride, int khalf, int lane) {
    const int lr = lane & 15, g = lane >> 4;
#pragma unroll 1
    for (int ks = 0; ks < nks; ++ks) { const int kk0 = 32 * ks + 8 * g; const bool part = kk0 >= khalf; const int idx = part ? kk0 - khalf : kk0;
        const bf16* src = (part ? im : re) + (size_t)idx * rstride + lr; unsigned short t[8];
#pragma unroll
        for (int e = 0; e < 8; ++e) t[e] = src[(size_t)e * rstride];
        u32x4 w; w.x = t[0] | ((unsigned)t[1] << 16); w.y = t[2] | ((unsigned)t[3] << 16); w.z = t[4] | ((unsigned)t[5] << 16); w.w = t[6] | ((unsigned)t[7] << 16);
        const bf16x8 bfrag = __builtin_bit_cast(bf16x8, w);
#pragma unroll
        for (int mb = 0; mb < 8; ++mb) { const bf16x8 a = *(const bf16x8*)(Fm + (size_t)(mrow0 + 16 * mb + lr) * ldF + 32 * ks + 8 * g); acc[mb] = MFMA16(a, bfrag, acc[mb]); }
    }
}
__device__ __forceinline__ void fft_stage1(Ctx& F) {
    const int lr = F.lane & 15, g = F.lane >> 4;
    f_to_lds(F.lds, F.F1, 128, 256, F.tid);
    for (int it = F.gw; it < 4096; it += F.NGW) { const int cb = it & 15, n2 = (it >> 4) & 127, b = it >> 11;
        f32x4 acc[8];
#pragma unroll
        for (int mb = 0; mb < 8; ++mb) acc[mb] = (f32x4){0.f, 0.f, 0.f, 0.f};
        const bf16* re = F.PB + (size_t)(b * SEQ + n2) * NP + PFA + 16 * cb;
        dft_mma_lds<4, 4>(acc, F.lds, 272, re, re + 256, (size_t)128 * NP, 64, F.lane);
#pragma unroll
        for (int mb = 0; mb < 4; ++mb)
#pragma unroll
            for (int r = 0; r < 4; ++r) { const int k1 = 16 * mb + 4 * g + r; const float a = (float)(k1 * n2) * (1.f / 8192.f); const float c = cos_rev(a), s = sin_rev(a);
                const float tr = acc[mb][r], ti = acc[mb + 4][r]; const float xr = tr * c + ti * s, xi = ti * c - tr * s;
                bf16* dst = F.TB + ((size_t)((b * 64 + k1) * 2) * 128 + n2) * 256 + 16 * cb + lr;
                dst[0] = (bf16)f2bf(xr); dst[(size_t)128 * 256] = (bf16)f2bf(xi); }
    }
}
__device__ __forceinline__ void fft_stage2(Ctx& F, int l) {
    const int lr = F.lane & 15, g = F.lane >> 4;
    f_to_lds(F.lds, F.F2, 128, 512, F.tid);
    for (int it = F.gw; it < 2048; it += F.NGW) {
        f32x4 acc[8];
#pragma unroll
        for (int mb = 0; mb < 8; ++mb) acc[mb] = (f32x4){0.f, 0.f, 0.f, 0.f};
        const int cb = it & 15, k1 = (it >> 4) & 63, b = it >> 10;
        const bf16* re = F.TB + (size_t)((b * 64 + k1) * 2) * 128 * 256 + 16 * cb;
        dft_mma_lds<8, 4>(acc, F.lds, 528, re, re + (size_t)128 * 256, 256, 128, F.lane);
#pragma unroll
        for (int mb = 0; mb < 8; ++mb)
#pragma unroll
            for (int r = 0; r < 4; ++r) { const int k2 = 16 * mb + 4 * g + r; F.YMIX[(size_t)(b * SEQ + k1 + 64 * k2) * D + 256 + 16 * cb + lr] = (bf16)f2bf(acc[mb][r]); }
    }
    __syncthreads();
}
__device__ __forceinline__ void ctx_dft(Ctx& F, int w0, int nw) {
    const int lr = F.lane & 15, g = F.lane >> 4;
    for (int it = w0; it >= 0 && it < 256; it += nw) { const int mq = it & 7, cb = (it >> 3) & 15, b = it >> 7;
            f32x4 acc[2] = {(f32x4){0.f, 0.f, 0.f, 0.f}, (f32x4){0.f, 0.f, 0.f, 0.f}};
            const bf16* re = F.PB + (size_t)(ML + b * CTXL) * NP + PFA + 16 * cb;
            dft_mma<8, 4, 2>(acc, F.FC, 512, 32 * mq, re, re, (size_t)NP, 256, F.lane); __builtin_amdgcn_sched_barrier(0);
            dft_mma<8, 4, 2>(acc, F.FC + 256, 512, 32 * mq, re + 256, re + 256, (size_t)NP, 256, F.lane);
#pragma unroll
            for (int mb = 0; mb < 2; ++mb)
#pragma unroll
                for (int r = 0; r < 4; ++r) { const int k = 32 * mq + 16 * mb + 4 * g + r; F.YMIX[(size_t)(ML + b * CTXL + k) * D + 256 + 16 * cb + lr] = (bf16)f2bf(acc[mb][r]); }
        }
}
__device__ __forceinline__ void load8(const bf16* q, float (&v)[8]) { const u32x4 w = *(const u32x4*)q; v[0] = bflo(w.x); v[1] = bfhi(w.x); v[2] = bflo(w.y); v[3] = bfhi(w.y); v[4] = bflo(w.z); v[5] = bfhi(w.z); v[6] = bflo(w.w); v[7] = bfhi(w.w); }
__device__ __forceinline__ void store8(bf16* q, const float (&v)[8]) { u32x4 w; w.x = pk2(v[0], v[1]); w.y = pk2(v[2], v[3]); w.z = pk2(v[4], v[5]); w.w = pk2(v[6], v[7]); *(u32x4*)q = w; }
__device__ __forceinline__ u32x4 ldrow(const bf16* base, int rbase, int t, int n, int col) { const int tc = t < 0 ? 0 : (t > n - 1 ? n - 1 : t); return *(const u32x4*)(base + (size_t)(rbase + tc) * NP + col); }
__device__ __forceinline__ void unpack8(const u32x4 w, float (&v)[8]) { v[0] = bflo(w.x); v[1] = bfhi(w.x); v[2] = bflo(w.y); v[3] = bfhi(w.y); v[4] = bflo(w.z); v[5] = bfhi(w.z); v[6] = bflo(w.w); v[7] = bfhi(w.w); }
__device__ __forceinline__ void convpool_item(PP p, Ctx& F, int l, int it) {
    int rbase, n, t0;
    if (it < 256) { rbase = it * 64; n = 64; t0 = 0; } else { const int sg = it - 256; rbase = ML + (sg >> 2) * CTXL; n = CTXL; t0 = (sg & 3) * 64; }
    const int oct = F.tid & 31, tl = F.tid >> 5, c0 = 8 * oct, tb = t0 + tl * 4;
    {
        u32x4 hw_[6], cw_[6], bw_[4];
#pragma unroll
        for (int i = 0; i < 6; ++i) { hw_[i] = ldrow(F.PB, rbase, tb - 1 + i, n, PH + c0); cw_[i] = ldrow(F.PB, rbase, tb - 1 + i, n, PCG + c0); }
#pragma unroll
        for (int q = 0; q < 4; ++q) bw_[q] = ldrow(F.PB, rbase, tb + q, n, PBG + c0);
        const f32x4 w0a = *(const f32x4*)(p->conv_w + (l * 3 + 0) * 256 + c0), w0b = *(const f32x4*)(p->conv_w + (l * 3 + 0) * 256 + c0 + 4);
        const f32x4 w1a = *(const f32x4*)(p->conv_w + (l * 3 + 1) * 256 + c0), w1b = *(const f32x4*)(p->conv_w + (l * 3 + 1) * 256 + c0 + 4);
        const f32x4 w2a = *(const f32x4*)(p->conv_w + (l * 3 + 2) * 256 + c0), w2b = *(const f32x4*)(p->conv_w + (l * 3 + 2) * 256 + c0 + 4);
        const f32x4 cba = *(const f32x4*)(p->conv_b + l * 256 + c0), cbb = *(const f32x4*)(p->conv_b + l * 256 + c0 + 4);
        float hc[6][8];
#pragma unroll
        for (int i = 0; i < 6; ++i) { float a[8], b[8]; unpack8(hw_[i], a); unpack8(cw_[i], b); const int t = tb - 1 + i; const float msk = (t >= 0 && t < n) ? 1.f : 0.f;
#pragma unroll
            for (int e = 0; e < 8; ++e) hc[i][e] = a[e] * b[e] * msk; }
#pragma unroll
        for (int q = 0; q < 4; ++q) { float bg[8], y[8]; unpack8(bw_[q], bg);
#pragma unroll
            for (int e = 0; e < 8; ++e) { const float w0 = e < 4 ? w0a[e & 3] : w0b[e & 3], w1 = e < 4 ? w1a[e & 3] : w1b[e & 3], w2 = e < 4 ? w2a[e & 3] : w2b[e & 3], cb = e < 4 ? cba[e & 3] : cbb[e & 3];
                y[e] = bg[e] * (w0 * hc[q][e] + w1 * hc[q + 1][e] + w2 * hc[q + 2][e] + cb); }
            store8(F.YMIX + (size_t)(rbase + tb + q) * D + 512 + c0, y); }
    }
    __builtin_amdgcn_sched_barrier(0);
    {
        const int wnd = 2 << (oct >> 3), hw = wnd >> 1;
        float s[4][8], self[4][8];
#pragma unroll
        for (int q = 0; q < 4; ++q) { unpack8(ldrow(F.PB, rbase, tb + q, n, PPOOL + c0), self[q]);
#pragma unroll
            for (int e = 0; e < 8; ++e) s[q][e] = 0.f; }
        __builtin_amdgcn_sched_barrier(0);
#pragma unroll
        for (int bt = 0; bt < 19; bt += 7) {
            u32x4 pw[7];
#pragma unroll
            for (int ii = 0; ii < 7; ++ii) if (bt + ii < 19) pw[ii] = ldrow(F.PB, rbase, tb - hw + bt + ii, n, PPOOL + c0);
#pragma unroll
            for (int ii = 0; ii < 7; ++ii) if (bt + ii < 19) { const int i = bt + ii; float v[8]; unpack8(pw[ii], v); const int t = tb - hw + i; const bool inr = (t >= 0 && t < n);
#pragma unroll
                for (int q = 0; q < 4; ++q) { const float mk = (inr && i >= q && i < q + wnd) ? 1.f : 0.f;
#pragma unroll
                    for (int e = 0; e < 8; ++e) s[q][e] += mk * v[e]; } }
            __builtin_amdgcn_sched_barrier(0);
        }
#pragma unroll
        for (int q = 0; q < 4; ++q) { const int t = tb + q; const int lo = (t - hw > 0) ? t - hw : 0, hi = (t + hw - 1 < n - 1) ? t + hw - 1 : n - 1; const float inv = 1.f / (float)(hi - lo + 1);
            float y[8];
#pragma unroll
            for (int e = 0; e < 8; ++e) y[e] = s[q][e] * inv - self[q][e];
            store8(F.YMIX + (size_t)(rbase + t) * D + 768 + c0, y); }
    }
}
__device__ __forceinline__ void ctx_act(PP p, Ctx& F, int l) {
    const int gt = blockIdx.x * 512 + F.tid, NT = F.G * 512;
    for (int i = gt; i < MC * 352; i += NT) { const int oc = i % 352, rc = i / 352, t = rc & 255, c0 = 8 * oc;
        const bf16* base = F.CAU + (size_t)rc * NUP + c0; float a[8], y[8], u[8];
        const float* cw = p->ffn_cw + (size_t)l * 3 * DFF + c0; const float* cb = p->ffn_cb + (size_t)l * DFF + c0;
#pragma unroll
        for (int e = 0; e < 8; ++e) y[e] = cb[e];
        if (t > 0) { load8(base - NUP, a);
#pragma unroll
            for (int e = 0; e < 8; ++e) y[e] += cw[e] * a[e]; }
        load8(base, a);
#pragma unroll
        for (int e = 0; e < 8; ++e) y[e] += cw[DFF + e] * a[e];
        if (t < 255) { load8(base + NUP, a);
#pragma unroll
            for (int e = 0; e < 8; ++e) y[e] += cw[2 * DFF + e] * a[e]; }
        load8(base + DFF, u);
#pragma unroll
        for (int e = 0; e < 8; ++e) y[e] = silu_f(y[e]) * u[e];
        store8(F.ACT + (size_t)(ML + rc) * DFF + c0, y);
    }
}
__global__ void __launch_bounds__(512, 2) fwd_megakernel(Params p_) {
    PP p = (PP)__builtin_amdgcn_kernarg_segment_ptr();
    extern __shared__ __attribute__((aligned(16))) unsigned char lds_raw[];
    cg::grid_group grid = cg::this_grid();
    Ctx F;
    F.lds = (LAS unsigned char*)lds_raw; F.tid = threadIdx.x; F.lane = F.tid & 63; F.wave = __builtin_amdgcn_readfirstlane(F.tid >> 6);
    const int wave_s = F.wave;
    F.G = gridDim.x; F.gw = blockIdx.x * 8 + F.wave; F.NGW = F.G * 8;
    unsigned char* ws = p->ws;
#define SETPTRS() do { { PP q_ = (PP)__builtin_amdgcn_kernarg_segment_ptr(); asm volatile("" : "+s"(q_)); p = q_; } unsigned char* w_ = p->ws; asm volatile("" : "+s"(w_)); \
    F.MOD = (float*)(w_ + WS_MOD); F.MCS = (float*)(w_ + WS_MCS); F.F1 = (bf16*)(w_ + WS_F1); F.F2 = (bf16*)(w_ + WS_F2); F.FC = (bf16*)(w_ + WS_FC); \
    F.HX = (bf16*)(w_ + WS_HX); F.TB = (bf16*)(w_ + WS_HX); F.YMIX = (bf16*)(w_ + WS_YMIX); F.PB = (bf16*)(w_ + WS_P); F.ACT = (bf16*)(w_ + WS_P); \
    F.XC = (float*)(w_ + WS_XC); F.ST = (float*)(w_ + WS_ST); F.DEC = (float*)(w_ + WS_DEC); F.CAU = (bf16*)(w_ + WS_CAU); } while (0)
    SETPTRS();

#ifndef NO_P0
#define REFRESH() do { int t_; asm volatile("v_mbcnt_lo_u32_b32 %0, -1, 0\n\tv_mbcnt_hi_u32_b32 %0, -1, %0" : "=v"(t_)); t_ |= (wave_s << 6); F.tid = t_; F.lane = t_ & 63; F.wave = __builtin_amdgcn_readfirstlane(t_ >> 6); F.gw = blockIdx.x * 8 + F.wave; SETPTRS(); } while (0)
    { volatile LAS unsigned* misc = (volatile LAS unsigned*)(F.lds + RING_BYTES); if (F.tid < 64) misc[F.tid] = 0u; }
    __syncthreads();
    XcdBarrier bar = xcd_barrier_post((unsigned*)(ws + WS_CTL), (volatile LAS unsigned*)(F.lds + RING_BYTES) + 8, F.tid);
#define GSYNC() do { REFRESH(); xcd_barrier(bar, F.tid); } while (0)
    REFRESH();
    phase0(p, F);
#endif
    if (p->ws == nullptr) grid.sync();
    GSYNC();
#define L0() ({ int lq_ = l; asm volatile("" : "+s"(lq_)); lq_ == 0; })
    for (int l = 0; l < 2; ++l) {
        const int M6 = L0() ? MT : ML;
#ifndef NO_P1
        REFRESH();
        norm_phase(p, F, l, 0, MT);
        REFRESH();
        if (L0()) fold_items(p, F);
#ifdef PROBE_B
        REFRESH(); norm_phase(p, F, l, 0, MT); if (L0()) fold_items(p, F);
#endif
#endif
        GSYNC();
#ifndef NO_P2
        REFRESH();
        { pg8::Gemm g{F.HX, win_t(p, l), MT, NP, D, D}; pg8::StaticOrder S; S.init(MT, NP, F.G, (int)blockIdx.x);
          EpiP E{F.PB, p->b_a2 + l * 256};
          pg8::gemm_phase<EpiP, pg8::StaticOrder, true, true>(F.lds, g, S, E, F.tid);
#ifdef PROBE_C
          __syncthreads(); pg8::gemm_phase<EpiP, pg8::StaticOrder, true, true>(F.lds, g, S, E, F.tid);
#endif
        }
#endif
        GSYNC();
#ifdef PROBE_A
        for (int rep_ = 0; rep_ < 2; ++rep_) {
#else
        {
#endif
#ifndef NO_GA
        REFRESH();
        for (int it = blockIdx.x; it < 2 * NCH; it += F.G) gla_a_item(F, it / NCH, it % NCH);
#ifdef PR_GA
        __syncthreads(); REFRESH();
        for (int it = blockIdx.x; it < 2 * NCH; it += F.G) gla_a_item(F, it / NCH, it % NCH);
#endif
#endif
#ifndef NO_F1
        REFRESH();
        fft_stage1(F);
#ifdef PR_F1
        __syncthreads(); REFRESH();
        fft_stage1(F);
#endif
#endif
#ifndef NO_CP
        REFRESH();
        for (int v = blockIdx.x; v < 512; v += F.G) { const int it = (v < 256) ? v : 256 + ((v + 248) & 255);
            if (it >= (L0() ? 264 : 256)) continue; convpool_item(p, F, l, it); }
#ifdef PR_CP
        __syncthreads(); REFRESH();
        for (int v = blockIdx.x; v < 512; v += F.G) { const int it = (v < 256) ? v : 256 + ((v + 248) & 255);
            if (it >= (L0() ? 264 : 256)) continue; convpool_item(p, F, l, it); }
#endif
#endif
        }
        GSYNC();
#ifdef PROBE_A
        REFRESH(); fft_stage2(F, l);
#endif
#ifndef NO_F2
        REFRESH();
        fft_stage2(F, l);
#ifdef PR_F2
        __syncthreads(); REFRESH();
        fft_stage2(F, l);
#endif
#endif
#ifndef NO_SC
        REFRESH();
        gla_scan(F);
#endif
        GSYNC();
#ifdef PROBE_A
        for (int rep_ = 0; rep_ < 2; ++rep_) {
#else
        {
#endif
#ifndef NO_GC
        REFRESH();
        for (int it = blockIdx.x; it < 256; it += F.G) gla_c_item<2>(p, F, l, it >> 7, 4 + (it & 127), 0);
        if (L0()) for (int j = blockIdx.x; j < 16; j += F.G) gla_c_item<1>(p, F, l, j >> 3, (j >> 1) & 3, j & 1);
        if (L0()) { if (F.G == 256) ctx_dft(F, F.gw - 256, 1 << 30); else ctx_dft(F, F.gw, F.NGW); }
#ifdef PR_GC
        __syncthreads(); REFRESH();
        for (int it = blockIdx.x; it < 256; it += F.G) gla_c_item<2>(p, F, l, it >> 7, 4 + (it & 127), 0);
#endif
#endif
        }
        GSYNC();
#ifndef NO_P6
        REFRESH();
        if (L0()) { pg8::Gemm g{F.YMIX, wout_t(p, l), MT, D, 256, D}; SplitOrder S; S.init(4, F.G, (int)blockIdx.x);
          EpiPartial E{(float*)(p->ws + WS_PART)};
          pg8::gemm_phase<EpiPartial, SplitOrder, false, false>(F.lds, g, S, E, F.tid); __syncthreads(); }
        REFRESH();
        { pg8::Gemm g{F.YMIX, wout_t(p, l), ML, D, D, D}; pg8::StaticOrder S; S.init(ML, D, F.G, (int)blockIdx.x);
          if (L0()) { EpiRes<false, true> E{p->x, p->out, F.MOD + l * 3 * 6144 + 2048}; pg8::gemm_phase<EpiRes<false, true>, pg8::StaticOrder, true, true>(F.lds, g, S, E, F.tid); }
          else if (F.G == 256) { EpiResNorm E{(const bf16*)p->out, (bf16*)(p->ws + WS_XB2), F.HX, F.MOD + l * 3 * 6144 + 2048, p->norm2_g + l * D, F.MOD + l * 3 * 6144, (float*)(p->ws + WS_SLOT) + 65536 * 2, (unsigned*)(p->ws + WS_CTL) + CW_FIN + 4096};
            pg8::gemm_phase<EpiResNorm, pg8::StaticOrder, false, true>(F.lds, g, S, E, F.tid); }
          else { EpiRes<true, true> E{p->out, p->out, F.MOD + l * 3 * 6144 + 2048}; pg8::gemm_phase<EpiRes<true, true>, pg8::StaticOrder, true, true>(F.lds, g, S, E, F.tid); } }
#endif
        GSYNC();
        if (L0() || F.G != 256) { REFRESH(); norm_phase(p, F, l, 1, M6); GSYNC(); }
#ifndef NO_P8
        REFRESH();
        { pg8::Gemm g{F.HX, wup_t(p, l), ML, NUP, D, D}; pg8::StaticOrder S; S.init(ML, NUP, F.G, (int)blockIdx.x);
          EpiUp E{F.ACT, p->ffn_cw + (size_t)l * 3 * DFF, p->ffn_cb + (size_t)l * DFF};
          pg8::gemm_phase<EpiUp, pg8::StaticOrder, true, true>(F.lds, g, S, E, F.tid);
        }
        if (L0()) { REFRESH(); __syncthreads();
          pg8::Gemm g{F.HX, wup_t(p, l), MT, NUP, D, D}; CtxOrder S; S.init(NUP, (int)blockIdx.x, 128);
          EpiUpCtx E{F.ACT, p->ffn_cw + (size_t)l * 3 * DFF, p->ffn_cb + (size_t)l * DFF, (LAS float*)(F.lds + RING_BYTES + 1024)};
          pg8::gemm_phase<EpiUpCtx, CtxOrder, true, false>(F.lds, g, S, E, F.tid); }
#endif
        GSYNC();
#ifndef NO_P9
        REFRESH();
        if (L0()) { pg8::Gemm g{F.ACT, wdn_t(p, l), MT, D, 256, DFF}; SplitOrder S; S.init(11, F.G, (int)blockIdx.x);
          EpiPartial E{(float*)(p->ws + WS_PART)};
          pg8::gemm_phase<EpiPartial, SplitOrder, false, false>(F.lds, g, S, E, F.tid); __syncthreads(); }
        REFRESH();
        { pg8::Gemm g{F.ACT, wdn_t(p, l), ML, D, DFF, DFF}; pg8::StaticOrder S; S.init(ML, D, F.G, (int)blockIdx.x);
          if (L0()) { EpiRes<true, true> E{p->out, p->out, F.MOD + l * 3 * 6144 + 5120}; pg8::gemm_phase<EpiRes<true, true>, pg8::StaticOrder, true, true>(F.lds, g, S, E, F.tid); }
          else if (F.G == 256) { EpiFinal E{(const bf16*)(p->ws + WS_XB2), p->out, F.MOD + l * 3 * 6144 + 5120, p->final_g, (float*)(p->ws + WS_SLOT), (unsigned*)(p->ws + WS_CTL) + CW_FIN};
            pg8::gemm_phase<EpiFinal, pg8::StaticOrder, false, true>(F.lds, g, S, E, F.tid); }
          else { EpiRes<true, false> E{p->out, p->ws + WS_HX, F.MOD + l * 3 * 6144 + 5120}; pg8::gemm_phase<EpiRes<true, false>, pg8::StaticOrder, true, true>(F.lds, g, S, E, F.tid); } }
#endif
        if (L0() || F.G != 256) GSYNC();
    }
        REFRESH();
    if (F.G != 256) final_norm(p, F);
}

extern "C" void kernel_launch(void* const* d_in, const int* in_sizes, int n_in, void* d_out, int out_size, void* d_ws, size_t ws_size, hipStream_t stream) {
    static int grid = 0;
    if (grid == 0) {
        if (n_in != 23 || in_sizes[0] != ML * D || out_size != ML * D || ws_size < WS_END) { fprintf(stderr, "kernel_launch: unexpected shapes / workspace (%d inputs, ws %zu)\n", n_in, ws_size); grid = -1; return; }
        int dev = 0, cus = 0, per_cu = 0;
        hipGetDevice(&dev); hipDeviceGetAttribute(&cus, hipDeviceAttributeMultiprocessorCount, dev);
        if (hipFuncSetAttribute((const void*)fwd_megakernel, hipFuncAttributeMaxDynamicSharedMemorySize, LDS_BYTES) != hipSuccess) { fprintf(stderr, "hipFuncSetAttribute failed\n"); grid = -1; return; }
        if (hipOccupancyMaxActiveBlocksPerMultiprocessor(&per_cu, (const void*)fwd_megakernel, 512, LDS_BYTES) != hipSuccess || per_cu < 1) per_cu = 1;
        (void)hipGetLastError();
        grid = cus * 1;
    }
    if (grid < 0) return;
    if (hipMemsetAsync((char*)d_ws + WS_CTL, 0, 65536, stream) != hipSuccess) { fprintf(stderr, "memset failed\n"); return; }
    Params p{};
    const float** pp = (const float**)&p;
    for (int i = 0; i < 23; ++i) pp[i] = (const float*)d_in[i];
    p.out = (float*)d_out; p.ws = (unsigned char*)d_ws;
    void* args[] = {&p};
    hipError_t e = hipLaunchCooperativeKernel((const void*)fwd_megakernel, dim3(grid), dim3(512), args, LDS_BYTES, stream);
    if (e != hipSuccess) fprintf(stderr, "cooperative launch failed: %s (grid %d)\n", hipGetErrorString(e), grid);
}
```

```cpp
#include <hip/hip_runtime.h>
#include <hip/hip_cooperative_groups.h>
#include <cstdio>
#include <cstdint>
namespace cg = cooperative_groups;
namespace pg8 {
#define PG8_LAS __attribute__((address_space(3)))
typedef unsigned short bf16_t;
typedef short bf16x8 __attribute__((ext_vector_type(8)));
typedef float f32x4 __attribute__((ext_vector_type(4)));
typedef unsigned u32x4 __attribute__((ext_vector_type(4)));
constexpr int BM = 256, BK = 64, HALF = 128, HTB = HALF * BK * 2  , STAGE_BYTES = 8 * HTB, NXCD = 8, WGM = 4;

__host__ __device__ __forceinline__ int lds_byte(int r, int c) { const int st = (r >> 4) * 2 + (c >> 5), rr = r & 15, cc = c & 31, ob = rr * 64 + cc * 2; return st * 1024 + (ob ^ (((ob >> 9) & 1) << 5)); }
__host__ __device__ __forceinline__ void stage_rc(int b, int& R, int& C) { const int st = b / 1024, sb = b % 1024, swz = sb ^ (((sb >> 9) & 1) << 5); R = (st >> 1) * 16 + swz / 64; C = (st & 1) * 32 + (swz % 64) / 2; }
__host__ __device__ __forceinline__ int perm32(int rho) { const int n = rho >> 4, i = rho & 15; return 8 * (i >> 2) + 4 * n + (i & 3); }

struct Unit { int pm, pn, ks; };
struct Gemm { const bf16_t* A; const bf16_t* Bt; int M, N, K, ld; };

struct StaticOrder {
    int nM, nN, nwg, G, c;
    __host__ __device__ void init(int M, int N, int G_, int c_) { nM = M / BM; nN = N / BM; nwg = nM * nN; G = G_; c = c_; }
    __host__ __device__ bool next(int i, Unit& u) const {
        const long L = (long)i * G + c; if (L >= nwg) return false;
        int wgid = (int)L; { const int q = nwg / NXCD, r = nwg % NXCD, xcd = wgid % NXCD, off = wgid / NXCD; wgid = (xcd < r ? xcd * (q + 1) : r * (q + 1) + (xcd - r) * q) + off; }
        const int nig = WGM * nN, gid = wgid / nig, fm = gid * WGM, gsz = (nM - fm) < WGM ? (nM - fm) : WGM;
        u.pm = fm + ((wgid % nig) % gsz); u.pn = (wgid % nig) / gsz; u.ks = 0; return true;
    }
    __device__ __forceinline__ void a_ready(const Unit&) const {}
    __device__ __forceinline__ void done(const Unit&) const {}
};

__device__ __forceinline__ unsigned cvt_pk_bf16(float lo, float hi) { unsigned r; asm volatile("v_cvt_pk_bf16_f32 %0, %1, %2" : "=v"(r) : "v"(lo), "v"(hi)); return r; }
template <class Epi, class Sched, bool ALIGN_EPI = false, bool SP2 = false>
__device__ __forceinline__ void gemm_phase(PG8_LAS unsigned char* lds, const Gemm g, const Sched& S, const Epi& E, int tid_in) {
    int tid_ = tid_in; asm volatile("" : "+v"(tid_)); const int tid = tid_, wid = __builtin_amdgcn_readfirstlane(tid >> 6), lane = tid & 63, wr = wid >> 2, wc = wid & 3, fr = lane & 15, fq = lane >> 4;
    const int K = g.ld, nt = g.K / BK; const size_t sstep = (size_t)g.K * 2;
    unsigned voffA[2], voffB[2];
#pragma unroll
    for (int i = 0; i < 2; ++i) { int R, C; stage_rc(tid * 16 + i * 8192, R, C); const int Rb = Epi::PERM ? ((R & ~31) + perm32(R & 31)) : R;
        voffA[i] = (unsigned)(R * K + C) * 2u; voffB[i] = (unsigned)(Rb * K + C) * 2u; }
    const size_t kstep = (size_t)(BK * 2);
    const size_t hstep = (size_t)HALF * K * 2;
    const size_t tstep = 2 * hstep;
    const unsigned ldsw = (unsigned)wid * 1024u;
    const int aoff = lds_byte(wr * 64 + fr, fq * 8), boff = lds_byte(wc * 32 + fr, fq * 8);
#define PG8_SA(b, h) (((b) * 2 + (h)) * HTB)
#define PG8_SB(b, h) ((4 + (b) * 2 + (h)) * HTB)
#define PG8_STAGE(bufoff, gbase, voff) do { _Pragma("unroll") for (int _i = 0; _i < 2; ++_i) \
        __builtin_amdgcn_global_load_lds((const unsigned*)((const char*)(gbase) + (voff)[_i]), (PG8_LAS unsigned*)(lds + (bufoff) + ldsw + _i * 8192), 16, 0, 0); } while (0)
#define PG8_LDA(dst, b, h) do { _Pragma("unroll") for (int m = 0; m < 4; ++m) _Pragma("unroll") for (int k = 0; k < 2; ++k) dst[m][k] = *(const PG8_LAS bf16x8*)(lds + PG8_SA(b, h) + aoff + m * 2048 + k * 1024); } while (0)
#define PG8_LDB(dst, b, h) do { _Pragma("unroll") for (int n = 0; n < 2; ++n) _Pragma("unroll") for (int k = 0; k < 2; ++k) dst[n][k] = *(const PG8_LAS bf16x8*)(lds + PG8_SB(b, h) + boff + n * 2048 + k * 1024); } while (0)
#define PG8_MMA(ai, bj, At, Bt) do { __builtin_amdgcn_s_setprio(1); _Pragma("unroll") for (int m = 0; m < 4; ++m) _Pragma("unroll") for (int n = 0; n < 2; ++n) _Pragma("unroll") for (int k = 0; k < 2; ++k) \
        acc[ai][bj][m][n] = __builtin_amdgcn_mfma_f32_16x16x32_bf16(Bt[n][k], At[m][k], acc[ai][bj][m][n], 0, 0, 0); __builtin_amdgcn_s_setprio(0); } while (0)
#define PG8_WAIT_V(n) asm volatile("s_waitcnt vmcnt(" #n ")" ::: "memory")
#define PG8_WAIT_L(n) asm volatile("s_waitcnt lgkmcnt(" #n ")" ::: "memory")
#define PG8_BAR __builtin_amdgcn_s_barrier()
#define PG8_SCHED __builtin_amdgcn_sched_barrier(0)
    Unit cur, nxt; int ui = 0;
    if (!S.next(0, cur)) return;
    f32x4 acc[2][2][4][2];
#pragma unroll
    for (int a = 0; a < 2; ++a)
#pragma unroll
        for (int b = 0; b < 2; ++b)
#pragma unroll
            for (int m = 0; m < 4; ++m)
#pragma unroll
                for (int n = 0; n < 2; ++n) acc[a][b][m][n] = (f32x4){0.f, 0.f, 0.f, 0.f};
    bf16x8 At[4][2], B0[2][2], B1[2][2];
    const char* cA = (const char*)g.A + (size_t)cur.pm * tstep + (size_t)cur.ks * sstep; const char* cB = (const char*)g.Bt + (size_t)cur.pn * tstep + (size_t)cur.ks * sstep;
    S.a_ready(cur);
    if constexpr (SP2) {
        PG8_STAGE(PG8_SB(0, 0), cB, voffB); PG8_STAGE(PG8_SB(0, 1), cB + hstep, voffB); PG8_STAGE(PG8_SA(0, 0), cA, voffA); PG8_STAGE(PG8_SA(0, 1), cA + hstep, voffA);
        if (wr == 1) PG8_BAR;
        PG8_WAIT_V(2); PG8_BAR;
        PG8_STAGE(PG8_SB(1, 0), cB + kstep, voffB); PG8_STAGE(PG8_SA(1, 0), cA + kstep, voffA); PG8_STAGE(PG8_SB(1, 1), cB + hstep + kstep, voffB);
        PG8_WAIT_V(6); PG8_BAR;
    } else {
        PG8_STAGE(PG8_SB(0, 0), cB, voffB); PG8_STAGE(PG8_SA(0, 0), cA, voffA); PG8_STAGE(PG8_SB(0, 1), cB + hstep, voffB); PG8_STAGE(PG8_SA(0, 1), cA + hstep, voffA);
        if (wr == 1) PG8_BAR;
        PG8_WAIT_V(4); PG8_BAR;
        PG8_STAGE(PG8_SB(1, 0), cB + kstep, voffB); PG8_STAGE(PG8_SA(1, 0), cA + kstep, voffA); PG8_STAGE(PG8_SB(1, 1), cB + hstep + kstep, voffB);
        PG8_WAIT_V(6); PG8_BAR;
    }
    for (;;) {
        const bool has_next = S.next(ui + 1, nxt);
        const char* nA = has_next ? (const char*)g.A + (size_t)nxt.pm * tstep + (size_t)nxt.ks * sstep : cA; const char* nB = has_next ? (const char*)g.Bt + (size_t)nxt.pn * tstep + (size_t)nxt.ks * sstep : cB;
        for (int t = 0; t < nt; t += 2) {
            const bool last = (t == nt - 2);
            const char* a1 = cA + (size_t)(t + 1) * kstep;
            const char* a2 = last ? nA : cA + (size_t)(t + 2) * kstep; const char* b2 = last ? nB : cB + (size_t)(t + 2) * kstep;
            const char* a3 = a2 + kstep; const char* b3 = b2 + kstep;
            if (last && has_next) S.a_ready(nxt);
            if constexpr (SP2) {
            PG8_LDB(B0, 0, 0); PG8_LDB(B1, 0, 1); PG8_SCHED; PG8_LDA(At, 0, 0); PG8_STAGE(PG8_SA(1, 1), a1 + hstep, voffA);
            PG8_WAIT_V(8); PG8_WAIT_L(0); PG8_BAR; PG8_MMA(0, 0, At, B0); PG8_MMA(0, 1, At, B1); PG8_BAR; PG8_SCHED;
            PG8_LDA(At, 0, 1); PG8_STAGE(PG8_SB(0, 0), b2, voffB); PG8_STAGE(PG8_SB(0, 1), b2 + hstep, voffB); PG8_STAGE(PG8_SA(0, 0), a2, voffA);
            PG8_WAIT_V(8); PG8_WAIT_L(0); PG8_BAR; PG8_MMA(1, 0, At, B0); PG8_MMA(1, 1, At, B1); PG8_BAR; PG8_SCHED;
            PG8_LDB(B0, 1, 0); PG8_LDB(B1, 1, 1); PG8_SCHED; PG8_LDA(At, 1, 0); PG8_STAGE(PG8_SA(0, 1), a2 + hstep, voffA);
            PG8_WAIT_V(8); PG8_WAIT_L(0); PG8_BAR; PG8_MMA(0, 0, At, B0); PG8_MMA(0, 1, At, B1); PG8_BAR; PG8_SCHED;
            PG8_LDA(At, 1, 1); PG8_STAGE(PG8_SB(1, 0), b3, voffB); PG8_STAGE(PG8_SB(1, 1), b3 + hstep, voffB); PG8_STAGE(PG8_SA(1, 0), a3, voffA);
            PG8_WAIT_V(8); PG8_WAIT_L(0); PG8_BAR; PG8_MMA(1, 0, At, B0); PG8_MMA(1, 1, At, B1); PG8_BAR; PG8_SCHED;
            } else {
            PG8_LDB(B0, 0, 0); PG8_SCHED; PG8_LDA(At, 0, 0); PG8_STAGE(PG8_SA(1, 1), a1 + hstep, voffA);
            PG8_WAIT_L(8); PG8_BAR; PG8_WAIT_L(0); PG8_MMA(0, 0, At, B0); PG8_BAR; PG8_SCHED;
            PG8_LDB(B1, 0, 1); PG8_STAGE(PG8_SB(0, 0), b2, voffB);
            PG8_BAR; PG8_WAIT_L(0); PG8_MMA(0, 1, At, B1); PG8_BAR;
            PG8_LDA(At, 0, 1); PG8_STAGE(PG8_SA(0, 0), a2, voffA);
            PG8_BAR; PG8_WAIT_L(0); PG8_MMA(1, 0, At, B0); PG8_BAR; PG8_SCHED;
            PG8_STAGE(PG8_SB(0, 1), b2 + hstep, voffB);
            PG8_WAIT_V(6); PG8_BAR; PG8_MMA(1, 1, At, B1); PG8_BAR;
            PG8_LDB(B0, 1, 0); PG8_SCHED; PG8_LDA(At, 1, 0); PG8_STAGE(PG8_SA(0, 1), a2 + hstep, voffA);
            PG8_WAIT_L(8); PG8_BAR; PG8_WAIT_L(0); PG8_MMA(0, 0, At, B0); PG8_BAR; PG8_SCHED;
            PG8_LDB(B1, 1, 1); PG8_STAGE(PG8_SB(1, 0), b3, voffB);
            PG8_BAR; PG8_WAIT_L(0); PG8_MMA(0, 1, At, B1); PG8_BAR;
            PG8_LDA(At, 1, 1); PG8_STAGE(PG8_SA(1, 0), a3, voffA);
            PG8_BAR; PG8_WAIT_L(0); PG8_MMA(1, 0, At, B0); PG8_BAR; PG8_SCHED;
            PG8_STAGE(PG8_SB(1, 1), b3 + hstep, voffB);
            PG8_WAIT_V(6); PG8_BAR; PG8_MMA(1, 1, At, B1); PG8_BAR;
            }
        }
        if constexpr (ALIGN_EPI) { if (wr == 0) PG8_BAR; }
        if constexpr (!Epi::AFTER_DRAIN) { E(acc, cur, wr, wc, fr, fq); S.done(cur); }
        if (!has_next) break;
#pragma unroll
        for (int a = 0; a < 2; ++a)
#pragma unroll
            for (int b = 0; b < 2; ++b)
#pragma unroll
                for (int m = 0; m < 4; ++m)
#pragma unroll
                    for (int n = 0; n < 2; ++n) acc[a][b][m][n] = (f32x4){0.f, 0.f, 0.f, 0.f};
        cur = nxt; cA = nA; cB = nB; ++ui;
        if constexpr (ALIGN_EPI) { if (wr == 1) PG8_BAR; }
    }
    PG8_WAIT_V(0);
    if constexpr (!ALIGN_EPI) { if (wr == 0) PG8_BAR; }
    PG8_BAR;
    if constexpr (Epi::AFTER_DRAIN) { E.fused(acc, cur, wr, wc, fr, fq, lds, wid, lane); S.done(cur); }
#undef PG8_SA
#undef PG8_SB
#undef PG8_STAGE
#undef PG8_LDA
#undef PG8_LDB
#undef PG8_MMA
#undef PG8_WAIT_V
#undef PG8_WAIT_L
#undef PG8_BAR
#undef PG8_SCHED
}
}
#define LAS __attribute__((address_space(3)))
typedef unsigned short bf16;
typedef float f32x4 __attribute__((ext_vector_type(4)));
typedef short bf16x8 __attribute__((ext_vector_type(8)));
typedef unsigned u32x4 __attribute__((ext_vector_type(4)));
typedef unsigned u32x2 __attribute__((ext_vector_type(2)));
#define LDS_WAIT() asm volatile("s_waitcnt lgkmcnt(0)" ::: "memory")

constexpr int D = 1024, SEQ = 8192, ML = 16384, MC = 512, MT = ML + MC, CTXL = 256;
constexpr int DIN = 2080, NP = 2560, DFF = 2816, NUP = 5632;
constexpr int PK = 0, PQ = 128, PV = 256, PLA = 512, PG = 768, PFA = 1024, PFB = 1280, PH = 1536, PBG = 1792, PCG = 2048, PPOOL = 2304;
constexpr int NCH = 132;
constexpr float EPS = 1e-6f;
constexpr size_t MiB = 1u << 20;
constexpr size_t WS_CTL = 0;
constexpr size_t WS_MOD = 1 * MiB;
constexpr size_t WS_MCS = 1 * MiB + 256 * 1024;
constexpr size_t WS_F1 = 1 * MiB + 512 * 1024;
constexpr size_t WS_F2 = WS_F1 + 32 * 1024;
constexpr size_t WS_FC = WS_F2 + 64 * 1024;
constexpr size_t WS_SLOT = 49 * MiB;
constexpr size_t WS_XB2 = 208 * MiB;
constexpr int CW_FIN = 3584;
constexpr size_t WS_W = 2 * MiB;
constexpr size_t W_IN_B = (size_t)NP * D * 2, W_OUT_B = (size_t)D * D * 2, W_UP_B = (size_t)NUP * D * 2, W_DN_B = (size_t)D * DFF * 2;
constexpr size_t W_LAYER_B = W_IN_B + W_OUT_B + W_UP_B + W_DN_B;
constexpr size_t WS_HX = 50 * MiB;
constexpr size_t WS_YMIX = 83 * MiB;
constexpr size_t WS_P = 116 * MiB;
constexpr size_t WS_XC = 207 * MiB;
constexpr size_t WS_ST = 209 * MiB;
constexpr size_t WS_DEC = 226 * MiB;
constexpr size_t WS_CAU = 227 * MiB;
constexpr size_t WS_PART = 233 * MiB;
constexpr size_t WS_END = 255 * MiB;
static_assert(WS_W + 2 * W_LAYER_B <= WS_HX, "weights");
static_assert(WS_P + (size_t)MT * DFF * 2 <= WS_XC, "act");
constexpr int RING_BYTES = 131072, LDS_BYTES = 147456;

struct Params {
    const float *x, *c, *ctx, *c_ctx, *norm1_g, *norm2_g, *w_mod, *b_mod, *w_in, *w_a2, *b_a2, *gla_g, *fft_w, *conv_w, *conv_b, *pool_w,
        *pool_scale, *w_out, *w_up, *ffn_cw, *ffn_cb, *w_down, *final_g;
    float* out; unsigned char* ws;
};

typedef const __attribute__((address_space(4))) Params* PP;
__device__ __forceinline__ unsigned f2bf(float f) { unsigned u = __builtin_bit_cast(unsigned, f); return (u + 0x7fffu + ((u >> 16) & 1u)) >> 16; }
__device__ __forceinline__ unsigned pk2(float lo, float hi) { return f2bf(lo) | (f2bf(hi) << 16); }
__device__ __forceinline__ float bf2f(unsigned h) { return __builtin_bit_cast(float, h << 16); }
__device__ __forceinline__ float bflo(unsigned w) { return __builtin_bit_cast(float, w << 16); }
__device__ __forceinline__ float bfhi(unsigned w) { return __builtin_bit_cast(float, w & 0xffff0000u); }
__device__ __forceinline__ float shfl_f(float v, int src_lane) { return __builtin_bit_cast(float, __builtin_amdgcn_ds_bpermute(src_lane << 2, __builtin_bit_cast(int, v))); }
__device__ __forceinline__ float wave_sum(float v, int lane) {
#pragma unroll
    for (int o = 1; o < 64; o <<= 1) v += shfl_f(v, lane ^ o);
    return v;
}
__device__ __forceinline__ float silu_f(float x) { return x * __builtin_amdgcn_rcpf(1.f + __expf(-x)); }
__device__ __forceinline__ float cos_rev(float r) { return __builtin_amdgcn_cosf(r); }
__device__ __forceinline__ float sin_rev(float r) { return __builtin_amdgcn_sinf(r); }
__device__ __forceinline__ bf16x8 pack8(float a0, float a1, float a2, float a3, float a4, float a5, float a6, float a7) {
    u32x4 w; w.x = pk2(a0, a1); w.y = pk2(a2, a3); w.z = pk2(a4, a5); w.w = pk2(a6, a7); return __builtin_bit_cast(bf16x8, w);
}
#define MFMA16(a, b, c) __builtin_amdgcn_mfma_f32_16x16x32_bf16(a, b, c, 0, 0, 0)

struct EpiP {
    static constexpr bool PERM = true, AFTER_DRAIN = false;
    bf16* O; const float* ba2;
    __device__ __forceinline__ void operator()(const pg8::f32x4 (&acc)[2][2][4][2], const pg8::Unit& u, int wr, int wc, int fr, int fq) const {
        const int row0 = u.pm * 256 + wr * 64 + fr, col0 = u.pn * 256 + wc * 32 + 8 * fq;
        const __amdgpu_buffer_rsrc_t prs = __builtin_amdgcn_make_buffer_rsrc(O, 0, MT * NP * 2, 0x00020000);
        const bool la = (u.pn == 2);
#pragma unroll
        for (int ai = 0; ai < 2; ++ai)
#pragma unroll
            for (int m = 0; m < 4; ++m) { bf16* rowp = O + (size_t)(row0 + ai * 128 + m * 16) * NP + col0;
#pragma unroll
                for (int bj = 0; bj < 2; ++bj) { pg8::f32x4 v0 = acc[ai][bj][m][0], v1 = acc[ai][bj][m][1];
                    if (la) { const float* bp = ba2 + (col0 + bj * 128 - PLA); const f32x4 b0 = *(const f32x4*)bp, b1 = *(const f32x4*)(bp + 4);
#pragma unroll
                        for (int e = 0; e < 4; ++e) { float xa = v0[e] + b0[e], xb = v1[e] + b1[e];
                            v0[e] = (fminf(xa, 0.f) - __logf(1.f + __expf(-fabsf(xa)))) * 0.0625f; v1[e] = (fminf(xb, 0.f) - __logf(1.f + __expf(-fabsf(xb)))) * 0.0625f; } }
                    u32x4 w; w.x = pg8::cvt_pk_bf16(v0[0], v0[1]); w.y = pg8::cvt_pk_bf16(v0[2], v0[3]); w.z = pg8::cvt_pk_bf16(v1[0], v1[1]); w.w = pg8::cvt_pk_bf16(v1[2], v1[3]);
                    __builtin_amdgcn_raw_buffer_store_b128(w, prs, (unsigned)(((row0 + ai * 128 + m * 16) * NP + col0 + bj * 128) * 2), 0, 16); } }
    }
};
template <bool INB, bool OUTB>
struct EpiRes {
    static constexpr bool PERM = true, AFTER_DRAIN = false;
    const void* xin; void* out; const float* modg;
    __device__ __forceinline__ void operator()(const pg8::f32x4 (&acc)[2][2][4][2], const pg8::Unit& u, int wr, int wc, int fr, int fq) const {
        const int w = u.pm >> 5; const int cb = u.pn * 256 + wc * 32 + 8 * fq;
        f32x4 gv[2][2];
#pragma unroll
        for (int bj = 0; bj < 2; ++bj)
#pragma unroll
            for (int n = 0; n < 2; ++n) gv[bj][n] = *(const f32x4*)(modg + w * 6144 + cb + bj * 128 + 4 * n);
        constexpr int RG = INB ? 4 : 2;
#pragma unroll
        for (int ai = 0; ai < 2; ++ai)
#pragma unroll
            for (int mp = 0; mp < 4 / RG; ++mp) {
                u32x4 xb[RG][2]; f32x4 xf[INB ? 1 : RG][2][2];
#pragma unroll
                for (int mm = 0; mm < RG; ++mm) { const size_t ro = (size_t)(u.pm * 256 + ai * 128 + wr * 64 + (RG * mp + mm) * 16 + fr) * D + cb;
#pragma unroll
                    for (int bj = 0; bj < 2; ++bj) {
                        if (INB) xb[mm][bj] = *(const u32x4*)((const bf16*)xin + ro + bj * 128);
                        else { xf[INB ? 0 : mm][bj][0] = __builtin_nontemporal_load((const f32x4*)((const float*)xin + ro + bj * 128)); xf[INB ? 0 : mm][bj][1] = __builtin_nontemporal_load((const f32x4*)((const float*)xin + ro + bj * 128 + 4)); } } }
#pragma unroll
                for (int mm = 0; mm < RG; ++mm) { const int m = RG * mp + mm; const size_t ro = (size_t)(u.pm * 256 + ai * 128 + wr * 64 + m * 16 + fr) * D + cb;
#pragma unroll
                    for (int bj = 0; bj < 2; ++bj) { f32x4 x0, x1;
                        if (INB) { const u32x4 t = xb[mm][bj]; x0 = (f32x4){bflo(t.x), bfhi(t.x), bflo(t.y), bfhi(t.y)}; x1 = (f32x4){bflo(t.z), bfhi(t.z), bflo(t.w), bfhi(t.w)}; }
                        else { x0 = xf[INB ? 0 : mm][bj][0]; x1 = xf[INB ? 0 : mm][bj][1]; }
                        const pg8::f32x4 a0 = acc[ai][bj][m][0], a1 = acc[ai][bj][m][1]; const f32x4 g0 = gv[bj][0], g1 = gv[bj][1];
                        f32x4 y0, y1;
#pragma unroll
                        for (int e = 0; e < 4; ++e) { y0[e] = x0[e] + g0[e] * a0[e]; y1[e] = x1[e] + g1[e] * a1[e]; }
                        if (OUTB) { u32x4 pk; pk.x = pg8::cvt_pk_bf16(y0[0], y0[1]); pk.y = pg8::cvt_pk_bf16(y0[2], y0[3]); pk.z = pg8::cvt_pk_bf16(y1[0], y1[1]); pk.w = pg8::cvt_pk_bf16(y1[2], y1[3]);
                            *(u32x4*)((bf16*)out + ro + bj * 128) = pk; }
                        else { *(f32x4*)((float*)out + ro + bj * 128) = y0; *(f32x4*)((float*)out + ro + bj * 128 + 4) = y1; } } }
            }
    }
};
template <bool STORE_X>
__device__ __forceinline__ void panel_rms(pg8::f32x4 (&acc)[2][2][4][2], const pg8::Unit& u, int wr, int wc, int fr, int fq, LAS unsigned char* lds, int wid, int lane,
                                          const bf16* xin, bf16* xout, const float* modg, float* slots, unsigned* cnt) {
    const int w = u.pm >> 5; const int cb = u.pn * 256 + wc * 32 + 8 * fq;
    LAS float* P = (LAS float*)lds;
    LAS float* S = (LAS float*)(lds + 4096);
    f32x4 gv[2][2];
#pragma unroll
    for (int bj = 0; bj < 2; ++bj)
#pragma unroll
        for (int n = 0; n < 2; ++n) gv[bj][n] = *(const f32x4*)(modg + w * 6144 + cb + bj * 128 + 4 * n);
#pragma unroll
    for (int ai = 0; ai < 2; ++ai) {
        u32x4 xb[4][2];
#pragma unroll
        for (int m = 0; m < 4; ++m) { const size_t ro = (size_t)(u.pm * 256 + ai * 128 + wr * 64 + m * 16 + fr) * D + cb;
#pragma unroll
            for (int bj = 0; bj < 2; ++bj) xb[m][bj] = *(const u32x4*)(xin + ro + bj * 128); }
#pragma unroll
        for (int m = 0; m < 4; ++m) { float sq = 0.f; const size_t ro = (size_t)(u.pm * 256 + ai * 128 + wr * 64 + m * 16 + fr) * D + cb;
#pragma unroll
            for (int bj = 0; bj < 2; ++bj) { const u32x4 t = xb[m][bj]; const f32x4 g0 = gv[bj][0], g1 = gv[bj][1]; pg8::f32x4 a0 = acc[ai][bj][m][0], a1 = acc[ai][bj][m][1];
                a0[0] = bflo(t.x) + g0[0] * a0[0]; a0[1] = bfhi(t.x) + g0[1] * a0[1]; a0[2] = bflo(t.y) + g0[2] * a0[2]; a0[3] = bfhi(t.y) + g0[3] * a0[3];
                a1[0] = bflo(t.z) + g1[0] * a1[0]; a1[1] = bfhi(t.z) + g1[1] * a1[1]; a1[2] = bflo(t.w) + g1[2] * a1[2]; a1[3] = bfhi(t.w) + g1[3] * a1[3];
                acc[ai][bj][m][0] = a0; acc[ai][bj][m][1] = a1;
                sq += ((a0[0] * a0[0] + a0[1] * a0[1]) + (a0[2] * a0[2] + a0[3] * a0[3])) + ((a1[0] * a1[0] + a1[1] * a1[1]) + (a1[2] * a1[2] + a1[3] * a1[3]));
                if (STORE_X) { u32x4 pk; pk.x = pg8::cvt_pk_bf16(a0[0], a0[1]); pk.y = pg8::cvt_pk_bf16(a0[2], a0[3]); pk.z = pg8::cvt_pk_bf16(a1[0], a1[1]); pk.w = pg8::cvt_pk_bf16(a1[2], a1[3]);
                    *(u32x4*)(xout + ro + bj * 128) = pk; } }
            sq += shfl_f(sq, lane ^ 16); sq += shfl_f(sq, lane ^ 32);
            if (fq == 0) P[(ai * 128 + wr * 64 + m * 16 + fr) * 4 + wc] = sq; }
    }
    asm volatile("s_waitcnt lgkmcnt(0)" ::: "memory"); __builtin_amdgcn_s_barrier(); asm volatile("" ::: "memory");
    const int row = wid * 32 + (lane & 31);
    if (lane < 32) { const float t = (P[row * 4 + 0] + P[row * 4 + 1]) + (P[row * 4 + 2] + P[row * 4 + 3]);
        __hip_atomic_store(slots + ((size_t)(u.pm * 256 + row) * 4 + u.pn), t, __ATOMIC_RELAXED, __HIP_MEMORY_SCOPE_AGENT); }
    asm volatile("s_waitcnt vmcnt(0)" ::: "memory");
    if (lane == 0) (void)__hip_atomic_fetch_add(cnt + 64 * u.pm, 1u, __ATOMIC_RELAXED, __HIP_MEMORY_SCOPE_AGENT);
    if (wid == 0) { unsigned sp = 0;
        while ((unsigned)__builtin_amdgcn_readfirstlane((int)__hip_atomic_load(cnt + 64 * u.pm, __ATOMIC_RELAXED, __HIP_MEMORY_SCOPE_AGENT)) < 32u) { __builtin_amdgcn_s_sleep(2); if (++sp > (1u << 22)) break; }
        __builtin_amdgcn_fence(__ATOMIC_ACQUIRE, "agent"); }
    asm volatile("s_waitcnt vmcnt(0) lgkmcnt(0)" ::: "memory"); __builtin_amdgcn_s_barrier(); asm volatile("" ::: "memory");
    if (lane < 32) { const float* sl = slots + (size_t)(u.pm * 256 + row) * 4; float t = 0.f;
#pragma unroll
        for (int q = 0; q < 4; ++q) t += __hip_atomic_load(sl + q, __ATOMIC_RELAXED, __HIP_MEMORY_SCOPE_AGENT);
        S[row] = 1.f / sqrtf(t * (1.f / D) + EPS); }
    asm volatile("s_waitcnt vmcnt(0) lgkmcnt(0)" ::: "memory"); __builtin_amdgcn_s_barrier(); asm volatile("" ::: "memory");
}
struct EpiFinal {
    static constexpr bool PERM = true, AFTER_DRAIN = true;
    const bf16* xin; float* out; const float* modg; const float* gfin; float* slots; unsigned* cnt;
    __device__ __forceinline__ void fused(pg8::f32x4 (&acc)[2][2][4][2], const pg8::Unit& u, int wr, int wc, int fr, int fq, LAS unsigned char* lds, int wid, int lane) const {
        panel_rms<false>(acc, u, wr, wc, fr, fq, lds, wid, lane, xin, nullptr, modg, slots, cnt);
        const LAS float* S = (const LAS float*)(lds + 4096); const int cb = u.pn * 256 + wc * 32 + 8 * fq;
        f32x4 gf[2][2];
#pragma unroll
        for (int bj = 0; bj < 2; ++bj)
#pragma unroll
            for (int n = 0; n < 2; ++n) gf[bj][n] = *(const f32x4*)(gfin + cb + bj * 128 + 4 * n);
#pragma unroll
        for (int ai = 0; ai < 2; ++ai)
#pragma unroll
            for (int m = 0; m < 4; ++m) { const int r = ai * 128 + wr * 64 + m * 16 + fr; const float rs = S[r]; float* o = out + (size_t)(u.pm * 256 + r) * D + cb;
#pragma unroll
                for (int bj = 0; bj < 2; ++bj)
#pragma unroll
                    for (int n = 0; n < 2; ++n) { const pg8::f32x4 a = acc[ai][bj][m][n]; const f32x4 g4 = gf[bj][n];
                        *(f32x4*)(o + bj * 128 + 4 * n) = (f32x4){a[0] * rs * g4[0], a[1] * rs * g4[1], a[2] * rs * g4[2], a[3] * rs * g4[3]}; } }
    }
};
struct EpiResNorm {
    static constexpr bool PERM = true, AFTER_DRAIN = true;
    const bf16* xin; bf16* xout; bf16* hout; const float* modg; const float* gn; const float* modn; float* slots; unsigned* cnt;
    __device__ __forceinline__ void fused(pg8::f32x4 (&acc)[2][2][4][2], const pg8::Unit& u, int wr, int wc, int fr, int fq, LAS unsigned char* lds, int wid, int lane) const {
        panel_rms<true>(acc, u, wr, wc, fr, fq, lds, wid, lane, xin, xout, modg, slots, cnt);
        const LAS float* S = (const LAS float*)(lds + 4096); const int w = u.pm >> 5; const int cb = u.pn * 256 + wc * 32 + 8 * fq;
        f32x4 gm[2][2], shv[2][2];
#pragma unroll
        for (int bj = 0; bj < 2; ++bj)
#pragma unroll
            for (int n = 0; n < 2; ++n) { const int c = cb + bj * 128 + 4 * n; const f32x4 g4 = *(const f32x4*)(gn + c), s4 = *(const f32x4*)(modn + w * 6144 + 4096 + c);
                shv[bj][n] = *(const f32x4*)(modn + w * 6144 + 3072 + c); gm[bj][n] = (f32x4){g4[0] * (1.f + s4[0]), g4[1] * (1.f + s4[1]), g4[2] * (1.f + s4[2]), g4[3] * (1.f + s4[3])}; }
#pragma unroll
        for (int ai = 0; ai < 2; ++ai)
#pragma unroll
            for (int m = 0; m < 4; ++m) { const int r = ai * 128 + wr * 64 + m * 16 + fr; const float rs = S[r]; bf16* o = hout + (size_t)(u.pm * 256 + r) * D + cb;
#pragma unroll
                for (int bj = 0; bj < 2; ++bj) { const pg8::f32x4 a0 = acc[ai][bj][m][0], a1 = acc[ai][bj][m][1]; const f32x4 g0 = gm[bj][0], g1 = gm[bj][1], h0 = shv[bj][0], h1 = shv[bj][1];
                    u32x4 pk; pk.x = pg8::cvt_pk_bf16(a0[0] * rs * g0[0] + h0[0], a0[1] * rs * g0[1] + h0[1]); pk.y = pg8::cvt_pk_bf16(a0[2] * rs * g0[2] + h0[2], a0[3] * rs * g0[3] + h0[3]);
                    pk.z = pg8::cvt_pk_bf16(a1[0] * rs * g1[0] + h1[0], a1[1] * rs * g1[1] + h1[1]); pk.w = pg8::cvt_pk_bf16(a1[2] * rs * g1[2] + h1[2], a1[3] * rs * g1[3] + h1[3]);
                    *(u32x4*)(o + bj * 128) = pk; } }
    }
};
struct EpiUp {
    static constexpr bool PERM = true, AFTER_DRAIN = false;
    bf16* ACT; const float* cw; const float* cb;
    __device__ __forceinline__ void operator()(const pg8::f32x4 (&acc)[2][2][4][2], const pg8::Unit& u, int wr, int wc, int fr, int fq) const {
        const int hc0 = u.pn * 128 + wc * 32 + 8 * fq;
        const __amdgpu_buffer_rsrc_t ars = __builtin_amdgcn_make_buffer_rsrc(ACT, 0, MT * DFF * 2, 0x00020000);
#pragma unroll
        for (int ai = 0; ai < 2; ++ai) { const int blk = ai * 2 + wr;
            float res[4][8];
#pragma unroll
            for (int n = 0; n < 2; ++n) {
                const f32x4 w0 = *(const f32x4*)(cw + hc0 + 4 * n), w1 = *(const f32x4*)(cw + DFF + hc0 + 4 * n), w2 = *(const f32x4*)(cw + 2 * DFF + hc0 + 4 * n), bb = *(const f32x4*)(cb + hc0 + 4 * n);
#pragma unroll
                for (int e = 0; e < 4; ++e) {
                    float xs[4], ps[4], ns[4]; const float bprev = 0.f, bnext = 0.f;
#pragma unroll
                    for (int m = 0; m < 4; ++m) { xs[m] = acc[ai][0][m][n][e]; ps[m] = __builtin_bit_cast(float, __builtin_amdgcn_update_dpp(0, __builtin_bit_cast(int, xs[m]), 0x121, 0xf, 0xf, false)); ns[m] = __builtin_bit_cast(float, __builtin_amdgcn_update_dpp(0, __builtin_bit_cast(int, xs[m]), 0x12f, 0xf, 0xf, false)); }
#pragma unroll
                    for (int m = 0; m < 4; ++m) {
                        const float oldp = (m > 0) ? ps[m > 0 ? m - 1 : 0] : bprev, oldn = (m < 3) ? ns[m < 3 ? m + 1 : 3] : bnext;
                        const float prev = __builtin_bit_cast(float, __builtin_amdgcn_update_dpp(__builtin_bit_cast(int, oldp), __builtin_bit_cast(int, xs[m]), 0x111, 0xf, 0xf, false));
                        const float next = __builtin_bit_cast(float, __builtin_amdgcn_update_dpp(__builtin_bit_cast(int, oldn), __builtin_bit_cast(int, xs[m]), 0x101, 0xf, 0xf, false));
                        const float a = w0[e] * prev + w1[e] * xs[m] + w2[e] * next + bb[e];
                        res[m][4 * n + e] = silu_f(a) * acc[ai][1][m][n][e];
                    }
                }
            }
#pragma unroll
            for (int m = 0; m < 4; ++m) { const int r = u.pm * 256 + ai * 128 + wr * 64 + m * 16 + fr;
                u32x4 w; w.x = pg8::cvt_pk_bf16(res[m][0], res[m][1]); w.y = pg8::cvt_pk_bf16(res[m][2], res[m][3]); w.z = pg8::cvt_pk_bf16(res[m][4], res[m][5]); w.w = pg8::cvt_pk_bf16(res[m][6], res[m][7]);
                __builtin_amdgcn_raw_buffer_store_b128(w, ars, (unsigned)((r * DFF + hc0) * 2), 0, 16); }
        }
    }
};
struct EpiUpCtx {
    static constexpr bool PERM = true, AFTER_DRAIN = false;
    bf16* ACT; const float* cw; const float* cb; LAS float* ex;
    __device__ __forceinline__ void operator()(const pg8::f32x4 (&acc)[2][2][4][2], const pg8::Unit& u, int wr, int wc, int fr, int fq) const {
        const int hc0 = u.pn * 128 + wc * 32 + 8 * fq;
            const int colw = wc * 32 + 8 * fq;
#pragma unroll
            for (int ai = 0; ai < 2; ++ai) { const int blk = ai * 2 + wr;
                if (fr == 0) {
#pragma unroll
                    for (int n = 0; n < 2; ++n)
#pragma unroll
                        for (int e = 0; e < 4; ++e) ex[(blk * 2 + 0) * 128 + colw + 4 * n + e] = acc[ai][0][0][n][e]; }
                if (fr == 15) {
#pragma unroll
                    for (int n = 0; n < 2; ++n)
#pragma unroll
                        for (int e = 0; e < 4; ++e) ex[(blk * 2 + 1) * 128 + colw + 4 * n + e] = acc[ai][0][3][n][e]; } }
            asm volatile("s_waitcnt lgkmcnt(0)" ::: "memory"); __builtin_amdgcn_s_barrier(); asm volatile("" ::: "memory");
#pragma unroll
            for (int ai = 0; ai < 2; ++ai) { const int blk = ai * 2 + wr;
                float res[4][8];
    #pragma unroll
                for (int n = 0; n < 2; ++n) {
                    const f32x4 w0 = *(const f32x4*)(cw + hc0 + 4 * n), w1 = *(const f32x4*)(cw + DFF + hc0 + 4 * n), w2 = *(const f32x4*)(cw + 2 * DFF + hc0 + 4 * n), bb = *(const f32x4*)(cb + hc0 + 4 * n);
    #pragma unroll
                    for (int e = 0; e < 4; ++e) {
                        float xs[4], ps[4], ns[4]; float bprev = 0.f, bnext = 0.f; if (blk > 0) bprev = ex[((blk - 1) * 2 + 1) * 128 + colw + 4 * n + e]; if (blk < 3) bnext = ex[((blk + 1) * 2 + 0) * 128 + colw + 4 * n + e];
    #pragma unroll
                        for (int m = 0; m < 4; ++m) { xs[m] = acc[ai][0][m][n][e]; ps[m] = __builtin_bit_cast(float, __builtin_amdgcn_update_dpp(0, __builtin_bit_cast(int, xs[m]), 0x121, 0xf, 0xf, false)); ns[m] = __builtin_bit_cast(float, __builtin_amdgcn_update_dpp(0, __builtin_bit_cast(int, xs[m]), 0x12f, 0xf, 0xf, false)); }
    #pragma unroll
                        for (int m = 0; m < 4; ++m) {
                            const float prev = (fr > 0) ? ps[m] : (m > 0 ? ps[m > 0 ? m - 1 : 0] : bprev);
                            const float next = (fr < 15) ? ns[m] : (m < 3 ? ns[m < 3 ? m + 1 : 3] : bnext);
                            const float a = w0[e] * prev + w1[e] * xs[m] + w2[e] * next + bb[e];
                            res[m][4 * n + e] = silu_f(a) * acc[ai][1][m][n][e];
                        }
                    }
                }
    #pragma unroll
                for (int m = 0; m < 4; ++m) { const int r = u.pm * 256 + ai * 128 + wr * 64 + m * 16 + fr;
                    u32x4 w; w.x = pg8::cvt_pk_bf16(res[m][0], res[m][1]); w.y = pg8::cvt_pk_bf16(res[m][2], res[m][3]); w.z = pg8::cvt_pk_bf16(res[m][4], res[m][5]); w.w = pg8::cvt_pk_bf16(res[m][6], res[m][7]);
                    *(u32x4*)(ACT + (size_t)r * DFF + hc0) = w; }
            }

    }
};
struct CtxOrder {
    int nN, c, c0;
    __device__ void init(int N, int c_, int c0_) { nN = N / 256; c = c_; c0 = c0_; }
    __device__ bool next(int i, pg8::Unit& u) const { const int j = c - c0; if (i > 0 || j < 0 || j >= 2 * nN) return false; u.pm = 64 + (j & 1); u.pn = j >> 1; u.ks = 0; return true; }
    __device__ __forceinline__ void a_ready(const pg8::Unit&) const {}
    __device__ __forceinline__ void done(const pg8::Unit&) const {}
};

struct SplitOrder {
    int nunits, G, c;
    __device__ void init(int nks, int G_, int c_) { nunits = 8 * nks; G = G_; c = c_; }
    __device__ bool next(int i, pg8::Unit& u) const { const int id = i * G + c; if (id >= nunits) return false; u.pm = 64 + (id & 1); u.pn = (id >> 1) & 3; u.ks = id >> 3; return true; }
    __device__ __forceinline__ void a_ready(const pg8::Unit&) const {}
    __device__ __forceinline__ void done(const pg8::Unit&) const {}
};
struct EpiPartial {
    static constexpr bool PERM = false, AFTER_DRAIN = false;
    float* part;
    __device__ __forceinline__ void operator()(const pg8::f32x4 (&acc)[2][2][4][2], const pg8::Unit& u, int wr, int wc, int fr, int fq) const {
#pragma unroll
        for (int ai = 0; ai < 2; ++ai)
#pragma unroll
            for (int m = 0; m < 4; ++m) { const int r = u.pm * 256 + ai * 128 + wr * 64 + m * 16 + fr; float* o = part + ((size_t)u.ks * MC + (size_t)(r - ML)) * D;
#pragma unroll
                for (int bj = 0; bj < 2; ++bj)
#pragma unroll
                    for (int n = 0; n < 2; ++n) { const int c = u.pn * 256 + bj * 128 + wc * 32 + 16 * n + 4 * fq; const pg8::f32x4 a = acc[ai][bj][m][n];
                        *(f32x4*)(o + c) = (f32x4){a[0], a[1], a[2], a[3]}; } }
    }
};
typedef __attribute__((address_space(1))) unsigned gu32;
#define XB_TMO      128
#define XB_XCNT(j)  (256  + 64 * (j))
#define XB_XSUB(j)  (1280 + 64 * (j))
#define XB_XGEN(j)  (2304 + 64 * (j))
#define XB_TOP      3328
#define XB_TOPGEN   3392
#define XCD_BAR_WORDS 3456
#define XB_SPIN_CAP (1u << 18)

__device__ __forceinline__ unsigned xb_ld(unsigned* p)              { return __hip_atomic_load(p, __ATOMIC_RELAXED, __HIP_MEMORY_SCOPE_AGENT); }
__device__ __forceinline__ unsigned xb_add(unsigned* p, unsigned v) { return __hip_atomic_fetch_add(p, v, __ATOMIC_RELAXED, __HIP_MEMORY_SCOPE_AGENT); }
__device__ __forceinline__ unsigned xb_xcc_id() { return (unsigned)__builtin_amdgcn_s_getreg((3 << 11) | 20) & 0xFu; }
#define XB_SPIN(cond, bar) do { unsigned _sp = 0; while (cond) { __builtin_amdgcn_s_sleep(1); \
    if ((++_sp & 255u) == 0u) { if (xb_ld(&(bar)[XB_TMO])) break; if (_sp > XB_SPIN_CAP) { atomicAdd(&(bar)[XB_TMO], 1u); break; } } } } while (0)

struct XcdBarrier {
    unsigned* bar; unsigned x;
    volatile LAS unsigned* st;
};

__device__ __forceinline__ XcdBarrier xcd_barrier_post(unsigned* bar, volatile LAS unsigned* st, int tid_) {
    XcdBarrier b; b.bar = bar; b.x = xb_xcc_id(); b.st = st;
    if (tid_ == 0) (void)xb_add(&bar[XB_XCNT(b.x)], 1u);
    return b;
}
__device__ __forceinline__ void xcd_barrier_complete(unsigned* bar, unsigned x, unsigned& nloc, unsigned& nx) {
    const unsigned G = gridDim.x * gridDim.y * gridDim.z;
    unsigned sum, cnt, mine, sp = 0u;
    for (;;) {
        sum = 0u; cnt = 0u; mine = 0u;
#pragma unroll
        for (unsigned j = 0; j < 16; ++j) { const unsigned c = xb_ld(&bar[XB_XCNT(j)]); sum += c; cnt += (c > 0u) ? 1u : 0u; mine = (j == x) ? c : mine; }
        if (sum == G) break;
        __builtin_amdgcn_s_sleep(1);
        if ((++sp & 255u) == 0u) { if (xb_ld(&bar[XB_TMO])) break; if (sp > XB_SPIN_CAP) { atomicAdd(&bar[XB_TMO], 1u); break; } }
    }
    nloc = mine > 0u ? mine : 1u; nx = cnt > 0u ? cnt : 1u;
}

__device__ __forceinline__ void xcd_barrier(const XcdBarrier& b, int tid_) {
    asm volatile("s_waitcnt vmcnt(0)" ::: "memory");
    __syncthreads();
    if (tid_ == 0) {
        unsigned* bar = b.bar; asm volatile("" : "+s"(bar)); unsigned bx = (unsigned)__builtin_amdgcn_readfirstlane((int)b.x); asm volatile("" : "+s"(bx));
        __builtin_amdgcn_s_waitcnt(0);
        unsigned nloc = b.st[0], nx = b.st[1];
        if (nloc == 0u) { xcd_barrier_complete(bar, bx, nloc, nx); b.st[0] = nloc; b.st[1] = nx; }
        const unsigned old = xb_add(&bar[XB_XSUB(bx)], 1u);
        const unsigned gen = old / nloc;
        if (old + 1u == (gen + 1u) * nloc) {
            __builtin_amdgcn_fence(__ATOMIC_RELEASE, "agent");
            asm volatile("s_waitcnt vmcnt(0)" ::: "memory");
            const unsigned og = xb_add(&bar[XB_TOP], 1u);
            const unsigned tg = og / nx;
            if (og + 1u == (tg + 1u) * nx) xb_add(&bar[XB_TOPGEN], 1u);
            else XB_SPIN(xb_ld(&bar[XB_TOPGEN]) == tg, bar);
            __builtin_amdgcn_fence(__ATOMIC_ACQUIRE, "agent");
            xb_add(&bar[XB_XGEN(bx)], 1u);
            asm volatile("s_waitcnt vmcnt(0)" ::: "memory");
        } else {
            XB_SPIN(xb_ld(&bar[XB_XGEN(bx)]) == gen, bar);
            __builtin_amdgcn_fence(__ATOMIC_ACQUIRE, "agent");
            asm volatile("s_waitcnt vmcnt(0)" ::: "memory");
        }
    }
    __syncthreads();
}
struct Ctx {
    LAS unsigned char* lds; int tid, lane, wave, G, gw, NGW;
    float* MOD; float* MCS; bf16 *F1, *F2, *FC; bf16 *HX, *YMIX, *PB, *ACT, *TB, *CAU; float *XC, *ST, *DEC;
};
__device__ __forceinline__ bf16* win_t(PP p, int l) { return (bf16*)(p->ws + WS_W + (size_t)l * W_LAYER_B); }
__device__ __forceinline__ bf16* wout_t(PP p, int l) { return (bf16*)(p->ws + WS_W + (size_t)l * W_LAYER_B + W_IN_B); }
__device__ __forceinline__ bf16* wup_t(PP p, int l) { return (bf16*)(p->ws + WS_W + (size_t)l * W_LAYER_B + W_IN_B + W_OUT_B); }
__device__ __forceinline__ bf16* wdn_t(PP p, int l) { return (bf16*)(p->ws + WS_W + (size_t)l * W_LAYER_B + W_IN_B + W_OUT_B + W_UP_B); }

__device__ __forceinline__ void transpose_item(const float* W, int K, int N, bf16* WT, int k0, int n0, int dst0, float scale, LAS float* scr, int lane) {
#pragma unroll
    for (int i = 0; i < 32; ++i) { const int kk = 2 * i + (lane >> 5); scr[kk * 33 + (lane & 31)] = __builtin_nontemporal_load(W + (size_t)(k0 + kk) * N + n0 + (lane & 31)) * scale; }
    LDS_WAIT(); __builtin_amdgcn_wave_barrier();
    const int c = lane & 7;
#pragma unroll
    for (int j = 0; j < 4; ++j) { const int n = (lane >> 3) + 8 * j; const LAS float* s = scr + (8 * c) * 33 + n;
        u32x4 o; o.x = pk2(s[0 * 33], s[1 * 33]); o.y = pk2(s[2 * 33], s[3 * 33]); o.z = pk2(s[4 * 33], s[5 * 33]); o.w = pk2(s[6 * 33], s[7 * 33]);
        __builtin_nontemporal_store(o, (u32x4*)(WT + (size_t)(dst0 + n) * K + k0 + 8 * c)); }
    LDS_WAIT(); __builtin_amdgcn_wave_barrier();
}

__device__ __forceinline__ void phase0(PP p, Ctx& F) {
    LAS float* sv = (LAS float*)F.lds; LAS float* red = sv + 3072;
    for (int i = F.tid; i < 3072; i += 512) { const int w = i >> 10, k = i & 1023; const float cv = (w < 2) ? p->c[w * 1024 + k] : p->c_ctx[k]; sv[i] = cv / (1.f + expf(-cv)); }
    __syncthreads();
    for (int it = blockIdx.x; it < 192; it += F.G) {
        const int l = it / 96, c0 = (it % 96) * 64; const float* W = p->w_mod + (size_t)l * 1024 * 6144 + c0 + F.lane;
        float a0 = 0.f, a1 = 0.f, a2 = 0.f; const int kb = F.wave * 128;
#pragma unroll 64
        for (int k = 0; k < 128; ++k) { const float wv = __builtin_nontemporal_load(W + (size_t)(kb + k) * 6144); a0 += sv[kb + k] * wv; a1 += sv[1024 + kb + k] * wv; a2 += sv[2048 + kb + k] * wv; }
        red[(F.wave * 3 + 0) * 64 + F.lane] = a0; red[(F.wave * 3 + 1) * 64 + F.lane] = a1; red[(F.wave * 3 + 2) * 64 + F.lane] = a2;
        __syncthreads();
        if (F.tid < 192) { const int w = F.tid >> 6, ln = F.tid & 63; float s = 0.f;
#pragma unroll
            for (int q = 0; q < 8; ++q) s += red[(q * 3 + w) * 64 + ln];
            F.MOD[(l * 3 + w) * 6144 + c0 + ln] = s + p->b_mod[l * 6144 + c0 + ln]; }
        __syncthreads();
    }
    __syncthreads();
    LAS float* scr = (LAS float*)(F.lds + F.wave * 16384);
    constexpr int I_IN = 48 * 16, I_OUT = 32 * 16, I_UP = 176 * 16, I_DN = 32 * 44, I_L = I_IN + I_OUT + I_UP + I_DN;
    for (int it = F.gw; it < 2 * I_L; it += F.NGW) {
        const int l = it / I_L; int r = it % I_L;
        if (r < I_IN) { const int cb = r / 16, kb = r % 16; int src, dst; float sc = 1.f;
            if (cb < 4) { src = 32 * cb; dst = PK + 32 * cb; }
            else if (cb < 8) { src = 416 + 32 * (cb - 4); dst = PQ + 32 * (cb - 4); sc = 0.17677669529663687f; }
            else if (cb < 16) { src = 128 + 32 * (cb - 8); dst = PV + 32 * (cb - 8); }
            else if (cb < 24) { src = 544 + 32 * (cb - 16); dst = PG + 32 * (cb - 16); }
            else if (cb < 32) { src = 1056 + 32 * (cb - 24); dst = PH + 32 * (cb - 24); }
            else if (cb < 40) { src = 1312 + 32 * (cb - 32); dst = PBG + 32 * (cb - 32); }
            else { src = 1568 + 32 * (cb - 40); dst = PCG + 32 * (cb - 40); }
            transpose_item(p->w_in + (size_t)l * D * DIN, D, DIN, win_t(p, l), 64 * kb, src, dst, sc, scr, F.lane); continue; }
        r -= I_IN;
        if (r < I_OUT) { const int cb = r / 16, kb = r % 16; transpose_item(p->w_out + (size_t)l * D * D, D, D, wout_t(p, l), 64 * kb, 32 * cb, 32 * cb, 1.f, scr, F.lane); continue; }
        r -= I_OUT;
        if (r < I_UP) { const int cb = r / 16, kb = r % 16; const int c = 32 * cb, isu = (c >= DFF) ? 1 : 0, j = c - isu * DFF; const int dst = (j / 128) * 256 + isu * 128 + (j % 128);
            transpose_item(p->w_up + (size_t)l * D * NUP, D, NUP, wup_t(p, l), 64 * kb, c, dst, 1.f, scr, F.lane); continue; }
        r -= I_UP;
        { const int cb = r / 44, kb = r % 44; transpose_item(p->w_down + (size_t)l * DFF * D, DFF, D, wdn_t(p, l), 64 * kb, 32 * cb, 32 * cb, 1.f, scr, F.lane); }
    }
    const int gt = blockIdx.x * 512 + F.tid, NT = F.G * 512;
    const int gtm = (F.G == 256) ? ((int)blockIdx.x - 192) * 512 + F.tid : gt; const int NTm = (F.G == 256) ? 32768 : NT;
    for (int i = gtm; i >= 0 && i < 32768; i += NTm) { const int d = i & 63, c = (i >> 6) & 63, g = (i >> 12) & 3, l = i >> 14;
        const float* wf = p->fft_w + (size_t)((l * 4 + g) * 64) * 64 + d; float mc = 0.f, ms = 0.f;
        for (int f = 0; f < 64; ++f) { const float a = (float)((f * c) & 63) * (1.f / 64.f); const float w = wf[f * 64]; mc += cos_rev(a) * w; ms -= sin_rev(a) * w; }
        F.MCS[(((l * 4 + g) * 2 + 0) * 64 + c) * 64 + d] = mc * 0.125f; F.MCS[(((l * 4 + g) * 2 + 1) * 64 + c) * 64 + d] = ms * 0.125f; }
    for (int i = gt; i < MC * D / 4; i += NT) ((f32x4*)F.XC)[i] = ((const f32x4*)p->ctx)[i];
    for (int i = gt; i < 180224; i += NT) {
        if (i < 16384) { const int mm = i >> 7, kk = i & 127, k1 = mm & 63, n1 = kk & 63; const float a = (float)((k1 * n1) & 63) * (1.f / 64.f); const float C = cos_rev(a), S = sin_rev(a);
            const float v = (mm < 64) ? (kk < 64 ? C : S) : (kk < 64 ? -S : C); F.F1[i] = (bf16)f2bf(v); }
        else if (i < 49152) { const int j = i - 16384, k2 = j >> 8, kk = j & 255, n2 = kk & 127; const float a = (float)((k2 * n2) & 127) * (1.f / 128.f);
            const float v = (kk < 128 ? cos_rev(a) : sin_rev(a)) * 0.011048543456039806f; F.F2[j] = (bf16)f2bf(v); }
        else { const int j = i - 49152, k = j >> 9, kk = j & 511, n = kk & 255; const float a = (float)((k * n) & 255) * (1.f / 256.f);
            const float v = (kk < 256 ? cos_rev(a) : sin_rev(a)) * 0.0625f; F.FC[j] = (bf16)f2bf(v); }
    }
}

__device__ __forceinline__ void fold_items(PP p, Ctx& F) {
    for (int it4 = F.gw; it4 < 1792; it4 += F.NGW) {
        const int dq = it4 & 3, it = it4 >> 2;
        const int l = it / 224, r = it % 224, s = r / 16, kb = r % 16; const int k = 64 * kb + F.lane;
        const float* wrow = p->w_in + (size_t)l * D * DIN + (size_t)k * DIN; bf16* WT = win_t(p, l);
        if (s < 2) {
            const f32x4* src = (const f32x4*)(wrow + 384 + 16 * s); f32x4 r4[4];
#pragma unroll
            for (int q = 0; q < 4; ++q) r4[q] = src[q];
            const float* M = p->w_a2 + (size_t)((l * 2 + s) * 16) * 128;
            for (int d = 32 * dq; d < 32 * dq + 32; ++d) { float a = 0.f;
#pragma unroll
                for (int c = 0; c < 16; ++c) a += r4[c >> 2][c & 3] * M[c * 128 + d];
                WT[(size_t)(PLA + s * 128 + d) * D + k] = (bf16)f2bf(a); }
        } else {
            const int kind = (s - 2) >> 2, g = (s - 2) & 3;
            const f32x4* src = (const f32x4*)(wrow + (kind < 2 ? 800 : 1824) + 64 * g); f32x4 r4[16];
#pragma unroll
            for (int q = 0; q < 16; ++q) r4[q] = src[q];
            const float* M = (kind < 2) ? (F.MCS + (size_t)(((l * 4 + g) * 2 + kind) * 64) * 64) : (p->pool_w + (size_t)((l * 4 + g) * 64) * 64);
            const int drow = (kind == 0 ? PFA : (kind == 1 ? PFB : PPOOL)) + 64 * g;
            for (int d = 16 * dq; d < 16 * dq + 16; ++d) { float a = 0.f;
#pragma unroll
                for (int c = 0; c < 64; ++c) a += r4[c >> 2][c & 3] * M[c * 64 + d];
                if (kind == 2) a *= p->pool_scale[l * 256 + g * 64 + d];
                WT[(size_t)(drow + d) * D + k] = (bf16)f2bf(a); }
        }
    }
}

__device__ __forceinline__ void norm_row_bf16(const float* xrow, bf16* orow, const float* g, const float* sc, const float* sh, int lane, const float* part, int nparts, const float* gate, float* xout) {
    f32x4 v[4]; float s = 0.f;
#pragma unroll
    for (int j = 0; j < 4; ++j) v[j] = ((const f32x4*)xrow)[lane + 64 * j];
    if (nparts > 0) {
        f32x4 a[4];
#pragma unroll
        for (int j = 0; j < 4; ++j) a[j] = (f32x4){0.f, 0.f, 0.f, 0.f};
        for (int q = 0; q < nparts; ++q) {
#pragma unroll
            for (int j = 0; j < 4; ++j) { const f32x4 t = ((const f32x4*)(part + (size_t)q * MC * D))[lane + 64 * j]; a[j][0] += t[0]; a[j][1] += t[1]; a[j][2] += t[2]; a[j][3] += t[3]; } }
#pragma unroll
        for (int j = 0; j < 4; ++j) { const f32x4 gv = ((const f32x4*)gate)[lane + 64 * j];
#pragma unroll
            for (int e = 0; e < 4; ++e) v[j][e] += gv[e] * a[j][e];
            ((f32x4*)xout)[lane + 64 * j] = v[j]; }
    }
#pragma unroll
    for (int j = 0; j < 4; ++j) s += (v[j][0] * v[j][0] + v[j][1] * v[j][1]) + (v[j][2] * v[j][2] + v[j][3] * v[j][3]);
    const float rstd = 1.f / sqrtf(wave_sum(s, lane) * (1.f / D) + EPS);
#pragma unroll
    for (int j = 0; j < 4; ++j) { const int idx = lane + 64 * j; const f32x4 gv = ((const f32x4*)g)[idx], scv = ((const f32x4*)sc)[idx], shv = ((const f32x4*)sh)[idx];
        float y[4];
#pragma unroll
        for (int e = 0; e < 4; ++e) y[e] = v[j][e] * rstd * gv[e] * (1.f + scv[e]) + shv[e];
        u32x2 o; o.x = pk2(y[0], y[1]); o.y = pk2(y[2], y[3]); ((u32x2*)orow)[idx] = o; }
}
template <bool FINAL, bool INB>
__device__ __forceinline__ void norm_rows4(const void* xbase, bf16* obase, float* fout, const float* g, const float* modl, int which, int m0, int stride, int lane) {
    f32x4 v[4][4]; float s[4]; int mk[4]; bool ok[4];
#pragma unroll
    for (int k = 0; k < 4; ++k) { const int m = m0 + k * stride; ok[k] = m < ML; mk[k] = ok[k] ? m : ML - 1;
#pragma unroll
        for (int j = 0; j < 4; ++j) {
            if (INB) { const u32x2 t = ((const u32x2*)((const bf16*)xbase + (size_t)mk[k] * D))[lane + 64 * j]; v[k][j] = (f32x4){bflo(t.x), bfhi(t.x), bflo(t.y), bfhi(t.y)}; }
            else v[k][j] = __builtin_nontemporal_load((const f32x4*)((const float*)xbase + (size_t)mk[k] * D) + lane + 64 * j); } }
    f32x4 gm[4], sh4[4];
    { const float* mod = FINAL ? g : modl + (m0 >> 13) * 6144 + which * 3072;
#pragma unroll
      for (int j = 0; j < 4; ++j) { const int idx = lane + 64 * j; const f32x4 gv = ((const f32x4*)g)[idx];
          if (FINAL) { gm[j] = gv; sh4[j] = (f32x4){0.f, 0.f, 0.f, 0.f}; }
          else { const f32x4 scv = ((const f32x4*)(mod + 1024))[idx]; sh4[j] = ((const f32x4*)mod)[idx];
#pragma unroll
              for (int e = 0; e < 4; ++e) gm[j][e] = gv[e] * (1.f + scv[e]); } } }
#pragma unroll
    for (int k = 0; k < 4; ++k) { float a = 0.f;
#pragma unroll
        for (int j = 0; j < 4; ++j) a += (v[k][j][0] * v[k][j][0] + v[k][j][1] * v[k][j][1]) + (v[k][j][2] * v[k][j][2] + v[k][j][3] * v[k][j][3]);
        s[k] = a; }
#pragma unroll
    for (int o = 1; o < 64; o <<= 1) {
#pragma unroll
        for (int k = 0; k < 4; ++k) s[k] += shfl_f(s[k], lane ^ o); }
#pragma unroll
    for (int k = 0; k < 4; ++k) { if (!ok[k]) continue;
        const float rstd = 1.f / sqrtf(s[k] * (1.f / D) + EPS);
#pragma unroll
        for (int j = 0; j < 4; ++j) { const int idx = lane + 64 * j;
            if (FINAL) { f32x4 y;
#pragma unroll
                for (int e = 0; e < 4; ++e) y[e] = v[k][j][e] * rstd * gm[j][e];
                ((f32x4*)(fout + (size_t)mk[k] * D))[idx] = y; }
            else { float y[4];
#pragma unroll
                for (int e = 0; e < 4; ++e) y[e] = v[k][j][e] * rstd * gm[j][e] + sh4[j][e];
                u32x2 o; o.x = pk2(y[0], y[1]); o.y = pk2(y[2], y[3]); ((u32x2*)(obase + (size_t)mk[k] * D))[idx] = o; } }
    }
}
__device__ __forceinline__ void norm_phase(PP p, Ctx& F, int l, int which, int mrows) {
    const float* g = (which == 0 ? p->norm1_g : p->norm2_g) + l * D;
    const float* PART = (const float*)(p->ws + WS_PART);
    if (l == 0 && which == 0) { for (int m0 = F.gw; m0 < ML; m0 += 4 * F.NGW) norm_rows4<false, false>(p->x, F.HX, nullptr, g, F.MOD + l * 3 * 6144, which, m0, F.NGW, F.lane); }
    else { const void* xb = (l == 1 && which == 1 && F.G == 256) ? (const void*)(p->ws + WS_XB2) : (const void*)p->out;
        for (int m0 = F.gw; m0 < ML; m0 += 4 * F.NGW) norm_rows4<false, true>(xb, F.HX, nullptr, g, F.MOD + l * 3 * 6144, which, m0, F.NGW, F.lane); }
    for (int m = ML + F.gw; m < mrows; m += F.NGW) {
        int nparts = 0; const float* gate = nullptr;
        const float* xr = ((l == 0 && which == 0) ? p->ctx : F.XC) + (size_t)(m - ML) * D;
        if (l == 0 && which == 1) { nparts = 4; gate = F.MOD + 2 * 6144 + 2048; }
        if (l == 1 && which == 0) { nparts = 11; gate = F.MOD + 2 * 6144 + 5120; }
        const float* part = PART + (size_t)(m - ML) * D; float* xout = F.XC + (size_t)(m - ML) * D;
        const float* mod = F.MOD + (l * 3 + 2) * 6144 + which * 3072;
        norm_row_bf16(xr, F.HX + (size_t)m * D, g, mod + 1024, mod, F.lane, part, nparts, gate, xout);
    }
}
__device__ __forceinline__ void final_norm(PP p, Ctx& F) {
    for (int m0 = F.gw; m0 < ML; m0 += 4 * F.NGW) norm_rows4<true, false>(p->ws + WS_HX  , nullptr, p->out, p->final_g, nullptr, 0, m0, F.NGW, F.lane);
}
constexpr int CP = 260;
__device__ __forceinline__ int chunk_row0(int b, int cidx) { return (cidx < 4) ? (ML + b * CTXL + cidx * 64) : (b * SEQ + (cidx - 4) * 64); }
__device__ __forceinline__ void cum_to_lds(LAS float* cum, const bf16* PB, int row0, int tid) {
    { const int oct = tid & 31, j0 = tid >> 5; u32x4 w[4];
#pragma unroll
      for (int q = 0; q < 4; ++q) w[q] = *(const u32x4*)(PB + (size_t)(row0 + j0 + 16 * q) * NP + PLA + 8 * oct);
#pragma unroll
      for (int q = 0; q < 4; ++q) { LAS float* d = cum + (j0 + 16 * q) * CP + 8 * oct;
          *(LAS f32x4*)d = (f32x4){bflo(w[q].x), bfhi(w[q].x), bflo(w[q].y), bfhi(w[q].y)}; *(LAS f32x4*)(d + 4) = (f32x4){bflo(w[q].z), bfhi(w[q].z), bflo(w[q].w), bfhi(w[q].w)}; } }
    __syncthreads();
    if (tid < 256) { float s = 0.f;
        if (tid < 128) {
#pragma unroll 16
            for (int j = 0; j < 64; ++j) { s += cum[j * CP + tid]; cum[j * CP + tid] = s; }
        } else {
#pragma unroll 16
            for (int j = 63; j >= 0; --j) { s += cum[j * CP + tid]; cum[j * CP + tid] = s; }
        } }
    __syncthreads();
}
typedef float f32x2_t __attribute__((ext_vector_type(2)));
typedef __bf16 bf16x2_t __attribute__((ext_vector_type(2)));
__device__ __forceinline__ unsigned pkh(float lo, float hi) { f32x2_t v = {lo, hi}; bf16x2_t b = __builtin_convertvector(v, bf16x2_t); return __builtin_bit_cast(unsigned, b); }
__device__ __forceinline__ bf16x8 pack8h(float a0, float a1, float a2, float a3, float a4, float a5, float a6, float a7) {
    u32x4 w; w.x = pkh(a0, a1); w.y = pkh(a2, a3); w.z = pkh(a4, a5); w.w = pkh(a6, a7); return __builtin_bit_cast(bf16x8, w);
}
__device__ __forceinline__ void la_load(u32x4 (&w)[4], const bf16* PB, int row0, int tid) {
    const int oct = tid & 31, j0 = tid >> 5;
#pragma unroll
    for (int q = 0; q < 4; ++q) w[q] = *(const u32x4*)(PB + (size_t)(row0 + j0 + 16 * q) * NP + PLA + 8 * oct);
}
__device__ __forceinline__ void la_scan(LAS float* cum, const u32x4 (&w)[4], int tid) {
    const int oct = tid & 31, j0 = tid >> 5;
#pragma unroll
    for (int q = 0; q < 4; ++q) { LAS float* d = cum + (j0 + 16 * q) * CP + 8 * oct;
        *(LAS f32x4*)d = (f32x4){bflo(w[q].x), bfhi(w[q].x), bflo(w[q].y), bfhi(w[q].y)}; *(LAS f32x4*)(d + 4) = (f32x4){bflo(w[q].z), bfhi(w[q].z), bflo(w[q].w), bfhi(w[q].w)}; }
    __syncthreads();
    if (tid < 256) { float carry = 0.f;
        if (tid < 128) {
#pragma unroll
            for (int hf = 0; hf < 4; ++hf) { float v[16];
#pragma unroll
                for (int j = 0; j < 16; ++j) v[j] = cum[(16 * hf + j) * CP + tid];
                v[0] += carry;
#pragma unroll
                for (int j = 1; j < 16; ++j) v[j] += v[j - 1];
                carry = v[15];
#pragma unroll
                for (int j = 0; j < 16; ++j) cum[(16 * hf + j) * CP + tid] = v[j]; }
        } else {
#pragma unroll
            for (int hf = 3; hf >= 0; --hf) { float v[16];
#pragma unroll
                for (int j = 0; j < 16; ++j) v[j] = cum[(16 * hf + j) * CP + tid];
                v[15] += carry;
#pragma unroll
                for (int j = 14; j >= 0; --j) v[j] += v[j + 1];
                carry = v[0];
#pragma unroll
                for (int j = 0; j < 16; ++j) cum[(16 * hf + j) * CP + tid] = v[j]; }
        } }
    __syncthreads();
}
__device__ __forceinline__ void gla_a_item(Ctx& F, int b, int cidx) {
    LAS float* cum = (LAS float*)F.lds; const int row0 = chunk_row0(b, cidx);
    const int h = F.wave & 3, dir = F.wave >> 2, chb = dir * 128 + h * 32, lr = F.lane & 15, g = F.lane >> 4;
    const int jl = dir ? 0 : 63;
    u32x4 wla[4]; la_load(wla, F.PB, row0, F.tid);
    unsigned short kt[2][2][8], vt[2][4][8];
#pragma unroll
    for (int ks = 0; ks < 2; ++ks) { const int j0 = 32 * ks + 8 * g;
#pragma unroll
        for (int mb = 0; mb < 2; ++mb)
#pragma unroll
            for (int e = 0; e < 8; ++e) kt[ks][mb][e] = F.PB[(size_t)(row0 + j0 + e) * NP + PK + h * 32 + 16 * mb + lr];
#pragma unroll
        for (int nb = 0; nb < 4; ++nb)
#pragma unroll
            for (int e = 0; e < 8; ++e) vt[ks][nb][e] = F.PB[(size_t)(row0 + j0 + e) * NP + PV + h * 64 + 16 * nb + lr]; }
    la_scan(cum, wla, F.tid);
    f32x4 acc[2][4];
#pragma unroll
    for (int mb = 0; mb < 2; ++mb)
#pragma unroll
        for (int nb = 0; nb < 4; ++nb) acc[mb][nb] = (f32x4){0.f, 0.f, 0.f, 0.f};
#pragma unroll
    for (int ks = 0; ks < 2; ++ks) {
        bf16x8 af[2], bfr[4]; const int j0 = 32 * ks + 8 * g;
#pragma unroll
        for (int mb = 0; mb < 2; ++mb) { const int dk = 16 * mb + lr; const float last = cum[jl * CP + chb + dk]; float a[8];
#pragma unroll
            for (int e = 0; e < 8; ++e) { const int j = j0 + e; a[e] = bf2f(kt[ks][mb][e]) * __expf(last - cum[j * CP + chb + dk]); }
            af[mb] = pack8h(a[0], a[1], a[2], a[3], a[4], a[5], a[6], a[7]); }
#pragma unroll
        for (int nb = 0; nb < 4; ++nb) { const unsigned short* t = vt[ks][nb];
            u32x4 w; w.x = t[0] | ((unsigned)t[1] << 16); w.y = t[2] | ((unsigned)t[3] << 16); w.z = t[4] | ((unsigned)t[5] << 16); w.w = t[6] | ((unsigned)t[7] << 16);
            bfr[nb] = __builtin_bit_cast(bf16x8, w); }
#pragma unroll
        for (int mb = 0; mb < 2; ++mb)
#pragma unroll
            for (int nb = 0; nb < 4; ++nb) acc[mb][nb] = MFMA16(af[mb], bfr[nb], acc[mb][nb]);
    }
    const size_t sidx = (size_t)(((b * 2 + dir) * 4 + h) * NCH + cidx);
    float* st = F.ST + sidx * 2048;
#pragma unroll
    for (int mb = 0; mb < 2; ++mb)
#pragma unroll
        for (int nb = 0; nb < 4; ++nb) *(f32x4*)(st + (16 * nb + lr) * 32 + 16 * mb + 4 * g) = acc[mb][nb];
    if (F.lane < 32) F.DEC[sidx * 32 + F.lane] = __expf(cum[jl * CP + chb + F.lane]);
    __syncthreads();
}
__device__ __forceinline__ void gla_scan(Ctx& F) {
    LAS float* xa = (LAS float*)F.lds; LAS float* xb = xa + 512;
    const int seg = F.tid >> 6, el = F.tid & 63;
    for (int blk = blockIdx.x; blk < 512; blk += F.G) {
        const int ge = blk * 64 + el, e = ge & 2047, seq = ge >> 11, dir = (seq >> 2) & 1, dk = e & 31;
        float* st = F.ST + (size_t)seq * NCH * 2048 + e; const float* dc = F.DEC + (size_t)seq * NCH * 32 + dk;
        float u[17], d[17];
#pragma unroll
        for (int i = 0; i < 17; ++i) { const int s = seg * 17 + i; const bool ok = s < NCH; const int sc = ok ? s : NCH - 1; const int c = dir ? (sc < 4 ? 3 - sc : 135 - sc) : sc;
            const float uu = st[(size_t)c * 2048], dd = dc[c * 32]; u[i] = ok ? uu : 0.f; d[i] = ok ? dd : 1.f; }
        float A = 1.f, B = 0.f;
#pragma unroll
        for (int i = 0; i < 17; ++i) { B = B * d[i] + u[i]; A *= d[i]; }
        xa[F.tid] = A; xb[F.tid] = B;
        __syncthreads();
        float S = 0.f;
        for (int sg = 0; sg < seg; ++sg) S = S * xa[sg * 64 + el] + xb[sg * 64 + el];
#pragma unroll
        for (int i = 0; i < 17; ++i) { const int s = seg * 17 + i; if (s < NCH) { const int c = dir ? (s < 4 ? 3 - s : 135 - s) : s; st[(size_t)c * 2048] = S; } S = S * d[i] + u[i]; }
        __syncthreads();
    }
}
template <int NI>
__device__ __forceinline__ void gla_c_item(PP p, Ctx& F, int l, int b, int cidx, int sub) {
    LAS float* cum = (LAS float*)F.lds; const int row0 = chunk_row0(b, cidx);
    const int h = F.wave & 3, half = (NI == 2) ? (F.wave >> 2) : sub, ibase = (NI == 2) ? 0 : (F.wave >> 2), lr = F.lane & 15, g = F.lane >> 4;
    u32x4 wla[4]; la_load(wla, F.PB, row0, F.tid);
    f32x4 o[4][2];
#pragma unroll
    for (int mb = 0; mb < 4; ++mb) { o[mb][0] = (f32x4){0.f, 0.f, 0.f, 0.f}; o[mb][1] = (f32x4){0.f, 0.f, 0.f, 0.f}; }
    bf16x8 av[4][2];
#pragma unroll
    for (int mb = 0; mb < 4; ++mb)
#pragma unroll
        for (int pp = 0; pp < 2; ++pp) { unsigned short t[8];
#pragma unroll
            for (int e = 0; e < 8; ++e) { const int j = 32 * pp + (e < 4 ? 4 * g + e : 16 + 4 * g + (e - 4)); t[e] = F.PB[(size_t)(row0 + j) * NP + PV + h * 64 + 16 * mb + lr]; }
            u32x4 w; w.x = t[0] | ((unsigned)t[1] << 16); w.y = t[2] | ((unsigned)t[3] << 16); w.z = t[4] | ((unsigned)t[5] << 16); w.w = t[6] | ((unsigned)t[7] << 16);
            av[mb][pp] = __builtin_bit_cast(bf16x8, w); }
    u32x4 qraw[2], kraw[4]; f32x4 sraw[2][4][2];
#pragma unroll
    for (int ibl = 0; ibl < NI; ++ibl) qraw[ibl] = *(const u32x4*)(F.PB + (size_t)(row0 + 16 * (2 * half + ibase + ibl) + lr) * NP + PQ + h * 32 + 8 * g);
#pragma unroll
    for (int jb = 0; jb < 4; ++jb) kraw[jb] = *(const u32x4*)(F.PB + (size_t)(row0 + 16 * jb + lr) * NP + PK + h * 32 + 8 * g);
    { const float* st = F.ST + (size_t)(((b * 2 + 0) * 4 + h) * NCH + cidx) * 2048;
#pragma unroll
        for (int mb = 0; mb < 4; ++mb) { sraw[0][mb][0] = *(const f32x4*)(st + (16 * mb + lr) * 32 + 8 * g); sraw[0][mb][1] = *(const f32x4*)(st + (16 * mb + lr) * 32 + 8 * g + 4); } }
    la_scan(cum, wla, F.tid);
    { const float* st = F.ST + (size_t)(((b * 2 + 1) * 4 + h) * NCH + cidx) * 2048;
#pragma unroll
        for (int mb = 0; mb < 4; ++mb) { sraw[1][mb][0] = *(const f32x4*)(st + (16 * mb + lr) * 32 + 8 * g); sraw[1][mb][1] = *(const f32x4*)(st + (16 * mb + lr) * 32 + 8 * g + 4); } }
#pragma unroll
    for (int dir = 0; dir < 2; ++dir) {
        const int chb = dir * 128 + h * 32;
        bf16x8 bq[2];
#pragma unroll
        for (int ibl = 0; ibl < NI; ++ibl) { const int i = 16 * (2 * half + ibase + ibl) + lr;
            const u32x4 qw = qraw[ibl];
            const f32x4 c0 = *(const LAS f32x4*)(cum + i * CP + chb + 8 * g), c1 = *(const LAS f32x4*)(cum + i * CP + chb + 8 * g + 4);
            bq[ibl] = pack8h(bflo(qw.x) * __expf(c0[0]), bfhi(qw.x) * __expf(c0[1]), bflo(qw.y) * __expf(c0[2]), bfhi(qw.y) * __expf(c0[3]),
                            bflo(qw.z) * __expf(c1[0]), bfhi(qw.z) * __expf(c1[1]), bflo(qw.w) * __expf(c1[2]), bfhi(qw.w) * __expf(c1[3])); }
#pragma unroll
        for (int mb = 0; mb < 4; ++mb) { const f32x4 s0 = sraw[dir][mb][0], s1 = sraw[dir][mb][1];
            const bf16x8 as = pack8h(s0[0], s0[1], s0[2], s0[3], s1[0], s1[1], s1[2], s1[3]);
            o[mb][0] = MFMA16(as, bq[0], o[mb][0]); if (NI == 2) o[mb][1] = MFMA16(as, bq[1], o[mb][1]); }
#pragma unroll
        for (int pp = 0; pp < 2; ++pp) {
            if ((dir == 0 && half == 0 && pp == 1) || (dir == 1 && half == 1 && pp == 0)) continue;
            f32x4 sc[2][2];
#pragma unroll
            for (int q = 0; q < 2; ++q) { const int jb = 2 * pp + q, j = 16 * jb + lr;
                const u32x4 kw = kraw[jb];
                const f32x4 c0 = *(const LAS f32x4*)(cum + j * CP + chb + 8 * g), c1 = *(const LAS f32x4*)(cum + j * CP + chb + 8 * g + 4);
                const bf16x8 ak = pack8h(bflo(kw.x) * __expf(-c0[0]), bfhi(kw.x) * __expf(-c0[1]), bflo(kw.y) * __expf(-c0[2]), bfhi(kw.y) * __expf(-c0[3]),
                                        bflo(kw.z) * __expf(-c1[0]), bfhi(kw.z) * __expf(-c1[1]), bflo(kw.w) * __expf(-c1[2]), bfhi(kw.w) * __expf(-c1[3]));
#pragma unroll
                for (int ibl = 0; ibl < NI; ++ibl) { f32x4 z = (f32x4){0.f, 0.f, 0.f, 0.f}; z = MFMA16(ak, bq[ibl], z);
                    const int i = 16 * (2 * half + ibase + ibl) + lr;
#pragma unroll
                    for (int r = 0; r < 4; ++r) { const int jj = 16 * jb + 4 * g + r; const bool keep = dir ? (jj >= i) : (jj <= i); z[r] = keep ? z[r] : 0.f; }
                    sc[q][ibl] = z; } }
#pragma unroll
            for (int ibl = 0; ibl < NI; ++ibl) { const bf16x8 pb = pack8h(sc[0][ibl][0], sc[0][ibl][1], sc[0][ibl][2], sc[0][ibl][3], sc[1][ibl][0], sc[1][ibl][1], sc[1][ibl][2], sc[1][ibl][3]);
#pragma unroll
                for (int mb = 0; mb < 4; ++mb) o[mb][ibl] = MFMA16(av[mb][pp], pb, o[mb][ibl]); }
        }
    }
    const float* gg = p->gla_g + l * 64;
#pragma unroll
    for (int ibl = 0; ibl < NI; ++ibl) { float ss = 0.f;
#pragma unroll
        for (int mb = 0; mb < 4; ++mb) ss += (o[mb][ibl][0] * o[mb][ibl][0] + o[mb][ibl][1] * o[mb][ibl][1]) + (o[mb][ibl][2] * o[mb][ibl][2] + o[mb][ibl][3] * o[mb][ibl][3]);
        ss += shfl_f(ss, F.lane ^ 16); ss += shfl_f(ss, F.lane ^ 32);
        const float rstd = 1.f / sqrtf(ss * (1.f / 64.f) + EPS);
        const int i = 16 * (2 * half + ibase + ibl) + lr; const size_t row = (size_t)(row0 + i);
#pragma unroll
        for (int mb = 0; mb < 4; ++mb) { const int dv = 16 * mb + 4 * g; const f32x4 gv = *(const f32x4*)(gg + dv);
            const u32x2 gw = *(const u32x2*)(F.PB + row * NP + PG + h * 64 + dv);
            const float y0 = o[mb][ibl][0] * rstd * gv[0] * silu_f(bflo(gw.x)), y1 = o[mb][ibl][1] * rstd * gv[1] * silu_f(bfhi(gw.x));
            const float y2 = o[mb][ibl][2] * rstd * gv[2] * silu_f(bflo(gw.y)), y3 = o[mb][ibl][3] * rstd * gv[3] * silu_f(bfhi(gw.y));
            u32x2 w; w.x = pk2(y0, y1); w.y = pk2(y2, y3); *(u32x2*)(F.YMIX + row * D + h * 64 + dv) = w; }
    }
    __syncthreads();
}

template <int NKS, int GRP>
__device__ __forceinline__ void dft_mma_lds(f32x4 (&acc)[8], const LAS unsigned char* fl, int pitchB, const bf16* re, const bf16* im, size_t rstride, int khalf, int lane) {
    const int lr = lane & 15, g = lane >> 4;
#pragma unroll
    for (int k0 = 0; k0 < NKS; k0 += GRP) {
        bf16x8 bfrag[GRP];
#pragma unroll
        for (int kq = 0; kq < GRP; ++kq) { const int ks = k0 + kq; const int kk0 = 32 * ks + 8 * g; const bool part = kk0 >= khalf; const int idx = part ? kk0 - khalf : kk0;
            const bf16* src = (part ? im : re) + (size_t)idx * rstride + lr; unsigned short t[8];
#pragma unroll
            for (int e = 0; e < 8; ++e) t[e] = src[(size_t)e * rstride];
            u32x4 w; w.x = t[0] | ((unsigned)t[1] << 16); w.y = t[2] | ((unsigned)t[3] << 16); w.z = t[4] | ((unsigned)t[5] << 16); w.w = t[6] | ((unsigned)t[7] << 16);
            bfrag[kq] = __builtin_bit_cast(bf16x8, w); }
#pragma unroll
        for (int kq = 0; kq < GRP; ++kq) { const int ks = k0 + kq;
#pragma unroll
            for (int mb = 0; mb < 8; ++mb) { const bf16x8 a = *(const LAS bf16x8*)(fl + (16 * mb + lr) * pitchB + (32 * ks + 8 * g) * 2); acc[mb] = MFMA16(a, bfrag[kq], acc[mb]); }
        }
    }
}
__device__ __forceinline__ void f_to_lds(LAS unsigned char* fl, const bf16* Fm, int rows, int rowB, int tid) {
    const int cpr = rowB >> 4, n = rows * cpr;
    for (int i = tid; i < n; i += 512) { const int r = i / cpr, c = i - r * cpr; *(LAS u32x4*)(fl + r * (rowB + 16) + c * 16) = *(const u32x4*)((const unsigned char*)Fm + (size_t)r * rowB + c * 16); }
    __syncthreads();
}
template <int NKS, int GRP = 4, int NMB = 8>
__device__ __forceinline__ void dft_mma(f32x4 (&acc)[NMB], const bf16* Fm, int ldF, int mrow0, const bf16* re, const bf16* im, size_t rstride, int khalf, int lane) {
    const int lr = lane & 15, g = lane >> 4;
#pragma unroll
    for (int k0 = 0; k0 < NKS; k0 += GRP) {
        bf16x8 bfrag[GRP];
#pragma unroll
        for (int kq = 0; kq < GRP; ++kq) { const int ks = k0 + kq; const int kk0 = 32 * ks + 8 * g; const bool part = kk0 >= khalf; const int idx = part ? kk0 - khalf : kk0;
            const bf16* src = (part ? im : re) + (size_t)idx * rstride + lr; unsigned short t[8];
#pragma unroll
            for (int e = 0; e < 8; ++e) t[e] = src[(size_t)e * rstride];
            u32x4 w; w.x = t[0] | ((unsigned)t[1] << 16); w.y = t[2] | ((unsigned)t[3] << 16); w.z = t[4] | ((unsigned)t[5] << 16); w.w = t[6] | ((unsigned)t[7] << 16);
            bfrag[kq] = __builtin_bit_cast(bf16x8, w); }
#pragma unroll
        for (int kq = 0; kq < GRP; ++kq) { const int ks = k0 + kq;
            bf16x8 a[NMB];
#pragma unroll
            for (int mb = 0; mb < NMB; ++mb) a[mb] = *(const bf16x8*)(Fm + (size_t)(mrow0 + 16 * mb + lr) * ldF + 32 * ks + 8 * g);
#pragma unroll
            for (int mb = 0; mb < NMB; ++mb) acc[mb] = MFMA16(a[mb], bfrag[kq], acc[mb]);
            if (kq & 1) __builtin_amdgcn_sched_barrier(0);
        }
    }
}
__device__ __forceinline__ void dft_mma_loop(f32x4 (&acc)[8], const bf16* Fm, int ldF, int mrow0, int nks, const bf16* re, const bf16* im, size_t rstride, int khalf, int lane) {
    const int lr = lane & 15, g = lane >> 4;
#pragma unroll 1
    for (int ks = 0; ks < nks; ++ks) { const int kk0 = 32 * ks + 8 * g; const bool part = kk0 >= khalf; const int idx = part ? kk0 - khalf : kk0;
        const bf16* src = (part ? im : re) + (size_t)idx * rstride + lr; unsigned short t[8];
#pragma unroll
        for (int e = 0; e < 8; ++e) t[e] = src[(size_t)e * rstride];
        u32x4 w; w.x = t[0] | ((unsigned)t[1] << 16); w.y = t[2] | ((unsigned)t[3] << 16); w.z = t[4] | ((unsigned)t[5] << 16); w.w = t[6] | ((unsigned)t[7] << 16);
        const bf16x8 bfrag = __builtin_bit_cast(bf16x8, w);
#pragma unroll
        for (int mb = 0; mb < 8; ++mb) { const bf16x8 a = *(const bf16x8*)(Fm + (size_t)(mrow0 + 16 * mb + lr) * ldF + 32 * ks + 8 * g); acc[mb] = MFMA16(a, bfrag, acc[mb]); }
    }
}
__device__ __forceinline__ void fft_stage1(Ctx& F) {
    const int lr = F.lane & 15, g = F.lane >> 4;
    f_to_lds(F.lds, F.F1, 128, 256, F.tid);
    for (int it = F.gw; it < 4096; it += F.NGW) { const int cb = it & 15, n2 = (it >> 4) & 127, b = it >> 11;
        f32x4 acc[8];
#pragma unroll
        for (int mb = 0; mb < 8; ++mb) acc[mb] = (f32x4){0.f, 0.f, 0.f, 0.f};
        const bf16* re = F.PB + (size_t)(b * SEQ + n2) * NP + PFA + 16 * cb;
        dft_mma_lds<4, 4>(acc, F.lds, 272, re, re + 256, (size_t)128 * NP, 64, F.lane);
#pragma unroll
        for (int mb = 0; mb < 4; ++mb)
#pragma unroll
            for (int r = 0; r < 4; ++r) { const int k1 = 16 * mb + 4 * g + r; const float a = (float)(k1 * n2) * (1.f / 8192.f); const float c = cos_rev(a), s = sin_rev(a);
                const float tr = acc[mb][r], ti = acc[mb + 4][r]; const float xr = tr * c + ti * s, xi = ti * c - tr * s;
                bf16* dst = F.TB + ((size_t)((b * 64 + k1) * 2) * 128 + n2) * 256 + 16 * cb + lr;
                dst[0] = (bf16)f2bf(xr); dst[(size_t)128 * 256] = (bf16)f2bf(xi); }
    }
}
__device__ __forceinline__ void fft_stage2(Ctx& F, int l) {
    const int lr = F.lane & 15, g = F.lane >> 4;
    f_to_lds(F.lds, F.F2, 128, 512, F.tid);
    for (int it = F.gw; it < 2048; it += F.NGW) {
        f32x4 acc[8];
#pragma unroll
        for (int mb = 0; mb < 8; ++mb) acc[mb] = (f32x4){0.f, 0.f, 0.f, 0.f};
        const int cb = it & 15, k1 = (it >> 4) & 63, b = it >> 10;
        const bf16* re = F.TB + (size_t)((b * 64 + k1) * 2) * 128 * 256 + 16 * cb;
        dft_mma_lds<8, 4>(acc, F.lds, 528, re, re + (size_t)128 * 256, 256, 128, F.lane);
#pragma unroll
        for (int mb = 0; mb < 8; ++mb)
#pragma unroll
            for (int r = 0; r < 4; ++r) { const int k2 = 16 * mb + 4 * g + r; F.YMIX[(size_t)(b * SEQ + k1 + 64 * k2) * D + 256 + 16 * cb + lr] = (bf16)f2bf(acc[mb][r]); }
    }
    __syncthreads();
}
__device__ __forceinline__ void ctx_dft(Ctx& F, int w0, int nw) {
    const int lr = F.lane & 15, g = F.lane >> 4;
    for (int it = w0; it >= 0 && it < 256; it += nw) { const int mq = it & 7, cb = (it >> 3) & 15, b = it >> 7;
            f32x4 acc[2] = {(f32x4){0.f, 0.f, 0.f, 0.f}, (f32x4){0.f, 0.f, 0.f, 0.f}};
            const bf16* re = F.PB + (size_t)(ML + b * CTXL) * NP + PFA + 16 * cb;
            dft_mma<8, 4, 2>(acc, F.FC, 512, 32 * mq, re, re, (size_t)NP, 256, F.lane); __builtin_amdgcn_sched_barrier(0);
            dft_mma<8, 4, 2>(acc, F.FC + 256, 512, 32 * mq, re + 256, re + 256, (size_t)NP, 256, F.lane);
#pragma unroll
            for (int mb = 0; mb < 2; ++mb)
#pragma unroll
                for (int r = 0; r < 4; ++r) { const int k = 32 * mq + 16 * mb + 4 * g + r; F.YMIX[(size_t)(ML + b * CTXL + k) * D + 256 + 16 * cb + lr] = (bf16)f2bf(acc[mb][r]); }
        }
}
__device__ __forceinline__ void load8(const bf16* q, float (&v)[8]) { const u32x4 w = *(const u32x4*)q; v[0] = bflo(w.x); v[1] = bfhi(w.x); v[2] = bflo(w.y); v[3] = bfhi(w.y); v[4] = bflo(w.z); v[5] = bfhi(w.z); v[6] = bflo(w.w); v[7] = bfhi(w.w); }
__device__ __forceinline__ void store8(bf16* q, const float (&v)[8]) { u32x4 w; w.x = pk2(v[0], v[1]); w.y = pk2(v[2], v[3]); w.z = pk2(v[4], v[5]); w.w = pk2(v[6], v[7]); *(u32x4*)q = w; }
__device__ __forceinline__ u32x4 ldrow(const bf16* base, int rbase, int t, int n, int col) { const int tc = t < 0 ? 0 : (t > n - 1 ? n - 1 : t); return *(const u32x4*)(base + (size_t)(rbase + tc) * NP + col); }
__device__ __forceinline__ void unpack8(const u32x4 w, float (&v)[8]) { v[0] = bflo(w.x); v[1] = bfhi(w.x); v[2] = bflo(w.y); v[3] = bfhi(w.y); v[4] = bflo(w.z); v[5] = bfhi(w.z); v[6] = bflo(w.w); v[7] = bfhi(w.w); }
__device__ __forceinline__ void convpool_item(PP p, Ctx& F, int l, int it) {
    int rbase, n, t0;
    if (it < 256) { rbase = it * 64; n = 64; t0 = 0; } else { const int sg = it - 256; rbase = ML + (sg >> 2) * CTXL; n = CTXL; t0 = (sg & 3) * 64; }
    const int oct = F.tid & 31, tl = F.tid >> 5, c0 = 8 * oct, tb = t0 + tl * 4;
    {
        u32x4 hw_[6], cw_[6], bw_[4];
#pragma unroll
        for (int i = 0; i < 6; ++i) { hw_[i] = ldrow(F.PB, rbase, tb - 1 + i, n, PH + c0); cw_[i] = ldrow(F.PB, rbase, tb - 1 + i, n, PCG + c0); }
#pragma unroll
        for (int q = 0; q < 4; ++q) bw_[q] = ldrow(F.PB, rbase, tb + q, n, PBG + c0);
        const f32x4 w0a = *(const f32x4*)(p->conv_w + (l * 3 + 0) * 256 + c0), w0b = *(const f32x4*)(p->conv_w + (l * 3 + 0) * 256 + c0 + 4);
        const f32x4 w1a = *(const f32x4*)(p->conv_w + (l * 3 + 1) * 256 + c0), w1b = *(const f32x4*)(p->conv_w + (l * 3 + 1) * 256 + c0 + 4);
        const f32x4 w2a = *(const f32x4*)(p->conv_w + (l * 3 + 2) * 256 + c0), w2b = *(const f32x4*)(p->conv_w + (l * 3 + 2) * 256 + c0 + 4);
        const f32x4 cba = *(const f32x4*)(p->conv_b + l * 256 + c0), cbb = *(const f32x4*)(p->conv_b + l * 256 + c0 + 4);
        float hc[6][8];
#pragma unroll
        for (int i = 0; i < 6; ++i) { float a[8], b[8]; unpack8(hw_[i], a); unpack8(cw_[i], b); const int t = tb - 1 + i; const float msk = (t >= 0 && t < n) ? 1.f : 0.f;
#pragma unroll
            for (int e = 0; e < 8; ++e) hc[i][e] = a[e] * b[e] * msk; }
#pragma unroll
        for (int q = 0; q < 4; ++q) { float bg[8], y[8]; unpack8(bw_[q], bg);
#pragma unroll
            for (int e = 0; e < 8; ++e) { const float w0 = e < 4 ? w0a[e & 3] : w0b[e & 3], w1 = e < 4 ? w1a[e & 3] : w1b[e & 3], w2 = e < 4 ? w2a[e & 3] : w2b[e & 3], cb = e < 4 ? cba[e & 3] : cbb[e & 3];
                y[e] = bg[e] * (w0 * hc[q][e] + w1 * hc[q + 1][e] + w2 * hc[q + 2][e] + cb); }
            store8(F.YMIX + (size_t)(rbase + tb + q) * D + 512 + c0, y); }
    }
    __builtin_amdgcn_sched_barrier(0);
    {
        const int wnd = 2 << (oct >> 3), hw = wnd >> 1;
        float s[4][8], self[4][8];
#pragma unroll
        for (int q = 0; q < 4; ++q) { unpack8(ldrow(F.PB, rbase, tb + q, n, PPOOL + c0), self[q]);
#pragma unroll
            for (int e = 0; e < 8; ++e) s[q][e] = 0.f; }
        __builtin_amdgcn_sched_barrier(0);
#pragma unroll
        for (int bt = 0; bt < 19; bt += 7) {
            u32x4 pw[7];
#pragma unroll
            for (int ii = 0; ii < 7; ++ii) if (bt + ii < 19) pw[ii] = ldrow(F.PB, rbase, tb - hw + bt + ii, n, PPOOL + c0);
#pragma unroll
            for (int ii = 0; ii < 7; ++ii) if (bt + ii < 19) { const int i = bt + ii; float v[8]; unpack8(pw[ii], v); const int t = tb - hw + i; const bool inr = (t >= 0 && t < n);
#pragma unroll
                for (int q = 0; q < 4; ++q) { const float mk = (inr && i >= q && i < q + wnd) ? 1.f : 0.f;
#pragma unroll
                    for (int e = 0; e < 8; ++e) s[q][e] += mk * v[e]; } }
            __builtin_amdgcn_sched_barrier(0);
        }
#pragma unroll
        for (int q = 0; q < 4; ++q) { const int t = tb + q; const int lo = (t - hw > 0) ? t - hw : 0, hi = (t + hw - 1 < n - 1) ? t + hw - 1 : n - 1; const float inv = 1.f / (float)(hi - lo + 1);
            float y[8];
#pragma unroll
            for (int e = 0; e < 8; ++e) y[e] = s[q][e] * inv - self[q][e];
            store8(F.YMIX + (size_t)(rbase + t) * D + 768 + c0, y); }
    }
}
__device__ __forceinline__ void ctx_act(PP p, Ctx& F, int l) {
    const int gt = blockIdx.x * 512 + F.tid, NT = F.G * 512;
    for (int i = gt; i < MC * 352; i += NT) { const int oc = i % 352, rc = i / 352, t = rc & 255, c0 = 8 * oc;
        const bf16* base = F.CAU + (size_t)rc * NUP + c0; float a[8], y[8], u[8];
        const float* cw = p->ffn_cw + (size_t)l * 3 * DFF + c0; const float* cb = p->ffn_cb + (size_t)l * DFF + c0;
#pragma unroll
        for (int e = 0; e < 8; ++e) y[e] = cb[e];
        if (t > 0) { load8(base - NUP, a);
#pragma unroll
            for (int e = 0; e < 8; ++e) y[e] += cw[e] * a[e]; }
        load8(base, a);
#pragma unroll
        for (int e = 0; e < 8; ++e) y[e] += cw[DFF + e] * a[e];
        if (t < 255) { load8(base + NUP, a);
#pragma unroll
            for (int e = 0; e < 8; ++e) y[e] += cw[2 * DFF + e] * a[e]; }
        load8(base + DFF, u);
#pragma unroll
        for (int e = 0; e < 8; ++e) y[e] = silu_f(y[e]) * u[e];
        store8(F.ACT + (size_t)(ML + rc) * DFF + c0, y);
    }
}
__global__ void __launch_bounds__(512, 2) fwd_megakernel(Params p_) {
    PP p = (PP)__builtin_amdgcn_kernarg_segment_ptr();
    extern __shared__ __attribute__((aligned(16))) unsigned char lds_raw[];
    cg::grid_group grid = cg::this_grid();
    Ctx F;
    F.lds = (LAS unsigned char*)lds_raw; F.tid = threadIdx.x; F.lane = F.tid & 63; F.wave = __builtin_amdgcn_readfirstlane(F.tid >> 6);
    const int wave_s = F.wave;
    F.G = gridDim.x; F.gw = blockIdx.x * 8 + F.wave; F.NGW = F.G * 8;
    unsigned char* ws = p->ws;
#define SETPTRS() do { { PP q_ = (PP)__builtin_amdgcn_kernarg_segment_ptr(); asm volatile("" : "+s"(q_)); p = q_; } unsigned char* w_ = p->ws; asm volatile("" : "+s"(w_)); \
    F.MOD = (float*)(w_ + WS_MOD); F.MCS = (float*)(w_ + WS_MCS); F.F1 = (bf16*)(w_ + WS_F1); F.F2 = (bf16*)(w_ + WS_F2); F.FC = (bf16*)(w_ + WS_FC); \
    F.HX = (bf16*)(w_ + WS_HX); F.TB = (bf16*)(w_ + WS_HX); F.YMIX = (bf16*)(w_ + WS_YMIX); F.PB = (bf16*)(w_ + WS_P); F.ACT = (bf16*)(w_ + WS_P); \
    F.XC = (float*)(w_ + WS_XC); F.ST = (float*)(w_ + WS_ST); F.DEC = (float*)(w_ + WS_DEC); F.CAU = (bf16*)(w_ + WS_CAU); } while (0)
    SETPTRS();

#ifndef NO_P0
#define REFRESH() do { int t_; asm volatile("v_mbcnt_lo_u32_b32 %0, -1, 0\n\tv_mbcnt_hi_u32_b32 %0, -1, %0" : "=v"(t_)); t_ |= (wave_s << 6); F.tid = t_; F.lane = t_ & 63; F.wave = __builtin_amdgcn_readfirstlane(t_ >> 6); F.gw = blockIdx.x * 8 + F.wave; SETPTRS(); } while (0)
    { volatile LAS unsigned* misc = (volatile LAS unsigned*)(F.lds + RING_BYTES); if (F.tid < 64) misc[F.tid] = 0u; }
    __syncthreads();
    XcdBarrier bar = xcd_barrier_post((unsigned*)(ws + WS_CTL), (volatile LAS unsigned*)(F.lds + RING_BYTES) + 8, F.tid);
#define GSYNC() do { REFRESH(); xcd_barrier(bar, F.tid); } while (0)
    REFRESH();
    phase0(p, F);
#endif
    if (p->ws == nullptr) grid.sync();
    GSYNC();
#define L0() ({ int lq_ = l; asm volatile("" : "+s"(lq_)); lq_ == 0; })
    for (int l = 0; l < 2; ++l) {
        const int M6 = L0() ? MT : ML;
#ifndef NO_P1
        REFRESH();
        norm_phase(p, F, l, 0, MT);
        REFRESH();
        if (L0()) fold_items(p, F);
#ifdef PROBE_B
        REFRESH(); norm_phase(p, F, l, 0, MT); if (L0()) fold_items(p, F);
#endif
#endif
        GSYNC();
#ifndef NO_P2
        REFRESH();
        { pg8::Gemm g{F.HX, win_t(p, l), MT, NP, D, D}; pg8::StaticOrder S; S.init(MT, NP, F.G, (int)blockIdx.x);
          EpiP E{F.PB, p->b_a2 + l * 256};
          pg8::gemm_phase<EpiP, pg8::StaticOrder, true, true>(F.lds, g, S, E, F.tid);
#ifdef PROBE_C
          __syncthreads(); pg8::gemm_phase<EpiP, pg8::StaticOrder, true, true>(F.lds, g, S, E, F.tid);
#endif
        }
#endif
        GSYNC();
#ifdef PROBE_A
        for (int rep_ = 0; rep_ < 2; ++rep_) {
#else
        {
#endif
#ifndef NO_GA
        REFRESH();
        for (int it = blockIdx.x; it < 2 * NCH; it += F.G) gla_a_item(F, it / NCH, it % NCH);
#ifdef PR_GA
        __syncthreads(); REFRESH();
        for (int it = blockIdx.x; it < 2 * NCH; it += F.G) gla_a_item(F, it / NCH, it % NCH);
#endif
#endif
#ifndef NO_F1
        REFRESH();
        fft_stage1(F);
#ifdef PR_F1
        __syncthreads(); REFRESH();
        fft_stage1(F);
#endif
#endif
#ifndef NO_CP
        REFRESH();
        for (int v = blockIdx.x; v < 512; v += F.G) { const int it = (v < 256) ? v : 256 + ((v + 248) & 255);
            if (it >= (L0() ? 264 : 256)) continue; convpool_item(p, F, l, it); }
#ifdef PR_CP
        __syncthreads(); REFRESH();
        for (int v = blockIdx.x; v < 512; v += F.G) { const int it = (v < 256) ? v : 256 + ((v + 248) & 255);
            if (it >= (L0() ? 264 : 256)) continue; convpool_item(p, F, l, it); }
#endif
#endif
        }
        GSYNC();
#ifdef PROBE_A
        REFRESH(); fft_stage2(F, l);
#endif
#ifndef NO_F2
        REFRESH();
        fft_stage2(F, l);
#ifdef PR_F2
        __syncthreads(); REFRESH();
        fft_stage2(F, l);
#endif
#endif
#ifndef NO_SC
        REFRESH();
        gla_scan(F);
#endif
        GSYNC();
#ifdef PROBE_A
        for (int rep_ = 0; rep_ < 2; ++rep_) {
#else
        {
#endif
#ifndef NO_GC
        REFRESH();
        for (int it = blockIdx.x; it < 256; it += F.G) gla_c_item<2>(p, F, l, it >> 7, 4 + (it & 127), 0);
        if (L0()) for (int j = blockIdx.x; j < 16; j += F.G) gla_c_item<1>(p, F, l, j >> 3, (j >> 1) & 3, j & 1);
        if (L0()) { if (F.G == 256) ctx_dft(F, F.gw - 256, 1 << 30); else ctx_dft(F, F.gw, F.NGW); }
#ifdef PR_GC
        __syncthreads(); REFRESH();
        for (int it = blockIdx.x; it < 256; it += F.G) gla_c_item<2>(p, F, l, it >> 7, 4 + (it & 127), 0);
#endif
#endif
        }
        GSYNC();
#ifndef NO_P6
        REFRESH();
        if (L0()) { pg8::Gemm g{F.YMIX, wout_t(p, l), MT, D, 256, D}; SplitOrder S; S.init(4, F.G, (int)blockIdx.x);
          EpiPartial E{(float*)(p->ws + WS_PART)};
          pg8::gemm_phase<EpiPartial, SplitOrder, false, false>(F.lds, g, S, E, F.tid); __syncthreads(); }
        REFRESH();
        { pg8::Gemm g{F.YMIX, wout_t(p, l), ML, D, D, D}; pg8::StaticOrder S; S.init(ML, D, F.G, (int)blockIdx.x);
          if (L0()) { EpiRes<false, true> E{p->x, p->out, F.MOD + l * 3 * 6144 + 2048}; pg8::gemm_phase<EpiRes<false, true>, pg8::StaticOrder, true, true>(F.lds, g, S, E, F.tid); }
          else if (F.G == 256) { EpiResNorm E{(const bf16*)p->out, (bf16*)(p->ws + WS_XB2), F.HX, F.MOD + l * 3 * 6144 + 2048, p->norm2_g + l * D, F.MOD + l * 3 * 6144, (float*)(p->ws + WS_SLOT) + 65536 * 2, (unsigned*)(p->ws + WS_CTL) + CW_FIN + 4096};
            pg8::gemm_phase<EpiResNorm, pg8::StaticOrder, false, true>(F.lds, g, S, E, F.tid); }
          else { EpiRes<true, true> E{p->out, p->out, F.MOD + l * 3 * 6144 + 2048}; pg8::gemm_phase<EpiRes<true, true>, pg8::StaticOrder, true, true>(F.lds, g, S, E, F.tid); } }
#endif
        GSYNC();
        if (L0() || F.G != 256) { REFRESH(); norm_phase(p, F, l, 1, M6); GSYNC(); }
#ifndef NO_P8
        REFRESH();
        { pg8::Gemm g{F.HX, wup_t(p, l), ML, NUP, D, D}; pg8::StaticOrder S; S.init(ML, NUP, F.G, (int)blockIdx.x);
          EpiUp E{F.ACT, p->ffn_cw + (size_t)l * 3 * DFF, p->ffn_cb + (size_t)l * DFF};
          pg8::gemm_phase<EpiUp, pg8::StaticOrder, true, true>(F.lds, g, S, E, F.tid);
        }
        if (L0()) { REFRESH(); __syncthreads();
          pg8::Gemm g{F.HX, wup_t(p, l), MT, NUP, D, D}; CtxOrder S; S.init(NUP, (int)blockIdx.x, 128);
          EpiUpCtx E{F.ACT, p->ffn_cw + (size_t)l * 3 * DFF, p->ffn_cb + (size_t)l * DFF, (LAS float*)(F.lds + RING_BYTES + 1024)};
          pg8::gemm_phase<EpiUpCtx, CtxOrder, true, false>(F.lds, g, S, E, F.tid); }
#endif
        GSYNC();
#ifndef NO_P9
        REFRESH();
        if (L0()) { pg8::Gemm g{F.ACT, wdn_t(p, l), MT, D, 256, DFF}; SplitOrder S; S.init(11, F.G, (int)blockIdx.x);
          EpiPartial E{(float*)(p->ws + WS_PART)};
          pg8::gemm_phase<EpiPartial, SplitOrder, false, false>(F.lds, g, S, E, F.tid); __syncthreads(); }
        REFRESH();
        { pg8::Gemm g{F.ACT, wdn_t(p, l), ML, D, DFF, DFF}; pg8::StaticOrder S; S.init(ML, D, F.G, (int)blockIdx.x);
          if (L0()) { EpiRes<true, true> E{p->out, p->out, F.MOD + l * 3 * 6144 + 5120}; pg8::gemm_phase<EpiRes<true, true>, pg8::StaticOrder, true, true>(F.lds, g, S, E, F.tid); }
          else if (F.G == 256) { EpiFinal E{(const bf16*)(p->ws + WS_XB2), p->out, F.MOD + l * 3 * 6144 + 5120, p->final_g, (float*)(p->ws + WS_SLOT), (unsigned*)(p->ws + WS_CTL) + CW_FIN};
            pg8::gemm_phase<EpiFinal, pg8::StaticOrder, false, true>(F.lds, g, S, E, F.tid); }
          else { EpiRes<true, false> E{p->out, p->ws + WS_HX, F.MOD + l * 3 * 6144 + 5120}; pg8::gemm_phase<EpiRes<true, false>, pg8::StaticOrder, true, true>(F.lds, g, S, E, F.tid); } }
#endif
        if (L0() || F.G != 256) GSYNC();
    }
        REFRESH();
    if (F.G != 256) final_norm(p, F);
}

extern "C" void kernel_launch(void* const* d_in, const int* in_sizes, int n_in, void* d_out, int out_size, void* d_ws, size_t ws_size, hipStream_t stream) {
    static int grid = 0;
    if (grid == 0) {
        if (n_in != 23 || in_sizes[0] != ML * D || out_size != ML * D || ws_size < WS_END) { fprintf(stderr, "kernel_launch: unexpected shapes / workspace (%d inputs, ws %zu)\n", n_in, ws_size); grid = -1; return; }
        int dev = 0, cus = 0, per_cu = 0;
        hipGetDevice(&dev); hipDeviceGetAttribute(&cus, hipDeviceAttributeMultiprocessorCount, dev);
        if (hipFuncSetAttribute((const void*)fwd_megakernel, hipFuncAttributeMaxDynamicSharedMemorySize, LDS_BYTES) != hipSuccess) { fprintf(stderr, "hipFuncSetAttribute failed\n"); grid = -1; return; }
        if (hipOccupancyMaxActiveBlocksPerMultiprocessor(&per_cu, (const void*)fwd_megakernel, 512, LDS_BYTES) != hipSuccess || per_cu < 1) per_cu = 1;
        (void)hipGetLastError();
        grid = cus * 1;
    }
    if (grid < 0) return;
    if (hipMemsetAsync((char*)d_ws + WS_CTL, 0, 65536, stream) != hipSuccess) { fprintf(stderr, "memset failed\n"); return; }
    Params p{};
    const float** pp = (const float**)&p;
    for (int i = 0; i < 23; ++i) pp[i] = (const float*)d_in[i];
    p.out = (float*)d_out; p.ws = (unsigned char*)d_ws;
    void* args[] = {&p};
    hipError_t e = hipLaunchCooperativeKernel((const void*)fwd_megakernel, dim3(grid), dim3(512), args, LDS_BYTES, stream);
    if (e != hipSuccess) fprintf(stderr, "cooperative launch failed: %s (grid %d)\n", hipGetErrorString(e), grid);
}
```

```cpp
#include <hip/hip_runtime.h>
#include <hip/hip_cooperative_groups.h>
#include <cstdio>
#include <cstdint>
namespace cg = cooperative_groups;
namespace pg8 {
#define PG8_LAS __attribute__((address_space(3)))
typedef unsigned short bf16_t;
typedef short bf16x8 __attribute__((ext_vector_type(8)));
typedef float f32x4 __attribute__((ext_vector_type(4)));
typedef unsigned u32x4 __attribute__((ext_vector_type(4)));
constexpr int BM = 256, BK = 64, HALF = 128, HTB = HALF * BK * 2  , STAGE_BYTES = 8 * HTB, NXCD = 8, WGM = 4;

__host__ __device__ __forceinline__ int lds_byte(int r, int c) { const int st = (r >> 4) * 2 + (c >> 5), rr = r & 15, cc = c & 31, ob = rr * 64 + cc * 2; return st * 1024 + (ob ^ (((ob >> 9) & 1) << 5)); }
__host__ __device__ __forceinline__ void stage_rc(int b, int& R, int& C) { const int st = b / 1024, sb = b % 1024, swz = sb ^ (((sb >> 9) & 1) << 5); R = (st >> 1) * 16 + swz / 64; C = (st & 1) * 32 + (swz % 64) / 2; }
__host__ __device__ __forceinline__ int perm32(int rho) { const int n = rho >> 4, i = rho & 15; return 8 * (i >> 2) + 4 * n + (i & 3); }

struct Unit { int pm, pn, ks; };
struct Gemm { const bf16_t* A; const bf16_t* Bt; int M, N, K, ld; };

struct StaticOrder {
    int nM, nN, nwg, G, c;
    __host__ __device__ void init(int M, int N, int G_, int c_) { nM = M / BM; nN = N / BM; nwg = nM * nN; G = G_; c = c_; }
    __host__ __device__ bool next(int i, Unit& u) const {
        const long L = (long)i * G + c; if (L >= nwg) return false;
        int wgid = (int)L; { const int q = nwg / NXCD, r = nwg % NXCD, xcd = wgid % NXCD, off = wgid / NXCD; wgid = (xcd < r ? xcd * (q + 1) : r * (q + 1) + (xcd - r) * q) + off; }
        const int nig = WGM * nN, gid = wgid / nig, fm = gid * WGM, gsz = (nM - fm) < WGM ? (nM - fm) : WGM;
        u.pm = fm + ((wgid % nig) % gsz); u.pn = (wgid % nig) / gsz; u.ks = 0; return true;
    }
    __device__ __forceinline__ void a_ready(const Unit&) const {}
    __device__ __forceinline__ void done(const Unit&) const {}
};

__device__ __forceinline__ unsigned cvt_pk_bf16(float lo, float hi) { unsigned r; asm volatile("v_cvt_pk_bf16_f32 %0, %1, %2" : "=v"(r) : "v"(lo), "v"(hi)); return r; }
template <class Epi, class Sched, bool ALIGN_EPI = false, bool SP2 = false>
__device__ __forceinline__ void gemm_phase(PG8_LAS unsigned char* lds, const Gemm g, const Sched& S, const Epi& E, int tid_in) {
    int tid_ = tid_in; asm volatile("" : "+v"(tid_)); const int tid = tid_, wid = __builtin_amdgcn_readfirstlane(tid >> 6), lane = tid & 63, wr = wid >> 2, wc = wid & 3, fr = lane & 15, fq = lane >> 4;
    const int K = g.ld, nt = g.K / BK; const size_t sstep = (size_t)g.K * 2;
    unsigned voffA[2], voffB[2];
#pragma unroll
    for (int i = 0; i < 2; ++i) { int R, C; stage_rc(tid * 16 + i * 8192, R, C); const int Rb = Epi::PERM ? ((R & ~31) + perm32(R & 31)) : R;
        voffA[i] = (unsigned)(R * K + C) * 2u; voffB[i] = (unsigned)(Rb * K + C) * 2u; }
    const size_t kstep = (size_t)(BK * 2);
    const size_t hstep = (size_t)HALF * K * 2;
    const size_t tstep = 2 * hstep;
    const unsigned ldsw = (unsigned)wid * 1024u;
    const int aoff = lds_byte(wr * 64 + fr, fq * 8), boff = lds_byte(wc * 32 + fr, fq * 8);
#define PG8_SA(b, h) (((b) * 2 + (h)) * HTB)
#define PG8_SB(b, h) ((4 + (b) * 2 + (h)) * HTB)
#define PG8_STAGE(bufoff, gbase, voff) do { _Pragma("unroll") for (int _i = 0; _i < 2; ++_i) \
        __builtin_amdgcn_global_load_lds((const unsigned*)((const char*)(gbase) + (voff)[_i]), (PG8_LAS unsigned*)(lds + (bufoff) + ldsw + _i * 8192), 16, 0, 0); } while (0)
#define PG8_LDA(dst, b, h) do { _Pragma("unroll") for (int m = 0; m < 4; ++m) _Pragma("unroll") for (int k = 0; k < 2; ++k) dst[m][k] = *(const PG8_LAS bf16x8*)(lds + PG8_SA(b, h) + aoff + m * 2048 + k * 1024); } while (0)
#define PG8_LDB(dst, b, h) do { _Pragma("unroll") for (int n = 0; n < 2; ++n) _Pragma("unroll") for (int k = 0; k < 2; ++k) dst[n][k] = *(const PG8_LAS bf16x8*)(lds + PG8_SB(b, h) + boff + n * 2048 + k * 1024); } while (0)
#define PG8_MMA(ai, bj, At, Bt) do { __builtin_amdgcn_s_setprio(1); _Pragma("unroll") for (int m = 0; m < 4; ++m) _Pragma("unroll") for (int n = 0; n < 2; ++n) _Pragma("unroll") for (int k = 0; k < 2; ++k) \
        acc[ai][bj][m][n] = __builtin_amdgcn_mfma_f32_16x16x32_bf16(Bt[n][k], At[m][k], acc[ai][bj][m][n], 0, 0, 0); __builtin_amdgcn_s_setprio(0); } while (0)
#define PG8_WAIT_V(n) asm volatile("s_waitcnt vmcnt(" #n ")" ::: "memory")
#define PG8_WAIT_L(n) asm volatile("s_waitcnt lgkmcnt(" #n ")" ::: "memory")
#define PG8_BAR __builtin_amdgcn_s_barrier()
#define PG8_SCHED __builtin_amdgcn_sched_barrier(0)
    Unit cur, nxt; int ui = 0;
    if (!S.next(0, cur)) return;
    f32x4 acc[2][2][4][2];
#pragma unroll
    for (int a = 0; a < 2; ++a)
#pragma unroll
        for (int b = 0; b < 2; ++b)
#pragma unroll
            for (int m = 0; m < 4; ++m)
#pragma unroll
                for (int n = 0; n < 2; ++n) acc[a][b][m][n] = (f32x4){0.f, 0.f, 0.f, 0.f};
    bf16x8 At[4][2], B0[2][2], B1[2][2];
    const char* cA = (const char*)g.A + (size_t)cur.pm * tstep + (size_t)cur.ks * sstep; const char* cB = (const char*)g.Bt + (size_t)cur.pn * tstep + (size_t)cur.ks * sstep;
    S.a_ready(cur);
    if constexpr (SP2) {
        PG8_STAGE(PG8_SB(0, 0), cB, voffB); PG8_STAGE(PG8_SB(0, 1), cB + hstep, voffB); PG8_STAGE(PG8_SA(0, 0), cA, voffA); PG8_STAGE(PG8_SA(0, 1), cA + hstep, voffA);
        if (wr == 1) PG8_BAR;
        PG8_WAIT_V(2); PG8_BAR;
        PG8_STAGE(PG8_SB(1, 0), cB + kstep, voffB); PG8_STAGE(PG8_SA(1, 0), cA + kstep, voffA); PG8_STAGE(PG8_SB(1, 1), cB + hstep + kstep, voffB);
        PG8_WAIT_V(6); PG8_BAR;
    } else {
        PG8_STAGE(PG8_SB(0, 0), cB, voffB); PG8_STAGE(PG8_SA(0, 0), cA, voffA); PG8_STAGE(PG8_SB(0, 1), cB + hstep, voffB); PG8_STAGE(PG8_SA(0, 1), cA + hstep, voffA);
        if (wr == 1) PG8_BAR;
        PG8_WAIT_V(4); PG8_BAR;
        PG8_STAGE(PG8_SB(1, 0), cB + kstep, voffB); PG8_STAGE(PG8_SA(1, 0), cA + kstep, voffA); PG8_STAGE(PG8_SB(1, 1), cB + hstep + kstep, voffB);
        PG8_WAIT_V(6); PG8_BAR;
    }
    for (;;) {
        const bool has_next = S.next(ui + 1, nxt);
        const char* nA = has_next ? (const char*)g.A + (size_t)nxt.pm * tstep + (size_t)nxt.ks * sstep : cA; const char* nB = has_next ? (const char*)g.Bt + (size_t)nxt.pn * tstep + (size_t)nxt.ks * sstep : cB;
        for (int t = 0; t < nt; t += 2) {
            const bool last = (t == nt - 2);
            const char* a1 = cA + (size_t)(t + 1) * kstep;
            const char* a2 = last ? nA : cA + (size_t)(t + 2) * kstep; const char* b2 = last ? nB : cB + (size_t)(t + 2) * kstep;
            const char* a3 = a2 + kstep; const char* b3 = b2 + kstep;
            if (last && has_next) S.a_ready(nxt);
            if constexpr (SP2) {
            PG8_LDB(B0, 0, 0); PG8_LDB(B1, 0, 1); PG8_SCHED; PG8_LDA(At, 0, 0); PG8_STAGE(PG8_SA(1, 1), a1 + hstep, voffA);
            PG8_WAIT_V(8); PG8_WAIT_L(0); PG8_BAR; PG8_MMA(0, 0, At, B0); PG8_MMA(0, 1, At, B1); PG8_BAR; PG8_SCHED;
            PG8_LDA(At, 0, 1); PG8_STAGE(PG8_SB(0, 0), b2, voffB); PG8_STAGE(PG8_SB(0, 1), b2 + hstep, voffB); PG8_STAGE(PG8_SA(0, 0), a2, voffA);
            PG8_WAIT_V(8); PG8_WAIT_L(0); PG8_BAR; PG8_MMA(1, 0, At, B0); PG8_MMA(1, 1, At, B1); PG8_BAR; PG8_SCHED;
            PG8_LDB(B0, 1, 0); PG8_LDB(B1, 1, 1); PG8_SCHED; PG8_LDA(At, 1, 0); PG8_STAGE(PG8_SA(0, 1), a2 + hstep, voffA);
            PG8_WAIT_V(8); PG8_WAIT_L(0); PG8_BAR; PG8_MMA(0, 0, At, B0); PG8_MMA(0, 1, At, B1); PG8_BAR; PG8_SCHED;
            PG8_LDA(At, 1, 1); PG8_STAGE(PG8_SB(1, 0), b3, voffB); PG8_STAGE(PG8_SB(1, 1), b3 + hstep, voffB); PG8_STAGE(PG8_SA(1, 0), a3, voffA);
            PG8_WAIT_V(8); PG8_WAIT_L(0); PG8_BAR; PG8_MMA(1, 0, At, B0); PG8_MMA(1, 1, At, B1); PG8_BAR; PG8_SCHED;
            } else {
            PG8_LDB(B0, 0, 0); PG8_SCHED; PG8_LDA(At, 0, 0); PG8_STAGE(PG8_SA(1, 1), a1 + hstep, voffA);
            PG8_WAIT_L(8); PG8_BAR; PG8_WAIT_L(0); PG8_MMA(0, 0, At, B0); PG8_BAR; PG8_SCHED;
            PG8_LDB(B1, 0, 1); PG8_STAGE(PG8_SB(0, 0), b2, voffB);
            PG8_BAR; PG8_WAIT_L(0); PG8_MMA(0, 1, At, B1); PG8_BAR;
            PG8_LDA(At, 0, 1); PG8_STAGE(PG8_SA(0, 0), a2, voffA);
            PG8_BAR; PG8_WAIT_L(0); PG8_MMA(1, 0, At, B0); PG8_BAR; PG8_SCHED;
            PG8_STAGE(PG8_SB(0, 1), b2 + hstep, voffB);
            PG8_WAIT_V(6); PG8_BAR; PG8_MMA(1, 1, At, B1); PG8_BAR;
            PG8_LDB(B0, 1, 0); PG8_SCHED; PG8_LDA(At, 1, 0); PG8_STAGE(PG8_SA(0, 1), a2 + hstep, voffA);
            PG8_WAIT_L(8); PG8_BAR; PG8_WAIT_L(0); PG8_MMA(0, 0, At, B0); PG8_BAR; PG8_SCHED;
            PG8_LDB(B1, 1, 1); PG8_STAGE(PG8_SB(1, 0), b3, voffB);
            PG8_BAR; PG8_WAIT_L(0); PG8_MMA(0, 1, At, B1); PG8_BAR;
            PG8_LDA(At, 1, 1); PG8_STAGE(PG8_SA(1, 0), a3, voffA);
            PG8_BAR; PG8_WAIT_L(0); PG8_MMA(1, 0, At, B0); PG8_BAR; PG8_SCHED;
            PG8_STAGE(PG8_SB(1, 1), b3 + hstep, voffB);
            PG8_WAIT_V(6); PG8_BAR; PG8_MMA(1, 1, At, B1); PG8_BAR;
            }
        }
        if constexpr (ALIGN_EPI) { if (wr == 0) PG8_BAR; }
        if constexpr (!Epi::AFTER_DRAIN) { E(acc, cur, wr, wc, fr, fq); S.done(cur); }
        if (!has_next) break;
#pragma unroll
        for (int a = 0; a < 2; ++a)
#pragma unroll
            for (int b = 0; b < 2; ++b)
#pragma unroll
                for (int m = 0; m < 4; ++m)
#pragma unroll
                    for (int n = 0; n < 2; ++n) acc[a][b][m][n] = (f32x4){0.f, 0.f, 0.f, 0.f};
        cur = nxt; cA = nA; cB = nB; ++ui;
        if constexpr (ALIGN_EPI) { if (wr == 1) PG8_BAR; }
    }
    PG8_WAIT_V(0);
    if constexpr (!ALIGN_EPI) { if (wr == 0) PG8_BAR; }
    PG8_BAR;
    if constexpr (Epi::AFTER_DRAIN) { E.fused(acc, cur, wr, wc, fr, fq, lds, wid, lane); S.done(cur); }
#undef PG8_SA
#undef PG8_SB
#undef PG8_STAGE
#undef PG8_LDA
#undef PG8_LDB
#undef PG8_MMA
#undef PG8_WAIT_V
#undef PG8_WAIT_L
#undef PG8_BAR
#undef PG8_SCHED
}
}
#define LAS __attribute__((address_space(3)))
typedef unsigned short bf16;
typedef float f32x4 __attribute__((ext_vector_type(4)));
typedef short bf16x8 __attribute__((ext_vector_type(8)));
typedef unsigned u32x4 __attribute__((ext_vector_type(4)));
typedef unsigned u32x2 __attribute__((ext_vector_type(2)));
#define LDS_WAIT() asm volatile("s_waitcnt lgkmcnt(0)" ::: "memory")

constexpr int D = 1024, SEQ = 8192, ML = 16384, MC = 512, MT = ML + MC, CTXL = 256;
constexpr int DIN = 2080, NP = 2560, DFF = 2816, NUP = 5632;
constexpr int PK = 0, PQ = 128, PV = 256, PLA = 512, PG = 768, PFA = 1024, PFB = 1280, PH = 1536, PBG = 1792, PCG = 2048, PPOOL = 2304;
constexpr int NCH = 132;
constexpr float EPS = 1e-6f;
constexpr size_t MiB = 1u << 20;
constexpr size_t WS_CTL = 0;
constexpr size_t WS_MOD = 1 * MiB;
constexpr size_t WS_MCS = 1 * MiB + 256 * 1024;
constexpr size_t WS_F1 = 1 * MiB + 512 * 1024;
constexpr size_t WS_F2 = WS_F1 + 32 * 1024;
constexpr size_t WS_FC = WS_F2 + 64 * 1024;
constexpr size_t WS_SLOT = 49 * MiB;
constexpr size_t WS_XB2 = 208 * MiB;
constexpr int CW_FIN = 3584;
constexpr size_t WS_W = 2 * MiB;
constexpr size_t W_IN_B = (size_t)NP * D * 2, W_OUT_B = (size_t)D * D * 2, W_UP_B = (size_t)NUP * D * 2, W_DN_B = (size_t)D * DFF * 2;
constexpr size_t W_LAYER_B = W_IN_B + W_OUT_B + W_UP_B + W_DN_B;
constexpr size_t WS_HX = 50 * MiB;
constexpr size_t WS_YMIX = 83 * MiB;
constexpr size_t WS_P = 116 * MiB;
constexpr size_t WS_XC = 207 * MiB;
constexpr size_t WS_ST = 209 * MiB;
constexpr size_t WS_DEC = 226 * MiB;
constexpr size_t WS_CAU = 227 * MiB;
constexpr size_t WS_PART = 233 * MiB;
constexpr size_t WS_END = 255 * MiB;
static_assert(WS_W + 2 * W_LAYER_B <= WS_HX, "weights");
static_assert(WS_P + (size_t)MT * DFF * 2 <= WS_XC, "act");
constexpr int RING_BYTES = 131072, LDS_BYTES = 147456;

struct Params {
    const float *x, *c, *ctx, *c_ctx, *norm1_g, *norm2_g, *w_mod, *b_mod, *w_in, *w_a2, *b_a2, *gla_g, *fft_w, *conv_w, *conv_b, *pool_w,
        *pool_scale, *w_out, *w_up, *ffn_cw, *ffn_cb, *w_down, *final_g;
    float* out; unsigned char* ws;
};

typedef const __attribute__((address_space(4))) Params* PP;
__device__ __forceinline__ unsigned f2bf(float f) { unsigned u = __builtin_bit_cast(unsigned, f); return (u + 0x7fffu + ((u >> 16) & 1u)) >> 16; }
__device__ __forceinline__ unsigned pk2(float lo, float hi) { return f2bf(lo) | (f2bf(hi) << 16); }
__device__ __forceinline__ float bf2f(unsigned h) { return __builtin_bit_cast(float, h << 16); }
__device__ __forceinline__ float bflo(unsigned w) { return __builtin_bit_cast(float, w << 16); }
__device__ __forceinline__ float bfhi(unsigned w) { return __builtin_bit_cast(float, w & 0xffff0000u); }
__device__ __forceinline__ float shfl_f(float v, int src_lane) { return __builtin_bit_cast(float, __builtin_amdgcn_ds_bpermute(src_lane << 2, __builtin_bit_cast(int, v))); }
__device__ __forceinline__ float wave_sum(float v, int lane) {
#pragma unroll
    for (int o = 1; o < 64; o <<= 1) v += shfl_f(v, lane ^ o);
    return v;
}
__device__ __forceinline__ float silu_f(float x) { return x * __builtin_amdgcn_rcpf(1.f + __expf(-x)); }
__device__ __forceinline__ float cos_rev(float r) { return __builtin_amdgcn_cosf(r); }
__device__ __forceinline__ float sin_rev(float r) { return __builtin_amdgcn_sinf(r); }
__device__ __forceinline__ bf16x8 pack8(float a0, float a1, float a2, float a3, float a4, float a5, float a6, float a7) {
    u32x4 w; w.x = pk2(a0, a1); w.y = pk2(a2, a3); w.z = pk2(a4, a5); w.w = pk2(a6, a7); return __builtin_bit_cast(bf16x8, w);
}
#define MFMA16(a, b, c) __builtin_amdgcn_mfma_f32_16x16x32_bf16(a, b, c, 0, 0, 0)

struct EpiP {
    static constexpr bool PERM = true, AFTER_DRAIN = false;
    bf16* O; const float* ba2;
    __device__ __forceinline__ void operator()(const pg8::f32x4 (&acc)[2][2][4][2], const pg8::Unit& u, int wr, int wc, int fr, int fq) const {
        const int row0 = u.pm * 256 + wr * 64 + fr, col0 = u.pn * 256 + wc * 32 + 8 * fq;
        const __amdgpu_buffer_rsrc_t prs = __builtin_amdgcn_make_buffer_rsrc(O, 0, MT * NP * 2, 0x00020000);
        const bool la = (u.pn == 2);
#pragma unroll
        for (int ai = 0; ai < 2; ++ai)
#pragma unroll
            for (int m = 0; m < 4; ++m) { bf16* rowp = O + (size_t)(row0 + ai * 128 + m * 16) * NP + col0;
#pragma unroll
                for (int bj = 0; bj < 2; ++bj) { pg8::f32x4 v0 = acc[ai][bj][m][0], v1 = acc[ai][bj][m][1];
                    if (la) { const float* bp = ba2 + (col0 + bj * 128 - PLA); const f32x4 b0 = *(const f32x4*)bp, b1 = *(const f32x4*)(bp + 4);
#pragma unroll
                        for (int e = 0; e < 4; ++e) { float xa = v0[e] + b0[e], xb = v1[e] + b1[e];
                            v0[e] = (fminf(xa, 0.f) - __logf(1.f + __expf(-fabsf(xa)))) * 0.0625f; v1[e] = (fminf(xb, 0.f) - __logf(1.f + __expf(-fabsf(xb)))) * 0.0625f; } }
                    u32x4 w; w.x = pg8::cvt_pk_bf16(v0[0], v0[1]); w.y = pg8::cvt_pk_bf16(v0[2], v0[3]); w.z = pg8::cvt_pk_bf16(v1[0], v1[1]); w.w = pg8::cvt_pk_bf16(v1[2], v1[3]);
                    *(u32x4*)(rowp + bj * 128) = w; } }
    }
};
template <bool INB, bool OUTB>
struct EpiRes {
    static constexpr bool PERM = true, AFTER_DRAIN = false;
    const void* xin; void* out; const float* modg;
    __device__ __forceinline__ void operator()(const pg8::f32x4 (&acc)[2][2][4][2], const pg8::Unit& u, int wr, int wc, int fr, int fq) const {
        const int w = u.pm >> 5; const int cb = u.pn * 256 + wc * 32 + 8 * fq;
        f32x4 gv[2][2];
#pragma unroll
        for (int bj = 0; bj < 2; ++bj)
#pragma unroll
            for (int n = 0; n < 2; ++n) gv[bj][n] = *(const f32x4*)(modg + w * 6144 + cb + bj * 128 + 4 * n);
        constexpr int RG = INB ? 4 : 2;
#pragma unroll
        for (int ai = 0; ai < 2; ++ai)
#pragma unroll
            for (int mp = 0; mp < 4 / RG; ++mp) {
                u32x4 xb[RG][2]; f32x4 xf[INB ? 1 : RG][2][2];
#pragma unroll
                for (int mm = 0; mm < RG; ++mm) { const size_t ro = (size_t)(u.pm * 256 + ai * 128 + wr * 64 + (RG * mp + mm) * 16 + fr) * D + cb;
#pragma unroll
                    for (int bj = 0; bj < 2; ++bj) {
                        if (INB) xb[mm][bj] = *(const u32x4*)((const bf16*)xin + ro + bj * 128);
                        else { xf[INB ? 0 : mm][bj][0] = __builtin_nontemporal_load((const f32x4*)((const float*)xin + ro + bj * 128)); xf[INB ? 0 : mm][bj][1] = __builtin_nontemporal_load((const f32x4*)((const float*)xin + ro + bj * 128 + 4)); } } }
#pragma unroll
                for (int mm = 0; mm < RG; ++mm) { const int m = RG * mp + mm; const size_t ro = (size_t)(u.pm * 256 + ai * 128 + wr * 64 + m * 16 + fr) * D + cb;
#pragma unroll
                    for (int bj = 0; bj < 2; ++bj) { f32x4 x0, x1;
                        if (INB) { const u32x4 t = xb[mm][bj]; x0 = (f32x4){bflo(t.x), bfhi(t.x), bflo(t.y), bfhi(t.y)}; x1 = (f32x4){bflo(t.z), bfhi(t.z), bflo(t.w), bfhi(t.w)}; }
                        else { x0 = xf[INB ? 0 : mm][bj][0]; x1 = xf[INB ? 0 : mm][bj][1]; }
                        const pg8::f32x4 a0 = acc[ai][bj][m][0], a1 = acc[ai][bj][m][1]; const f32x4 g0 = gv[bj][0], g1 = gv[bj][1];
                        f32x4 y0, y1;
#pragma unroll
                        for (int e = 0; e < 4; ++e) { y0[e] = x0[e] + g0[e] * a0[e]; y1[e] = x1[e] + g1[e] * a1[e]; }
                        if (OUTB) { u32x4 pk; pk.x = pg8::cvt_pk_bf16(y0[0], y0[1]); pk.y = pg8::cvt_pk_bf16(y0[2], y0[3]); pk.z = pg8::cvt_pk_bf16(y1[0], y1[1]); pk.w = pg8::cvt_pk_bf16(y1[2], y1[3]);
                            *(u32x4*)((bf16*)out + ro + bj * 128) = pk; }
                        else { *(f32x4*)((float*)out + ro + bj * 128) = y0; *(f32x4*)((float*)out + ro + bj * 128 + 4) = y1; } } }
            }
    }
};
template <bool STORE_X>
__device__ __forceinline__ void panel_rms(pg8::f32x4 (&acc)[2][2][4][2], const pg8::Unit& u, int wr, int wc, int fr, int fq, LAS unsigned char* lds, int wid, int lane,
                                          const bf16* xin, bf16* xout, const float* modg, float* slots, unsigned* cnt) {
    const int w = u.pm >> 5; const int cb = u.pn * 256 + wc * 32 + 8 * fq;
    LAS float* P = (LAS float*)lds;
    LAS float* S = (LAS float*)(lds + 4096);
    f32x4 gv[2][2];
#pragma unroll
    for (int bj = 0; bj < 2; ++bj)
#pragma unroll
        for (int n = 0; n < 2; ++n) gv[bj][n] = *(const f32x4*)(modg + w * 6144 + cb + bj * 128 + 4 * n);
#pragma unroll
    for (int ai = 0; ai < 2; ++ai) {
        u32x4 xb[4][2];
#pragma unroll
        for (int m = 0; m < 4; ++m) { const size_t ro = (size_t)(u.pm * 256 + ai * 128 + wr * 64 + m * 16 + fr) * D + cb;
#pragma unroll
            for (int bj = 0; bj < 2; ++bj) xb[m][bj] = *(const u32x4*)(xin + ro + bj * 128); }
#pragma unroll
        for (int m = 0; m < 4; ++m) { float sq = 0.f; const size_t ro = (size_t)(u.pm * 256 + ai * 128 + wr * 64 + m * 16 + fr) * D + cb;
#pragma unroll
            for (int bj = 0; bj < 2; ++bj) { const u32x4 t = xb[m][bj]; const f32x4 g0 = gv[bj][0], g1 = gv[bj][1]; pg8::f32x4 a0 = acc[ai][bj][m][0], a1 = acc[ai][bj][m][1];
                a0[0] = bflo(t.x) + g0[0] * a0[0]; a0[1] = bfhi(t.x) + g0[1] * a0[1]; a0[2] = bflo(t.y) + g0[2] * a0[2]; a0[3] = bfhi(t.y) + g0[3] * a0[3];
                a1[0] = bflo(t.z) + g1[0] * a1[0]; a1[1] = bfhi(t.z) + g1[1] * a1[1]; a1[2] = bflo(t.w) + g1[2] * a1[2]; a1[3] = bfhi(t.w) + g1[3] * a1[3];
                acc[ai][bj][m][0] = a0; acc[ai][bj][m][1] = a1;
                sq += ((a0[0] * a0[0] + a0[1] * a0[1]) + (a0[2] * a0[2] + a0[3] * a0[3])) + ((a1[0] * a1[0] + a1[1] * a1[1]) + (a1[2] * a1[2] + a1[3] * a1[3]));
                if (STORE_X) { u32x4 pk; pk.x = pg8::cvt_pk_bf16(a0[0], a0[1]); pk.y = pg8::cvt_pk_bf16(a0[2], a0[3]); pk.z = pg8::cvt_pk_bf16(a1[0], a1[1]); pk.w = pg8::cvt_pk_bf16(a1[2], a1[3]);
                    *(u32x4*)(xout + ro + bj * 128) = pk; } }
            sq += shfl_f(sq, lane ^ 16); sq += shfl_f(sq, lane ^ 32);
            if (fq == 0) P[(ai * 128 + wr * 64 + m * 16 + fr) * 4 + wc] = sq; }
    }
    asm volatile("s_waitcnt lgkmcnt(0)" ::: "memory"); __builtin_amdgcn_s_barrier(); asm volatile("" ::: "memory");
    const int row = wid * 32 + (lane & 31);
    if (lane < 32) { const float t = (P[row * 4 + 0] + P[row * 4 + 1]) + (P[row * 4 + 2] + P[row * 4 + 3]);
        __hip_atomic_store(slots + ((size_t)(u.pm * 256 + row) * 4 + u.pn), t, __ATOMIC_RELAXED, __HIP_MEMORY_SCOPE_AGENT); }
    asm volatile("s_waitcnt vmcnt(0)" ::: "memory");
    if (lane == 0) (void)__hip_atomic_fetch_add(cnt + 64 * u.pm, 1u, __ATOMIC_RELAXED, __HIP_MEMORY_SCOPE_AGENT);
    if (wid == 0) { unsigned sp = 0;
        while ((unsigned)__builtin_amdgcn_readfirstlane((int)__hip_atomic_load(cnt + 64 * u.pm, __ATOMIC_RELAXED, __HIP_MEMORY_SCOPE_AGENT)) < 32u) { __builtin_amdgcn_s_sleep(2); if (++sp > (1u << 22)) break; }
        __builtin_amdgcn_fence(__ATOMIC_ACQUIRE, "agent"); }
    asm volatile("s_waitcnt vmcnt(0) lgkmcnt(0)" ::: "memory"); __builtin_amdgcn_s_barrier(); asm volatile("" ::: "memory");
    if (lane < 32) { const float* sl = slots + (size_t)(u.pm * 256 + row) * 4; float t = 0.f;
#pragma unroll
        for (int q = 0; q < 4; ++q) t += __hip_atomic_load(sl + q, __ATOMIC_RELAXED, __HIP_MEMORY_SCOPE_AGENT);
        S[row] = 1.f / sqrtf(t * (1.f / D) + EPS); }
    asm volatile("s_waitcnt vmcnt(0) lgkmcnt(0)" ::: "memory"); __builtin_amdgcn_s_barrier(); asm volatile("" ::: "memory");
}
struct EpiFinal {
    static constexpr bool PERM = true, AFTER_DRAIN = true;
    const bf16* xin; float* out; const float* modg; const float* gfin; float* slots; unsigned* cnt;
    __device__ __forceinline__ void fused(pg8::f32x4 (&acc)[2][2][4][2], const pg8::Unit& u, int wr, int wc, int fr, int fq, LAS unsigned char* lds, int wid, int lane) const {
        panel_rms<false>(acc, u, wr, wc, fr, fq, lds, wid, lane, xin, nullptr, modg, slots, cnt);
        const LAS float* S = (const LAS float*)(lds + 4096); const int cb = u.pn * 256 + wc * 32 + 8 * fq;
        f32x4 gf[2][2];
#pragma unroll
        for (int bj = 0; bj < 2; ++bj)
#pragma unroll
            for (int n = 0; n < 2; ++n) gf[bj][n] = *(const f32x4*)(gfin + cb + bj * 128 + 4 * n);
#pragma unroll
        for (int ai = 0; ai < 2; ++ai)
#pragma unroll
            for (int m = 0; m < 4; ++m) { const int r = ai * 128 + wr * 64 + m * 16 + fr; const float rs = S[r]; float* o = out + (size_t)(u.pm * 256 + r) * D + cb;
#pragma unroll
                for (int bj = 0; bj < 2; ++bj)
#pragma unroll
                    for (int n = 0; n < 2; ++n) { const pg8::f32x4 a = acc[ai][bj][m][n]; const f32x4 g4 = gf[bj][n];
                        *(f32x4*)(o + bj * 128 + 4 * n) = (f32x4){a[0] * rs * g4[0], a[1] * rs * g4[1], a[2] * rs * g4[2], a[3] * rs * g4[3]}; } }
    }
};
struct EpiResNorm {
    static constexpr bool PERM = true, AFTER_DRAIN = true;
    const bf16* xin; bf16* xout; bf16* hout; const float* modg; const float* gn; const float* modn; float* slots; unsigned* cnt;
    __device__ __forceinline__ void fused(pg8::f32x4 (&acc)[2][2][4][2], const pg8::Unit& u, int wr, int wc, int fr, int fq, LAS unsigned char* lds, int wid, int lane) const {
        panel_rms<true>(acc, u, wr, wc, fr, fq, lds, wid, lane, xin, xout, modg, slots, cnt);
        const LAS float* S = (const LAS float*)(lds + 4096); const int w = u.pm >> 5; const int cb = u.pn * 256 + wc * 32 + 8 * fq;
        f32x4 gm[2][2], shv[2][2];
#pragma unroll
        for (int bj = 0; bj < 2; ++bj)
#pragma unroll
            for (int n = 0; n < 2; ++n) { const int c = cb + bj * 128 + 4 * n; const f32x4 g4 = *(const f32x4*)(gn + c), s4 = *(const f32x4*)(modn + w * 6144 + 4096 + c);
                shv[bj][n] = *(const f32x4*)(modn + w * 6144 + 3072 + c); gm[bj][n] = (f32x4){g4[0] * (1.f + s4[0]), g4[1] * (1.f + s4[1]), g4[2] * (1.f + s4[2]), g4[3] * (1.f + s4[3])}; }
#pragma unroll
        for (int ai = 0; ai < 2; ++ai)
#pragma unroll
            for (int m = 0; m < 4; ++m) { const int r = ai * 128 + wr * 64 + m * 16 + fr; const float rs = S[r]; bf16* o = hout + (size_t)(u.pm * 256 + r) * D + cb;
#pragma unroll
                for (int bj = 0; bj < 2; ++bj) { const pg8::f32x4 a0 = acc[ai][bj][m][0], a1 = acc[ai][bj][m][1]; const f32x4 g0 = gm[bj][0], g1 = gm[bj][1], h0 = shv[bj][0], h1 = shv[bj][1];
                    u32x4 pk; pk.x = pg8::cvt_pk_bf16(a0[0] * rs * g0[0] + h0[0], a0[1] * rs * g0[1] + h0[1]); pk.y = pg8::cvt_pk_bf16(a0[2] * rs * g0[2] + h0[2], a0[3] * rs * g0[3] + h0[3]);
                    pk.z = pg8::cvt_pk_bf16(a1[0] * rs * g1[0] + h1[0], a1[1] * rs * g1[1] + h1[1]); pk.w = pg8::cvt_pk_bf16(a1[2] * rs * g1[2] + h1[2], a1[3] * rs * g1[3] + h1[3]);
                    *(u32x4*)(o + bj * 128) = pk; } }
    }
};
struct EpiUp {
    static constexpr bool PERM = true, AFTER_DRAIN = false;
    bf16* ACT; const float* cw; const float* cb;
    __device__ __forceinline__ void operator()(const pg8::f32x4 (&acc)[2][2][4][2], const pg8::Unit& u, int wr, int wc, int fr, int fq) const {
        const int hc0 = u.pn * 128 + wc * 32 + 8 * fq;
        const __amdgpu_buffer_rsrc_t ars = __builtin_amdgcn_make_buffer_rsrc(ACT, 0, MT * DFF * 2, 0x00020000);
#pragma unroll
        for (int ai = 0; ai < 2; ++ai) { const int blk = ai * 2 + wr;
            float res[4][8];
#pragma unroll
            for (int n = 0; n < 2; ++n) {
                const f32x4 w0 = *(const f32x4*)(cw + hc0 + 4 * n), w1 = *(const f32x4*)(cw + DFF + hc0 + 4 * n), w2 = *(const f32x4*)(cw + 2 * DFF + hc0 + 4 * n), bb = *(const f32x4*)(cb + hc0 + 4 * n);
#pragma unroll
                for (int e = 0; e < 4; ++e) {
                    float xs[4], ps[4], ns[4]; const float bprev = 0.f, bnext = 0.f;
#pragma unroll
                    for (int m = 0; m < 4; ++m) { xs[m] = acc[ai][0][m][n][e]; ps[m] = __builtin_bit_cast(float, __builtin_amdgcn_update_dpp(0, __builtin_bit_cast(int, xs[m]), 0x121, 0xf, 0xf, false)); ns[m] = __builtin_bit_cast(float, __builtin_amdgcn_update_dpp(0, __builtin_bit_cast(int, xs[m]), 0x12f, 0xf, 0xf, false)); }
#pragma unroll
                    for (int m = 0; m < 4; ++m) {
                        const float oldp = (m > 0) ? ps[m > 0 ? m - 1 : 0] : bprev, oldn = (m < 3) ? ns[m < 3 ? m + 1 : 3] : bnext;
                        const float prev = __builtin_bit_cast(float, __builtin_amdgcn_update_dpp(__builtin_bit_cast(int, oldp), __builtin_bit_cast(int, xs[m]), 0x111, 0xf, 0xf, false));
                        const float next = __builtin_bit_cast(float, __builtin_amdgcn_update_dpp(__builtin_bit_cast(int, oldn), __builtin_bit_cast(int, xs[m]), 0x101, 0xf, 0xf, false));
                        const float a = w0[e] * prev + w1[e] * xs[m] + w2[e] * next + bb[e];
                        res[m][4 * n + e] = silu_f(a) * acc[ai][1][m][n][e];
                    }
                }
            }
#pragma unroll
            for (int m = 0; m < 4; ++m) { const int r = u.pm * 256 + ai * 128 + wr * 64 + m * 16 + fr;
                u32x4 w; w.x = pg8::cvt_pk_bf16(res[m][0], res[m][1]); w.y = pg8::cvt_pk_bf16(res[m][2], res[m][3]); w.z = pg8::cvt_pk_bf16(res[m][4], res[m][5]); w.w = pg8::cvt_pk_bf16(res[m][6], res[m][7]);
                __builtin_amdgcn_raw_buffer_store_b128(w, ars, (unsigned)((r * DFF + hc0) * 2), 0, 16); }
        }
    }
};
struct EpiUpCtx {
    static constexpr bool PERM = true, AFTER_DRAIN = false;
    bf16* ACT; const float* cw; const float* cb; LAS float* ex;
    __device__ __forceinline__ void operator()(const pg8::f32x4 (&acc)[2][2][4][2], const pg8::Unit& u, int wr, int wc, int fr, int fq) const {
        const int hc0 = u.pn * 128 + wc * 32 + 8 * fq;
            const int colw = wc * 32 + 8 * fq;
#pragma unroll
            for (int ai = 0; ai < 2; ++ai) { const int blk = ai * 2 + wr;
                if (fr == 0) {
#pragma unroll
                    for (int n = 0; n < 2; ++n)
#pragma unroll
                        for (int e = 0; e < 4; ++e) ex[(blk * 2 + 0) * 128 + colw + 4 * n + e] = acc[ai][0][0][n][e]; }
                if (fr == 15) {
#pragma unroll
                    for (int n = 0; n < 2; ++n)
#pragma unroll
                        for (int e = 0; e < 4; ++e) ex[(blk * 2 + 1) * 128 + colw + 4 * n + e] = acc[ai][0][3][n][e]; } }
            asm volatile("s_waitcnt lgkmcnt(0)" ::: "memory"); __builtin_amdgcn_s_barrier(); asm volatile("" ::: "memory");
#pragma unroll
            for (int ai = 0; ai < 2; ++ai) { const int blk = ai * 2 + wr;
                float res[4][8];
    #pragma unroll
                for (int n = 0; n < 2; ++n) {
                    const f32x4 w0 = *(const f32x4*)(cw + hc0 + 4 * n), w1 = *(const f32x4*)(cw + DFF + hc0 + 4 * n), w2 = *(const f32x4*)(cw + 2 * DFF + hc0 + 4 * n), bb = *(const f32x4*)(cb + hc0 + 4 * n);
    #pragma unroll
                    for (int e = 0; e < 4; ++e) {
                        float xs[4], ps[4], ns[4]; float bprev = 0.f, bnext = 0.f; if (blk > 0) bprev = ex[((blk - 1) * 2 + 1) * 128 + colw + 4 * n + e]; if (blk < 3) bnext = ex[((blk + 1) * 2 + 0) * 128 + colw + 4 * n + e];
    #pragma unroll
                        for (int m = 0; m < 4; ++m) { xs[m] = acc[ai][0][m][n][e]; ps[m] = __builtin_bit_cast(float, __builtin_amdgcn_update_dpp(0, __builtin_bit_cast(int, xs[m]), 0x121, 0xf, 0xf, false)); ns[m] = __builtin_bit_cast(float, __builtin_amdgcn_update_dpp(0, __builtin_bit_cast(int, xs[m]), 0x12f, 0xf, 0xf, false)); }
    #pragma unroll
                        for (int m = 0; m < 4; ++m) {
                            const float prev = (fr > 0) ? ps[m] : (m > 0 ? ps[m > 0 ? m - 1 : 0] : bprev);
                            const float next = (fr < 15) ? ns[m] : (m < 3 ? ns[m < 3 ? m + 1 : 3] : bnext);
                            const float a = w0[e] * prev + w1[e] * xs[m] + w2[e] * next + bb[e];
                            res[m][4 * n + e] = silu_f(a) * acc[ai][1][m][n][e];
                        }
                    }
                }
    #pragma unroll
                for (int m = 0; m < 4; ++m) { const int r = u.pm * 256 + ai * 128 + wr * 64 + m * 16 + fr;
                    u32x4 w; w.x = pg8::cvt_pk_bf16(res[m][0], res[m][1]); w.y = pg8::cvt_pk_bf16(res[m][2], res[m][3]); w.z = pg8::cvt_pk_bf16(res[m][4], res[m][5]); w.w = pg8::cvt_pk_bf16(res[m][6], res[m][7]);
                    *(u32x4*)(ACT + (size_t)r * DFF + hc0) = w; }
            }

    }
};
struct CtxOrder {
    int nN, c, c0;
    __device__ void init(int N, int c_, int c0_) { nN = N / 256; c = c_; c0 = c0_; }
    __device__ bool next(int i, pg8::Unit& u) const { const int j = c - c0; if (i > 0 || j < 0 || j >= 2 * nN) return false; u.pm = 64 + (j & 1); u.pn = j >> 1; u.ks = 0; return true; }
    __device__ __forceinline__ void a_ready(const pg8::Unit&) const {}
    __device__ __forceinline__ void done(const pg8::Unit&) const {}
};

struct SplitOrder {
    int nunits, G, c;
    __device__ void init(int nks, int G_, int c_) { nunits = 8 * nks; G = G_; c = c_; }
    __device__ bool next(int i, pg8::Unit& u) const { const int id = i * G + c; if (id >= nunits) return false; u.pm = 64 + (id & 1); u.pn = (id >> 1) & 3; u.ks = id >> 3; return true; }
    __device__ __forceinline__ void a_ready(const pg8::Unit&) const {}
    __device__ __forceinline__ void done(const pg8::Unit&) const {}
};
struct EpiPartial {
    static constexpr bool PERM = false, AFTER_DRAIN = false;
    float* part;
    __device__ __forceinline__ void operator()(const pg8::f32x4 (&acc)[2][2][4][2], const pg8::Unit& u, int wr, int wc, int fr, int fq) const {
#pragma unroll
        for (int ai = 0; ai < 2; ++ai)
#pragma unroll
            for (int m = 0; m < 4; ++m) { const int r = u.pm * 256 + ai * 128 + wr * 64 + m * 16 + fr; float* o = part + ((size_t)u.ks * MC + (size_t)(r - ML)) * D;
#pragma unroll
                for (int bj = 0; bj < 2; ++bj)
#pragma unroll
                    for (int n = 0; n < 2; ++n) { const int c = u.pn * 256 + bj * 128 + wc * 32 + 16 * n + 4 * fq; const pg8::f32x4 a = acc[ai][bj][m][n];
                        *(f32x4*)(o + c) = (f32x4){a[0], a[1], a[2], a[3]}; } }
    }
};
typedef __attribute__((address_space(1))) unsigned gu32;
#define XB_TMO      128
#define XB_XCNT(j)  (256  + 64 * (j))
#define XB_XSUB(j)  (1280 + 64 * (j))
#define XB_XGEN(j)  (2304 + 64 * (j))
#define XB_TOP      3328
#define XB_TOPGEN   3392
#define XCD_BAR_WORDS 3456
#define XB_SPIN_CAP (1u << 18)

__device__ __forceinline__ unsigned xb_ld(unsigned* p)              { return __hip_atomic_load(p, __ATOMIC_RELAXED, __HIP_MEMORY_SCOPE_AGENT); }
__device__ __forceinline__ unsigned xb_add(unsigned* p, unsigned v) { return __hip_atomic_fetch_add(p, v, __ATOMIC_RELAXED, __HIP_MEMORY_SCOPE_AGENT); }
__device__ __forceinline__ unsigned xb_xcc_id() { return (unsigned)__builtin_amdgcn_s_getreg((3 << 11) | 20) & 0xFu; }
#define XB_SPIN(cond, bar) do { unsigned _sp = 0; while (cond) { __builtin_amdgcn_s_sleep(1); \
    if ((++_sp & 255u) == 0u) { if (xb_ld(&(bar)[XB_TMO])) break; if (_sp > XB_SPIN_CAP) { atomicAdd(&(bar)[XB_TMO], 1u); break; } } } } while (0)

struct XcdBarrier {
    unsigned* bar; unsigned x;
    volatile LAS unsigned* st;
};

__device__ __forceinline__ XcdBarrier xcd_barrier_post(unsigned* bar, volatile LAS unsigned* st, int tid_) {
    XcdBarrier b; b.bar = bar; b.x = xb_xcc_id(); b.st = st;
    if (tid_ == 0) (void)xb_add(&bar[XB_XCNT(b.x)], 1u);
    return b;
}
__device__ __forceinline__ void xcd_barrier_complete(unsigned* bar, unsigned x, unsigned& nloc, unsigned& nx) {
    const unsigned G = gridDim.x * gridDim.y * gridDim.z;
    unsigned sum, cnt, mine, sp = 0u;
    for (;;) {
        sum = 0u; cnt = 0u; mine = 0u;
#pragma unroll
        for (unsigned j = 0; j < 16; ++j) { const unsigned c = xb_ld(&bar[XB_XCNT(j)]); sum += c; cnt += (c > 0u) ? 1u : 0u; mine = (j == x) ? c : mine; }
        if (sum == G) break;
        __builtin_amdgcn_s_sleep(1);
        if ((++sp & 255u) == 0u) { if (xb_ld(&bar[XB_TMO])) break; if (sp > XB_SPIN_CAP) { atomicAdd(&bar[XB_TMO], 1u); break; } }
    }
    nloc = mine > 0u ? mine : 1u; nx = cnt > 0u ? cnt : 1u;
}

__device__ __forceinline__ void xcd_barrier(const XcdBarrier& b, int tid_) {
    asm volatile("s_waitcnt vmcnt(0)" ::: "memory");
    __syncthreads();
    if (tid_ == 0) {
        unsigned* bar = b.bar; asm volatile("" : "+s"(bar)); unsigned bx = (unsigned)__builtin_amdgcn_readfirstlane((int)b.x); asm volatile("" : "+s"(bx));
        __builtin_amdgcn_s_waitcnt(0);
        unsigned nloc = b.st[0], nx = b.st[1];
        if (nloc == 0u) { xcd_barrier_complete(bar, bx, nloc, nx); b.st[0] = nloc; b.st[1] = nx; }
        const unsigned old = xb_add(&bar[XB_XSUB(bx)], 1u);
        const unsigned gen = old / nloc;
        if (old + 1u == (gen + 1u) * nloc) {
            __builtin_amdgcn_fence(__ATOMIC_RELEASE, "agent");
            asm volatile("s_waitcnt vmcnt(0)" ::: "memory");
            const unsigned og = xb_add(&bar[XB_TOP], 1u);
            const unsigned tg = og / nx;
            if (og + 1u == (tg + 1u) * nx) xb_add(&bar[XB_TOPGEN], 1u);
            else XB_SPIN(xb_ld(&bar[XB_TOPGEN]) == tg, bar);
            __builtin_amdgcn_fence(__ATOMIC_ACQUIRE, "agent");
            xb_add(&bar[XB_XGEN(bx)], 1u);
            asm volatile("s_waitcnt vmcnt(0)" ::: "memory");
        } else {
            XB_SPIN(xb_ld(&bar[XB_XGEN(bx)]) == gen, bar);
            __builtin_amdgcn_fence(__ATOMIC_ACQUIRE, "agent");
            asm volatile("s_waitcnt vmcnt(0)" ::: "memory");
        }
    }
    __syncthreads();
}
struct Ctx {
    LAS unsigned char* lds; int tid, lane, wave, G, gw, NGW;
    float* MOD; float* MCS; bf16 *F1, *F2, *FC; bf16 *HX, *YMIX, *PB, *ACT, *TB, *CAU; float *XC, *ST, *DEC;
};
__device__ __forceinline__ bf16* win_t(PP p, int l) { return (bf16*)(p->ws + WS_W + (size_t)l * W_LAYER_B); }
__device__ __forceinline__ bf16* wout_t(PP p, int l) { return (bf16*)(p->ws + WS_W + (size_t)l * W_LAYER_B + W_IN_B); }
__device__ __forceinline__ bf16* wup_t(PP p, int l) { return (bf16*)(p->ws + WS_W + (size_t)l * W_LAYER_B + W_IN_B + W_OUT_B); }
__device__ __forceinline__ bf16* wdn_t(PP p, int l) { return (bf16*)(p->ws + WS_W + (size_t)l * W_LAYER_B + W_IN_B + W_OUT_B + W_UP_B); }

__device__ __forceinline__ void transpose_item(const float* W, int K, int N, bf16* WT, int k0, int n0, int dst0, float scale, LAS float* scr, int lane) {
#pragma unroll
    for (int i = 0; i < 32; ++i) { const int kk = 2 * i + (lane >> 5); scr[kk * 33 + (lane & 31)] = __builtin_nontemporal_load(W + (size_t)(k0 + kk) * N + n0 + (lane & 31)) * scale; }
    LDS_WAIT(); __builtin_amdgcn_wave_barrier();
    const int c = lane & 7;
#pragma unroll
    for (int j = 0; j < 4; ++j) { const int n = (lane >> 3) + 8 * j; const LAS float* s = scr + (8 * c) * 33 + n;
        u32x4 o; o.x = pk2(s[0 * 33], s[1 * 33]); o.y = pk2(s[2 * 33], s[3 * 33]); o.z = pk2(s[4 * 33], s[5 * 33]); o.w = pk2(s[6 * 33], s[7 * 33]);
        __builtin_nontemporal_store(o, (u32x4*)(WT + (size_t)(dst0 + n) * K + k0 + 8 * c)); }
    LDS_WAIT(); __builtin_amdgcn_wave_barrier();
}

__device__ __forceinline__ void phase0(PP p, Ctx& F) {
    LAS float* sv = (LAS float*)F.lds; LAS float* red = sv + 3072;
    for (int i = F.tid; i < 3072; i += 512) { const int w = i >> 10, k = i & 1023; const float cv = (w < 2) ? p->c[w * 1024 + k] : p->c_ctx[k]; sv[i] = cv / (1.f + expf(-cv)); }
    __syncthreads();
    for (int it = blockIdx.x; it < 192; it += F.G) {
        const int l = it / 96, c0 = (it % 96) * 64; const float* W = p->w_mod + (size_t)l * 1024 * 6144 + c0 + F.lane;
        float a0 = 0.f, a1 = 0.f, a2 = 0.f; const int kb = F.wave * 128;
#pragma unroll 64
        for (int k = 0; k < 128; ++k) { const float wv = __builtin_nontemporal_load(W + (size_t)(kb + k) * 6144); a0 += sv[kb + k] * wv; a1 += sv[1024 + kb + k] * wv; a2 += sv[2048 + kb + k] * wv; }
        red[(F.wave * 3 + 0) * 64 + F.lane] = a0; red[(F.wave * 3 + 1) * 64 + F.lane] = a1; red[(F.wave * 3 + 2) * 64 + F.lane] = a2;
        __syncthreads();
        if (F.tid < 192) { const int w = F.tid >> 6, ln = F.tid & 63; float s = 0.f;
#pragma unroll
            for (int q = 0; q < 8; ++q) s += red[(q * 3 + w) * 64 + ln];
            F.MOD[(l * 3 + w) * 6144 + c0 + ln] = s + p->b_mod[l * 6144 + c0 + ln]; }
        __syncthreads();
    }
    __syncthreads();
    LAS float* scr = (LAS float*)(F.lds + F.wave * 16384);
    constexpr int I_IN = 48 * 16, I_OUT = 32 * 16, I_UP = 176 * 16, I_DN = 32 * 44, I_L = I_IN + I_OUT + I_UP + I_DN;
    for (int it = F.gw; it < 2 * I_L; it += F.NGW) {
        const int l = it / I_L; int r = it % I_L;
        if (r < I_IN) { const int cb = r / 16, kb = r % 16; int src, dst; float sc = 1.f;
            if (cb < 4) { src = 32 * cb; dst = PK + 32 * cb; }
            else if (cb < 8) { src = 416 + 32 * (cb - 4); dst = PQ + 32 * (cb - 4); sc = 0.17677669529663687f; }
            else if (cb < 16) { src = 128 + 32 * (cb - 8); dst = PV + 32 * (cb - 8); }
            else if (cb < 24) { src = 544 + 32 * (cb - 16); dst = PG + 32 * (cb - 16); }
            else if (cb < 32) { src = 1056 + 32 * (cb - 24); dst = PH + 32 * (cb - 24); }
            else if (cb < 40) { src = 1312 + 32 * (cb - 32); dst = PBG + 32 * (cb - 32); }
            else { src = 1568 + 32 * (cb - 40); dst = PCG + 32 * (cb - 40); }
            transpose_item(p->w_in + (size_t)l * D * DIN, D, DIN, win_t(p, l), 64 * kb, src, dst, sc, scr, F.lane); continue; }
        r -= I_IN;
        if (r < I_OUT) { const int cb = r / 16, kb = r % 16; transpose_item(p->w_out + (size_t)l * D * D, D, D, wout_t(p, l), 64 * kb, 32 * cb, 32 * cb, 1.f, scr, F.lane); continue; }
        r -= I_OUT;
        if (r < I_UP) { const int cb = r / 16, kb = r % 16; const int c = 32 * cb, isu = (c >= DFF) ? 1 : 0, j = c - isu * DFF; const int dst = (j / 128) * 256 + isu * 128 + (j % 128);
            transpose_item(p->w_up + (size_t)l * D * NUP, D, NUP, wup_t(p, l), 64 * kb, c, dst, 1.f, scr, F.lane); continue; }
        r -= I_UP;
        { const int cb = r / 44, kb = r % 44; transpose_item(p->w_down + (size_t)l * DFF * D, DFF, D, wdn_t(p, l), 64 * kb, 32 * cb, 32 * cb, 1.f, scr, F.lane); }
    }
    const int gt = blockIdx.x * 512 + F.tid, NT = F.G * 512;
    const int gtm = (F.G == 256) ? ((int)blockIdx.x - 192) * 512 + F.tid : gt; const int NTm = (F.G == 256) ? 32768 : NT;
    for (int i = gtm; i >= 0 && i < 32768; i += NTm) { const int d = i & 63, c = (i >> 6) & 63, g = (i >> 12) & 3, l = i >> 14;
        const float* wf = p->fft_w + (size_t)((l * 4 + g) * 64) * 64 + d; float mc = 0.f, ms = 0.f;
        for (int f = 0; f < 64; ++f) { const float a = (float)((f * c) & 63) * (1.f / 64.f); const float w = wf[f * 64]; mc += cos_rev(a) * w; ms -= sin_rev(a) * w; }
        F.MCS[(((l * 4 + g) * 2 + 0) * 64 + c) * 64 + d] = mc * 0.125f; F.MCS[(((l * 4 + g) * 2 + 1) * 64 + c) * 64 + d] = ms * 0.125f; }
    for (int i = gt; i < MC * D / 4; i += NT) ((f32x4*)F.XC)[i] = ((const f32x4*)p->ctx)[i];
    for (int i = gt; i < 180224; i += NT) {
        if (i < 16384) { const int mm = i >> 7, kk = i & 127, k1 = mm & 63, n1 = kk & 63; const float a = (float)((k1 * n1) & 63) * (1.f / 64.f); const float C = cos_rev(a), S = sin_rev(a);
            const float v = (mm < 64) ? (kk < 64 ? C : S) : (kk < 64 ? -S : C); F.F1[i] = (bf16)f2bf(v); }
        else if (i < 49152) { const int j = i - 16384, k2 = j >> 8, kk = j & 255, n2 = kk & 127; const float a = (float)((k2 * n2) & 127) * (1.f / 128.f);
            const float v = (kk < 128 ? cos_rev(a) : sin_rev(a)) * 0.011048543456039806f; F.F2[j] = (bf16)f2bf(v); }
        else { const int j = i - 49152, k = j >> 9, kk = j & 511, n = kk & 255; const float a = (float)((k * n) & 255) * (1.f / 256.f);
            const float v = (kk < 256 ? cos_rev(a) : sin_rev(a)) * 0.0625f; F.FC[j] = (bf16)f2bf(v); }
    }
}

__device__ __forceinline__ void fold_items(PP p, Ctx& F) {
    for (int it4 = F.gw; it4 < 1792; it4 += F.NGW) {
        const int dq = it4 & 3, it = it4 >> 2;
        const int l = it / 224, r = it % 224, s = r / 16, kb = r % 16; const int k = 64 * kb + F.lane;
        const float* wrow = p->w_in + (size_t)l * D * DIN + (size_t)k * DIN; bf16* WT = win_t(p, l);
        if (s < 2) {
            const f32x4* src = (const f32x4*)(wrow + 384 + 16 * s); f32x4 r4[4];
#pragma unroll
            for (int q = 0; q < 4; ++q) r4[q] = src[q];
            const float* M = p->w_a2 + (size_t)((l * 2 + s) * 16) * 128;
            for (int d = 32 * dq; d < 32 * dq + 32; ++d) { float a = 0.f;
#pragma unroll
                for (int c = 0; c < 16; ++c) a += r4[c >> 2][c & 3] * M[c * 128 + d];
                WT[(size_t)(PLA + s * 128 + d) * D + k] = (bf16)f2bf(a); }
        } else {
            const int kind = (s - 2) >> 2, g = (s - 2) & 3;
            const f32x4* src = (const f32x4*)(wrow + (kind < 2 ? 800 : 1824) + 64 * g); f32x4 r4[16];
#pragma unroll
            for (int q = 0; q < 16; ++q) r4[q] = src[q];
            const float* M = (kind < 2) ? (F.MCS + (size_t)(((l * 4 + g) * 2 + kind) * 64) * 64) : (p->pool_w + (size_t)((l * 4 + g) * 64) * 64);
            const int drow = (kind == 0 ? PFA : (kind == 1 ? PFB : PPOOL)) + 64 * g;
            for (int d = 16 * dq; d < 16 * dq + 16; ++d) { float a = 0.f;
#pragma unroll
                for (int c = 0; c < 64; ++c) a += r4[c >> 2][c & 3] * M[c * 64 + d];
                if (kind == 2) a *= p->pool_scale[l * 256 + g * 64 + d];
                WT[(size_t)(drow + d) * D + k] = (bf16)f2bf(a); }
        }
    }
}

__device__ __forceinline__ void norm_row_bf16(const float* xrow, bf16* orow, const float* g, const float* sc, const float* sh, int lane, const float* part, int nparts, const float* gate, float* xout) {
    f32x4 v[4]; float s = 0.f;
#pragma unroll
    for (int j = 0; j < 4; ++j) v[j] = ((const f32x4*)xrow)[lane + 64 * j];
    if (nparts > 0) {
        f32x4 a[4];
#pragma unroll
        for (int j = 0; j < 4; ++j) a[j] = (f32x4){0.f, 0.f, 0.f, 0.f};
        for (int q = 0; q < nparts; ++q) {
#pragma unroll
            for (int j = 0; j < 4; ++j) { const f32x4 t = ((const f32x4*)(part + (size_t)q * MC * D))[lane + 64 * j]; a[j][0] += t[0]; a[j][1] += t[1]; a[j][2] += t[2]; a[j][3] += t[3]; } }
#pragma unroll
        for (int j = 0; j < 4; ++j) { const f32x4 gv = ((const f32x4*)gate)[lane + 64 * j];
#pragma unroll
            for (int e = 0; e < 4; ++e) v[j][e] += gv[e] * a[j][e];
            ((f32x4*)xout)[lane + 64 * j] = v[j]; }
    }
#pragma unroll
    for (int j = 0; j < 4; ++j) s += (v[j][0] * v[j][0] + v[j][1] * v[j][1]) + (v[j][2] * v[j][2] + v[j][3] * v[j][3]);
    const float rstd = 1.f / sqrtf(wave_sum(s, lane) * (1.f / D) + EPS);
#pragma unroll
    for (int j = 0; j < 4; ++j) { const int idx = lane + 64 * j; const f32x4 gv = ((const f32x4*)g)[idx], scv = ((const f32x4*)sc)[idx], shv = ((const f32x4*)sh)[idx];
        float y[4];
#pragma unroll
        for (int e = 0; e < 4; ++e) y[e] = v[j][e] * rstd * gv[e] * (1.f + scv[e]) + shv[e];
        u32x2 o; o.x = pk2(y[0], y[1]); o.y = pk2(y[2], y[3]); ((u32x2*)orow)[idx] = o; }
}
template <bool FINAL, bool INB>
__device__ __forceinline__ void norm_rows4(const void* xbase, bf16* obase, float* fout, const float* g, const float* modl, int which, int m0, int stride, int lane) {
    f32x4 v[4][4]; float s[4]; int mk[4]; bool ok[4];
#pragma unroll
    for (int k = 0; k < 4; ++k) { const int m = m0 + k * stride; ok[k] = m < ML; mk[k] = ok[k] ? m : ML - 1;
#pragma unroll
        for (int j = 0; j < 4; ++j) {
            if (INB) { const u32x2 t = ((const u32x2*)((const bf16*)xbase + (size_t)mk[k] * D))[lane + 64 * j]; v[k][j] = (f32x4){bflo(t.x), bfhi(t.x), bflo(t.y), bfhi(t.y)}; }
            else v[k][j] = __builtin_nontemporal_load((const f32x4*)((const float*)xbase + (size_t)mk[k] * D) + lane + 64 * j); } }
    f32x4 gm[4], sh4[4];
    { const float* mod = FINAL ? g : modl + (m0 >> 13) * 6144 + which * 3072;
#pragma unroll
      for (int j = 0; j < 4; ++j) { const int idx = lane + 64 * j; const f32x4 gv = ((const f32x4*)g)[idx];
          if (FINAL) { gm[j] = gv; sh4[j] = (f32x4){0.f, 0.f, 0.f, 0.f}; }
          else { const f32x4 scv = ((const f32x4*)(mod + 1024))[idx]; sh4[j] = ((const f32x4*)mod)[idx];
#pragma unroll
              for (int e = 0; e < 4; ++e) gm[j][e] = gv[e] * (1.f + scv[e]); } } }
#pragma unroll
    for (int k = 0; k < 4; ++k) { float a = 0.f;
#pragma unroll
        for (int j = 0; j < 4; ++j) a += (v[k][j][0] * v[k][j][0] + v[k][j][1] * v[k][j][1]) + (v[k][j][2] * v[k][j][2] + v[k][j][3] * v[k][j][3]);
        s[k] = a; }
#pragma unroll
    for (int o = 1; o < 64; o <<= 1) {
#pragma unroll
        for (int k = 0; k < 4; ++k) s[k] += shfl_f(s[k], lane ^ o); }
#pragma unroll
    for (int k = 0; k < 4; ++k) { if (!ok[k]) continue;
        const float rstd = 1.f / sqrtf(s[k] * (1.f / D) + EPS);
#pragma unroll
        for (int j = 0; j < 4; ++j) { const int idx = lane + 64 * j;
            if (FINAL) { f32x4 y;
#pragma unroll
                for (int e = 0; e < 4; ++e) y[e] = v[k][j][e] * rstd * gm[j][e];
                ((f32x4*)(fout + (size_t)mk[k] * D))[idx] = y; }
            else { float y[4];
#pragma unroll
                for (int e = 0; e < 4; ++e) y[e] = v[k][j][e] * rstd * gm[j][e] + sh4[j][e];
                u32x2 o; o.x = pk2(y[0], y[1]); o.y = pk2(y[2], y[3]); ((u32x2*)(obase + (size_t)mk[k] * D))[idx] = o; } }
    }
}
__device__ __forceinline__ void norm_phase(PP p, Ctx& F, int l, int which, int mrows) {
    const float* g = (which == 0 ? p->norm1_g : p->norm2_g) + l * D;
    const float* PART = (const float*)(p->ws + WS_PART);
    if (l == 0 && which == 0) { for (int m0 = F.gw; m0 < ML; m0 += 4 * F.NGW) norm_rows4<false, false>(p->x, F.HX, nullptr, g, F.MOD + l * 3 * 6144, which, m0, F.NGW, F.lane); }
    else { const void* xb = (l == 1 && which == 1 && F.G == 256) ? (const void*)(p->ws + WS_XB2) : (const void*)p->out;
        for (int m0 = F.gw; m0 < ML; m0 += 4 * F.NGW) norm_rows4<false, true>(xb, F.HX, nullptr, g, F.MOD + l * 3 * 6144, which, m0, F.NGW, F.lane); }
    for (int m = ML + F.gw; m < mrows; m += F.NGW) {
        int nparts = 0; const float* gate = nullptr;
        const float* xr = ((l == 0 && which == 0) ? p->ctx : F.XC) + (size_t)(m - ML) * D;
        if (l == 0 && which == 1) { nparts = 4; gate = F.MOD + 2 * 6144 + 2048; }
        if (l == 1 && which == 0) { nparts = 11; gate = F.MOD + 2 * 6144 + 5120; }
        const float* part = PART + (size_t)(m - ML) * D; float* xout = F.XC + (size_t)(m - ML) * D;
        const float* mod = F.MOD + (l * 3 + 2) * 6144 + which * 3072;
        norm_row_bf16(xr, F.HX + (size_t)m * D, g, mod + 1024, mod, F.lane, part, nparts, gate, xout);
    }
}
__device__ __forceinline__ void final_norm(PP p, Ctx& F) {
    for (int m0 = F.gw; m0 < ML; m0 += 4 * F.NGW) norm_rows4<true, false>(p->ws + WS_HX  , nullptr, p->out, p->final_g, nullptr, 0, m0, F.NGW, F.lane);
}
constexpr int CP = 260;
__device__ __forceinline__ int chunk_row0(int b, int cidx) { return (cidx < 4) ? (ML + b * CTXL + cidx * 64) : (b * SEQ + (cidx - 4) * 64); }
__device__ __forceinline__ void cum_to_lds(LAS float* cum, const bf16* PB, int row0, int tid) {
    { const int oct = tid & 31, j0 = tid >> 5; u32x4 w[4];
#pragma unroll
      for (int q = 0; q < 4; ++q) w[q] = *(const u32x4*)(PB + (size_t)(row0 + j0 + 16 * q) * NP + PLA + 8 * oct);
#pragma unroll
      for (int q = 0; q < 4; ++q) { LAS float* d = cum + (j0 + 16 * q) * CP + 8 * oct;
          *(LAS f32x4*)d = (f32x4){bflo(w[q].x), bfhi(w[q].x), bflo(w[q].y), bfhi(w[q].y)}; *(LAS f32x4*)(d + 4) = (f32x4){bflo(w[q].z), bfhi(w[q].z), bflo(w[q].w), bfhi(w[q].w)}; } }
    __syncthreads();
    if (tid < 256) { float s = 0.f;
        if (tid < 128) {
#pragma unroll 16
            for (int j = 0; j < 64; ++j) { s += cum[j * CP + tid]; cum[j * CP + tid] = s; }
        } else {
#pragma unroll 16
            for (int j = 63; j >= 0; --j) { s += cum[j * CP + tid]; cum[j * CP + tid] = s; }
        } }
    __syncthreads();
}
typedef float f32x2_t __attribute__((ext_vector_type(2)));
typedef __bf16 bf16x2_t __attribute__((ext_vector_type(2)));
__device__ __forceinline__ unsigned pkh(float lo, float hi) { f32x2_t v = {lo, hi}; bf16x2_t b = __builtin_convertvector(v, bf16x2_t); return __builtin_bit_cast(unsigned, b); }
__device__ __forceinline__ bf16x8 pack8h(float a0, float a1, float a2, float a3, float a4, float a5, float a6, float a7) {
    u32x4 w; w.x = pkh(a0, a1); w.y = pkh(a2, a3); w.z = pkh(a4, a5); w.w = pkh(a6, a7); return __builtin_bit_cast(bf16x8, w);
}
__device__ __forceinline__ void la_load(u32x4 (&w)[4], const bf16* PB, int row0, int tid) {
    const int oct = tid & 31, j0 = tid >> 5;
#pragma unroll
    for (int q = 0; q < 4; ++q) w[q] = *(const u32x4*)(PB + (size_t)(row0 + j0 + 16 * q) * NP + PLA + 8 * oct);
}
__device__ __forceinline__ void la_scan(LAS float* cum, const u32x4 (&w)[4], int tid) {
    const int oct = tid & 31, j0 = tid >> 5;
#pragma unroll
    for (int q = 0; q < 4; ++q) { LAS float* d = cum + (j0 + 16 * q) * CP + 8 * oct;
        *(LAS f32x4*)d = (f32x4){bflo(w[q].x), bfhi(w[q].x), bflo(w[q].y), bfhi(w[q].y)}; *(LAS f32x4*)(d + 4) = (f32x4){bflo(w[q].z), bfhi(w[q].z), bflo(w[q].w), bfhi(w[q].w)}; }
    __syncthreads();
    if (tid < 256) { float carry = 0.f;
        if (tid < 128) {
#pragma unroll
            for (int hf = 0; hf < 4; ++hf) { float v[16];
#pragma unroll
                for (int j = 0; j < 16; ++j) v[j] = cum[(16 * hf + j) * CP + tid];
                v[0] += carry;
#pragma unroll
                for (int j = 1; j < 16; ++j) v[j] += v[j - 1];
                carry = v[15];
#pragma unroll
                for (int j = 0; j < 16; ++j) cum[(16 * hf + j) * CP + tid] = v[j]; }
        } else {
#pragma unroll
            for (int hf = 3; hf >= 0; --hf) { float v[16];
#pragma unroll
                for (int j = 0; j < 16; ++j) v[j] = cum[(16 * hf + j) * CP + tid];
                v[15] += carry;
#pragma unroll
                for (int j = 14; j >= 0; --j) v[j] += v[j + 1];
                carry = v[0];
#pragma unroll
                for (int j = 0; j < 16; ++j) cum[(16 * hf + j) * CP + tid] = v[j]; }
        } }
    __syncthreads();
}
__device__ __forceinline__ void gla_a_item(Ctx& F, int b, int cidx) {
    LAS float* cum = (LAS float*)F.lds; const int row0 = chunk_row0(b, cidx);
    const int h = F.wave & 3, dir = F.wave >> 2, chb = dir * 128 + h * 32, lr = F.lane & 15, g = F.lane >> 4;
    const int jl = dir ? 0 : 63;
    u32x4 wla[4]; la_load(wla, F.PB, row0, F.tid);
    unsigned short kt[2][2][8], vt[2][4][8];
#pragma unroll
    for (int ks = 0; ks < 2; ++ks) { const int j0 = 32 * ks + 8 * g;
#pragma unroll
        for (int mb = 0; mb < 2; ++mb)
#pragma unroll
            for (int e = 0; e < 8; ++e) kt[ks][mb][e] = F.PB[(size_t)(row0 + j0 + e) * NP + PK + h * 32 + 16 * mb + lr];
#pragma unroll
        for (int nb = 0; nb < 4; ++nb)
#pragma unroll
            for (int e = 0; e < 8; ++e) vt[ks][nb][e] = F.PB[(size_t)(row0 + j0 + e) * NP + PV + h * 64 + 16 * nb + lr]; }
    la_scan(cum, wla, F.tid);
    f32x4 acc[2][4];
#pragma unroll
    for (int mb = 0; mb < 2; ++mb)
#pragma unroll
        for (int nb = 0; nb < 4; ++nb) acc[mb][nb] = (f32x4){0.f, 0.f, 0.f, 0.f};
#pragma unroll
    for (int ks = 0; ks < 2; ++ks) {
        bf16x8 af[2], bfr[4]; const int j0 = 32 * ks + 8 * g;
#pragma unroll
        for (int mb = 0; mb < 2; ++mb) { const int dk = 16 * mb + lr; const float last = cum[jl * CP + chb + dk]; float a[8];
#pragma unroll
            for (int e = 0; e < 8; ++e) { const int j = j0 + e; a[e] = bf2f(kt[ks][mb][e]) * __expf(last - cum[j * CP + chb + dk]); }
            af[mb] = pack8h(a[0], a[1], a[2], a[3], a[4], a[5], a[6], a[7]); }
#pragma unroll
        for (int nb = 0; nb < 4; ++nb) { const unsigned short* t = vt[ks][nb];
            u32x4 w; w.x = t[0] | ((unsigned)t[1] << 16); w.y = t[2] | ((unsigned)t[3] << 16); w.z = t[4] | ((unsigned)t[5] << 16); w.w = t[6] | ((unsigned)t[7] << 16);
            bfr[nb] = __builtin_bit_cast(bf16x8, w); }
#pragma unroll
        for (int mb = 0; mb < 2; ++mb)
#pragma unroll
            for (int nb = 0; nb < 4; ++nb) acc[mb][nb] = MFMA16(af[mb], bfr[nb], acc[mb][nb]);
    }
    const size_t sidx = (size_t)(((b * 2 + dir) * 4 + h) * NCH + cidx);
    float* st = F.ST + sidx * 2048;
#pragma unroll
    for (int mb = 0; mb < 2; ++mb)
#pragma unroll
        for (int nb = 0; nb < 4; ++nb) *(f32x4*)(st + (16 * nb + lr) * 32 + 16 * mb + 4 * g) = acc[mb][nb];
    if (F.lane < 32) F.DEC[sidx * 32 + F.lane] = __expf(cum[jl * CP + chb + F.lane]);
    __syncthreads();
}
__device__ __forceinline__ void gla_scan(Ctx& F) {
    LAS float* xa = (LAS float*)F.lds; LAS float* xb = xa + 512;
    const int seg = F.tid >> 6, el = F.tid & 63;
    for (int blk = blockIdx.x; blk < 512; blk += F.G) {
        const int ge = blk * 64 + el, e = ge & 2047, seq = ge >> 11, dir = (seq >> 2) & 1, dk = e & 31;
        float* st = F.ST + (size_t)seq * NCH * 2048 + e; const float* dc = F.DEC + (size_t)seq * NCH * 32 + dk;
        float u[17], d[17];
#pragma unroll
        for (int i = 0; i < 17; ++i) { const int s = seg * 17 + i; const bool ok = s < NCH; const int sc = ok ? s : NCH - 1; const int c = dir ? (sc < 4 ? 3 - sc : 135 - sc) : sc;
            const float uu = st[(size_t)c * 2048], dd = dc[c * 32]; u[i] = ok ? uu : 0.f; d[i] = ok ? dd : 1.f; }
        float A = 1.f, B = 0.f;
#pragma unroll
        for (int i = 0; i < 17; ++i) { B = B * d[i] + u[i]; A *= d[i]; }
        xa[F.tid] = A; xb[F.tid] = B;
        __syncthreads();
        float S = 0.f;
        for (int sg = 0; sg < seg; ++sg) S = S * xa[sg * 64 + el] + xb[sg * 64 + el];
#pragma unroll
        for (int i = 0; i < 17; ++i) { const int s = seg * 17 + i; if (s < NCH) { const int c = dir ? (s < 4 ? 3 - s : 135 - s) : s; st[(size_t)c * 2048] = S; } S = S * d[i] + u[i]; }
        __syncthreads();
    }
}
template <int NI>
__device__ __forceinline__ void gla_c_item(PP p, Ctx& F, int l, int b, int cidx, int sub) {
    LAS float* cum = (LAS float*)F.lds; const int row0 = chunk_row0(b, cidx);
    const int h = F.wave & 3, half = (NI == 2) ? (F.wave >> 2) : sub, ibase = (NI == 2) ? 0 : (F.wave >> 2), lr = F.lane & 15, g = F.lane >> 4;
    u32x4 wla[4]; la_load(wla, F.PB, row0, F.tid);
    f32x4 o[4][2];
#pragma unroll
    for (int mb = 0; mb < 4; ++mb) { o[mb][0] = (f32x4){0.f, 0.f, 0.f, 0.f}; o[mb][1] = (f32x4){0.f, 0.f, 0.f, 0.f}; }
    bf16x8 av[4][2];
#pragma unroll
    for (int mb = 0; mb < 4; ++mb)
#pragma unroll
        for (int pp = 0; pp < 2; ++pp) { unsigned short t[8];
#pragma unroll
            for (int e = 0; e < 8; ++e) { const int j = 32 * pp + (e < 4 ? 4 * g + e : 16 + 4 * g + (e - 4)); t[e] = F.PB[(size_t)(row0 + j) * NP + PV + h * 64 + 16 * mb + lr]; }
            u32x4 w; w.x = t[0] | ((unsigned)t[1] << 16); w.y = t[2] | ((unsigned)t[3] << 16); w.z = t[4] | ((unsigned)t[5] << 16); w.w = t[6] | ((unsigned)t[7] << 16);
            av[mb][pp] = __builtin_bit_cast(bf16x8, w); }
    u32x4 qraw[2], kraw[4]; f32x4 sraw[2][4][2];
#pragma unroll
    for (int ibl = 0; ibl < NI; ++ibl) qraw[ibl] = *(const u32x4*)(F.PB + (size_t)(row0 + 16 * (2 * half + ibase + ibl) + lr) * NP + PQ + h * 32 + 8 * g);
#pragma unroll
    for (int jb = 0; jb < 4; ++jb) kraw[jb] = *(const u32x4*)(F.PB + (size_t)(row0 + 16 * jb + lr) * NP + PK + h * 32 + 8 * g);
    { const float* st = F.ST + (size_t)(((b * 2 + 0) * 4 + h) * NCH + cidx) * 2048;
#pragma unroll
        for (int mb = 0; mb < 4; ++mb) { sraw[0][mb][0] = *(const f32x4*)(st + (16 * mb + lr) * 32 + 8 * g); sraw[0][mb][1] = *(const f32x4*)(st + (16 * mb + lr) * 32 + 8 * g + 4); } }
    la_scan(cum, wla, F.tid);
    { const float* st = F.ST + (size_t)(((b * 2 + 1) * 4 + h) * NCH + cidx) * 2048;
#pragma unroll
        for (int mb = 0; mb < 4; ++mb) { sraw[1][mb][0] = *(const f32x4*)(st + (16 * mb + lr) * 32 + 8 * g); sraw[1][mb][1] = *(const f32x4*)(st + (16 * mb + lr) * 32 + 8 * g + 4); } }
#pragma unroll
    for (int dir = 0; dir < 2; ++dir) {
        const int chb = dir * 128 + h * 32;
        bf16x8 bq[2];
#pragma unroll
        for (int ibl = 0; ibl < NI; ++ibl) { const int i = 16 * (2 * half + ibase + ibl) + lr;
            const u32x4 qw = qraw[ibl];
            const f32x4 c0 = *(const LAS f32x4*)(cum + i * CP + chb + 8 * g), c1 = *(const LAS f32x4*)(cum + i * CP + chb + 8 * g + 4);
            bq[ibl] = pack8h(bflo(qw.x) * __expf(c0[0]), bfhi(qw.x) * __expf(c0[1]), bflo(qw.y) * __expf(c0[2]), bfhi(qw.y) * __expf(c0[3]),
                            bflo(qw.z) * __expf(c1[0]), bfhi(qw.z) * __expf(c1[1]), bflo(qw.w) * __expf(c1[2]), bfhi(qw.w) * __expf(c1[3])); }
#pragma unroll
        for (int mb = 0; mb < 4; ++mb) { const f32x4 s0 = sraw[dir][mb][0], s1 = sraw[dir][mb][1];
            const bf16x8 as = pack8h(s0[0], s0[1], s0[2], s0[3], s1[0], s1[1], s1[2], s1[3]);
            o[mb][0] = MFMA16(as, bq[0], o[mb][0]); if (NI == 2) o[mb][1] = MFMA16(as, bq[1], o[mb][1]); }
#pragma unroll
        for (int pp = 0; pp < 2; ++pp) {
            if ((dir == 0 && half == 0 && pp == 1) || (dir == 1 && half == 1 && pp == 0)) continue;
            f32x4 sc[2][2];
#pragma unroll
            for (int q = 0; q < 2; ++q) { const int jb = 2 * pp + q, j = 16 * jb + lr;
                const u32x4 kw = kraw[jb];
                const f32x4 c0 = *(const LAS f32x4*)(cum + j * CP + chb + 8 * g), c1 = *(const LAS f32x4*)(cum + j * CP + chb + 8 * g + 4);
                const bf16x8 ak = pack8h(bflo(kw.x) * __expf(-c0[0]), bfhi(kw.x) * __expf(-c0[1]), bflo(kw.y) * __expf(-c0[2]), bfhi(kw.y) * __expf(-c0[3]),
                                        bflo(kw.z) * __expf(-c1[0]), bfhi(kw.z) * __expf(-c1[1]), bflo(kw.w) * __expf(-c1[2]), bfhi(kw.w) * __expf(-c1[3]));
#pragma unroll
                for (int ibl = 0; ibl < NI; ++ibl) { f32x4 z = (f32x4){0.f, 0.f, 0.f, 0.f}; z = MFMA16(ak, bq[ibl], z);
                    const int i = 16 * (2 * half + ibase + ibl) + lr;
#pragma unroll
                    for (int r = 0; r < 4; ++r) { const int jj = 16 * jb + 4 * g + r; const bool keep = dir ? (jj >= i) : (jj <= i); z[r] = keep ? z[r] : 0.f; }
                    sc[q][ibl] = z; } }
#pragma unroll
            for (int ibl = 0; ibl < NI; ++ibl) { const bf16x8 pb = pack8h(sc[0][ibl][0], sc[0][ibl][1], sc[0][ibl][2], sc[0][ibl][3], sc[1][ibl][0], sc[1][ibl][1], sc[1][ibl][2], sc[1][ibl][3]);
#pragma unroll
                for (int mb = 0; mb < 4; ++mb) o[mb][ibl] = MFMA16(av[mb][pp], pb, o[mb][ibl]); }
        }
    }
    const float* gg = p->gla_g + l * 64;
#pragma unroll
    for (int ibl = 0; ibl < NI; ++ibl) { float ss = 0.f;
#pragma unroll
        for (int mb = 0; mb < 4; ++mb) ss += (o[mb][ibl][0] * o[mb][ibl][0] + o[mb][ibl][1] * o[mb][ibl][1]) + (o[mb][ibl][2] * o[mb][ibl][2] + o[mb][ibl][3] * o[mb][ibl][3]);
        ss += shfl_f(ss, F.lane ^ 16); ss += shfl_f(ss, F.lane ^ 32);
        const float rstd = 1.f / sqrtf(ss * (1.f / 64.f) + EPS);
        const int i = 16 * (2 * half + ibase + ibl) + lr; const size_t row = (size_t)(row0 + i);
#pragma unroll
        for (int mb = 0; mb < 4; ++mb) { const int dv = 16 * mb + 4 * g; const f32x4 gv = *(const f32x4*)(gg + dv);
            const u32x2 gw = *(const u32x2*)(F.PB + row * NP + PG + h * 64 + dv);
            const float y0 = o[mb][ibl][0] * rstd * gv[0] * silu_f(bflo(gw.x)), y1 = o[mb][ibl][1] * rstd * gv[1] * silu_f(bfhi(gw.x));
            const float y2 = o[mb][ibl][2] * rstd * gv[2] * silu_f(bflo(gw.y)), y3 = o[mb][ibl][3] * rstd * gv[3] * silu_f(bfhi(gw.y));
            u32x2 w; w.x = pk2(y0, y1); w.y = pk2(y2, y3); *(u32x2*)(F.YMIX + row * D + h * 64 + dv) = w; }
    }
    __syncthreads();
}

template <int NKS, int GRP>
__device__ __forceinline__ void dft_mma_lds(f32x4 (&acc)[8], const LAS unsigned char* fl, int pitchB, const bf16* re, const bf16* im, size_t rstride, int khalf, int lane) {
    const int lr = lane & 15, g = lane >> 4;
#pragma unroll
    for (int k0 = 0; k0 < NKS; k0 += GRP) {
        bf16x8 bfrag[GRP];
#pragma unroll
        for (int kq = 0; kq < GRP; ++kq) { const int ks = k0 + kq; const int kk0 = 32 * ks + 8 * g; const bool part = kk0 >= khalf; const int idx = part ? kk0 - khalf : kk0;
            const bf16* src = (part ? im : re) + (size_t)idx * rstride + lr; unsigned short t[8];
#pragma unroll
            for (int e = 0; e < 8; ++e) t[e] = src[(size_t)e * rstride];
            u32x4 w; w.x = t[0] | ((unsigned)t[1] << 16); w.y = t[2] | ((unsigned)t[3] << 16); w.z = t[4] | ((unsigned)t[5] << 16); w.w = t[6] | ((unsigned)t[7] << 16);
            bfrag[kq] = __builtin_bit_cast(bf16x8, w); }
#pragma unroll
        for (int kq = 0; kq < GRP; ++kq) { const int ks = k0 + kq;
#pragma unroll
            for (int mb = 0; mb < 8; ++mb) { const bf16x8 a = *(const LAS bf16x8*)(fl + (16 * mb + lr) * pitchB + (32 * ks + 8 * g) * 2); acc[mb] = MFMA16(a, bfrag[kq], acc[mb]); }
        }
    }
}
__device__ __forceinline__ void f_to_lds(LAS unsigned char* fl, const bf16* Fm, int rows, int rowB, int tid) {
    const int cpr = rowB >> 4, n = rows * cpr;
    for (int i = tid; i < n; i += 512) { const int r = i / cpr, c = i - r * cpr; *(LAS u32x4*)(fl + r * (rowB + 16) + c * 16) = *(const u32x4*)((const unsigned char*)Fm + (size_t)r * rowB + c * 16); }
    __syncthreads();
}
template <int NKS, int GRP = 4, int NMB = 8>
__device__ __forceinline__ void dft_mma(f32x4 (&acc)[NMB], const bf16* Fm, int ldF, int mrow0, const bf16* re, const bf16* im, size_t rstride, int khalf, int lane) {
    const int lr = lane & 15, g = lane >> 4;
#pragma unroll
    for (int k0 = 0; k0 < NKS; k0 += GRP) {
        bf16x8 bfrag[GRP];
#pragma unroll
        for (int kq = 0; kq < GRP; ++kq) { const int ks = k0 + kq; const int kk0 = 32 * ks + 8 * g; const bool part = kk0 >= khalf; const int idx = part ? kk0 - khalf : kk0;
            const bf16* src = (part ? im : re) + (size_t)idx * rstride + lr; unsigned short t[8];
#pragma unroll
            for (int e = 0; e < 8; ++e) t[e] = src[(size_t)e * rstride];
            u32x4 w; w.x = t[0] | ((unsigned)t[1] << 16); w.y = t[2] | ((unsigned)t[3] << 16); w.z = t[4] | ((unsigned)t[5] << 16); w.w = t[6] | ((unsigned)t[7] << 16);
            bfrag[kq] = __builtin_bit_cast(bf16x8, w); }
#pragma unroll
        for (int kq = 0; kq < GRP; ++kq) { const int ks = k0 + kq;
            bf16x8 a[NMB];
#pragma unroll
            for (int mb = 0; mb < NMB; ++mb) a[mb] = *(const bf16x8*)(Fm + (size_t)(mrow0 + 16 * mb + lr) * ldF + 32 * ks + 8 * g);
#pragma unroll
            for (int mb = 0; mb < NMB; ++mb) acc[mb] = MFMA16(a[mb], bfrag[kq], acc[mb]);
            if (kq & 1) __builtin_amdgcn_sched_barrier(0);
        }
    }
}
__device__ __forceinline__ void dft_mma_loop(f32x4 (&acc)[8], const bf16* Fm, int ldF, int mrow0, int nks, const bf16* re, const bf16* im, size_t rstride, int khalf, int lane) {
    const int lr = lane & 15, g = lane >> 4;
#pragma unroll 1
    for (int ks = 0; ks < nks; ++ks) { const int kk0 = 32 * ks + 8 * g; const bool part = kk0 >= khalf; const int idx = part ? kk0 - khalf : kk0;
        const bf16* src = (part ? im : re) + (size_t)idx * rstride + lr; unsigned short t[8];
#pragma unroll
        for (int e = 0; e < 8; ++e) t[e] = src[(size_t)e * rstride];
        u32x4 w; w.x = t[0] | ((unsigned)t[1] << 16); w.y = t[2] | ((unsigned)t[3] << 16); w.z = t[4] | ((unsigned)t[5] << 16); w.w = t[6] | ((unsigned)t[7] << 16);
        const bf16x8 bfrag = __builtin_bit_cast(bf16x8, w);
#pragma unroll
        for (int mb = 0; mb < 8; ++mb) { const bf16x8 a = *(const bf16x8*)(Fm + (size_t)(mrow0 + 16 * mb + lr) * ldF + 32 * ks + 8 * g); acc[mb] = MFMA16(a, bfrag, acc[mb]); }
    }
}
__device__ __forceinline__ void fft_stage1(Ctx& F) {
    const int lr = F.lane & 15, g = F.lane >> 4;
    f_to_lds(F.lds, F.F1, 128, 256, F.tid);
    for (int it = F.gw; it < 4096; it += F.NGW) { const int cb = it & 15, n2 = (it >> 4) & 127, b = it >> 11;
        f32x4 acc[8];
#pragma unroll
        for (int mb = 0; mb < 8; ++mb) acc[mb] = (f32x4){0.f, 0.f, 0.f, 0.f};
        const bf16* re = F.PB + (size_t)(b * SEQ + n2) * NP + PFA + 16 * cb;
        dft_mma_lds<4, 4>(acc, F.lds, 272, re, re + 256, (size_t)128 * NP, 64, F.lane);
#pragma unroll
        for (int mb = 0; mb < 4; ++mb)
#pragma unroll
            for (int r = 0; r < 4; ++r) { const int k1 = 16 * mb + 4 * g + r; const float a = (float)(k1 * n2) * (1.f / 8192.f); const float c = cos_rev(a), s = sin_rev(a);
                const float tr = acc[mb][r], ti = acc[mb + 4][r]; const float xr = tr * c + ti * s, xi = ti * c - tr * s;
                bf16* dst = F.TB + ((size_t)((b * 64 + k1) * 2) * 128 + n2) * 256 + 16 * cb + lr;
                dst[0] = (bf16)f2bf(xr); dst[(size_t)128 * 256] = (bf16)f2bf(xi); }
    }
}
__device__ __forceinline__ void fft_stage2(Ctx& F, int l) {
    const int lr = F.lane & 15, g = F.lane >> 4;
    f_to_lds(F.lds, F.F2, 128, 512, F.tid);
    for (int it = F.gw; it < 2048; it += F.NGW) {
        f32x4 acc[8];
#pragma unroll
        for (int mb = 0; mb < 8; ++mb) acc[mb] = (f32x4){0.f, 0.f, 0.f, 0.f};
        const int cb = it & 15, k1 = (it >> 4) & 63, b = it >> 10;
        const bf16* re = F.TB + (size_t)((b * 64 + k1) * 2) * 128 * 256 + 16 * cb;
        dft_mma_lds<8, 4>(acc, F.lds, 528, re, re + (size_t)128 * 256, 256, 128, F.lane);
#pragma unroll
        for (int mb = 0; mb < 8; ++mb)
#pragma unroll
            for (int r = 0; r < 4; ++r) { const int k2 = 16 * mb + 4 * g + r; F.YMIX[(size_t)(b * SEQ + k1 + 64 * k2) * D + 256 + 16 * cb + lr] = (bf16)f2bf(acc[mb][r]); }
    }
    __syncthreads();
}
__device__ __forceinline__ void ctx_dft(Ctx& F, int w0, int nw) {
    const int lr = F.lane & 15, g = F.lane >> 4;
    for (int it = w0; it >= 0 && it < 256; it += nw) { const int mq = it & 7, cb = (it >> 3) & 15, b = it >> 7;
            f32x4 acc[2] = {(f32x4){0.f, 0.f, 0.f, 0.f}, (f32x4){0.f, 0.f, 0.f, 0.f}};
            const bf16* re = F.PB + (size_t)(ML + b * CTXL) * NP + PFA + 16 * cb;
            dft_mma<8, 4, 2>(acc, F.FC, 512, 32 * mq, re, re, (size_t)NP, 256, F.lane); __builtin_amdgcn_sched_barrier(0);
            dft_mma<8, 4, 2>(acc, F.FC + 256, 512, 32 * mq, re + 256, re + 256, (size_t)NP, 256, F.lane);
#pragma unroll
            for (int mb = 0; mb < 2; ++mb)
#pragma unroll
                for (int r = 0; r < 4; ++r) { const int k = 32 * mq + 16 * mb + 4 * g + r; F.YMIX[(size_t)(ML + b * CTXL + k) * D + 256 + 16 * cb + lr] = (bf16)f2bf(acc[mb][r]); }
        }
}
__device__ __forceinline__ void load8(const bf16* q, float (&v)[8]) { const u32x4 w = *(const u32x4*)q; v[0] = bflo(w.x); v[1] = bfhi(w.x); v[2] = bflo(w.y); v[3] = bfhi(w.y); v[4] = bflo(w.z); v[5] = bfhi(w.z); v[6] = bflo(w.w); v[7] = bfhi(w.w); }
__device__ __forceinline__ void store8(bf16* q, const float (&v)[8]) { u32x4 w; w.x = pk2(v[0], v[1]); w.y = pk2(v[2], v[3]); w.z = pk2(v[4], v[5]); w.w = pk2(v[6], v[7]); *(u32x4*)q = w; }
__device__ __forceinline__ u32x4 ldrow(const bf16* base, int rbase, int t, int n, int col) { const int tc = t < 0 ? 0 : (t > n - 1 ? n - 1 : t); return *(const u32x4*)(base + (size_t)(rbase + tc) * NP + col); }
__device__ __forceinline__ void unpack8(const u32x4 w, float (&v)[8]) { v[0] = bflo(w.x); v[1] = bfhi(w.x); v[2] = bflo(w.y); v[3] = bfhi(w.y); v[4] = bflo(w.z); v[5] = bfhi(w.z); v[6] = bflo(w.w); v[7] = bfhi(w.w); }
__device__ __forceinline__ void convpool_item(PP p, Ctx& F, int l, int it) {
    int rbase, n, t0;
    if (it < 256) { rbase = it * 64; n = 64; t0 = 0; } else { const int sg = it - 256; rbase = ML + (sg >> 2) * CTXL; n = CTXL; t0 = (sg & 3) * 64; }
    const int oct = F.tid & 31, tl = F.tid >> 5, c0 = 8 * oct, tb = t0 + tl * 4;
    {
        u32x4 hw_[6], cw_[6], bw_[4];
#pragma unroll
        for (int i = 0; i < 6; ++i) { hw_[i] = ldrow(F.PB, rbase, tb - 1 + i, n, PH + c0); cw_[i] = ldrow(F.PB, rbase, tb - 1 + i, n, PCG + c0); }
#pragma unroll
        for (int q = 0; q < 4; ++q) bw_[q] = ldrow(F.PB, rbase, tb + q, n, PBG + c0);
        const f32x4 w0a = *(const f32x4*)(p->conv_w + (l * 3 + 0) * 256 + c0), w0b = *(const f32x4*)(p->conv_w + (l * 3 + 0) * 256 + c0 + 4);
        const f32x4 w1a = *(const f32x4*)(p->conv_w + (l * 3 + 1) * 256 + c0), w1b = *(const f32x4*)(p->conv_w + (l * 3 + 1) * 256 + c0 + 4);
        const f32x4 w2a = *(const f32x4*)(p->conv_w + (l * 3 + 2) * 256 + c0), w2b = *(const f32x4*)(p->conv_w + (l * 3 + 2) * 256 + c0 + 4);
        const f32x4 cba = *(const f32x4*)(p->conv_b + l * 256 + c0), cbb = *(const f32x4*)(p->conv_b + l * 256 + c0 + 4);
        float hc[6][8];
#pragma unroll
        for (int i = 0; i < 6; ++i) { float a[8], b[8]; unpack8(hw_[i], a); unpack8(cw_[i], b); const int t = tb - 1 + i; const float msk = (t >= 0 && t < n) ? 1.f : 0.f;
#pragma unroll
            for (int e = 0; e < 8; ++e) hc[i][e] = a[e] * b[e] * msk; }
#pragma unroll
        for (int q = 0; q < 4; ++q) { float bg[8], y[8]; unpack8(bw_[q], bg);
#pragma unroll
            for (int e = 0; e < 8; ++e) { const float w0 = e < 4 ? w0a[e & 3] : w0b[e & 3], w1 = e < 4 ? w1a[e & 3] : w1b[e & 3], w2 = e < 4 ? w2a[e & 3] : w2b[e & 3], cb = e < 4 ? cba[e & 3] : cbb[e & 3];
                y[e] = bg[e] * (w0 * hc[q][e] + w1 * hc[q + 1][e] + w2 * hc[q + 2][e] + cb); }
            store8(F.YMIX + (size_t)(rbase + tb + q) * D + 512 + c0, y); }
    }
    __builtin_amdgcn_sched_barrier(0);
    {
        const int wnd = 2 << (oct >> 3), hw = wnd >> 1;
        float s[4][8], self[4][8];
#pragma unroll
        for (int q = 0; q < 4; ++q) { unpack8(ldrow(F.PB, rbase, tb + q, n, PPOOL + c0), self[q]);
#pragma unroll
            for (int e = 0; e < 8; ++e) s[q][e] = 0.f; }
        __builtin_amdgcn_sched_barrier(0);
#pragma unroll
        for (int bt = 0; bt < 19; bt += 7) {
            u32x4 pw[7];
#pragma unroll
            for (int ii = 0; ii < 7; ++ii) if (bt + ii < 19) pw[ii] = ldrow(F.PB, rbase, tb - hw + bt + ii, n, PPOOL + c0);
#pragma unroll
            for (int ii = 0; ii < 7; ++ii) if (bt + ii < 19) { const int i = bt + ii; float v[8]; unpack8(pw[ii], v); const int t = tb - hw + i; const bool inr = (t >= 0 && t < n);
#pragma unroll
                for (int q = 0; q < 4; ++q) { const float mk = (inr && i >= q && i < q + wnd) ? 1.f : 0.f;
#pragma unroll
                    for (int e = 0; e < 8; ++e) s[q][e] += mk * v[e]; } }
            __builtin_amdgcn_sched_barrier(0);
        }
#pragma unroll
        for (int q = 0; q < 4; ++q) { const int t = tb + q; const int lo = (t - hw > 0) ? t - hw : 0, hi = (t + hw - 1 < n - 1) ? t + hw - 1 : n - 1; const float inv = 1.f / (float)(hi - lo + 1);
            float y[8];
#pragma unroll
            for (int e = 0; e < 8; ++e) y[e] = s[q][e] * inv - self[q][e];
            store8(F.YMIX + (size_t)(rbase + t) * D + 768 + c0, y); }
    }
}
__device__ __forceinline__ void ctx_act(PP p, Ctx& F, int l) {
    const int gt = blockIdx.x * 512 + F.tid, NT = F.G * 512;
    for (int i = gt; i < MC * 352; i += NT) { const int oc = i % 352, rc = i / 352, t = rc & 255, c0 = 8 * oc;
        const bf16* base = F.CAU + (size_t)rc * NUP + c0; float a[8], y[8], u[8];
        const float* cw = p->ffn_cw + (size_t)l * 3 * DFF + c0; const float* cb = p->ffn_cb + (size_t)l * DFF + c0;
#pragma unroll
        for (int e = 0; e < 8; ++e) y[e] = cb[e];
        if (t > 0) { load8(base - NUP, a);
#pragma unroll
            for (int e = 0; e < 8; ++e) y[e] += cw[e] * a[e]; }
        load8(base, a);
#pragma unroll
        for (int e = 0; e < 8; ++e) y[e] += cw[DFF + e] * a[e];
        if (t < 255) { load8(base + NUP, a);
#pragma unroll
            for (int e = 0; e < 8; ++e) y[e] += cw[2 * DFF + e] * a[e]; }
        load8(base + DFF, u);
#pragma unroll
        for (int e = 0; e < 8; ++e) y[e] = silu_f(y[e]) * u[e];
        store8(F.ACT + (size_t)(ML + rc) * DFF + c0, y);
    }
}
__global__ void __launch_bounds__(512, 2) fwd_megakernel(Params p_) {
    PP p = (PP)__builtin_amdgcn_kernarg_segment_ptr();
    extern __shared__ __attribute__((aligned(16))) unsigned char lds_raw[];
    cg::grid_group grid = cg::this_grid();
    Ctx F;
    F.lds = (LAS unsigned char*)lds_raw; F.tid = threadIdx.x; F.lane = F.tid & 63; F.wave = __builtin_amdgcn_readfirstlane(F.tid >> 6);
    const int wave_s = F.wave;
    F.G = gridDim.x; F.gw = blockIdx.x * 8 + F.wave; F.NGW = F.G * 8;
    unsigned char* ws = p->ws;
#define SETPTRS() do { { PP q_ = (PP)__builtin_amdgcn_kernarg_segment_ptr(); asm volatile("" : "+s"(q_)); p = q_; } unsigned char* w_ = p->ws; asm volatile("" : "+s"(w_)); \
    F.MOD = (float*)(w_ + WS_MOD); F.MCS = (float*)(w_ + WS_MCS); F.F1 = (bf16*)(w_ + WS_F1); F.F2 = (bf16*)(w_ + WS_F2); F.FC = (bf16*)(w_ + WS_FC); \
    F.HX = (bf16*)(w_ + WS_HX); F.TB = (bf16*)(w_ + WS_HX); F.YMIX = (bf16*)(w_ + WS_YMIX); F.PB = (bf16*)(w_ + WS_P); F.ACT = (bf16*)(w_ + WS_P); \
    F.XC = (float*)(w_ + WS_XC); F.ST = (float*)(w_ + WS_ST); F.DEC = (float*)(w_ + WS_DEC); F.CAU = (bf16*)(w_ + WS_CAU); } while (0)
    SETPTRS();

#ifndef NO_P0
#define REFRESH() do { int t_; asm volatile("v_mbcnt_lo_u32_b32 %0, -1, 0\n\tv_mbcnt_hi_u32_b32 %0, -1, %0" : "=v"(t_)); t_ |= (wave_s << 6); F.tid = t_; F.lane = t_ & 63; F.wave = __builtin_amdgcn_readfirstlane(t_ >> 6); F.gw = blockIdx.x * 8 + F.wave; SETPTRS(); } while (0)
    { volatile LAS unsigned* misc = (volatile LAS unsigned*)(F.lds + RING_BYTES); if (F.tid < 64) misc[F.tid] = 0u; }
    __syncthreads();
    XcdBarrier bar = xcd_barrier_post((unsigned*)(ws + WS_CTL), (volatile LAS unsigned*)(F.lds + RING_BYTES) + 8, F.tid);
#define GSYNC() do { REFRESH(); xcd_barrier(bar, F.tid); } while (0)
    REFRESH();
    phase0(p, F);
#endif
    if (p->ws == nullptr) grid.sync();
    GSYNC();
#define L0() ({ int lq_ = l; asm volatile("" : "+s"(lq_)); lq_ == 0; })
    for (int l = 0; l < 2; ++l) {
        const int M6 = L0() ? MT : ML;
#ifndef NO_P1
        REFRESH();
        norm_phase(p, F, l, 0, MT);
        REFRESH();
        if (L0()) fold_items(p, F);
#ifdef PROBE_B
        REFRESH(); norm_phase(p, F, l, 0, MT); if (L0()) fold_items(p, F);
#endif
#endif
        GSYNC();
#ifndef NO_P2
        REFRESH();
        { pg8::Gemm g{F.HX, win_t(p, l), MT, NP, D, D}; pg8::StaticOrder S; S.init(MT, NP, F.G, (int)blockIdx.x);
          EpiP E{F.PB, p->b_a2 + l * 256};
          pg8::gemm_phase<EpiP, pg8::StaticOrder, true, true>(F.lds, g, S, E, F.tid);
#ifdef PROBE_C
          __syncthreads(); pg8::gemm_phase<EpiP, pg8::StaticOrder, true, true>(F.lds, g, S, E, F.tid);
#endif
        }
#endif
        GSYNC();
#ifdef PROBE_A
        for (int rep_ = 0; rep_ < 2; ++rep_) {
#else
        {
#endif
#ifndef NO_GA
        REFRESH();
        for (int it = blockIdx.x; it < 2 * NCH; it += F.G) gla_a_item(F, it / NCH, it % NCH);
#ifdef PR_GA
        __syncthreads(); REFRESH();
        for (int it = blockIdx.x; it < 2 * NCH; it += F.G) gla_a_item(F, it / NCH, it % NCH);
#endif
#endif
#ifndef NO_F1
        REFRESH();
        fft_stage1(F);
#ifdef PR_F1
        __syncthreads(); REFRESH();
        fft_stage1(F);
#endif
#endif
#ifndef NO_CP
        REFRESH();
        for (int v = blockIdx.x; v < 512; v += F.G) { const int it = (v < 256) ? v : 256 + ((v + 248) & 255);
            if (it >= (L0() ? 264 : 256)) continue; convpool_item(p, F, l, it); }
#ifdef PR_CP
        __syncthreads(); REFRESH();
        for (int v = blockIdx.x; v < 512; v += F.G) { const int it = (v < 256) ? v : 256 + ((v + 248) & 255);
            if (it >= (L0() ? 264 : 256)) continue; convpool_item(p, F, l, it); }
#endif
#endif
        }
        GSYNC();
#ifdef PROBE_A
        REFRESH(); fft_stage2(F, l);
#endif
#ifndef NO_F2
        REFRESH();
        fft_stage2(F, l);
#ifdef PR_F2
        __syncthreads(); REFRESH();
        fft_stage2(F, l);
#endif
#endif
#ifndef NO_SC
        REFRESH();
        gla_scan(F);
#endif
        GSYNC();
#ifdef PROBE_A
        for (int rep_ = 0; rep_ < 2; ++rep_) {
#else
        {
#endif
#ifndef NO_GC
        REFRESH();
        for (int it = blockIdx.x; it < 256; it += F.G) gla_c_item<2>(p, F, l, it >> 7, 4 + (it & 127), 0);
        if (L0()) for (int j = blockIdx.x; j < 16; j += F.G) gla_c_item<1>(p, F, l, j >> 3, (j >> 1) & 3, j & 1);
        if (L0()) { if (F.G == 256) ctx_dft(F, F.gw - 256, 1 << 30); else ctx_dft(F, F.gw, F.NGW); }
#ifdef PR_GC
        __syncthreads(); REFRESH();
        for (int it = blockIdx.x; it < 256; it += F.G) gla_c_item<2>(p, F, l, it >> 7, 4 + (it & 127), 0);
#endif
#endif
        }
        GSYNC();
#ifndef NO_P6
        REFRESH();
        if (L0()) { pg8::Gemm g{F.YMIX, wout_t(p, l), MT, D, 256, D}; SplitOrder S; S.init(4, F.G, (int)blockIdx.x);
          EpiPartial E{(float*)(p->ws + WS_PART)};
          pg8::gemm_phase<EpiPartial, SplitOrder, false, false>(F.lds, g, S, E, F.tid); __syncthreads(); }
        REFRESH();
        { pg8::Gemm g{F.YMIX, wout_t(p, l), ML, D, D, D}; pg8::StaticOrder S; S.init(ML, D, F.G, (int)blockIdx.x);
          if (L0()) { EpiRes<false, true> E{p->x, p->out, F.MOD + l * 3 * 6144 + 2048}; pg8::gemm_phase<EpiRes<false, true>, pg8::StaticOrder, true, true>(F.lds, g, S, E, F.tid); }
          else if (F.G == 256) { EpiResNorm E{(const bf16*)p->out, (bf16*)(p->ws + WS_XB2), F.HX, F.MOD + l * 3 * 6144 + 2048, p->norm2_g + l * D, F.MOD + l * 3 * 6144, (float*)(p->ws + WS_SLOT) + 65536 * 2, (unsigned*)(p->ws + WS_CTL) + CW_FIN + 4096};
            pg8::gemm_phase<EpiResNorm, pg8::StaticOrder, false, true>(F.lds, g, S, E, F.tid); }
          else { EpiRes<true, true> E{p->out, p->out, F.MOD + l * 3 * 6144 + 2048}; pg8::gemm_phase<EpiRes<true, true>, pg8::StaticOrder, true, true>(F.lds, g, S, E, F.tid); } }
#endif
        GSYNC();
        if (L0() || F.G != 256) { REFRESH(); norm_phase(p, F, l, 1, M6); GSYNC(); }
#ifndef NO_P8
        REFRESH();
        { pg8::Gemm g{F.HX, wup_t(p, l), ML, NUP, D, D}; pg8::StaticOrder S; S.init(ML, NUP, F.G, (int)blockIdx.x);
          EpiUp E{F.ACT, p->ffn_cw + (size_t)l * 3 * DFF, p->ffn_cb + (size_t)l * DFF};
          pg8::gemm_phase<EpiUp, pg8::StaticOrder, true, true>(F.lds, g, S, E, F.tid);
        }
        if (L0()) { REFRESH(); __syncthreads();
          pg8::Gemm g{F.HX, wup_t(p, l), MT, NUP, D, D}; CtxOrder S; S.init(NUP, (int)blockIdx.x, 128);
          EpiUpCtx E{F.ACT, p->ffn_cw + (size_t)l * 3 * DFF, p->ffn_cb + (size_t)l * DFF, (LAS float*)(F.lds + RING_BYTES + 1024)};
          pg8::gemm_phase<EpiUpCtx, CtxOrder, true, false>(F.lds, g, S, E, F.tid); }
#endif
        GSYNC();
#ifndef NO_P9
        REFRESH();
        if (L0()) { pg8::Gemm g{F.ACT, wdn_t(p, l), MT, D, 256, DFF}; SplitOrder S; S.init(11, F.G, (int)blockIdx.x);
          EpiPartial E{(float*)(p->ws + WS_PART)};
          pg8::gemm_phase<EpiPartial, SplitOrder, false, false>(F.lds, g, S, E, F.tid); __syncthreads(); }
        REFRESH();
        { pg8::Gemm g{F.ACT, wdn_t(p, l), ML, D, DFF, DFF}; pg8::StaticOrder S; S.init(ML, D, F.G, (int)blockIdx.x);
          if (L0()) { EpiRes<true, true> E{p->out, p->out, F.MOD + l * 3 * 6144 + 5120}; pg8::gemm_phase<EpiRes<true, true>, pg8::StaticOrder, true, true>(F.lds, g, S, E, F.tid); }
          else if (F.G == 256) { EpiFinal E{(const bf16*)(p->ws + WS_XB2), p->out, F.MOD + l * 3 * 6144 + 5120, p->final_g, (float*)(p->ws + WS_SLOT), (unsigned*)(p->ws + WS_CTL) + CW_FIN};
            pg8::gemm_phase<EpiFinal, pg8::StaticOrder, false, true>(F.lds, g, S, E, F.tid); }
          else { EpiRes<true, false> E{p->out, p->ws + WS_HX, F.MOD + l * 3 * 6144 + 5120}; pg8::gemm_phase<EpiRes<true, false>, pg8::StaticOrder, true, true>(F.lds, g, S, E, F.tid); } }
#endif
        if (L0() || F.G != 256) GSYNC();
    }
        REFRESH();
    if (F.G != 256) final_norm(p, F);
}

extern "C" void kernel_launch(void* const* d_in, const int* in_sizes, int n_in, void* d_out, int out_size, void* d_ws, size_t ws_size, hipStream_t stream) {
    static int grid = 0;
    if (grid == 0) {
        if (n_in != 23 || in_sizes[0] != ML * D || out_size != ML * D || ws_size < WS_END) { fprintf(stderr, "kernel_launch: unexpected shapes / workspace (%d inputs, ws %zu)\n", n_in, ws_size); grid = -1; return; }
        int dev = 0, cus = 0, per_cu = 0;
        hipGetDevice(&dev); hipDeviceGetAttribute(&cus, hipDeviceAttributeMultiprocessorCount, dev);
        if (hipFuncSetAttribute((const void*)fwd_megakernel, hipFuncAttributeMaxDynamicSharedMemorySize, LDS_BYTES) != hipSuccess) { fprintf(stderr, "hipFuncSetAttribute failed\n"); grid = -1; return; }
        if (hipOccupancyMaxActiveBlocksPerMultiprocessor(&per_cu, (const void*)fwd_megakernel, 512, LDS_BYTES) != hipSuccess || per_cu < 1) per_cu = 1;
        (void)hipGetLastError();
        grid = cus * 1;
    }
    if (grid < 0) return;
    if (hipMemsetAsync((char*)d_ws + WS_CTL, 0, 65536, stream) != hipSuccess) { fprintf(stderr, "memset failed\n"); return; }
    Params p{};
    const float** pp = (const float**)&p;
    for (int i = 0; i < 23; ++i) pp[i] = (const float*)d_in[i];
    p.out = (float*)d_out; p.ws = (unsigned char*)d_ws;
    void* args[] = {&p};
    hipError_t e = hipLaunchCooperativeKernel((const void*)fwd_megakernel, dim3(grid), dim3(512), args, LDS_BYTES, stream);
    if (e != hipSuccess) fprintf(stderr, "cooperative launch failed: %s (grid %d)\n", hipGetErrorString(e), grid);
}
```
